# Optimizing an MI355X kernel written in HIP

```python
import jax
import jax.numpy as jnp
from jax import lax
import numpy as np

D_MODEL = 1024
BATCH = 2
SEQ = 8192
DEPTH = 1

GRID_W = 64
Q_BLOCK = 128
ROPE_THETA = 10000.0
NORM_EPS = 1e-6

MLA_HEADS = 8
MLA_Q_LORA = 256
MLA_KV_LORA = 128
MLA_NOPE = 64
MLA_ROPE = 32
MLA_V = 64
MLA_WIDTH = MLA_HEADS * MLA_V

GQA_HEADS = 8
GQA_KV_HEADS = 2
GQA_HEAD_DIM = 64
GQA_GROUP = GQA_HEADS // GQA_KV_HEADS
GQA_WIDTH = GQA_HEADS * GQA_HEAD_DIM
GQA_KV_WIDTH = GQA_KV_HEADS * GQA_HEAD_DIM

MIX_WIDTH = MLA_WIDTH + GQA_WIDTH
IN_COLS = MLA_Q_LORA + MLA_KV_LORA + MLA_ROPE + GQA_WIDTH + 2 * GQA_KV_WIDTH
IN_SPLITS = (MLA_Q_LORA,
             MLA_Q_LORA + MLA_KV_LORA,
             MLA_Q_LORA + MLA_KV_LORA + MLA_ROPE,
             MLA_Q_LORA + MLA_KV_LORA + MLA_ROPE + GQA_WIDTH,
             MLA_Q_LORA + MLA_KV_LORA + MLA_ROPE + GQA_WIDTH + GQA_KV_WIDTH)

N_EXPERTS = 256
TOP_K = 8
N_GROUPS = 8
TOPK_GROUPS = 4
EXPERT_FF = 256
SHARED_FF = 256
ROUTED_SCALE = 2.5
EXPERT_BLOCK = 128

N_MOD = 6

kernel_name = "hybrid_mla_gqa_moe_encoder_layer"


def rms_norm(x, g):
    xf = x.astype(jnp.float32)
    y = xf * lax.rsqrt(jnp.mean(xf * xf, axis=-1, keepdims=True) + NORM_EPS)
    return (y * g.astype(jnp.float32)).astype(x.dtype)


def swiglu(x, w_gate, w_up, w_down):
    return (jax.nn.silu(x @ w_gate) * (x @ w_up)) @ w_down


def axial_rope_tables(n, dim):
    rows = n // GRID_W
    row = jnp.broadcast_to(jnp.arange(rows, dtype=jnp.float32)[:, None], (rows, GRID_W)).reshape(n)
    col = jnp.broadcast_to(jnp.arange(GRID_W, dtype=jnp.float32)[None, :], (rows, GRID_W)).reshape(n)
    n_freq = dim // 4
    inv_freq = ROPE_THETA ** (-jnp.arange(n_freq, dtype=jnp.float32) / n_freq)
    ang = jnp.concatenate([row[:, None] * inv_freq, col[:, None] * inv_freq], axis=-1)
    return jnp.cos(ang), jnp.sin(ang)


def apply_rope(x, cos, sin):
    d = x.shape[-1]
    xp = x.reshape(*x.shape[:-1], d // 2, 2)
    bshape = (1, cos.shape[0]) + (1,) * (x.ndim - 3) + (cos.shape[1],)
    c = cos.reshape(bshape).astype(x.dtype)
    s = sin.reshape(bshape).astype(x.dtype)
    x0, x1 = xp[..., 0], xp[..., 1]
    return jnp.stack([x0 * c - x1 * s, x0 * s + x1 * c], axis=-1).reshape(x.shape)


def sweep_query_blocks(block_fn, *qs):
    b, s = qs[0].shape[:2]
    nb = s // Q_BLOCK
    blocked = tuple(jnp.moveaxis(q.reshape(b, nb, Q_BLOCK, *q.shape[2:]), 1, 0) for q in qs)
    out = lax.map(lambda args: block_fn(*args), blocked)
    out = jnp.moveaxis(out, 0, 1)
    return out.reshape(b, s, *out.shape[3:])


def mla_attention(q_lat, kv_lat, k_rope, g_q_a, w_q_b, g_kv_a, w_kv_b, cos, sin):
    b, s, _ = q_lat.shape
    q = (rms_norm(q_lat, g_q_a) @ w_q_b).reshape(b, s, MLA_HEADS, MLA_NOPE + MLA_ROPE)
    q_nope = q[..., :MLA_NOPE]
    q_pe = apply_rope(q[..., MLA_NOPE:], cos, sin)
    kv = (rms_norm(kv_lat, g_kv_a) @ w_kv_b).reshape(b, s, MLA_HEADS, MLA_NOPE + MLA_V)
    k_nope, v = kv[..., :MLA_NOPE], kv[..., MLA_NOPE:]
    k_pe = apply_rope(k_rope, cos, sin)
    scale = (MLA_NOPE + MLA_ROPE) ** -0.5

    def block(qn, qr):
        sc = (jnp.einsum('bqhd,bkhd->bhqk', qn, k_nope)
              + jnp.einsum('bqhr,bkr->bhqk', qr, k_pe))
        p = jax.nn.softmax(sc.astype(jnp.float32) * scale, axis=-1).astype(v.dtype)
        return jnp.einsum('bhqk,bkhd->bqhd', p, v)

    o = sweep_query_blocks(block, q_nope, q_pe)
    return o.reshape(b, s, MLA_WIDTH)


def gqa_attention(q, k, v, g_q_head, g_k_head, cos, sin):
    b, s, _ = q.shape
    q = rms_norm(q.reshape(b, s, GQA_HEADS, GQA_HEAD_DIM), g_q_head)
    q = apply_rope(q, cos, sin).reshape(b, s, GQA_KV_HEADS, GQA_GROUP, GQA_HEAD_DIM)
    k = apply_rope(rms_norm(k.reshape(b, s, GQA_KV_HEADS, GQA_HEAD_DIM), g_k_head), cos, sin)
    v = v.reshape(b, s, GQA_KV_HEADS, GQA_HEAD_DIM)
    scale = GQA_HEAD_DIM ** -0.5

    def block(qb):
        sc = jnp.einsum('bqhgd,bkhd->bhgqk', qb, k)
        p = jax.nn.softmax(sc.astype(jnp.float32) * scale, axis=-1).astype(v.dtype)
        return jnp.einsum('bhgqk,bkhd->bqhgd', p, v)

    o = sweep_query_blocks(block, q)
    return o.reshape(b, s, GQA_WIDTH)


def routed_experts(t, top_idx, top_w, w_gate_e, w_up_e, w_down_e):
    n, d = t.shape
    a = n * TOP_K
    flat_e = top_idx.reshape(a).astype(jnp.int32)
    flat_tok = jnp.repeat(jnp.arange(n, dtype=jnp.int32), TOP_K)
    flat_w = top_w.reshape(a).astype(t.dtype)
    counts = jnp.zeros((N_EXPERTS,), jnp.int32).at[flat_e].add(1)
    padded = (counts + EXPERT_BLOCK - 1) // EXPERT_BLOCK * EXPERT_BLOCK
    pad_end = jnp.cumsum(padded)
    pad_start = pad_end - padded
    raw_start = jnp.cumsum(counts) - counts
    order = jnp.argsort(flat_e)
    sorted_e = flat_e[order]
    dest = pad_start[sorted_e] + (jnp.arange(a, dtype=jnp.int32) - raw_start[sorted_e])
    n_blocks = (a + EXPERT_BLOCK - 1) // EXPERT_BLOCK + N_EXPERTS
    p_rows = n_blocks * EXPERT_BLOCK
    buf_tok = jnp.full((p_rows,), n, jnp.int32).at[dest].set(flat_tok[order])
    buf_w = jnp.zeros((p_rows,), t.dtype).at[dest].set(flat_w[order])
    block_starts = jnp.arange(n_blocks, dtype=jnp.int32) * EXPERT_BLOCK
    block_expert = jnp.minimum(jnp.searchsorted(pad_end, block_starts, side='right'),
                               N_EXPERTS - 1).astype(jnp.int32)
    t_pad = jnp.concatenate([t, jnp.zeros((1, d), t.dtype)], axis=0)

    def expert_block(args):
        tok, e, wts = args
        xb = t_pad[tok]
        return swiglu(xb, w_gate_e[e], w_up_e[e], w_down_e[e]) * wts[:, None]

    out = lax.map(expert_block, (buf_tok.reshape(n_blocks, EXPERT_BLOCK), block_expert,
                                 buf_w.reshape(n_blocks, EXPERT_BLOCK)))
    return jnp.zeros((n + 1, d), t.dtype).at[buf_tok].add(out.reshape(p_rows, d))[:n]


def moe_ffn(h, w_router, b_router, w_gate_e, w_up_e, w_down_e, w_gate_s, w_up_s, w_down_s):
    b, s, d = h.shape
    n = b * s
    t = h.reshape(n, d)
    scores = jax.nn.sigmoid(t.astype(jnp.float32) @ w_router.astype(jnp.float32))
    biased = scores + b_router.astype(jnp.float32)
    grouped = biased.reshape(n, N_GROUPS, N_EXPERTS // N_GROUPS)
    group_score = lax.top_k(grouped, 2)[0].sum(axis=-1)
    _, top_groups = lax.top_k(group_score, TOPK_GROUPS)
    group_mask = jnp.any(top_groups[:, :, None] == jnp.arange(N_GROUPS)[None, None, :], axis=1)
    expert_mask = jnp.repeat(group_mask, N_EXPERTS // N_GROUPS, axis=1)
    _, top_idx = lax.top_k(jnp.where(expert_mask, biased, -jnp.inf), TOP_K)
    top_w = jnp.take_along_axis(scores, top_idx, axis=1)
    top_w = top_w / jnp.sum(top_w, axis=-1, keepdims=True) * ROUTED_SCALE
    routed = routed_experts(t, top_idx, top_w, w_gate_e, w_up_e, w_down_e)
    shared = swiglu(t, w_gate_s, w_up_s, w_down_s)
    return (routed + shared).reshape(b, s, d)


def hybrid_layer(x, c, w_ada, b_ada, g_pre_mix, g_post_mix, g_pre_ffn, g_post_ffn, w_in,
                 g_q_a, w_q_b, g_kv_a, w_kv_b, g_q_head, g_k_head, g_mla_out, g_gqa_out,
                 w_out, w_router, b_router, w_gate_e, w_up_e, w_down_e,
                 w_gate_s, w_up_s, w_down_s):
    b, s, _ = x.shape
    mod = (jax.nn.silu(c) @ w_ada + b_ada)[:, None, :]
    shift_m, scale_m, gate_m, shift_f, scale_f, gate_f = jnp.split(mod, N_MOD, axis=-1)

    h = rms_norm(x, g_pre_mix) * (1 + scale_m) + shift_m
    proj = h @ w_in
    q_lat, kv_lat, k_rope, q_g, k_g, v_g = jnp.split(proj, IN_SPLITS, axis=-1)
    cos_m, sin_m = axial_rope_tables(s, MLA_ROPE)
    cos_g, sin_g = axial_rope_tables(s, GQA_HEAD_DIM)
    o_mla = mla_attention(q_lat, kv_lat, k_rope, g_q_a, w_q_b, g_kv_a, w_kv_b, cos_m, sin_m)
    o_gqa = gqa_attention(q_g, k_g, v_g, g_q_head, g_k_head, cos_g, sin_g)
    mixed = jnp.concatenate([rms_norm(o_mla, g_mla_out), rms_norm(o_gqa, g_gqa_out)],
                            axis=-1) @ w_out
    x = x + gate_m * rms_norm(mixed, g_post_mix)

    h = rms_norm(x, g_pre_ffn) * (1 + scale_f) + shift_f
    y = moe_ffn(h, w_router, b_router, w_gate_e, w_up_e, w_down_e, w_gate_s, w_up_s, w_down_s)
    return x + gate_f * rms_norm(y, g_post_ffn)


def setup_inputs(seed: int = 0) -> dict:
    key = jax.random.key(seed)
    ks = jax.random.split(key, 26)
    L, D = DEPTH, D_MODEL

    def nrm(k, shape, scale):
        return jax.random.normal(k, shape, jnp.float32) * scale

    def gain(k, shape):
        return 1.0 + 0.02 * jax.random.normal(k, shape, jnp.float32)

    return {
        "x": nrm(ks[0], (BATCH, SEQ, D), 1.0),
        "c": nrm(ks[1], (BATCH, D), 1.0),
        "w_ada": nrm(ks[2], (L, D, N_MOD * D), 0.5 * D ** -0.5),
        "b_ada": nrm(ks[3], (L, N_MOD * D), 0.02),
        "g_pre_mix": gain(ks[4], (L, D)),
        "g_post_mix": gain(ks[5], (L, D)),
        "g_pre_ffn": gain(ks[6], (L, D)),
        "g_post_ffn": gain(ks[7], (L, D)),
        "w_in": nrm(ks[8], (L, D, IN_COLS), D ** -0.5),
        "g_q_a": gain(ks[9], (L, MLA_Q_LORA)),
        "w_q_b": nrm(ks[10], (L, MLA_Q_LORA, MLA_HEADS * (MLA_NOPE + MLA_ROPE)), MLA_Q_LORA ** -0.5),
        "g_kv_a": gain(ks[11], (L, MLA_KV_LORA)),
        "w_kv_b": nrm(ks[12], (L, MLA_KV_LORA, MLA_HEADS * (MLA_NOPE + MLA_V)), MLA_KV_LORA ** -0.5),
        "g_q_head": gain(ks[13], (L, GQA_HEAD_DIM)),
        "g_k_head": gain(ks[14], (L, GQA_HEAD_DIM)),
        "g_mla_out": gain(ks[15], (L, MLA_WIDTH)),
        "g_gqa_out": gain(ks[16], (L, GQA_WIDTH)),
        "w_out": nrm(ks[17], (L, MIX_WIDTH, D), MIX_WIDTH ** -0.5),
        "w_router": nrm(ks[18], (L, D, N_EXPERTS), D ** -0.5),
        "b_router": nrm(ks[19], (L, N_EXPERTS), 0.01),
        "w_gate_e": nrm(ks[20], (L, N_EXPERTS, D, EXPERT_FF), D ** -0.5),
        "w_up_e": nrm(ks[21], (L, N_EXPERTS, D, EXPERT_FF), D ** -0.5),
        "w_down_e": nrm(ks[22], (L, N_EXPERTS, EXPERT_FF, D), EXPERT_FF ** -0.5),
        "w_gate_s": nrm(ks[23], (L, D, SHARED_FF), D ** -0.5),
        "w_up_s": nrm(ks[24], (L, D, SHARED_FF), D ** -0.5),
        "w_down_s": nrm(ks[25], (L, SHARED_FF, D), SHARED_FF ** -0.5),
    }


def reference(x, c, w_ada, b_ada, g_pre_mix, g_post_mix, g_pre_ffn, g_post_ffn, w_in,
              g_q_a, w_q_b, g_kv_a, w_kv_b, g_q_head, g_k_head, g_mla_out, g_gqa_out,
              w_out, w_router, b_router, w_gate_e, w_up_e, w_down_e,
              w_gate_s, w_up_s, w_down_s):
    for l in range(DEPTH):
        x = hybrid_layer(x, c, w_ada[l], b_ada[l], g_pre_mix[l], g_post_mix[l], g_pre_ffn[l],
                         g_post_ffn[l], w_in[l], g_q_a[l], w_q_b[l], g_kv_a[l], w_kv_b[l],
                         g_q_head[l], g_k_head[l], g_mla_out[l], g_gqa_out[l], w_out[l],
                         w_router[l], b_router[l], w_gate_e[l], w_up_e[l], w_down_e[l],
                         w_gate_s[l], w_up_s[l], w_down_s[l])
    return x
```

```cpp
#include <hip/hip_runtime.h>
#include <cstdio>
#include <cstdint>

#ifndef REP_FROM
#define REP_FROM 99
#endif
#ifndef REPEAT_MASK
#define REPEAT_MASK 0
#endif
#ifndef CONV_MODE
#define CONV_MODE 5
#endif
#ifndef MK_N_LAUNCHES
#define MK_N_LAUNCHES 1
#endif

#ifndef ATTN_NAIVE
#define ATTN_NAIVE 0
#endif
#define LAS __attribute__((address_space(3)))
typedef unsigned short bf16_t;

constexpr int NB = 2, SEQ = 8192, NTOK = NB * SEQ, DM = 1024;
constexpr int QLORA = 256, KVLORA = 128, MROPE = 32, MNOPE = 64, MV = 64, MH = 8, DQKM = 96;
constexpr int GH = 8, GKV = 2, GD = 64;
constexpr int INC = 1184;
constexpr int C_QLAT = 0, C_KVLAT = 256, C_KROPE = 384, C_GQ = 416, C_GK = 928, C_GV = 1056;
constexpr int NE = 256, TOPK = 8, EFF = 256;
constexpr int LCAP = 16384;
constexpr float EPS = 1e-6f;
constexpr float LOG2E = 1.4426950408889634f;
constexpr float C2M = 0.10206207261596575f * LOG2E;
constexpr float C2G = 0.125f * LOG2E;

constexpr size_t MiB = 1u << 20;
constexpr size_t WS_CTL = 0, CTL_ZERO_BYTES = 32768;
constexpr size_t WS_MOD = 1 * MiB;
constexpr size_t WS_COSM = 2 * MiB, WS_SINM = 2 * MiB + 512 * 1024, WS_COSG = 3 * MiB, WS_SING = 4 * MiB;
constexpr size_t WS_WQBT = 5 * MiB;
constexpr size_t WS_WINQ = 5 * MiB + 512 * 1024;
constexpr size_t WS_WKVBT = 6 * MiB;
constexpr size_t WS_WINKV = 6 * MiB + 512 * 1024;
constexpr size_t WS_WDST = 7 * MiB;
constexpr size_t WS_H2 = 8 * MiB;
constexpr size_t WS_X1 = 40 * MiB;
constexpr size_t WS_CNTS = 72 * MiB;
constexpr int CNT_STRIDE = 1088;
constexpr size_t WS_WTS = 104 * MiB;
constexpr size_t WS_OSTAT = 252 * MiB;
constexpr size_t WS_POSREC = 105 * MiB;
constexpr size_t WS_LIST = 106 * MiB;
constexpr size_t WS_WBIGT = 122 * MiB;
constexpr size_t WS_WOUTT = 128 * MiB;
constexpr size_t WS_WRST = 130 * MiB;
constexpr size_t WS_ACT = 132 * MiB;
constexpr size_t WS_LOG = 196 * MiB;
constexpr size_t WS_ACTS = 212 * MiB;
constexpr size_t WS_YSH = 220 * MiB;
constexpr size_t WS_SLOTS = 256 * MiB;
constexpr size_t WS_PBUF = 256 * MiB;
constexpr size_t WS_QM = 352 * MiB, WS_KM = 376 * MiB, WS_VM = 400 * MiB, WS_QG = 416 * MiB, WS_KG = 432 * MiB, WS_VG = 436 * MiB;
constexpr size_t WS_O = 440 * MiB;
constexpr size_t WS_MIXED = 472 * MiB;
constexpr size_t WS_WGUT = 512 * MiB;
constexpr size_t WS_WDT = 768 * MiB;
constexpr size_t WS_END = 896 * MiB;
constexpr size_t WS_HF = 512 * MiB, WS_PROJ = 576 * MiB, WS_H2F = 650 * MiB, WS_GS = 714 * MiB, WS_US = 730 * MiB, WS_ACTSF = 746 * MiB, WS_YSHF = 768 * MiB, WS_LOGF = 832 * MiB;
constexpr int CW_CNT = 1024;
constexpr int CW_KMAX = 2048;
constexpr int CW_BAR = 4096;

constexpr int LDS_BYTES = 147456;
constexpr int NTHR = 512, NWAVES = 8;

#define XB_TMO      128
#define XB_XCNT(j)  (256  + 64 * (j))
#define XB_XSUB(j)  (1280 + 64 * (j))
#define XB_XGEN(j)  (2304 + 64 * (j))
#define XB_TOP      3328
#define XB_TOPGEN   3392
#define XCD_BAR_WORDS 3456
#define XB_SPIN_CAP (1u << 18)
__device__ __forceinline__ unsigned xb_ld(unsigned* p)              { return __hip_atomic_load(p, __ATOMIC_RELAXED, __HIP_MEMORY_SCOPE_AGENT); }
__device__ __forceinline__ unsigned xb_add(unsigned* p, unsigned v) { return __hip_atomic_fetch_add(p, v, __ATOMIC_RELAXED, __HIP_MEMORY_SCOPE_AGENT); }
__device__ __forceinline__ unsigned xb_xcc_id() { return (unsigned)__builtin_amdgcn_s_getreg((3 << 11) | 20) & 0xFu; }
#define XB_SPIN(cond, bar) do { unsigned _sp = 0; while (cond) { __builtin_amdgcn_s_sleep(1); \
    if ((++_sp & 255u) == 0u) { if (xb_ld(&(bar)[XB_TMO])) break; if (_sp > XB_SPIN_CAP) { atomicAdd(&(bar)[XB_TMO], 1u); break; } } } } while (0)
struct XcdBarrier { unsigned* bar; unsigned x; volatile LAS unsigned* st; };
__device__ __forceinline__ XcdBarrier xcd_barrier_post(unsigned* bar, volatile LAS unsigned* st) {
    XcdBarrier b; b.bar = bar; b.x = xb_xcc_id(); b.st = st;
    if (threadIdx.x == 0) (void)xb_add(&bar[XB_XCNT(b.x)], 1u);
    return b;
}
__device__ __forceinline__ void xcd_barrier_complete(unsigned* bar, unsigned x, unsigned& nloc, unsigned& nx) {
    const unsigned G = gridDim.x * gridDim.y * gridDim.z;
    unsigned sum, cnt, mine, sp = 0u;
    for (;;) {
        sum = 0u; cnt = 0u; mine = 0u;
#pragma unroll
        for (unsigned j = 0; j < 16; ++j) { const unsigned c = xb_ld(&bar[XB_XCNT(j)]); sum += c; cnt += (c > 0u) ? 1u : 0u; mine = (j == x) ? c : mine; }
        if (sum == G) break;
        __builtin_amdgcn_s_sleep(1);
        if ((++sp & 255u) == 0u) { if (xb_ld(&bar[XB_TMO])) break; if (sp > XB_SPIN_CAP) { atomicAdd(&bar[XB_TMO], 1u); break; } }
    }
    nloc = mine > 0u ? mine : 1u; nx = cnt > 0u ? cnt : 1u;
}
__device__ __forceinline__ void xcd_barrier(const XcdBarrier& b) {
    asm volatile("s_waitcnt vmcnt(0)" ::: "memory");
    __syncthreads();
    if (threadIdx.x == 0) {
        unsigned* bar = b.bar;
        __builtin_amdgcn_s_waitcnt(0);
        unsigned nloc = b.st[0], nx = b.st[1];
        if (nloc == 0u) { xcd_barrier_complete(bar, b.x, nloc, nx); b.st[0] = nloc; b.st[1] = nx; }
        const unsigned old = xb_add(&bar[XB_XSUB(b.x)], 1u);
        const unsigned gen = old / nloc;
        if (old + 1u == (gen + 1u) * nloc) {
            __builtin_amdgcn_fence(__ATOMIC_RELEASE, "agent");
            asm volatile("s_waitcnt vmcnt(0)" ::: "memory");
            const unsigned og = xb_add(&bar[XB_TOP], 1u);
            const unsigned tg = og / nx;
            if (og + 1u == (tg + 1u) * nx) xb_add(&bar[XB_TOPGEN], 1u);
            else XB_SPIN(xb_ld(&bar[XB_TOPGEN]) == tg, bar);
            __builtin_amdgcn_fence(__ATOMIC_ACQUIRE, "agent");
            xb_add(&bar[XB_XGEN(b.x)], 1u);
            asm volatile("s_waitcnt vmcnt(0)" ::: "memory");
        } else {
            XB_SPIN(xb_ld(&bar[XB_XGEN(b.x)]) == gen, bar);
            __builtin_amdgcn_fence(__ATOMIC_ACQUIRE, "agent");
            asm volatile("s_waitcnt vmcnt(0)" ::: "memory");
        }
    }
    __syncthreads();
}

__device__ __forceinline__ unsigned f2bf(float f) { unsigned u = __builtin_bit_cast(unsigned, f); return (u + 0x7fffu + ((u >> 16) & 1u)) >> 16; }
__device__ __forceinline__ float bf2f(unsigned h) { return __builtin_bit_cast(float, h << 16); }
__device__ __forceinline__ unsigned pk2(float lo, float hi) { return f2bf(lo) | (f2bf(hi) << 16); }
template <int CTRL, int RM> __device__ __forceinline__ float dppmov(float old, float v) {
    return __builtin_bit_cast(float, __builtin_amdgcn_update_dpp(__builtin_bit_cast(int, old), __builtin_bit_cast(int, v), CTRL, RM, 0xF, false)); }
__device__ __forceinline__ float wave_sum(float v) {
    v += dppmov<0xB1, 0xF>(0.f, v);
    v += dppmov<0x4E, 0xF>(0.f, v);
    v += dppmov<0x141, 0xF>(0.f, v);
    v += dppmov<0x140, 0xF>(0.f, v);
    v += dppmov<0x142, 0xA>(0.f, v);
    v += dppmov<0x143, 0xC>(0.f, v);
    return __builtin_bit_cast(float, __builtin_amdgcn_readlane(__builtin_bit_cast(int, v), 63));
}
__device__ __forceinline__ float wave_max(float v) {
    const float NI = -INFINITY;
    v = fmaxf(v, dppmov<0xB1, 0xF>(NI, v)); v = fmaxf(v, dppmov<0x4E, 0xF>(NI, v)); v = fmaxf(v, dppmov<0x141, 0xF>(NI, v)); v = fmaxf(v, dppmov<0x140, 0xF>(NI, v));
    v = fmaxf(v, dppmov<0x142, 0xA>(NI, v)); v = fmaxf(v, dppmov<0x143, 0xC>(NI, v));
    return __builtin_bit_cast(float, __builtin_amdgcn_readlane(__builtin_bit_cast(int, v), 63));
}
__device__ __forceinline__ float grp8_sum(float v) {
    v += dppmov<0xB1, 0xF>(0.f, v); v += dppmov<0x4E, 0xF>(0.f, v); v += dppmov<0x141, 0xF>(0.f, v); return v;
}
__device__ __forceinline__ float grp8_max(float v) {
    const float NI = -INFINITY;
    v = fmaxf(v, dppmov<0xB1, 0xF>(NI, v)); v = fmaxf(v, dppmov<0x4E, 0xF>(NI, v)); v = fmaxf(v, dppmov<0x141, 0xF>(NI, v)); return v;
}
__device__ __forceinline__ float sigmoidf_(float x) { return 1.f / (1.f + __expf(-x)); }

struct Args { const float* in[26]; float* out; unsigned char* ws; int ph_lo, ph_hi; };

struct Ctx {
    int tid, lane, wave, bid, nb, gw, ngw;
    unsigned char* ws; float* lds;
};
__device__ __forceinline__ Ctx mkctx(unsigned char* ws, unsigned char* lds_raw) {
    Ctx c; int t = threadIdx.x; asm volatile("" : "+v"(t));
    c.tid = t; c.lane = t & 63; c.wave = __builtin_amdgcn_readfirstlane(t >> 6);
    c.bid = blockIdx.x; c.nb = gridDim.x; c.gw = c.bid * NWAVES + c.wave; c.ngw = c.nb * NWAVES; c.ws = ws; c.lds = (float*)lds_raw; return c;
}

namespace att {
using bf16x8 = __attribute__((ext_vector_type(8))) short;
using s16x4 = __attribute__((ext_vector_type(4))) short;
using f32x16 = __attribute__((ext_vector_type(16))) float;
using u32x4 = __attribute__((ext_vector_type(4))) unsigned;
typedef float f32x2_t __attribute__((ext_vector_type(2))); typedef __bf16 bf16x2_t __attribute__((ext_vector_type(2)));
typedef __attribute__((address_space(3))) const char* lds_cptr;
typedef short v4i16_t __attribute__((ext_vector_type(4)));
constexpr int NT = SEQ / 64;
constexpr int KSLOT = 12288, VSLOT = 8192, NSLOT = 3;
constexpr int LDS_K = 0, LDS_V = NSLOT * KSLOT, LDS_WS = LDS_V + NSLOT * VSLOT, LDS_OST = LDS_WS + NWAVES * 256, LDS_ATT = LDS_OST + NWAVES * 4096;
#define SBAR() __builtin_amdgcn_sched_barrier(0)
#define MFMA(a, b, c) __builtin_amdgcn_mfma_f32_32x32x16_bf16(a, b, c, 0, 0, 0)
__device__ __forceinline__ int crow(int r, int hi) { return (r & 3) + 8 * (r >> 2) + 4 * hi; }
__device__ __forceinline__ unsigned cvtpk_s(float lo, float hi) { f32x2_t v = {lo, hi}; bf16x2_t b = __builtin_convertvector(v, bf16x2_t); return __builtin_bit_cast(unsigned, b); }
__device__ __forceinline__ void glds16(const void* g, unsigned lds_base) {
    unsigned sv; asm volatile("s_mov_b32 %0, m0\n\ts_mov_b32 m0, %2\n\ts_nop 0\n\tglobal_load_lds_dwordx4 %1, off\n\ts_mov_b32 m0, %0" : "=&s"(sv) : "v"(g), "s"(lds_base) : "memory"); }
__device__ __forceinline__ s16x4 vtr(lds_cptr p) { return __builtin_bit_cast(s16x4, __builtin_amdgcn_ds_read_tr16_b64_v4i16((__attribute__((address_space(3))) v4i16_t*)p)); }
#define MX3(a, b, c) __builtin_fmaxf(__builtin_fmaxf((a), (b)), (c))
__device__ __forceinline__ float rowmax(const f32x16& p0, const f32x16& p1) {
    float a = MX3(p0[0], p0[1], p1[0]), b = MX3(p0[2], p0[3], p1[1]); a = MX3(a, p1[2], p1[3]);
#pragma unroll
    for (int r = 4; r < 16; r += 4) { a = MX3(a, p0[r], p0[r + 1]); b = MX3(b, p0[r + 2], p0[r + 3]); a = MX3(a, p1[r], p1[r + 1]); b = MX3(b, p1[r + 2], p1[r + 3]); }
    float m = __builtin_fmaxf(a, b); auto rr = __builtin_amdgcn_permlane32_swap(__float_as_uint(m), __float_as_uint(m), false, false);
    return __builtin_fmaxf(__uint_as_float(rr[0]), __uint_as_float(rr[1])); }

template <int DQK>
__device__ __forceinline__ void unit_simple(const bf16_t* Qh, const bf16_t* __restrict__ Kh, const bf16_t* __restrict__ Vh, bf16_t* Ob, int q0, char* shm) {
    constexpr int NCH = DQK / 8, ND0 = DQK / 16;
    int tid_ = threadIdx.x; asm volatile("" : "+v"(tid_));
    const int tid = tid_, lane = tid & 63, r32 = lane & 31, hi = lane >> 5; const int wid = __builtin_amdgcn_readfirstlane(tid >> 6);
    const bf16_t* Qw = Qh + (size_t)(q0 + wid * 32) * DQK;
    const unsigned lds0 = (unsigned)(uintptr_t)shm; float* wsf = (float*)(shm + LDS_WS) + wid * 64;
    const bf16_t* ksrc0 = Kh + (size_t)lane * DQK + wid * 8;
    const bf16_t* ksrc1 = Kh + (size_t)lane * DQK + (8 + (wid & 3)) * 8;
    const bf16_t* vsrc = Vh + (size_t)(16 * (wid & 3) + (lane >> 2)) * 64 + (wid >> 2) * 32 + (lane & 3) * 8;
    const unsigned kdst0 = lds0 + LDS_K + wid * 1024, kdst1 = lds0 + LDS_K + (8 + (wid & 3)) * 1024, vdst = lds0 + LDS_V + wid * 1024;
#define DMA_KV(t, sl) do { glds16(ksrc0 + (size_t)(t) * 64 * DQK, (unsigned)__builtin_amdgcn_readfirstlane(kdst0 + (sl) * KSLOT)); \
        if (NCH == 12 && wid < 4) glds16(ksrc1 + (size_t)(t) * 64 * DQK, (unsigned)__builtin_amdgcn_readfirstlane(kdst1 + (sl) * KSLOT)); \
        glds16(vsrc + (size_t)(t) * 64 * 64, (unsigned)__builtin_amdgcn_readfirstlane(vdst + (sl) * VSLOT)); } while (0)
    const lds_cptr shm3 = (lds_cptr)shm;
    const lds_cptr vp0 = shm3 + LDS_V + ((lane >> 4) & 1) * 32 + (lane & 3) * 8 + (4 * hi + ((lane & 15) >> 2)) * 64;
    const lds_cptr kp0 = shm3 + LDS_K + hi * 1024 + r32 * 16;
    DMA_KV(0, 0);
    bf16x8 qr[ND0];
#pragma unroll
    for (int d0 = 0; d0 < ND0; ++d0) qr[d0] = *reinterpret_cast<const bf16x8*>(&Qw[(size_t)r32 * DQK + d0 * 16 + hi * 8]);
    float mhat = -INFINITY, l_reg = 0.f; f32x16 o[2]; o[0] = f32x16{}; o[1] = f32x16{};
    asm volatile("s_waitcnt vmcnt(0) lgkmcnt(0)\n\ts_barrier" ::: "memory");
    for (int t = 0; t < NT; ++t) {
        const int sl = t & 1;
        if (t + 1 < NT) DMA_KV(t + 1, sl ^ 1);
        f32x16 p0 = f32x16{}, p1 = f32x16{};
        const lds_cptr kp = kp0 + sl * KSLOT;
#pragma unroll
        for (int d0 = 0; d0 < ND0; ++d0) {
            const bf16x8 b0 = *(const __attribute__((address_space(3))) bf16x8*)(kp + d0 * 2048);
            const bf16x8 b1 = *(const __attribute__((address_space(3))) bf16x8*)(kp + d0 * 2048 + 512);
            p0 = MFMA(b0, qr[d0], p0); p1 = MFMA(b1, qr[d0], p1);
        }
        const float rm = rowmax(p0, p1);
        const float mn = __builtin_fmaxf(mhat, rm), f = __builtin_amdgcn_exp2f(mhat - mn); mhat = mn;
        float sacc = 0.f;
#pragma unroll
        for (int r = 0; r < 16; ++r) { p0[r] = __builtin_amdgcn_exp2f(p0[r] - mn); p1[r] = __builtin_amdgcn_exp2f(p1[r] - mn); sacc += p0[r] + p1[r]; }
        l_reg = l_reg * f + sacc;
        if (hi == 0) wsf[r32] = f;
        asm volatile("s_waitcnt lgkmcnt(0)" ::: "memory");
#pragma unroll
        for (int d_ = 0; d_ < 2; ++d_)
#pragma unroll
            for (int r = 0; r < 16; ++r) o[d_][r] *= wsf[crow(r, hi)];
        u32x4 pw[4];
#pragma unroll
        for (int i = 0; i < 4; ++i) { pw[0][i] = cvtpk_s(p0[2 * i], p0[2 * i + 1]); pw[1][i] = cvtpk_s(p0[8 + 2 * i], p0[8 + 2 * i + 1]); pw[2][i] = cvtpk_s(p1[2 * i], p1[2 * i + 1]); pw[3][i] = cvtpk_s(p1[8 + 2 * i], p1[8 + 2 * i + 1]); }
        const lds_cptr vp_ = vp0 + sl * VSLOT;
#pragma unroll
        for (int d0 = 0; d0 < 2; ++d0)
#pragma unroll
            for (int ks = 0; ks < 4; ++ks) {
                const s16x4 lo = vtr(vp_ + d0 * 4096 + ks * 1024), hh = vtr(vp_ + d0 * 4096 + ks * 1024 + 512);
                const bf16x8 vf = (bf16x8){lo[0], lo[1], lo[2], lo[3], hh[0], hh[1], hh[2], hh[3]};
                o[d0] = MFMA(__builtin_bit_cast(bf16x8, pw[ks]), vf, o[d0]);
            }
        asm volatile("s_waitcnt vmcnt(0) lgkmcnt(0)\n\ts_barrier" ::: "memory");
    }
#undef DMA_KV
    { auto rr = __builtin_amdgcn_permlane32_swap(__float_as_uint(l_reg), __float_as_uint(l_reg), false, false); l_reg = __uint_as_float(rr[0]) + __uint_as_float(rr[1]); }
    if (hi == 0) wsf[32 + r32] = l_reg; asm volatile("s_waitcnt lgkmcnt(0)" ::: "memory");
    float rli[16];
#pragma unroll
    for (int r = 0; r < 16; ++r) rli[r] = __builtin_amdgcn_rcpf(wsf[32 + crow(r, hi)]);
    bf16_t* Ow = Ob + (size_t)(wid * 32) * DM; bf16_t* stg = (bf16_t*)(shm + LDS_OST) + wid * 2048;
#pragma unroll
    for (int r = 0; r < 16; ++r) { const int orow = crow(r, hi);
#pragma unroll
        for (int d0 = 0; d0 < 2; ++d0) stg[orow * 64 + d0 * 32 + r32] = (bf16_t)f2bf(o[d0][r] * rli[r]); }
    asm volatile("s_waitcnt lgkmcnt(0)" ::: "memory");
#pragma unroll
    for (int i = 0; i < 4; ++i) { const int row = i * 8 + (lane >> 3), ch = lane & 7; *(u32x4*)(Ow + (size_t)row * DM + ch * 8) = *(const u32x4*)(stg + row * 64 + ch * 8); }
    asm volatile("s_waitcnt vmcnt(0) lgkmcnt(0)\n\ts_barrier" ::: "memory");
}

constexpr int CONV_LDS = 112640;
struct ConvState { int cj, jbase; const char* wg; const char* wu; const char* wd; char* dgu; char* dd; unsigned ldsbuf; lds_cptr rdbuf; };
struct ConvJob { const char* sbase; char* dbase; unsigned ldwB, KdB; };
__device__ __forceinline__ ConvJob conv_job(const ConvState& cs, int j) {
    const int J = (CONV_MODE >= 5) ? j : cs.jbase + (j < 383 ? j : 383); const int m = J >> 10, r = J & 1023; ConvJob q;
    if (m < 2) { const int g = r >> 7, kg = r & 127; const int drow0 = ((g < 4) ? g * 32 : 256 + (g - 4) * 32) + m * 128;
        q.sbase = (m ? cs.wu : cs.wg) + (size_t)((8 * kg) * EFF + g * 32) * 4; q.ldwB = EFF * 4; q.dbase = cs.dgu + (size_t)(drow0 * DM + 8 * kg) * 2; q.KdB = DM * 2; }
    else { const int g = r >> 5, kg = r & 31;
        q.sbase = cs.wd + (size_t)((8 * kg) * DM + g * 32) * 4; q.ldwB = DM * 4; q.dbase = cs.dd + (size_t)((g * 32) * EFF + 8 * kg) * 2; q.KdB = EFF * 2; }
    return q;
}
__device__ __forceinline__ void glds16_s(const char* sbase, unsigned voff, unsigned lds_base) {
    unsigned sv; asm volatile("s_mov_b32 %0, m0\n\ts_mov_b32 m0, %3\n\ts_nop 4\n\tglobal_load_lds_dwordx4 %1, %2\n\ts_mov_b32 m0, %0" : "=&s"(sv) : "v"(voff), "s"(sbase), "s"(lds_base) : "memory"); }
#if CONV_MODE == 1 || CONV_MODE == 3 || CONV_MODE == 4 || CONV_MODE >= 5
#define CONV_DRAIN() do { const int jd_ = cs.cj - 3; const ConvJob q_ = conv_job(cs, jd_); \
        const __attribute__((address_space(3))) float* bp_ = (const __attribute__((address_space(3))) float*)(cs.rdbuf + (jd_ & 3) * 1024) + (lane >> 5) * 128 + (lane & 31); \
        uint2 w_; w_.x = cvtpk_s(bp_[0], bp_[32]); w_.y = cvtpk_s(bp_[64], bp_[96]); \
        if (CONV_MODE == 1) *(uint2*)(q_.dbase + (size_t)((unsigned)(lane & 31) * q_.KdB + (unsigned)(lane >> 5) * 8u)) = w_; \
        else if (CONV_MODE == 4) *(uint2*)(cs.dgu + 0x30000000ull + (size_t)((unsigned)(lane & 31) * 2048u + (unsigned)(lane >> 5) * 8u + (unsigned)(jd_ & 127) * 16u)) = w_; \
        else asm volatile("" :: "v"(w_)); } while (0)
#else
#define CONV_DRAIN() do { } while (0)
#endif
#if CONV_MODE >= 5
#undef CONV_DRAIN
#define CONV_NSTEP 384
#define CONV_DRAIN() do { if (CONV_MODE == 5 && rst && cs.cj >= 3 && cs.cj < CONV_NSTEP + 3) { const int jb_ = 8 * (cs.cj - 3) + 4 * (wid - 6); const ConvJob q_ = conv_job(cs, jb_); \
          \
        const __attribute__((address_space(3))) float* bp_ = (const __attribute__((address_space(3))) float*)(cs.rdbuf + (jb_ & 31) * 1024) + (lane >> 5) * 512 + (lane & 31); \
        float v_[16]; \
        _Pragma("unroll") for (int i_ = 0; i_ < 16; ++i_) v_[i_] = bp_[i_ * 32]; \
        char* dp_ = q_.dbase + (size_t)((unsigned)(lane & 31) * q_.KdB + (unsigned)(lane >> 5) * 32u); \
        _Pragma("unroll") for (int i_ = 0; i_ < 2; ++i_) { uint4 w_; w_.x = cvtpk_s(v_[8 * i_], v_[8 * i_ + 1]); w_.y = cvtpk_s(v_[8 * i_ + 2], v_[8 * i_ + 3]); \
            w_.z = cvtpk_s(v_[8 * i_ + 4], v_[8 * i_ + 5]); w_.w = cvtpk_s(v_[8 * i_ + 6], v_[8 * i_ + 7]); *(uint4*)(dp_ + 16 * i_) = w_; } } } while (0)
#define CONV_ISSUE() do { if (CONV_MODE != 6 && rcl && cs.cj < CONV_NSTEP) { const int jb_ = 8 * cs.cj + 4 * (wid - 4); const ConvJob q_ = conv_job(cs, jb_); \
        const unsigned vo_ = (unsigned)(lane >> 3) * q_.ldwB + (unsigned)(lane & 7) * 16u; const unsigned lb_ = (unsigned)__builtin_amdgcn_readfirstlane(cs.ldsbuf + (jb_ & 31) * 1024); \
        glds16_s(q_.sbase, vo_, lb_); glds16_s(q_.sbase + (size_t)8 * q_.ldwB, vo_, lb_ + 1024); glds16_s(q_.sbase + (size_t)16 * q_.ldwB, vo_, lb_ + 2048); glds16_s(q_.sbase + (size_t)24 * q_.ldwB, vo_, lb_ + 3072); } \
        ++cs.cj; } while (0)
#define WAIT_BARL() asm volatile("s_waitcnt lgkmcnt(0)\n\ts_barrier" ::: "memory")
#define RWAIT(N) do { if (rkv) { WAIT_BAR(N); } else if (rcl) { WAIT_BAR(8); } else { WAIT_BARL(); } } while (0)
#elif CONV_MODE != 0
#define CONV_ISSUE() do { const ConvJob q_ = conv_job(cs, cs.cj); \
        glds16_s(q_.sbase, (unsigned)(lane >> 3) * q_.ldwB + (unsigned)(lane & 7) * 16u, (unsigned)__builtin_amdgcn_readfirstlane(cs.ldsbuf + (cs.cj & 3) * 1024)); ++cs.cj; } while (0)
#define WB_P() WAIT_BAR(3)
#define WB_S() WAIT_BAR(4)
#define WB_E1() WAIT_BAR(3)
#define WB_E0() WAIT_BAR(1)
#define WB_PL() WAIT_BAR(4)
#define WB_SL() WAIT_BAR(5)
#else
#define CONV_ISSUE() do { } while (0)
#define WB_P() WAIT_BAR(2)
#define WB_S() WAIT_BAR(2)
#define WB_E1() WAIT_BAR(1)
#define WB_E0() WAIT_BAR(0)
#define WB_PL() WAIT_BAR(3)
#define WB_SL() WAIT_BAR(3)
#endif

constexpr int T_SLOTB = 8192, T_LDS_K = 0, T_LDS_V = 3 * T_SLOTB, T_LDS_WS = 6 * T_SLOTB, T_LDS_OST = T_LDS_WS + NWAVES * 256;
#define WAIT_BAR(N) asm volatile("s_waitcnt vmcnt(" #N ") lgkmcnt(0)\n\ts_barrier" ::: "memory")
__device__ __forceinline__ float max3f(float a, float b, float c) { float r; asm("v_max3_f32 %0, %1, %2, %3" : "=v"(r) : "v"(a), "v"(b), "v"(c)); return r; }
__device__ __forceinline__ float max2f(float a, float b) { float r; asm("v_max_f32_e32 %0, %1, %2" : "=v"(r) : "v"(a), "v"(b)); return r; }
__device__ __forceinline__ float fadd_s(float a, float b) { float r; asm("v_add_f32_e32 %0, %1, %2" : "=v"(r) : "v"(a), "v"(b)); return r; }
__device__ __forceinline__ float fsub_s(float a, float b) { float r; asm("v_sub_f32_e32 %0, %1, %2" : "=v"(r) : "v"(a), "v"(b)); return r; }
__device__ __forceinline__ float rowmax_asm(const f32x16& p0, const f32x16& p1) {
    float a = max3f(p0[0], p0[1], p1[0]), b = max3f(p0[2], p0[3], p1[1]); a = max3f(a, p1[2], p1[3]);
#pragma unroll
    for (int r = 4; r < 16; r += 4) { a = max3f(a, p0[r], p0[r + 1]); b = max3f(b, p0[r + 2], p0[r + 3]); a = max3f(a, p1[r], p1[r + 1]); b = max3f(b, p1[r + 2], p1[r + 3]); }
    const float m = max2f(a, b);
    auto rr = __builtin_amdgcn_permlane32_swap(__float_as_uint(m), __float_as_uint(m), false, false);
    return max2f(__uint_as_float(rr[0]), __uint_as_float(rr[1]));
}
__device__ __forceinline__ void kload8(bf16x8* kf, lds_cptr kp) {
    kf[0] = *(const __attribute__((address_space(3))) bf16x8*)(kp);        kf[1] = *(const __attribute__((address_space(3))) bf16x8*)(kp + 512);
    kf[2] = *(const __attribute__((address_space(3))) bf16x8*)(kp + 2048); kf[3] = *(const __attribute__((address_space(3))) bf16x8*)(kp + 2560);
    kf[4] = *(const __attribute__((address_space(3))) bf16x8*)(kp + 4096); kf[5] = *(const __attribute__((address_space(3))) bf16x8*)(kp + 4608);
    kf[6] = *(const __attribute__((address_space(3))) bf16x8*)(kp + 6144); kf[7] = *(const __attribute__((address_space(3))) bf16x8*)(kp + 6656);
}
__device__ __forceinline__ void kload2(bf16x8* kf, lds_cptr kp, int j) { kf[2 * j] = *(const __attribute__((address_space(3))) bf16x8*)(kp + j * 2048); kf[2 * j + 1] = *(const __attribute__((address_space(3))) bf16x8*)(kp + j * 2048 + 512); }

template <int THRL>
__device__ __forceinline__ void unit64(const bf16_t* Qh, const bf16_t* __restrict__ Kh, const bf16_t* __restrict__ Vh, bf16_t* Ob, float* ostat, int q0, char* shm, ConvState& cs, float mfix) {
    constexpr int DQ = 64;
    int tid_ = threadIdx.x; asm volatile("" : "+v"(tid_));
    const int tid = tid_, lane = tid & 63, r32 = lane & 31, hi = lane >> 5; const int wid = __builtin_amdgcn_readfirstlane(tid >> 6);
    const bf16_t* Qw = Qh + (size_t)(q0 + wid * 32) * DQ;
    const unsigned lds0 = (unsigned)(uintptr_t)shm;
    float* wsf = (float*)(shm + T_LDS_WS) + wid * 64;
#if CONV_MODE >= 5
    const bool rkv = wid < 4, rcl = (wid == 4 || wid == 5), rst = wid >= 6; const int pw = wid & 3;
    const bf16_t* ksrc = Kh + (size_t)lane * DQ + pw * 8;
    const bf16_t* vsrc = Vh + (size_t)(16 * pw + (lane >> 2)) * 64 + (lane & 3) * 8;
    const unsigned kdst = lds0 + T_LDS_K + pw * 1024, vdst = lds0 + T_LDS_V + pw * 1024;
#define DMA_K(t, slot) do { if (rkv) { glds16(ksrc + (size_t)(t) * 64 * DQ, (unsigned)__builtin_amdgcn_readfirstlane(kdst + (slot))); \
        glds16(ksrc + 32 + (size_t)(t) * 64 * DQ, (unsigned)__builtin_amdgcn_readfirstlane(kdst + 4096 + (slot))); } } while (0)
#define DMA_V(t, slot) do { if (rkv) { glds16(vsrc + (size_t)(t) * 64 * 64, (unsigned)__builtin_amdgcn_readfirstlane(vdst + (slot))); \
        glds16(vsrc + 32 + (size_t)(t) * 64 * 64, (unsigned)__builtin_amdgcn_readfirstlane(vdst + 4096 + (slot))); } } while (0)
#define WB_P() RWAIT(4)
#define WB_S() RWAIT(4)
#define WB_E1() RWAIT(2)
#define WB_E0() RWAIT(0)
#else
    const bf16_t* ksrc = Kh + (size_t)lane * DQ + wid * 8;
    const bf16_t* vsrc = Vh + (size_t)(16 * (wid & 3) + (lane >> 2)) * 64 + (wid >> 2) * 32 + (lane & 3) * 8;
    const unsigned kdst = lds0 + T_LDS_K + wid * 1024, vdst = lds0 + T_LDS_V + wid * 1024;
#define DMA_K(t, slot) glds16(ksrc + (size_t)(t) * 64 * DQ, (unsigned)__builtin_amdgcn_readfirstlane(kdst + (slot)))
#define DMA_V(t, slot) glds16(vsrc + (size_t)(t) * 64 * 64, (unsigned)__builtin_amdgcn_readfirstlane(vdst + (slot)))
#endif
    const int vb0 = (int)(lds0 + T_LDS_V) + ((lane >> 4) & 1) * 32 + (lane & 3) * 8 + (4 * hi + ((lane & 15) >> 2)) * 64;
    bf16x8 kf[8];
    const lds_cptr shm3 = (lds_cptr)shm; const lds_cptr kp0 = shm3 + T_LDS_K + hi * 1024 + r32 * 16;
    const lds_cptr vp0 = shm3 + T_LDS_V + ((lane >> 4) & 1) * 32 + (lane & 3) * 8 + (4 * hi + ((lane & 15) >> 2)) * 64;
    DMA_K(0, 0); DMA_V(0, 0); DMA_K(1, T_SLOTB);
    bf16x8 qr[4];
#pragma unroll
    for (int d0 = 0; d0 < 4; ++d0) qr[d0] = *reinterpret_cast<const bf16x8*>(&Qw[(size_t)r32 * DQ + d0 * 16 + hi * 8]);
    float mfo = mfix; asm volatile("" : "+v"(mfo));
    float mhat = mfo, l_reg = 0.f; f32x16 o[2]; o[0] = f32x16{}; o[1] = f32x16{}; f32x16 negm;
#pragma unroll
    for (int r = 0; r < 16; ++r) negm[r] = -mfo;
    asm volatile("" : "+v"(negm));
    bool resc = false;
#define START(P0, P1) do { resc = false; _Pragma("unroll") for (int r = 0; r < 16; ++r) P0[r] = __builtin_amdgcn_exp2f(P0[r]); } while (0)
#define RESC() do { if (resc) { asm volatile("s_waitcnt lgkmcnt(0)" ::: "memory"); \
      _Pragma("unroll") for (int d_ = 0; d_ < 2; ++d_) _Pragma("unroll") for (int r = 0; r < 16; ++r) o[d_][r] *= wsf[crow(r, hi)]; } } while (0)
    f32x16 pA0, pA1, pB0, pB1;
    int sl_prev = 0, sl_cur = 0, sl_next = T_SLOTB;
#define ROT() do { sl_prev = sl_cur; sl_cur = sl_next; sl_next = (sl_next == 2 * T_SLOTB) ? 0 : sl_next + T_SLOTB; } while (0)
    DMA_K(2, 2 * T_SLOTB);
#if CONV_MODE >= 5
    WAIT_BAR(0);
#else
    WAIT_BAR(3);
#endif
    CONV_DRAIN();
    {
        const lds_cptr kb = kp0;
#pragma unroll
        for (int d0 = 0; d0 < 4; ++d0) {
            const bf16x8 b0 = *(const __attribute__((address_space(3))) bf16x8*)(kb + d0 * 2048);
            const bf16x8 b1 = *(const __attribute__((address_space(3))) bf16x8*)(kb + d0 * 2048 + 512);
            if (d0 == 0) { pA0 = MFMA(b0, qr[0], negm); pA1 = MFMA(b1, qr[0], negm); }
            else { pA0 = MFMA(b0, qr[d0], pA0); pA1 = MFMA(b1, qr[d0], pA1); } }
    }
    asm volatile("s_nop 15\n\ts_nop 7" : "+v"(pA0), "+v"(pA1));
    START(pA0, pA1);
#pragma unroll
    for (int r = 0; r < 16; ++r) pA1[r] = __builtin_amdgcn_exp2f(pA1[r]);
    WAIT_BAR(0);
    DMA_K(3, 0); DMA_V(1, T_SLOTB); CONV_ISSUE();
    ROT();
    kload8(kf, kp0 + sl_cur);
    WB_P();
    s16x4 vlo[8], vhi[8]; u32x4 pw0, pw1, pw2, pw3;
#define PKW(P, B) cvtpk_s(P[B], P[B + 1])
#define PAF(k) __builtin_bit_cast(bf16x8, pw##k)
#define VFR(i) (bf16x8){vlo[i][0], vlo[i][1], vlo[i][2], vlo[i][3], vhi[i][0], vhi[i][1], vhi[i][2], vhi[i][3]}
#define PIN(x) asm volatile("" : "+v"(x))
#define GAPA(MF, A0, A1, A2, A3, W0, W1, PW) do { MF; sacc += A0; sacc += A1; sacc += A2; sacc += A3; PIN(sacc); W0; W1; PIN(PW); SBAR(); } while (0)
#define EX(v) __builtin_amdgcn_exp2f(v)
#define GAPB(MF, X, B) do { MF; X[B] = EX(X[B]); X[B + 1] = EX(X[B + 1]); X[B + 2] = EX(X[B + 2]); X[B + 3] = EX(X[B + 3]); PIN(X); SBAR(); } while (0)
#define VRD(i) do { vlo[i] = vtr(vp_ + (((i) >> 2) * 4096 + ((i) & 3) * 1024)); vhi[i] = vtr(vp_ + (((i) >> 2) * 4096 + ((i) & 3) * 1024 + 512)); } while (0)
#define KRD(G, j) do { if (G) { kload2(kf, kp0 + sl_next, j); SBAR(); } } while (0)
#define STEP(C0, C1, P0, P1, t, GK, GV, GL) do { SBAR(); CONV_DRAIN(); SBAR(); \
    const lds_cptr vp_ = vp0 + sl_prev; \
    VRD(0); SBAR(); float sacc = (P0[0] + P0[1]); \
    GAPA(C0 = MFMA(kf[0], qr[0], negm), P0[2], P0[3], P0[4], P0[5],     pw0[0] = PKW(P0, 0), pw0[1] = PKW(P0, 2), pw0); \
    VRD(4); SBAR(); GAPA(C1 = MFMA(kf[1], qr[0], negm), P0[6], P0[7], P0[8], P0[9],     pw0[2] = PKW(P0, 4), pw0[3] = PKW(P0, 6), pw0); \
    VRD(1); SBAR(); GAPA(C0 = MFMA(kf[2], qr[1], C0),   P0[10], P0[11], P0[12], P0[13], pw1[0] = PKW(P0, 8), pw1[1] = PKW(P0, 10), pw1); \
    VRD(5); SBAR(); GAPA(C1 = MFMA(kf[3], qr[1], C1),   P0[14], P0[15], P1[0], P1[1],   pw1[2] = PKW(P0, 12), pw1[3] = PKW(P0, 14), pw1); \
    VRD(2); SBAR(); GAPA(C0 = MFMA(kf[4], qr[2], C0),   P1[2], P1[3], P1[4], P1[5],     pw2[0] = PKW(P1, 0), pw2[1] = PKW(P1, 2), pw2); \
    VRD(6); SBAR(); GAPA(C1 = MFMA(kf[5], qr[2], C1),   P1[6], P1[7], P1[8], P1[9],     pw2[2] = PKW(P1, 4), pw2[3] = PKW(P1, 6), pw2); \
    VRD(3); SBAR(); GAPA(C0 = MFMA(kf[6], qr[3], C0),   P1[10], P1[11], P1[12], P1[13], pw3[0] = PKW(P1, 8), pw3[1] = PKW(P1, 10), pw3); \
    VRD(7); SBAR(); GAPA(C1 = MFMA(kf[7], qr[3], C1),   P1[14], P1[15], 0.f, 0.f,       pw3[2] = PKW(P1, 12), pw3[3] = PKW(P1, 14), pw3); \
    l_reg += sacc; \
    if (GK) { DMA_K((t) + 3, sl_cur); } if (GV) { DMA_V((t) + 1, sl_next); } CONV_ISSUE(); \
    SBAR(); \
    GAPB(o[0] = MFMA(PAF(0), VFR(0), o[0]), C0, 0); \
    GAPB(o[1] = MFMA(PAF(0), VFR(4), o[1]), C0, 4); \
    KRD(GL, 0); GAPB(o[0] = MFMA(PAF(1), VFR(1), o[0]), C0, 8); \
    KRD(GL, 1); GAPB(o[1] = MFMA(PAF(1), VFR(5), o[1]), C0, 12); \
    KRD(GL, 2); GAPB(o[0] = MFMA(PAF(2), VFR(2), o[0]), C1, 0); \
    KRD(GL, 3); GAPB(o[1] = MFMA(PAF(2), VFR(6), o[1]), C1, 4); \
    GAPB(o[0] = MFMA(PAF(3), VFR(3), o[0]), C1, 8); \
    GAPB(o[1] = MFMA(PAF(3), VFR(7), o[1]), C1, 12); \
    } while (0)
    int t = 1;
    for (; t + 5 < NT; t += 2) {
        STEP(pB0, pB1, pA0, pA1, t, true, true, true);     WB_S(); RESC(); ROT();
        STEP(pA0, pA1, pB0, pB1, t + 1, true, true, true); WB_S(); RESC(); ROT();
    }
#define ENDW(tt) do { if ((tt) + 3 < NT) { WB_S(); } else if ((tt) + 2 < NT) { WB_E1(); } else { WB_E0(); } } while (0)
    for (; t + 1 < NT; t += 2) {
        STEP(pB0, pB1, pA0, pA1, t, (t + 3 < NT), (t + 1 < NT), (t + 1 < NT));         ENDW(t);     RESC(); ROT();
        STEP(pA0, pA1, pB0, pB1, t + 1, (t + 4 < NT), (t + 2 < NT), (t + 2 < NT));     ENDW(t + 1); RESC(); ROT();
    }
    STEP(pB0, pB1, pA0, pA1, NT - 1, false, false, false); RESC();
    {
        float sacc = pB0[0] + pB0[1];
#pragma unroll
        for (int r = 2; r < 16; ++r) sacc += pB0[r];
#pragma unroll
        for (int r = 0; r < 16; ++r) sacc += pB1[r];
        l_reg += sacc;
        pw0 = (u32x4){PKW(pB0, 0), PKW(pB0, 2), PKW(pB0, 4), PKW(pB0, 6)}; pw1 = (u32x4){PKW(pB0, 8), PKW(pB0, 10), PKW(pB0, 12), PKW(pB0, 14)};
        pw2 = (u32x4){PKW(pB1, 0), PKW(pB1, 2), PKW(pB1, 4), PKW(pB1, 6)}; pw3 = (u32x4){PKW(pB1, 8), PKW(pB1, 10), PKW(pB1, 12), PKW(pB1, 14)};
        SBAR();
        const lds_cptr vp_ = vp0 + sl_cur;
#pragma unroll
        for (int i = 0; i < 8; ++i) VRD(i);
        o[0] = MFMA(PAF(0), VFR(0), o[0]); o[1] = MFMA(PAF(0), VFR(4), o[1]); o[0] = MFMA(PAF(1), VFR(1), o[0]); o[1] = MFMA(PAF(1), VFR(5), o[1]);
        o[0] = MFMA(PAF(2), VFR(2), o[0]); o[1] = MFMA(PAF(2), VFR(6), o[1]); o[0] = MFMA(PAF(3), VFR(3), o[0]); o[1] = MFMA(PAF(3), VFR(7), o[1]);
    }
#undef PKW
#undef PAF
#undef VFR
#undef PIN
#undef GAPA
#undef GAPB
#undef EX
#undef VRD
#undef KRD
#undef STEP
#undef ENDW
    { auto rr = __builtin_amdgcn_permlane32_swap(__float_as_uint(l_reg), __float_as_uint(l_reg), false, false); l_reg = __uint_as_float(rr[0]) + __uint_as_float(rr[1]); }
    if (hi == 0) wsf[32 + r32] = l_reg; asm volatile("s_waitcnt lgkmcnt(0)" ::: "memory");
    float rli[16];
#pragma unroll
    for (int r = 0; r < 16; ++r) rli[r] = __builtin_amdgcn_rcpf(wsf[32 + crow(r, hi)]);
    bf16_t* Ow = Ob + (size_t)(wid * 32) * DM; bf16_t* stg = (bf16_t*)(shm + T_LDS_OST) + wid * 2048;
#pragma unroll
    for (int r = 0; r < 16; ++r) { const int orow = crow(r, hi);
#pragma unroll
        for (int d0 = 0; d0 < 2; ++d0) stg[orow * 64 + d0 * 32 + r32] = (bf16_t)f2bf(o[d0][r] * rli[r]); }
    asm volatile("s_waitcnt lgkmcnt(0)" ::: "memory");
#pragma unroll
    for (int i = 0; i < 4; ++i) { const int row = i * 8 + (lane >> 3), ch = lane & 7; const u32x4 v = *(const u32x4*)(stg + row * 64 + ch * 8); *(u32x4*)(Ow + (size_t)row * DM + ch * 8) = v;
        float q = 0.f;
#pragma unroll
        for (int d = 0; d < 4; ++d) { const float a = bf2f(v[d] & 0xffffu), bq = bf2f(v[d] >> 16); q += a * a + bq * bq; }
        q += dppmov<0xB1, 0xF>(0.f, q); q += dppmov<0x4E, 0xF>(0.f, q); q += dppmov<0x141, 0xF>(0.f, q);
        if (ch == 0) ostat[(size_t)(wid * 32 + row) * 16] = q; }
    asm volatile("s_waitcnt vmcnt(0) lgkmcnt(0)\n\ts_barrier" ::: "memory");
#if CONV_MODE >= 5
#undef WB_P
#undef WB_S
#undef WB_E1
#undef WB_E0
#endif
#undef DMA_K
#undef DMA_V
#undef START
#undef RESC
#undef ROT
}
constexpr int M_KSLOT = 12288, M_LDS_K = 0, M_LDS_V = 3 * M_KSLOT, M_LDS_WS = M_LDS_V + 3 * T_SLOTB, M_LDS_Q = M_LDS_WS + NWAVES * 256, M_LDS_OST = 0  ;
#define WBAR2() do { if (lowv) { WB_PL(); } else { WB_P(); } } while (0)
#define WBARS() do { if (lowv) { WB_SL(); } else { WB_S(); } } while (0)
template <int THRL>
__device__ __forceinline__ void unit96(const bf16_t* Qh, const bf16_t* __restrict__ Kh, const bf16_t* __restrict__ Vh, bf16_t* Ob, float* ostat, int q0, char* shm, ConvState& cs, float kb2) {
    constexpr int DQ = 96;
    int tid_ = threadIdx.x; asm volatile("" : "+v"(tid_));
    const int tid = tid_, lane = tid & 63, r32 = lane & 31, hi = lane >> 5; const int wid = __builtin_amdgcn_readfirstlane(tid >> 6);
    const bf16_t* Qw = Qh + (size_t)(q0 + wid * 32) * DQ;
    const unsigned lds0 = (unsigned)(uintptr_t)shm;
    float* wsf = (float*)(shm + M_LDS_WS) + wid * 64;
#if CONV_MODE >= 5
    const bool rkv = wid < 4, rcl = (wid == 4 || wid == 5), rst = wid >= 6; const int pw = wid & 3;
    const bf16_t* ksrc = Kh + (size_t)lane * DQ + pw * 8;
    const bool lowv = false;
#else
    const bf16_t* ksrc = Kh + (size_t)lane * DQ + wid * 8;
    const bf16_t* ksrc1 = Kh + (size_t)lane * DQ + (8 + (wid & 3)) * 8;
    const bool lowv = wid < 4;
#endif
#if CONV_MODE >= 5
    const bf16_t* vsrc = Vh + (size_t)(16 * pw + (lane >> 2)) * 64 + (lane & 3) * 8;
    const unsigned kdst = lds0 + M_LDS_K + pw * 1024, vdst = lds0 + M_LDS_V + pw * 1024, qdst = lds0 + M_LDS_Q + wid * 6144;
#define DMA_K(t, slot) do { if (rkv) { glds16(ksrc + (size_t)(t) * 64 * DQ, (unsigned)__builtin_amdgcn_readfirstlane(kdst + (slot))); \
        glds16(ksrc + 32 + (size_t)(t) * 64 * DQ, (unsigned)__builtin_amdgcn_readfirstlane(kdst + 4096 + (slot))); \
        glds16(ksrc + 64 + (size_t)(t) * 64 * DQ, (unsigned)__builtin_amdgcn_readfirstlane(kdst + 8192 + (slot))); } } while (0)
#define DMA_V(t, slot) do { if (rkv) { glds16(vsrc + (size_t)(t) * 64 * 64, (unsigned)__builtin_amdgcn_readfirstlane(vdst + (slot))); \
        glds16(vsrc + 32 + (size_t)(t) * 64 * 64, (unsigned)__builtin_amdgcn_readfirstlane(vdst + 4096 + (slot))); } } while (0)
#undef WBAR2
#undef WBARS
#define WBAR2() RWAIT(5)
#define WBARS() RWAIT(5)
#define WB_E1() RWAIT(2)
#define WB_E0() RWAIT(0)
#else
    const bf16_t* vsrc = Vh + (size_t)(16 * (wid & 3) + (lane >> 2)) * 64 + (wid >> 2) * 32 + (lane & 3) * 8;
    const unsigned kdst = lds0 + M_LDS_K + wid * 1024, kdst1 = lds0 + M_LDS_K + (8 + (wid & 3)) * 1024, vdst = lds0 + M_LDS_V + wid * 1024, qdst = lds0 + M_LDS_Q + wid * 6144;
#define DMA_K(t, slot) do { glds16(ksrc + (size_t)(t) * 64 * DQ, (unsigned)__builtin_amdgcn_readfirstlane(kdst + (slot))); \
        if (lowv) glds16(ksrc1 + (size_t)(t) * 64 * DQ, (unsigned)__builtin_amdgcn_readfirstlane(kdst1 + (slot))); } while (0)
#define DMA_V(t, slot) glds16(vsrc + (size_t)(t) * 64 * 64, (unsigned)__builtin_amdgcn_readfirstlane(vdst + (slot)))
#endif
    const int vb0 = (int)(lds0 + M_LDS_V) + ((lane >> 4) & 1) * 32 + (lane & 3) * 8 + (4 * hi + ((lane & 15) >> 2)) * 64;
    bf16x8 kf[12];
    const lds_cptr shm3 = (lds_cptr)shm; const lds_cptr kp0 = shm3 + M_LDS_K + hi * 1024 + r32 * 16; const lds_cptr qp0 = shm3 + M_LDS_Q + wid * 6144 + lane * 16;
    const lds_cptr vp0 = shm3 + M_LDS_V + ((lane >> 4) & 1) * 32 + (lane & 3) * 8 + (4 * hi + ((lane & 15) >> 2)) * 64;
#pragma unroll
    for (int d0 = 0; d0 < 6; ++d0) glds16(Qw + (size_t)r32 * DQ + d0 * 16 + hi * 8, (unsigned)__builtin_amdgcn_readfirstlane(qdst + d0 * 1024));
    DMA_K(0, 0); DMA_V(0, 0); DMA_K(1, M_KSLOT);
#define QF(d0) (*(const __attribute__((address_space(3))) bf16x8*)(qp0 + (d0) * 1024))
    float mhat = 0.f, l_reg = 0.f; f32x16 o[2]; o[0] = f32x16{}; o[1] = f32x16{}; f32x16 negm = f32x16{}; asm volatile("" : "+v"(negm));
    bool resc = false;
#define START(P0, P1) do { resc = false; _Pragma("unroll") for (int r = 0; r < 16; ++r) P0[r] = __builtin_amdgcn_exp2f(P0[r]); } while (0)
#define RESC() do { if (resc) { asm volatile("s_waitcnt lgkmcnt(0)" ::: "memory"); \
      _Pragma("unroll") for (int d_ = 0; d_ < 2; ++d_) _Pragma("unroll") for (int r = 0; r < 16; ++r) o[d_][r] *= wsf[crow(r, hi)]; } } while (0)
    f32x16 pA0, pA1, pB0, pB1;
    int sl_prev = 0, sl_cur = 0, sl_next = M_KSLOT; int vs_prev = 0, vs_cur = 0, vs_next = T_SLOTB;
#define ROT() do { sl_prev = sl_cur; sl_cur = sl_next; sl_next = (sl_next == 2 * M_KSLOT) ? 0 : sl_next + M_KSLOT; vs_prev = vs_cur; vs_cur = vs_next; vs_next = (vs_next == 2 * T_SLOTB) ? 0 : vs_next + T_SLOTB; } while (0)
    DMA_K(2, 2 * M_KSLOT);
    WAIT_BAR(0);
    {
        float qn = 0.f;
#pragma unroll
        for (int d0 = 0; d0 < 6; ++d0) { const bf16x8 qf = QF(d0);
#pragma unroll
            for (int i = 0; i < 8; ++i) { const float x = bf2f((unsigned short)qf[i]); qn += x * x; } }
        auto rr = __builtin_amdgcn_permlane32_swap(__float_as_uint(qn), __float_as_uint(qn), false, false); qn = __uint_as_float(rr[0]) + __uint_as_float(rr[1]);
        mhat = fminf(sqrtf(qn * kb2) * 1.02f + 0.5f, 60.f);
#pragma unroll
        for (int r = 0; r < 16; ++r) negm[r] = -mhat;
        asm volatile("" : "+v"(negm));
    }
    CONV_DRAIN();
    {
        const lds_cptr kb = kp0;
#pragma unroll
        for (int d0 = 0; d0 < 6; ++d0) {
            const bf16x8 b0 = *(const __attribute__((address_space(3))) bf16x8*)(kb + d0 * 2048);
            const bf16x8 b1 = *(const __attribute__((address_space(3))) bf16x8*)(kb + d0 * 2048 + 512);
            const bf16x8 qf = QF(d0);
            if (d0 == 0) { pA0 = MFMA(b0, qf, negm); pA1 = MFMA(b1, qf, negm); }
            else { pA0 = MFMA(b0, qf, pA0); pA1 = MFMA(b1, qf, pA1); } }
    }
    asm volatile("s_nop 15\n\ts_nop 7" : "+v"(pA0), "+v"(pA1));
    START(pA0, pA1);
#pragma unroll
    for (int r = 0; r < 16; ++r) pA1[r] = __builtin_amdgcn_exp2f(pA1[r]);
    WAIT_BAR(0);
    DMA_K(3, 0); DMA_V(1, T_SLOTB); CONV_ISSUE();
    ROT();
#pragma unroll
    for (int j = 0; j < 6; ++j) kload2(kf, kp0 + sl_cur, j);
    WBAR2();
    s16x4 vlo[8], vhi[8]; u32x4 pw0, pw1, pw2, pw3;
#define PKW(P, B) cvtpk_s(P[B], P[B + 1])
#define PAF(k) __builtin_bit_cast(bf16x8, pw##k)
#define VFR(i) (bf16x8){vlo[i][0], vlo[i][1], vlo[i][2], vlo[i][3], vhi[i][0], vhi[i][1], vhi[i][2], vhi[i][3]}
#define PIN(x) asm volatile("" : "+v"(x))
#define GAPA(MF, A0, A1, A2, A3, W0, W1, PW) do { MF; sacc += A0; sacc += A1; sacc += A2; sacc += A3; PIN(sacc); W0; W1; PIN(PW); SBAR(); } while (0)
#define EX(v) __builtin_amdgcn_exp2f(v)
#define GAPB(MF, X, B) do { MF; X[B] = EX(X[B]); X[B + 1] = EX(X[B + 1]); X[B + 2] = EX(X[B + 2]); X[B + 3] = EX(X[B + 3]); PIN(X); SBAR(); } while (0)
#define VRD(i) do { vlo[i] = vtr(vp_ + (((i) >> 2) * 4096 + ((i) & 3) * 1024)); vhi[i] = vtr(vp_ + (((i) >> 2) * 4096 + ((i) & 3) * 1024 + 512)); } while (0)
#define KRD(G, j) do { if (G) { kload2(kf, kp0 + sl_next, j); SBAR(); } } while (0)
#define STEP(C0, C1, P0, P1, t, GK, GV, GL) do { SBAR(); CONV_DRAIN(); SBAR(); \
    const lds_cptr vp_ = vp0 + vs_prev; \
    bf16x8 qa = QF(0), qb = QF(1); \
    VRD(0); SBAR(); float sacc = (P0[0] + P0[1]); \
    GAPA(C0 = MFMA(kf[0], qa, negm), P0[2], P0[3], P0[4], P0[5],     pw0[0] = PKW(P0, 0), pw0[1] = PKW(P0, 2), pw0); \
    VRD(4); SBAR(); GAPA(C1 = MFMA(kf[1], qa, negm), P0[6], P0[7], P0[8], P0[9],     pw0[2] = PKW(P0, 4), pw0[3] = PKW(P0, 6), pw0); \
    qa = QF(2); VRD(1); SBAR(); GAPA(C0 = MFMA(kf[2], qb, C0),   P0[10], P0[11], P0[12], P0[13], pw1[0] = PKW(P0, 8), pw1[1] = PKW(P0, 10), pw1); \
    VRD(5); SBAR(); GAPA(C1 = MFMA(kf[3], qb, C1),   P0[14], P0[15], P1[0], P1[1],   pw1[2] = PKW(P0, 12), pw1[3] = PKW(P0, 14), pw1); \
    qb = QF(3); VRD(2); SBAR(); GAPA(C0 = MFMA(kf[4], qa, C0),   P1[2], P1[3], P1[4], P1[5],     pw2[0] = PKW(P1, 0), pw2[1] = PKW(P1, 2), pw2); \
    VRD(6); SBAR(); GAPA(C1 = MFMA(kf[5], qa, C1),   P1[6], P1[7], P1[8], P1[9],     pw2[2] = PKW(P1, 4), pw2[3] = PKW(P1, 6), pw2); \
    qa = QF(4); VRD(3); SBAR(); GAPA(C0 = MFMA(kf[6], qb, C0),   P1[10], P1[11], P1[12], P1[13], pw3[0] = PKW(P1, 8), pw3[1] = PKW(P1, 10), pw3); \
    VRD(7); SBAR(); GAPA(C1 = MFMA(kf[7], qb, C1),   P1[14], P1[15], 0.f, 0.f,       pw3[2] = PKW(P1, 12), pw3[3] = PKW(P1, 14), pw3); \
    qb = QF(5); SBAR(); C0 = MFMA(kf[8], qa, C0); C1 = MFMA(kf[9], qa, C1); SBAR(); \
    C0 = MFMA(kf[10], qb, C0); C1 = MFMA(kf[11], qb, C1); SBAR(); \
    l_reg += sacc; \
    if (GK) { DMA_K((t) + 3, sl_cur); } if (GV) { DMA_V((t) + 1, vs_next); } CONV_ISSUE(); \
    SBAR(); \
    GAPB(o[0] = MFMA(PAF(0), VFR(0), o[0]), C0, 0); \
    KRD(GL, 0); GAPB(o[1] = MFMA(PAF(0), VFR(4), o[1]), C0, 4); \
    KRD(GL, 1); GAPB(o[0] = MFMA(PAF(1), VFR(1), o[0]), C0, 8); \
    KRD(GL, 2); GAPB(o[1] = MFMA(PAF(1), VFR(5), o[1]), C0, 12); \
    KRD(GL, 3); GAPB(o[0] = MFMA(PAF(2), VFR(2), o[0]), C1, 0); \
    KRD(GL, 4); GAPB(o[1] = MFMA(PAF(2), VFR(6), o[1]), C1, 4); \
    KRD(GL, 5); GAPB(o[0] = MFMA(PAF(3), VFR(3), o[0]), C1, 8); \
    GAPB(o[1] = MFMA(PAF(3), VFR(7), o[1]), C1, 12); \
    } while (0)
    int t = 1;
    for (; t + 5 < NT; t += 2) {
        STEP(pB0, pB1, pA0, pA1, t, true, true, true);     WBARS(); RESC(); ROT();
        STEP(pA0, pA1, pB0, pB1, t + 1, true, true, true); WBARS(); RESC(); ROT();
    }
#define ENDW(tt) do { if ((tt) + 3 < NT) { WBARS(); } else if ((tt) + 2 < NT) { WB_E1(); } else { WB_E0(); } } while (0)
    for (; t + 1 < NT; t += 2) {
        STEP(pB0, pB1, pA0, pA1, t, (t + 3 < NT), (t + 1 < NT), (t + 1 < NT));         ENDW(t);     RESC(); ROT();
        STEP(pA0, pA1, pB0, pB1, t + 1, (t + 4 < NT), (t + 2 < NT), (t + 2 < NT));     ENDW(t + 1); RESC(); ROT();
    }
    STEP(pB0, pB1, pA0, pA1, NT - 1, false, false, false); RESC();
    {
        float sacc = pB0[0] + pB0[1];
#pragma unroll
        for (int r = 2; r < 16; ++r) sacc += pB0[r];
#pragma unroll
        for (int r = 0; r < 16; ++r) sacc += pB1[r];
        l_reg += sacc;
        pw0 = (u32x4){PKW(pB0, 0), PKW(pB0, 2), PKW(pB0, 4), PKW(pB0, 6)}; pw1 = (u32x4){PKW(pB0, 8), PKW(pB0, 10), PKW(pB0, 12), PKW(pB0, 14)};
        pw2 = (u32x4){PKW(pB1, 0), PKW(pB1, 2), PKW(pB1, 4), PKW(pB1, 6)}; pw3 = (u32x4){PKW(pB1, 8), PKW(pB1, 10), PKW(pB1, 12), PKW(pB1, 14)};
        SBAR();
        const lds_cptr vp_ = vp0 + vs_cur;
#pragma unroll
        for (int i = 0; i < 8; ++i) VRD(i);
        o[0] = MFMA(PAF(0), VFR(0), o[0]); o[1] = MFMA(PAF(0), VFR(4), o[1]); o[0] = MFMA(PAF(1), VFR(1), o[0]); o[1] = MFMA(PAF(1), VFR(5), o[1]);
        o[0] = MFMA(PAF(2), VFR(2), o[0]); o[1] = MFMA(PAF(2), VFR(6), o[1]); o[0] = MFMA(PAF(3), VFR(3), o[0]); o[1] = MFMA(PAF(3), VFR(7), o[1]);
    }
#undef PKW
#undef PAF
#undef VFR
#undef PIN
#undef GAPA
#undef GAPB
#undef EX
#undef VRD
#undef KRD
#undef STEP
#undef ENDW
    { auto rr = __builtin_amdgcn_permlane32_swap(__float_as_uint(l_reg), __float_as_uint(l_reg), false, false); l_reg = __uint_as_float(rr[0]) + __uint_as_float(rr[1]); }
    if (hi == 0) wsf[32 + r32] = l_reg; asm volatile("s_waitcnt lgkmcnt(0)" ::: "memory");
    float rli[16];
#pragma unroll
    for (int r = 0; r < 16; ++r) rli[r] = __builtin_amdgcn_rcpf(wsf[32 + crow(r, hi)]);
    bf16_t* Ow = Ob + (size_t)(wid * 32) * DM; bf16_t* stg = (bf16_t*)(shm + M_LDS_OST) + wid * 2048;
#pragma unroll
    for (int r = 0; r < 16; ++r) { const int orow = crow(r, hi);
#pragma unroll
        for (int d0 = 0; d0 < 2; ++d0) stg[orow * 64 + d0 * 32 + r32] = (bf16_t)f2bf(o[d0][r] * rli[r]); }
    asm volatile("s_waitcnt lgkmcnt(0)" ::: "memory");
#pragma unroll
    for (int i = 0; i < 4; ++i) { const int row = i * 8 + (lane >> 3), ch = lane & 7; const u32x4 v = *(const u32x4*)(stg + row * 64 + ch * 8); *(u32x4*)(Ow + (size_t)row * DM + ch * 8) = v;
        float q = 0.f;
#pragma unroll
        for (int d = 0; d < 4; ++d) { const float a = bf2f(v[d] & 0xffffu), bq = bf2f(v[d] >> 16); q += a * a + bq * bq; }
        q += dppmov<0xB1, 0xF>(0.f, q); q += dppmov<0x4E, 0xF>(0.f, q); q += dppmov<0x141, 0xF>(0.f, q);
        if (ch == 0) ostat[(size_t)(wid * 32 + row) * 16] = q; }
    asm volatile("s_waitcnt vmcnt(0) lgkmcnt(0)\n\ts_barrier" ::: "memory");
#if CONV_MODE >= 5
#undef WB_E1
#undef WB_E0
#endif
#undef QF
#undef DMA_K
#undef DMA_V
#undef START
#undef RESC
#undef ROT
}
#undef WBAR2
#undef WBARS
#undef WAIT_BAR
}


namespace pg8 {
typedef short bf16x8 __attribute__((ext_vector_type(8)));
typedef float f32x4 __attribute__((ext_vector_type(4)));
typedef unsigned u32x4 __attribute__((ext_vector_type(4)));
constexpr int BM = 256, BK = 64, HALF = 128, HTB = HALF * BK * 2, STAGE_BYTES = 8 * HTB, NXCD = 8, WGM = 8;
__host__ __device__ __forceinline__ int lds_byte(int r, int c) { const int st = (r >> 4) * 2 + (c >> 5), rr = r & 15, cc = c & 31, ob = rr * 64 + cc * 2; return st * 1024 + (ob ^ (((ob >> 9) & 1) << 5)); }
__host__ __device__ __forceinline__ void stage_rc(int b, int& R, int& C) { const int st = b / 1024, sb = b % 1024, swz = sb ^ (((sb >> 9) & 1) << 5); R = (st >> 1) * 16 + swz / 64; C = (st & 1) * 32 + (swz % 64) / 2; }
__host__ __device__ __forceinline__ int perm32(int rho) { const int n = rho >> 4, i = rho & 15; return 8 * (i >> 2) + 4 * n + (i & 3); }
__device__ __forceinline__ unsigned cvt_pk_bf16(float lo, float hi) { unsigned r; asm volatile("v_cvt_pk_bf16_f32 %0, %1, %2" : "=v"(r) : "v"(lo), "v"(hi)); return r; }

struct Unit { int pm, pn, e, nrows, rowbase; };

struct DenseOrder {
    int nM, nN, nwg, G, c, K; const char* Bt;
    __device__ void init(int M, int N, int K_, const bf16_t* Bt_, int G_, int c_) { nM = M / BM; nN = N / BM; nwg = nM * nN; G = G_; c = c_; K = K_; Bt = (const char*)Bt_; }
    __device__ __forceinline__ bool next(int i, Unit& u) const {
        const long L = (long)i * G + c; if (L >= nwg) return false;
        int wgid = (int)L; { const int q = nwg / NXCD, r = nwg % NXCD, xcd = wgid % NXCD, off = wgid / NXCD; wgid = (xcd < r ? xcd * (q + 1) : r * (q + 1) + (xcd - r) * q) + off; }
        const int nig = WGM * nN, gid = wgid / nig, fm = gid * WGM, gsz = (nM - fm) < WGM ? (nM - fm) : WGM;
        u.pm = fm + ((wgid % nig) % gsz); u.pn = (wgid % nig) / gsz; u.e = 0; u.nrows = 256; u.rowbase = u.pm * BM; return true;
    }
    __device__ __forceinline__ void a_offsets(const Unit&, int, unsigned (&)[2][2]) const {}
    __device__ __forceinline__ const char* b_tile(const Unit& u) const { return Bt + (size_t)u.pn * BM * K * 2; }
};

struct EpiBf16 {
    static constexpr bool PERM = true;
    bf16_t* O; int ldc;
    __device__ __forceinline__ void operator()(const f32x4 (&acc)[2][2][4][2], const Unit& u, int wr, int wc, int fr, int fq) const {
        const int row0 = u.pm * BM + wr * 64 + fr, col0 = u.pn * BM + wc * 32 + 8 * fq;
#pragma unroll
        for (int ai = 0; ai < 2; ++ai)
#pragma unroll
            for (int m = 0; m < 4; ++m) { bf16_t* rowp = O + (size_t)(row0 + ai * HALF + m * 16) * ldc + col0;
#pragma unroll
                for (int bj = 0; bj < 2; ++bj) { const f32x4 v0 = acc[ai][bj][m][0], v1 = acc[ai][bj][m][1];
                    u32x4 w; w.x = cvt_pk_bf16(v0[0], v0[1]); w.y = cvt_pk_bf16(v0[2], v0[3]); w.z = cvt_pk_bf16(v1[0], v1[1]); w.w = cvt_pk_bf16(v1[2], v1[3]);
                    *(u32x4*)(rowp + bj * HALF) = w; } }
    }
};


__device__ __forceinline__ float silu_mul(float g, float u) { return g * __builtin_amdgcn_rcpf(1.f + __expf(-g)) * u; }

struct MoeOrder {
    const LAS int* pre; const LAS int* offs; const LAS int* cntl; const int* list; const char* Bt; size_t bstride; int K, npn, G, c, mode;
    __device__ __forceinline__ bool next(int i, Unit& u) const {
        const int L = i * G + c, total = pre[NE] * npn; if (L >= total) return false;
        const int rtg = L / npn; const int pn = L - rtg * npn;
        int lo_ = 0, hi_ = NE;
        while (hi_ - lo_ > 1) { const int mid = (lo_ + hi_) >> 1; if (pre[mid] <= rtg) lo_ = mid; else hi_ = mid; }
        const int e = lo_, pm = rtg - pre[e], n = cntl[e] - pm * BM;
        u.e = __builtin_amdgcn_readfirstlane(e); u.pm = __builtin_amdgcn_readfirstlane(pm); u.pn = __builtin_amdgcn_readfirstlane(pn);
        u.nrows = __builtin_amdgcn_readfirstlane(n < BM ? n : BM); u.rowbase = __builtin_amdgcn_readfirstlane(offs[e] + pm * BM); return true;
    }
    __device__ __forceinline__ void a_offsets(const Unit& u, int tid, unsigned (&ua)[2][2]) const {
#pragma unroll
        for (int i = 0; i < 2; ++i) { int R, C; stage_rc(tid * 16 + i * 8192, R, C);
#pragma unroll
            for (int h = 0; h < 2; ++h) { int r = h * HALF + R; if (r >= u.nrows) r = 0; const int row = list[(size_t)u.e * LCAP + u.pm * BM + r] >> 3;
                ua[h][i] = (unsigned)((row * K + C) * 2); } }
    }
    __device__ __forceinline__ const char* b_tile(const Unit& u) const { return Bt + (size_t)u.e * bstride + (size_t)u.pn * BM * K * 2; }
};

struct EpiAct {
    static constexpr bool PERM = true;
    bf16_t* ACT;
    __device__ __forceinline__ void operator()(const f32x4 (&acc)[2][2][4][2], const Unit& u, int wr, int wc, int fr, int fq) const {
        const __amdgpu_buffer_rsrc_t rs = __builtin_amdgcn_make_buffer_rsrc((void*)ACT, 0, (NTOK * TOPK + 256) * EFF * 2, 0x00020000);
        const unsigned cb = (unsigned)((u.pn * HALF + wc * 32 + 8 * fq) * 2);
#pragma unroll
        for (int ai = 0; ai < 2; ++ai)
#pragma unroll
            for (int m = 0; m < 4; ++m) { const int r = ai * HALF + wr * 64 + m * 16 + fr;
                const unsigned off = (r < u.nrows) ? (unsigned)(u.rowbase + r) * (EFF * 2) + cb : 0xFFFFFFF0u;
                const f32x4 g0 = acc[ai][0][m][0], g1 = acc[ai][0][m][1], u0 = acc[ai][1][m][0], u1 = acc[ai][1][m][1];
                u32x4 w; w.x = cvt_pk_bf16(silu_mul(g0[0], u0[0]), silu_mul(g0[1], u0[1])); w.y = cvt_pk_bf16(silu_mul(g0[2], u0[2]), silu_mul(g0[3], u0[3]));
                w.z = cvt_pk_bf16(silu_mul(g1[0], u1[0]), silu_mul(g1[1], u1[1])); w.w = cvt_pk_bf16(silu_mul(g1[2], u1[2]), silu_mul(g1[3], u1[3]));
                __builtin_amdgcn_raw_buffer_store_b128(w, rs, off, 0, 0); }
    }
};
struct EpiSlots {
    static constexpr bool PERM = true;
    unsigned char* SL;
    __device__ __forceinline__ void operator()(const f32x4 (&acc)[2][2][4][2], const Unit& u, int wr, int wc, int fr, int fq) const {
        const __amdgpu_buffer_rsrc_t rs = __builtin_amdgcn_make_buffer_rsrc((void*)SL, 0, NTOK * TOPK * DM, 0x00020000);
        const unsigned cb = (unsigned)(u.pn * BM + wc * 32 + 8 * fq);
#pragma unroll
        for (int ai = 0; ai < 2; ++ai)
#pragma unroll
            for (int m = 0; m < 4; ++m) { const int r = ai * HALF + wr * 64 + m * 16 + fr;
                const unsigned off = (r < u.nrows) ? (unsigned)(u.rowbase + r) * DM + cb : 0xFFFFFFF0u;
#pragma unroll
                for (int bj = 0; bj < 2; ++bj) { const f32x4 v0 = acc[ai][bj][m][0] * 16.f, v1 = acc[ai][bj][m][1] * 16.f;
                    int lo = __builtin_amdgcn_cvt_pk_fp8_f32(v0[0], v0[1], 0, false); lo = __builtin_amdgcn_cvt_pk_fp8_f32(v0[2], v0[3], lo, true);
                    int hi = __builtin_amdgcn_cvt_pk_fp8_f32(v1[0], v1[1], 0, false); hi = __builtin_amdgcn_cvt_pk_fp8_f32(v1[2], v1[3], hi, true);
                    typedef unsigned u32x2 __attribute__((ext_vector_type(2)));
                    __builtin_amdgcn_raw_buffer_store_b64((u32x2){(unsigned)lo, (unsigned)hi}, rs, off, bj * HALF, 0); } }
    }
};
struct EpiRS {
    static constexpr bool PERM = true;
    float* LOG; bf16_t* ACTS;
    __device__ __forceinline__ void operator()(const f32x4 (&acc)[2][2][4][2], const Unit& u, int wr, int wc, int fr, int fq) const {
        const int row0 = u.pm * BM + wr * 64 + fr;
#pragma unroll
        for (int ai = 0; ai < 2; ++ai)
#pragma unroll
            for (int m = 0; m < 4; ++m) { const int row = row0 + ai * HALF + m * 16;
                if (u.pn == 0) {
#pragma unroll
                    for (int bj = 0; bj < 2; ++bj) { float* lp = LOG + (size_t)row * NE + bj * HALF + wc * 32 + 8 * fq; *(f32x4*)lp = acc[ai][bj][m][0]; *(f32x4*)(lp + 4) = acc[ai][bj][m][1]; }
                } else {
                    const f32x4 g0 = acc[ai][0][m][0], g1 = acc[ai][0][m][1], u0 = acc[ai][1][m][0], u1 = acc[ai][1][m][1];
                    u32x4 w; w.x = cvt_pk_bf16(silu_mul(g0[0], u0[0]), silu_mul(g0[1], u0[1])); w.y = cvt_pk_bf16(silu_mul(g0[2], u0[2]), silu_mul(g0[3], u0[3]));
                    w.z = cvt_pk_bf16(silu_mul(g1[0], u1[0]), silu_mul(g1[1], u1[1])); w.w = cvt_pk_bf16(silu_mul(g1[2], u1[2]), silu_mul(g1[3], u1[3]));
                    *(u32x4*)(ACTS + (size_t)row * EFF + (u.pn - 1) * HALF + wc * 32 + 8 * fq) = w; } }
    }
};

struct EpiBf16RowScale {
    static constexpr bool PERM = true;
    bf16_t* O; int ldc; const LAS float* rtab;
    __device__ __forceinline__ void operator()(const f32x4 (&acc)[2][2][4][2], const Unit& u, int wr, int wc, int fr, int fq) const {
        const int row0 = u.pm * BM + wr * 64 + fr, col0 = u.pn * BM + wc * 32 + 8 * fq;
#pragma unroll
        for (int ai = 0; ai < 2; ++ai)
#pragma unroll
            for (int m = 0; m < 4; ++m) { const int row = row0 + ai * HALF + m * 16; bf16_t* rowp = O + (size_t)row * ldc + col0;
                const float g = rtab[2 * (row - u.pm * BM) + 1];
#pragma unroll
                for (int bj = 0; bj < 2; ++bj) { const f32x4 v0 = acc[ai][bj][m][0] * g, v1 = acc[ai][bj][m][1] * g;
                    u32x4 w; w.x = cvt_pk_bf16(v0[0], v0[1]); w.y = cvt_pk_bf16(v0[2], v0[3]); w.z = cvt_pk_bf16(v1[0], v1[1]); w.w = cvt_pk_bf16(v1[2], v1[3]);
                    *(u32x4*)(rowp + bj * HALF) = w; } }
    }
};

template <class Epi, class Sched, bool ALIGN_EPI, bool GATHER = false, bool MIDSCALE = false>
__device__ __forceinline__ void gemm_phase(LAS unsigned char* lds, const bf16_t* Abase_, int K, const Sched& S, const Epi& E, const float* stat = nullptr) {
    int tid_ = threadIdx.x; asm volatile("" : "+v"(tid_));
    const int tid = tid_, wid = __builtin_amdgcn_readfirstlane(tid >> 6), lane = tid & 63, wr = wid >> 2, wc = wid & 3, fr = lane & 15, fq = lane >> 4;
    const int nt = K / BK;
    const char* Abase = (const char*)Abase_;
    unsigned voffB[2], voffA[2];
#pragma unroll
    for (int i = 0; i < 2; ++i) { int R, C; stage_rc(tid * 16 + i * 8192, R, C); const int Rb = Epi::PERM ? ((R & ~31) + perm32(R & 31)) : R; voffB[i] = (unsigned)(Rb * K + C) * 2u; voffA[i] = (unsigned)(R * K + C) * 2u; }
    const size_t kstep = (size_t)(BK * 2);
    const size_t hstep = (size_t)HALF * K * 2;
    const unsigned ldsw = (unsigned)wid * 1024u;
    const int aoff = lds_byte(wr * 64 + fr, fq * 8), boff = lds_byte(wc * 32 + fr, fq * 8);
#define PG8_SA(b, h) (((b) * 2 + (h)) * HTB)
#define PG8_SB(b, h) ((4 + (b) * 2 + (h)) * HTB)
#define PG8_STAGE_B(bufoff, gbase) do { _Pragma("unroll") for (int _i = 0; _i < 2; ++_i) \
        __builtin_amdgcn_global_load_lds((const unsigned*)((const char*)(gbase) + voffB[_i]), (LAS unsigned*)(lds + (bufoff) + ldsw + _i * 8192), 16, 0, 0); } while (0)
#define PG8_STAGE_A(bufoff, ua, pa, h, koff) do { _Pragma("unroll") for (int _i = 0; _i < 2; ++_i) { \
        const char* _g = GATHER ? (Abase + (size_t)(ua)[h][_i] + (koff)) : ((pa) + (size_t)(h) * hstep + voffA[_i] + (koff)); \
        __builtin_amdgcn_global_load_lds((const unsigned*)_g, (LAS unsigned*)(lds + (bufoff) + ldsw + _i * 8192), 16, 0, 0); } } while (0)
#define PG8_LDA(dst, b, h) do { _Pragma("unroll") for (int m = 0; m < 4; ++m) _Pragma("unroll") for (int k = 0; k < 2; ++k) dst[m][k] = *(const LAS bf16x8*)(lds + PG8_SA(b, h) + aoff + m * 2048 + k * 1024); } while (0)
#define PG8_LDB(dst, b, h) do { _Pragma("unroll") for (int n = 0; n < 2; ++n) _Pragma("unroll") for (int k = 0; k < 2; ++k) dst[n][k] = *(const LAS bf16x8*)(lds + PG8_SB(b, h) + boff + n * 2048 + k * 1024); } while (0)
#define PG8_MMA(ai, bj, At, Bt) do { __builtin_amdgcn_s_setprio(1); _Pragma("unroll") for (int m = 0; m < 4; ++m) _Pragma("unroll") for (int n = 0; n < 2; ++n) _Pragma("unroll") for (int k = 0; k < 2; ++k) \
        acc[ai][bj][m][n] = __builtin_amdgcn_mfma_f32_16x16x32_bf16(Bt[n][k], At[m][k], acc[ai][bj][m][n], 0, 0, 0); __builtin_amdgcn_s_setprio(0); } while (0)
#define PG8_WAIT_V(n) asm volatile("s_waitcnt vmcnt(" #n ")" ::: "memory")
#define PG8_WAIT_L(n) asm volatile("s_waitcnt lgkmcnt(" #n ")" ::: "memory")
#define PG8_BAR __builtin_amdgcn_s_barrier()
#define PG8_SCHED __builtin_amdgcn_sched_barrier(0)
    Unit cur, nxt; int ui = 0;
    if (!S.next(0, cur)) return;
    f32x4 acc[2][2][4][2];
#pragma unroll
    for (int a = 0; a < 2; ++a)
#pragma unroll
        for (int b = 0; b < 2; ++b)
#pragma unroll
            for (int m = 0; m < 4; ++m)
#pragma unroll
                for (int n = 0; n < 2; ++n) acc[a][b][m][n] = (f32x4){0.f, 0.f, 0.f, 0.f};
    bf16x8 At[4][2], B0[2][2], B1[2][2];
    unsigned uc[2][2], un[2][2];
    if constexpr (GATHER) S.a_offsets(cur, tid, uc);
    const char* cA = Abase + (size_t)cur.rowbase * K * 2;
    const char* cB = S.b_tile(cur);
    PG8_STAGE_B(PG8_SB(0, 0), cB); PG8_STAGE_B(PG8_SB(0, 1), cB + hstep); PG8_STAGE_A(PG8_SA(0, 0), uc, cA, 0, (size_t)0); PG8_STAGE_A(PG8_SA(0, 1), uc, cA, 1, (size_t)0);
    if (wr == 1) PG8_BAR;
    PG8_WAIT_V(2); PG8_BAR;
    PG8_STAGE_B(PG8_SB(1, 0), cB + kstep); PG8_STAGE_A(PG8_SA(1, 0), uc, cA, 0, kstep); PG8_STAGE_B(PG8_SB(1, 1), cB + hstep + kstep);
    PG8_WAIT_V(6); PG8_BAR;
    for (;;) {
        const bool has_next = S.next(ui + 1, nxt);
        const bool lower = cur.nrows > wr * 64, upper = cur.nrows > HALF + wr * 64;
        const char* nB = cB; const char* nA = cA;
        if (has_next) { if constexpr (GATHER) S.a_offsets(nxt, tid, un); nB = S.b_tile(nxt); nA = Abase + (size_t)nxt.rowbase * K * 2; }
        else if constexpr (GATHER) {
#pragma unroll
            for (int h = 0; h < 2; ++h)
#pragma unroll
                for (int i = 0; i < 2; ++i) un[h][i] = uc[h][i];
        }
#pragma unroll 1
        for (int t = 0; t < nt; t += 2) {
            const bool last = (t == nt - 2);
            const size_t k1 = (size_t)(t + 1) * kstep;
            const size_t k2 = last ? (size_t)0 : (size_t)(t + 2) * kstep, k3 = k2 + kstep;
            const char* b2 = last ? nB : cB + (size_t)(t + 2) * kstep; const char* b3 = b2 + kstep;
            const char* a2 = last ? nA : cA;
            unsigned x2[2][2];
            if constexpr (GATHER) {
#pragma unroll
                for (int h = 0; h < 2; ++h)
#pragma unroll
                    for (int i = 0; i < 2; ++i) x2[h][i] = uc[h][i];
                if (last) { asm volatile("; next unit's A offsets" ::: "memory");
#pragma unroll
                    for (int h = 0; h < 2; ++h)
#pragma unroll
                        for (int i = 0; i < 2; ++i) x2[h][i] = un[h][i]; }
            }
            if constexpr (MIDSCALE) { if (t == nt / 2) {
#pragma unroll
                for (int ai = 0; ai < 2; ++ai)
#pragma unroll
                    for (int m = 0; m < 4; ++m) { const float f = ((const LAS float*)(lds + STAGE_BYTES))[2 * (ai * HALF + wr * 64 + m * 16 + fr)];
#pragma unroll
                        for (int bj = 0; bj < 2; ++bj)
#pragma unroll
                            for (int n = 0; n < 2; ++n) acc[ai][bj][m][n] *= f; } } }
            PG8_LDB(B0, 0, 0); PG8_LDB(B1, 0, 1); PG8_SCHED; PG8_LDA(At, 0, 0); PG8_STAGE_A(PG8_SA(1, 1), uc, cA, 1, k1);
            PG8_WAIT_V(8); PG8_WAIT_L(0); PG8_BAR; if (lower) { PG8_MMA(0, 0, At, B0); PG8_MMA(0, 1, At, B1); } PG8_BAR; PG8_SCHED;
            PG8_LDA(At, 0, 1); PG8_STAGE_B(PG8_SB(0, 0), b2); PG8_STAGE_B(PG8_SB(0, 1), b2 + hstep); PG8_STAGE_A(PG8_SA(0, 0), x2, a2, 0, k2);
            PG8_WAIT_V(8); PG8_WAIT_L(0); PG8_BAR; if (upper) { PG8_MMA(1, 0, At, B0); PG8_MMA(1, 1, At, B1); } PG8_BAR; PG8_SCHED;
            PG8_LDB(B0, 1, 0); PG8_LDB(B1, 1, 1); PG8_SCHED; PG8_LDA(At, 1, 0); PG8_STAGE_A(PG8_SA(0, 1), x2, a2, 1, k2);
            PG8_WAIT_V(8); PG8_WAIT_L(0); PG8_BAR; if (lower) { PG8_MMA(0, 0, At, B0); PG8_MMA(0, 1, At, B1); } PG8_BAR; PG8_SCHED;
            PG8_LDA(At, 1, 1); PG8_STAGE_B(PG8_SB(1, 0), b3); PG8_STAGE_B(PG8_SB(1, 1), b3 + hstep); PG8_STAGE_A(PG8_SA(1, 0), x2, a2, 0, k3);
            PG8_WAIT_V(8); PG8_WAIT_L(0); PG8_BAR; if (upper) { PG8_MMA(1, 0, At, B0); PG8_MMA(1, 1, At, B1); } PG8_BAR; PG8_SCHED;
        }
        if constexpr (ALIGN_EPI) { if (wr == 0) PG8_BAR; }
        E(acc, cur, wr, wc, fr, fq);
        if (!has_next) break;
#pragma unroll
        for (int a = 0; a < 2; ++a)
#pragma unroll
            for (int b = 0; b < 2; ++b)
#pragma unroll
                for (int m = 0; m < 4; ++m)
#pragma unroll
                    for (int n = 0; n < 2; ++n) acc[a][b][m][n] = (f32x4){0.f, 0.f, 0.f, 0.f};
        cur = nxt; cB = nB; cA = nA; ++ui;
        if constexpr (GATHER) {
#pragma unroll
            for (int h = 0; h < 2; ++h)
#pragma unroll
                for (int i = 0; i < 2; ++i) uc[h][i] = un[h][i];
        }
        if constexpr (ALIGN_EPI) { if (wr == 1) PG8_BAR; }
    }
    PG8_WAIT_V(0);
    if constexpr (!ALIGN_EPI) { if (wr == 0) PG8_BAR; }
    PG8_BAR;
#undef PG8_SA
#undef PG8_SB
#undef PG8_STAGE_A
#undef PG8_STAGE_B
#undef PG8_LDA
#undef PG8_LDB
#undef PG8_MMA
#undef PG8_WAIT_V
#undef PG8_WAIT_L
#undef PG8_BAR
#undef PG8_SCHED
}
}

__device__ __forceinline__ void cvt_item(const float* W, int ldw, int col0, int k0, bf16_t* WT, int drow0, int Kd, const float* gk, LAS float* scr, int lane) {
    const int kr = lane >> 3, n4 = lane & 7;
    float4 v[8];
#pragma unroll
    for (int i = 0; i < 8; ++i) v[i] = *(const float4*)&W[(size_t)(k0 + 8 * i + kr) * ldw + col0 + 4 * n4];
#pragma unroll
    for (int i = 0; i < 8; ++i) { const int kk = 8 * i + kr; const float g = gk ? gk[k0 + kk] : 1.f; LAS float* d = scr + kk * 33 + 4 * n4;
        d[0] = v[i].x * g; d[1] = v[i].y * g; d[2] = v[i].z * g; d[3] = v[i].w * g; }
    asm volatile("s_waitcnt lgkmcnt(0)" ::: "memory");
    const int cch = lane & 7;
#pragma unroll
    for (int j = 0; j < 4; ++j) { const int n = (lane >> 3) + 8 * j; const LAS float* sp = scr + (8 * cch) * 33 + n;
        uint4 o; o.x = pk2(sp[0 * 33], sp[1 * 33]); o.y = pk2(sp[2 * 33], sp[3 * 33]); o.z = pk2(sp[4 * 33], sp[5 * 33]); o.w = pk2(sp[6 * 33], sp[7 * 33]);
        *(uint4*)(WT + (size_t)(drow0 + n) * Kd + k0 + 8 * cch) = o; }
    asm volatile("s_waitcnt lgkmcnt(0)" ::: "memory");
}
#define PHASE_PTRS \
    unsigned char* wsp = args.ws; asm volatile("" : "+s"(wsp)); \
    const float* x = args.in[0]; const float* cvec = args.in[1]; const float* w_ada = args.in[2]; const float* b_ada = args.in[3]; \
    const float* g_pre_mix = args.in[4]; const float* g_post_mix = args.in[5]; const float* g_pre_ffn = args.in[6]; const float* g_post_ffn = args.in[7]; \
    const float* w_in = args.in[8]; const float* g_q_a = args.in[9]; const float* w_q_b = args.in[10]; const float* g_kv_a = args.in[11]; const float* w_kv_b = args.in[12]; \
    const float* g_q_head = args.in[13]; const float* g_k_head = args.in[14]; const float* g_mla_out = args.in[15]; const float* g_gqa_out = args.in[16]; \
    const float* w_out = args.in[17]; const float* w_router = args.in[18]; const float* b_router = args.in[19]; \
    const float* w_gate_e = args.in[20]; const float* w_up_e = args.in[21]; const float* w_down_e = args.in[22]; \
    const float* w_gate_s = args.in[23]; const float* w_up_s = args.in[24]; const float* w_down_s = args.in[25]; \
    float* mod = (float*)(wsp + WS_MOD); \
    float* cosm = (float*)(wsp + WS_COSM); float* sinm = (float*)(wsp + WS_SINM); float* cosg = (float*)(wsp + WS_COSG); float* sing = (float*)(wsp + WS_SING); \
    bf16_t* H2 = (bf16_t*)(wsp + WS_H2); \
    bf16_t* QM = (bf16_t*)(wsp + WS_QM); bf16_t* KM = (bf16_t*)(wsp + WS_KM); bf16_t* VM = (bf16_t*)(wsp + WS_VM); \
    bf16_t* QG = (bf16_t*)(wsp + WS_QG); bf16_t* KG = (bf16_t*)(wsp + WS_KG); bf16_t* VG = (bf16_t*)(wsp + WS_VG); \
    bf16_t* O = (bf16_t*)(wsp + WS_O); \
    bf16_t* X1 = (bf16_t*)(wsp + WS_X1); float* WTS = (float*)(wsp + WS_WTS); int* LIST = (int*)(wsp + WS_LIST); \
    bf16_t* SLOTS = (bf16_t*)(wsp + WS_SLOTS); int* POSREC = (int*)(wsp + WS_POSREC); float* OSTAT = (float*)(wsp + WS_OSTAT); \
    bf16_t* PBUF = (bf16_t*)(wsp + WS_PBUF); bf16_t* WBIGT = (bf16_t*)(wsp + WS_WBIGT); \
    bf16_t* WQBT = (bf16_t*)(wsp + WS_WQBT); bf16_t* WINQ = (bf16_t*)(wsp + WS_WINQ); bf16_t* WKVBT = (bf16_t*)(wsp + WS_WKVBT); bf16_t* WINKV = (bf16_t*)(wsp + WS_WINKV); \
    bf16_t* WOUTT = (bf16_t*)(wsp + WS_WOUTT); bf16_t* WRST = (bf16_t*)(wsp + WS_WRST); bf16_t* WDST = (bf16_t*)(wsp + WS_WDST); \
    bf16_t* WGUT = (bf16_t*)(wsp + WS_WGUT); bf16_t* WDT = (bf16_t*)(wsp + WS_WDT); \
    bf16_t* MIXED = (bf16_t*)(wsp + WS_MIXED); float* LOG = (float*)(wsp + WS_LOG); bf16_t* ACT = (bf16_t*)(wsp + WS_ACT); bf16_t* ACTS = (bf16_t*)(wsp + WS_ACTS); bf16_t* YSH = (bf16_t*)(wsp + WS_YSH);

__global__ void __launch_bounds__(NTHR, 2) mega(Args args) {
    extern __shared__ __attribute__((aligned(16))) unsigned char lds_raw[];
    unsigned char* ws = args.ws;
    unsigned* ctl = (unsigned*)(ws + WS_CTL);
    volatile LAS unsigned* bst = (volatile LAS unsigned*)(lds_raw + LDS_BYTES - 16);
    if (threadIdx.x < 4) bst[threadIdx.x] = 0u;
    const int nbk = gridDim.x, bidk = blockIdx.x;
    __syncthreads();
    XcdBarrier bar; bar.bar = ctl + CW_BAR; bar.x = 0; bar.st = bst;
    if (MK_N_LAUNCHES == 1) bar = xcd_barrier_post(ctl + CW_BAR, bst);
    const int lo = args.ph_lo, hi = args.ph_hi;
    const int vcu = (nbk % 8 == 0) ? (bidk % 8) * (nbk / 8) + bidk / 8 : bidk;
    LAS unsigned char* ldsb = (LAS unsigned char*)lds_raw;
#define IN(k) (lo <= (k) && (k) < hi && (pass_ == 0 || ((k) >= REP_FROM && (k) != 8)))
#define SEAM(k) do { if (lo <= (k) && (k) + 1 < hi && (pass_ == 0 || (k) >= REP_FROM)) xcd_barrier(bar); } while (0)

    unsigned* CNT = (unsigned*)(ws + WS_CNTS);

    for (int pass_ = 0; pass_ < (REP_FROM < 12 ? 2 : 1); ++pass_) {
    if (pass_) xcd_barrier(bar);
    if (IN(0)) for (int rep_ = 0; rep_ < (((REPEAT_MASK >> 0) & 1) ? 2 : 1); ++rep_) {
        const Ctx c = mkctx(ws, lds_raw); PHASE_PTRS
        float* red = c.lds;
        if (c.tid == 0) for (int e = c.bid; e < NE; e += c.nb) CNT[(size_t)e * CNT_STRIDE] = 0u;
        for (int g = c.bid; g < 192; g += c.nb) {
            const int c4 = c.tid & 7, kr = c.tid >> 3;
            float4 w[16];
#pragma unroll
            for (int i = 0; i < 16; ++i) w[i] = *(const float4*)&w_ada[(size_t)(64 * i + kr) * 6144 + g * 32 + 4 * c4];
            float4 a0 = make_float4(0.f, 0.f, 0.f, 0.f), a1 = a0;
#pragma unroll
            for (int i = 0; i < 16; ++i) { const int k = 64 * i + kr; const float c0 = cvec[k], c1 = cvec[DM + k]; const float f0 = c0 * sigmoidf_(c0), f1 = c1 * sigmoidf_(c1);
                a0.x += f0 * w[i].x; a0.y += f0 * w[i].y; a0.z += f0 * w[i].z; a0.w += f0 * w[i].w; a1.x += f1 * w[i].x; a1.y += f1 * w[i].y; a1.z += f1 * w[i].z; a1.w += f1 * w[i].w; }
            __syncthreads();
            *(float4*)&red[(kr * 8 + c4) * 4] = a0; *(float4*)&red[2048 + (kr * 8 + c4) * 4] = a1;
            __syncthreads();
            if (c.tid < 64) { const int b = c.tid >> 5, cc = c.tid & 31; float sacc = 0.f; for (int j = 0; j < 64; ++j) sacc += red[b * 2048 + j * 32 + cc]; mod[b * 6144 + g * 32 + cc] = sacc + b_ada[g * 32 + cc]; }
        }
        __syncthreads();
        for (int idx = c.bid * NTHR + c.tid; idx < SEQ * 16; idx += c.nb * NTHR) {
            const int s = idx >> 4, i = idx & 15, f = i & 7;
            const float inv = powf(10000.f, -(float)f / 8.f);
            const float pos = (float)((i < 8) ? (s >> 6) : (s & 63));
            const float ang = pos * inv;
            cosm[idx] = cosf(ang); sinm[idx] = sinf(ang);
        }
        for (int idx = c.bid * NTHR + c.tid; idx < SEQ * 32; idx += c.nb * NTHR) {
            const int s = idx >> 5, i = idx & 31, f = i & 15;
            const float inv = powf(10000.f, -(float)f / 16.f);
            const float pos = (float)((i < 16) ? (s >> 6) : (s & 63));
            const float ang = pos * inv;
            cosg[idx] = cosf(ang); sing[idx] = sinf(ang);
        }
        LAS float* scr = (LAS float*)(ldsb + 8192 + c.wave * 8448);
        constexpr int I_BIG = 37 * 16;
        constexpr int I_QB = 24 * 4;
        constexpr int I_KVB = 32 * 2;
        constexpr int I_OUT = 32 * 16;
        constexpr int I_RS = 24 * 16;
        constexpr int I_DS = 32 * 4;
        const int I_EXP = (c.nb == NE && (CONV_MODE == 1 || CONV_MODE == 5)) ? 0 : NE * 384;
        const int I_TOT = I_BIG + I_QB + I_KVB + I_OUT + I_RS + I_DS + I_EXP;
        for (int it = c.gw; it < I_TOT; it += c.ngw) {
            int r = it;
            if (r < I_BIG) { const int grp = r >> 4, kb = r & 15; const int col0 = grp * 32, drow = (grp < 13) ? grp * 32 : 2304 + (grp - 13) * 32;
                cvt_item(w_in, INC, col0, kb * 64, WBIGT, drow, DM, nullptr, scr, c.lane); continue; }
            r -= I_BIG;
            if (r < I_QB) { const int grp = r >> 2, kb = r & 3; cvt_item(w_q_b, 768, grp * 32, kb * 64, WQBT, grp * 32, 256, g_q_a, scr, c.lane); continue; }
            r -= I_QB;
            if (r < I_KVB) { const int grp = r >> 1, kb = r & 1; cvt_item(w_kv_b, 1024, grp * 32, kb * 64, WKVBT, grp * 32, 256, g_kv_a, scr, c.lane); continue; }
            r -= I_KVB;
            if (r < I_OUT) { const int grp = r >> 4, kb = r & 15; cvt_item(w_out, DM, grp * 32, kb * 64, WOUTT, grp * 32, DM, (kb < 8) ? g_mla_out : (g_gqa_out - 512), scr, c.lane); continue; }
            r -= I_OUT;
            if (r < I_RS) { const int grp = r >> 4, kb = r & 15;
                if (grp < 8) cvt_item(w_router, NE, grp * 32, kb * 64, WRST, grp * 32, DM, nullptr, scr, c.lane);
                else { const int q = grp - 8, blk = q >> 2, sub = q & 3;
                    cvt_item((blk & 1) ? w_up_s : w_gate_s, EFF, (blk >> 1) * 128 + sub * 32, kb * 64, WRST, 256 + blk * 128 + sub * 32, DM, nullptr, scr, c.lane); }
                continue; }
            r -= I_RS;
            if (r < I_DS) { const int grp = r >> 2, kb = r & 3; cvt_item(w_down_s, DM, grp * 32, kb * 64, WDST, grp * 32, EFF, nullptr, scr, c.lane); continue; }
            r -= I_DS;
            { const int e = r / 384, q = r % 384;
              if (q < 256) { const int up = q >> 7, q2 = q & 127, grp = q2 >> 4, kb = q2 & 15;
                  const int drow = ((grp < 4) ? grp * 32 : 256 + (grp - 4) * 32) + up * 128;
                  cvt_item((up ? w_up_e : w_gate_e) + (size_t)e * DM * EFF, EFF, grp * 32, kb * 64, WGUT + (size_t)e * 512 * DM, drow, DM, nullptr, scr, c.lane); }
              else { const int q2 = q - 256, grp = q2 >> 2, kb = q2 & 3;
                  cvt_item(w_down_e + (size_t)e * EFF * DM, DM, grp * 32, kb * 64, WDT + (size_t)e * DM * EFF, grp * 32, EFF, nullptr, scr, c.lane); } }
        }
        const int gt = c.bid * NTHR + c.tid, ngt = c.nb * NTHR;
        for (int i = gt; i < 96 * 1024 / 8; i += ngt) *(uint4*)(WBIGT + (size_t)416 * DM + (size_t)i * 8) = make_uint4(0u, 0u, 0u, 0u);
        for (int i = gt; i < 1024 * 16; i += ngt) { const int n = i >> 4, q = i & 15; *(uint4*)(WKVBT + (size_t)n * 256 + 128 + q * 8) = make_uint4(0u, 0u, 0u, 0u); }
        for (int i = gt; i < 1024 * 64; i += ngt) { const int k = i >> 6, q = i & 63; const float4 v = *(const float4*)&w_in[(size_t)k * INC + q * 4]; uint2 o; o.x = pk2(v.x, v.y); o.y = pk2(v.z, v.w); *(uint2*)(WINQ + (size_t)k * 256 + q * 4) = o; }
        for (int i = gt; i < 1024 * 64; i += ngt) { const int k = i >> 6, q = i & 63; uint2 o = make_uint2(0u, 0u);
            if (q < 32) { const float4 v = *(const float4*)&w_in[(size_t)k * INC + 256 + q * 4]; o.x = pk2(v.x, v.y); o.y = pk2(v.z, v.w); }
            *(uint2*)(WINKV + (size_t)k * 256 + q * 4) = o; }
    }
    SEAM(0);

    if (IN(1)) for (int rep_ = 0; rep_ < (((REPEAT_MASK >> 1) & 1) ? 2 : 1); ++rep_) {
        const Ctx c = mkctx(ws, lds_raw); PHASE_PTRS
        { pg8::DenseOrder S; S.init(768, 1024, 256, WINQ, c.nb, c.bid); pg8::EpiBf16 E{WBIGT + (size_t)512 * DM, DM};
          pg8::gemm_phase<pg8::EpiBf16, pg8::DenseOrder, true>(ldsb, WQBT, 256, S, E); }
        { pg8::DenseOrder S; S.init(1024, 1024, 256, WINKV, c.nb, (c.bid >= 12 && c.nb >= 28) ? c.bid - 12 : c.bid + (c.nb >= 28 ? c.nb : 0)); pg8::EpiBf16 E{WBIGT + (size_t)1280 * DM, DM};
          pg8::gemm_phase<pg8::EpiBf16, pg8::DenseOrder, true>(ldsb, WKVBT, 256, S, E); }
        for (int m0 = c.gw; m0 < NTOK; m0 += 2 * c.ngw) {
            float4 v[2][4]; float ss[2];
#pragma unroll
            for (int q = 0; q < 2; ++q) { const int m = m0 + q * c.ngw; ss[q] = 0.f;
#pragma unroll
                for (int j = 0; j < 4; ++j) { v[q][j] = *(const float4*)&x[(size_t)m * DM + 4 * c.lane + 256 * j]; } }
#pragma unroll
            for (int q = 0; q < 2; ++q) {
                const int m = m0 + q * c.ngw; const int b = m / SEQ; const float* md = mod + b * 6144;
#pragma unroll
                for (int j = 0; j < 4; ++j) ss[q] += v[q][j].x * v[q][j].x + v[q][j].y * v[q][j].y + v[q][j].z * v[q][j].z + v[q][j].w * v[q][j].w;
                const float rstd = rsqrtf(wave_sum(ss[q]) * (1.f / DM) + EPS);
#pragma unroll
                for (int j = 0; j < 4; ++j) {
                    const int cc = 4 * c.lane + 256 * j;
                    const float4 g = *(const float4*)&g_pre_mix[cc], sc = *(const float4*)&md[1024 + cc], sh = *(const float4*)&md[cc];
                    uint2 o;
                    o.x = pk2(v[q][j].x * rstd * g.x * (1.f + sc.x) + sh.x, v[q][j].y * rstd * g.y * (1.f + sc.y) + sh.y);
                    o.y = pk2(v[q][j].z * rstd * g.z * (1.f + sc.z) + sh.z, v[q][j].w * rstd * g.w * (1.f + sc.w) + sh.w);
                    *(uint2*)&H2[(size_t)m * DM + cc] = o;
                }
            }
        }
    }
    SEAM(1);

    if (IN(2)) for (int rep_ = 0; rep_ < (((REPEAT_MASK >> 2) & 1) ? 2 : 1); ++rep_) {
        const Ctx c = mkctx(ws, lds_raw); PHASE_PTRS
        pg8::DenseOrder S; S.init(NTOK, 3072, DM, WBIGT, c.nb, c.bid); pg8::EpiBf16 E{PBUF, 3072};
        pg8::gemm_phase<pg8::EpiBf16, pg8::DenseOrder, true>(ldsb, H2, DM, S, E);
    }
    SEAM(2);

    if (IN(3)) for (int rep_ = 0; rep_ < (((REPEAT_MASK >> 3) & 1) ? 2 : 1); ++rep_) {
        const Ctx c = mkctx(ws, lds_raw); PHASE_PTRS
        unsigned* kmaxL = (unsigned*)lds_raw;
        if (c.tid < 18) kmaxL[c.tid] = 0u;
        __syncthreads();
        uint4 nraw[6];
#pragma unroll
        for (int j = 0; j < 6; ++j) nraw[j] = *(const uint4*)(PBUF + (size_t)c.gw * 3072 + 512 * j + 8 * c.lane);
        for (int m = c.gw; m < NTOK; m += c.ngw) {
            const int b = m / SEQ, s = m % SEQ;
            uint4 raw[6];
#pragma unroll
            for (int j = 0; j < 6; ++j) raw[j] = nraw[j];
            if (m + c.ngw < NTOK) {
#pragma unroll
                for (int j = 0; j < 6; ++j) nraw[j] = *(const uint4*)(PBUF + (size_t)(m + c.ngw) * 3072 + 512 * j + 8 * c.lane);
            }
            float rq, rkv;
            {
                float v[8]; { const uint4 u = raw[0]; v[0] = bf2f(u.x & 0xffffu); v[1] = bf2f(u.x >> 16); v[2] = bf2f(u.y & 0xffffu); v[3] = bf2f(u.y >> 16); v[4] = bf2f(u.z & 0xffffu); v[5] = bf2f(u.z >> 16); v[6] = bf2f(u.w & 0xffffu); v[7] = bf2f(u.w >> 16); }
                float sq = 0.f;
#pragma unroll
                for (int i = 0; i < 8; ++i) sq += v[i] * v[i];
                rq = rsqrtf(wave_sum(c.lane < 32 ? sq : 0.f) * (1.f / QLORA) + EPS);
                rkv = rsqrtf(wave_sum((c.lane >= 32 && c.lane < 48) ? sq : 0.f) * (1.f / KVLORA) + EPS);
                if (c.lane >= 48 && c.lane < 52) {
                    const int i0 = 4 * (c.lane - 48); uint4 o; unsigned ow[4];
#pragma unroll
                    for (int pq = 0; pq < 4; ++pq) { const float cs = cosm[s * 16 + i0 + pq], sn = sinm[s * 16 + i0 + pq]; ow[pq] = pk2(v[2 * pq] * cs - v[2 * pq + 1] * sn, v[2 * pq] * sn + v[2 * pq + 1] * cs); }
                    o.x = ow[0]; o.y = ow[1]; o.z = ow[2]; o.w = ow[3];
#pragma unroll
                    for (int h = 0; h < MH; ++h) *(uint4*)&KM[((size_t)(b * MH + h) * SEQ + s) * DQKM + MNOPE + 2 * i0] = o;
                    float pq = 0.f;
#pragma unroll
                    for (int i = 0; i < 8; ++i) pq += v[i] * v[i];
                    pq += dppmov<0xB1, 0xF>(0.f, pq); pq += dppmov<0x4E, 0xF>(0.f, pq);
                    if (c.lane == 48) atomicMax(&kmaxL[16 + b], __builtin_bit_cast(unsigned, pq));
                }
            }
#pragma unroll
            for (int j = 1; j < 6; ++j) {
                const int col0 = 512 * j + 8 * c.lane;
                float v[8]; { const uint4 u = raw[j]; v[0] = bf2f(u.x & 0xffffu); v[1] = bf2f(u.x >> 16); v[2] = bf2f(u.y & 0xffffu); v[3] = bf2f(u.y >> 16); v[4] = bf2f(u.z & 0xffffu); v[5] = bf2f(u.z >> 16); v[6] = bf2f(u.w & 0xffffu); v[7] = bf2f(u.w >> 16); }
                if (col0 < 1280) {
                    const int qc = col0 - 512, h = qc / DQKM, d0 = qc % DQKM; const float sc = rq * C2M;
                    uint4 o; unsigned ow[4];
                    if (d0 >= MNOPE) { const int i0 = (d0 - MNOPE) >> 1;
#pragma unroll
                        for (int pq = 0; pq < 4; ++pq) { const float cs = cosm[s * 16 + i0 + pq], sn = sinm[s * 16 + i0 + pq]; ow[pq] = pk2((v[2 * pq] * cs - v[2 * pq + 1] * sn) * sc, (v[2 * pq] * sn + v[2 * pq + 1] * cs) * sc); }
                    } else {
#pragma unroll
                        for (int pq = 0; pq < 4; ++pq) ow[pq] = pk2(v[2 * pq] * sc, v[2 * pq + 1] * sc);
                    }
                    o.x = ow[0]; o.y = ow[1]; o.z = ow[2]; o.w = ow[3];
                    *(uint4*)&QM[((size_t)(b * MH + h) * SEQ + s) * DQKM + d0] = o;
                } else if (col0 < 2304) {
                    const int kc = col0 - 1280, h = kc >> 7, d0 = kc & 127;
                    uint4 o; o.x = pk2(v[0] * rkv, v[1] * rkv); o.y = pk2(v[2] * rkv, v[3] * rkv); o.z = pk2(v[4] * rkv, v[5] * rkv); o.w = pk2(v[6] * rkv, v[7] * rkv);
                    if (d0 < MNOPE) { *(uint4*)&KM[((size_t)(b * MH + h) * SEQ + s) * DQKM + d0] = o;
                        float kq = 0.f;
#pragma unroll
                        for (int i = 0; i < 8; ++i) kq += (v[i] * rkv) * (v[i] * rkv);
                        kq += dppmov<0xB1, 0xF>(0.f, kq); kq += dppmov<0x4E, 0xF>(0.f, kq); kq += dppmov<0x141, 0xF>(0.f, kq);
                        if ((c.lane & 7) == 0) atomicMax(&kmaxL[b * 8 + h], __builtin_bit_cast(unsigned, kq)); }
                    else *(uint4*)&VM[((size_t)(b * MH + h) * SEQ + s) * MV + (d0 - MNOPE)] = o;
                } else if (col0 < 2944) {
                    const bool isq = col0 < 2816; const int hc = isq ? (col0 - 2304) : (col0 - 2816), h = hc >> 6, d0 = hc & 63;
                    float sq = 0.f;
#pragma unroll
                    for (int i = 0; i < 8; ++i) sq += v[i] * v[i];
                    sq += __shfl_xor(sq, 1); sq += __shfl_xor(sq, 2); sq += __shfl_xor(sq, 4);
                    const float rs = rsqrtf(sq * (1.f / GD) + EPS) * (isq ? C2G : 1.f); const float* gh = isq ? g_q_head : g_k_head;
                    uint4 o; unsigned ow[4];
#pragma unroll
                    for (int pq = 0; pq < 4; ++pq) { const int d = d0 + 2 * pq; const float cs = cosg[s * 32 + (d >> 1)], sn = sing[s * 32 + (d >> 1)];
                        const float x0 = v[2 * pq] * rs * gh[d], x1 = v[2 * pq + 1] * rs * gh[d + 1]; ow[pq] = pk2(x0 * cs - x1 * sn, x0 * sn + x1 * cs); }
                    o.x = ow[0]; o.y = ow[1]; o.z = ow[2]; o.w = ow[3];
                    if (isq) *(uint4*)&QG[((size_t)(b * GH + h) * SEQ + s) * GD + d0] = o;
                    else *(uint4*)&KG[((size_t)(b * GKV + h) * SEQ + s) * GD + d0] = o;
                } else {
                    const int hc = col0 - 2944, h = hc >> 6, d0 = hc & 63;
                    *(uint4*)&VG[((size_t)(b * GKV + h) * SEQ + s) * GD + d0] = raw[j];
                }
            }
        }
        __syncthreads();
        if (c.tid < 18) atomicMax(ctl + CW_KMAX + c.tid, kmaxL[c.tid]);
    }
    SEAM(3);

    if (IN(4)) for (int rep_ = 0; rep_ < (((REPEAT_MASK >> 4) & 1) ? 2 : 1); ++rep_) {
        const Ctx c = mkctx(ws, lds_raw); PHASE_PTRS
        att::ConvState cs;
        { const int e = (c.nb == NE) ? c.bid : 0;
          cs.cj = 0; cs.jbase = 384 * c.wave;
          cs.wg = (const char*)(w_gate_e + (size_t)e * DM * EFF); cs.wu = (const char*)(w_up_e + (size_t)e * DM * EFF); cs.wd = (const char*)(w_down_e + (size_t)e * EFF * DM);
          cs.dgu = (char*)(WGUT + (size_t)e * 512 * DM); cs.dd = (char*)(WDT + (size_t)e * DM * EFF);
          cs.ldsbuf = (unsigned)(uintptr_t)lds_raw + att::CONV_LDS + (CONV_MODE >= 5 ? 0 : c.wave * 4096); cs.rdbuf = (att::lds_cptr)lds_raw + att::CONV_LDS + (CONV_MODE >= 5 ? 0 : c.wave * 4096);
          if (CONV_MODE >= 5) cs.jbase = 0;
          if (CONV_MODE != 0 && CONV_MODE < 5) for (int i = 0; i < 3; ++i) { const att::ConvJob q = att::conv_job(cs, cs.cj);
              att::glds16_s(q.sbase, (unsigned)(c.lane >> 3) * q.ldwB + (unsigned)(c.lane & 7) * 16u, (unsigned)__builtin_amdgcn_readfirstlane(cs.ldsbuf + (cs.cj & 3) * 1024)); ++cs.cj; }
          asm volatile("s_waitcnt vmcnt(0)" ::: "memory"); }
        float mfix;
        { const float gq = wave_max(fabsf(g_q_head[c.lane])), gk = wave_max(fabsf(g_k_head[c.lane])); mfix = fminf(64.f * C2G * gq * gk * 1.03f + 0.5f, 60.f); }
        for (int uu = vcu; uu < 512; uu += c.nb) {
            const int bh = uu >> 5, b = bh >> 3, h = bh & 7, qp = uu & 31;
            const int q0 = qp * 256;
            const float kb2 = __builtin_bit_cast(float, ctl[CW_KMAX + b * 8 + h]) + __builtin_bit_cast(float, ctl[CW_KMAX + 16 + b]);
            att::unit96<8>(QM + (size_t)(b * MH + h) * SEQ * DQKM, KM + (size_t)(b * MH + h) * SEQ * DQKM, VM + (size_t)(b * MH + h) * SEQ * MV,
                                 O + ((size_t)b * SEQ + q0) * DM + h * 64, OSTAT + ((size_t)b * SEQ + q0) * 16 + h, q0, (char*)lds_raw, cs, kb2);
            att::unit64<8>(QG + (size_t)(b * GH + h) * SEQ * GD, KG + (size_t)(b * GKV + (h >> 2)) * SEQ * GD, VG + (size_t)(b * GKV + (h >> 2)) * SEQ * GD,
                                 O + ((size_t)b * SEQ + q0) * DM + (8 + h) * 64, OSTAT + ((size_t)b * SEQ + q0) * 16 + 8 + h, q0, (char*)lds_raw, cs, mfix);
        }
#if CONV_MODE >= 5
        {
            using namespace att;
            const int wid = c.wave, lane = c.lane; const bool rst = wid >= 6;
            for (int r4 = 0; r4 < 3; ++r4) { CONV_DRAIN(); ++cs.cj; }
        }
#endif
    }
    SEAM(4);

    if (IN(5)) for (int rep_ = 0; rep_ < (((REPEAT_MASK >> 5) & 1) ? 2 : 1); ++rep_) {
        const Ctx c = mkctx(ws, lds_raw); PHASE_PTRS
        pg8::DenseOrder S; S.init(NTOK, DM, DM, WOUTT, c.nb, c.bid);
        LAS float* rtab = (LAS float*)(ldsb + pg8::STAGE_BYTES);
        { pg8::Unit u0; if (S.next(0, u0) && c.tid < 256) { const float4* sp = (const float4*)&OSTAT[(size_t)(u0.pm * 256 + c.tid) * 16]; const float4 s0 = sp[0], s1 = sp[1], s2 = sp[2], s3 = sp[3];
            const float sm = ((s0.x + s0.y) + (s0.z + s0.w)) + ((s1.x + s1.y) + (s1.z + s1.w)), sg = ((s2.x + s2.y) + (s2.z + s2.w)) + ((s3.x + s3.y) + (s3.z + s3.w));
            const float rm = rsqrtf(sm * (1.f / 512) + EPS), rg = rsqrtf(sg * (1.f / 512) + EPS); rtab[2 * c.tid] = rm / rg; rtab[2 * c.tid + 1] = rg; }
          __syncthreads(); }
        pg8::EpiBf16RowScale E{MIXED, DM, rtab};
        pg8::gemm_phase<pg8::EpiBf16RowScale, pg8::DenseOrder, true, false, true>(ldsb, O, DM, S, E, nullptr);
    }
    SEAM(5);

    if (IN(6)) for (int rep_ = 0; rep_ < (((REPEAT_MASK >> 6) & 1) ? 2 : 1); ++rep_) {
        const Ctx c = mkctx(ws, lds_raw); PHASE_PTRS
        for (int m0 = c.gw; m0 < NTOK; m0 += 2 * c.ngw) {
            uint2 mu[2][4]; float4 xq[2][4];
#pragma unroll
            for (int q = 0; q < 2; ++q)
#pragma unroll
                for (int j = 0; j < 4; ++j) { const int m = m0 + q * c.ngw; mu[q][j] = *(const uint2*)&MIXED[(size_t)m * DM + 4 * c.lane + 256 * j]; xq[q][j] = *(const float4*)&x[(size_t)m * DM + 4 * c.lane + 256 * j]; }
#pragma unroll
            for (int q = 0; q < 2; ++q) {
                const int m = m0 + q * c.ngw; const int b = m / SEQ; const float* md = mod + b * 6144;
                float4 v[4], xr[4]; float ss = 0.f;
#pragma unroll
                for (int j = 0; j < 4; ++j) { const uint2 u = mu[q][j];
                    v[j].x = bf2f(u.x & 0xffffu); v[j].y = bf2f(u.x >> 16); v[j].z = bf2f(u.y & 0xffffu); v[j].w = bf2f(u.y >> 16);
                    ss += v[j].x * v[j].x + v[j].y * v[j].y + v[j].z * v[j].z + v[j].w * v[j].w; }
                const float rstd = rsqrtf(wave_sum(ss) * (1.f / DM) + EPS);
                float ss1 = 0.f;
#pragma unroll
                for (int j = 0; j < 4; ++j) {
                    const int cc = 4 * c.lane + 256 * j;
                    const float4 g = *(const float4*)&g_post_mix[cc], gt = *(const float4*)&md[2048 + cc], xx = xq[q][j];
                    xr[j].x = xx.x + gt.x * (v[j].x * rstd * g.x); xr[j].y = xx.y + gt.y * (v[j].y * rstd * g.y);
                    xr[j].z = xx.z + gt.z * (v[j].z * rstd * g.z); xr[j].w = xx.w + gt.w * (v[j].w * rstd * g.w);
                    ss1 += xr[j].x * xr[j].x + xr[j].y * xr[j].y + xr[j].z * xr[j].z + xr[j].w * xr[j].w;
                    { uint2 xo; xo.x = pk2(xr[j].x, xr[j].y); xo.y = pk2(xr[j].z, xr[j].w); *(uint2*)&X1[(size_t)m * DM + cc] = xo; }
                }
                const float rstd1 = rsqrtf(wave_sum(ss1) * (1.f / DM) + EPS);
#pragma unroll
                for (int j = 0; j < 4; ++j) {
                    const int cc = 4 * c.lane + 256 * j;
                    const float4 g = *(const float4*)&g_pre_ffn[cc], sc = *(const float4*)&md[4096 + cc], sh = *(const float4*)&md[3072 + cc];
                    uint2 pk;
                    pk.x = pk2(xr[j].x * rstd1 * g.x * (1.f + sc.x) + sh.x, xr[j].y * rstd1 * g.y * (1.f + sc.y) + sh.y);
                    pk.y = pk2(xr[j].z * rstd1 * g.z * (1.f + sc.z) + sh.z, xr[j].w * rstd1 * g.w * (1.f + sc.w) + sh.w);
                    *(uint2*)&H2[(size_t)m * DM + cc] = pk;
                }
            }
        }
    }
    SEAM(6);

    if (IN(7)) for (int rep_ = 0; rep_ < (((REPEAT_MASK >> 7) & 1) ? 2 : 1); ++rep_) {
        const Ctx c = mkctx(ws, lds_raw); PHASE_PTRS
        pg8::DenseOrder S; S.init(NTOK, 768, DM, WRST, c.nb, c.bid); pg8::EpiRS E{LOG, ACTS};
        pg8::gemm_phase<pg8::EpiRS, pg8::DenseOrder, true>(ldsb, H2, DM, S, E);
    }
    SEAM(7);

    if (IN(8)) for (int rep_ = 0; rep_ < (((REPEAT_MASK >> 8) & 1) ? 2 : 1); ++rep_) {
        const Ctx c = mkctx(ws, lds_raw); PHASE_PTRS
        const float4 bb = *(const float4*)&b_router[4 * c.lane];
        float4 lgn = *(const float4*)&LOG[(size_t)c.gw * NE + 4 * c.lane];
        int my_e = 0; float my_s = 0.f; int rb = 0, mb = c.gw;
        for (int m = c.gw; m < NTOK; m += c.ngw) {
            const float4 lg = lgn;
            if (m + c.ngw < NTOK) lgn = *(const float4*)&LOG[(size_t)(m + c.ngw) * NE + 4 * c.lane];
            const float s0 = sigmoidf_(lg.x), s1 = sigmoidf_(lg.y), s2 = sigmoidf_(lg.z), s3 = sigmoidf_(lg.w);
            float v0 = s0 + bb.x, v1 = s1 + bb.y, v2 = s2 + bb.z, v3 = s3 + bb.w;
            const int e0 = 4 * c.lane, g = c.lane >> 3;
            float gsc;
            {
                const float h01 = fmaxf(v0, v1), l01 = fminf(v0, v1), h23 = fmaxf(v2, v3), l23 = fminf(v2, v3);
                const float a1 = fmaxf(h01, h23), a2 = fmaxf(fminf(h01, h23), (h01 >= h23) ? l01 : l23);
                const float g1 = grp8_max(a1);
                const unsigned long long bm = __ballot(a1 == g1);
                const unsigned grpbits = (unsigned)(bm >> (8 * g)) & 0xffu;
                const bool first = (a1 == g1) && ((grpbits & ((1u << (c.lane & 7)) - 1u)) == 0u);
                const float g2 = grp8_max(first ? a2 : a1);
                gsc = g1 + g2;
            }
            int rank = 0;
#pragma unroll
            for (int j = 0; j < 8; ++j) { const float og = __builtin_bit_cast(float, __builtin_amdgcn_readlane(__builtin_bit_cast(int, gsc), 8 * j)); rank += (og > gsc || (og == gsc && j < g)) ? 1 : 0; }
            if (rank >= 4) { v0 = -INFINITY; v1 = -INFINITY; v2 = -INFINITY; v3 = -INFINITY; }
#pragma unroll 1
            for (int rnd = 0; rnd < TOPK; ++rnd) {
                float lm = v0; int li = 0; float ls = s0;
                if (v1 > lm) { lm = v1; li = 1; ls = s1; } if (v2 > lm) { lm = v2; li = 2; ls = s2; } if (v3 > lm) { lm = v3; li = 3; ls = s3; }
                const float mx = wave_max(lm);
                const unsigned long long bm = __ballot(lm == mx);
                const int owner = __builtin_amdgcn_readfirstlane((int)__builtin_ctzll(bm));
                const int bi = 4 * owner + __builtin_amdgcn_readlane(li, owner);
                const float sc = __builtin_bit_cast(float, __builtin_amdgcn_readlane(__builtin_bit_cast(int, ls), owner));
                if (c.lane == 8 * rb + rnd) { my_e = bi; my_s = sc; }
                if (bi == e0) v0 = -INFINITY; if (bi == e0 + 1) v1 = -INFINITY; if (bi == e0 + 2) v2 = -INFINITY; if (bi == e0 + 3) v3 = -INFINITY;
            }
            ++rb;
            if (rb == 8 || m + c.ngw >= NTOK) {
                const int rr = c.lane >> 3, k = c.lane & 7;
                const float tot = grp8_sum(my_s);
                if (rr < rb) { const int id = (mb + rr * c.ngw) * TOPK + k;
                    const unsigned pos = atomicAdd(&CNT[(size_t)my_e * CNT_STRIDE], 1u);
                    LIST[(size_t)my_e * LCAP + pos] = id; POSREC[id] = (my_e << 16) | (int)pos; WTS[id] = my_s / tot * 2.5f; }
                rb = 0; mb = m + c.ngw;
            }
        }
    }
    SEAM(8);

    LAS int* pre = (LAS int*)(ldsb + pg8::STAGE_BYTES);
    LAS int* offs = pre + 320; LAS int* cntl = offs + 320;
    if (IN(9) || IN(10) || IN(11)) {
        const Ctx c = mkctx(ws, lds_raw); PHASE_PTRS
        __syncthreads();
        if (c.tid < NE) cntl[c.tid] = (int)CNT[(size_t)c.tid * CNT_STRIDE];
        __syncthreads();
        if (c.tid <= NE) { int a = 0, o = 0; for (int j = 0; j < c.tid; ++j) { const int q = cntl[j]; a += (q + 255) >> 8; o += q; } pre[c.tid] = a; offs[c.tid] = o; }
        __syncthreads();
    }
    if (IN(9)) for (int rep_ = 0; rep_ < (((REPEAT_MASK >> 9) & 1) ? 2 : 1); ++rep_) {
        const Ctx c = mkctx(ws, lds_raw); PHASE_PTRS
        pg8::MoeOrder S{pre, offs, cntl, LIST, (const char*)WGUT, (size_t)512 * DM * 2, DM, 2, c.nb, vcu, 0};
        pg8::EpiAct E{ACT};
        pg8::gemm_phase<pg8::EpiAct, pg8::MoeOrder, true, true>(ldsb, H2, DM, S, E);
    }
    SEAM(9);

    if (IN(10)) for (int rep_ = 0; rep_ < (((REPEAT_MASK >> 10) & 1) ? 2 : 1); ++rep_) {
        const Ctx c = mkctx(ws, lds_raw); PHASE_PTRS
        { pg8::MoeOrder S{pre, offs, cntl, LIST, (const char*)WDT, (size_t)DM * EFF * 2, EFF, 4, c.nb, vcu, 1};
          pg8::EpiSlots E{(unsigned char*)SLOTS};
          pg8::gemm_phase<pg8::EpiSlots, pg8::MoeOrder, true>(ldsb, ACT, EFF, S, E); }
        { pg8::DenseOrder S; S.init(NTOK, DM, EFF, WDST, c.nb, c.bid); pg8::EpiBf16 E{YSH, DM};
          pg8::gemm_phase<pg8::EpiBf16, pg8::DenseOrder, true>(ldsb, ACTS, EFF, S, E); }
    }
    SEAM(10);

    if (IN(11)) for (int rep_ = 0; rep_ < (((REPEAT_MASK >> 11) & 1) ? 2 : 1); ++rep_) {
        const Ctx c = mkctx(ws, lds_raw); PHASE_PTRS
        const unsigned char* SL8 = (const unsigned char*)SLOTS;
        typedef float f32x2v __attribute__((ext_vector_type(2)));
        for (int m0 = c.gw; m0 < NTOK; m0 += 2 * c.ngw) {
            int srow[2][TOPK]; float swt[2][TOPK];
#pragma unroll
            for (int q = 0; q < 2; ++q)
#pragma unroll
                for (int k = 0; k < TOPK; ++k) { const int m = m0 + q * c.ngw; const int rec = POSREC[(size_t)m * TOPK + k]; srow[q][k] = offs[rec >> 16] + (rec & 0xffff); swt[q][k] = WTS[(size_t)m * TOPK + k] * (1.f / 16.f); }
#pragma unroll
            for (int q = 0; q < 2; ++q) {
                const int m = m0 + q * c.ngw; const int b = m / SEQ; const float* md = mod + b * 6144;
                const int cc = 16 * c.lane;
                float y[16]; float ss = 0.f;
#pragma unroll
                for (int hq = 0; hq < 2; ++hq) { const uint4 u = *(const uint4*)&YSH[(size_t)m * DM + cc + 8 * hq];
                    y[8 * hq + 0] = bf2f(u.x & 0xffffu); y[8 * hq + 1] = bf2f(u.x >> 16); y[8 * hq + 2] = bf2f(u.y & 0xffffu); y[8 * hq + 3] = bf2f(u.y >> 16);
                    y[8 * hq + 4] = bf2f(u.z & 0xffffu); y[8 * hq + 5] = bf2f(u.z >> 16); y[8 * hq + 6] = bf2f(u.w & 0xffffu); y[8 * hq + 7] = bf2f(u.w >> 16); }
#pragma unroll
                for (int k = 0; k < TOPK; ++k) { const uint4 u = *(const uint4*)&SL8[(size_t)srow[q][k] * DM + cc]; const float wk = swt[q][k];
                    const unsigned wds[4] = {u.x, u.y, u.z, u.w};
#pragma unroll
                    for (int d = 0; d < 4; ++d) { const f32x2v a = __builtin_amdgcn_cvt_pk_f32_fp8((int)wds[d], false), bb = __builtin_amdgcn_cvt_pk_f32_fp8((int)wds[d], true);
                        y[4 * d] += wk * a.x; y[4 * d + 1] += wk * a.y; y[4 * d + 2] += wk * bb.x; y[4 * d + 3] += wk * bb.y; } }
#pragma unroll
                for (int i = 0; i < 16; ++i) ss += y[i] * y[i];
                const float rstd = rsqrtf(wave_sum(ss) * (1.f / DM) + EPS);
#pragma unroll
                for (int hq = 0; hq < 4; ++hq) {
                    const int c4 = cc + 4 * hq;
                    const float4 g = *(const float4*)&g_post_ffn[c4], gt = *(const float4*)&md[5120 + c4]; const uint2 xu = *(const uint2*)&X1[(size_t)m * DM + c4];
                    float4 xx; xx.x = bf2f(xu.x & 0xffffu); xx.y = bf2f(xu.x >> 16); xx.z = bf2f(xu.y & 0xffffu); xx.w = bf2f(xu.y >> 16);
                    float4 r; r.x = xx.x + gt.x * (y[4 * hq] * rstd * g.x); r.y = xx.y + gt.y * (y[4 * hq + 1] * rstd * g.y);
                    r.z = xx.z + gt.z * (y[4 * hq + 2] * rstd * g.z); r.w = xx.w + gt.w * (y[4 * hq + 3] * rstd * g.w);
                    *(float4*)&args.out[(size_t)m * DM + c4] = r;
                }
            }
        }
    }
    }
#undef IN
#undef SEAM
}

constexpr int NPHASE = 12;

extern "C" void kernel_launch(void* const* d_in, const int* in_sizes, int n_in, void* d_out, int out_size, void* d_ws, size_t ws_size, hipStream_t stream) {
    static int grid = 0;
    if (grid == 0) {
        if (n_in != 26 || out_size != NTOK * DM || ws_size < WS_END) { fprintf(stderr, "kernel_launch: unexpected shapes (n_in %d, out %d, ws %zu)\n", n_in, out_size, ws_size); grid = -1; return; }
        int dev = 0, cus = 0, per_cu = 0;
        if (hipGetDevice(&dev) != hipSuccess || hipDeviceGetAttribute(&cus, hipDeviceAttributeMultiprocessorCount, dev) != hipSuccess) { grid = -1; return; }
        if (hipFuncSetAttribute((const void*)mega, hipFuncAttributeMaxDynamicSharedMemorySize, LDS_BYTES) != hipSuccess) { fprintf(stderr, "kernel_launch: hipFuncSetAttribute failed\n"); grid = -1; return; }
        if (hipOccupancyMaxActiveBlocksPerMultiprocessor(&per_cu, (const void*)mega, NTHR, LDS_BYTES) != hipSuccess || per_cu < 1) fprintf(stderr, "kernel_launch: occupancy query says %d\n", per_cu);
        (void)hipGetLastError();
        grid = cus;
    }
    if (grid < 0) return;
    (void)hipMemsetAsync((char*)d_ws + WS_CTL, 0, CTL_ZERO_BYTES, stream);
    Args a{};
    for (int i = 0; i < 26; ++i) a.in[i] = (const float*)d_in[i];
    a.out = (float*)d_out; a.ws = (unsigned char*)d_ws;
    if (MK_N_LAUNCHES == 1) { a.ph_lo = 0; a.ph_hi = NPHASE; hipLaunchKernelGGL(mega, dim3(grid), dim3(NTHR), LDS_BYTES, stream, a); }
    else for (int p = 0; p < NPHASE; ++p) { a.ph_lo = p; a.ph_hi = p + 1; hipLaunchKernelGGL(mega, dim3(grid), dim3(NTHR), LDS_BYTES, stream, a); }
}
```

```cpp
#include <hip/hip_runtime.h>
#include <cstdio>
#include <cstdint>

#ifndef REP_FROM
#define REP_FROM 99
#endif
#ifndef REPEAT_MASK
#define REPEAT_MASK 0
#endif
#ifndef CONV_MODE
#define CONV_MODE 5
#endif
#ifndef MK_N_LAUNCHES
#define MK_N_LAUNCHES 1
#endif

#ifndef ATTN_NAIVE
#define ATTN_NAIVE 0
#endif
#define LAS __attribute__((address_space(3)))
typedef unsigned short bf16_t;

constexpr int NB = 2, SEQ = 8192, NTOK = NB * SEQ, DM = 1024;
constexpr int QLORA = 256, KVLORA = 128, MROPE = 32, MNOPE = 64, MV = 64, MH = 8, DQKM = 96;
constexpr int GH = 8, GKV = 2, GD = 64;
constexpr int INC = 1184;
constexpr int C_QLAT = 0, C_KVLAT = 256, C_KROPE = 384, C_GQ = 416, C_GK = 928, C_GV = 1056;
constexpr int NE = 256, TOPK = 8, EFF = 256;
constexpr int LCAP = 16384;
constexpr float EPS = 1e-6f;
constexpr float LOG2E = 1.4426950408889634f;
constexpr float C2M = 0.10206207261596575f * LOG2E;
constexpr float C2G = 0.125f * LOG2E;

constexpr size_t MiB = 1u << 20;
constexpr size_t WS_CTL = 0, CTL_ZERO_BYTES = 32768;
constexpr size_t WS_MOD = 1 * MiB;
constexpr size_t WS_COSM = 2 * MiB, WS_SINM = 2 * MiB + 512 * 1024, WS_COSG = 3 * MiB, WS_SING = 4 * MiB;
constexpr size_t WS_WQBT = 5 * MiB;
constexpr size_t WS_WINQ = 5 * MiB + 512 * 1024;
constexpr size_t WS_WKVBT = 6 * MiB;
constexpr size_t WS_WINKV = 6 * MiB + 512 * 1024;
constexpr size_t WS_WDST = 7 * MiB;
constexpr size_t WS_H2 = 8 * MiB;
constexpr size_t WS_X1 = 40 * MiB;
constexpr size_t WS_CNTS = 72 * MiB;
constexpr int CNT_STRIDE = 1088;
constexpr size_t WS_WTS = 104 * MiB;
constexpr size_t WS_OSTAT = 252 * MiB;
constexpr size_t WS_POSREC = 105 * MiB;
constexpr size_t WS_LIST = 106 * MiB;
constexpr size_t WS_WBIGT = 122 * MiB;
constexpr size_t WS_WOUTT = 128 * MiB;
constexpr size_t WS_WRST = 130 * MiB;
constexpr size_t WS_ACT = 132 * MiB;
constexpr size_t WS_LOG = 196 * MiB;
constexpr size_t WS_ACTS = 212 * MiB;
constexpr size_t WS_YSH = 220 * MiB;
constexpr size_t WS_SLOTS = 256 * MiB;
constexpr size_t WS_PBUF = 256 * MiB;
constexpr size_t WS_QM = 352 * MiB, WS_KM = 376 * MiB, WS_VM = 400 * MiB, WS_QG = 416 * MiB, WS_KG = 432 * MiB, WS_VG = 436 * MiB;
constexpr size_t WS_O = 440 * MiB;
constexpr size_t WS_MIXED = 472 * MiB;
constexpr size_t WS_WGUT = 512 * MiB;
constexpr size_t WS_WDT = 768 * MiB;
constexpr size_t WS_END = 896 * MiB;
constexpr size_t WS_HF = 512 * MiB, WS_PROJ = 576 * MiB, WS_H2F = 650 * MiB, WS_GS = 714 * MiB, WS_US = 730 * MiB, WS_ACTSF = 746 * MiB, WS_YSHF = 768 * MiB, WS_LOGF = 832 * MiB;
constexpr int CW_CNT = 1024;
constexpr int CW_KMAX = 2048;
constexpr int CW_BAR = 4096;

constexpr int LDS_BYTES = 147456;
constexpr int NTHR = 512, NWAVES = 8;

#define XB_TMO      128
#define XB_XCNT(j)  (256  + 64 * (j))
#define XB_XSUB(j)  (1280 + 64 * (j))
#define XB_XGEN(j)  (2304 + 64 * (j))
#define XB_TOP      3328
#define XB_TOPGEN   3392
#define XCD_BAR_WORDS 3456
#define XB_SPIN_CAP (1u << 18)
__device__ __forceinline__ unsigned xb_ld(unsigned* p)              { return __hip_atomic_load(p, __ATOMIC_RELAXED, __HIP_MEMORY_SCOPE_AGENT); }
__device__ __forceinline__ unsigned xb_add(unsigned* p, unsigned v) { return __hip_atomic_fetch_add(p, v, __ATOMIC_RELAXED, __HIP_MEMORY_SCOPE_AGENT); }
__device__ __forceinline__ unsigned xb_xcc_id() { return (unsigned)__builtin_amdgcn_s_getreg((3 << 11) | 20) & 0xFu; }
#define XB_SPIN(cond, bar) do { unsigned _sp = 0; while (cond) { __builtin_amdgcn_s_sleep(1); \
    if ((++_sp & 255u) == 0u) { if (xb_ld(&(bar)[XB_TMO])) break; if (_sp > XB_SPIN_CAP) { atomicAdd(&(bar)[XB_TMO], 1u); break; } } } } while (0)
struct XcdBarrier { unsigned* bar; unsigned x; volatile LAS unsigned* st; };
__device__ __forceinline__ XcdBarrier xcd_barrier_post(unsigned* bar, volatile LAS unsigned* st) {
    XcdBarrier b; b.bar = bar; b.x = xb_xcc_id(); b.st = st;
    if (threadIdx.x == 0) (void)xb_add(&bar[XB_XCNT(b.x)], 1u);
    return b;
}
__device__ __forceinline__ void xcd_barrier_complete(unsigned* bar, unsigned x, unsigned& nloc, unsigned& nx) {
    const unsigned G = gridDim.x * gridDim.y * gridDim.z;
    unsigned sum, cnt, mine, sp = 0u;
    for (;;) {
        sum = 0u; cnt = 0u; mine = 0u;
#pragma unroll
        for (unsigned j = 0; j < 16; ++j) { const unsigned c = xb_ld(&bar[XB_XCNT(j)]); sum += c; cnt += (c > 0u) ? 1u : 0u; mine = (j == x) ? c : mine; }
        if (sum == G) break;
        __builtin_amdgcn_s_sleep(1);
        if ((++sp & 255u) == 0u) { if (xb_ld(&bar[XB_TMO])) break; if (sp > XB_SPIN_CAP) { atomicAdd(&bar[XB_TMO], 1u); break; } }
    }
    nloc = mine > 0u ? mine : 1u; nx = cnt > 0u ? cnt : 1u;
}
__device__ __forceinline__ void xcd_barrier(const XcdBarrier& b) {
    asm volatile("s_waitcnt vmcnt(0)" ::: "memory");
    __syncthreads();
    if (threadIdx.x == 0) {
        unsigned* bar = b.bar;
        __builtin_amdgcn_s_waitcnt(0);
        unsigned nloc = b.st[0], nx = b.st[1];
        if (nloc == 0u) { xcd_barrier_complete(bar, b.x, nloc, nx); b.st[0] = nloc; b.st[1] = nx; }
        const unsigned old = xb_add(&bar[XB_XSUB(b.x)], 1u);
        const unsigned gen = old / nloc;
        if (old + 1u == (gen + 1u) * nloc) {
            __builtin_amdgcn_fence(__ATOMIC_RELEASE, "agent");
            asm volatile("s_waitcnt vmcnt(0)" ::: "memory");
            const unsigned og = xb_add(&bar[XB_TOP], 1u);
            const unsigned tg = og / nx;
            if (og + 1u == (tg + 1u) * nx) xb_add(&bar[XB_TOPGEN], 1u);
            else XB_SPIN(xb_ld(&bar[XB_TOPGEN]) == tg, bar);
            __builtin_amdgcn_fence(__ATOMIC_ACQUIRE, "agent");
            xb_add(&bar[XB_XGEN(b.x)], 1u);
            asm volatile("s_waitcnt vmcnt(0)" ::: "memory");
        } else {
            XB_SPIN(xb_ld(&bar[XB_XGEN(b.x)]) == gen, bar);
            __builtin_amdgcn_fence(__ATOMIC_ACQUIRE, "agent");
            asm volatile("s_waitcnt vmcnt(0)" ::: "memory");
        }
    }
    __syncthreads();
}

__device__ __forceinline__ unsigned f2bf(float f) { unsigned u = __builtin_bit_cast(unsigned, f); return (u + 0x7fffu + ((u >> 16) & 1u)) >> 16; }
__device__ __forceinline__ float bf2f(unsigned h) { return __builtin_bit_cast(float, h << 16); }
__device__ __forceinline__ unsigned pk2(float lo, float hi) { return f2bf(lo) | (f2bf(hi) << 16); }
template <int CTRL, int RM> __device__ __forceinline__ float dppmov(float old, float v) {
    return __builtin_bit_cast(float, __builtin_amdgcn_update_dpp(__builtin_bit_cast(int, old), __builtin_bit_cast(int, v), CTRL, RM, 0xF, false)); }
__device__ __forceinline__ float wave_sum(float v) {
    v += dppmov<0xB1, 0xF>(0.f, v);
    v += dppmov<0x4E, 0xF>(0.f, v);
    v += dppmov<0x141, 0xF>(0.f, v);
    v += dppmov<0x140, 0xF>(0.f, v);
    v += dppmov<0x142, 0xA>(0.f, v);
    v += dppmov<0x143, 0xC>(0.f, v);
    return __builtin_bit_cast(float, __builtin_amdgcn_readlane(__builtin_bit_cast(int, v), 63));
}
__device__ __forceinline__ float wave_max(float v) {
    const float NI = -INFINITY;
    v = fmaxf(v, dppmov<0xB1, 0xF>(NI, v)); v = fmaxf(v, dppmov<0x4E, 0xF>(NI, v)); v = fmaxf(v, dppmov<0x141, 0xF>(NI, v)); v = fmaxf(v, dppmov<0x140, 0xF>(NI, v));
    v = fmaxf(v, dppmov<0x142, 0xA>(NI, v)); v = fmaxf(v, dppmov<0x143, 0xC>(NI, v));
    return __builtin_bit_cast(float, __builtin_amdgcn_readlane(__builtin_bit_cast(int, v), 63));
}
template <int CTRL, int RM> __device__ __forceinline__ int dppmovi(int old, int v) { return __builtin_amdgcn_update_dpp(old, v, CTRL, RM, 0xF, false); }
__device__ __forceinline__ int imax_(int a, int b) { return a > b ? a : b; }
__device__ __forceinline__ int imin_(int a, int b) { return a < b ? a : b; }
__device__ __forceinline__ int wave_max_i(int v) {
    const int NI = (int)0x80000000;
    v = imax_(v, dppmovi<0xB1, 0xF>(NI, v)); v = imax_(v, dppmovi<0x4E, 0xF>(NI, v)); v = imax_(v, dppmovi<0x141, 0xF>(NI, v)); v = imax_(v, dppmovi<0x140, 0xF>(NI, v));
    v = imax_(v, dppmovi<0x142, 0xA>(NI, v)); v = imax_(v, dppmovi<0x143, 0xC>(NI, v));
    return __builtin_amdgcn_readlane(v, 63);
}
__device__ __forceinline__ int grp8_max_i(int v) {
    const int NI = (int)0x80000000;
    v = imax_(v, dppmovi<0xB1, 0xF>(NI, v)); v = imax_(v, dppmovi<0x4E, 0xF>(NI, v)); v = imax_(v, dppmovi<0x141, 0xF>(NI, v)); return v;
}
__device__ __forceinline__ int ford(float f) { const int b = __builtin_bit_cast(int, f); return b ^ ((b >> 31) & 0x7fffffff); }
__device__ __forceinline__ float funord(int k) { return __builtin_bit_cast(float, k ^ ((k >> 31) & 0x7fffffff)); }
__device__ __forceinline__ float grp8_sum(float v) {
    v += dppmov<0xB1, 0xF>(0.f, v); v += dppmov<0x4E, 0xF>(0.f, v); v += dppmov<0x141, 0xF>(0.f, v); return v;
}
__device__ __forceinline__ float grp8_max(float v) {
    const float NI = -INFINITY;
    v = fmaxf(v, dppmov<0xB1, 0xF>(NI, v)); v = fmaxf(v, dppmov<0x4E, 0xF>(NI, v)); v = fmaxf(v, dppmov<0x141, 0xF>(NI, v)); return v;
}
__device__ __forceinline__ float sigmoidf_(float x) { return 1.f / (1.f + __expf(-x)); }

struct Args { const float* in[26]; float* out; unsigned char* ws; int ph_lo, ph_hi; };

struct Ctx {
    int tid, lane, wave, bid, nb, gw, ngw;
    unsigned char* ws; float* lds;
};
__device__ __forceinline__ Ctx mkctx(unsigned char* ws, unsigned char* lds_raw) {
    Ctx c; int t = threadIdx.x; asm volatile("" : "+v"(t));
    c.tid = t; c.lane = t & 63; c.wave = __builtin_amdgcn_readfirstlane(t >> 6);
    c.bid = blockIdx.x; c.nb = gridDim.x; c.gw = c.bid * NWAVES + c.wave; c.ngw = c.nb * NWAVES; c.ws = ws; c.lds = (float*)lds_raw; return c;
}

namespace att {
using bf16x8 = __attribute__((ext_vector_type(8))) short;
using s16x4 = __attribute__((ext_vector_type(4))) short;
using f32x16 = __attribute__((ext_vector_type(16))) float;
using u32x4 = __attribute__((ext_vector_type(4))) unsigned;
typedef float f32x2_t __attribute__((ext_vector_type(2))); typedef __bf16 bf16x2_t __attribute__((ext_vector_type(2)));
typedef __attribute__((address_space(3))) const char* lds_cptr;
typedef short v4i16_t __attribute__((ext_vector_type(4)));
constexpr int NT = SEQ / 64;
constexpr int KSLOT = 12288, VSLOT = 8192, NSLOT = 3;
constexpr int LDS_K = 0, LDS_V = NSLOT * KSLOT, LDS_WS = LDS_V + NSLOT * VSLOT, LDS_OST = LDS_WS + NWAVES * 256, LDS_ATT = LDS_OST + NWAVES * 4096;
#define SBAR() __builtin_amdgcn_sched_barrier(0)
#define MFMA(a, b, c) __builtin_amdgcn_mfma_f32_32x32x16_bf16(a, b, c, 0, 0, 0)
__device__ __forceinline__ int crow(int r, int hi) { return (r & 3) + 8 * (r >> 2) + 4 * hi; }
__device__ __forceinline__ unsigned cvtpk_s(float lo, float hi) { f32x2_t v = {lo, hi}; bf16x2_t b = __builtin_convertvector(v, bf16x2_t); return __builtin_bit_cast(unsigned, b); }
__device__ __forceinline__ void glds16(const void* g, unsigned lds_base) {
    unsigned sv; asm volatile("s_mov_b32 %0, m0\n\ts_mov_b32 m0, %2\n\ts_nop 0\n\tglobal_load_lds_dwordx4 %1, off\n\ts_mov_b32 m0, %0" : "=&s"(sv) : "v"(g), "s"(lds_base) : "memory"); }
__device__ __forceinline__ s16x4 vtr(lds_cptr p) { return __builtin_bit_cast(s16x4, __builtin_amdgcn_ds_read_tr16_b64_v4i16((__attribute__((address_space(3))) v4i16_t*)p)); }
#define MX3(a, b, c) __builtin_fmaxf(__builtin_fmaxf((a), (b)), (c))
__device__ __forceinline__ float rowmax(const f32x16& p0, const f32x16& p1) {
    float a = MX3(p0[0], p0[1], p1[0]), b = MX3(p0[2], p0[3], p1[1]); a = MX3(a, p1[2], p1[3]);
#pragma unroll
    for (int r = 4; r < 16; r += 4) { a = MX3(a, p0[r], p0[r + 1]); b = MX3(b, p0[r + 2], p0[r + 3]); a = MX3(a, p1[r], p1[r + 1]); b = MX3(b, p1[r + 2], p1[r + 3]); }
    float m = __builtin_fmaxf(a, b); auto rr = __builtin_amdgcn_permlane32_swap(__float_as_uint(m), __float_as_uint(m), false, false);
    return __builtin_fmaxf(__uint_as_float(rr[0]), __uint_as_float(rr[1])); }

template <int DQK>
__device__ __forceinline__ void unit_simple(const bf16_t* Qh, const bf16_t* __restrict__ Kh, const bf16_t* __restrict__ Vh, bf16_t* Ob, int q0, char* shm) {
    constexpr int NCH = DQK / 8, ND0 = DQK / 16;
    int tid_ = threadIdx.x; asm volatile("" : "+v"(tid_));
    const int tid = tid_, lane = tid & 63, r32 = lane & 31, hi = lane >> 5; const int wid = __builtin_amdgcn_readfirstlane(tid >> 6);
    const bf16_t* Qw = Qh + (size_t)(q0 + wid * 32) * DQK;
    const unsigned lds0 = (unsigned)(uintptr_t)shm; float* wsf = (float*)(shm + LDS_WS) + wid * 64;
    const bf16_t* ksrc0 = Kh + (size_t)lane * DQK + wid * 8;
    const bf16_t* ksrc1 = Kh + (size_t)lane * DQK + (8 + (wid & 3)) * 8;
    const bf16_t* vsrc = Vh + (size_t)(16 * (wid & 3) + (lane >> 2)) * 64 + (wid >> 2) * 32 + (lane & 3) * 8;
    const unsigned kdst0 = lds0 + LDS_K + wid * 1024, kdst1 = lds0 + LDS_K + (8 + (wid & 3)) * 1024, vdst = lds0 + LDS_V + wid * 1024;
#define DMA_KV(t, sl) do { glds16(ksrc0 + (size_t)(t) * 64 * DQK, (unsigned)__builtin_amdgcn_readfirstlane(kdst0 + (sl) * KSLOT)); \
        if (NCH == 12 && wid < 4) glds16(ksrc1 + (size_t)(t) * 64 * DQK, (unsigned)__builtin_amdgcn_readfirstlane(kdst1 + (sl) * KSLOT)); \
        glds16(vsrc + (size_t)(t) * 64 * 64, (unsigned)__builtin_amdgcn_readfirstlane(vdst + (sl) * VSLOT)); } while (0)
    const lds_cptr shm3 = (lds_cptr)shm;
    const lds_cptr vp0 = shm3 + LDS_V + ((lane >> 4) & 1) * 32 + (lane & 3) * 8 + (4 * hi + ((lane & 15) >> 2)) * 64;
    const lds_cptr kp0 = shm3 + LDS_K + hi * 1024 + r32 * 16;
    DMA_KV(0, 0);
    bf16x8 qr[ND0];
#pragma unroll
    for (int d0 = 0; d0 < ND0; ++d0) qr[d0] = *reinterpret_cast<const bf16x8*>(&Qw[(size_t)r32 * DQK + d0 * 16 + hi * 8]);
    float mhat = -INFINITY, l_reg = 0.f; f32x16 o[2]; o[0] = f32x16{}; o[1] = f32x16{};
    asm volatile("s_waitcnt vmcnt(0) lgkmcnt(0)\n\ts_barrier" ::: "memory");
    for (int t = 0; t < NT; ++t) {
        const int sl = t & 1;
        if (t + 1 < NT) DMA_KV(t + 1, sl ^ 1);
        f32x16 p0 = f32x16{}, p1 = f32x16{};
        const lds_cptr kp = kp0 + sl * KSLOT;
#pragma unroll
        for (int d0 = 0; d0 < ND0; ++d0) {
            const bf16x8 b0 = *(const __attribute__((address_space(3))) bf16x8*)(kp + d0 * 2048);
            const bf16x8 b1 = *(const __attribute__((address_space(3))) bf16x8*)(kp + d0 * 2048 + 512);
            p0 = MFMA(b0, qr[d0], p0); p1 = MFMA(b1, qr[d0], p1);
        }
        const float rm = rowmax(p0, p1);
        const float mn = __builtin_fmaxf(mhat, rm), f = __builtin_amdgcn_exp2f(mhat - mn); mhat = mn;
        float sacc = 0.f;
#pragma unroll
        for (int r = 0; r < 16; ++r) { p0[r] = __builtin_amdgcn_exp2f(p0[r] - mn); p1[r] = __builtin_amdgcn_exp2f(p1[r] - mn); sacc += p0[r] + p1[r]; }
        l_reg = l_reg * f + sacc;
        if (hi == 0) wsf[r32] = f;
        asm volatile("s_waitcnt lgkmcnt(0)" ::: "memory");
#pragma unroll
        for (int d_ = 0; d_ < 2; ++d_)
#pragma unroll
            for (int r = 0; r < 16; ++r) o[d_][r] *= wsf[crow(r, hi)];
        u32x4 pw[4];
#pragma unroll
        for (int i = 0; i < 4; ++i) { pw[0][i] = cvtpk_s(p0[2 * i], p0[2 * i + 1]); pw[1][i] = cvtpk_s(p0[8 + 2 * i], p0[8 + 2 * i + 1]); pw[2][i] = cvtpk_s(p1[2 * i], p1[2 * i + 1]); pw[3][i] = cvtpk_s(p1[8 + 2 * i], p1[8 + 2 * i + 1]); }
        const lds_cptr vp_ = vp0 + sl * VSLOT;
#pragma unroll
        for (int d0 = 0; d0 < 2; ++d0)
#pragma unroll
            for (int ks = 0; ks < 4; ++ks) {
                const s16x4 lo = vtr(vp_ + d0 * 4096 + ks * 1024), hh = vtr(vp_ + d0 * 4096 + ks * 1024 + 512);
                const bf16x8 vf = (bf16x8){lo[0], lo[1], lo[2], lo[3], hh[0], hh[1], hh[2], hh[3]};
                o[d0] = MFMA(__builtin_bit_cast(bf16x8, pw[ks]), vf, o[d0]);
            }
        asm volatile("s_waitcnt vmcnt(0) lgkmcnt(0)\n\ts_barrier" ::: "memory");
    }
#undef DMA_KV
    { auto rr = __builtin_amdgcn_permlane32_swap(__float_as_uint(l_reg), __float_as_uint(l_reg), false, false); l_reg = __uint_as_float(rr[0]) + __uint_as_float(rr[1]); }
    if (hi == 0) wsf[32 + r32] = l_reg; asm volatile("s_waitcnt lgkmcnt(0)" ::: "memory");
    float rli[16];
#pragma unroll
    for (int r = 0; r < 16; ++r) rli[r] = __builtin_amdgcn_rcpf(wsf[32 + crow(r, hi)]);
    bf16_t* Ow = Ob + (size_t)(wid * 32) * DM; bf16_t* stg = (bf16_t*)(shm + LDS_OST) + wid * 2048;
#pragma unroll
    for (int r = 0; r < 16; ++r) { const int orow = crow(r, hi);
#pragma unroll
        for (int d0 = 0; d0 < 2; ++d0) stg[orow * 64 + d0 * 32 + r32] = (bf16_t)f2bf(o[d0][r] * rli[r]); }
    asm volatile("s_waitcnt lgkmcnt(0)" ::: "memory");
#pragma unroll
    for (int i = 0; i < 4; ++i) { const int row = i * 8 + (lane >> 3), ch = lane & 7; *(u32x4*)(Ow + (size_t)row * DM + ch * 8) = *(const u32x4*)(stg + row * 64 + ch * 8); }
    asm volatile("s_waitcnt vmcnt(0) lgkmcnt(0)\n\ts_barrier" ::: "memory");
}

constexpr int CONV_LDS = 112640;
struct ConvState { int cj, jbase; const char* wg; const char* wu; const char* wd; char* dgu; char* dd; unsigned ldsbuf; lds_cptr rdbuf; };
struct ConvJob { const char* sbase; char* dbase; unsigned ldwB, KdB; };
__device__ __forceinline__ ConvJob conv_job(const ConvState& cs, int j) {
    const int J = (CONV_MODE >= 5) ? j : cs.jbase + (j < 383 ? j : 383); const int m = J >> 10, r = J & 1023; ConvJob q;
    if (m < 2) { const int g = r >> 7, kg = r & 127; const int drow0 = ((g < 4) ? g * 32 : 256 + (g - 4) * 32) + m * 128;
        q.sbase = (m ? cs.wu : cs.wg) + (size_t)((8 * kg) * EFF + g * 32) * 4; q.ldwB = EFF * 4; q.dbase = cs.dgu + (size_t)(drow0 * DM + 8 * kg) * 2; q.KdB = DM * 2; }
    else { const int g = r >> 5, kg = r & 31;
        q.sbase = cs.wd + (size_t)((8 * kg) * DM + g * 32) * 4; q.ldwB = DM * 4; q.dbase = cs.dd + (size_t)((g * 32) * EFF + 8 * kg) * 2; q.KdB = EFF * 2; }
    return q;
}
__device__ __forceinline__ void glds16_s(const char* sbase, unsigned voff, unsigned lds_base) {
    unsigned sv; asm volatile("s_mov_b32 %0, m0\n\ts_mov_b32 m0, %3\n\ts_nop 4\n\tglobal_load_lds_dwordx4 %1, %2\n\ts_mov_b32 m0, %0" : "=&s"(sv) : "v"(voff), "s"(sbase), "s"(lds_base) : "memory"); }
#if CONV_MODE == 1 || CONV_MODE == 3 || CONV_MODE == 4 || CONV_MODE >= 5
#define CONV_DRAIN() do { const int jd_ = cs.cj - 3; const ConvJob q_ = conv_job(cs, jd_); \
        const __attribute__((address_space(3))) float* bp_ = (const __attribute__((address_space(3))) float*)(cs.rdbuf + (jd_ & 3) * 1024) + (lane >> 5) * 128 + (lane & 31); \
        uint2 w_; w_.x = cvtpk_s(bp_[0], bp_[32]); w_.y = cvtpk_s(bp_[64], bp_[96]); \
        if (CONV_MODE == 1) *(uint2*)(q_.dbase + (size_t)((unsigned)(lane & 31) * q_.KdB + (unsigned)(lane >> 5) * 8u)) = w_; \
        else if (CONV_MODE == 4) *(uint2*)(cs.dgu + 0x30000000ull + (size_t)((unsigned)(lane & 31) * 2048u + (unsigned)(lane >> 5) * 8u + (unsigned)(jd_ & 127) * 16u)) = w_; \
        else asm volatile("" :: "v"(w_)); } while (0)
#else
#define CONV_DRAIN() do { } while (0)
#endif
#if CONV_MODE >= 5
#undef CONV_DRAIN
#define CONV_NSTEP 384
#define CONV_DRAIN() do { if (CONV_MODE == 5 && rst && cs.cj >= 3 && cs.cj < CONV_NSTEP + 3) { const int jb_ = 8 * (cs.cj - 3) + 4 * (wid - 6); const ConvJob q_ = conv_job(cs, jb_); \
          \
        const __attribute__((address_space(3))) float* bp_ = (const __attribute__((address_space(3))) float*)(cs.rdbuf + (jb_ & 31) * 1024) + (lane >> 5) * 512 + (lane & 31); \
        float v_[16]; \
        _Pragma("unroll") for (int i_ = 0; i_ < 16; ++i_) v_[i_] = bp_[i_ * 32]; \
        char* dp_ = q_.dbase + (size_t)((unsigned)(lane & 31) * q_.KdB + (unsigned)(lane >> 5) * 32u); \
        _Pragma("unroll") for (int i_ = 0; i_ < 2; ++i_) { uint4 w_; w_.x = cvtpk_s(v_[8 * i_], v_[8 * i_ + 1]); w_.y = cvtpk_s(v_[8 * i_ + 2], v_[8 * i_ + 3]); \
            w_.z = cvtpk_s(v_[8 * i_ + 4], v_[8 * i_ + 5]); w_.w = cvtpk_s(v_[8 * i_ + 6], v_[8 * i_ + 7]); *(uint4*)(dp_ + 16 * i_) = w_; } } } while (0)
#define CONV_ISSUE() do { if (CONV_MODE != 6 && rcl && cs.cj < CONV_NSTEP) { const int jb_ = 8 * cs.cj + 4 * (wid - 4); const ConvJob q_ = conv_job(cs, jb_); \
        const unsigned vo_ = (unsigned)(lane >> 3) * q_.ldwB + (unsigned)(lane & 7) * 16u; const unsigned lb_ = (unsigned)__builtin_amdgcn_readfirstlane(cs.ldsbuf + (jb_ & 31) * 1024); \
        glds16_s(q_.sbase, vo_, lb_); glds16_s(q_.sbase + (size_t)8 * q_.ldwB, vo_, lb_ + 1024); glds16_s(q_.sbase + (size_t)16 * q_.ldwB, vo_, lb_ + 2048); glds16_s(q_.sbase + (size_t)24 * q_.ldwB, vo_, lb_ + 3072); } \
        ++cs.cj; } while (0)
#define WAIT_BARL() asm volatile("s_waitcnt lgkmcnt(0)\n\ts_barrier" ::: "memory")
#define RWAIT(N) do { if (rkv) { WAIT_BAR(N); } else if (rcl) { WAIT_BAR(8); } else { WAIT_BARL(); } } while (0)
#elif CONV_MODE != 0
#define CONV_ISSUE() do { const ConvJob q_ = conv_job(cs, cs.cj); \
        glds16_s(q_.sbase, (unsigned)(lane >> 3) * q_.ldwB + (unsigned)(lane & 7) * 16u, (unsigned)__builtin_amdgcn_readfirstlane(cs.ldsbuf + (cs.cj & 3) * 1024)); ++cs.cj; } while (0)
#define WB_P() WAIT_BAR(3)
#define WB_S() WAIT_BAR(4)
#define WB_E1() WAIT_BAR(3)
#define WB_E0() WAIT_BAR(1)
#define WB_PL() WAIT_BAR(4)
#define WB_SL() WAIT_BAR(5)
#else
#define CONV_ISSUE() do { } while (0)
#define WB_P() WAIT_BAR(2)
#define WB_S() WAIT_BAR(2)
#define WB_E1() WAIT_BAR(1)
#define WB_E0() WAIT_BAR(0)
#define WB_PL() WAIT_BAR(3)
#define WB_SL() WAIT_BAR(3)
#endif

constexpr int T_SLOTB = 8192, T_LDS_K = 0, T_LDS_V = 3 * T_SLOTB, T_LDS_WS = 6 * T_SLOTB, T_LDS_OST = T_LDS_WS + NWAVES * 256;
#define WAIT_BAR(N) asm volatile("s_waitcnt vmcnt(" #N ") lgkmcnt(0)\n\ts_barrier" ::: "memory")
__device__ __forceinline__ float max3f(float a, float b, float c) { float r; asm("v_max3_f32 %0, %1, %2, %3" : "=v"(r) : "v"(a), "v"(b), "v"(c)); return r; }
__device__ __forceinline__ float max2f(float a, float b) { float r; asm("v_max_f32_e32 %0, %1, %2" : "=v"(r) : "v"(a), "v"(b)); return r; }
__device__ __forceinline__ float fadd_s(float a, float b) { float r; asm("v_add_f32_e32 %0, %1, %2" : "=v"(r) : "v"(a), "v"(b)); return r; }
__device__ __forceinline__ float fsub_s(float a, float b) { float r; asm("v_sub_f32_e32 %0, %1, %2" : "=v"(r) : "v"(a), "v"(b)); return r; }
__device__ __forceinline__ float rowmax_asm(const f32x16& p0, const f32x16& p1) {
    float a = max3f(p0[0], p0[1], p1[0]), b = max3f(p0[2], p0[3], p1[1]); a = max3f(a, p1[2], p1[3]);
#pragma unroll
    for (int r = 4; r < 16; r += 4) { a = max3f(a, p0[r], p0[r + 1]); b = max3f(b, p0[r + 2], p0[r + 3]); a = max3f(a, p1[r], p1[r + 1]); b = max3f(b, p1[r + 2], p1[r + 3]); }
    const float m = max2f(a, b);
    auto rr = __builtin_amdgcn_permlane32_swap(__float_as_uint(m), __float_as_uint(m), false, false);
    return max2f(__uint_as_float(rr[0]), __uint_as_float(rr[1]));
}
__device__ __forceinline__ void kload8(bf16x8* kf, lds_cptr kp) {
    kf[0] = *(const __attribute__((address_space(3))) bf16x8*)(kp);        kf[1] = *(const __attribute__((address_space(3))) bf16x8*)(kp + 512);
    kf[2] = *(const __attribute__((address_space(3))) bf16x8*)(kp + 2048); kf[3] = *(const __attribute__((address_space(3))) bf16x8*)(kp + 2560);
    kf[4] = *(const __attribute__((address_space(3))) bf16x8*)(kp + 4096); kf[5] = *(const __attribute__((address_space(3))) bf16x8*)(kp + 4608);
    kf[6] = *(const __attribute__((address_space(3))) bf16x8*)(kp + 6144); kf[7] = *(const __attribute__((address_space(3))) bf16x8*)(kp + 6656);
}
__device__ __forceinline__ void kload2(bf16x8* kf, lds_cptr kp, int j) { kf[2 * j] = *(const __attribute__((address_space(3))) bf16x8*)(kp + j * 2048); kf[2 * j + 1] = *(const __attribute__((address_space(3))) bf16x8*)(kp + j * 2048 + 512); }

template <int THRL>
__device__ __forceinline__ void unit64(const bf16_t* Qh, const bf16_t* __restrict__ Kh, const bf16_t* __restrict__ Vh, bf16_t* Ob, float* ostat, int q0, char* shm, ConvState& cs, float mfix) {
    constexpr int DQ = 64;
    int tid_ = threadIdx.x; asm volatile("" : "+v"(tid_));
    const int tid = tid_, lane = tid & 63, r32 = lane & 31, hi = lane >> 5; const int wid = __builtin_amdgcn_readfirstlane(tid >> 6);
    const bf16_t* Qw = Qh + (size_t)(q0 + wid * 32) * DQ;
    const unsigned lds0 = (unsigned)(uintptr_t)shm;
    float* wsf = (float*)(shm + T_LDS_WS) + wid * 64;
#if CONV_MODE >= 5
    const bool rkv = wid < 4, rcl = (wid == 4 || wid == 5), rst = wid >= 6; const int pw = wid & 3;
    const bf16_t* ksrc = Kh + (size_t)lane * DQ + pw * 8;
    const bf16_t* vsrc = Vh + (size_t)(16 * pw + (lane >> 2)) * 64 + (lane & 3) * 8;
    const unsigned kdst = lds0 + T_LDS_K + pw * 1024, vdst = lds0 + T_LDS_V + pw * 1024;
#define DMA_K(t, slot) do { if (rkv) { glds16(ksrc + (size_t)(t) * 64 * DQ, (unsigned)__builtin_amdgcn_readfirstlane(kdst + (slot))); \
        glds16(ksrc + 32 + (size_t)(t) * 64 * DQ, (unsigned)__builtin_amdgcn_readfirstlane(kdst + 4096 + (slot))); } } while (0)
#define DMA_V(t, slot) do { if (rkv) { glds16(vsrc + (size_t)(t) * 64 * 64, (unsigned)__builtin_amdgcn_readfirstlane(vdst + (slot))); \
        glds16(vsrc + 32 + (size_t)(t) * 64 * 64, (unsigned)__builtin_amdgcn_readfirstlane(vdst + 4096 + (slot))); } } while (0)
#define WB_P() RWAIT(4)
#define WB_S() RWAIT(4)
#define WB_E1() RWAIT(2)
#define WB_E0() RWAIT(0)
#else
    const bf16_t* ksrc = Kh + (size_t)lane * DQ + wid * 8;
    const bf16_t* vsrc = Vh + (size_t)(16 * (wid & 3) + (lane >> 2)) * 64 + (wid >> 2) * 32 + (lane & 3) * 8;
    const unsigned kdst = lds0 + T_LDS_K + wid * 1024, vdst = lds0 + T_LDS_V + wid * 1024;
#define DMA_K(t, slot) glds16(ksrc + (size_t)(t) * 64 * DQ, (unsigned)__builtin_amdgcn_readfirstlane(kdst + (slot)))
#define DMA_V(t, slot) glds16(vsrc + (size_t)(t) * 64 * 64, (unsigned)__builtin_amdgcn_readfirstlane(vdst + (slot)))
#endif
    const int vb0 = (int)(lds0 + T_LDS_V) + ((lane >> 4) & 1) * 32 + (lane & 3) * 8 + (4 * hi + ((lane & 15) >> 2)) * 64;
    bf16x8 kf[8];
    const lds_cptr shm3 = (lds_cptr)shm; const lds_cptr kp0 = shm3 + T_LDS_K + hi * 1024 + r32 * 16;
    const lds_cptr vp0 = shm3 + T_LDS_V + ((lane >> 4) & 1) * 32 + (lane & 3) * 8 + (4 * hi + ((lane & 15) >> 2)) * 64;
    DMA_K(0, 0); DMA_V(0, 0); DMA_K(1, T_SLOTB);
    bf16x8 qr[4];
#pragma unroll
    for (int d0 = 0; d0 < 4; ++d0) qr[d0] = *reinterpret_cast<const bf16x8*>(&Qw[(size_t)r32 * DQ + d0 * 16 + hi * 8]);
    float mfo = mfix; asm volatile("" : "+v"(mfo));
    float mhat = mfo, l_reg = 0.f; f32x16 o[2]; o[0] = f32x16{}; o[1] = f32x16{}; f32x16 negm;
#pragma unroll
    for (int r = 0; r < 16; ++r) negm[r] = -mfo;
    asm volatile("" : "+v"(negm));
    bool resc = false;
#define START(P0, P1) do { resc = false; _Pragma("unroll") for (int r = 0; r < 16; ++r) P0[r] = __builtin_amdgcn_exp2f(P0[r]); } while (0)
#define RESC() do { if (resc) { asm volatile("s_waitcnt lgkmcnt(0)" ::: "memory"); \
      _Pragma("unroll") for (int d_ = 0; d_ < 2; ++d_) _Pragma("unroll") for (int r = 0; r < 16; ++r) o[d_][r] *= wsf[crow(r, hi)]; } } while (0)
    f32x16 pA0, pA1, pB0, pB1;
    int sl_prev = 0, sl_cur = 0, sl_next = T_SLOTB;
#define ROT() do { sl_prev = sl_cur; sl_cur = sl_next; sl_next = (sl_next == 2 * T_SLOTB) ? 0 : sl_next + T_SLOTB; } while (0)
    DMA_K(2, 2 * T_SLOTB);
#if CONV_MODE >= 5
    WAIT_BAR(0);
#else
    WAIT_BAR(3);
#endif
    CONV_DRAIN();
    {
        const lds_cptr kb = kp0;
#pragma unroll
        for (int d0 = 0; d0 < 4; ++d0) {
            const bf16x8 b0 = *(const __attribute__((address_space(3))) bf16x8*)(kb + d0 * 2048);
            const bf16x8 b1 = *(const __attribute__((address_space(3))) bf16x8*)(kb + d0 * 2048 + 512);
            if (d0 == 0) { pA0 = MFMA(b0, qr[0], negm); pA1 = MFMA(b1, qr[0], negm); }
            else { pA0 = MFMA(b0, qr[d0], pA0); pA1 = MFMA(b1, qr[d0], pA1); } }
    }
    asm volatile("s_nop 15\n\ts_nop 7" : "+v"(pA0), "+v"(pA1));
    START(pA0, pA1);
#pragma unroll
    for (int r = 0; r < 16; ++r) pA1[r] = __builtin_amdgcn_exp2f(pA1[r]);
    WAIT_BAR(0);
    DMA_K(3, 0); DMA_V(1, T_SLOTB); CONV_ISSUE();
    ROT();
    kload8(kf, kp0 + sl_cur);
    WB_P();
    s16x4 vlo[8], vhi[8]; u32x4 pw0, pw1, pw2, pw3;
#define PKW(P, B) cvtpk_s(P[B], P[B + 1])
#define PAF(k) __builtin_bit_cast(bf16x8, pw##k)
#define VFR(i) (bf16x8){vlo[i][0], vlo[i][1], vlo[i][2], vlo[i][3], vhi[i][0], vhi[i][1], vhi[i][2], vhi[i][3]}
#define PIN(x) asm volatile("" : "+v"(x))
#define GAPA(MF, A0, A1, A2, A3, W0, W1, PW) do { MF; sacc += A0; sacc += A1; sacc += A2; sacc += A3; PIN(sacc); W0; W1; PIN(PW); SBAR(); } while (0)
#define EX(v) __builtin_amdgcn_exp2f(v)
#define GAPB(MF, X, B) do { MF; X[B] = EX(X[B]); X[B + 1] = EX(X[B + 1]); X[B + 2] = EX(X[B + 2]); X[B + 3] = EX(X[B + 3]); PIN(X); SBAR(); } while (0)
#define VRD(i) do { vlo[i] = vtr(vp_ + (((i) >> 2) * 4096 + ((i) & 3) * 1024)); vhi[i] = vtr(vp_ + (((i) >> 2) * 4096 + ((i) & 3) * 1024 + 512)); } while (0)
#define KRD(G, j) do { if (G) { kload2(kf, kp0 + sl_next, j); SBAR(); } } while (0)
#define STEP(C0, C1, P0, P1, t, GK, GV, GL) do { SBAR(); CONV_DRAIN(); SBAR(); \
    const lds_cptr vp_ = vp0 + sl_prev; \
    VRD(0); SBAR(); float sacc = (P0[0] + P0[1]); \
    GAPA(C0 = MFMA(kf[0], qr[0], negm), P0[2], P0[3], P0[4], P0[5],     pw0[0] = PKW(P0, 0), pw0[1] = PKW(P0, 2), pw0); \
    VRD(4); SBAR(); GAPA(C1 = MFMA(kf[1], qr[0], negm), P0[6], P0[7], P0[8], P0[9],     pw0[2] = PKW(P0, 4), pw0[3] = PKW(P0, 6), pw0); \
    VRD(1); SBAR(); GAPA(C0 = MFMA(kf[2], qr[1], C0),   P0[10], P0[11], P0[12], P0[13], pw1[0] = PKW(P0, 8), pw1[1] = PKW(P0, 10), pw1); \
    VRD(5); SBAR(); GAPA(C1 = MFMA(kf[3], qr[1], C1),   P0[14], P0[15], P1[0], P1[1],   pw1[2] = PKW(P0, 12), pw1[3] = PKW(P0, 14), pw1); \
    VRD(2); SBAR(); GAPA(C0 = MFMA(kf[4], qr[2], C0),   P1[2], P1[3], P1[4], P1[5],     pw2[0] = PKW(P1, 0), pw2[1] = PKW(P1, 2), pw2); \
    VRD(6); SBAR(); GAPA(C1 = MFMA(kf[5], qr[2], C1),   P1[6], P1[7], P1[8], P1[9],     pw2[2] = PKW(P1, 4), pw2[3] = PKW(P1, 6), pw2); \
    VRD(3); SBAR(); GAPA(C0 = MFMA(kf[6], qr[3], C0),   P1[10], P1[11], P1[12], P1[13], pw3[0] = PKW(P1, 8), pw3[1] = PKW(P1, 10), pw3); \
    VRD(7); SBAR(); GAPA(C1 = MFMA(kf[7], qr[3], C1),   P1[14], P1[15], 0.f, 0.f,       pw3[2] = PKW(P1, 12), pw3[3] = PKW(P1, 14), pw3); \
    l_reg += sacc; \
    if (GK) { DMA_K((t) + 3, sl_cur); } if (GV) { DMA_V((t) + 1, sl_next); } CONV_ISSUE(); \
    SBAR(); \
    GAPB(o[0] = MFMA(PAF(0), VFR(0), o[0]), C0, 0); \
    GAPB(o[1] = MFMA(PAF(0), VFR(4), o[1]), C0, 4); \
    KRD(GL, 0); GAPB(o[0] = MFMA(PAF(1), VFR(1), o[0]), C0, 8); \
    KRD(GL, 1); GAPB(o[1] = MFMA(PAF(1), VFR(5), o[1]), C0, 12); \
    KRD(GL, 2); GAPB(o[0] = MFMA(PAF(2), VFR(2), o[0]), C1, 0); \
    KRD(GL, 3); GAPB(o[1] = MFMA(PAF(2), VFR(6), o[1]), C1, 4); \
    GAPB(o[0] = MFMA(PAF(3), VFR(3), o[0]), C1, 8); \
    GAPB(o[1] = MFMA(PAF(3), VFR(7), o[1]), C1, 12); \
    } while (0)
    int t = 1;
    for (; t + 5 < NT; t += 2) {
        STEP(pB0, pB1, pA0, pA1, t, true, true, true);     WB_S(); RESC(); ROT();
        STEP(pA0, pA1, pB0, pB1, t + 1, true, true, true); WB_S(); RESC(); ROT();
    }
#define ENDW(tt) do { if ((tt) + 3 < NT) { WB_S(); } else if ((tt) + 2 < NT) { WB_E1(); } else { WB_E0(); } } while (0)
    for (; t + 1 < NT; t += 2) {
        STEP(pB0, pB1, pA0, pA1, t, (t + 3 < NT), (t + 1 < NT), (t + 1 < NT));         ENDW(t);     RESC(); ROT();
        STEP(pA0, pA1, pB0, pB1, t + 1, (t + 4 < NT), (t + 2 < NT), (t + 2 < NT));     ENDW(t + 1); RESC(); ROT();
    }
    STEP(pB0, pB1, pA0, pA1, NT - 1, false, false, false); RESC();
    {
        float sacc = pB0[0] + pB0[1];
#pragma unroll
        for (int r = 2; r < 16; ++r) sacc += pB0[r];
#pragma unroll
        for (int r = 0; r < 16; ++r) sacc += pB1[r];
        l_reg += sacc;
        pw0 = (u32x4){PKW(pB0, 0), PKW(pB0, 2), PKW(pB0, 4), PKW(pB0, 6)}; pw1 = (u32x4){PKW(pB0, 8), PKW(pB0, 10), PKW(pB0, 12), PKW(pB0, 14)};
        pw2 = (u32x4){PKW(pB1, 0), PKW(pB1, 2), PKW(pB1, 4), PKW(pB1, 6)}; pw3 = (u32x4){PKW(pB1, 8), PKW(pB1, 10), PKW(pB1, 12), PKW(pB1, 14)};
        SBAR();
        const lds_cptr vp_ = vp0 + sl_cur;
#pragma unroll
        for (int i = 0; i < 8; ++i) VRD(i);
        o[0] = MFMA(PAF(0), VFR(0), o[0]); o[1] = MFMA(PAF(0), VFR(4), o[1]); o[0] = MFMA(PAF(1), VFR(1), o[0]); o[1] = MFMA(PAF(1), VFR(5), o[1]);
        o[0] = MFMA(PAF(2), VFR(2), o[0]); o[1] = MFMA(PAF(2), VFR(6), o[1]); o[0] = MFMA(PAF(3), VFR(3), o[0]); o[1] = MFMA(PAF(3), VFR(7), o[1]);
    }
#undef PKW
#undef PAF
#undef VFR
#undef PIN
#undef GAPA
#undef GAPB
#undef EX
#undef VRD
#undef KRD
#undef STEP
#undef ENDW
    { auto rr = __builtin_amdgcn_permlane32_swap(__float_as_uint(l_reg), __float_as_uint(l_reg), false, false); l_reg = __uint_as_float(rr[0]) + __uint_as_float(rr[1]); }
    if (hi == 0) wsf[32 + r32] = l_reg; asm volatile("s_waitcnt lgkmcnt(0)" ::: "memory");
    float rli[16];
#pragma unroll
    for (int r = 0; r < 16; ++r) rli[r] = __builtin_amdgcn_rcpf(wsf[32 + crow(r, hi)]);
    bf16_t* Ow = Ob + (size_t)(wid * 32) * DM; bf16_t* stg = (bf16_t*)(shm + T_LDS_OST) + wid * 2048;
#pragma unroll
    for (int r = 0; r < 16; ++r) { const int orow = crow(r, hi);
#pragma unroll
        for (int d0 = 0; d0 < 2; ++d0) stg[orow * 64 + d0 * 32 + r32] = (bf16_t)f2bf(o[d0][r] * rli[r]); }
    asm volatile("s_waitcnt lgkmcnt(0)" ::: "memory");
#pragma unroll
    for (int i = 0; i < 4; ++i) { const int row = i * 8 + (lane >> 3), ch = lane & 7; const u32x4 v = *(const u32x4*)(stg + row * 64 + ch * 8); *(u32x4*)(Ow + (size_t)row * DM + ch * 8) = v;
        float q = 0.f;
#pragma unroll
        for (int d = 0; d < 4; ++d) { const float a = bf2f(v[d] & 0xffffu), bq = bf2f(v[d] >> 16); q += a * a + bq * bq; }
        q += dppmov<0xB1, 0xF>(0.f, q); q += dppmov<0x4E, 0xF>(0.f, q); q += dppmov<0x141, 0xF>(0.f, q);
        if (ch == 0) ostat[(size_t)(wid * 32 + row) * 16] = q; }
    asm volatile("s_waitcnt vmcnt(0) lgkmcnt(0)\n\ts_barrier" ::: "memory");
#if CONV_MODE >= 5
#undef WB_P
#undef WB_S
#undef WB_E1
#undef WB_E0
#endif
#undef DMA_K
#undef DMA_V
#undef START
#undef RESC
#undef ROT
}
constexpr int M_KSLOT = 12288, M_LDS_K = 0, M_LDS_V = 3 * M_KSLOT, M_LDS_WS = M_LDS_V + 3 * T_SLOTB, M_LDS_Q = M_LDS_WS + NWAVES * 256, M_LDS_OST = 0  ;
#define WBAR2() do { if (lowv) { WB_PL(); } else { WB_P(); } } while (0)
#define WBARS() do { if (lowv) { WB_SL(); } else { WB_S(); } } while (0)
template <int THRL>
__device__ __forceinline__ void unit96(const bf16_t* Qh, const bf16_t* __restrict__ Kh, const bf16_t* __restrict__ Vh, bf16_t* Ob, float* ostat, int q0, char* shm, ConvState& cs, float kb2) {
    constexpr int DQ = 96;
    int tid_ = threadIdx.x; asm volatile("" : "+v"(tid_));
    const int tid = tid_, lane = tid & 63, r32 = lane & 31, hi = lane >> 5; const int wid = __builtin_amdgcn_readfirstlane(tid >> 6);
    const bf16_t* Qw = Qh + (size_t)(q0 + wid * 32) * DQ;
    const unsigned lds0 = (unsigned)(uintptr_t)shm;
    float* wsf = (float*)(shm + M_LDS_WS) + wid * 64;
#if CONV_MODE >= 5
    const bool rkv = wid < 4, rcl = (wid == 4 || wid == 5), rst = wid >= 6; const int pw = wid & 3;
    const bf16_t* ksrc = Kh + (size_t)lane * DQ + pw * 8;
    const bool lowv = false;
#else
    const bf16_t* ksrc = Kh + (size_t)lane * DQ + wid * 8;
    const bf16_t* ksrc1 = Kh + (size_t)lane * DQ + (8 + (wid & 3)) * 8;
    const bool lowv = wid < 4;
#endif
#if CONV_MODE >= 5
    const bf16_t* vsrc = Vh + (size_t)(16 * pw + (lane >> 2)) * 64 + (lane & 3) * 8;
    const unsigned kdst = lds0 + M_LDS_K + pw * 1024, vdst = lds0 + M_LDS_V + pw * 1024, qdst = lds0 + M_LDS_Q + wid * 6144;
#define DMA_K(t, slot) do { if (rkv) { glds16(ksrc + (size_t)(t) * 64 * DQ, (unsigned)__builtin_amdgcn_readfirstlane(kdst + (slot))); \
        glds16(ksrc + 32 + (size_t)(t) * 64 * DQ, (unsigned)__builtin_amdgcn_readfirstlane(kdst + 4096 + (slot))); \
        glds16(ksrc + 64 + (size_t)(t) * 64 * DQ, (unsigned)__builtin_amdgcn_readfirstlane(kdst + 8192 + (slot))); } } while (0)
#define DMA_V(t, slot) do { if (rkv) { glds16(vsrc + (size_t)(t) * 64 * 64, (unsigned)__builtin_amdgcn_readfirstlane(vdst + (slot))); \
        glds16(vsrc + 32 + (size_t)(t) * 64 * 64, (unsigned)__builtin_amdgcn_readfirstlane(vdst + 4096 + (slot))); } } while (0)
#undef WBAR2
#undef WBARS
#define WBAR2() RWAIT(5)
#define WBARS() RWAIT(5)
#define WB_E1() RWAIT(2)
#define WB_E0() RWAIT(0)
#else
    const bf16_t* vsrc = Vh + (size_t)(16 * (wid & 3) + (lane >> 2)) * 64 + (wid >> 2) * 32 + (lane & 3) * 8;
    const unsigned kdst = lds0 + M_LDS_K + wid * 1024, kdst1 = lds0 + M_LDS_K + (8 + (wid & 3)) * 1024, vdst = lds0 + M_LDS_V + wid * 1024, qdst = lds0 + M_LDS_Q + wid * 6144;
#define DMA_K(t, slot) do { glds16(ksrc + (size_t)(t) * 64 * DQ, (unsigned)__builtin_amdgcn_readfirstlane(kdst + (slot))); \
        if (lowv) glds16(ksrc1 + (size_t)(t) * 64 * DQ, (unsigned)__builtin_amdgcn_readfirstlane(kdst1 + (slot))); } while (0)
#define DMA_V(t, slot) glds16(vsrc + (size_t)(t) * 64 * 64, (unsigned)__builtin_amdgcn_readfirstlane(vdst + (slot)))
#endif
    const int vb0 = (int)(lds0 + M_LDS_V) + ((lane >> 4) & 1) * 32 + (lane & 3) * 8 + (4 * hi + ((lane & 15) >> 2)) * 64;
    bf16x8 kf[12];
    const lds_cptr shm3 = (lds_cptr)shm; const lds_cptr kp0 = shm3 + M_LDS_K + hi * 1024 + r32 * 16; const lds_cptr qp0 = shm3 + M_LDS_Q + wid * 6144 + lane * 16;
    const lds_cptr vp0 = shm3 + M_LDS_V + ((lane >> 4) & 1) * 32 + (lane & 3) * 8 + (4 * hi + ((lane & 15) >> 2)) * 64;
#pragma unroll
    for (int d0 = 0; d0 < 6; ++d0) glds16(Qw + (size_t)r32 * DQ + d0 * 16 + hi * 8, (unsigned)__builtin_amdgcn_readfirstlane(qdst + d0 * 1024));
    DMA_K(0, 0); DMA_V(0, 0); DMA_K(1, M_KSLOT);
#define QF(d0) (*(const __attribute__((address_space(3))) bf16x8*)(qp0 + (d0) * 1024))
    float mhat = 0.f, l_reg = 0.f; f32x16 o[2]; o[0] = f32x16{}; o[1] = f32x16{}; f32x16 negm = f32x16{}; asm volatile("" : "+v"(negm));
    bool resc = false;
#define START(P0, P1) do { resc = false; _Pragma("unroll") for (int r = 0; r < 16; ++r) P0[r] = __builtin_amdgcn_exp2f(P0[r]); } while (0)
#define RESC() do { if (resc) { asm volatile("s_waitcnt lgkmcnt(0)" ::: "memory"); \
      _Pragma("unroll") for (int d_ = 0; d_ < 2; ++d_) _Pragma("unroll") for (int r = 0; r < 16; ++r) o[d_][r] *= wsf[crow(r, hi)]; } } while (0)
    f32x16 pA0, pA1, pB0, pB1;
    int sl_prev = 0, sl_cur = 0, sl_next = M_KSLOT; int vs_prev = 0, vs_cur = 0, vs_next = T_SLOTB;
#define ROT() do { sl_prev = sl_cur; sl_cur = sl_next; sl_next = (sl_next == 2 * M_KSLOT) ? 0 : sl_next + M_KSLOT; vs_prev = vs_cur; vs_cur = vs_next; vs_next = (vs_next == 2 * T_SLOTB) ? 0 : vs_next + T_SLOTB; } while (0)
    DMA_K(2, 2 * M_KSLOT);
    WAIT_BAR(0);
    {
        float qn = 0.f;
#pragma unroll
        for (int d0 = 0; d0 < 6; ++d0) { const bf16x8 qf = QF(d0);
#pragma unroll
            for (int i = 0; i < 8; ++i) { const float x = bf2f((unsigned short)qf[i]); qn += x * x; } }
        auto rr = __builtin_amdgcn_permlane32_swap(__float_as_uint(qn), __float_as_uint(qn), false, false); qn = __uint_as_float(rr[0]) + __uint_as_float(rr[1]);
        mhat = fminf(sqrtf(qn * kb2) * 1.02f + 0.5f, 60.f);
#pragma unroll
        for (int r = 0; r < 16; ++r) negm[r] = -mhat;
        asm volatile("" : "+v"(negm));
    }
    CONV_DRAIN();
    {
        const lds_cptr kb = kp0;
#pragma unroll
        for (int d0 = 0; d0 < 6; ++d0) {
            const bf16x8 b0 = *(const __attribute__((address_space(3))) bf16x8*)(kb + d0 * 2048);
            const bf16x8 b1 = *(const __attribute__((address_space(3))) bf16x8*)(kb + d0 * 2048 + 512);
            const bf16x8 qf = QF(d0);
            if (d0 == 0) { pA0 = MFMA(b0, qf, negm); pA1 = MFMA(b1, qf, negm); }
            else { pA0 = MFMA(b0, qf, pA0); pA1 = MFMA(b1, qf, pA1); } }
    }
    asm volatile("s_nop 15\n\ts_nop 7" : "+v"(pA0), "+v"(pA1));
    START(pA0, pA1);
#pragma unroll
    for (int r = 0; r < 16; ++r) pA1[r] = __builtin_amdgcn_exp2f(pA1[r]);
    WAIT_BAR(0);
    DMA_K(3, 0); DMA_V(1, T_SLOTB); CONV_ISSUE();
    ROT();
#pragma unroll
    for (int j = 0; j < 6; ++j) kload2(kf, kp0 + sl_cur, j);
    WBAR2();
    s16x4 vlo[8], vhi[8]; u32x4 pw0, pw1, pw2, pw3;
#define PKW(P, B) cvtpk_s(P[B], P[B + 1])
#define PAF(k) __builtin_bit_cast(bf16x8, pw##k)
#define VFR(i) (bf16x8){vlo[i][0], vlo[i][1], vlo[i][2], vlo[i][3], vhi[i][0], vhi[i][1], vhi[i][2], vhi[i][3]}
#define PIN(x) asm volatile("" : "+v"(x))
#define GAPA(MF, A0, A1, A2, A3, W0, W1, PW) do { MF; sacc += A0; sacc += A1; sacc += A2; sacc += A3; PIN(sacc); W0; W1; PIN(PW); SBAR(); } while (0)
#define EX(v) __builtin_amdgcn_exp2f(v)
#define GAPB(MF, X, B) do { MF; X[B] = EX(X[B]); X[B + 1] = EX(X[B + 1]); X[B + 2] = EX(X[B + 2]); X[B + 3] = EX(X[B + 3]); PIN(X); SBAR(); } while (0)
#define VRD(i) do { vlo[i] = vtr(vp_ + (((i) >> 2) * 4096 + ((i) & 3) * 1024)); vhi[i] = vtr(vp_ + (((i) >> 2) * 4096 + ((i) & 3) * 1024 + 512)); } while (0)
#define KRD(G, j) do { if (G) { kload2(kf, kp0 + sl_next, j); SBAR(); } } while (0)
#define STEP(C0, C1, P0, P1, t, GK, GV, GL) do { SBAR(); CONV_DRAIN(); SBAR(); \
    const lds_cptr vp_ = vp0 + vs_prev; \
    bf16x8 qa = QF(0), qb = QF(1); \
    VRD(0); SBAR(); float sacc = (P0[0] + P0[1]); \
    GAPA(C0 = MFMA(kf[0], qa, negm), P0[2], P0[3], P0[4], P0[5],     pw0[0] = PKW(P0, 0), pw0[1] = PKW(P0, 2), pw0); \
    VRD(4); SBAR(); GAPA(C1 = MFMA(kf[1], qa, negm), P0[6], P0[7], P0[8], P0[9],     pw0[2] = PKW(P0, 4), pw0[3] = PKW(P0, 6), pw0); \
    qa = QF(2); VRD(1); SBAR(); GAPA(C0 = MFMA(kf[2], qb, C0),   P0[10], P0[11], P0[12], P0[13], pw1[0] = PKW(P0, 8), pw1[1] = PKW(P0, 10), pw1); \
    VRD(5); SBAR(); GAPA(C1 = MFMA(kf[3], qb, C1),   P0[14], P0[15], P1[0], P1[1],   pw1[2] = PKW(P0, 12), pw1[3] = PKW(P0, 14), pw1); \
    qb = QF(3); VRD(2); SBAR(); GAPA(C0 = MFMA(kf[4], qa, C0),   P1[2], P1[3], P1[4], P1[5],     pw2[0] = PKW(P1, 0), pw2[1] = PKW(P1, 2), pw2); \
    VRD(6); SBAR(); GAPA(C1 = MFMA(kf[5], qa, C1),   P1[6], P1[7], P1[8], P1[9],     pw2[2] = PKW(P1, 4), pw2[3] = PKW(P1, 6), pw2); \
    qa = QF(4); VRD(3); SBAR(); GAPA(C0 = MFMA(kf[6], qb, C0),   P1[10], P1[11], P1[12], P1[13], pw3[0] = PKW(P1, 8), pw3[1] = PKW(P1, 10), pw3); \
    VRD(7); SBAR(); GAPA(C1 = MFMA(kf[7], qb, C1),   P1[14], P1[15], 0.f, 0.f,       pw3[2] = PKW(P1, 12), pw3[3] = PKW(P1, 14), pw3); \
    qb = QF(5); SBAR(); C0 = MFMA(kf[8], qa, C0); C1 = MFMA(kf[9], qa, C1); SBAR(); \
    C0 = MFMA(kf[10], qb, C0); C1 = MFMA(kf[11], qb, C1); SBAR(); \
    l_reg += sacc; \
    if (GK) { DMA_K((t) + 3, sl_cur); } if (GV) { DMA_V((t) + 1, vs_next); } CONV_ISSUE(); \
    SBAR(); \
    GAPB(o[0] = MFMA(PAF(0), VFR(0), o[0]), C0, 0); \
    KRD(GL, 0); GAPB(o[1] = MFMA(PAF(0), VFR(4), o[1]), C0, 4); \
    KRD(GL, 1); GAPB(o[0] = MFMA(PAF(1), VFR(1), o[0]), C0, 8); \
    KRD(GL, 2); GAPB(o[1] = MFMA(PAF(1), VFR(5), o[1]), C0, 12); \
    KRD(GL, 3); GAPB(o[0] = MFMA(PAF(2), VFR(2), o[0]), C1, 0); \
    KRD(GL, 4); GAPB(o[1] = MFMA(PAF(2), VFR(6), o[1]), C1, 4); \
    KRD(GL, 5); GAPB(o[0] = MFMA(PAF(3), VFR(3), o[0]), C1, 8); \
    GAPB(o[1] = MFMA(PAF(3), VFR(7), o[1]), C1, 12); \
    } while (0)
    int t = 1;
    for (; t + 5 < NT; t += 2) {
        STEP(pB0, pB1, pA0, pA1, t, true, true, true);     WBARS(); RESC(); ROT();
        STEP(pA0, pA1, pB0, pB1, t + 1, true, true, true); WBARS(); RESC(); ROT();
    }
#define ENDW(tt) do { if ((tt) + 3 < NT) { WBARS(); } else if ((tt) + 2 < NT) { WB_E1(); } else { WB_E0(); } } while (0)
    for (; t + 1 < NT; t += 2) {
        STEP(pB0, pB1, pA0, pA1, t, (t + 3 < NT), (t + 1 < NT), (t + 1 < NT));         ENDW(t);     RESC(); ROT();
        STEP(pA0, pA1, pB0, pB1, t + 1, (t + 4 < NT), (t + 2 < NT), (t + 2 < NT));     ENDW(t + 1); RESC(); ROT();
    }
    STEP(pB0, pB1, pA0, pA1, NT - 1, false, false, false); RESC();
    {
        float sacc = pB0[0] + pB0[1];
#pragma unroll
        for (int r = 2; r < 16; ++r) sacc += pB0[r];
#pragma unroll
        for (int r = 0; r < 16; ++r) sacc += pB1[r];
        l_reg += sacc;
        pw0 = (u32x4){PKW(pB0, 0), PKW(pB0, 2), PKW(pB0, 4), PKW(pB0, 6)}; pw1 = (u32x4){PKW(pB0, 8), PKW(pB0, 10), PKW(pB0, 12), PKW(pB0, 14)};
        pw2 = (u32x4){PKW(pB1, 0), PKW(pB1, 2), PKW(pB1, 4), PKW(pB1, 6)}; pw3 = (u32x4){PKW(pB1, 8), PKW(pB1, 10), PKW(pB1, 12), PKW(pB1, 14)};
        SBAR();
        const lds_cptr vp_ = vp0 + vs_cur;
#pragma unroll
        for (int i = 0; i < 8; ++i) VRD(i);
        o[0] = MFMA(PAF(0), VFR(0), o[0]); o[1] = MFMA(PAF(0), VFR(4), o[1]); o[0] = MFMA(PAF(1), VFR(1), o[0]); o[1] = MFMA(PAF(1), VFR(5), o[1]);
        o[0] = MFMA(PAF(2), VFR(2), o[0]); o[1] = MFMA(PAF(2), VFR(6), o[1]); o[0] = MFMA(PAF(3), VFR(3), o[0]); o[1] = MFMA(PAF(3), VFR(7), o[1]);
    }
#undef PKW
#undef PAF
#undef VFR
#undef PIN
#undef GAPA
#undef GAPB
#undef EX
#undef VRD
#undef KRD
#undef STEP
#undef ENDW
    { auto rr = __builtin_amdgcn_permlane32_swap(__float_as_uint(l_reg), __float_as_uint(l_reg), false, false); l_reg = __uint_as_float(rr[0]) + __uint_as_float(rr[1]); }
    if (hi == 0) wsf[32 + r32] = l_reg; asm volatile("s_waitcnt lgkmcnt(0)" ::: "memory");
    float rli[16];
#pragma unroll
    for (int r = 0; r < 16; ++r) rli[r] = __builtin_amdgcn_rcpf(wsf[32 + crow(r, hi)]);
    bf16_t* Ow = Ob + (size_t)(wid * 32) * DM; bf16_t* stg = (bf16_t*)(shm + M_LDS_OST) + wid * 2048;
#pragma unroll
    for (int r = 0; r < 16; ++r) { const int orow = crow(r, hi);
#pragma unroll
        for (int d0 = 0; d0 < 2; ++d0) stg[orow * 64 + d0 * 32 + r32] = (bf16_t)f2bf(o[d0][r] * rli[r]); }
    asm volatile("s_waitcnt lgkmcnt(0)" ::: "memory");
#pragma unroll
    for (int i = 0; i < 4; ++i) { const int row = i * 8 + (lane >> 3), ch = lane & 7; const u32x4 v = *(const u32x4*)(stg + row * 64 + ch * 8); *(u32x4*)(Ow + (size_t)row * DM + ch * 8) = v;
        float q = 0.f;
#pragma unroll
        for (int d = 0; d < 4; ++d) { const float a = bf2f(v[d] & 0xffffu), bq = bf2f(v[d] >> 16); q += a * a + bq * bq; }
        q += dppmov<0xB1, 0xF>(0.f, q); q += dppmov<0x4E, 0xF>(0.f, q); q += dppmov<0x141, 0xF>(0.f, q);
        if (ch == 0) ostat[(size_t)(wid * 32 + row) * 16] = q; }
    asm volatile("s_waitcnt vmcnt(0) lgkmcnt(0)\n\ts_barrier" ::: "memory");
#if CONV_MODE >= 5
#undef WB_E1
#undef WB_E0
#endif
#undef QF
#undef DMA_K
#undef DMA_V
#undef START
#undef RESC
#undef ROT
}
#undef WBAR2
#undef WBARS
#undef WAIT_BAR
}


namespace pg8 {
typedef short bf16x8 __attribute__((ext_vector_type(8)));
typedef float f32x4 __attribute__((ext_vector_type(4)));
typedef unsigned u32x4 __attribute__((ext_vector_type(4)));
constexpr int BM = 256, BK = 64, HALF = 128, HTB = HALF * BK * 2, STAGE_BYTES = 8 * HTB, NXCD = 8, WGM = 8;
__host__ __device__ __forceinline__ int lds_byte(int r, int c) { const int st = (r >> 4) * 2 + (c >> 5), rr = r & 15, cc = c & 31, ob = rr * 64 + cc * 2; return st * 1024 + (ob ^ (((ob >> 9) & 1) << 5)); }
__host__ __device__ __forceinline__ void stage_rc(int b, int& R, int& C) { const int st = b / 1024, sb = b % 1024, swz = sb ^ (((sb >> 9) & 1) << 5); R = (st >> 1) * 16 + swz / 64; C = (st & 1) * 32 + (swz % 64) / 2; }
__host__ __device__ __forceinline__ int perm32(int rho) { const int n = rho >> 4, i = rho & 15; return 8 * (i >> 2) + 4 * n + (i & 3); }
__device__ __forceinline__ unsigned cvt_pk_bf16(float lo, float hi) { unsigned r; asm volatile("v_cvt_pk_bf16_f32 %0, %1, %2" : "=v"(r) : "v"(lo), "v"(hi)); return r; }

struct Unit { int pm, pn, e, nrows, rowbase; };

struct DenseOrder {
    int nM, nN, nwg, G, c, K; const char* Bt;
    __device__ void init(int M, int N, int K_, const bf16_t* Bt_, int G_, int c_) { nM = M / BM; nN = N / BM; nwg = nM * nN; G = G_; c = c_; K = K_; Bt = (const char*)Bt_; }
    __device__ __forceinline__ bool next(int i, Unit& u) const {
        const long L = (long)i * G + c; if (L >= nwg) return false;
        int wgid = (int)L; { const int q = nwg / NXCD, r = nwg % NXCD, xcd = wgid % NXCD, off = wgid / NXCD; wgid = (xcd < r ? xcd * (q + 1) : r * (q + 1) + (xcd - r) * q) + off; }
        const int nig = WGM * nN, gid = wgid / nig, fm = gid * WGM, gsz = (nM - fm) < WGM ? (nM - fm) : WGM;
        u.pm = fm + ((wgid % nig) % gsz); u.pn = (wgid % nig) / gsz; u.e = 0; u.nrows = 256; u.rowbase = u.pm * BM; return true;
    }
    __device__ __forceinline__ void a_offsets(const Unit&, int, unsigned (&)[2][2]) const {}
    __device__ __forceinline__ const char* b_tile(const Unit& u) const { return Bt + (size_t)u.pn * BM * K * 2; }
};

struct EpiBf16 {
    static constexpr bool PERM = true;
    bf16_t* O; int ldc;
    __device__ __forceinline__ void operator()(const f32x4 (&acc)[2][2][4][2], const Unit& u, int wr, int wc, int fr, int fq) const {
        const int row0 = u.pm * BM + wr * 64 + fr, col0 = u.pn * BM + wc * 32 + 8 * fq;
#pragma unroll
        for (int ai = 0; ai < 2; ++ai)
#pragma unroll
            for (int m = 0; m < 4; ++m) { bf16_t* rowp = O + (size_t)(row0 + ai * HALF + m * 16) * ldc + col0;
#pragma unroll
                for (int bj = 0; bj < 2; ++bj) { const f32x4 v0 = acc[ai][bj][m][0], v1 = acc[ai][bj][m][1];
                    u32x4 w; w.x = cvt_pk_bf16(v0[0], v0[1]); w.y = cvt_pk_bf16(v0[2], v0[3]); w.z = cvt_pk_bf16(v1[0], v1[1]); w.w = cvt_pk_bf16(v1[2], v1[3]);
                    *(u32x4*)(rowp + bj * HALF) = w; } }
    }
};


__device__ __forceinline__ float silu_mul(float g, float u) { return g * __builtin_amdgcn_rcpf(1.f + __expf(-g)) * u; }

struct MoeOrder {
    const LAS int* pre; const LAS int* offs; const LAS int* cntl; const int* list; const char* Bt; size_t bstride; int K, npn, G, c, mode;
    __device__ __forceinline__ bool next(int i, Unit& u) const {
        const int L = i * G + c, total = pre[NE] * npn; if (L >= total) return false;
        const int rtg = L / npn; const int pn = L - rtg * npn;
        int lo_ = 0, hi_ = NE;
        while (hi_ - lo_ > 1) { const int mid = (lo_ + hi_) >> 1; if (pre[mid] <= rtg) lo_ = mid; else hi_ = mid; }
        const int e = lo_, pm = rtg - pre[e], n = cntl[e] - pm * BM;
        u.e = __builtin_amdgcn_readfirstlane(e); u.pm = __builtin_amdgcn_readfirstlane(pm); u.pn = __builtin_amdgcn_readfirstlane(pn);
        u.nrows = __builtin_amdgcn_readfirstlane(n < BM ? n : BM); u.rowbase = __builtin_amdgcn_readfirstlane(offs[e] + pm * BM); return true;
    }
    __device__ __forceinline__ void a_offsets(const Unit& u, int tid, unsigned (&ua)[2][2]) const {
#pragma unroll
        for (int i = 0; i < 2; ++i) { int R, C; stage_rc(tid * 16 + i * 8192, R, C);
#pragma unroll
            for (int h = 0; h < 2; ++h) { int r = h * HALF + R; if (r >= u.nrows) r = 0; const int row = list[(size_t)u.e * LCAP + u.pm * BM + r] >> 3;
                ua[h][i] = (unsigned)((row * K + C) * 2); } }
    }
    __device__ __forceinline__ const char* b_tile(const Unit& u) const { return Bt + (size_t)u.e * bstride + (size_t)u.pn * BM * K * 2; }
};

struct EpiAct {
    static constexpr bool PERM = true;
    bf16_t* ACT;
    __device__ __forceinline__ void operator()(const f32x4 (&acc)[2][2][4][2], const Unit& u, int wr, int wc, int fr, int fq) const {
        const __amdgpu_buffer_rsrc_t rs = __builtin_amdgcn_make_buffer_rsrc((void*)ACT, 0, (NTOK * TOPK + 256) * EFF * 2, 0x00020000);
        const unsigned cb = (unsigned)((u.pn * HALF + wc * 32 + 8 * fq) * 2);
#pragma unroll
        for (int ai = 0; ai < 2; ++ai)
#pragma unroll
            for (int m = 0; m < 4; ++m) { const int r = ai * HALF + wr * 64 + m * 16 + fr;
                const unsigned off = (r < u.nrows) ? (unsigned)(u.rowbase + r) * (EFF * 2) + cb : 0xFFFFFFF0u;
                const f32x4 g0 = acc[ai][0][m][0], g1 = acc[ai][0][m][1], u0 = acc[ai][1][m][0], u1 = acc[ai][1][m][1];
                u32x4 w; w.x = cvt_pk_bf16(silu_mul(g0[0], u0[0]), silu_mul(g0[1], u0[1])); w.y = cvt_pk_bf16(silu_mul(g0[2], u0[2]), silu_mul(g0[3], u0[3]));
                w.z = cvt_pk_bf16(silu_mul(g1[0], u1[0]), silu_mul(g1[1], u1[1])); w.w = cvt_pk_bf16(silu_mul(g1[2], u1[2]), silu_mul(g1[3], u1[3]));
                __builtin_amdgcn_raw_buffer_store_b128(w, rs, off, 0, 0); }
    }
};
struct EpiSlots {
    static constexpr bool PERM = true;
    unsigned char* SL;
    __device__ __forceinline__ void operator()(const f32x4 (&acc)[2][2][4][2], const Unit& u, int wr, int wc, int fr, int fq) const {
        const __amdgpu_buffer_rsrc_t rs = __builtin_amdgcn_make_buffer_rsrc((void*)SL, 0, NTOK * TOPK * DM, 0x00020000);
        const unsigned cb = (unsigned)(u.pn * BM + wc * 32 + 8 * fq);
#pragma unroll
        for (int ai = 0; ai < 2; ++ai)
#pragma unroll
            for (int m = 0; m < 4; ++m) { const int r = ai * HALF + wr * 64 + m * 16 + fr;
                const unsigned off = (r < u.nrows) ? (unsigned)(u.rowbase + r) * DM + cb : 0xFFFFFFF0u;
#pragma unroll
                for (int bj = 0; bj < 2; ++bj) { const f32x4 v0 = acc[ai][bj][m][0] * 16.f, v1 = acc[ai][bj][m][1] * 16.f;
                    int lo = __builtin_amdgcn_cvt_pk_fp8_f32(v0[0], v0[1], 0, false); lo = __builtin_amdgcn_cvt_pk_fp8_f32(v0[2], v0[3], lo, true);
                    int hi = __builtin_amdgcn_cvt_pk_fp8_f32(v1[0], v1[1], 0, false); hi = __builtin_amdgcn_cvt_pk_fp8_f32(v1[2], v1[3], hi, true);
                    typedef unsigned u32x2 __attribute__((ext_vector_type(2)));
                    __builtin_amdgcn_raw_buffer_store_b64((u32x2){(unsigned)lo, (unsigned)hi}, rs, off, bj * HALF, 0); } }
    }
};
struct EpiRS {
    static constexpr bool PERM = true;
    float* LOG; bf16_t* ACTS;
    __device__ __forceinline__ void operator()(const f32x4 (&acc)[2][2][4][2], const Unit& u, int wr, int wc, int fr, int fq) const {
        const int row0 = u.pm * BM + wr * 64 + fr;
#pragma unroll
        for (int ai = 0; ai < 2; ++ai)
#pragma unroll
            for (int m = 0; m < 4; ++m) { const int row = row0 + ai * HALF + m * 16;
                if (u.pn == 0) {
#pragma unroll
                    for (int bj = 0; bj < 2; ++bj) { float* lp = LOG + (size_t)row * NE + bj * HALF + wc * 32 + 8 * fq; *(f32x4*)lp = acc[ai][bj][m][0]; *(f32x4*)(lp + 4) = acc[ai][bj][m][1]; }
                } else {
                    const f32x4 g0 = acc[ai][0][m][0], g1 = acc[ai][0][m][1], u0 = acc[ai][1][m][0], u1 = acc[ai][1][m][1];
                    u32x4 w; w.x = cvt_pk_bf16(silu_mul(g0[0], u0[0]), silu_mul(g0[1], u0[1])); w.y = cvt_pk_bf16(silu_mul(g0[2], u0[2]), silu_mul(g0[3], u0[3]));
                    w.z = cvt_pk_bf16(silu_mul(g1[0], u1[0]), silu_mul(g1[1], u1[1])); w.w = cvt_pk_bf16(silu_mul(g1[2], u1[2]), silu_mul(g1[3], u1[3]));
                    *(u32x4*)(ACTS + (size_t)row * EFF + (u.pn - 1) * HALF + wc * 32 + 8 * fq) = w; } }
    }
};

struct EpiBf16RowScale {
    static constexpr bool PERM = true;
    bf16_t* O; int ldc; const LAS float* rtab;
    __device__ __forceinline__ void operator()(const f32x4 (&acc)[2][2][4][2], const Unit& u, int wr, int wc, int fr, int fq) const {
        const int row0 = u.pm * BM + wr * 64 + fr, col0 = u.pn * BM + wc * 32 + 8 * fq;
#pragma unroll
        for (int ai = 0; ai < 2; ++ai)
#pragma unroll
            for (int m = 0; m < 4; ++m) { const int row = row0 + ai * HALF + m * 16; bf16_t* rowp = O + (size_t)row * ldc + col0;
                const float g = rtab[2 * (row - u.pm * BM) + 1];
#pragma unroll
                for (int bj = 0; bj < 2; ++bj) { const f32x4 v0 = acc[ai][bj][m][0] * g, v1 = acc[ai][bj][m][1] * g;
                    u32x4 w; w.x = cvt_pk_bf16(v0[0], v0[1]); w.y = cvt_pk_bf16(v0[2], v0[3]); w.z = cvt_pk_bf16(v1[0], v1[1]); w.w = cvt_pk_bf16(v1[2], v1[3]);
                    *(u32x4*)(rowp + bj * HALF) = w; } }
    }
};

template <class Epi, class Sched, bool ALIGN_EPI, bool GATHER = false, bool MIDSCALE = false>
__device__ __forceinline__ void gemm_phase(LAS unsigned char* lds, const bf16_t* Abase_, int K, const Sched& S, const Epi& E, const float* stat = nullptr) {
    int tid_ = threadIdx.x; asm volatile("" : "+v"(tid_));
    const int tid = tid_, wid = __builtin_amdgcn_readfirstlane(tid >> 6), lane = tid & 63, wr = wid >> 2, wc = wid & 3, fr = lane & 15, fq = lane >> 4;
    const int nt = K / BK;
    const char* Abase = (const char*)Abase_;
    unsigned voffB[2], voffA[2];
#pragma unroll
    for (int i = 0; i < 2; ++i) { int R, C; stage_rc(tid * 16 + i * 8192, R, C); const int Rb = Epi::PERM ? ((R & ~31) + perm32(R & 31)) : R; voffB[i] = (unsigned)(Rb * K + C) * 2u; voffA[i] = (unsigned)(R * K + C) * 2u; }
    const size_t kstep = (size_t)(BK * 2);
    const size_t hstep = (size_t)HALF * K * 2;
    const unsigned ldsw = (unsigned)wid * 1024u;
    const int aoff = lds_byte(wr * 64 + fr, fq * 8), boff = lds_byte(wc * 32 + fr, fq * 8);
#define PG8_SA(b, h) (((b) * 2 + (h)) * HTB)
#define PG8_SB(b, h) ((4 + (b) * 2 + (h)) * HTB)
#define PG8_STAGE_B(bufoff, gbase) do { _Pragma("unroll") for (int _i = 0; _i < 2; ++_i) \
        __builtin_amdgcn_global_load_lds((const unsigned*)((const char*)(gbase) + voffB[_i]), (LAS unsigned*)(lds + (bufoff) + ldsw + _i * 8192), 16, 0, 0); } while (0)
#define PG8_STAGE_A(bufoff, ua, pa, h, koff) do { _Pragma("unroll") for (int _i = 0; _i < 2; ++_i) { \
        const char* _g = GATHER ? (Abase + (size_t)(ua)[h][_i] + (koff)) : ((pa) + (size_t)(h) * hstep + voffA[_i] + (koff)); \
        __builtin_amdgcn_global_load_lds((const unsigned*)_g, (LAS unsigned*)(lds + (bufoff) + ldsw + _i * 8192), 16, 0, 0); } } while (0)
#define PG8_LDA(dst, b, h) do { _Pragma("unroll") for (int m = 0; m < 4; ++m) _Pragma("unroll") for (int k = 0; k < 2; ++k) dst[m][k] = *(const LAS bf16x8*)(lds + PG8_SA(b, h) + aoff + m * 2048 + k * 1024); } while (0)
#define PG8_LDB(dst, b, h) do { _Pragma("unroll") for (int n = 0; n < 2; ++n) _Pragma("unroll") for (int k = 0; k < 2; ++k) dst[n][k] = *(const LAS bf16x8*)(lds + PG8_SB(b, h) + boff + n * 2048 + k * 1024); } while (0)
#define PG8_MMA(ai, bj, At, Bt) do { __builtin_amdgcn_s_setprio(1); _Pragma("unroll") for (int m = 0; m < 4; ++m) _Pragma("unroll") for (int n = 0; n < 2; ++n) _Pragma("unroll") for (int k = 0; k < 2; ++k) \
        acc[ai][bj][m][n] = __builtin_amdgcn_mfma_f32_16x16x32_bf16(Bt[n][k], At[m][k], acc[ai][bj][m][n], 0, 0, 0); __builtin_amdgcn_s_setprio(0); } while (0)
#define PG8_WAIT_V(n) asm volatile("s_waitcnt vmcnt(" #n ")" ::: "memory")
#define PG8_WAIT_L(n) asm volatile("s_waitcnt lgkmcnt(" #n ")" ::: "memory")
#define PG8_BAR __builtin_amdgcn_s_barrier()
#define PG8_SCHED __builtin_amdgcn_sched_barrier(0)
    Unit cur, nxt; int ui = 0;
    if (!S.next(0, cur)) return;
    f32x4 acc[2][2][4][2];
#pragma unroll
    for (int a = 0; a < 2; ++a)
#pragma unroll
        for (int b = 0; b < 2; ++b)
#pragma unroll
            for (int m = 0; m < 4; ++m)
#pragma unroll
                for (int n = 0; n < 2; ++n) acc[a][b][m][n] = (f32x4){0.f, 0.f, 0.f, 0.f};
    bf16x8 At[4][2], B0[2][2], B1[2][2];
    unsigned uc[2][2], un[2][2];
    if constexpr (GATHER) S.a_offsets(cur, tid, uc);
    const char* cA = Abase + (size_t)cur.rowbase * K * 2;
    const char* cB = S.b_tile(cur);
    PG8_STAGE_B(PG8_SB(0, 0), cB); PG8_STAGE_B(PG8_SB(0, 1), cB + hstep); PG8_STAGE_A(PG8_SA(0, 0), uc, cA, 0, (size_t)0); PG8_STAGE_A(PG8_SA(0, 1), uc, cA, 1, (size_t)0);
    if (wr == 1) PG8_BAR;
    PG8_WAIT_V(2); PG8_BAR;
    PG8_STAGE_B(PG8_SB(1, 0), cB + kstep); PG8_STAGE_A(PG8_SA(1, 0), uc, cA, 0, kstep); PG8_STAGE_B(PG8_SB(1, 1), cB + hstep + kstep);
    PG8_WAIT_V(6); PG8_BAR;
    for (;;) {
        const bool has_next = S.next(ui + 1, nxt);
        const bool lower = cur.nrows > wr * 64, upper = cur.nrows > HALF + wr * 64;
        const char* nB = cB; const char* nA = cA;
        if (has_next) { if constexpr (GATHER) S.a_offsets(nxt, tid, un); nB = S.b_tile(nxt); nA = Abase + (size_t)nxt.rowbase * K * 2; }
        else if constexpr (GATHER) {
#pragma unroll
            for (int h = 0; h < 2; ++h)
#pragma unroll
                for (int i = 0; i < 2; ++i) un[h][i] = uc[h][i];
        }
#pragma unroll 1
        for (int t = 0; t < nt; t += 2) {
            const bool last = (t == nt - 2);
            const size_t k1 = (size_t)(t + 1) * kstep;
            const size_t k2 = last ? (size_t)0 : (size_t)(t + 2) * kstep, k3 = k2 + kstep;
            const char* b2 = last ? nB : cB + (size_t)(t + 2) * kstep; const char* b3 = b2 + kstep;
            const char* a2 = last ? nA : cA;
            unsigned x2[2][2];
            if constexpr (GATHER) {
#pragma unroll
                for (int h = 0; h < 2; ++h)
#pragma unroll
                    for (int i = 0; i < 2; ++i) x2[h][i] = uc[h][i];
                if (last) { asm volatile("; next unit's A offsets" ::: "memory");
#pragma unroll
                    for (int h = 0; h < 2; ++h)
#pragma unroll
                        for (int i = 0; i < 2; ++i) x2[h][i] = un[h][i]; }
            }
            if constexpr (MIDSCALE) { if (t == nt / 2) {
#pragma unroll
                for (int ai = 0; ai < 2; ++ai)
#pragma unroll
                    for (int m = 0; m < 4; ++m) { const float f = ((const LAS float*)(lds + STAGE_BYTES))[2 * (ai * HALF + wr * 64 + m * 16 + fr)];
#pragma unroll
                        for (int bj = 0; bj < 2; ++bj)
#pragma unroll
                            for (int n = 0; n < 2; ++n) acc[ai][bj][m][n] *= f; } } }
            PG8_LDB(B0, 0, 0); PG8_LDB(B1, 0, 1); PG8_SCHED; PG8_LDA(At, 0, 0); PG8_STAGE_A(PG8_SA(1, 1), uc, cA, 1, k1);
            PG8_WAIT_V(8); PG8_WAIT_L(0); PG8_BAR; if (lower) { PG8_MMA(0, 0, At, B0); PG8_MMA(0, 1, At, B1); } PG8_BAR; PG8_SCHED;
            PG8_LDA(At, 0, 1); PG8_STAGE_B(PG8_SB(0, 0), b2); PG8_STAGE_B(PG8_SB(0, 1), b2 + hstep); PG8_STAGE_A(PG8_SA(0, 0), x2, a2, 0, k2);
            PG8_WAIT_V(8); PG8_WAIT_L(0); PG8_BAR; if (upper) { PG8_MMA(1, 0, At, B0); PG8_MMA(1, 1, At, B1); } PG8_BAR; PG8_SCHED;
            PG8_LDB(B0, 1, 0); PG8_LDB(B1, 1, 1); PG8_SCHED; PG8_LDA(At, 1, 0); PG8_STAGE_A(PG8_SA(0, 1), x2, a2, 1, k2);
            PG8_WAIT_V(8); PG8_WAIT_L(0); PG8_BAR; if (lower) { PG8_MMA(0, 0, At, B0); PG8_MMA(0, 1, At, B1); } PG8_BAR; PG8_SCHED;
            PG8_LDA(At, 1, 1); PG8_STAGE_B(PG8_SB(1, 0), b3); PG8_STAGE_B(PG8_SB(1, 1), b3 + hstep); PG8_STAGE_A(PG8_SA(1, 0), x2, a2, 0, k3);
            PG8_WAIT_V(8); PG8_WAIT_L(0); PG8_BAR; if (upper) { PG8_MMA(1, 0, At, B0); PG8_MMA(1, 1, At, B1); } PG8_BAR; PG8_SCHED;
        }
        if constexpr (ALIGN_EPI) { if (wr == 0) PG8_BAR; }
        E(acc, cur, wr, wc, fr, fq);
        if (!has_next) break;
#pragma unroll
        for (int a = 0; a < 2; ++a)
#pragma unroll
            for (int b = 0; b < 2; ++b)
#pragma unroll
                for (int m = 0; m < 4; ++m)
#pragma unroll
                    for (int n = 0; n < 2; ++n) acc[a][b][m][n] = (f32x4){0.f, 0.f, 0.f, 0.f};
        cur = nxt; cB = nB; cA = nA; ++ui;
        if constexpr (GATHER) {
#pragma unroll
            for (int h = 0; h < 2; ++h)
#pragma unroll
                for (int i = 0; i < 2; ++i) uc[h][i] = un[h][i];
        }
        if constexpr (ALIGN_EPI) { if (wr == 1) PG8_BAR; }
    }
    PG8_WAIT_V(0);
    if constexpr (!ALIGN_EPI) { if (wr == 0) PG8_BAR; }
    PG8_BAR;
#undef PG8_SA
#undef PG8_SB
#undef PG8_STAGE_A
#undef PG8_STAGE_B
#undef PG8_LDA
#undef PG8_LDB
#undef PG8_MMA
#undef PG8_WAIT_V
#undef PG8_WAIT_L
#undef PG8_BAR
#undef PG8_SCHED
}
}

__device__ __forceinline__ void cvt_item(const float* W, int ldw, int col0, int k0, bf16_t* WT, int drow0, int Kd, const float* gk, LAS float* scr, int lane) {
    const int kr = lane >> 3, n4 = lane & 7;
    float4 v[8];
#pragma unroll
    for (int i = 0; i < 8; ++i) v[i] = *(const float4*)&W[(size_t)(k0 + 8 * i + kr) * ldw + col0 + 4 * n4];
#pragma unroll
    for (int i = 0; i < 8; ++i) { const int kk = 8 * i + kr; const float g = gk ? gk[k0 + kk] : 1.f; LAS float* d = scr + kk * 33 + 4 * n4;
        d[0] = v[i].x * g; d[1] = v[i].y * g; d[2] = v[i].z * g; d[3] = v[i].w * g; }
    asm volatile("s_waitcnt lgkmcnt(0)" ::: "memory");
    const int cch = lane & 7;
#pragma unroll
    for (int j = 0; j < 4; ++j) { const int n = (lane >> 3) + 8 * j; const LAS float* sp = scr + (8 * cch) * 33 + n;
        uint4 o; o.x = pk2(sp[0 * 33], sp[1 * 33]); o.y = pk2(sp[2 * 33], sp[3 * 33]); o.z = pk2(sp[4 * 33], sp[5 * 33]); o.w = pk2(sp[6 * 33], sp[7 * 33]);
        *(uint4*)(WT + (size_t)(drow0 + n) * Kd + k0 + 8 * cch) = o; }
    asm volatile("s_waitcnt lgkmcnt(0)" ::: "memory");
}
#define PHASE_PTRS \
    unsigned char* wsp = args.ws; asm volatile("" : "+s"(wsp)); \
    const float* x = args.in[0]; const float* cvec = args.in[1]; const float* w_ada = args.in[2]; const float* b_ada = args.in[3]; \
    const float* g_pre_mix = args.in[4]; const float* g_post_mix = args.in[5]; const float* g_pre_ffn = args.in[6]; const float* g_post_ffn = args.in[7]; \
    const float* w_in = args.in[8]; const float* g_q_a = args.in[9]; const float* w_q_b = args.in[10]; const float* g_kv_a = args.in[11]; const float* w_kv_b = args.in[12]; \
    const float* g_q_head = args.in[13]; const float* g_k_head = args.in[14]; const float* g_mla_out = args.in[15]; const float* g_gqa_out = args.in[16]; \
    const float* w_out = args.in[17]; const float* w_router = args.in[18]; const float* b_router = args.in[19]; \
    const float* w_gate_e = args.in[20]; const float* w_up_e = args.in[21]; const float* w_down_e = args.in[22]; \
    const float* w_gate_s = args.in[23]; const float* w_up_s = args.in[24]; const float* w_down_s = args.in[25]; \
    float* mod = (float*)(wsp + WS_MOD); \
    float* cosm = (float*)(wsp + WS_COSM); float* sinm = (float*)(wsp + WS_SINM); float* cosg = (float*)(wsp + WS_COSG); float* sing = (float*)(wsp + WS_SING); \
    bf16_t* H2 = (bf16_t*)(wsp + WS_H2); \
    bf16_t* QM = (bf16_t*)(wsp + WS_QM); bf16_t* KM = (bf16_t*)(wsp + WS_KM); bf16_t* VM = (bf16_t*)(wsp + WS_VM); \
    bf16_t* QG = (bf16_t*)(wsp + WS_QG); bf16_t* KG = (bf16_t*)(wsp + WS_KG); bf16_t* VG = (bf16_t*)(wsp + WS_VG); \
    bf16_t* O = (bf16_t*)(wsp + WS_O); \
    bf16_t* X1 = (bf16_t*)(wsp + WS_X1); float* WTS = (float*)(wsp + WS_WTS); int* LIST = (int*)(wsp + WS_LIST); \
    bf16_t* SLOTS = (bf16_t*)(wsp + WS_SLOTS); int* POSREC = (int*)(wsp + WS_POSREC); float* OSTAT = (float*)(wsp + WS_OSTAT); \
    bf16_t* PBUF = (bf16_t*)(wsp + WS_PBUF); bf16_t* WBIGT = (bf16_t*)(wsp + WS_WBIGT); \
    bf16_t* WQBT = (bf16_t*)(wsp + WS_WQBT); bf16_t* WINQ = (bf16_t*)(wsp + WS_WINQ); bf16_t* WKVBT = (bf16_t*)(wsp + WS_WKVBT); bf16_t* WINKV = (bf16_t*)(wsp + WS_WINKV); \
    bf16_t* WOUTT = (bf16_t*)(wsp + WS_WOUTT); bf16_t* WRST = (bf16_t*)(wsp + WS_WRST); bf16_t* WDST = (bf16_t*)(wsp + WS_WDST); \
    bf16_t* WGUT = (bf16_t*)(wsp + WS_WGUT); bf16_t* WDT = (bf16_t*)(wsp + WS_WDT); \
    bf16_t* MIXED = (bf16_t*)(wsp + WS_MIXED); float* LOG = (float*)(wsp + WS_LOG); bf16_t* ACT = (bf16_t*)(wsp + WS_ACT); bf16_t* ACTS = (bf16_t*)(wsp + WS_ACTS); bf16_t* YSH = (bf16_t*)(wsp + WS_YSH);

__global__ void __launch_bounds__(NTHR, 2) mega(Args args) {
    extern __shared__ __attribute__((aligned(16))) unsigned char lds_raw[];
    unsigned char* ws = args.ws;
    unsigned* ctl = (unsigned*)(ws + WS_CTL);
    volatile LAS unsigned* bst = (volatile LAS unsigned*)(lds_raw + LDS_BYTES - 16);
    if (threadIdx.x < 4) bst[threadIdx.x] = 0u;
    const int nbk = gridDim.x, bidk = blockIdx.x;
    __syncthreads();
    XcdBarrier bar; bar.bar = ctl + CW_BAR; bar.x = 0; bar.st = bst;
    if (MK_N_LAUNCHES == 1) bar = xcd_barrier_post(ctl + CW_BAR, bst);
    const int lo = args.ph_lo, hi = args.ph_hi;
    const int vcu = (nbk % 8 == 0) ? (bidk % 8) * (nbk / 8) + bidk / 8 : bidk;
    LAS unsigned char* ldsb = (LAS unsigned char*)lds_raw;
#define IN(k) (lo <= (k) && (k) < hi && (pass_ == 0 || ((k) >= REP_FROM && (k) != 8)))
#define SEAM(k) do { if (lo <= (k) && (k) + 1 < hi && (pass_ == 0 || (k) >= REP_FROM)) xcd_barrier(bar); } while (0)

    unsigned* CNT = (unsigned*)(ws + WS_CNTS);

    for (int pass_ = 0; pass_ < (REP_FROM < 12 ? 2 : 1); ++pass_) {
    if (pass_) xcd_barrier(bar);
    if (IN(0)) for (int rep_ = 0; rep_ < (((REPEAT_MASK >> 0) & 1) ? 2 : 1); ++rep_) {
        const Ctx c = mkctx(ws, lds_raw); PHASE_PTRS
        float* red = c.lds;
        if (c.tid == 0) for (int e = c.bid; e < NE; e += c.nb) CNT[(size_t)e * CNT_STRIDE] = 0u;
        for (int g = c.bid; g < 192; g += c.nb) {
            const int c4 = c.tid & 7, kr = c.tid >> 3;
            float4 w[16];
#pragma unroll
            for (int i = 0; i < 16; ++i) w[i] = *(const float4*)&w_ada[(size_t)(64 * i + kr) * 6144 + g * 32 + 4 * c4];
            float4 a0 = make_float4(0.f, 0.f, 0.f, 0.f), a1 = a0;
#pragma unroll
            for (int i = 0; i < 16; ++i) { const int k = 64 * i + kr; const float c0 = cvec[k], c1 = cvec[DM + k]; const float f0 = c0 * sigmoidf_(c0), f1 = c1 * sigmoidf_(c1);
                a0.x += f0 * w[i].x; a0.y += f0 * w[i].y; a0.z += f0 * w[i].z; a0.w += f0 * w[i].w; a1.x += f1 * w[i].x; a1.y += f1 * w[i].y; a1.z += f1 * w[i].z; a1.w += f1 * w[i].w; }
            __syncthreads();
            *(float4*)&red[(kr * 8 + c4) * 4] = a0; *(float4*)&red[2048 + (kr * 8 + c4) * 4] = a1;
            __syncthreads();
            if (c.tid < 64) { const int b = c.tid >> 5, cc = c.tid & 31; float sacc = 0.f; for (int j = 0; j < 64; ++j) sacc += red[b * 2048 + j * 32 + cc]; mod[b * 6144 + g * 32 + cc] = sacc + b_ada[g * 32 + cc]; }
        }
        __syncthreads();
        for (int idx = c.bid * NTHR + c.tid; idx < SEQ * 16; idx += c.nb * NTHR) {
            const int s = idx >> 4, i = idx & 15, f = i & 7;
            const float inv = powf(10000.f, -(float)f / 8.f);
            const float pos = (float)((i < 8) ? (s >> 6) : (s & 63));
            const float ang = pos * inv;
            cosm[idx] = cosf(ang); sinm[idx] = sinf(ang);
        }
        for (int idx = c.bid * NTHR + c.tid; idx < SEQ * 32; idx += c.nb * NTHR) {
            const int s = idx >> 5, i = idx & 31, f = i & 15;
            const float inv = powf(10000.f, -(float)f / 16.f);
            const float pos = (float)((i < 16) ? (s >> 6) : (s & 63));
            const float ang = pos * inv;
            cosg[idx] = cosf(ang); sing[idx] = sinf(ang);
        }
        LAS float* scr = (LAS float*)(ldsb + 8192 + c.wave * 8448);
        constexpr int I_BIG = 37 * 16;
        constexpr int I_QB = 24 * 4;
        constexpr int I_KVB = 32 * 2;
        constexpr int I_OUT = 32 * 16;
        constexpr int I_RS = 24 * 16;
        constexpr int I_DS = 32 * 4;
        const int I_EXP = (c.nb == NE && (CONV_MODE == 1 || CONV_MODE == 5)) ? 0 : NE * 384;
        const int I_TOT = I_BIG + I_QB + I_KVB + I_OUT + I_RS + I_DS + I_EXP;
        for (int it = c.gw; it < I_TOT; it += c.ngw) {
            int r = it;
            if (r < I_BIG) { const int grp = r >> 4, kb = r & 15; const int col0 = grp * 32, drow = (grp < 13) ? grp * 32 : 2304 + (grp - 13) * 32;
                cvt_item(w_in, INC, col0, kb * 64, WBIGT, drow, DM, nullptr, scr, c.lane); continue; }
            r -= I_BIG;
            if (r < I_QB) { const int grp = r >> 2, kb = r & 3; cvt_item(w_q_b, 768, grp * 32, kb * 64, WQBT, grp * 32, 256, g_q_a, scr, c.lane); continue; }
            r -= I_QB;
            if (r < I_KVB) { const int grp = r >> 1, kb = r & 1; cvt_item(w_kv_b, 1024, grp * 32, kb * 64, WKVBT, grp * 32, 256, g_kv_a, scr, c.lane); continue; }
            r -= I_KVB;
            if (r < I_OUT) { const int grp = r >> 4, kb = r & 15; cvt_item(w_out, DM, grp * 32, kb * 64, WOUTT, grp * 32, DM, (kb < 8) ? g_mla_out : (g_gqa_out - 512), scr, c.lane); continue; }
            r -= I_OUT;
            if (r < I_RS) { const int grp = r >> 4, kb = r & 15;
                if (grp < 8) cvt_item(w_router, NE, grp * 32, kb * 64, WRST, grp * 32, DM, nullptr, scr, c.lane);
                else { const int q = grp - 8, blk = q >> 2, sub = q & 3;
                    cvt_item((blk & 1) ? w_up_s : w_gate_s, EFF, (blk >> 1) * 128 + sub * 32, kb * 64, WRST, 256 + blk * 128 + sub * 32, DM, nullptr, scr, c.lane); }
                continue; }
            r -= I_RS;
            if (r < I_DS) { const int grp = r >> 2, kb = r & 3; cvt_item(w_down_s, DM, grp * 32, kb * 64, WDST, grp * 32, EFF, nullptr, scr, c.lane); continue; }
            r -= I_DS;
            { const int e = r / 384, q = r % 384;
              if (q < 256) { const int up = q >> 7, q2 = q & 127, grp = q2 >> 4, kb = q2 & 15;
                  const int drow = ((grp < 4) ? grp * 32 : 256 + (grp - 4) * 32) + up * 128;
                  cvt_item((up ? w_up_e : w_gate_e) + (size_t)e * DM * EFF, EFF, grp * 32, kb * 64, WGUT + (size_t)e * 512 * DM, drow, DM, nullptr, scr, c.lane); }
              else { const int q2 = q - 256, grp = q2 >> 2, kb = q2 & 3;
                  cvt_item(w_down_e + (size_t)e * EFF * DM, DM, grp * 32, kb * 64, WDT + (size_t)e * DM * EFF, grp * 32, EFF, nullptr, scr, c.lane); } }
        }
        const int gt = c.bid * NTHR + c.tid, ngt = c.nb * NTHR;
        for (int i = gt; i < 96 * 1024 / 8; i += ngt) *(uint4*)(WBIGT + (size_t)416 * DM + (size_t)i * 8) = make_uint4(0u, 0u, 0u, 0u);
        for (int i = gt; i < 1024 * 16; i += ngt) { const int n = i >> 4, q = i & 15; *(uint4*)(WKVBT + (size_t)n * 256 + 128 + q * 8) = make_uint4(0u, 0u, 0u, 0u); }
        for (int i = gt; i < 1024 * 64; i += ngt) { const int k = i >> 6, q = i & 63; const float4 v = *(const float4*)&w_in[(size_t)k * INC + q * 4]; uint2 o; o.x = pk2(v.x, v.y); o.y = pk2(v.z, v.w); *(uint2*)(WINQ + (size_t)k * 256 + q * 4) = o; }
        for (int i = gt; i < 1024 * 64; i += ngt) { const int k = i >> 6, q = i & 63; uint2 o = make_uint2(0u, 0u);
            if (q < 32) { const float4 v = *(const float4*)&w_in[(size_t)k * INC + 256 + q * 4]; o.x = pk2(v.x, v.y); o.y = pk2(v.z, v.w); }
            *(uint2*)(WINKV + (size_t)k * 256 + q * 4) = o; }
    }
    SEAM(0);

    if (IN(1)) for (int rep_ = 0; rep_ < (((REPEAT_MASK >> 1) & 1) ? 2 : 1); ++rep_) {
        const Ctx c = mkctx(ws, lds_raw); PHASE_PTRS
        { pg8::DenseOrder S; S.init(768, 1024, 256, WINQ, c.nb, c.bid); pg8::EpiBf16 E{WBIGT + (size_t)512 * DM, DM};
          pg8::gemm_phase<pg8::EpiBf16, pg8::DenseOrder, true>(ldsb, WQBT, 256, S, E); }
        { pg8::DenseOrder S; S.init(1024, 1024, 256, WINKV, c.nb, (c.bid >= 12 && c.nb >= 28) ? c.bid - 12 : c.bid + (c.nb >= 28 ? c.nb : 0)); pg8::EpiBf16 E{WBIGT + (size_t)1280 * DM, DM};
          pg8::gemm_phase<pg8::EpiBf16, pg8::DenseOrder, true>(ldsb, WKVBT, 256, S, E); }
        for (int m0 = c.gw; m0 < NTOK; m0 += 2 * c.ngw) {
            float4 v[2][4]; float ss[2];
#pragma unroll
            for (int q = 0; q < 2; ++q) { const int m = m0 + q * c.ngw; ss[q] = 0.f;
#pragma unroll
                for (int j = 0; j < 4; ++j) { v[q][j] = *(const float4*)&x[(size_t)m * DM + 4 * c.lane + 256 * j]; } }
#pragma unroll
            for (int q = 0; q < 2; ++q) {
                const int m = m0 + q * c.ngw; const int b = m / SEQ; const float* md = mod + b * 6144;
#pragma unroll
                for (int j = 0; j < 4; ++j) ss[q] += v[q][j].x * v[q][j].x + v[q][j].y * v[q][j].y + v[q][j].z * v[q][j].z + v[q][j].w * v[q][j].w;
                const float rstd = rsqrtf(wave_sum(ss[q]) * (1.f / DM) + EPS);
#pragma unroll
                for (int j = 0; j < 4; ++j) {
                    const int cc = 4 * c.lane + 256 * j;
                    const float4 g = *(const float4*)&g_pre_mix[cc], sc = *(const float4*)&md[1024 + cc], sh = *(const float4*)&md[cc];
                    uint2 o;
                    o.x = pk2(v[q][j].x * rstd * g.x * (1.f + sc.x) + sh.x, v[q][j].y * rstd * g.y * (1.f + sc.y) + sh.y);
                    o.y = pk2(v[q][j].z * rstd * g.z * (1.f + sc.z) + sh.z, v[q][j].w * rstd * g.w * (1.f + sc.w) + sh.w);
                    *(uint2*)&H2[(size_t)m * DM + cc] = o;
                }
            }
        }
    }
    SEAM(1);

    if (IN(2)) for (int rep_ = 0; rep_ < (((REPEAT_MASK >> 2) & 1) ? 2 : 1); ++rep_) {
        const Ctx c = mkctx(ws, lds_raw); PHASE_PTRS
        pg8::DenseOrder S; S.init(NTOK, 3072, DM, WBIGT, c.nb, c.bid); pg8::EpiBf16 E{PBUF, 3072};
        pg8::gemm_phase<pg8::EpiBf16, pg8::DenseOrder, true>(ldsb, H2, DM, S, E);
    }
    SEAM(2);

    if (IN(3)) for (int rep_ = 0; rep_ < (((REPEAT_MASK >> 3) & 1) ? 2 : 1); ++rep_) {
        const Ctx c = mkctx(ws, lds_raw); PHASE_PTRS
        unsigned* kmaxL = (unsigned*)lds_raw;
        if (c.tid < 18) kmaxL[c.tid] = 0u;
        __syncthreads();
        uint4 nraw[6];
#pragma unroll
        for (int j = 0; j < 6; ++j) nraw[j] = *(const uint4*)(PBUF + (size_t)c.gw * 3072 + 512 * j + 8 * c.lane);
        for (int m = c.gw; m < NTOK; m += c.ngw) {
            const int b = m / SEQ, s = m % SEQ;
            uint4 raw[6];
#pragma unroll
            for (int j = 0; j < 6; ++j) raw[j] = nraw[j];
            if (m + c.ngw < NTOK) {
#pragma unroll
                for (int j = 0; j < 6; ++j) nraw[j] = *(const uint4*)(PBUF + (size_t)(m + c.ngw) * 3072 + 512 * j + 8 * c.lane);
            }
            float rq, rkv;
            {
                float v[8]; { const uint4 u = raw[0]; v[0] = bf2f(u.x & 0xffffu); v[1] = bf2f(u.x >> 16); v[2] = bf2f(u.y & 0xffffu); v[3] = bf2f(u.y >> 16); v[4] = bf2f(u.z & 0xffffu); v[5] = bf2f(u.z >> 16); v[6] = bf2f(u.w & 0xffffu); v[7] = bf2f(u.w >> 16); }
                float sq = 0.f;
#pragma unroll
                for (int i = 0; i < 8; ++i) sq += v[i] * v[i];
                rq = rsqrtf(wave_sum(c.lane < 32 ? sq : 0.f) * (1.f / QLORA) + EPS);
                rkv = rsqrtf(wave_sum((c.lane >= 32 && c.lane < 48) ? sq : 0.f) * (1.f / KVLORA) + EPS);
                if (c.lane >= 48 && c.lane < 52) {
                    const int i0 = 4 * (c.lane - 48); uint4 o; unsigned ow[4];
#pragma unroll
                    for (int pq = 0; pq < 4; ++pq) { const float cs = cosm[s * 16 + i0 + pq], sn = sinm[s * 16 + i0 + pq]; ow[pq] = pk2(v[2 * pq] * cs - v[2 * pq + 1] * sn, v[2 * pq] * sn + v[2 * pq + 1] * cs); }
                    o.x = ow[0]; o.y = ow[1]; o.z = ow[2]; o.w = ow[3];
#pragma unroll
                    for (int h = 0; h < MH; ++h) *(uint4*)&KM[((size_t)(b * MH + h) * SEQ + s) * DQKM + MNOPE + 2 * i0] = o;
                    float pq = 0.f;
#pragma unroll
                    for (int i = 0; i < 8; ++i) pq += v[i] * v[i];
                    pq += dppmov<0xB1, 0xF>(0.f, pq); pq += dppmov<0x4E, 0xF>(0.f, pq);
                    if (c.lane == 48) atomicMax(&kmaxL[16 + b], __builtin_bit_cast(unsigned, pq));
                }
            }
#pragma unroll
            for (int j = 1; j < 6; ++j) {
                const int col0 = 512 * j + 8 * c.lane;
                float v[8]; { const uint4 u = raw[j]; v[0] = bf2f(u.x & 0xffffu); v[1] = bf2f(u.x >> 16); v[2] = bf2f(u.y & 0xffffu); v[3] = bf2f(u.y >> 16); v[4] = bf2f(u.z & 0xffffu); v[5] = bf2f(u.z >> 16); v[6] = bf2f(u.w & 0xffffu); v[7] = bf2f(u.w >> 16); }
                if (col0 < 1280) {
                    const int qc = col0 - 512, h = qc / DQKM, d0 = qc % DQKM; const float sc = rq * C2M;
                    uint4 o; unsigned ow[4];
                    if (d0 >= MNOPE) { const int i0 = (d0 - MNOPE) >> 1;
#pragma unroll
                        for (int pq = 0; pq < 4; ++pq) { const float cs = cosm[s * 16 + i0 + pq], sn = sinm[s * 16 + i0 + pq]; ow[pq] = pk2((v[2 * pq] * cs - v[2 * pq + 1] * sn) * sc, (v[2 * pq] * sn + v[2 * pq + 1] * cs) * sc); }
                    } else {
#pragma unroll
                        for (int pq = 0; pq < 4; ++pq) ow[pq] = pk2(v[2 * pq] * sc, v[2 * pq + 1] * sc);
                    }
                    o.x = ow[0]; o.y = ow[1]; o.z = ow[2]; o.w = ow[3];
                    *(uint4*)&QM[((size_t)(b * MH + h) * SEQ + s) * DQKM + d0] = o;
                } else if (col0 < 2304) {
                    const int kc = col0 - 1280, h = kc >> 7, d0 = kc & 127;
                    uint4 o; o.x = pk2(v[0] * rkv, v[1] * rkv); o.y = pk2(v[2] * rkv, v[3] * rkv); o.z = pk2(v[4] * rkv, v[5] * rkv); o.w = pk2(v[6] * rkv, v[7] * rkv);
                    if (d0 < MNOPE) { *(uint4*)&KM[((size_t)(b * MH + h) * SEQ + s) * DQKM + d0] = o;
                        float kq = 0.f;
#pragma unroll
                        for (int i = 0; i < 8; ++i) kq += (v[i] * rkv) * (v[i] * rkv);
                        kq += dppmov<0xB1, 0xF>(0.f, kq); kq += dppmov<0x4E, 0xF>(0.f, kq); kq += dppmov<0x141, 0xF>(0.f, kq);
                        if ((c.lane & 7) == 0) atomicMax(&kmaxL[b * 8 + h], __builtin_bit_cast(unsigned, kq)); }
                    else *(uint4*)&VM[((size_t)(b * MH + h) * SEQ + s) * MV + (d0 - MNOPE)] = o;
                } else if (col0 < 2944) {
                    const bool isq = col0 < 2816; const int hc = isq ? (col0 - 2304) : (col0 - 2816), h = hc >> 6, d0 = hc & 63;
                    float sq = 0.f;
#pragma unroll
                    for (int i = 0; i < 8; ++i) sq += v[i] * v[i];
                    sq += __shfl_xor(sq, 1); sq += __shfl_xor(sq, 2); sq += __shfl_xor(sq, 4);
                    const float rs = rsqrtf(sq * (1.f / GD) + EPS) * (isq ? C2G : 1.f); const float* gh = isq ? g_q_head : g_k_head;
                    uint4 o; unsigned ow[4];
#pragma unroll
                    for (int pq = 0; pq < 4; ++pq) { const int d = d0 + 2 * pq; const float cs = cosg[s * 32 + (d >> 1)], sn = sing[s * 32 + (d >> 1)];
                        const float x0 = v[2 * pq] * rs * gh[d], x1 = v[2 * pq + 1] * rs * gh[d + 1]; ow[pq] = pk2(x0 * cs - x1 * sn, x0 * sn + x1 * cs); }
                    o.x = ow[0]; o.y = ow[1]; o.z = ow[2]; o.w = ow[3];
                    if (isq) *(uint4*)&QG[((size_t)(b * GH + h) * SEQ + s) * GD + d0] = o;
                    else *(uint4*)&KG[((size_t)(b * GKV + h) * SEQ + s) * GD + d0] = o;
                } else {
                    const int hc = col0 - 2944, h = hc >> 6, d0 = hc & 63;
                    *(uint4*)&VG[((size_t)(b * GKV + h) * SEQ + s) * GD + d0] = raw[j];
                }
            }
        }
        __syncthreads();
        if (c.tid < 18) atomicMax(ctl + CW_KMAX + c.tid, kmaxL[c.tid]);
    }
    SEAM(3);

    if (IN(4)) for (int rep_ = 0; rep_ < (((REPEAT_MASK >> 4) & 1) ? 2 : 1); ++rep_) {
        const Ctx c = mkctx(ws, lds_raw); PHASE_PTRS
        att::ConvState cs;
        { const int e = (c.nb == NE) ? c.bid : 0;
          cs.cj = 0; cs.jbase = 384 * c.wave;
          cs.wg = (const char*)(w_gate_e + (size_t)e * DM * EFF); cs.wu = (const char*)(w_up_e + (size_t)e * DM * EFF); cs.wd = (const char*)(w_down_e + (size_t)e * EFF * DM);
          cs.dgu = (char*)(WGUT + (size_t)e * 512 * DM); cs.dd = (char*)(WDT + (size_t)e * DM * EFF);
          cs.ldsbuf = (unsigned)(uintptr_t)lds_raw + att::CONV_LDS + (CONV_MODE >= 5 ? 0 : c.wave * 4096); cs.rdbuf = (att::lds_cptr)lds_raw + att::CONV_LDS + (CONV_MODE >= 5 ? 0 : c.wave * 4096);
          if (CONV_MODE >= 5) cs.jbase = 0;
          if (CONV_MODE != 0 && CONV_MODE < 5) for (int i = 0; i < 3; ++i) { const att::ConvJob q = att::conv_job(cs, cs.cj);
              att::glds16_s(q.sbase, (unsigned)(c.lane >> 3) * q.ldwB + (unsigned)(c.lane & 7) * 16u, (unsigned)__builtin_amdgcn_readfirstlane(cs.ldsbuf + (cs.cj & 3) * 1024)); ++cs.cj; }
          asm volatile("s_waitcnt vmcnt(0)" ::: "memory"); }
        float mfix;
        { const float gq = wave_max(fabsf(g_q_head[c.lane])), gk = wave_max(fabsf(g_k_head[c.lane])); mfix = fminf(64.f * C2G * gq * gk * 1.03f + 0.5f, 60.f); }
        for (int uu = vcu; uu < 512; uu += c.nb) {
            const int bh = uu >> 5, b = bh >> 3, h = bh & 7, qp = uu & 31;
            const int q0 = qp * 256;
            const float kb2 = __builtin_bit_cast(float, ctl[CW_KMAX + b * 8 + h]) + __builtin_bit_cast(float, ctl[CW_KMAX + 16 + b]);
            att::unit96<8>(QM + (size_t)(b * MH + h) * SEQ * DQKM, KM + (size_t)(b * MH + h) * SEQ * DQKM, VM + (size_t)(b * MH + h) * SEQ * MV,
                                 O + ((size_t)b * SEQ + q0) * DM + h * 64, OSTAT + ((size_t)b * SEQ + q0) * 16 + h, q0, (char*)lds_raw, cs, kb2);
            att::unit64<8>(QG + (size_t)(b * GH + h) * SEQ * GD, KG + (size_t)(b * GKV + (h >> 2)) * SEQ * GD, VG + (size_t)(b * GKV + (h >> 2)) * SEQ * GD,
                                 O + ((size_t)b * SEQ + q0) * DM + (8 + h) * 64, OSTAT + ((size_t)b * SEQ + q0) * 16 + 8 + h, q0, (char*)lds_raw, cs, mfix);
        }
#if CONV_MODE >= 5
        {
            using namespace att;
            const int wid = c.wave, lane = c.lane; const bool rst = wid >= 6;
            for (int r4 = 0; r4 < 3; ++r4) { CONV_DRAIN(); ++cs.cj; }
        }
#endif
    }
    SEAM(4);

    if (IN(5)) for (int rep_ = 0; rep_ < (((REPEAT_MASK >> 5) & 1) ? 2 : 1); ++rep_) {
        const Ctx c = mkctx(ws, lds_raw); PHASE_PTRS
        pg8::DenseOrder S; S.init(NTOK, DM, DM, WOUTT, c.nb, c.bid);
        LAS float* rtab = (LAS float*)(ldsb + pg8::STAGE_BYTES);
        { pg8::Unit u0; if (S.next(0, u0) && c.tid < 256) { const float4* sp = (const float4*)&OSTAT[(size_t)(u0.pm * 256 + c.tid) * 16]; const float4 s0 = sp[0], s1 = sp[1], s2 = sp[2], s3 = sp[3];
            const float sm = ((s0.x + s0.y) + (s0.z + s0.w)) + ((s1.x + s1.y) + (s1.z + s1.w)), sg = ((s2.x + s2.y) + (s2.z + s2.w)) + ((s3.x + s3.y) + (s3.z + s3.w));
            const float rm = rsqrtf(sm * (1.f / 512) + EPS), rg = rsqrtf(sg * (1.f / 512) + EPS); rtab[2 * c.tid] = rm / rg; rtab[2 * c.tid + 1] = rg; }
          __syncthreads(); }
        pg8::EpiBf16RowScale E{MIXED, DM, rtab};
        pg8::gemm_phase<pg8::EpiBf16RowScale, pg8::DenseOrder, true, false, true>(ldsb, O, DM, S, E, nullptr);
    }
    SEAM(5);

    if (IN(6)) for (int rep_ = 0; rep_ < (((REPEAT_MASK >> 6) & 1) ? 2 : 1); ++rep_) {
        const Ctx c = mkctx(ws, lds_raw); PHASE_PTRS
        for (int m0 = c.gw; m0 < NTOK; m0 += 2 * c.ngw) {
            uint2 mu[2][4]; float4 xq[2][4];
#pragma unroll
            for (int q = 0; q < 2; ++q)
#pragma unroll
                for (int j = 0; j < 4; ++j) { const int m = m0 + q * c.ngw; mu[q][j] = *(const uint2*)&MIXED[(size_t)m * DM + 4 * c.lane + 256 * j]; xq[q][j] = *(const float4*)&x[(size_t)m * DM + 4 * c.lane + 256 * j]; }
#pragma unroll
            for (int q = 0; q < 2; ++q) {
                const int m = m0 + q * c.ngw; const int b = m / SEQ; const float* md = mod + b * 6144;
                float4 v[4], xr[4]; float ss = 0.f;
#pragma unroll
                for (int j = 0; j < 4; ++j) { const uint2 u = mu[q][j];
                    v[j].x = bf2f(u.x & 0xffffu); v[j].y = bf2f(u.x >> 16); v[j].z = bf2f(u.y & 0xffffu); v[j].w = bf2f(u.y >> 16);
                    ss += v[j].x * v[j].x + v[j].y * v[j].y + v[j].z * v[j].z + v[j].w * v[j].w; }
                const float rstd = rsqrtf(wave_sum(ss) * (1.f / DM) + EPS);
                float ss1 = 0.f;
#pragma unroll
                for (int j = 0; j < 4; ++j) {
                    const int cc = 4 * c.lane + 256 * j;
                    const float4 g = *(const float4*)&g_post_mix[cc], gt = *(const float4*)&md[2048 + cc], xx = xq[q][j];
                    xr[j].x = xx.x + gt.x * (v[j].x * rstd * g.x); xr[j].y = xx.y + gt.y * (v[j].y * rstd * g.y);
                    xr[j].z = xx.z + gt.z * (v[j].z * rstd * g.z); xr[j].w = xx.w + gt.w * (v[j].w * rstd * g.w);
                    ss1 += xr[j].x * xr[j].x + xr[j].y * xr[j].y + xr[j].z * xr[j].z + xr[j].w * xr[j].w;
                    { uint2 xo; xo.x = pk2(xr[j].x, xr[j].y); xo.y = pk2(xr[j].z, xr[j].w); *(uint2*)&X1[(size_t)m * DM + cc] = xo; }
                }
                const float rstd1 = rsqrtf(wave_sum(ss1) * (1.f / DM) + EPS);
#pragma unroll
                for (int j = 0; j < 4; ++j) {
                    const int cc = 4 * c.lane + 256 * j;
                    const float4 g = *(const float4*)&g_pre_ffn[cc], sc = *(const float4*)&md[4096 + cc], sh = *(const float4*)&md[3072 + cc];
                    uint2 pk;
                    pk.x = pk2(xr[j].x * rstd1 * g.x * (1.f + sc.x) + sh.x, xr[j].y * rstd1 * g.y * (1.f + sc.y) + sh.y);
                    pk.y = pk2(xr[j].z * rstd1 * g.z * (1.f + sc.z) + sh.z, xr[j].w * rstd1 * g.w * (1.f + sc.w) + sh.w);
                    *(uint2*)&H2[(size_t)m * DM + cc] = pk;
                }
            }
        }
    }
    SEAM(6);

    if (IN(7)) for (int rep_ = 0; rep_ < (((REPEAT_MASK >> 7) & 1) ? 2 : 1); ++rep_) {
        const Ctx c = mkctx(ws, lds_raw); PHASE_PTRS
        pg8::DenseOrder S; S.init(NTOK, 768, DM, WRST, c.nb, c.bid); pg8::EpiRS E{LOG, ACTS};
        pg8::gemm_phase<pg8::EpiRS, pg8::DenseOrder, true>(ldsb, H2, DM, S, E);
    }
    SEAM(7);

    if (IN(8)) for (int rep_ = 0; rep_ < (((REPEAT_MASK >> 8) & 1) ? 2 : 1); ++rep_) {
        const Ctx c = mkctx(ws, lds_raw); PHASE_PTRS
        const float4 bb = *(const float4*)&b_router[4 * c.lane];
        const unsigned rowL = (unsigned)(uintptr_t)lds_raw + c.wave * 8192;
        const LAS unsigned char* rowP = ldsb + c.wave * 8192;
        for (int mb = c.gw; mb < NTOK; mb += 8 * c.ngw) {
#pragma unroll
          for (int r = 0; r < 8; ++r) { const int mr = mb + r * c.ngw; if (mr < NTOK) att::glds16(LOG + (size_t)mr * NE + 4 * c.lane, (unsigned)__builtin_amdgcn_readfirstlane(rowL + r * 1024)); }
          asm volatile("s_waitcnt vmcnt(0)" ::: "memory");
          int my_e = 0; float my_s = 0.f; int rb = 0;
#pragma unroll 1
          for (int m = mb; m < NTOK && rb < 8; m += c.ngw) {
            typedef float f32x4v __attribute__((ext_vector_type(4)));
            const f32x4v lg = *(const LAS f32x4v*)(rowP + rb * 1024 + c.lane * 16);
            const float s0 = __builtin_amdgcn_rcpf(1.f + __builtin_amdgcn_exp2f(lg.x * -1.44269504f)), s1 = __builtin_amdgcn_rcpf(1.f + __builtin_amdgcn_exp2f(lg.y * -1.44269504f));
            const float s2 = __builtin_amdgcn_rcpf(1.f + __builtin_amdgcn_exp2f(lg.z * -1.44269504f)), s3 = __builtin_amdgcn_rcpf(1.f + __builtin_amdgcn_exp2f(lg.w * -1.44269504f));
            const int o0 = ford(s0 + bb.x), o1 = ford(s1 + bb.y), o2 = ford(s2 + bb.z), o3 = ford(s3 + bb.w);
            const int e0 = 4 * c.lane, g = c.lane >> 3;
            const int IMIN = (int)0x80000000;
            int gkey;
            {
                const int h01 = imax_(o0, o1), l01 = imin_(o0, o1), h23 = imax_(o2, o3), l23 = imin_(o2, o3);
                const int a1 = imax_(h01, h23), a2 = imax_(imin_(h01, h23), (h01 >= h23) ? l01 : l23);
                const int g1 = grp8_max_i(a1);
                const unsigned long long bm = __ballot(a1 == g1);
                const unsigned grpbits = (unsigned)(bm >> (8 * g)) & 0xffu;
                const bool first = (a1 == g1) && ((grpbits & ((1u << (c.lane & 7)) - 1u)) == 0u);
                const int g2 = grp8_max_i(first ? a2 : a1);
                gkey = (ford(funord(g1) + funord(g2)) & ~7) | (7 - g);
            }
            int rank = 0;
#pragma unroll
            for (int j = 0; j < 8; ++j) rank += (__builtin_amdgcn_readlane(gkey, 8 * j) > gkey) ? 1 : 0;
            const bool sel = rank < 4;
            int k0 = sel ? ((o0 & ~0xff) | (255 - e0)) : IMIN, k1 = sel ? ((o1 & ~0xff) | (254 - e0)) : IMIN, k2 = sel ? ((o2 & ~0xff) | (253 - e0)) : IMIN, k3 = sel ? ((o3 & ~0xff) | (252 - e0)) : IMIN;
            int my_key = 0;
#pragma unroll 1
            for (int rnd = 0; rnd < TOPK; ++rnd) {
                const int mx = wave_max_i(imax_(imax_(k0, k1), imax_(k2, k3)));
                if (c.lane == 8 * rb + rnd) my_key = mx;
                k0 = (k0 == mx) ? IMIN : k0; k1 = (k1 == mx) ? IMIN : k1; k2 = (k2 == mx) ? IMIN : k2; k3 = (k3 == mx) ? IMIN : k3;
            }
            {
                const int ee = 255 - (my_key & 0xff), src = (ee >> 2) * 4;
                const float q0 = __builtin_bit_cast(float, __builtin_amdgcn_ds_bpermute(src, __builtin_bit_cast(int, s0))), q1 = __builtin_bit_cast(float, __builtin_amdgcn_ds_bpermute(src, __builtin_bit_cast(int, s1)));
                const float q2 = __builtin_bit_cast(float, __builtin_amdgcn_ds_bpermute(src, __builtin_bit_cast(int, s2))), q3 = __builtin_bit_cast(float, __builtin_amdgcn_ds_bpermute(src, __builtin_bit_cast(int, s3)));
                if ((c.lane >> 3) == rb) { my_e = ee; my_s = (ee & 2) ? ((ee & 1) ? q3 : q2) : ((ee & 1) ? q1 : q0); }
            }
            ++rb;
          }
          { const int rr = c.lane >> 3, k = c.lane & 7;
            const float tot = grp8_sum(my_s);
            if (rr < rb) { const int id = (mb + rr * c.ngw) * TOPK + k;
                const unsigned pos = atomicAdd(&CNT[(size_t)my_e * CNT_STRIDE], 1u);
                LIST[(size_t)my_e * LCAP + pos] = id; POSREC[id] = (my_e << 16) | (int)pos; WTS[id] = my_s / tot * 2.5f; } }
        }
    }
    SEAM(8);

    LAS int* pre = (LAS int*)(ldsb + pg8::STAGE_BYTES);
    LAS int* offs = pre + 320; LAS int* cntl = offs + 320;
    if (IN(9) || IN(10) || IN(11)) {
        const Ctx c = mkctx(ws, lds_raw); PHASE_PTRS
        __syncthreads();
        if (c.tid < NE) cntl[c.tid] = (int)CNT[(size_t)c.tid * CNT_STRIDE];
        __syncthreads();
        if (c.tid <= NE) { int a = 0, o = 0; for (int j = 0; j < c.tid; ++j) { const int q = cntl[j]; a += (q + 255) >> 8; o += q; } pre[c.tid] = a; offs[c.tid] = o; }
        __syncthreads();
    }
    if (IN(9)) for (int rep_ = 0; rep_ < (((REPEAT_MASK >> 9) & 1) ? 2 : 1); ++rep_) {
        const Ctx c = mkctx(ws, lds_raw); PHASE_PTRS
        pg8::MoeOrder S{pre, offs, cntl, LIST, (const char*)WGUT, (size_t)512 * DM * 2, DM, 2, c.nb, vcu, 0};
        pg8::EpiAct E{ACT};
        pg8::gemm_phase<pg8::EpiAct, pg8::MoeOrder, true, true>(ldsb, H2, DM, S, E);
    }
    SEAM(9);

    if (IN(10)) for (int rep_ = 0; rep_ < (((REPEAT_MASK >> 10) & 1) ? 2 : 1); ++rep_) {
        const Ctx c = mkctx(ws, lds_raw); PHASE_PTRS
        { pg8::MoeOrder S{pre, offs, cntl, LIST, (const char*)WDT, (size_t)DM * EFF * 2, EFF, 4, c.nb, vcu, 1};
          pg8::EpiSlots E{(unsigned char*)SLOTS};
          pg8::gemm_phase<pg8::EpiSlots, pg8::MoeOrder, true>(ldsb, ACT, EFF, S, E); }
        { pg8::DenseOrder S; S.init(NTOK, DM, EFF, WDST, c.nb, c.bid); pg8::EpiBf16 E{YSH, DM};
          pg8::gemm_phase<pg8::EpiBf16, pg8::DenseOrder, true>(ldsb, ACTS, EFF, S, E); }
    }
    SEAM(10);

    if (IN(11)) for (int rep_ = 0; rep_ < (((REPEAT_MASK >> 11) & 1) ? 2 : 1); ++rep_) {
        const Ctx c = mkctx(ws, lds_raw); PHASE_PTRS
        const unsigned char* SL8 = (const unsigned char*)SLOTS;
        typedef float f32x2v __attribute__((ext_vector_type(2)));
        for (int m0 = c.gw; m0 < NTOK; m0 += 2 * c.ngw) {
            int srow[2][TOPK]; float swt[2][TOPK];
#pragma unroll
            for (int q = 0; q < 2; ++q)
#pragma unroll
                for (int k = 0; k < TOPK; ++k) { const int m = m0 + q * c.ngw; const int rec = POSREC[(size_t)m * TOPK + k]; srow[q][k] = offs[rec >> 16] + (rec & 0xffff); swt[q][k] = WTS[(size_t)m * TOPK + k] * (1.f / 16.f); }
#pragma unroll
            for (int q = 0; q < 2; ++q) {
                const int m = m0 + q * c.ngw; const int b = m / SEQ; const float* md = mod + b * 6144;
                const int cc = 16 * c.lane;
                float y[16]; float ss = 0.f;
#pragma unroll
                for (int hq = 0; hq < 2; ++hq) { const uint4 u = *(const uint4*)&YSH[(size_t)m * DM + cc + 8 * hq];
                    y[8 * hq + 0] = bf2f(u.x & 0xffffu); y[8 * hq + 1] = bf2f(u.x >> 16); y[8 * hq + 2] = bf2f(u.y & 0xffffu); y[8 * hq + 3] = bf2f(u.y >> 16);
                    y[8 * hq + 4] = bf2f(u.z & 0xffffu); y[8 * hq + 5] = bf2f(u.z >> 16); y[8 * hq + 6] = bf2f(u.w & 0xffffu); y[8 * hq + 7] = bf2f(u.w >> 16); }
#pragma unroll
                for (int k = 0; k < TOPK; ++k) { const uint4 u = *(const uint4*)&SL8[(size_t)srow[q][k] * DM + cc]; const float wk = swt[q][k];
                    const unsigned wds[4] = {u.x, u.y, u.z, u.w};
#pragma unroll
                    for (int d = 0; d < 4; ++d) { const f32x2v a = __builtin_amdgcn_cvt_pk_f32_fp8((int)wds[d], false), bb = __builtin_amdgcn_cvt_pk_f32_fp8((int)wds[d], true);
                        y[4 * d] += wk * a.x; y[4 * d + 1] += wk * a.y; y[4 * d + 2] += wk * bb.x; y[4 * d + 3] += wk * bb.y; } }
#pragma unroll
                for (int i = 0; i < 16; ++i) ss += y[i] * y[i];
                const float rstd = rsqrtf(wave_sum(ss) * (1.f / DM) + EPS);
#pragma unroll
                for (int hq = 0; hq < 4; ++hq) {
                    const int c4 = cc + 4 * hq;
                    const float4 g = *(const float4*)&g_post_ffn[c4], gt = *(const float4*)&md[5120 + c4]; const uint2 xu = *(const uint2*)&X1[(size_t)m * DM + c4];
                    float4 xx; xx.x = bf2f(xu.x & 0xffffu); xx.y = bf2f(xu.x >> 16); xx.z = bf2f(xu.y & 0xffffu); xx.w = bf2f(xu.y >> 16);
                    float4 r; r.x = xx.x + gt.x * (y[4 * hq] * rstd * g.x); r.y = xx.y + gt.y * (y[4 * hq + 1] * rstd * g.y);
                    r.z = xx.z + gt.z * (y[4 * hq + 2] * rstd * g.z); r.w = xx.w + gt.w * (y[4 * hq + 3] * rstd * g.w);
                    *(float4*)&args.out[(size_t)m * DM + c4] = r;
                }
            }
        }
    }
    }
#undef IN
#undef SEAM
}

constexpr int NPHASE = 12;

extern "C" void kernel_launch(void* const* d_in, const int* in_sizes, int n_in, void* d_out, int out_size, void* d_ws, size_t ws_size, hipStream_t stream) {
    static int grid = 0;
    if (grid == 0) {
        if (n_in != 26 || out_size != NTOK * DM || ws_size < WS_END) { fprintf(stderr, "kernel_launch: unexpected shapes (n_in %d, out %d, ws %zu)\n", n_in, out_size, ws_size); grid = -1; return; }
        int dev = 0, cus = 0, per_cu = 0;
        if (hipGetDevice(&dev) != hipSuccess || hipDeviceGetAttribute(&cus, hipDeviceAttributeMultiprocessorCount, dev) != hipSuccess) { grid = -1; return; }
        if (hipFuncSetAttribute((const void*)mega, hipFuncAttributeMaxDynamicSharedMemorySize, LDS_BYTES) != hipSuccess) { fprintf(stderr, "kernel_launch: hipFuncSetAttribute failed\n"); grid = -1; return; }
        if (hipOccupancyMaxActiveBlocksPerMultiprocessor(&per_cu, (const void*)mega, NTHR, LDS_BYTES) != hipSuccess || per_cu < 1) fprintf(stderr, "kernel_launch: occupancy query says %d\n", per_cu);
        (void)hipGetLastError();
        grid = cus;
    }
    if (grid < 0) return;
    (void)hipMemsetAsync((char*)d_ws + WS_CTL, 0, CTL_ZERO_BYTES, stream);
    Args a{};
    for (int i = 0; i < 26; ++i) a.in[i] = (const float*)d_in[i];
    a.out = (float*)d_out; a.ws = (unsigned char*)d_ws;
    if (MK_N_LAUNCHES == 1) { a.ph_lo = 0; a.ph_hi = NPHASE; hipLaunchKernelGGL(mega, dim3(grid), dim3(NTHR), LDS_BYTES, stream, a); }
    else for (int p = 0; p < NPHASE; ++p) { a.ph_lo = p; a.ph_hi = p + 1; hipLaunchKernelGGL(mega, dim3(grid), dim3(NTHR), LDS_BYTES, stream, a); }
}
```

```cpp
#include <hip/hip_runtime.h>
#include <cstdio>
#include <cstdint>

#ifndef REP_FROM
#define REP_FROM 99
#endif
#ifndef REPEAT_MASK
#define REPEAT_MASK 0
#endif
#ifndef CONV_MODE
#define CONV_MODE 5
#endif
#ifndef MK_N_LAUNCHES
#define MK_N_LAUNCHES 1
#endif

#ifndef ATTN_NAIVE
#define ATTN_NAIVE 0
#endif
#define LAS __attribute__((address_space(3)))
typedef unsigned short bf16_t;

constexpr int NB = 2, SEQ = 8192, NTOK = NB * SEQ, DM = 1024;
constexpr int QLORA = 256, KVLORA = 128, MROPE = 32, MNOPE = 64, MV = 64, MH = 8, DQKM = 96;
constexpr int GH = 8, GKV = 2, GD = 64;
constexpr int INC = 1184;
constexpr int C_QLAT = 0, C_KVLAT = 256, C_KROPE = 384, C_GQ = 416, C_GK = 928, C_GV = 1056;
constexpr int NE = 256, TOPK = 8, EFF = 256;
constexpr int LCAP = 16384;
constexpr float EPS = 1e-6f;
constexpr float LOG2E = 1.4426950408889634f;
constexpr float C2M = 0.10206207261596575f * LOG2E;
constexpr float C2G = 0.125f * LOG2E;

constexpr size_t MiB = 1u << 20;
constexpr size_t WS_CTL = 0, CTL_ZERO_BYTES = 32768;
constexpr size_t WS_MOD = 1 * MiB;
constexpr size_t WS_COSM = 2 * MiB, WS_SINM = 2 * MiB + 512 * 1024, WS_COSG = 3 * MiB, WS_SING = 4 * MiB;
constexpr size_t WS_WQBT = 5 * MiB;
constexpr size_t WS_WINQ = 5 * MiB + 512 * 1024;
constexpr size_t WS_WKVBT = 6 * MiB;
constexpr size_t WS_WINKV = 6 * MiB + 512 * 1024;
constexpr size_t WS_WDST = 7 * MiB;
constexpr size_t WS_H2 = 8 * MiB;
constexpr size_t WS_X1 = 40 * MiB;
constexpr size_t WS_CNTS = 72 * MiB;
constexpr int CNT_STRIDE = 1088;
constexpr size_t WS_HIST = 82 * MiB;
constexpr size_t WS_WTS = 104 * MiB;
constexpr size_t WS_OSTAT = 252 * MiB;
constexpr size_t WS_POSREC = 105 * MiB;
constexpr size_t WS_LIST = 106 * MiB;
constexpr size_t WS_WBIGT = 122 * MiB;
constexpr size_t WS_WOUTT = 128 * MiB;
constexpr size_t WS_WRST = 130 * MiB;
constexpr size_t WS_ACT = 132 * MiB;
constexpr size_t WS_LOG = 196 * MiB;
constexpr size_t WS_ACTS = 212 * MiB;
constexpr size_t WS_YSH = 220 * MiB;
constexpr size_t WS_SLOTS = 256 * MiB;
constexpr size_t WS_PBUF = 256 * MiB;
constexpr size_t WS_QM = 352 * MiB, WS_KM = 376 * MiB, WS_VM = 400 * MiB, WS_QG = 416 * MiB, WS_KG = 432 * MiB, WS_VG = 436 * MiB;
constexpr size_t WS_O = 440 * MiB;
constexpr size_t WS_MIXED = 472 * MiB;
constexpr size_t WS_WGUT = 512 * MiB;
constexpr size_t WS_WDT = 768 * MiB;
constexpr size_t WS_END = 896 * MiB;
constexpr size_t WS_HF = 512 * MiB, WS_PROJ = 576 * MiB, WS_H2F = 650 * MiB, WS_GS = 714 * MiB, WS_US = 730 * MiB, WS_ACTSF = 746 * MiB, WS_YSHF = 768 * MiB, WS_LOGF = 832 * MiB;
constexpr int CW_CNT = 1024;
constexpr int CW_KMAX = 2048;
constexpr int CW_BAR = 4096;

constexpr int LDS_BYTES = 147456;
constexpr int NTHR = 512, NWAVES = 8;

#define XB_TMO      128
#define XB_XCNT(j)  (256  + 64 * (j))
#define XB_XSUB(j)  (1280 + 64 * (j))
#define XB_XGEN(j)  (2304 + 64 * (j))
#define XB_TOP      3328
#define XB_TOPGEN   3392
#define XCD_BAR_WORDS 3456
#define XB_SPIN_CAP (1u << 18)
__device__ __forceinline__ unsigned xb_ld(unsigned* p)              { return __hip_atomic_load(p, __ATOMIC_RELAXED, __HIP_MEMORY_SCOPE_AGENT); }
__device__ __forceinline__ unsigned xb_add(unsigned* p, unsigned v) { return __hip_atomic_fetch_add(p, v, __ATOMIC_RELAXED, __HIP_MEMORY_SCOPE_AGENT); }
__device__ __forceinline__ unsigned xb_xcc_id() { return (unsigned)__builtin_amdgcn_s_getreg((3 << 11) | 20) & 0xFu; }
#define XB_SPIN(cond, bar) do { unsigned _sp = 0; while (cond) { __builtin_amdgcn_s_sleep(1); \
    if ((++_sp & 255u) == 0u) { if (xb_ld(&(bar)[XB_TMO])) break; if (_sp > XB_SPIN_CAP) { atomicAdd(&(bar)[XB_TMO], 1u); break; } } } } while (0)
struct XcdBarrier { unsigned* bar; unsigned x; volatile LAS unsigned* st; };
__device__ __forceinline__ XcdBarrier xcd_barrier_post(unsigned* bar, volatile LAS unsigned* st) {
    XcdBarrier b; b.bar = bar; b.x = xb_xcc_id(); b.st = st;
    if (threadIdx.x == 0) (void)xb_add(&bar[XB_XCNT(b.x)], 1u);
    return b;
}
__device__ __forceinline__ void xcd_barrier_complete(unsigned* bar, unsigned x, unsigned& nloc, unsigned& nx) {
    const unsigned G = gridDim.x * gridDim.y * gridDim.z;
    unsigned sum, cnt, mine, sp = 0u;
    for (;;) {
        sum = 0u; cnt = 0u; mine = 0u;
#pragma unroll
        for (unsigned j = 0; j < 16; ++j) { const unsigned c = xb_ld(&bar[XB_XCNT(j)]); sum += c; cnt += (c > 0u) ? 1u : 0u; mine = (j == x) ? c : mine; }
        if (sum == G) break;
        __builtin_amdgcn_s_sleep(1);
        if ((++sp & 255u) == 0u) { if (xb_ld(&bar[XB_TMO])) break; if (sp > XB_SPIN_CAP) { atomicAdd(&bar[XB_TMO], 1u); break; } }
    }
    nloc = mine > 0u ? mine : 1u; nx = cnt > 0u ? cnt : 1u;
}
__device__ __forceinline__ void xcd_barrier(const XcdBarrier& b) {
    asm volatile("s_waitcnt vmcnt(0)" ::: "memory");
    __syncthreads();
    if (threadIdx.x == 0) {
        unsigned* bar = b.bar;
        __builtin_amdgcn_s_waitcnt(0);
        unsigned nloc = b.st[0], nx = b.st[1];
        if (nloc == 0u) { xcd_barrier_complete(bar, b.x, nloc, nx); b.st[0] = nloc; b.st[1] = nx; }
        const unsigned old = xb_add(&bar[XB_XSUB(b.x)], 1u);
        const unsigned gen = old / nloc;
        if (old + 1u == (gen + 1u) * nloc) {
            __builtin_amdgcn_fence(__ATOMIC_RELEASE, "agent");
            asm volatile("s_waitcnt vmcnt(0)" ::: "memory");
            const unsigned og = xb_add(&bar[XB_TOP], 1u);
            const unsigned tg = og / nx;
            if (og + 1u == (tg + 1u) * nx) xb_add(&bar[XB_TOPGEN], 1u);
            else XB_SPIN(xb_ld(&bar[XB_TOPGEN]) == tg, bar);
            __builtin_amdgcn_fence(__ATOMIC_ACQUIRE, "agent");
            xb_add(&bar[XB_XGEN(b.x)], 1u);
            asm volatile("s_waitcnt vmcnt(0)" ::: "memory");
        } else {
            XB_SPIN(xb_ld(&bar[XB_XGEN(b.x)]) == gen, bar);
            __builtin_amdgcn_fence(__ATOMIC_ACQUIRE, "agent");
            asm volatile("s_waitcnt vmcnt(0)" ::: "memory");
        }
    }
    __syncthreads();
}

__device__ __forceinline__ unsigned f2bf(float f) { unsigned u = __builtin_bit_cast(unsigned, f); return (u + 0x7fffu + ((u >> 16) & 1u)) >> 16; }
__device__ __forceinline__ float bf2f(unsigned h) { return __builtin_bit_cast(float, h << 16); }
__device__ __forceinline__ unsigned pk2(float lo, float hi) { return f2bf(lo) | (f2bf(hi) << 16); }
template <int CTRL, int RM> __device__ __forceinline__ float dppmov(float old, float v) {
    return __builtin_bit_cast(float, __builtin_amdgcn_update_dpp(__builtin_bit_cast(int, old), __builtin_bit_cast(int, v), CTRL, RM, 0xF, false)); }
__device__ __forceinline__ float wave_sum(float v) {
    v += dppmov<0xB1, 0xF>(0.f, v);
    v += dppmov<0x4E, 0xF>(0.f, v);
    v += dppmov<0x141, 0xF>(0.f, v);
    v += dppmov<0x140, 0xF>(0.f, v);
    v += dppmov<0x142, 0xA>(0.f, v);
    v += dppmov<0x143, 0xC>(0.f, v);
    return __builtin_bit_cast(float, __builtin_amdgcn_readlane(__builtin_bit_cast(int, v), 63));
}
__device__ __forceinline__ float wave_max(float v) {
    const float NI = -INFINITY;
    v = fmaxf(v, dppmov<0xB1, 0xF>(NI, v)); v = fmaxf(v, dppmov<0x4E, 0xF>(NI, v)); v = fmaxf(v, dppmov<0x141, 0xF>(NI, v)); v = fmaxf(v, dppmov<0x140, 0xF>(NI, v));
    v = fmaxf(v, dppmov<0x142, 0xA>(NI, v)); v = fmaxf(v, dppmov<0x143, 0xC>(NI, v));
    return __builtin_bit_cast(float, __builtin_amdgcn_readlane(__builtin_bit_cast(int, v), 63));
}
template <int CTRL, int RM> __device__ __forceinline__ int dppmovi(int old, int v) { return __builtin_amdgcn_update_dpp(old, v, CTRL, RM, 0xF, false); }
__device__ __forceinline__ int imax_(int a, int b) { return a > b ? a : b; }
__device__ __forceinline__ int imin_(int a, int b) { return a < b ? a : b; }
__device__ __forceinline__ int wave_max_i(int v) {
    const int NI = (int)0x80000000;
    v = imax_(v, dppmovi<0xB1, 0xF>(NI, v)); v = imax_(v, dppmovi<0x4E, 0xF>(NI, v)); v = imax_(v, dppmovi<0x141, 0xF>(NI, v)); v = imax_(v, dppmovi<0x140, 0xF>(NI, v));
    v = imax_(v, dppmovi<0x142, 0xA>(NI, v)); v = imax_(v, dppmovi<0x143, 0xC>(NI, v));
    return __builtin_amdgcn_readlane(v, 63);
}
__device__ __forceinline__ int grp8_max_i(int v) {
    const int NI = (int)0x80000000;
    v = imax_(v, dppmovi<0xB1, 0xF>(NI, v)); v = imax_(v, dppmovi<0x4E, 0xF>(NI, v)); v = imax_(v, dppmovi<0x141, 0xF>(NI, v)); return v;
}
__device__ __forceinline__ int ford(float f) { const int b = __builtin_bit_cast(int, f); return b ^ ((b >> 31) & 0x7fffffff); }
__device__ __forceinline__ float funord(int k) { return __builtin_bit_cast(float, k ^ ((k >> 31) & 0x7fffffff)); }
__device__ __forceinline__ float grp8_sum(float v) {
    v += dppmov<0xB1, 0xF>(0.f, v); v += dppmov<0x4E, 0xF>(0.f, v); v += dppmov<0x141, 0xF>(0.f, v); return v;
}
__device__ __forceinline__ float grp8_max(float v) {
    const float NI = -INFINITY;
    v = fmaxf(v, dppmov<0xB1, 0xF>(NI, v)); v = fmaxf(v, dppmov<0x4E, 0xF>(NI, v)); v = fmaxf(v, dppmov<0x141, 0xF>(NI, v)); return v;
}
__device__ __forceinline__ float sigmoidf_(float x) { return 1.f / (1.f + __expf(-x)); }

struct Args { const float* in[26]; float* out; unsigned char* ws; int ph_lo, ph_hi; };

struct Ctx {
    int tid, lane, wave, bid, nb, gw, ngw;
    unsigned char* ws; float* lds;
};
__device__ __forceinline__ Ctx mkctx(unsigned char* ws, unsigned char* lds_raw) {
    Ctx c; int t = threadIdx.x; asm volatile("" : "+v"(t));
    c.tid = t; c.lane = t & 63; c.wave = __builtin_amdgcn_readfirstlane(t >> 6);
    c.bid = blockIdx.x; c.nb = gridDim.x; c.gw = c.bid * NWAVES + c.wave; c.ngw = c.nb * NWAVES; c.ws = ws; c.lds = (float*)lds_raw; return c;
}

namespace att {
using bf16x8 = __attribute__((ext_vector_type(8))) short;
using s16x4 = __attribute__((ext_vector_type(4))) short;
using f32x16 = __attribute__((ext_vector_type(16))) float;
using u32x4 = __attribute__((ext_vector_type(4))) unsigned;
typedef float f32x2_t __attribute__((ext_vector_type(2))); typedef __bf16 bf16x2_t __attribute__((ext_vector_type(2)));
typedef __attribute__((address_space(3))) const char* lds_cptr;
typedef short v4i16_t __attribute__((ext_vector_type(4)));
constexpr int NT = SEQ / 64;
constexpr int KSLOT = 12288, VSLOT = 8192, NSLOT = 3;
constexpr int LDS_K = 0, LDS_V = NSLOT * KSLOT, LDS_WS = LDS_V + NSLOT * VSLOT, LDS_OST = LDS_WS + NWAVES * 256, LDS_ATT = LDS_OST + NWAVES * 4096;
#define SBAR() __builtin_amdgcn_sched_barrier(0)
#define MFMA(a, b, c) __builtin_amdgcn_mfma_f32_32x32x16_bf16(a, b, c, 0, 0, 0)
__device__ __forceinline__ int crow(int r, int hi) { return (r & 3) + 8 * (r >> 2) + 4 * hi; }
__device__ __forceinline__ unsigned cvtpk_s(float lo, float hi) { f32x2_t v = {lo, hi}; bf16x2_t b = __builtin_convertvector(v, bf16x2_t); return __builtin_bit_cast(unsigned, b); }
__device__ __forceinline__ void glds16(const void* g, unsigned lds_base) {
    unsigned sv; asm volatile("s_mov_b32 %0, m0\n\ts_mov_b32 m0, %2\n\ts_nop 0\n\tglobal_load_lds_dwordx4 %1, off\n\ts_mov_b32 m0, %0" : "=&s"(sv) : "v"(g), "s"(lds_base) : "memory"); }
__device__ __forceinline__ s16x4 vtr(lds_cptr p) { return __builtin_bit_cast(s16x4, __builtin_amdgcn_ds_read_tr16_b64_v4i16((__attribute__((address_space(3))) v4i16_t*)p)); }
#define MX3(a, b, c) __builtin_fmaxf(__builtin_fmaxf((a), (b)), (c))
__device__ __forceinline__ float rowmax(const f32x16& p0, const f32x16& p1) {
    float a = MX3(p0[0], p0[1], p1[0]), b = MX3(p0[2], p0[3], p1[1]); a = MX3(a, p1[2], p1[3]);
#pragma unroll
    for (int r = 4; r < 16; r += 4) { a = MX3(a, p0[r], p0[r + 1]); b = MX3(b, p0[r + 2], p0[r + 3]); a = MX3(a, p1[r], p1[r + 1]); b = MX3(b, p1[r + 2], p1[r + 3]); }
    float m = __builtin_fmaxf(a, b); auto rr = __builtin_amdgcn_permlane32_swap(__float_as_uint(m), __float_as_uint(m), false, false);
    return __builtin_fmaxf(__uint_as_float(rr[0]), __uint_as_float(rr[1])); }

template <int DQK>
__device__ __forceinline__ void unit_simple(const bf16_t* Qh, const bf16_t* __restrict__ Kh, const bf16_t* __restrict__ Vh, bf16_t* Ob, int q0, char* shm) {
    constexpr int NCH = DQK / 8, ND0 = DQK / 16;
    int tid_ = threadIdx.x; asm volatile("" : "+v"(tid_));
    const int tid = tid_, lane = tid & 63, r32 = lane & 31, hi = lane >> 5; const int wid = __builtin_amdgcn_readfirstlane(tid >> 6);
    const bf16_t* Qw = Qh + (size_t)(q0 + wid * 32) * DQK;
    const unsigned lds0 = (unsigned)(uintptr_t)shm; float* wsf = (float*)(shm + LDS_WS) + wid * 64;
    const bf16_t* ksrc0 = Kh + (size_t)lane * DQK + wid * 8;
    const bf16_t* ksrc1 = Kh + (size_t)lane * DQK + (8 + (wid & 3)) * 8;
    const bf16_t* vsrc = Vh + (size_t)(16 * (wid & 3) + (lane >> 2)) * 64 + (wid >> 2) * 32 + (lane & 3) * 8;
    const unsigned kdst0 = lds0 + LDS_K + wid * 1024, kdst1 = lds0 + LDS_K + (8 + (wid & 3)) * 1024, vdst = lds0 + LDS_V + wid * 1024;
#define DMA_KV(t, sl) do { glds16(ksrc0 + (size_t)(t) * 64 * DQK, (unsigned)__builtin_amdgcn_readfirstlane(kdst0 + (sl) * KSLOT)); \
        if (NCH == 12 && wid < 4) glds16(ksrc1 + (size_t)(t) * 64 * DQK, (unsigned)__builtin_amdgcn_readfirstlane(kdst1 + (sl) * KSLOT)); \
        glds16(vsrc + (size_t)(t) * 64 * 64, (unsigned)__builtin_amdgcn_readfirstlane(vdst + (sl) * VSLOT)); } while (0)
    const lds_cptr shm3 = (lds_cptr)shm;
    const lds_cptr vp0 = shm3 + LDS_V + ((lane >> 4) & 1) * 32 + (lane & 3) * 8 + (4 * hi + ((lane & 15) >> 2)) * 64;
    const lds_cptr kp0 = shm3 + LDS_K + hi * 1024 + r32 * 16;
    DMA_KV(0, 0);
    bf16x8 qr[ND0];
#pragma unroll
    for (int d0 = 0; d0 < ND0; ++d0) qr[d0] = *reinterpret_cast<const bf16x8*>(&Qw[(size_t)r32 * DQK + d0 * 16 + hi * 8]);
    float mhat = -INFINITY, l_reg = 0.f; f32x16 o[2]; o[0] = f32x16{}; o[1] = f32x16{};
    asm volatile("s_waitcnt vmcnt(0) lgkmcnt(0)\n\ts_barrier" ::: "memory");
    for (int t = 0; t < NT; ++t) {
        const int sl = t & 1;
        if (t + 1 < NT) DMA_KV(t + 1, sl ^ 1);
        f32x16 p0 = f32x16{}, p1 = f32x16{};
        const lds_cptr kp = kp0 + sl * KSLOT;
#pragma unroll
        for (int d0 = 0; d0 < ND0; ++d0) {
            const bf16x8 b0 = *(const __attribute__((address_space(3))) bf16x8*)(kp + d0 * 2048);
            const bf16x8 b1 = *(const __attribute__((address_space(3))) bf16x8*)(kp + d0 * 2048 + 512);
            p0 = MFMA(b0, qr[d0], p0); p1 = MFMA(b1, qr[d0], p1);
        }
        const float rm = rowmax(p0, p1);
        const float mn = __builtin_fmaxf(mhat, rm), f = __builtin_amdgcn_exp2f(mhat - mn); mhat = mn;
        float sacc = 0.f;
#pragma unroll
        for (int r = 0; r < 16; ++r) { p0[r] = __builtin_amdgcn_exp2f(p0[r] - mn); p1[r] = __builtin_amdgcn_exp2f(p1[r] - mn); sacc += p0[r] + p1[r]; }
        l_reg = l_reg * f + sacc;
        if (hi == 0) wsf[r32] = f;
        asm volatile("s_waitcnt lgkmcnt(0)" ::: "memory");
#pragma unroll
        for (int d_ = 0; d_ < 2; ++d_)
#pragma unroll
            for (int r = 0; r < 16; ++r) o[d_][r] *= wsf[crow(r, hi)];
        u32x4 pw[4];
#pragma unroll
        for (int i = 0; i < 4; ++i) { pw[0][i] = cvtpk_s(p0[2 * i], p0[2 * i + 1]); pw[1][i] = cvtpk_s(p0[8 + 2 * i], p0[8 + 2 * i + 1]); pw[2][i] = cvtpk_s(p1[2 * i], p1[2 * i + 1]); pw[3][i] = cvtpk_s(p1[8 + 2 * i], p1[8 + 2 * i + 1]); }
        const lds_cptr vp_ = vp0 + sl * VSLOT;
#pragma unroll
        for (int d0 = 0; d0 < 2; ++d0)
#pragma unroll
            for (int ks = 0; ks < 4; ++ks) {
                const s16x4 lo = vtr(vp_ + d0 * 4096 + ks * 1024), hh = vtr(vp_ + d0 * 4096 + ks * 1024 + 512);
                const bf16x8 vf = (bf16x8){lo[0], lo[1], lo[2], lo[3], hh[0], hh[1], hh[2], hh[3]};
                o[d0] = MFMA(__builtin_bit_cast(bf16x8, pw[ks]), vf, o[d0]);
            }
        asm volatile("s_waitcnt vmcnt(0) lgkmcnt(0)\n\ts_barrier" ::: "memory");
    }
#undef DMA_KV
    { auto rr = __builtin_amdgcn_permlane32_swap(__float_as_uint(l_reg), __float_as_uint(l_reg), false, false); l_reg = __uint_as_float(rr[0]) + __uint_as_float(rr[1]); }
    if (hi == 0) wsf[32 + r32] = l_reg; asm volatile("s_waitcnt lgkmcnt(0)" ::: "memory");
    float rli[16];
#pragma unroll
    for (int r = 0; r < 16; ++r) rli[r] = __builtin_amdgcn_rcpf(wsf[32 + crow(r, hi)]);
    bf16_t* Ow = Ob + (size_t)(wid * 32) * DM; bf16_t* stg = (bf16_t*)(shm + LDS_OST) + wid * 2048;
#pragma unroll
    for (int r = 0; r < 16; ++r) { const int orow = crow(r, hi);
#pragma unroll
        for (int d0 = 0; d0 < 2; ++d0) stg[orow * 64 + d0 * 32 + r32] = (bf16_t)f2bf(o[d0][r] * rli[r]); }
    asm volatile("s_waitcnt lgkmcnt(0)" ::: "memory");
#pragma unroll
    for (int i = 0; i < 4; ++i) { const int row = i * 8 + (lane >> 3), ch = lane & 7; *(u32x4*)(Ow + (size_t)row * DM + ch * 8) = *(const u32x4*)(stg + row * 64 + ch * 8); }
    asm volatile("s_waitcnt vmcnt(0) lgkmcnt(0)\n\ts_barrier" ::: "memory");
}

constexpr int CONV_LDS = 112640;
struct ConvState { int cj, jbase; const char* wg; const char* wu; const char* wd; char* dgu; char* dd; unsigned ldsbuf; lds_cptr rdbuf; };
struct ConvJob { const char* sbase; char* dbase; unsigned ldwB, KdB; };
__device__ __forceinline__ ConvJob conv_job(const ConvState& cs, int j) {
    const int J = (CONV_MODE >= 5) ? j : cs.jbase + (j < 383 ? j : 383); const int m = J >> 10, r = J & 1023; ConvJob q;
    if (m < 2) { const int g = r >> 7, kg = r & 127; const int drow0 = ((g < 4) ? g * 32 : 256 + (g - 4) * 32) + m * 128;
        q.sbase = (m ? cs.wu : cs.wg) + (size_t)((8 * kg) * EFF + g * 32) * 4; q.ldwB = EFF * 4; q.dbase = cs.dgu + (size_t)(drow0 * DM + 8 * kg) * 2; q.KdB = DM * 2; }
    else { const int g = r >> 5, kg = r & 31;
        q.sbase = cs.wd + (size_t)((8 * kg) * DM + g * 32) * 4; q.ldwB = DM * 4; q.dbase = cs.dd + (size_t)((g * 32) * EFF + 8 * kg) * 2; q.KdB = EFF * 2; }
    return q;
}
__device__ __forceinline__ void glds16_s(const char* sbase, unsigned voff, unsigned lds_base) {
    unsigned sv; asm volatile("s_mov_b32 %0, m0\n\ts_mov_b32 m0, %3\n\ts_nop 4\n\tglobal_load_lds_dwordx4 %1, %2\n\ts_mov_b32 m0, %0" : "=&s"(sv) : "v"(voff), "s"(sbase), "s"(lds_base) : "memory"); }
#if CONV_MODE == 1 || CONV_MODE == 3 || CONV_MODE == 4 || CONV_MODE >= 5
#define CONV_DRAIN() do { const int jd_ = cs.cj - 3; const ConvJob q_ = conv_job(cs, jd_); \
        const __attribute__((address_space(3))) float* bp_ = (const __attribute__((address_space(3))) float*)(cs.rdbuf + (jd_ & 3) * 1024) + (lane >> 5) * 128 + (lane & 31); \
        uint2 w_; w_.x = cvtpk_s(bp_[0], bp_[32]); w_.y = cvtpk_s(bp_[64], bp_[96]); \
        if (CONV_MODE == 1) *(uint2*)(q_.dbase + (size_t)((unsigned)(lane & 31) * q_.KdB + (unsigned)(lane >> 5) * 8u)) = w_; \
        else if (CONV_MODE == 4) *(uint2*)(cs.dgu + 0x30000000ull + (size_t)((unsigned)(lane & 31) * 2048u + (unsigned)(lane >> 5) * 8u + (unsigned)(jd_ & 127) * 16u)) = w_; \
        else asm volatile("" :: "v"(w_)); } while (0)
#else
#define CONV_DRAIN() do { } while (0)
#endif
#if CONV_MODE >= 5
#undef CONV_DRAIN
#define CONV_NSTEP 384
#define CONV_DRAIN() do { if (CONV_MODE == 5 && rst && cs.cj >= 3 && cs.cj < CONV_NSTEP + 3) { const int jb_ = 8 * (cs.cj - 3) + 4 * (wid - 6); const ConvJob q_ = conv_job(cs, jb_); \
          \
        const __attribute__((address_space(3))) float* bp_ = (const __attribute__((address_space(3))) float*)(cs.rdbuf + (jb_ & 31) * 1024) + (lane >> 5) * 512 + (lane & 31); \
        float v_[16]; \
        _Pragma("unroll") for (int i_ = 0; i_ < 16; ++i_) v_[i_] = bp_[i_ * 32]; \
        char* dp_ = q_.dbase + (size_t)((unsigned)(lane & 31) * q_.KdB + (unsigned)(lane >> 5) * 32u); \
        _Pragma("unroll") for (int i_ = 0; i_ < 2; ++i_) { uint4 w_; w_.x = cvtpk_s(v_[8 * i_], v_[8 * i_ + 1]); w_.y = cvtpk_s(v_[8 * i_ + 2], v_[8 * i_ + 3]); \
            w_.z = cvtpk_s(v_[8 * i_ + 4], v_[8 * i_ + 5]); w_.w = cvtpk_s(v_[8 * i_ + 6], v_[8 * i_ + 7]); *(uint4*)(dp_ + 16 * i_) = w_; } } } while (0)
#define CONV_ISSUE() do { if (CONV_MODE != 6 && rcl && cs.cj < CONV_NSTEP) { const int jb_ = 8 * cs.cj + 4 * (wid - 4); const ConvJob q_ = conv_job(cs, jb_); \
        const unsigned vo_ = (unsigned)(lane >> 3) * q_.ldwB + (unsigned)(lane & 7) * 16u; const unsigned lb_ = (unsigned)__builtin_amdgcn_readfirstlane(cs.ldsbuf + (jb_ & 31) * 1024); \
        glds16_s(q_.sbase, vo_, lb_); glds16_s(q_.sbase + (size_t)8 * q_.ldwB, vo_, lb_ + 1024); glds16_s(q_.sbase + (size_t)16 * q_.ldwB, vo_, lb_ + 2048); glds16_s(q_.sbase + (size_t)24 * q_.ldwB, vo_, lb_ + 3072); } \
        ++cs.cj; } while (0)
#define WAIT_BARL() asm volatile("s_waitcnt lgkmcnt(0)\n\ts_barrier" ::: "memory")
#define RWAIT(N) do { if (rkv) { WAIT_BAR(N); } else if (rcl) { WAIT_BAR(8); } else { WAIT_BARL(); } } while (0)
#elif CONV_MODE != 0
#define CONV_ISSUE() do { const ConvJob q_ = conv_job(cs, cs.cj); \
        glds16_s(q_.sbase, (unsigned)(lane >> 3) * q_.ldwB + (unsigned)(lane & 7) * 16u, (unsigned)__builtin_amdgcn_readfirstlane(cs.ldsbuf + (cs.cj & 3) * 1024)); ++cs.cj; } while (0)
#define WB_P() WAIT_BAR(3)
#define WB_S() WAIT_BAR(4)
#define WB_E1() WAIT_BAR(3)
#define WB_E0() WAIT_BAR(1)
#define WB_PL() WAIT_BAR(4)
#define WB_SL() WAIT_BAR(5)
#else
#define CONV_ISSUE() do { } while (0)
#define WB_P() WAIT_BAR(2)
#define WB_S() WAIT_BAR(2)
#define WB_E1() WAIT_BAR(1)
#define WB_E0() WAIT_BAR(0)
#define WB_PL() WAIT_BAR(3)
#define WB_SL() WAIT_BAR(3)
#endif

constexpr int T_SLOTB = 8192, T_LDS_K = 0, T_LDS_V = 3 * T_SLOTB, T_LDS_WS = 6 * T_SLOTB, T_LDS_OST = T_LDS_WS + NWAVES * 256;
#define WAIT_BAR(N) asm volatile("s_waitcnt vmcnt(" #N ") lgkmcnt(0)\n\ts_barrier" ::: "memory")
__device__ __forceinline__ float max3f(float a, float b, float c) { float r; asm("v_max3_f32 %0, %1, %2, %3" : "=v"(r) : "v"(a), "v"(b), "v"(c)); return r; }
__device__ __forceinline__ float max2f(float a, float b) { float r; asm("v_max_f32_e32 %0, %1, %2" : "=v"(r) : "v"(a), "v"(b)); return r; }
__device__ __forceinline__ float fadd_s(float a, float b) { float r; asm("v_add_f32_e32 %0, %1, %2" : "=v"(r) : "v"(a), "v"(b)); return r; }
__device__ __forceinline__ float fsub_s(float a, float b) { float r; asm("v_sub_f32_e32 %0, %1, %2" : "=v"(r) : "v"(a), "v"(b)); return r; }
__device__ __forceinline__ float rowmax_asm(const f32x16& p0, const f32x16& p1) {
    float a = max3f(p0[0], p0[1], p1[0]), b = max3f(p0[2], p0[3], p1[1]); a = max3f(a, p1[2], p1[3]);
#pragma unroll
    for (int r = 4; r < 16; r += 4) { a = max3f(a, p0[r], p0[r + 1]); b = max3f(b, p0[r + 2], p0[r + 3]); a = max3f(a, p1[r], p1[r + 1]); b = max3f(b, p1[r + 2], p1[r + 3]); }
    const float m = max2f(a, b);
    auto rr = __builtin_amdgcn_permlane32_swap(__float_as_uint(m), __float_as_uint(m), false, false);
    return max2f(__uint_as_float(rr[0]), __uint_as_float(rr[1]));
}
__device__ __forceinline__ void kload8(bf16x8* kf, lds_cptr kp) {
    kf[0] = *(const __attribute__((address_space(3))) bf16x8*)(kp);        kf[1] = *(const __attribute__((address_space(3))) bf16x8*)(kp + 512);
    kf[2] = *(const __attribute__((address_space(3))) bf16x8*)(kp + 2048); kf[3] = *(const __attribute__((address_space(3))) bf16x8*)(kp + 2560);
    kf[4] = *(const __attribute__((address_space(3))) bf16x8*)(kp + 4096); kf[5] = *(const __attribute__((address_space(3))) bf16x8*)(kp + 4608);
    kf[6] = *(const __attribute__((address_space(3))) bf16x8*)(kp + 6144); kf[7] = *(const __attribute__((address_space(3))) bf16x8*)(kp + 6656);
}
__device__ __forceinline__ void kload2(bf16x8* kf, lds_cptr kp, int j) { kf[2 * j] = *(const __attribute__((address_space(3))) bf16x8*)(kp + j * 2048); kf[2 * j + 1] = *(const __attribute__((address_space(3))) bf16x8*)(kp + j * 2048 + 512); }

template <int THRL>
__device__ __forceinline__ void unit64(const bf16_t* Qh, const bf16_t* __restrict__ Kh, const bf16_t* __restrict__ Vh, bf16_t* Ob, float* ostat, int q0, char* shm, ConvState& cs, float mfix) {
    constexpr int DQ = 64;
    int tid_ = threadIdx.x; asm volatile("" : "+v"(tid_));
    const int tid = tid_, lane = tid & 63, r32 = lane & 31, hi = lane >> 5; const int wid = __builtin_amdgcn_readfirstlane(tid >> 6);
    const bf16_t* Qw = Qh + (size_t)(q0 + wid * 32) * DQ;
    const unsigned lds0 = (unsigned)(uintptr_t)shm;
    float* wsf = (float*)(shm + T_LDS_WS) + wid * 64;
#if CONV_MODE >= 5
    const bool rkv = wid < 4, rcl = (wid == 4 || wid == 5), rst = wid >= 6; const int pw = wid & 3;
    const bf16_t* ksrc = Kh + (size_t)lane * DQ + pw * 8;
    const bf16_t* vsrc = Vh + (size_t)(16 * pw + (lane >> 2)) * 64 + (lane & 3) * 8;
    const unsigned kdst = lds0 + T_LDS_K + pw * 1024, vdst = lds0 + T_LDS_V + pw * 1024;
#define DMA_K(t, slot) do { if (rkv) { glds16(ksrc + (size_t)(t) * 64 * DQ, (unsigned)__builtin_amdgcn_readfirstlane(kdst + (slot))); \
        glds16(ksrc + 32 + (size_t)(t) * 64 * DQ, (unsigned)__builtin_amdgcn_readfirstlane(kdst + 4096 + (slot))); } } while (0)
#define DMA_V(t, slot) do { if (rkv) { glds16(vsrc + (size_t)(t) * 64 * 64, (unsigned)__builtin_amdgcn_readfirstlane(vdst + (slot))); \
        glds16(vsrc + 32 + (size_t)(t) * 64 * 64, (unsigned)__builtin_amdgcn_readfirstlane(vdst + 4096 + (slot))); } } while (0)
#define WB_P() RWAIT(4)
#define WB_S() RWAIT(4)
#define WB_E1() RWAIT(2)
#define WB_E0() RWAIT(0)
#else
    const bf16_t* ksrc = Kh + (size_t)lane * DQ + wid * 8;
    const bf16_t* vsrc = Vh + (size_t)(16 * (wid & 3) + (lane >> 2)) * 64 + (wid >> 2) * 32 + (lane & 3) * 8;
    const unsigned kdst = lds0 + T_LDS_K + wid * 1024, vdst = lds0 + T_LDS_V + wid * 1024;
#define DMA_K(t, slot) glds16(ksrc + (size_t)(t) * 64 * DQ, (unsigned)__builtin_amdgcn_readfirstlane(kdst + (slot)))
#define DMA_V(t, slot) glds16(vsrc + (size_t)(t) * 64 * 64, (unsigned)__builtin_amdgcn_readfirstlane(vdst + (slot)))
#endif
    const int vb0 = (int)(lds0 + T_LDS_V) + ((lane >> 4) & 1) * 32 + (lane & 3) * 8 + (4 * hi + ((lane & 15) >> 2)) * 64;
    bf16x8 kf[8];
    const lds_cptr shm3 = (lds_cptr)shm; const lds_cptr kp0 = shm3 + T_LDS_K + hi * 1024 + r32 * 16;
    const lds_cptr vp0 = shm3 + T_LDS_V + ((lane >> 4) & 1) * 32 + (lane & 3) * 8 + (4 * hi + ((lane & 15) >> 2)) * 64;
    DMA_K(0, 0); DMA_V(0, 0); DMA_K(1, T_SLOTB);
    bf16x8 qr[4];
#pragma unroll
    for (int d0 = 0; d0 < 4; ++d0) qr[d0] = *reinterpret_cast<const bf16x8*>(&Qw[(size_t)r32 * DQ + d0 * 16 + hi * 8]);
    float mfo = mfix; asm volatile("" : "+v"(mfo));
    float mhat = mfo, l_reg = 0.f; f32x16 o[2]; o[0] = f32x16{}; o[1] = f32x16{}; f32x16 negm;
#pragma unroll
    for (int r = 0; r < 16; ++r) negm[r] = -mfo;
    asm volatile("" : "+v"(negm));
    bool resc = false;
#define START(P0, P1) do { resc = false; _Pragma("unroll") for (int r = 0; r < 16; ++r) P0[r] = __builtin_amdgcn_exp2f(P0[r]); } while (0)
#define RESC() do { if (resc) { asm volatile("s_waitcnt lgkmcnt(0)" ::: "memory"); \
      _Pragma("unroll") for (int d_ = 0; d_ < 2; ++d_) _Pragma("unroll") for (int r = 0; r < 16; ++r) o[d_][r] *= wsf[crow(r, hi)]; } } while (0)
    f32x16 pA0, pA1, pB0, pB1;
    int sl_prev = 0, sl_cur = 0, sl_next = T_SLOTB;
#define ROT() do { sl_prev = sl_cur; sl_cur = sl_next; sl_next = (sl_next == 2 * T_SLOTB) ? 0 : sl_next + T_SLOTB; } while (0)
    DMA_K(2, 2 * T_SLOTB);
#if CONV_MODE >= 5
    WAIT_BAR(0);
#else
    WAIT_BAR(3);
#endif
    CONV_DRAIN();
    {
        const lds_cptr kb = kp0;
#pragma unroll
        for (int d0 = 0; d0 < 4; ++d0) {
            const bf16x8 b0 = *(const __attribute__((address_space(3))) bf16x8*)(kb + d0 * 2048);
            const bf16x8 b1 = *(const __attribute__((address_space(3))) bf16x8*)(kb + d0 * 2048 + 512);
            if (d0 == 0) { pA0 = MFMA(b0, qr[0], negm); pA1 = MFMA(b1, qr[0], negm); }
            else { pA0 = MFMA(b0, qr[d0], pA0); pA1 = MFMA(b1, qr[d0], pA1); } }
    }
    asm volatile("s_nop 15\n\ts_nop 7" : "+v"(pA0), "+v"(pA1));
    START(pA0, pA1);
#pragma unroll
    for (int r = 0; r < 16; ++r) pA1[r] = __builtin_amdgcn_exp2f(pA1[r]);
    WAIT_BAR(0);
    DMA_K(3, 0); DMA_V(1, T_SLOTB); CONV_ISSUE();
    ROT();
    kload8(kf, kp0 + sl_cur);
    WB_P();
    s16x4 vlo[8], vhi[8]; u32x4 pw0, pw1, pw2, pw3;
#define PKW(P, B) cvtpk_s(P[B], P[B + 1])
#define PAF(k) __builtin_bit_cast(bf16x8, pw##k)
#define VFR(i) (bf16x8){vlo[i][0], vlo[i][1], vlo[i][2], vlo[i][3], vhi[i][0], vhi[i][1], vhi[i][2], vhi[i][3]}
#define PIN(x) asm volatile("" : "+v"(x))
#define GAPA(MF, A0, A1, A2, A3, W0, W1, PW) do { MF; sacc += A0; sacc += A1; sacc += A2; sacc += A3; PIN(sacc); W0; W1; PIN(PW); SBAR(); } while (0)
#define EX(v) __builtin_amdgcn_exp2f(v)
#define GAPB(MF, X, B) do { MF; X[B] = EX(X[B]); X[B + 1] = EX(X[B + 1]); X[B + 2] = EX(X[B + 2]); X[B + 3] = EX(X[B + 3]); PIN(X); SBAR(); } while (0)
#define VRD(i) do { vlo[i] = vtr(vp_ + (((i) >> 2) * 4096 + ((i) & 3) * 1024)); vhi[i] = vtr(vp_ + (((i) >> 2) * 4096 + ((i) & 3) * 1024 + 512)); } while (0)
#define KRD(G, j) do { if (G) { kload2(kf, kp0 + sl_next, j); SBAR(); } } while (0)
#define STEP(C0, C1, P0, P1, t, GK, GV, GL) do { SBAR(); CONV_DRAIN(); SBAR(); \
    const lds_cptr vp_ = vp0 + sl_prev; \
    VRD(0); SBAR(); float sacc = (P0[0] + P0[1]); \
    GAPA(C0 = MFMA(kf[0], qr[0], negm), P0[2], P0[3], P0[4], P0[5],     pw0[0] = PKW(P0, 0), pw0[1] = PKW(P0, 2), pw0); \
    VRD(4); SBAR(); GAPA(C1 = MFMA(kf[1], qr[0], negm), P0[6], P0[7], P0[8], P0[9],     pw0[2] = PKW(P0, 4), pw0[3] = PKW(P0, 6), pw0); \
    VRD(1); SBAR(); GAPA(C0 = MFMA(kf[2], qr[1], C0),   P0[10], P0[11], P0[12], P0[13], pw1[0] = PKW(P0, 8), pw1[1] = PKW(P0, 10), pw1); \
    VRD(5); SBAR(); GAPA(C1 = MFMA(kf[3], qr[1], C1),   P0[14], P0[15], P1[0], P1[1],   pw1[2] = PKW(P0, 12), pw1[3] = PKW(P0, 14), pw1); \
    VRD(2); SBAR(); GAPA(C0 = MFMA(kf[4], qr[2], C0),   P1[2], P1[3], P1[4], P1[5],     pw2[0] = PKW(P1, 0), pw2[1] = PKW(P1, 2), pw2); \
    VRD(6); SBAR(); GAPA(C1 = MFMA(kf[5], qr[2], C1),   P1[6], P1[7], P1[8], P1[9],     pw2[2] = PKW(P1, 4), pw2[3] = PKW(P1, 6), pw2); \
    VRD(3); SBAR(); GAPA(C0 = MFMA(kf[6], qr[3], C0),   P1[10], P1[11], P1[12], P1[13], pw3[0] = PKW(P1, 8), pw3[1] = PKW(P1, 10), pw3); \
    VRD(7); SBAR(); GAPA(C1 = MFMA(kf[7], qr[3], C1),   P1[14], P1[15], 0.f, 0.f,       pw3[2] = PKW(P1, 12), pw3[3] = PKW(P1, 14), pw3); \
    l_reg += sacc; \
    if (GK) { DMA_K((t) + 3, sl_cur); } if (GV) { DMA_V((t) + 1, sl_next); } CONV_ISSUE(); \
    SBAR(); \
    GAPB(o[0] = MFMA(PAF(0), VFR(0), o[0]), C0, 0); \
    GAPB(o[1] = MFMA(PAF(0), VFR(4), o[1]), C0, 4); \
    KRD(GL, 0); GAPB(o[0] = MFMA(PAF(1), VFR(1), o[0]), C0, 8); \
    KRD(GL, 1); GAPB(o[1] = MFMA(PAF(1), VFR(5), o[1]), C0, 12); \
    KRD(GL, 2); GAPB(o[0] = MFMA(PAF(2), VFR(2), o[0]), C1, 0); \
    KRD(GL, 3); GAPB(o[1] = MFMA(PAF(2), VFR(6), o[1]), C1, 4); \
    GAPB(o[0] = MFMA(PAF(3), VFR(3), o[0]), C1, 8); \
    GAPB(o[1] = MFMA(PAF(3), VFR(7), o[1]), C1, 12); \
    } while (0)
    int t = 1;
    for (; t + 5 < NT; t += 2) {
        STEP(pB0, pB1, pA0, pA1, t, true, true, true);     WB_S(); RESC(); ROT();
        STEP(pA0, pA1, pB0, pB1, t + 1, true, true, true); WB_S(); RESC(); ROT();
    }
#define ENDW(tt) do { if ((tt) + 3 < NT) { WB_S(); } else if ((tt) + 2 < NT) { WB_E1(); } else { WB_E0(); } } while (0)
    for (; t + 1 < NT; t += 2) {
        STEP(pB0, pB1, pA0, pA1, t, (t + 3 < NT), (t + 1 < NT), (t + 1 < NT));         ENDW(t);     RESC(); ROT();
        STEP(pA0, pA1, pB0, pB1, t + 1, (t + 4 < NT), (t + 2 < NT), (t + 2 < NT));     ENDW(t + 1); RESC(); ROT();
    }
    STEP(pB0, pB1, pA0, pA1, NT - 1, false, false, false); RESC();
    {
        float sacc = pB0[0] + pB0[1];
#pragma unroll
        for (int r = 2; r < 16; ++r) sacc += pB0[r];
#pragma unroll
        for (int r = 0; r < 16; ++r) sacc += pB1[r];
        l_reg += sacc;
        pw0 = (u32x4){PKW(pB0, 0), PKW(pB0, 2), PKW(pB0, 4), PKW(pB0, 6)}; pw1 = (u32x4){PKW(pB0, 8), PKW(pB0, 10), PKW(pB0, 12), PKW(pB0, 14)};
        pw2 = (u32x4){PKW(pB1, 0), PKW(pB1, 2), PKW(pB1, 4), PKW(pB1, 6)}; pw3 = (u32x4){PKW(pB1, 8), PKW(pB1, 10), PKW(pB1, 12), PKW(pB1, 14)};
        SBAR();
        const lds_cptr vp_ = vp0 + sl_cur;
#pragma unroll
        for (int i = 0; i < 8; ++i) VRD(i);
        o[0] = MFMA(PAF(0), VFR(0), o[0]); o[1] = MFMA(PAF(0), VFR(4), o[1]); o[0] = MFMA(PAF(1), VFR(1), o[0]); o[1] = MFMA(PAF(1), VFR(5), o[1]);
        o[0] = MFMA(PAF(2), VFR(2), o[0]); o[1] = MFMA(PAF(2), VFR(6), o[1]); o[0] = MFMA(PAF(3), VFR(3), o[0]); o[1] = MFMA(PAF(3), VFR(7), o[1]);
    }
#undef PKW
#undef PAF
#undef VFR
#undef PIN
#undef GAPA
#undef GAPB
#undef EX
#undef VRD
#undef KRD
#undef STEP
#undef ENDW
    { auto rr = __builtin_amdgcn_permlane32_swap(__float_as_uint(l_reg), __float_as_uint(l_reg), false, false); l_reg = __uint_as_float(rr[0]) + __uint_as_float(rr[1]); }
    if (hi == 0) wsf[32 + r32] = l_reg; asm volatile("s_waitcnt lgkmcnt(0)" ::: "memory");
    float rli[16];
#pragma unroll
    for (int r = 0; r < 16; ++r) rli[r] = __builtin_amdgcn_rcpf(wsf[32 + crow(r, hi)]);
    bf16_t* Ow = Ob + (size_t)(wid * 32) * DM; bf16_t* stg = (bf16_t*)(shm + T_LDS_OST) + wid * 2048;
#pragma unroll
    for (int r = 0; r < 16; ++r) { const int orow = crow(r, hi);
#pragma unroll
        for (int d0 = 0; d0 < 2; ++d0) stg[orow * 64 + d0 * 32 + r32] = (bf16_t)f2bf(o[d0][r] * rli[r]); }
    asm volatile("s_waitcnt lgkmcnt(0)" ::: "memory");
#pragma unroll
    for (int i = 0; i < 4; ++i) { const int row = i * 8 + (lane >> 3), ch = lane & 7; const u32x4 v = *(const u32x4*)(stg + row * 64 + ch * 8); *(u32x4*)(Ow + (size_t)row * DM + ch * 8) = v;
        float q = 0.f;
#pragma unroll
        for (int d = 0; d < 4; ++d) { const float a = bf2f(v[d] & 0xffffu), bq = bf2f(v[d] >> 16); q += a * a + bq * bq; }
        q += dppmov<0xB1, 0xF>(0.f, q); q += dppmov<0x4E, 0xF>(0.f, q); q += dppmov<0x141, 0xF>(0.f, q);
        if (ch == 0) ostat[(size_t)(wid * 32 + row) * 16] = q; }
    asm volatile("s_waitcnt vmcnt(0) lgkmcnt(0)\n\ts_barrier" ::: "memory");
#if CONV_MODE >= 5
#undef WB_P
#undef WB_S
#undef WB_E1
#undef WB_E0
#endif
#undef DMA_K
#undef DMA_V
#undef START
#undef RESC
#undef ROT
}
constexpr int M_KSLOT = 12288, M_LDS_K = 0, M_LDS_V = 3 * M_KSLOT, M_LDS_WS = M_LDS_V + 3 * T_SLOTB, M_LDS_Q = M_LDS_WS + NWAVES * 256, M_LDS_OST = 0  ;
#define WBAR2() do { if (lowv) { WB_PL(); } else { WB_P(); } } while (0)
#define WBARS() do { if (lowv) { WB_SL(); } else { WB_S(); } } while (0)
template <int THRL>
__device__ __forceinline__ void unit96(const bf16_t* Qh, const bf16_t* __restrict__ Kh, const bf16_t* __restrict__ Vh, bf16_t* Ob, float* ostat, int q0, char* shm, ConvState& cs, float kb2) {
    constexpr int DQ = 96;
    int tid_ = threadIdx.x; asm volatile("" : "+v"(tid_));
    const int tid = tid_, lane = tid & 63, r32 = lane & 31, hi = lane >> 5; const int wid = __builtin_amdgcn_readfirstlane(tid >> 6);
    const bf16_t* Qw = Qh + (size_t)(q0 + wid * 32) * DQ;
    const unsigned lds0 = (unsigned)(uintptr_t)shm;
    float* wsf = (float*)(shm + M_LDS_WS) + wid * 64;
#if CONV_MODE >= 5
    const bool rkv = wid < 4, rcl = (wid == 4 || wid == 5), rst = wid >= 6; const int pw = wid & 3;
    const bf16_t* ksrc = Kh + (size_t)lane * DQ + pw * 8;
    const bool lowv = false;
#else
    const bf16_t* ksrc = Kh + (size_t)lane * DQ + wid * 8;
    const bf16_t* ksrc1 = Kh + (size_t)lane * DQ + (8 + (wid & 3)) * 8;
    const bool lowv = wid < 4;
#endif
#if CONV_MODE >= 5
    const bf16_t* vsrc = Vh + (size_t)(16 * pw + (lane >> 2)) * 64 + (lane & 3) * 8;
    const unsigned kdst = lds0 + M_LDS_K + pw * 1024, vdst = lds0 + M_LDS_V + pw * 1024, qdst = lds0 + M_LDS_Q + wid * 6144;
#define DMA_K(t, slot) do { if (rkv) { glds16(ksrc + (size_t)(t) * 64 * DQ, (unsigned)__builtin_amdgcn_readfirstlane(kdst + (slot))); \
        glds16(ksrc + 32 + (size_t)(t) * 64 * DQ, (unsigned)__builtin_amdgcn_readfirstlane(kdst + 4096 + (slot))); \
        glds16(ksrc + 64 + (size_t)(t) * 64 * DQ, (unsigned)__builtin_amdgcn_readfirstlane(kdst + 8192 + (slot))); } } while (0)
#define DMA_V(t, slot) do { if (rkv) { glds16(vsrc + (size_t)(t) * 64 * 64, (unsigned)__builtin_amdgcn_readfirstlane(vdst + (slot))); \
        glds16(vsrc + 32 + (size_t)(t) * 64 * 64, (unsigned)__builtin_amdgcn_readfirstlane(vdst + 4096 + (slot))); } } while (0)
#undef WBAR2
#undef WBARS
#define WBAR2() RWAIT(5)
#define WBARS() RWAIT(5)
#define WB_E1() RWAIT(2)
#define WB_E0() RWAIT(0)
#else
    const bf16_t* vsrc = Vh + (size_t)(16 * (wid & 3) + (lane >> 2)) * 64 + (wid >> 2) * 32 + (lane & 3) * 8;
    const unsigned kdst = lds0 + M_LDS_K + wid * 1024, kdst1 = lds0 + M_LDS_K + (8 + (wid & 3)) * 1024, vdst = lds0 + M_LDS_V + wid * 1024, qdst = lds0 + M_LDS_Q + wid * 6144;
#define DMA_K(t, slot) do { glds16(ksrc + (size_t)(t) * 64 * DQ, (unsigned)__builtin_amdgcn_readfirstlane(kdst + (slot))); \
        if (lowv) glds16(ksrc1 + (size_t)(t) * 64 * DQ, (unsigned)__builtin_amdgcn_readfirstlane(kdst1 + (slot))); } while (0)
#define DMA_V(t, slot) glds16(vsrc + (size_t)(t) * 64 * 64, (unsigned)__builtin_amdgcn_readfirstlane(vdst + (slot)))
#endif
    const int vb0 = (int)(lds0 + M_LDS_V) + ((lane >> 4) & 1) * 32 + (lane & 3) * 8 + (4 * hi + ((lane & 15) >> 2)) * 64;
    bf16x8 kf[12];
    const lds_cptr shm3 = (lds_cptr)shm; const lds_cptr kp0 = shm3 + M_LDS_K + hi * 1024 + r32 * 16; const lds_cptr qp0 = shm3 + M_LDS_Q + wid * 6144 + lane * 16;
    const lds_cptr vp0 = shm3 + M_LDS_V + ((lane >> 4) & 1) * 32 + (lane & 3) * 8 + (4 * hi + ((lane & 15) >> 2)) * 64;
#pragma unroll
    for (int d0 = 0; d0 < 6; ++d0) glds16(Qw + (size_t)r32 * DQ + d0 * 16 + hi * 8, (unsigned)__builtin_amdgcn_readfirstlane(qdst + d0 * 1024));
    DMA_K(0, 0); DMA_V(0, 0); DMA_K(1, M_KSLOT);
#define QF(d0) (*(const __attribute__((address_space(3))) bf16x8*)(qp0 + (d0) * 1024))
    float mhat = 0.f, l_reg = 0.f; f32x16 o[2]; o[0] = f32x16{}; o[1] = f32x16{}; f32x16 negm = f32x16{}; asm volatile("" : "+v"(negm));
    bool resc = false;
#define START(P0, P1) do { resc = false; _Pragma("unroll") for (int r = 0; r < 16; ++r) P0[r] = __builtin_amdgcn_exp2f(P0[r]); } while (0)
#define RESC() do { if (resc) { asm volatile("s_waitcnt lgkmcnt(0)" ::: "memory"); \
      _Pragma("unroll") for (int d_ = 0; d_ < 2; ++d_) _Pragma("unroll") for (int r = 0; r < 16; ++r) o[d_][r] *= wsf[crow(r, hi)]; } } while (0)
    f32x16 pA0, pA1, pB0, pB1;
    int sl_prev = 0, sl_cur = 0, sl_next = M_KSLOT; int vs_prev = 0, vs_cur = 0, vs_next = T_SLOTB;
#define ROT() do { sl_prev = sl_cur; sl_cur = sl_next; sl_next = (sl_next == 2 * M_KSLOT) ? 0 : sl_next + M_KSLOT; vs_prev = vs_cur; vs_cur = vs_next; vs_next = (vs_next == 2 * T_SLOTB) ? 0 : vs_next + T_SLOTB; } while (0)
    DMA_K(2, 2 * M_KSLOT);
    WAIT_BAR(0);
    {
        float qn = 0.f;
#pragma unroll
        for (int d0 = 0; d0 < 6; ++d0) { const bf16x8 qf = QF(d0);
#pragma unroll
            for (int i = 0; i < 8; ++i) { const float x = bf2f((unsigned short)qf[i]); qn += x * x; } }
        auto rr = __builtin_amdgcn_permlane32_swap(__float_as_uint(qn), __float_as_uint(qn), false, false); qn = __uint_as_float(rr[0]) + __uint_as_float(rr[1]);
        mhat = fminf(sqrtf(qn * kb2) * 1.02f + 0.5f, 60.f);
#pragma unroll
        for (int r = 0; r < 16; ++r) negm[r] = -mhat;
        asm volatile("" : "+v"(negm));
    }
    CONV_DRAIN();
    {
        const lds_cptr kb = kp0;
#pragma unroll
        for (int d0 = 0; d0 < 6; ++d0) {
            const bf16x8 b0 = *(const __attribute__((address_space(3))) bf16x8*)(kb + d0 * 2048);
            const bf16x8 b1 = *(const __attribute__((address_space(3))) bf16x8*)(kb + d0 * 2048 + 512);
            const bf16x8 qf = QF(d0);
            if (d0 == 0) { pA0 = MFMA(b0, qf, negm); pA1 = MFMA(b1, qf, negm); }
            else { pA0 = MFMA(b0, qf, pA0); pA1 = MFMA(b1, qf, pA1); } }
    }
    asm volatile("s_nop 15\n\ts_nop 7" : "+v"(pA0), "+v"(pA1));
    START(pA0, pA1);
#pragma unroll
    for (int r = 0; r < 16; ++r) pA1[r] = __builtin_amdgcn_exp2f(pA1[r]);
    WAIT_BAR(0);
    DMA_K(3, 0); DMA_V(1, T_SLOTB); CONV_ISSUE();
    ROT();
#pragma unroll
    for (int j = 0; j < 6; ++j) kload2(kf, kp0 + sl_cur, j);
    WBAR2();
    s16x4 vlo[8], vhi[8]; u32x4 pw0, pw1, pw2, pw3;
#define PKW(P, B) cvtpk_s(P[B], P[B + 1])
#define PAF(k) __builtin_bit_cast(bf16x8, pw##k)
#define VFR(i) (bf16x8){vlo[i][0], vlo[i][1], vlo[i][2], vlo[i][3], vhi[i][0], vhi[i][1], vhi[i][2], vhi[i][3]}
#define PIN(x) asm volatile("" : "+v"(x))
#define GAPA(MF, A0, A1, A2, A3, W0, W1, PW) do { MF; sacc += A0; sacc += A1; sacc += A2; sacc += A3; PIN(sacc); W0; W1; PIN(PW); SBAR(); } while (0)
#define EX(v) __builtin_amdgcn_exp2f(v)
#define GAPB(MF, X, B) do { MF; X[B] = EX(X[B]); X[B + 1] = EX(X[B + 1]); X[B + 2] = EX(X[B + 2]); X[B + 3] = EX(X[B + 3]); PIN(X); SBAR(); } while (0)
#define VRD(i) do { vlo[i] = vtr(vp_ + (((i) >> 2) * 4096 + ((i) & 3) * 1024)); vhi[i] = vtr(vp_ + (((i) >> 2) * 4096 + ((i) & 3) * 1024 + 512)); } while (0)
#define KRD(G, j) do { if (G) { kload2(kf, kp0 + sl_next, j); SBAR(); } } while (0)
#define STEP(C0, C1, P0, P1, t, GK, GV, GL) do { SBAR(); CONV_DRAIN(); SBAR(); \
    const lds_cptr vp_ = vp0 + vs_prev; \
    bf16x8 qa = QF(0), qb = QF(1); \
    VRD(0); SBAR(); float sacc = (P0[0] + P0[1]); \
    GAPA(C0 = MFMA(kf[0], qa, negm), P0[2], P0[3], P0[4], P0[5],     pw0[0] = PKW(P0, 0), pw0[1] = PKW(P0, 2), pw0); \
    VRD(4); SBAR(); GAPA(C1 = MFMA(kf[1], qa, negm), P0[6], P0[7], P0[8], P0[9],     pw0[2] = PKW(P0, 4), pw0[3] = PKW(P0, 6), pw0); \
    qa = QF(2); VRD(1); SBAR(); GAPA(C0 = MFMA(kf[2], qb, C0),   P0[10], P0[11], P0[12], P0[13], pw1[0] = PKW(P0, 8), pw1[1] = PKW(P0, 10), pw1); \
    VRD(5); SBAR(); GAPA(C1 = MFMA(kf[3], qb, C1),   P0[14], P0[15], P1[0], P1[1],   pw1[2] = PKW(P0, 12), pw1[3] = PKW(P0, 14), pw1); \
    qb = QF(3); VRD(2); SBAR(); GAPA(C0 = MFMA(kf[4], qa, C0),   P1[2], P1[3], P1[4], P1[5],     pw2[0] = PKW(P1, 0), pw2[1] = PKW(P1, 2), pw2); \
    VRD(6); SBAR(); GAPA(C1 = MFMA(kf[5], qa, C1),   P1[6], P1[7], P1[8], P1[9],     pw2[2] = PKW(P1, 4), pw2[3] = PKW(P1, 6), pw2); \
    qa = QF(4); VRD(3); SBAR(); GAPA(C0 = MFMA(kf[6], qb, C0),   P1[10], P1[11], P1[12], P1[13], pw3[0] = PKW(P1, 8), pw3[1] = PKW(P1, 10), pw3); \
    VRD(7); SBAR(); GAPA(C1 = MFMA(kf[7], qb, C1),   P1[14], P1[15], 0.f, 0.f,       pw3[2] = PKW(P1, 12), pw3[3] = PKW(P1, 14), pw3); \
    qb = QF(5); SBAR(); C0 = MFMA(kf[8], qa, C0); C1 = MFMA(kf[9], qa, C1); SBAR(); \
    C0 = MFMA(kf[10], qb, C0); C1 = MFMA(kf[11], qb, C1); SBAR(); \
    l_reg += sacc; \
    if (GK) { DMA_K((t) + 3, sl_cur); } if (GV) { DMA_V((t) + 1, vs_next); } CONV_ISSUE(); \
    SBAR(); \
    GAPB(o[0] = MFMA(PAF(0), VFR(0), o[0]), C0, 0); \
    KRD(GL, 0); GAPB(o[1] = MFMA(PAF(0), VFR(4), o[1]), C0, 4); \
    KRD(GL, 1); GAPB(o[0] = MFMA(PAF(1), VFR(1), o[0]), C0, 8); \
    KRD(GL, 2); GAPB(o[1] = MFMA(PAF(1), VFR(5), o[1]), C0, 12); \
    KRD(GL, 3); GAPB(o[0] = MFMA(PAF(2), VFR(2), o[0]), C1, 0); \
    KRD(GL, 4); GAPB(o[1] = MFMA(PAF(2), VFR(6), o[1]), C1, 4); \
    KRD(GL, 5); GAPB(o[0] = MFMA(PAF(3), VFR(3), o[0]), C1, 8); \
    GAPB(o[1] = MFMA(PAF(3), VFR(7), o[1]), C1, 12); \
    } while (0)
    int t = 1;
    for (; t + 5 < NT; t += 2) {
        STEP(pB0, pB1, pA0, pA1, t, true, true, true);     WBARS(); RESC(); ROT();
        STEP(pA0, pA1, pB0, pB1, t + 1, true, true, true); WBARS(); RESC(); ROT();
    }
#define ENDW(tt) do { if ((tt) + 3 < NT) { WBARS(); } else if ((tt) + 2 < NT) { WB_E1(); } else { WB_E0(); } } while (0)
    for (; t + 1 < NT; t += 2) {
        STEP(pB0, pB1, pA0, pA1, t, (t + 3 < NT), (t + 1 < NT), (t + 1 < NT));         ENDW(t);     RESC(); ROT();
        STEP(pA0, pA1, pB0, pB1, t + 1, (t + 4 < NT), (t + 2 < NT), (t + 2 < NT));     ENDW(t + 1); RESC(); ROT();
    }
    STEP(pB0, pB1, pA0, pA1, NT - 1, false, false, false); RESC();
    {
        float sacc = pB0[0] + pB0[1];
#pragma unroll
        for (int r = 2; r < 16; ++r) sacc += pB0[r];
#pragma unroll
        for (int r = 0; r < 16; ++r) sacc += pB1[r];
        l_reg += sacc;
        pw0 = (u32x4){PKW(pB0, 0), PKW(pB0, 2), PKW(pB0, 4), PKW(pB0, 6)}; pw1 = (u32x4){PKW(pB0, 8), PKW(pB0, 10), PKW(pB0, 12), PKW(pB0, 14)};
        pw2 = (u32x4){PKW(pB1, 0), PKW(pB1, 2), PKW(pB1, 4), PKW(pB1, 6)}; pw3 = (u32x4){PKW(pB1, 8), PKW(pB1, 10), PKW(pB1, 12), PKW(pB1, 14)};
        SBAR();
        const lds_cptr vp_ = vp0 + vs_cur;
#pragma unroll
        for (int i = 0; i < 8; ++i) VRD(i);
        o[0] = MFMA(PAF(0), VFR(0), o[0]); o[1] = MFMA(PAF(0), VFR(4), o[1]); o[0] = MFMA(PAF(1), VFR(1), o[0]); o[1] = MFMA(PAF(1), VFR(5), o[1]);
        o[0] = MFMA(PAF(2), VFR(2), o[0]); o[1] = MFMA(PAF(2), VFR(6), o[1]); o[0] = MFMA(PAF(3), VFR(3), o[0]); o[1] = MFMA(PAF(3), VFR(7), o[1]);
    }
#undef PKW
#undef PAF
#undef VFR
#undef PIN
#undef GAPA
#undef GAPB
#undef EX
#undef VRD
#undef KRD
#undef STEP
#undef ENDW
    { auto rr = __builtin_amdgcn_permlane32_swap(__float_as_uint(l_reg), __float_as_uint(l_reg), false, false); l_reg = __uint_as_float(rr[0]) + __uint_as_float(rr[1]); }
    if (hi == 0) wsf[32 + r32] = l_reg; asm volatile("s_waitcnt lgkmcnt(0)" ::: "memory");
    float rli[16];
#pragma unroll
    for (int r = 0; r < 16; ++r) rli[r] = __builtin_amdgcn_rcpf(wsf[32 + crow(r, hi)]);
    bf16_t* Ow = Ob + (size_t)(wid * 32) * DM; bf16_t* stg = (bf16_t*)(shm + M_LDS_OST) + wid * 2048;
#pragma unroll
    for (int r = 0; r < 16; ++r) { const int orow = crow(r, hi);
#pragma unroll
        for (int d0 = 0; d0 < 2; ++d0) stg[orow * 64 + d0 * 32 + r32] = (bf16_t)f2bf(o[d0][r] * rli[r]); }
    asm volatile("s_waitcnt lgkmcnt(0)" ::: "memory");
#pragma unroll
    for (int i = 0; i < 4; ++i) { const int row = i * 8 + (lane >> 3), ch = lane & 7; const u32x4 v = *(const u32x4*)(stg + row * 64 + ch * 8); *(u32x4*)(Ow + (size_t)row * DM + ch * 8) = v;
        float q = 0.f;
#pragma unroll
        for (int d = 0; d < 4; ++d) { const float a = bf2f(v[d] & 0xffffu), bq = bf2f(v[d] >> 16); q += a * a + bq * bq; }
        q += dppmov<0xB1, 0xF>(0.f, q); q += dppmov<0x4E, 0xF>(0.f, q); q += dppmov<0x141, 0xF>(0.f, q);
        if (ch == 0) ostat[(size_t)(wid * 32 + row) * 16] = q; }
    asm volatile("s_waitcnt vmcnt(0) lgkmcnt(0)\n\ts_barrier" ::: "memory");
#if CONV_MODE >= 5
#undef WB_E1
#undef WB_E0
#endif
#undef QF
#undef DMA_K
#undef DMA_V
#undef START
#undef RESC
#undef ROT
}
#undef WBAR2
#undef WBARS
#undef WAIT_BAR
}


namespace pg8 {
typedef short bf16x8 __attribute__((ext_vector_type(8)));
typedef float f32x4 __attribute__((ext_vector_type(4)));
typedef unsigned u32x4 __attribute__((ext_vector_type(4)));
constexpr int BM = 256, BK = 64, HALF = 128, HTB = HALF * BK * 2, STAGE_BYTES = 8 * HTB, NXCD = 8, WGM = 8;
__host__ __device__ __forceinline__ int lds_byte(int r, int c) { const int st = (r >> 4) * 2 + (c >> 5), rr = r & 15, cc = c & 31, ob = rr * 64 + cc * 2; return st * 1024 + (ob ^ (((ob >> 9) & 1) << 5)); }
__host__ __device__ __forceinline__ void stage_rc(int b, int& R, int& C) { const int st = b / 1024, sb = b % 1024, swz = sb ^ (((sb >> 9) & 1) << 5); R = (st >> 1) * 16 + swz / 64; C = (st & 1) * 32 + (swz % 64) / 2; }
__host__ __device__ __forceinline__ int perm32(int rho) { const int n = rho >> 4, i = rho & 15; return 8 * (i >> 2) + 4 * n + (i & 3); }
__device__ __forceinline__ unsigned cvt_pk_bf16(float lo, float hi) { unsigned r; asm volatile("v_cvt_pk_bf16_f32 %0, %1, %2" : "=v"(r) : "v"(lo), "v"(hi)); return r; }

struct Unit { int pm, pn, e, nrows, rowbase; };

struct DenseOrder {
    int nM, nN, nwg, G, c, K; const char* Bt;
    __device__ void init(int M, int N, int K_, const bf16_t* Bt_, int G_, int c_) { nM = M / BM; nN = N / BM; nwg = nM * nN; G = G_; c = c_; K = K_; Bt = (const char*)Bt_; }
    __device__ __forceinline__ bool next(int i, Unit& u) const {
        const long L = (long)i * G + c; if (L >= nwg) return false;
        int wgid = (int)L; { const int q = nwg / NXCD, r = nwg % NXCD, xcd = wgid % NXCD, off = wgid / NXCD; wgid = (xcd < r ? xcd * (q + 1) : r * (q + 1) + (xcd - r) * q) + off; }
        const int nig = WGM * nN, gid = wgid / nig, fm = gid * WGM, gsz = (nM - fm) < WGM ? (nM - fm) : WGM;
        u.pm = fm + ((wgid % nig) % gsz); u.pn = (wgid % nig) / gsz; u.e = 0; u.nrows = 256; u.rowbase = u.pm * BM; return true;
    }
    __device__ __forceinline__ void a_offsets(const Unit&, int, unsigned (&)[2][2]) const {}
    __device__ __forceinline__ const char* b_tile(const Unit& u) const { return Bt + (size_t)u.pn * BM * K * 2; }
};

struct EpiBf16 {
    static constexpr bool PERM = true;
    bf16_t* O; int ldc;
    __device__ __forceinline__ void operator()(const f32x4 (&acc)[2][2][4][2], const Unit& u, int wr, int wc, int fr, int fq) const {
        const int row0 = u.pm * BM + wr * 64 + fr, col0 = u.pn * BM + wc * 32 + 8 * fq;
#pragma unroll
        for (int ai = 0; ai < 2; ++ai)
#pragma unroll
            for (int m = 0; m < 4; ++m) { bf16_t* rowp = O + (size_t)(row0 + ai * HALF + m * 16) * ldc + col0;
#pragma unroll
                for (int bj = 0; bj < 2; ++bj) { const f32x4 v0 = acc[ai][bj][m][0], v1 = acc[ai][bj][m][1];
                    u32x4 w; w.x = cvt_pk_bf16(v0[0], v0[1]); w.y = cvt_pk_bf16(v0[2], v0[3]); w.z = cvt_pk_bf16(v1[0], v1[1]); w.w = cvt_pk_bf16(v1[2], v1[3]);
                    *(u32x4*)(rowp + bj * HALF) = w; } }
    }
};


__device__ __forceinline__ float silu_mul(float g, float u) { return g * __builtin_amdgcn_rcpf(1.f + __expf(-g)) * u; }

struct MoeOrder {
    const LAS int* pre; const LAS int* offs; const LAS int* cntl; const int* list; const char* Bt; size_t bstride; int K, npn, G, c, mode;
    __device__ __forceinline__ bool next(int i, Unit& u) const {
        const int L = i * G + c, total = pre[NE] * npn; if (L >= total) return false;
        const int rtg = L / npn; const int pn = L - rtg * npn;
        int lo_ = 0, hi_ = NE;
        while (hi_ - lo_ > 1) { const int mid = (lo_ + hi_) >> 1; if (pre[mid] <= rtg) lo_ = mid; else hi_ = mid; }
        const int e = lo_, pm = rtg - pre[e], n = cntl[e] - pm * BM;
        u.e = __builtin_amdgcn_readfirstlane(e); u.pm = __builtin_amdgcn_readfirstlane(pm); u.pn = __builtin_amdgcn_readfirstlane(pn);
        u.nrows = __builtin_amdgcn_readfirstlane(n < BM ? n : BM); u.rowbase = __builtin_amdgcn_readfirstlane(offs[e] + pm * BM); return true;
    }
    __device__ __forceinline__ void a_offsets(const Unit& u, int tid, unsigned (&ua)[2][2]) const {
#pragma unroll
        for (int i = 0; i < 2; ++i) { int R, C; stage_rc(tid * 16 + i * 8192, R, C);
#pragma unroll
            for (int h = 0; h < 2; ++h) { int r = h * HALF + R; if (r >= u.nrows) r = 0; const int row = list[(size_t)u.e * LCAP + u.pm * BM + r] >> 3;
                ua[h][i] = (unsigned)((row * K + C) * 2); } }
    }
    __device__ __forceinline__ const char* b_tile(const Unit& u) const { return Bt + (size_t)u.e * bstride + (size_t)u.pn * BM * K * 2; }
};

struct EpiAct {
    static constexpr bool PERM = true;
    bf16_t* ACT;
    __device__ __forceinline__ void operator()(const f32x4 (&acc)[2][2][4][2], const Unit& u, int wr, int wc, int fr, int fq) const {
        const __amdgpu_buffer_rsrc_t rs = __builtin_amdgcn_make_buffer_rsrc((void*)ACT, 0, (NTOK * TOPK + 256) * EFF * 2, 0x00020000);
        const unsigned cb = (unsigned)((u.pn * HALF + wc * 32 + 8 * fq) * 2);
#pragma unroll
        for (int ai = 0; ai < 2; ++ai)
#pragma unroll
            for (int m = 0; m < 4; ++m) { const int r = ai * HALF + wr * 64 + m * 16 + fr;
                const unsigned off = (r < u.nrows) ? (unsigned)(u.rowbase + r) * (EFF * 2) + cb : 0xFFFFFFF0u;
                const f32x4 g0 = acc[ai][0][m][0], g1 = acc[ai][0][m][1], u0 = acc[ai][1][m][0], u1 = acc[ai][1][m][1];
                u32x4 w; w.x = cvt_pk_bf16(silu_mul(g0[0], u0[0]), silu_mul(g0[1], u0[1])); w.y = cvt_pk_bf16(silu_mul(g0[2], u0[2]), silu_mul(g0[3], u0[3]));
                w.z = cvt_pk_bf16(silu_mul(g1[0], u1[0]), silu_mul(g1[1], u1[1])); w.w = cvt_pk_bf16(silu_mul(g1[2], u1[2]), silu_mul(g1[3], u1[3]));
                __builtin_amdgcn_raw_buffer_store_b128(w, rs, off, 0, 0); }
    }
};
struct EpiSlots {
    static constexpr bool PERM = true;
    unsigned char* SL;
    __device__ __forceinline__ void operator()(const f32x4 (&acc)[2][2][4][2], const Unit& u, int wr, int wc, int fr, int fq) const {
        const __amdgpu_buffer_rsrc_t rs = __builtin_amdgcn_make_buffer_rsrc((void*)SL, 0, NTOK * TOPK * DM, 0x00020000);
        const unsigned cb = (unsigned)(u.pn * BM + wc * 32 + 8 * fq);
#pragma unroll
        for (int ai = 0; ai < 2; ++ai)
#pragma unroll
            for (int m = 0; m < 4; ++m) { const int r = ai * HALF + wr * 64 + m * 16 + fr;
                const unsigned off = (r < u.nrows) ? (unsigned)(u.rowbase + r) * DM + cb : 0xFFFFFFF0u;
#pragma unroll
                for (int bj = 0; bj < 2; ++bj) { const f32x4 v0 = acc[ai][bj][m][0] * 16.f, v1 = acc[ai][bj][m][1] * 16.f;
                    int lo = __builtin_amdgcn_cvt_pk_fp8_f32(v0[0], v0[1], 0, false); lo = __builtin_amdgcn_cvt_pk_fp8_f32(v0[2], v0[3], lo, true);
                    int hi = __builtin_amdgcn_cvt_pk_fp8_f32(v1[0], v1[1], 0, false); hi = __builtin_amdgcn_cvt_pk_fp8_f32(v1[2], v1[3], hi, true);
                    typedef unsigned u32x2 __attribute__((ext_vector_type(2)));
                    __builtin_amdgcn_raw_buffer_store_b64((u32x2){(unsigned)lo, (unsigned)hi}, rs, off, bj * HALF, 0); } }
    }
};
struct EpiRS {
    static constexpr bool PERM = true;
    float* LOG; bf16_t* ACTS;
    __device__ __forceinline__ void operator()(const f32x4 (&acc)[2][2][4][2], const Unit& u, int wr, int wc, int fr, int fq) const {
        const int row0 = u.pm * BM + wr * 64 + fr;
#pragma unroll
        for (int ai = 0; ai < 2; ++ai)
#pragma unroll
            for (int m = 0; m < 4; ++m) { const int row = row0 + ai * HALF + m * 16;
                if (u.pn == 0) {
#pragma unroll
                    for (int bj = 0; bj < 2; ++bj) { float* lp = LOG + (size_t)row * NE + bj * HALF + wc * 32 + 8 * fq; *(f32x4*)lp = acc[ai][bj][m][0]; *(f32x4*)(lp + 4) = acc[ai][bj][m][1]; }
                } else {
                    const f32x4 g0 = acc[ai][0][m][0], g1 = acc[ai][0][m][1], u0 = acc[ai][1][m][0], u1 = acc[ai][1][m][1];
                    u32x4 w; w.x = cvt_pk_bf16(silu_mul(g0[0], u0[0]), silu_mul(g0[1], u0[1])); w.y = cvt_pk_bf16(silu_mul(g0[2], u0[2]), silu_mul(g0[3], u0[3]));
                    w.z = cvt_pk_bf16(silu_mul(g1[0], u1[0]), silu_mul(g1[1], u1[1])); w.w = cvt_pk_bf16(silu_mul(g1[2], u1[2]), silu_mul(g1[3], u1[3]));
                    *(u32x4*)(ACTS + (size_t)row * EFF + (u.pn - 1) * HALF + wc * 32 + 8 * fq) = w; } }
    }
};

struct EpiBf16RowScale {
    static constexpr bool PERM = true;
    bf16_t* O; int ldc; const LAS float* rtab;
    __device__ __forceinline__ void operator()(const f32x4 (&acc)[2][2][4][2], const Unit& u, int wr, int wc, int fr, int fq) const {
        const int row0 = u.pm * BM + wr * 64 + fr, col0 = u.pn * BM + wc * 32 + 8 * fq;
#pragma unroll
        for (int ai = 0; ai < 2; ++ai)
#pragma unroll
            for (int m = 0; m < 4; ++m) { const int row = row0 + ai * HALF + m * 16; bf16_t* rowp = O + (size_t)row * ldc + col0;
                const float g = rtab[2 * (row - u.pm * BM) + 1];
#pragma unroll
                for (int bj = 0; bj < 2; ++bj) { const f32x4 v0 = acc[ai][bj][m][0] * g, v1 = acc[ai][bj][m][1] * g;
                    u32x4 w; w.x = cvt_pk_bf16(v0[0], v0[1]); w.y = cvt_pk_bf16(v0[2], v0[3]); w.z = cvt_pk_bf16(v1[0], v1[1]); w.w = cvt_pk_bf16(v1[2], v1[3]);
                    *(u32x4*)(rowp + bj * HALF) = w; } }
    }
};

template <class Epi, class Sched, bool ALIGN_EPI, bool GATHER = false, bool MIDSCALE = false>
__device__ __forceinline__ void gemm_phase(LAS unsigned char* lds, const bf16_t* Abase_, int K, const Sched& S, const Epi& E, const float* stat = nullptr) {
    int tid_ = threadIdx.x; asm volatile("" : "+v"(tid_));
    const int tid = tid_, wid = __builtin_amdgcn_readfirstlane(tid >> 6), lane = tid & 63, wr = wid >> 2, wc = wid & 3, fr = lane & 15, fq = lane >> 4;
    const int nt = K / BK;
    const char* Abase = (const char*)Abase_;
    unsigned voffB[2], voffA[2];
#pragma unroll
    for (int i = 0; i < 2; ++i) { int R, C; stage_rc(tid * 16 + i * 8192, R, C); const int Rb = Epi::PERM ? ((R & ~31) + perm32(R & 31)) : R; voffB[i] = (unsigned)(Rb * K + C) * 2u; voffA[i] = (unsigned)(R * K + C) * 2u; }
    const size_t kstep = (size_t)(BK * 2);
    const size_t hstep = (size_t)HALF * K * 2;
    const unsigned ldsw = (unsigned)wid * 1024u;
    const int aoff = lds_byte(wr * 64 + fr, fq * 8), boff = lds_byte(wc * 32 + fr, fq * 8);
#define PG8_SA(b, h) (((b) * 2 + (h)) * HTB)
#define PG8_SB(b, h) ((4 + (b) * 2 + (h)) * HTB)
#define PG8_STAGE_B(bufoff, gbase) do { _Pragma("unroll") for (int _i = 0; _i < 2; ++_i) \
        __builtin_amdgcn_global_load_lds((const unsigned*)((const char*)(gbase) + voffB[_i]), (LAS unsigned*)(lds + (bufoff) + ldsw + _i * 8192), 16, 0, 0); } while (0)
#define PG8_STAGE_A(bufoff, ua, pa, h, koff) do { _Pragma("unroll") for (int _i = 0; _i < 2; ++_i) { \
        const char* _g = GATHER ? (Abase + (size_t)(ua)[h][_i] + (koff)) : ((pa) + (size_t)(h) * hstep + voffA[_i] + (koff)); \
        __builtin_amdgcn_global_load_lds((const unsigned*)_g, (LAS unsigned*)(lds + (bufoff) + ldsw + _i * 8192), 16, 0, 0); } } while (0)
#define PG8_LDA(dst, b, h) do { _Pragma("unroll") for (int m = 0; m < 4; ++m) _Pragma("unroll") for (int k = 0; k < 2; ++k) dst[m][k] = *(const LAS bf16x8*)(lds + PG8_SA(b, h) + aoff + m * 2048 + k * 1024); } while (0)
#define PG8_LDB(dst, b, h) do { _Pragma("unroll") for (int n = 0; n < 2; ++n) _Pragma("unroll") for (int k = 0; k < 2; ++k) dst[n][k] = *(const LAS bf16x8*)(lds + PG8_SB(b, h) + boff + n * 2048 + k * 1024); } while (0)
#define PG8_MMA(ai, bj, At, Bt) do { __builtin_amdgcn_s_setprio(1); _Pragma("unroll") for (int m = 0; m < 4; ++m) _Pragma("unroll") for (int n = 0; n < 2; ++n) _Pragma("unroll") for (int k = 0; k < 2; ++k) \
        acc[ai][bj][m][n] = __builtin_amdgcn_mfma_f32_16x16x32_bf16(Bt[n][k], At[m][k], acc[ai][bj][m][n], 0, 0, 0); __builtin_amdgcn_s_setprio(0); } while (0)
#define PG8_WAIT_V(n) asm volatile("s_waitcnt vmcnt(" #n ")" ::: "memory")
#define PG8_WAIT_L(n) asm volatile("s_waitcnt lgkmcnt(" #n ")" ::: "memory")
#define PG8_BAR __builtin_amdgcn_s_barrier()
#define PG8_SCHED __builtin_amdgcn_sched_barrier(0)
    Unit cur, nxt; int ui = 0;
    if (!S.next(0, cur)) return;
    f32x4 acc[2][2][4][2];
#pragma unroll
    for (int a = 0; a < 2; ++a)
#pragma unroll
        for (int b = 0; b < 2; ++b)
#pragma unroll
            for (int m = 0; m < 4; ++m)
#pragma unroll
                for (int n = 0; n < 2; ++n) acc[a][b][m][n] = (f32x4){0.f, 0.f, 0.f, 0.f};
    bf16x8 At[4][2], B0[2][2], B1[2][2];
    unsigned uc[2][2], un[2][2];
    if constexpr (GATHER) S.a_offsets(cur, tid, uc);
    const char* cA = Abase + (size_t)cur.rowbase * K * 2;
    const char* cB = S.b_tile(cur);
    PG8_STAGE_B(PG8_SB(0, 0), cB); PG8_STAGE_B(PG8_SB(0, 1), cB + hstep); PG8_STAGE_A(PG8_SA(0, 0), uc, cA, 0, (size_t)0); PG8_STAGE_A(PG8_SA(0, 1), uc, cA, 1, (size_t)0);
    if (wr == 1) PG8_BAR;
    PG8_WAIT_V(2); PG8_BAR;
    PG8_STAGE_B(PG8_SB(1, 0), cB + kstep); PG8_STAGE_A(PG8_SA(1, 0), uc, cA, 0, kstep); PG8_STAGE_B(PG8_SB(1, 1), cB + hstep + kstep);
    PG8_WAIT_V(6); PG8_BAR;
    for (;;) {
        const bool has_next = S.next(ui + 1, nxt);
        const bool lower = cur.nrows > wr * 64, upper = cur.nrows > HALF + wr * 64;
        const char* nB = cB; const char* nA = cA;
        if (has_next) { if constexpr (GATHER) S.a_offsets(nxt, tid, un); nB = S.b_tile(nxt); nA = Abase + (size_t)nxt.rowbase * K * 2; }
        else if constexpr (GATHER) {
#pragma unroll
            for (int h = 0; h < 2; ++h)
#pragma unroll
                for (int i = 0; i < 2; ++i) un[h][i] = uc[h][i];
        }
#pragma unroll 1
        for (int t = 0; t < nt; t += 2) {
            const bool last = (t == nt - 2);
            const size_t k1 = (size_t)(t + 1) * kstep;
            const size_t k2 = last ? (size_t)0 : (size_t)(t + 2) * kstep, k3 = k2 + kstep;
            const char* b2 = last ? nB : cB + (size_t)(t + 2) * kstep; const char* b3 = b2 + kstep;
            const char* a2 = last ? nA : cA;
            unsigned x2[2][2];
            if constexpr (GATHER) {
#pragma unroll
                for (int h = 0; h < 2; ++h)
#pragma unroll
                    for (int i = 0; i < 2; ++i) x2[h][i] = uc[h][i];
                if (last) { asm volatile("; next unit's A offsets" ::: "memory");
#pragma unroll
                    for (int h = 0; h < 2; ++h)
#pragma unroll
                        for (int i = 0; i < 2; ++i) x2[h][i] = un[h][i]; }
            }
            if constexpr (MIDSCALE) { if (t == nt / 2) {
#pragma unroll
                for (int ai = 0; ai < 2; ++ai)
#pragma unroll
                    for (int m = 0; m < 4; ++m) { const float f = ((const LAS float*)(lds + STAGE_BYTES))[2 * (ai * HALF + wr * 64 + m * 16 + fr)];
#pragma unroll
                        for (int bj = 0; bj < 2; ++bj)
#pragma unroll
                            for (int n = 0; n < 2; ++n) acc[ai][bj][m][n] *= f; } } }
            PG8_LDB(B0, 0, 0); PG8_LDB(B1, 0, 1); PG8_SCHED; PG8_LDA(At, 0, 0); PG8_STAGE_A(PG8_SA(1, 1), uc, cA, 1, k1);
            PG8_WAIT_V(8); PG8_WAIT_L(0); PG8_BAR; if (lower) { PG8_MMA(0, 0, At, B0); PG8_MMA(0, 1, At, B1); } PG8_BAR; PG8_SCHED;
            PG8_LDA(At, 0, 1); PG8_STAGE_B(PG8_SB(0, 0), b2); PG8_STAGE_B(PG8_SB(0, 1), b2 + hstep); PG8_STAGE_A(PG8_SA(0, 0), x2, a2, 0, k2);
            PG8_WAIT_V(8); PG8_WAIT_L(0); PG8_BAR; if (upper) { PG8_MMA(1, 0, At, B0); PG8_MMA(1, 1, At, B1); } PG8_BAR; PG8_SCHED;
            PG8_LDB(B0, 1, 0); PG8_LDB(B1, 1, 1); PG8_SCHED; PG8_LDA(At, 1, 0); PG8_STAGE_A(PG8_SA(0, 1), x2, a2, 1, k2);
            PG8_WAIT_V(8); PG8_WAIT_L(0); PG8_BAR; if (lower) { PG8_MMA(0, 0, At, B0); PG8_MMA(0, 1, At, B1); } PG8_BAR; PG8_SCHED;
            PG8_LDA(At, 1, 1); PG8_STAGE_B(PG8_SB(1, 0), b3); PG8_STAGE_B(PG8_SB(1, 1), b3 + hstep); PG8_STAGE_A(PG8_SA(1, 0), x2, a2, 0, k3);
            PG8_WAIT_V(8); PG8_WAIT_L(0); PG8_BAR; if (upper) { PG8_MMA(1, 0, At, B0); PG8_MMA(1, 1, At, B1); } PG8_BAR; PG8_SCHED;
        }
        if constexpr (ALIGN_EPI) { if (wr == 0) PG8_BAR; }
        E(acc, cur, wr, wc, fr, fq);
        if (!has_next) break;
#pragma unroll
        for (int a = 0; a < 2; ++a)
#pragma unroll
            for (int b = 0; b < 2; ++b)
#pragma unroll
                for (int m = 0; m < 4; ++m)
#pragma unroll
                    for (int n = 0; n < 2; ++n) acc[a][b][m][n] = (f32x4){0.f, 0.f, 0.f, 0.f};
        cur = nxt; cB = nB; cA = nA; ++ui;
        if constexpr (GATHER) {
#pragma unroll
            for (int h = 0; h < 2; ++h)
#pragma unroll
                for (int i = 0; i < 2; ++i) uc[h][i] = un[h][i];
        }
        if constexpr (ALIGN_EPI) { if (wr == 1) PG8_BAR; }
    }
    PG8_WAIT_V(0);
    if constexpr (!ALIGN_EPI) { if (wr == 0) PG8_BAR; }
    PG8_BAR;
#undef PG8_SA
#undef PG8_SB
#undef PG8_STAGE_A
#undef PG8_STAGE_B
#undef PG8_LDA
#undef PG8_LDB
#undef PG8_MMA
#undef PG8_WAIT_V
#undef PG8_WAIT_L
#undef PG8_BAR
#undef PG8_SCHED
}
}

__device__ __forceinline__ void cvt_item(const float* W, int ldw, int col0, int k0, bf16_t* WT, int drow0, int Kd, const float* gk, LAS float* scr, int lane) {
    const int kr = lane >> 3, n4 = lane & 7;
    float4 v[8];
#pragma unroll
    for (int i = 0; i < 8; ++i) v[i] = *(const float4*)&W[(size_t)(k0 + 8 * i + kr) * ldw + col0 + 4 * n4];
#pragma unroll
    for (int i = 0; i < 8; ++i) { const int kk = 8 * i + kr; const float g = gk ? gk[k0 + kk] : 1.f; LAS float* d = scr + kk * 33 + 4 * n4;
        d[0] = v[i].x * g; d[1] = v[i].y * g; d[2] = v[i].z * g; d[3] = v[i].w * g; }
    asm volatile("s_waitcnt lgkmcnt(0)" ::: "memory");
    const int cch = lane & 7;
#pragma unroll
    for (int j = 0; j < 4; ++j) { const int n = (lane >> 3) + 8 * j; const LAS float* sp = scr + (8 * cch) * 33 + n;
        uint4 o; o.x = pk2(sp[0 * 33], sp[1 * 33]); o.y = pk2(sp[2 * 33], sp[3 * 33]); o.z = pk2(sp[4 * 33], sp[5 * 33]); o.w = pk2(sp[6 * 33], sp[7 * 33]);
        *(uint4*)(WT + (size_t)(drow0 + n) * Kd + k0 + 8 * cch) = o; }
    asm volatile("s_waitcnt lgkmcnt(0)" ::: "memory");
}
#define PHASE_PTRS \
    unsigned char* wsp = args.ws; asm volatile("" : "+s"(wsp)); \
    const float* x = args.in[0]; const float* cvec = args.in[1]; const float* w_ada = args.in[2]; const float* b_ada = args.in[3]; \
    const float* g_pre_mix = args.in[4]; const float* g_post_mix = args.in[5]; const float* g_pre_ffn = args.in[6]; const float* g_post_ffn = args.in[7]; \
    const float* w_in = args.in[8]; const float* g_q_a = args.in[9]; const float* w_q_b = args.in[10]; const float* g_kv_a = args.in[11]; const float* w_kv_b = args.in[12]; \
    const float* g_q_head = args.in[13]; const float* g_k_head = args.in[14]; const float* g_mla_out = args.in[15]; const float* g_gqa_out = args.in[16]; \
    const float* w_out = args.in[17]; const float* w_router = args.in[18]; const float* b_router = args.in[19]; \
    const float* w_gate_e = args.in[20]; const float* w_up_e = args.in[21]; const float* w_down_e = args.in[22]; \
    const float* w_gate_s = args.in[23]; const float* w_up_s = args.in[24]; const float* w_down_s = args.in[25]; \
    float* mod = (float*)(wsp + WS_MOD); \
    float* cosm = (float*)(wsp + WS_COSM); float* sinm = (float*)(wsp + WS_SINM); float* cosg = (float*)(wsp + WS_COSG); float* sing = (float*)(wsp + WS_SING); \
    bf16_t* H2 = (bf16_t*)(wsp + WS_H2); \
    bf16_t* QM = (bf16_t*)(wsp + WS_QM); bf16_t* KM = (bf16_t*)(wsp + WS_KM); bf16_t* VM = (bf16_t*)(wsp + WS_VM); \
    bf16_t* QG = (bf16_t*)(wsp + WS_QG); bf16_t* KG = (bf16_t*)(wsp + WS_KG); bf16_t* VG = (bf16_t*)(wsp + WS_VG); \
    bf16_t* O = (bf16_t*)(wsp + WS_O); \
    bf16_t* X1 = (bf16_t*)(wsp + WS_X1); float* WTS = (float*)(wsp + WS_WTS); int* LIST = (int*)(wsp + WS_LIST); \
    bf16_t* SLOTS = (bf16_t*)(wsp + WS_SLOTS); int* POSREC = (int*)(wsp + WS_POSREC); float* OSTAT = (float*)(wsp + WS_OSTAT); \
    bf16_t* PBUF = (bf16_t*)(wsp + WS_PBUF); bf16_t* WBIGT = (bf16_t*)(wsp + WS_WBIGT); \
    bf16_t* WQBT = (bf16_t*)(wsp + WS_WQBT); bf16_t* WINQ = (bf16_t*)(wsp + WS_WINQ); bf16_t* WKVBT = (bf16_t*)(wsp + WS_WKVBT); bf16_t* WINKV = (bf16_t*)(wsp + WS_WINKV); \
    bf16_t* WOUTT = (bf16_t*)(wsp + WS_WOUTT); bf16_t* WRST = (bf16_t*)(wsp + WS_WRST); bf16_t* WDST = (bf16_t*)(wsp + WS_WDST); \
    bf16_t* WGUT = (bf16_t*)(wsp + WS_WGUT); bf16_t* WDT = (bf16_t*)(wsp + WS_WDT); \
    bf16_t* MIXED = (bf16_t*)(wsp + WS_MIXED); float* LOG = (float*)(wsp + WS_LOG); bf16_t* ACT = (bf16_t*)(wsp + WS_ACT); bf16_t* ACTS = (bf16_t*)(wsp + WS_ACTS); bf16_t* YSH = (bf16_t*)(wsp + WS_YSH);

__global__ void __launch_bounds__(NTHR, 2) mega(Args args) {
    extern __shared__ __attribute__((aligned(16))) unsigned char lds_raw[];
    unsigned char* ws = args.ws;
    unsigned* ctl = (unsigned*)(ws + WS_CTL);
    volatile LAS unsigned* bst = (volatile LAS unsigned*)(lds_raw + LDS_BYTES - 16);
    if (threadIdx.x < 4) bst[threadIdx.x] = 0u;
    const int nbk = gridDim.x, bidk = blockIdx.x;
    __syncthreads();
    XcdBarrier bar; bar.bar = ctl + CW_BAR; bar.x = 0; bar.st = bst;
    if (MK_N_LAUNCHES == 1) bar = xcd_barrier_post(ctl + CW_BAR, bst);
    const int lo = args.ph_lo, hi = args.ph_hi;
    const int vcu = (nbk % 8 == 0) ? (bidk % 8) * (nbk / 8) + bidk / 8 : bidk;
    LAS unsigned char* ldsb = (LAS unsigned char*)lds_raw;
#define IN(k) (lo <= (k) && (k) < hi && (pass_ == 0 || ((k) >= REP_FROM && (k) != 8)))
#define SEAM(k) do { if (lo <= (k) && (k) + 1 < hi && (pass_ == 0 || (k) >= REP_FROM)) xcd_barrier(bar); } while (0)

    unsigned* CNT = (unsigned*)(ws + WS_CNTS);

    for (int pass_ = 0; pass_ < (REP_FROM < 12 ? 2 : 1); ++pass_) {
    if (pass_) xcd_barrier(bar);
    if (IN(0)) for (int rep_ = 0; rep_ < (((REPEAT_MASK >> 0) & 1) ? 2 : 1); ++rep_) {
        const Ctx c = mkctx(ws, lds_raw); PHASE_PTRS
        float* red = c.lds;
        if (c.tid == 0) for (int e = c.bid; e < NE; e += c.nb) CNT[(size_t)e * CNT_STRIDE] = 0u;
        for (int g = c.bid; g < 192; g += c.nb) {
            const int c4 = c.tid & 7, kr = c.tid >> 3;
            float4 w[16];
#pragma unroll
            for (int i = 0; i < 16; ++i) w[i] = *(const float4*)&w_ada[(size_t)(64 * i + kr) * 6144 + g * 32 + 4 * c4];
            float4 a0 = make_float4(0.f, 0.f, 0.f, 0.f), a1 = a0;
#pragma unroll
            for (int i = 0; i < 16; ++i) { const int k = 64 * i + kr; const float c0 = cvec[k], c1 = cvec[DM + k]; const float f0 = c0 * sigmoidf_(c0), f1 = c1 * sigmoidf_(c1);
                a0.x += f0 * w[i].x; a0.y += f0 * w[i].y; a0.z += f0 * w[i].z; a0.w += f0 * w[i].w; a1.x += f1 * w[i].x; a1.y += f1 * w[i].y; a1.z += f1 * w[i].z; a1.w += f1 * w[i].w; }
            __syncthreads();
            *(float4*)&red[(kr * 8 + c4) * 4] = a0; *(float4*)&red[2048 + (kr * 8 + c4) * 4] = a1;
            __syncthreads();
            if (c.tid < 64) { const int b = c.tid >> 5, cc = c.tid & 31; float sacc = 0.f; for (int j = 0; j < 64; ++j) sacc += red[b * 2048 + j * 32 + cc]; mod[b * 6144 + g * 32 + cc] = sacc + b_ada[g * 32 + cc]; }
        }
        __syncthreads();
        for (int idx = c.bid * NTHR + c.tid; idx < SEQ * 16; idx += c.nb * NTHR) {
            const int s = idx >> 4, i = idx & 15, f = i & 7;
            const float inv = powf(10000.f, -(float)f / 8.f);
            const float pos = (float)((i < 8) ? (s >> 6) : (s & 63));
            const float ang = pos * inv;
            cosm[idx] = cosf(ang); sinm[idx] = sinf(ang);
        }
        for (int idx = c.bid * NTHR + c.tid; idx < SEQ * 32; idx += c.nb * NTHR) {
            const int s = idx >> 5, i = idx & 31, f = i & 15;
            const float inv = powf(10000.f, -(float)f / 16.f);
            const float pos = (float)((i < 16) ? (s >> 6) : (s & 63));
            const float ang = pos * inv;
            cosg[idx] = cosf(ang); sing[idx] = sinf(ang);
        }
        LAS float* scr = (LAS float*)(ldsb + 8192 + c.wave * 8448);
        constexpr int I_BIG = 37 * 16;
        constexpr int I_QB = 24 * 4;
        constexpr int I_KVB = 32 * 2;
        constexpr int I_OUT = 32 * 16;
        constexpr int I_RS = 24 * 16;
        constexpr int I_DS = 32 * 4;
        const int I_EXP = (c.nb == NE && (CONV_MODE == 1 || CONV_MODE == 5)) ? 0 : NE * 384;
        const int I_TOT = I_BIG + I_QB + I_KVB + I_OUT + I_RS + I_DS + I_EXP;
        for (int it = c.gw; it < I_TOT; it += c.ngw) {
            int r = it;
            if (r < I_BIG) { const int grp = r >> 4, kb = r & 15; const int col0 = grp * 32, drow = (grp < 13) ? grp * 32 : 2304 + (grp - 13) * 32;
                cvt_item(w_in, INC, col0, kb * 64, WBIGT, drow, DM, nullptr, scr, c.lane); continue; }
            r -= I_BIG;
            if (r < I_QB) { const int grp = r >> 2, kb = r & 3; cvt_item(w_q_b, 768, grp * 32, kb * 64, WQBT, grp * 32, 256, g_q_a, scr, c.lane); continue; }
            r -= I_QB;
            if (r < I_KVB) { const int grp = r >> 1, kb = r & 1; cvt_item(w_kv_b, 1024, grp * 32, kb * 64, WKVBT, grp * 32, 256, g_kv_a, scr, c.lane); continue; }
            r -= I_KVB;
            if (r < I_OUT) { const int grp = r >> 4, kb = r & 15; cvt_item(w_out, DM, grp * 32, kb * 64, WOUTT, grp * 32, DM, (kb < 8) ? g_mla_out : (g_gqa_out - 512), scr, c.lane); continue; }
            r -= I_OUT;
            if (r < I_RS) { const int grp = r >> 4, kb = r & 15;
                if (grp < 8) cvt_item(w_router, NE, grp * 32, kb * 64, WRST, grp * 32, DM, nullptr, scr, c.lane);
                else { const int q = grp - 8, blk = q >> 2, sub = q & 3;
                    cvt_item((blk & 1) ? w_up_s : w_gate_s, EFF, (blk >> 1) * 128 + sub * 32, kb * 64, WRST, 256 + blk * 128 + sub * 32, DM, nullptr, scr, c.lane); }
                continue; }
            r -= I_RS;
            if (r < I_DS) { const int grp = r >> 2, kb = r & 3; cvt_item(w_down_s, DM, grp * 32, kb * 64, WDST, grp * 32, EFF, nullptr, scr, c.lane); continue; }
            r -= I_DS;
            { const int e = r / 384, q = r % 384;
              if (q < 256) { const int up = q >> 7, q2 = q & 127, grp = q2 >> 4, kb = q2 & 15;
                  const int drow = ((grp < 4) ? grp * 32 : 256 + (grp - 4) * 32) + up * 128;
                  cvt_item((up ? w_up_e : w_gate_e) + (size_t)e * DM * EFF, EFF, grp * 32, kb * 64, WGUT + (size_t)e * 512 * DM, drow, DM, nullptr, scr, c.lane); }
              else { const int q2 = q - 256, grp = q2 >> 2, kb = q2 & 3;
                  cvt_item(w_down_e + (size_t)e * EFF * DM, DM, grp * 32, kb * 64, WDT + (size_t)e * DM * EFF, grp * 32, EFF, nullptr, scr, c.lane); } }
        }
        const int gt = c.bid * NTHR + c.tid, ngt = c.nb * NTHR;
        for (int i = gt; i < 96 * 1024 / 8; i += ngt) *(uint4*)(WBIGT + (size_t)416 * DM + (size_t)i * 8) = make_uint4(0u, 0u, 0u, 0u);
        for (int i = gt; i < 1024 * 16; i += ngt) { const int n = i >> 4, q = i & 15; *(uint4*)(WKVBT + (size_t)n * 256 + 128 + q * 8) = make_uint4(0u, 0u, 0u, 0u); }
        for (int i = gt; i < 1024 * 64; i += ngt) { const int k = i >> 6, q = i & 63; const float4 v = *(const float4*)&w_in[(size_t)k * INC + q * 4]; uint2 o; o.x = pk2(v.x, v.y); o.y = pk2(v.z, v.w); *(uint2*)(WINQ + (size_t)k * 256 + q * 4) = o; }
        for (int i = gt; i < 1024 * 64; i += ngt) { const int k = i >> 6, q = i & 63; uint2 o = make_uint2(0u, 0u);
            if (q < 32) { const float4 v = *(const float4*)&w_in[(size_t)k * INC + 256 + q * 4]; o.x = pk2(v.x, v.y); o.y = pk2(v.z, v.w); }
            *(uint2*)(WINKV + (size_t)k * 256 + q * 4) = o; }
    }
    SEAM(0);

    if (IN(1)) for (int rep_ = 0; rep_ < (((REPEAT_MASK >> 1) & 1) ? 2 : 1); ++rep_) {
        const Ctx c = mkctx(ws, lds_raw); PHASE_PTRS
        { pg8::DenseOrder S; S.init(768, 1024, 256, WINQ, c.nb, c.bid); pg8::EpiBf16 E{WBIGT + (size_t)512 * DM, DM};
          pg8::gemm_phase<pg8::EpiBf16, pg8::DenseOrder, true>(ldsb, WQBT, 256, S, E); }
        { pg8::DenseOrder S; S.init(1024, 1024, 256, WINKV, c.nb, (c.bid >= 12 && c.nb >= 28) ? c.bid - 12 : c.bid + (c.nb >= 28 ? c.nb : 0)); pg8::EpiBf16 E{WBIGT + (size_t)1280 * DM, DM};
          pg8::gemm_phase<pg8::EpiBf16, pg8::DenseOrder, true>(ldsb, WKVBT, 256, S, E); }
        for (int m0 = c.gw; m0 < NTOK; m0 += 2 * c.ngw) {
            float4 v[2][4]; float ss[2];
#pragma unroll
            for (int q = 0; q < 2; ++q) { const int m = m0 + q * c.ngw; ss[q] = 0.f;
#pragma unroll
                for (int j = 0; j < 4; ++j) { v[q][j] = *(const float4*)&x[(size_t)m * DM + 4 * c.lane + 256 * j]; } }
#pragma unroll
            for (int q = 0; q < 2; ++q) {
                const int m = m0 + q * c.ngw; const int b = m / SEQ; const float* md = mod + b * 6144;
#pragma unroll
                for (int j = 0; j < 4; ++j) ss[q] += v[q][j].x * v[q][j].x + v[q][j].y * v[q][j].y + v[q][j].z * v[q][j].z + v[q][j].w * v[q][j].w;
                const float rstd = rsqrtf(wave_sum(ss[q]) * (1.f / DM) + EPS);
#pragma unroll
                for (int j = 0; j < 4; ++j) {
                    const int cc = 4 * c.lane + 256 * j;
                    const float4 g = *(const float4*)&g_pre_mix[cc], sc = *(const float4*)&md[1024 + cc], sh = *(const float4*)&md[cc];
                    uint2 o;
                    o.x = pk2(v[q][j].x * rstd * g.x * (1.f + sc.x) + sh.x, v[q][j].y * rstd * g.y * (1.f + sc.y) + sh.y);
                    o.y = pk2(v[q][j].z * rstd * g.z * (1.f + sc.z) + sh.z, v[q][j].w * rstd * g.w * (1.f + sc.w) + sh.w);
                    *(uint2*)&H2[(size_t)m * DM + cc] = o;
                }
            }
        }
    }
    SEAM(1);

    if (IN(2)) for (int rep_ = 0; rep_ < (((REPEAT_MASK >> 2) & 1) ? 2 : 1); ++rep_) {
        const Ctx c = mkctx(ws, lds_raw); PHASE_PTRS
        pg8::DenseOrder S; S.init(NTOK, 3072, DM, WBIGT, c.nb, c.bid); pg8::EpiBf16 E{PBUF, 3072};
        pg8::gemm_phase<pg8::EpiBf16, pg8::DenseOrder, true>(ldsb, H2, DM, S, E);
    }
    SEAM(2);

    if (IN(3)) for (int rep_ = 0; rep_ < (((REPEAT_MASK >> 3) & 1) ? 2 : 1); ++rep_) {
        const Ctx c = mkctx(ws, lds_raw); PHASE_PTRS
        unsigned* kmaxL = (unsigned*)lds_raw;
        if (c.tid < 18) kmaxL[c.tid] = 0u;
        __syncthreads();
        uint4 nraw[6];
#pragma unroll
        for (int j = 0; j < 6; ++j) nraw[j] = *(const uint4*)(PBUF + (size_t)c.gw * 3072 + 512 * j + 8 * c.lane);
        for (int m = c.gw; m < NTOK; m += c.ngw) {
            const int b = m / SEQ, s = m % SEQ;
            uint4 raw[6];
#pragma unroll
            for (int j = 0; j < 6; ++j) raw[j] = nraw[j];
            if (m + c.ngw < NTOK) {
#pragma unroll
                for (int j = 0; j < 6; ++j) nraw[j] = *(const uint4*)(PBUF + (size_t)(m + c.ngw) * 3072 + 512 * j + 8 * c.lane);
            }
            float rq, rkv;
            {
                float v[8]; { const uint4 u = raw[0]; v[0] = bf2f(u.x & 0xffffu); v[1] = bf2f(u.x >> 16); v[2] = bf2f(u.y & 0xffffu); v[3] = bf2f(u.y >> 16); v[4] = bf2f(u.z & 0xffffu); v[5] = bf2f(u.z >> 16); v[6] = bf2f(u.w & 0xffffu); v[7] = bf2f(u.w >> 16); }
                float sq = 0.f;
#pragma unroll
                for (int i = 0; i < 8; ++i) sq += v[i] * v[i];
                rq = rsqrtf(wave_sum(c.lane < 32 ? sq : 0.f) * (1.f / QLORA) + EPS);
                rkv = rsqrtf(wave_sum((c.lane >= 32 && c.lane < 48) ? sq : 0.f) * (1.f / KVLORA) + EPS);
                if (c.lane >= 48 && c.lane < 52) {
                    const int i0 = 4 * (c.lane - 48); uint4 o; unsigned ow[4];
#pragma unroll
                    for (int pq = 0; pq < 4; ++pq) { const float cs = cosm[s * 16 + i0 + pq], sn = sinm[s * 16 + i0 + pq]; ow[pq] = pk2(v[2 * pq] * cs - v[2 * pq + 1] * sn, v[2 * pq] * sn + v[2 * pq + 1] * cs); }
                    o.x = ow[0]; o.y = ow[1]; o.z = ow[2]; o.w = ow[3];
#pragma unroll
                    for (int h = 0; h < MH; ++h) *(uint4*)&KM[((size_t)(b * MH + h) * SEQ + s) * DQKM + MNOPE + 2 * i0] = o;
                    float pq = 0.f;
#pragma unroll
                    for (int i = 0; i < 8; ++i) pq += v[i] * v[i];
                    pq += dppmov<0xB1, 0xF>(0.f, pq); pq += dppmov<0x4E, 0xF>(0.f, pq);
                    if (c.lane == 48) atomicMax(&kmaxL[16 + b], __builtin_bit_cast(unsigned, pq));
                }
            }
#pragma unroll
            for (int j = 1; j < 6; ++j) {
                const int col0 = 512 * j + 8 * c.lane;
                float v[8]; { const uint4 u = raw[j]; v[0] = bf2f(u.x & 0xffffu); v[1] = bf2f(u.x >> 16); v[2] = bf2f(u.y & 0xffffu); v[3] = bf2f(u.y >> 16); v[4] = bf2f(u.z & 0xffffu); v[5] = bf2f(u.z >> 16); v[6] = bf2f(u.w & 0xffffu); v[7] = bf2f(u.w >> 16); }
                if (col0 < 1280) {
                    const int qc = col0 - 512, h = qc / DQKM, d0 = qc % DQKM; const float sc = rq * C2M;
                    uint4 o; unsigned ow[4];
                    if (d0 >= MNOPE) { const int i0 = (d0 - MNOPE) >> 1;
#pragma unroll
                        for (int pq = 0; pq < 4; ++pq) { const float cs = cosm[s * 16 + i0 + pq], sn = sinm[s * 16 + i0 + pq]; ow[pq] = pk2((v[2 * pq] * cs - v[2 * pq + 1] * sn) * sc, (v[2 * pq] * sn + v[2 * pq + 1] * cs) * sc); }
                    } else {
#pragma unroll
                        for (int pq = 0; pq < 4; ++pq) ow[pq] = pk2(v[2 * pq] * sc, v[2 * pq + 1] * sc);
                    }
                    o.x = ow[0]; o.y = ow[1]; o.z = ow[2]; o.w = ow[3];
                    *(uint4*)&QM[((size_t)(b * MH + h) * SEQ + s) * DQKM + d0] = o;
                } else if (col0 < 2304) {
                    const int kc = col0 - 1280, h = kc >> 7, d0 = kc & 127;
                    uint4 o; o.x = pk2(v[0] * rkv, v[1] * rkv); o.y = pk2(v[2] * rkv, v[3] * rkv); o.z = pk2(v[4] * rkv, v[5] * rkv); o.w = pk2(v[6] * rkv, v[7] * rkv);
                    if (d0 < MNOPE) { *(uint4*)&KM[((size_t)(b * MH + h) * SEQ + s) * DQKM + d0] = o;
                        float kq = 0.f;
#pragma unroll
                        for (int i = 0; i < 8; ++i) kq += (v[i] * rkv) * (v[i] * rkv);
                        kq += dppmov<0xB1, 0xF>(0.f, kq); kq += dppmov<0x4E, 0xF>(0.f, kq); kq += dppmov<0x141, 0xF>(0.f, kq);
                        if ((c.lane & 7) == 0) atomicMax(&kmaxL[b * 8 + h], __builtin_bit_cast(unsigned, kq)); }
                    else *(uint4*)&VM[((size_t)(b * MH + h) * SEQ + s) * MV + (d0 - MNOPE)] = o;
                } else if (col0 < 2944) {
                    const bool isq = col0 < 2816; const int hc = isq ? (col0 - 2304) : (col0 - 2816), h = hc >> 6, d0 = hc & 63;
                    float sq = 0.f;
#pragma unroll
                    for (int i = 0; i < 8; ++i) sq += v[i] * v[i];
                    sq += __shfl_xor(sq, 1); sq += __shfl_xor(sq, 2); sq += __shfl_xor(sq, 4);
                    const float rs = rsqrtf(sq * (1.f / GD) + EPS) * (isq ? C2G : 1.f); const float* gh = isq ? g_q_head : g_k_head;
                    uint4 o; unsigned ow[4];
#pragma unroll
                    for (int pq = 0; pq < 4; ++pq) { const int d = d0 + 2 * pq; const float cs = cosg[s * 32 + (d >> 1)], sn = sing[s * 32 + (d >> 1)];
                        const float x0 = v[2 * pq] * rs * gh[d], x1 = v[2 * pq + 1] * rs * gh[d + 1]; ow[pq] = pk2(x0 * cs - x1 * sn, x0 * sn + x1 * cs); }
                    o.x = ow[0]; o.y = ow[1]; o.z = ow[2]; o.w = ow[3];
                    if (isq) *(uint4*)&QG[((size_t)(b * GH + h) * SEQ + s) * GD + d0] = o;
                    else *(uint4*)&KG[((size_t)(b * GKV + h) * SEQ + s) * GD + d0] = o;
                } else {
                    const int hc = col0 - 2944, h = hc >> 6, d0 = hc & 63;
                    *(uint4*)&VG[((size_t)(b * GKV + h) * SEQ + s) * GD + d0] = raw[j];
                }
            }
        }
        __syncthreads();
        if (c.tid < 18) atomicMax(ctl + CW_KMAX + c.tid, kmaxL[c.tid]);
    }
    SEAM(3);

    if (IN(4)) for (int rep_ = 0; rep_ < (((REPEAT_MASK >> 4) & 1) ? 2 : 1); ++rep_) {
        const Ctx c = mkctx(ws, lds_raw); PHASE_PTRS
        att::ConvState cs;
        { const int e = (c.nb == NE) ? c.bid : 0;
          cs.cj = 0; cs.jbase = 384 * c.wave;
          cs.wg = (const char*)(w_gate_e + (size_t)e * DM * EFF); cs.wu = (const char*)(w_up_e + (size_t)e * DM * EFF); cs.wd = (const char*)(w_down_e + (size_t)e * EFF * DM);
          cs.dgu = (char*)(WGUT + (size_t)e * 512 * DM); cs.dd = (char*)(WDT + (size_t)e * DM * EFF);
          cs.ldsbuf = (unsigned)(uintptr_t)lds_raw + att::CONV_LDS + (CONV_MODE >= 5 ? 0 : c.wave * 4096); cs.rdbuf = (att::lds_cptr)lds_raw + att::CONV_LDS + (CONV_MODE >= 5 ? 0 : c.wave * 4096);
          if (CONV_MODE >= 5) cs.jbase = 0;
          if (CONV_MODE != 0 && CONV_MODE < 5) for (int i = 0; i < 3; ++i) { const att::ConvJob q = att::conv_job(cs, cs.cj);
              att::glds16_s(q.sbase, (unsigned)(c.lane >> 3) * q.ldwB + (unsigned)(c.lane & 7) * 16u, (unsigned)__builtin_amdgcn_readfirstlane(cs.ldsbuf + (cs.cj & 3) * 1024)); ++cs.cj; }
          asm volatile("s_waitcnt vmcnt(0)" ::: "memory"); }
        float mfix;
        { const float gq = wave_max(fabsf(g_q_head[c.lane])), gk = wave_max(fabsf(g_k_head[c.lane])); mfix = fminf(64.f * C2G * gq * gk * 1.03f + 0.5f, 60.f); }
        for (int uu = vcu; uu < 512; uu += c.nb) {
            const int bh = uu >> 5, b = bh >> 3, h = bh & 7, qp = uu & 31;
            const int q0 = qp * 256;
            const float kb2 = __builtin_bit_cast(float, ctl[CW_KMAX + b * 8 + h]) + __builtin_bit_cast(float, ctl[CW_KMAX + 16 + b]);
            att::unit96<8>(QM + (size_t)(b * MH + h) * SEQ * DQKM, KM + (size_t)(b * MH + h) * SEQ * DQKM, VM + (size_t)(b * MH + h) * SEQ * MV,
                                 O + ((size_t)b * SEQ + q0) * DM + h * 64, OSTAT + ((size_t)b * SEQ + q0) * 16 + h, q0, (char*)lds_raw, cs, kb2);
            att::unit64<8>(QG + (size_t)(b * GH + h) * SEQ * GD, KG + (size_t)(b * GKV + (h >> 2)) * SEQ * GD, VG + (size_t)(b * GKV + (h >> 2)) * SEQ * GD,
                                 O + ((size_t)b * SEQ + q0) * DM + (8 + h) * 64, OSTAT + ((size_t)b * SEQ + q0) * 16 + 8 + h, q0, (char*)lds_raw, cs, mfix);
        }
#if CONV_MODE >= 5
        {
            using namespace att;
            const int wid = c.wave, lane = c.lane; const bool rst = wid >= 6;
            for (int r4 = 0; r4 < 3; ++r4) { CONV_DRAIN(); ++cs.cj; }
        }
#endif
    }
    SEAM(4);

    if (IN(5)) for (int rep_ = 0; rep_ < (((REPEAT_MASK >> 5) & 1) ? 2 : 1); ++rep_) {
        const Ctx c = mkctx(ws, lds_raw); PHASE_PTRS
        pg8::DenseOrder S; S.init(NTOK, DM, DM, WOUTT, c.nb, c.bid);
        LAS float* rtab = (LAS float*)(ldsb + pg8::STAGE_BYTES);
        { pg8::Unit u0; if (S.next(0, u0) && c.tid < 256) { const float4* sp = (const float4*)&OSTAT[(size_t)(u0.pm * 256 + c.tid) * 16]; const float4 s0 = sp[0], s1 = sp[1], s2 = sp[2], s3 = sp[3];
            const float sm = ((s0.x + s0.y) + (s0.z + s0.w)) + ((s1.x + s1.y) + (s1.z + s1.w)), sg = ((s2.x + s2.y) + (s2.z + s2.w)) + ((s3.x + s3.y) + (s3.z + s3.w));
            const float rm = rsqrtf(sm * (1.f / 512) + EPS), rg = rsqrtf(sg * (1.f / 512) + EPS); rtab[2 * c.tid] = rm / rg; rtab[2 * c.tid + 1] = rg; }
          __syncthreads(); }
        pg8::EpiBf16RowScale E{MIXED, DM, rtab};
        pg8::gemm_phase<pg8::EpiBf16RowScale, pg8::DenseOrder, true, false, true>(ldsb, O, DM, S, E, nullptr);
    }
    SEAM(5);

    if (IN(6)) for (int rep_ = 0; rep_ < (((REPEAT_MASK >> 6) & 1) ? 2 : 1); ++rep_) {
        const Ctx c = mkctx(ws, lds_raw); PHASE_PTRS
        for (int m0 = c.gw; m0 < NTOK; m0 += 2 * c.ngw) {
            uint2 mu[2][4]; float4 xq[2][4];
#pragma unroll
            for (int q = 0; q < 2; ++q)
#pragma unroll
                for (int j = 0; j < 4; ++j) { const int m = m0 + q * c.ngw; mu[q][j] = *(const uint2*)&MIXED[(size_t)m * DM + 4 * c.lane + 256 * j]; xq[q][j] = *(const float4*)&x[(size_t)m * DM + 4 * c.lane + 256 * j]; }
#pragma unroll
            for (int q = 0; q < 2; ++q) {
                const int m = m0 + q * c.ngw; const int b = m / SEQ; const float* md = mod + b * 6144;
                float4 v[4], xr[4]; float ss = 0.f;
#pragma unroll
                for (int j = 0; j < 4; ++j) { const uint2 u = mu[q][j];
                    v[j].x = bf2f(u.x & 0xffffu); v[j].y = bf2f(u.x >> 16); v[j].z = bf2f(u.y & 0xffffu); v[j].w = bf2f(u.y >> 16);
                    ss += v[j].x * v[j].x + v[j].y * v[j].y + v[j].z * v[j].z + v[j].w * v[j].w; }
                const float rstd = rsqrtf(wave_sum(ss) * (1.f / DM) + EPS);
                float ss1 = 0.f;
#pragma unroll
                for (int j = 0; j < 4; ++j) {
                    const int cc = 4 * c.lane + 256 * j;
                    const float4 g = *(const float4*)&g_post_mix[cc], gt = *(const float4*)&md[2048 + cc], xx = xq[q][j];
                    xr[j].x = xx.x + gt.x * (v[j].x * rstd * g.x); xr[j].y = xx.y + gt.y * (v[j].y * rstd * g.y);
                    xr[j].z = xx.z + gt.z * (v[j].z * rstd * g.z); xr[j].w = xx.w + gt.w * (v[j].w * rstd * g.w);
                    ss1 += xr[j].x * xr[j].x + xr[j].y * xr[j].y + xr[j].z * xr[j].z + xr[j].w * xr[j].w;
                    { uint2 xo; xo.x = pk2(xr[j].x, xr[j].y); xo.y = pk2(xr[j].z, xr[j].w); *(uint2*)&X1[(size_t)m * DM + cc] = xo; }
                }
                const float rstd1 = rsqrtf(wave_sum(ss1) * (1.f / DM) + EPS);
#pragma unroll
                for (int j = 0; j < 4; ++j) {
                    const int cc = 4 * c.lane + 256 * j;
                    const float4 g = *(const float4*)&g_pre_ffn[cc], sc = *(const float4*)&md[4096 + cc], sh = *(const float4*)&md[3072 + cc];
                    uint2 pk;
                    pk.x = pk2(xr[j].x * rstd1 * g.x * (1.f + sc.x) + sh.x, xr[j].y * rstd1 * g.y * (1.f + sc.y) + sh.y);
                    pk.y = pk2(xr[j].z * rstd1 * g.z * (1.f + sc.z) + sh.z, xr[j].w * rstd1 * g.w * (1.f + sc.w) + sh.w);
                    *(uint2*)&H2[(size_t)m * DM + cc] = pk;
                }
            }
        }
    }
    SEAM(6);

    if (IN(7)) for (int rep_ = 0; rep_ < (((REPEAT_MASK >> 7) & 1) ? 2 : 1); ++rep_) {
        const Ctx c = mkctx(ws, lds_raw); PHASE_PTRS
        pg8::DenseOrder S; S.init(NTOK, 768, DM, WRST, c.nb, c.bid); pg8::EpiRS E{LOG, ACTS};
        pg8::gemm_phase<pg8::EpiRS, pg8::DenseOrder, true>(ldsb, H2, DM, S, E);
    }
    SEAM(7);

    if (IN(8)) for (int rep_ = 0; rep_ < (((REPEAT_MASK >> 8) & 1) ? 2 : 1); ++rep_) {
        const Ctx c = mkctx(ws, lds_raw); PHASE_PTRS
        const float4 bb = *(const float4*)&b_router[4 * c.lane];
        const unsigned rowL = (unsigned)(uintptr_t)lds_raw + c.wave * 8192;
        const LAS unsigned char* rowP = ldsb + c.wave * 8192;
        const bool cnt_sort = (MK_N_LAUNCHES == 1) && c.nb == NE && 8 * c.ngw == NTOK && lo < 8 && hi > 9;
        int* histg = (int*)(lds_raw + 65536); int* HIST = (int*)(wsp + WS_HIST);
        if (cnt_sort) { if (c.tid < NE) histg[c.tid] = 0; __syncthreads(); }
        for (int mb = c.gw; mb < NTOK; mb += 8 * c.ngw) {
#pragma unroll
          for (int r = 0; r < 8; ++r) { const int mr = mb + r * c.ngw; if (mr < NTOK) att::glds16(LOG + (size_t)mr * NE + 4 * c.lane, (unsigned)__builtin_amdgcn_readfirstlane(rowL + r * 1024)); }
          asm volatile("s_waitcnt vmcnt(0)" ::: "memory");
          int my_e = 0; float my_s = 0.f; int rb = 0;
#pragma unroll 1
          for (int m = mb; m < NTOK && rb < 8; m += c.ngw) {
            typedef float f32x4v __attribute__((ext_vector_type(4)));
            const f32x4v lg = *(const LAS f32x4v*)(rowP + rb * 1024 + c.lane * 16);
            const float s0 = __builtin_amdgcn_rcpf(1.f + __builtin_amdgcn_exp2f(lg.x * -1.44269504f)), s1 = __builtin_amdgcn_rcpf(1.f + __builtin_amdgcn_exp2f(lg.y * -1.44269504f));
            const float s2 = __builtin_amdgcn_rcpf(1.f + __builtin_amdgcn_exp2f(lg.z * -1.44269504f)), s3 = __builtin_amdgcn_rcpf(1.f + __builtin_amdgcn_exp2f(lg.w * -1.44269504f));
            const int o0 = ford(s0 + bb.x), o1 = ford(s1 + bb.y), o2 = ford(s2 + bb.z), o3 = ford(s3 + bb.w);
            const int e0 = 4 * c.lane, g = c.lane >> 3;
            const int IMIN = (int)0x80000000;
            int gkey;
            {
                const int h01 = imax_(o0, o1), l01 = imin_(o0, o1), h23 = imax_(o2, o3), l23 = imin_(o2, o3);
                const int a1 = imax_(h01, h23), a2 = imax_(imin_(h01, h23), (h01 >= h23) ? l01 : l23);
                const int g1 = grp8_max_i(a1);
                const unsigned long long bm = __ballot(a1 == g1);
                const unsigned grpbits = (unsigned)(bm >> (8 * g)) & 0xffu;
                const bool first = (a1 == g1) && ((grpbits & ((1u << (c.lane & 7)) - 1u)) == 0u);
                const int g2 = grp8_max_i(first ? a2 : a1);
                gkey = (ford(funord(g1) + funord(g2)) & ~7) | (7 - g);
            }
            int rank = 0;
#pragma unroll
            for (int j = 0; j < 8; ++j) rank += (__builtin_amdgcn_readlane(gkey, 8 * j) > gkey) ? 1 : 0;
            const bool sel = rank < 4;
            int k0 = sel ? ((o0 & ~0xff) | (255 - e0)) : IMIN, k1 = sel ? ((o1 & ~0xff) | (254 - e0)) : IMIN, k2 = sel ? ((o2 & ~0xff) | (253 - e0)) : IMIN, k3 = sel ? ((o3 & ~0xff) | (252 - e0)) : IMIN;
            int my_key = 0;
#pragma unroll 1
            for (int rnd = 0; rnd < TOPK; ++rnd) {
                const int mx = wave_max_i(imax_(imax_(k0, k1), imax_(k2, k3)));
                if (c.lane == 8 * rb + rnd) my_key = mx;
                k0 = (k0 == mx) ? IMIN : k0; k1 = (k1 == mx) ? IMIN : k1; k2 = (k2 == mx) ? IMIN : k2; k3 = (k3 == mx) ? IMIN : k3;
            }
            {
                const int ee = 255 - (my_key & 0xff), src = (ee >> 2) * 4;
                const float q0 = __builtin_bit_cast(float, __builtin_amdgcn_ds_bpermute(src, __builtin_bit_cast(int, s0))), q1 = __builtin_bit_cast(float, __builtin_amdgcn_ds_bpermute(src, __builtin_bit_cast(int, s1)));
                const float q2 = __builtin_bit_cast(float, __builtin_amdgcn_ds_bpermute(src, __builtin_bit_cast(int, s2))), q3 = __builtin_bit_cast(float, __builtin_amdgcn_ds_bpermute(src, __builtin_bit_cast(int, s3)));
                if ((c.lane >> 3) == rb) { my_e = ee; my_s = (ee & 2) ? ((ee & 1) ? q3 : q2) : ((ee & 1) ? q1 : q0); }
            }
            ++rb;
          }
          { const int rr = c.lane >> 3, k = c.lane & 7;
            const float tot = grp8_sum(my_s);
            const bool valid = rr < rb; const int id = (mb + rr * c.ngw) * TOPK + k; const float wt = my_s / tot * 2.5f;
            if (!cnt_sort) {
                if (valid) { const unsigned pos = atomicAdd(&CNT[(size_t)my_e * CNT_STRIDE], 1u);
                    LIST[(size_t)my_e * LCAP + pos] = id; POSREC[id] = (my_e << 16) | (int)pos; WTS[id] = wt; }
            } else {
                int lpos = 0; if (valid) lpos = atomicAdd(&histg[my_e], 1);
                __syncthreads();
                if (c.tid < NE) HIST[c.bid * NE + c.tid] = histg[c.tid];
                xcd_barrier(bar);
                { const int e = c.tid & (NE - 1); int acc0 = 0, acc1 = 0, acc2 = 0, acc3 = 0; int w = c.tid >> 8;
                  for (; w + 6 < c.bid; w += 8) { acc0 += HIST[w * NE + e]; acc1 += HIST[(w + 2) * NE + e]; acc2 += HIST[(w + 4) * NE + e]; acc3 += HIST[(w + 6) * NE + e]; }
                  for (; w < c.bid; w += 2) acc0 += HIST[w * NE + e];
                  histg[256 + c.tid] = (acc0 + acc1) + (acc2 + acc3); }
                __syncthreads();
                if (c.tid < NE) { const int bs = histg[256 + c.tid] + histg[512 + c.tid]; histg[768 + c.tid] = bs; if (c.bid == c.nb - 1) HIST[NE * NE + c.tid] = bs + histg[c.tid]; }
                __syncthreads();
                if (valid) { const int pos = histg[768 + my_e] + lpos;
                    LIST[(size_t)my_e * LCAP + pos] = id; POSREC[id] = (my_e << 16) | pos; WTS[id] = wt; }
            } }
        }
    }
    SEAM(8);

    LAS int* pre = (LAS int*)(ldsb + pg8::STAGE_BYTES);
    LAS int* offs = pre + 320; LAS int* cntl = offs + 320;
    if (IN(9) || IN(10) || IN(11)) {
        const Ctx c = mkctx(ws, lds_raw); PHASE_PTRS
        __syncthreads();
        if (c.tid < NE) cntl[c.tid] = ((MK_N_LAUNCHES == 1) && c.nb == NE && 8 * c.ngw == NTOK && lo < 8 && hi > 9) ? ((const int*)(wsp + WS_HIST))[NE * NE + c.tid] : (int)CNT[(size_t)c.tid * CNT_STRIDE];
        __syncthreads();
        if (c.tid <= NE) { int a = 0, o = 0; for (int j = 0; j < c.tid; ++j) { const int q = cntl[j]; a += (q + 255) >> 8; o += q; } pre[c.tid] = a; offs[c.tid] = o; }
        __syncthreads();
    }
    if (IN(9)) for (int rep_ = 0; rep_ < (((REPEAT_MASK >> 9) & 1) ? 2 : 1); ++rep_) {
        const Ctx c = mkctx(ws, lds_raw); PHASE_PTRS
        pg8::MoeOrder S{pre, offs, cntl, LIST, (const char*)WGUT, (size_t)512 * DM * 2, DM, 2, c.nb, vcu, 0};
        pg8::EpiAct E{ACT};
        pg8::gemm_phase<pg8::EpiAct, pg8::MoeOrder, true, true>(ldsb, H2, DM, S, E);
    }
    SEAM(9);

    if (IN(10)) for (int rep_ = 0; rep_ < (((REPEAT_MASK >> 10) & 1) ? 2 : 1); ++rep_) {
        const Ctx c = mkctx(ws, lds_raw); PHASE_PTRS
        { pg8::MoeOrder S{pre, offs, cntl, LIST, (const char*)WDT, (size_t)DM * EFF * 2, EFF, 4, c.nb, vcu, 1};
          pg8::EpiSlots E{(unsigned char*)SLOTS};
          pg8::gemm_phase<pg8::EpiSlots, pg8::MoeOrder, true>(ldsb, ACT, EFF, S, E); }
        { pg8::DenseOrder S; S.init(NTOK, DM, EFF, WDST, c.nb, c.bid); pg8::EpiBf16 E{YSH, DM};
          pg8::gemm_phase<pg8::EpiBf16, pg8::DenseOrder, true>(ldsb, ACTS, EFF, S, E); }
    }
    SEAM(10);

    if (IN(11)) for (int rep_ = 0; rep_ < (((REPEAT_MASK >> 11) & 1) ? 2 : 1); ++rep_) {
        const Ctx c = mkctx(ws, lds_raw); PHASE_PTRS
        const unsigned char* SL8 = (const unsigned char*)SLOTS;
        typedef float f32x2v __attribute__((ext_vector_type(2)));
        for (int m0 = c.gw; m0 < NTOK; m0 += 2 * c.ngw) {
            int srow[2][TOPK]; float swt[2][TOPK];
#pragma unroll
            for (int q = 0; q < 2; ++q)
#pragma unroll
                for (int k = 0; k < TOPK; ++k) { const int m = m0 + q * c.ngw; const int rec = POSREC[(size_t)m * TOPK + k]; srow[q][k] = offs[rec >> 16] + (rec & 0xffff); swt[q][k] = WTS[(size_t)m * TOPK + k] * (1.f / 16.f); }
#pragma unroll
            for (int q = 0; q < 2; ++q) {
                const int m = m0 + q * c.ngw; const int b = m / SEQ; const float* md = mod + b * 6144;
                const int cc = 16 * c.lane;
                float y[16]; float ss = 0.f;
#pragma unroll
                for (int hq = 0; hq < 2; ++hq) { const uint4 u = *(const uint4*)&YSH[(size_t)m * DM + cc + 8 * hq];
                    y[8 * hq + 0] = bf2f(u.x & 0xffffu); y[8 * hq + 1] = bf2f(u.x >> 16); y[8 * hq + 2] = bf2f(u.y & 0xffffu); y[8 * hq + 3] = bf2f(u.y >> 16);
                    y[8 * hq + 4] = bf2f(u.z & 0xffffu); y[8 * hq + 5] = bf2f(u.z >> 16); y[8 * hq + 6] = bf2f(u.w & 0xffffu); y[8 * hq + 7] = bf2f(u.w >> 16); }
#pragma unroll
                for (int k = 0; k < TOPK; ++k) { const uint4 u = *(const uint4*)&SL8[(size_t)srow[q][k] * DM + cc]; const float wk = swt[q][k];
                    const unsigned wds[4] = {u.x, u.y, u.z, u.w};
#pragma unroll
                    for (int d = 0; d < 4; ++d) { const f32x2v a = __builtin_amdgcn_cvt_pk_f32_fp8((int)wds[d], false), bb = __builtin_amdgcn_cvt_pk_f32_fp8((int)wds[d], true);
                        y[4 * d] += wk * a.x; y[4 * d + 1] += wk * a.y; y[4 * d + 2] += wk * bb.x; y[4 * d + 3] += wk * bb.y; } }
#pragma unroll
                for (int i = 0; i < 16; ++i) ss += y[i] * y[i];
                const float rstd = rsqrtf(wave_sum(ss) * (1.f / DM) + EPS);
#pragma unroll
                for (int hq = 0; hq < 4; ++hq) {
                    const int c4 = cc + 4 * hq;
                    const float4 g = *(const float4*)&g_post_ffn[c4], gt = *(const float4*)&md[5120 + c4]; const uint2 xu = *(const uint2*)&X1[(size_t)m * DM + c4];
                    float4 xx; xx.x = bf2f(xu.x & 0xffffu); xx.y = bf2f(xu.x >> 16); xx.z = bf2f(xu.y & 0xffffu); xx.w = bf2f(xu.y >> 16);
                    float4 r; r.x = xx.x + gt.x * (y[4 * hq] * rstd * g.x); r.y = xx.y + gt.y * (y[4 * hq + 1] * rstd * g.y);
                    r.z = xx.z + gt.z * (y[4 * hq + 2] * rstd * g.z); r.w = xx.w + gt.w * (y[4 * hq + 3] * rstd * g.w);
                    *(float4*)&args.out[(size_t)m * DM + c4] = r;
                }
            }
        }
    }
    }
#undef IN
#undef SEAM
}

constexpr int NPHASE = 12;

extern "C" void kernel_launch(void* const* d_in, const int* in_sizes, int n_in, void* d_out, int out_size, void* d_ws, size_t ws_size, hipStream_t stream) {
    static int grid = 0;
    if (grid == 0) {
        if (n_in != 26 || out_size != NTOK * DM || ws_size < WS_END) { fprintf(stderr, "kernel_launch: unexpected shapes (n_in %d, out %d, ws %zu)\n", n_in, out_size, ws_size); grid = -1; return; }
        int dev = 0, cus = 0, per_cu = 0;
        if (hipGetDevice(&dev) != hipSuccess || hipDeviceGetAttribute(&cus, hipDeviceAttributeMultiprocessorCount, dev) != hipSuccess) { grid = -1; return; }
        if (hipFuncSetAttribute((const void*)mega, hipFuncAttributeMaxDynamicSharedMemorySize, LDS_BYTES) != hipSuccess) { fprintf(stderr, "kernel_launch: hipFuncSetAttribute failed\n"); grid = -1; return; }
        if (hipOccupancyMaxActiveBlocksPerMultiprocessor(&per_cu, (const void*)mega, NTHR, LDS_BYTES) != hipSuccess || per_cu < 1) fprintf(stderr, "kernel_launch: occupancy query says %d\n", per_cu);
        (void)hipGetLastError();
        grid = cus;
    }
    if (grid < 0) return;
    (void)hipMemsetAsync((char*)d_ws + WS_CTL, 0, CTL_ZERO_BYTES, stream);
    Args a{};
    for (int i = 0; i < 26; ++i) a.in[i] = (const float*)d_in[i];
    a.out = (float*)d_out; a.ws = (unsigned char*)d_ws;
    if (MK_N_LAUNCHES == 1) { a.ph_lo = 0; a.ph_hi = NPHASE; hipLaunchKernelGGL(mega, dim3(grid), dim3(NTHR), LDS_BYTES, stream, a); }
    else for (int p = 0; p < NPHASE; ++p) { a.ph_lo = p; a.ph_hi = p + 1; hipLaunchKernelGGL(mega, dim3(grid), dim3(NTHR), LDS_BYTES, stream, a); }
}
```

```cpp
#include <hip/hip_runtime.h>
#include <cstdio>
#include <cstdint>

#ifndef REP_FROM
#define REP_FROM 99
#endif
#ifndef REPEAT_MASK
#define REPEAT_MASK 0
#endif
#ifndef CONV_MODE
#define CONV_MODE 5
#endif
#ifndef MK_N_LAUNCHES
#define MK_N_LAUNCHES 1
#endif

#ifndef ATTN_NAIVE
#define ATTN_NAIVE 0
#endif
#define LAS __attribute__((address_space(3)))
typedef unsigned short bf16_t;

constexpr int NB = 2, SEQ = 8192, NTOK = NB * SEQ, DM = 1024;
constexpr int QLORA = 256, KVLORA = 128, MROPE = 32, MNOPE = 64, MV = 64, MH = 8, DQKM = 96;
constexpr int GH = 8, GKV = 2, GD = 64;
constexpr int INC = 1184;
constexpr int C_QLAT = 0, C_KVLAT = 256, C_KROPE = 384, C_GQ = 416, C_GK = 928, C_GV = 1056;
constexpr int NE = 256, TOPK = 8, EFF = 256;
constexpr int LCAP = 16384;
constexpr float EPS = 1e-6f;
constexpr float LOG2E = 1.4426950408889634f;
constexpr float C2M = 0.10206207261596575f * LOG2E;
constexpr float C2G = 0.125f * LOG2E;

constexpr size_t MiB = 1u << 20;
constexpr size_t WS_CTL = 0, CTL_ZERO_BYTES = 32768;
constexpr size_t WS_MOD = 1 * MiB;
constexpr size_t WS_COSM = 2 * MiB, WS_SINM = 2 * MiB + 512 * 1024, WS_COSG = 3 * MiB, WS_SING = 4 * MiB;
constexpr size_t WS_WQBT = 5 * MiB;
constexpr size_t WS_WINQ = 5 * MiB + 512 * 1024;
constexpr size_t WS_WKVBT = 6 * MiB;
constexpr size_t WS_WINKV = 6 * MiB + 512 * 1024;
constexpr size_t WS_WDST = 7 * MiB;
constexpr size_t WS_H2 = 8 * MiB;
constexpr size_t WS_X1 = 40 * MiB;
constexpr size_t WS_CNTS = 72 * MiB;
constexpr int CNT_STRIDE = 1088;
constexpr size_t WS_HIST = 82 * MiB;
constexpr size_t WS_WTS = 104 * MiB;
constexpr size_t WS_OSTAT = 252 * MiB;
constexpr size_t WS_POSREC = 105 * MiB;
constexpr size_t WS_LIST = 106 * MiB;
constexpr size_t WS_WBIGT = 122 * MiB;
constexpr size_t WS_WOUTT = 128 * MiB;
constexpr size_t WS_WRST = 130 * MiB;
constexpr size_t WS_ACT = 132 * MiB;
constexpr size_t WS_LOG = 196 * MiB;
constexpr size_t WS_ACTS = 212 * MiB;
constexpr size_t WS_YSH = 220 * MiB;
constexpr size_t WS_SLOTS = 256 * MiB;
constexpr size_t WS_PBUF = 256 * MiB;
constexpr size_t WS_QM = 352 * MiB, WS_KM = 376 * MiB, WS_VM = 400 * MiB, WS_QG = 416 * MiB, WS_KG = 432 * MiB, WS_VG = 436 * MiB;
constexpr size_t WS_O = 440 * MiB;
constexpr size_t WS_MIXED = 472 * MiB;
constexpr size_t WS_WGUT = 512 * MiB;
constexpr size_t WS_WDT = 768 * MiB;
constexpr size_t WS_END = 896 * MiB;
constexpr size_t WS_HF = 512 * MiB, WS_PROJ = 576 * MiB, WS_H2F = 650 * MiB, WS_GS = 714 * MiB, WS_US = 730 * MiB, WS_ACTSF = 746 * MiB, WS_YSHF = 768 * MiB, WS_LOGF = 832 * MiB;
constexpr int CW_CNT = 1024;
constexpr int CW_KMAX = 2048;
constexpr int CW_BAR = 4096;

constexpr int LDS_BYTES = 147456;
constexpr int NTHR = 512, NWAVES = 8;

#define XB_TMO      128
#define XB_XCNT(j)  (256  + 64 * (j))
#define XB_XSUB(j)  (1280 + 64 * (j))
#define XB_XGEN(j)  (2304 + 64 * (j))
#define XB_TOP      3328
#define XB_TOPGEN   3392
#define XCD_BAR_WORDS 3456
#define XB_SPIN_CAP (1u << 18)
__device__ __forceinline__ unsigned xb_ld(unsigned* p)              { return __hip_atomic_load(p, __ATOMIC_RELAXED, __HIP_MEMORY_SCOPE_AGENT); }
__device__ __forceinline__ unsigned xb_add(unsigned* p, unsigned v) { return __hip_atomic_fetch_add(p, v, __ATOMIC_RELAXED, __HIP_MEMORY_SCOPE_AGENT); }
__device__ __forceinline__ unsigned xb_xcc_id() { return (unsigned)__builtin_amdgcn_s_getreg((3 << 11) | 20) & 0xFu; }
#define XB_SPIN(cond, bar) do { unsigned _sp = 0; while (cond) { __builtin_amdgcn_s_sleep(1); \
    if ((++_sp & 255u) == 0u) { if (xb_ld(&(bar)[XB_TMO])) break; if (_sp > XB_SPIN_CAP) { atomicAdd(&(bar)[XB_TMO], 1u); break; } } } } while (0)
struct XcdBarrier { unsigned* bar; unsigned x; volatile LAS unsigned* st; };
__device__ __forceinline__ XcdBarrier xcd_barrier_post(unsigned* bar, volatile LAS unsigned* st) {
    XcdBarrier b; b.bar = bar; b.x = xb_xcc_id(); b.st = st;
    if (threadIdx.x == 0) (void)xb_add(&bar[XB_XCNT(b.x)], 1u);
    return b;
}
__device__ __forceinline__ void xcd_barrier_complete(unsigned* bar, unsigned x, unsigned& nloc, unsigned& nx) {
    const unsigned G = gridDim.x * gridDim.y * gridDim.z;
    unsigned sum, cnt, mine, sp = 0u;
    for (;;) {
        sum = 0u; cnt = 0u; mine = 0u;
#pragma unroll
        for (unsigned j = 0; j < 16; ++j) { const unsigned c = xb_ld(&bar[XB_XCNT(j)]); sum += c; cnt += (c > 0u) ? 1u : 0u; mine = (j == x) ? c : mine; }
        if (sum == G) break;
        __builtin_amdgcn_s_sleep(1);
        if ((++sp & 255u) == 0u) { if (xb_ld(&bar[XB_TMO])) break; if (sp > XB_SPIN_CAP) { atomicAdd(&bar[XB_TMO], 1u); break; } }
    }
    nloc = mine > 0u ? mine : 1u; nx = cnt > 0u ? cnt : 1u;
}
__device__ __forceinline__ void xcd_barrier(const XcdBarrier& b) {
    asm volatile("s_waitcnt vmcnt(0)" ::: "memory");
    __syncthreads();
    if (threadIdx.x == 0) {
        unsigned* bar = b.bar;
        __builtin_amdgcn_s_waitcnt(0);
        unsigned nloc = b.st[0], nx = b.st[1];
        if (nloc == 0u) { xcd_barrier_complete(bar, b.x, nloc, nx); b.st[0] = nloc; b.st[1] = nx; }
        const unsigned old = xb_add(&bar[XB_XSUB(b.x)], 1u);
        const unsigned gen = old / nloc;
        if (old + 1u == (gen + 1u) * nloc) {
            __builtin_amdgcn_fence(__ATOMIC_RELEASE, "agent");
            asm volatile("s_waitcnt vmcnt(0)" ::: "memory");
            const unsigned og = xb_add(&bar[XB_TOP], 1u);
            const unsigned tg = og / nx;
            if (og + 1u == (tg + 1u) * nx) xb_add(&bar[XB_TOPGEN], 1u);
            else XB_SPIN(xb_ld(&bar[XB_TOPGEN]) == tg, bar);
            __builtin_amdgcn_fence(__ATOMIC_ACQUIRE, "agent");
            xb_add(&bar[XB_XGEN(b.x)], 1u);
            asm volatile("s_waitcnt vmcnt(0)" ::: "memory");
        } else {
            XB_SPIN(xb_ld(&bar[XB_XGEN(b.x)]) == gen, bar);
            __builtin_amdgcn_fence(__ATOMIC_ACQUIRE, "agent");
            asm volatile("s_waitcnt vmcnt(0)" ::: "memory");
        }
    }
    __syncthreads();
}

__device__ __forceinline__ unsigned f2bf(float f) { unsigned u = __builtin_bit_cast(unsigned, f); return (u + 0x7fffu + ((u >> 16) & 1u)) >> 16; }
__device__ __forceinline__ float bf2f(unsigned h) { return __builtin_bit_cast(float, h << 16); }
__device__ __forceinline__ unsigned pk2(float lo, float hi) { return f2bf(lo) | (f2bf(hi) << 16); }
template <int CTRL, int RM> __device__ __forceinline__ float dppmov(float old, float v) {
    return __builtin_bit_cast(float, __builtin_amdgcn_update_dpp(__builtin_bit_cast(int, old), __builtin_bit_cast(int, v), CTRL, RM, 0xF, false)); }
__device__ __forceinline__ float wave_sum(float v) {
    v += dppmov<0xB1, 0xF>(0.f, v);
    v += dppmov<0x4E, 0xF>(0.f, v);
    v += dppmov<0x141, 0xF>(0.f, v);
    v += dppmov<0x140, 0xF>(0.f, v);
    v += dppmov<0x142, 0xA>(0.f, v);
    v += dppmov<0x143, 0xC>(0.f, v);
    return __builtin_bit_cast(float, __builtin_amdgcn_readlane(__builtin_bit_cast(int, v), 63));
}
__device__ __forceinline__ float wave_max(float v) {
    const float NI = -INFINITY;
    v = fmaxf(v, dppmov<0xB1, 0xF>(NI, v)); v = fmaxf(v, dppmov<0x4E, 0xF>(NI, v)); v = fmaxf(v, dppmov<0x141, 0xF>(NI, v)); v = fmaxf(v, dppmov<0x140, 0xF>(NI, v));
    v = fmaxf(v, dppmov<0x142, 0xA>(NI, v)); v = fmaxf(v, dppmov<0x143, 0xC>(NI, v));
    return __builtin_bit_cast(float, __builtin_amdgcn_readlane(__builtin_bit_cast(int, v), 63));
}
template <int CTRL, int RM> __device__ __forceinline__ int dppmovi(int old, int v) { return __builtin_amdgcn_update_dpp(old, v, CTRL, RM, 0xF, false); }
__device__ __forceinline__ int imax_(int a, int b) { return a > b ? a : b; }
__device__ __forceinline__ int imin_(int a, int b) { return a < b ? a : b; }
__device__ __forceinline__ int wave_max_i(int v) {
    const int NI = (int)0x80000000;
    v = imax_(v, dppmovi<0xB1, 0xF>(NI, v)); v = imax_(v, dppmovi<0x4E, 0xF>(NI, v)); v = imax_(v, dppmovi<0x141, 0xF>(NI, v)); v = imax_(v, dppmovi<0x140, 0xF>(NI, v));
    v = imax_(v, dppmovi<0x142, 0xA>(NI, v)); v = imax_(v, dppmovi<0x143, 0xC>(NI, v));
    return __builtin_amdgcn_readlane(v, 63);
}
__device__ __forceinline__ int grp8_max_i(int v) {
    const int NI = (int)0x80000000;
    v = imax_(v, dppmovi<0xB1, 0xF>(NI, v)); v = imax_(v, dppmovi<0x4E, 0xF>(NI, v)); v = imax_(v, dppmovi<0x141, 0xF>(NI, v)); return v;
}
__device__ __forceinline__ int ford(float f) { const int b = __builtin_bit_cast(int, f); return b ^ ((b >> 31) & 0x7fffffff); }
__device__ __forceinline__ float funord(int k) { return __builtin_bit_cast(float, k ^ ((k >> 31) & 0x7fffffff)); }
__device__ __forceinline__ float grp8_sum(float v) {
    v += dppmov<0xB1, 0xF>(0.f, v); v += dppmov<0x4E, 0xF>(0.f, v); v += dppmov<0x141, 0xF>(0.f, v); return v;
}
__device__ __forceinline__ float grp8_max(float v) {
    const float NI = -INFINITY;
    v = fmaxf(v, dppmov<0xB1, 0xF>(NI, v)); v = fmaxf(v, dppmov<0x4E, 0xF>(NI, v)); v = fmaxf(v, dppmov<0x141, 0xF>(NI, v)); return v;
}
__device__ __forceinline__ float sigmoidf_(float x) { return 1.f / (1.f + __expf(-x)); }

struct Args { const float* in[26]; float* out; unsigned char* ws; int ph_lo, ph_hi; };

struct Ctx {
    int tid, lane, wave, bid, nb, gw, ngw;
    unsigned char* ws; float* lds;
};
__device__ __forceinline__ Ctx mkctx(unsigned char* ws, unsigned char* lds_raw) {
    Ctx c; int t = threadIdx.x; asm volatile("" : "+v"(t));
    c.tid = t; c.lane = t & 63; c.wave = __builtin_amdgcn_readfirstlane(t >> 6);
    c.bid = blockIdx.x; c.nb = gridDim.x; c.gw = c.bid * NWAVES + c.wave; c.ngw = c.nb * NWAVES; c.ws = ws; c.lds = (float*)lds_raw; return c;
}

namespace att {
using bf16x8 = __attribute__((ext_vector_type(8))) short;
using s16x4 = __attribute__((ext_vector_type(4))) short;
using f32x16 = __attribute__((ext_vector_type(16))) float;
using u32x4 = __attribute__((ext_vector_type(4))) unsigned;
typedef float f32x2_t __attribute__((ext_vector_type(2))); typedef __bf16 bf16x2_t __attribute__((ext_vector_type(2)));
typedef __attribute__((address_space(3))) const char* lds_cptr;
typedef short v4i16_t __attribute__((ext_vector_type(4)));
constexpr int NT = SEQ / 64;
constexpr int KSLOT = 12288, VSLOT = 8192, NSLOT = 3;
constexpr int LDS_K = 0, LDS_V = NSLOT * KSLOT, LDS_WS = LDS_V + NSLOT * VSLOT, LDS_OST = LDS_WS + NWAVES * 256, LDS_ATT = LDS_OST + NWAVES * 4096;
#define SBAR() __builtin_amdgcn_sched_barrier(0)
#define MFMA(a, b, c) __builtin_amdgcn_mfma_f32_32x32x16_bf16(a, b, c, 0, 0, 0)
__device__ __forceinline__ int crow(int r, int hi) { return (r & 3) + 8 * (r >> 2) + 4 * hi; }
__device__ __forceinline__ unsigned cvtpk_s(float lo, float hi) { f32x2_t v = {lo, hi}; bf16x2_t b = __builtin_convertvector(v, bf16x2_t); return __builtin_bit_cast(unsigned, b); }
__device__ __forceinline__ void glds16(const void* g, unsigned lds_base) {
    unsigned sv; asm volatile("s_mov_b32 %0, m0\n\ts_mov_b32 m0, %2\n\ts_nop 0\n\tglobal_load_lds_dwordx4 %1, off\n\ts_mov_b32 m0, %0" : "=&s"(sv) : "v"(g), "s"(lds_base) : "memory"); }
__device__ __forceinline__ s16x4 vtr(lds_cptr p) { return __builtin_bit_cast(s16x4, __builtin_amdgcn_ds_read_tr16_b64_v4i16((__attribute__((address_space(3))) v4i16_t*)p)); }
#define MX3(a, b, c) __builtin_fmaxf(__builtin_fmaxf((a), (b)), (c))
__device__ __forceinline__ float rowmax(const f32x16& p0, const f32x16& p1) {
    float a = MX3(p0[0], p0[1], p1[0]), b = MX3(p0[2], p0[3], p1[1]); a = MX3(a, p1[2], p1[3]);
#pragma unroll
    for (int r = 4; r < 16; r += 4) { a = MX3(a, p0[r], p0[r + 1]); b = MX3(b, p0[r + 2], p0[r + 3]); a = MX3(a, p1[r], p1[r + 1]); b = MX3(b, p1[r + 2], p1[r + 3]); }
    float m = __builtin_fmaxf(a, b); auto rr = __builtin_amdgcn_permlane32_swap(__float_as_uint(m), __float_as_uint(m), false, false);
    return __builtin_fmaxf(__uint_as_float(rr[0]), __uint_as_float(rr[1])); }

template <int DQK>
__device__ __forceinline__ void unit_simple(const bf16_t* Qh, const bf16_t* __restrict__ Kh, const bf16_t* __restrict__ Vh, bf16_t* Ob, int q0, char* shm) {
    constexpr int NCH = DQK / 8, ND0 = DQK / 16;
    int tid_ = threadIdx.x; asm volatile("" : "+v"(tid_));
    const int tid = tid_, lane = tid & 63, r32 = lane & 31, hi = lane >> 5; const int wid = __builtin_amdgcn_readfirstlane(tid >> 6);
    const bf16_t* Qw = Qh + (size_t)(q0 + wid * 32) * DQK;
    const unsigned lds0 = (unsigned)(uintptr_t)shm; float* wsf = (float*)(shm + LDS_WS) + wid * 64;
    const bf16_t* ksrc0 = Kh + (size_t)lane * DQK + wid * 8;
    const bf16_t* ksrc1 = Kh + (size_t)lane * DQK + (8 + (wid & 3)) * 8;
    const bf16_t* vsrc = Vh + (size_t)(16 * (wid & 3) + (lane >> 2)) * 64 + (wid >> 2) * 32 + (lane & 3) * 8;
    const unsigned kdst0 = lds0 + LDS_K + wid * 1024, kdst1 = lds0 + LDS_K + (8 + (wid & 3)) * 1024, vdst = lds0 + LDS_V + wid * 1024;
#define DMA_KV(t, sl) do { glds16(ksrc0 + (size_t)(t) * 64 * DQK, (unsigned)__builtin_amdgcn_readfirstlane(kdst0 + (sl) * KSLOT)); \
        if (NCH == 12 && wid < 4) glds16(ksrc1 + (size_t)(t) * 64 * DQK, (unsigned)__builtin_amdgcn_readfirstlane(kdst1 + (sl) * KSLOT)); \
        glds16(vsrc + (size_t)(t) * 64 * 64, (unsigned)__builtin_amdgcn_readfirstlane(vdst + (sl) * VSLOT)); } while (0)
    const lds_cptr shm3 = (lds_cptr)shm;
    const lds_cptr vp0 = shm3 + LDS_V + ((lane >> 4) & 1) * 32 + (lane & 3) * 8 + (4 * hi + ((lane & 15) >> 2)) * 64;
    const lds_cptr kp0 = shm3 + LDS_K + hi * 1024 + r32 * 16;
    DMA_KV(0, 0);
    bf16x8 qr[ND0];
#pragma unroll
    for (int d0 = 0; d0 < ND0; ++d0) qr[d0] = *reinterpret_cast<const bf16x8*>(&Qw[(size_t)r32 * DQK + d0 * 16 + hi * 8]);
    float mhat = -INFINITY, l_reg = 0.f; f32x16 o[2]; o[0] = f32x16{}; o[1] = f32x16{};
    asm volatile("s_waitcnt vmcnt(0) lgkmcnt(0)\n\ts_barrier" ::: "memory");
    for (int t = 0; t < NT; ++t) {
        const int sl = t & 1;
        if (t + 1 < NT) DMA_KV(t + 1, sl ^ 1);
        f32x16 p0 = f32x16{}, p1 = f32x16{};
        const lds_cptr kp = kp0 + sl * KSLOT;
#pragma unroll
        for (int d0 = 0; d0 < ND0; ++d0) {
            const bf16x8 b0 = *(const __attribute__((address_space(3))) bf16x8*)(kp + d0 * 2048);
            const bf16x8 b1 = *(const __attribute__((address_space(3))) bf16x8*)(kp + d0 * 2048 + 512);
            p0 = MFMA(b0, qr[d0], p0); p1 = MFMA(b1, qr[d0], p1);
        }
        const float rm = rowmax(p0, p1);
        const float mn = __builtin_fmaxf(mhat, rm), f = __builtin_amdgcn_exp2f(mhat - mn); mhat = mn;
        float sacc = 0.f;
#pragma unroll
        for (int r = 0; r < 16; ++r) { p0[r] = __builtin_amdgcn_exp2f(p0[r] - mn); p1[r] = __builtin_amdgcn_exp2f(p1[r] - mn); sacc += p0[r] + p1[r]; }
        l_reg = l_reg * f + sacc;
        if (hi == 0) wsf[r32] = f;
        asm volatile("s_waitcnt lgkmcnt(0)" ::: "memory");
#pragma unroll
        for (int d_ = 0; d_ < 2; ++d_)
#pragma unroll
            for (int r = 0; r < 16; ++r) o[d_][r] *= wsf[crow(r, hi)];
        u32x4 pw[4];
#pragma unroll
        for (int i = 0; i < 4; ++i) { pw[0][i] = cvtpk_s(p0[2 * i], p0[2 * i + 1]); pw[1][i] = cvtpk_s(p0[8 + 2 * i], p0[8 + 2 * i + 1]); pw[2][i] = cvtpk_s(p1[2 * i], p1[2 * i + 1]); pw[3][i] = cvtpk_s(p1[8 + 2 * i], p1[8 + 2 * i + 1]); }
        const lds_cptr vp_ = vp0 + sl * VSLOT;
#pragma unroll
        for (int d0 = 0; d0 < 2; ++d0)
#pragma unroll
            for (int ks = 0; ks < 4; ++ks) {
                const s16x4 lo = vtr(vp_ + d0 * 4096 + ks * 1024), hh = vtr(vp_ + d0 * 4096 + ks * 1024 + 512);
                const bf16x8 vf = (bf16x8){lo[0], lo[1], lo[2], lo[3], hh[0], hh[1], hh[2], hh[3]};
                o[d0] = MFMA(__builtin_bit_cast(bf16x8, pw[ks]), vf, o[d0]);
            }
        asm volatile("s_waitcnt vmcnt(0) lgkmcnt(0)\n\ts_barrier" ::: "memory");
    }
#undef DMA_KV
    { auto rr = __builtin_amdgcn_permlane32_swap(__float_as_uint(l_reg), __float_as_uint(l_reg), false, false); l_reg = __uint_as_float(rr[0]) + __uint_as_float(rr[1]); }
    if (hi == 0) wsf[32 + r32] = l_reg; asm volatile("s_waitcnt lgkmcnt(0)" ::: "memory");
    float rli[16];
#pragma unroll
    for (int r = 0; r < 16; ++r) rli[r] = __builtin_amdgcn_rcpf(wsf[32 + crow(r, hi)]);
    bf16_t* Ow = Ob + (size_t)(wid * 32) * DM; bf16_t* stg = (bf16_t*)(shm + LDS_OST) + wid * 2048;
#pragma unroll
    for (int r = 0; r < 16; ++r) { const int orow = crow(r, hi);
#pragma unroll
        for (int d0 = 0; d0 < 2; ++d0) stg[orow * 64 + d0 * 32 + r32] = (bf16_t)f2bf(o[d0][r] * rli[r]); }
    asm volatile("s_waitcnt lgkmcnt(0)" ::: "memory");
#pragma unroll
    for (int i = 0; i < 4; ++i) { const int row = i * 8 + (lane >> 3), ch = lane & 7; *(u32x4*)(Ow + (size_t)row * DM + ch * 8) = *(const u32x4*)(stg + row * 64 + ch * 8); }
    asm volatile("s_waitcnt vmcnt(0) lgkmcnt(0)\n\ts_barrier" ::: "memory");
}

constexpr int CONV_LDS = 112640;
struct ConvState { int cj, jbase; const char* wg; const char* wu; const char* wd; char* dgu; char* dd; unsigned ldsbuf; lds_cptr rdbuf; };
struct ConvJob { const char* sbase; char* dbase; unsigned ldwB, KdB; };
__device__ __forceinline__ ConvJob conv_job(const ConvState& cs, int j) {
    const int J = (CONV_MODE >= 5) ? j : cs.jbase + (j < 383 ? j : 383); const int m = J >> 10, r = J & 1023; ConvJob q;
    if (m < 2) { const int g = r >> 7, kg = r & 127; const int drow0 = ((g < 4) ? g * 32 : 256 + (g - 4) * 32) + m * 128;
        q.sbase = (m ? cs.wu : cs.wg) + (size_t)((8 * kg) * EFF + g * 32) * 4; q.ldwB = EFF * 4; q.dbase = cs.dgu + (size_t)(drow0 * DM + 8 * kg) * 2; q.KdB = DM * 2; }
    else { const int g = r >> 5, kg = r & 31;
        q.sbase = cs.wd + (size_t)((8 * kg) * DM + g * 32) * 4; q.ldwB = DM * 4; q.dbase = cs.dd + (size_t)((g * 32) * EFF + 8 * kg) * 2; q.KdB = EFF * 2; }
    return q;
}
__device__ __forceinline__ void glds16_s(const char* sbase, unsigned voff, unsigned lds_base) {
    unsigned sv; asm volatile("s_mov_b32 %0, m0\n\ts_mov_b32 m0, %3\n\ts_nop 4\n\tglobal_load_lds_dwordx4 %1, %2\n\ts_mov_b32 m0, %0" : "=&s"(sv) : "v"(voff), "s"(sbase), "s"(lds_base) : "memory"); }
#if CONV_MODE == 1 || CONV_MODE == 3 || CONV_MODE == 4 || CONV_MODE >= 5
#define CONV_DRAIN() do { const int jd_ = cs.cj - 3; const ConvJob q_ = conv_job(cs, jd_); \
        const __attribute__((address_space(3))) float* bp_ = (const __attribute__((address_space(3))) float*)(cs.rdbuf + (jd_ & 3) * 1024) + (lane >> 5) * 128 + (lane & 31); \
        uint2 w_; w_.x = cvtpk_s(bp_[0], bp_[32]); w_.y = cvtpk_s(bp_[64], bp_[96]); \
        if (CONV_MODE == 1) *(uint2*)(q_.dbase + (size_t)((unsigned)(lane & 31) * q_.KdB + (unsigned)(lane >> 5) * 8u)) = w_; \
        else if (CONV_MODE == 4) *(uint2*)(cs.dgu + 0x30000000ull + (size_t)((unsigned)(lane & 31) * 2048u + (unsigned)(lane >> 5) * 8u + (unsigned)(jd_ & 127) * 16u)) = w_; \
        else asm volatile("" :: "v"(w_)); } while (0)
#else
#define CONV_DRAIN() do { } while (0)
#endif
#if CONV_MODE >= 5
#undef CONV_DRAIN
#define CONV_NSTEP 384
#define CONV_DRAIN() do { if (CONV_MODE == 5 && rst && cs.cj >= 3 && cs.cj < CONV_NSTEP + 3) { const int jb_ = 8 * (cs.cj - 3) + 4 * (wid - 6); const ConvJob q_ = conv_job(cs, jb_); \
          \
        const __attribute__((address_space(3))) float* bp_ = (const __attribute__((address_space(3))) float*)(cs.rdbuf + (jb_ & 31) * 1024) + (lane >> 5) * 512 + (lane & 31); \
        float v_[16]; \
        _Pragma("unroll") for (int i_ = 0; i_ < 16; ++i_) v_[i_] = bp_[i_ * 32]; \
        char* dp_ = q_.dbase + (size_t)((unsigned)(lane & 31) * q_.KdB + (unsigned)(lane >> 5) * 32u); \
        _Pragma("unroll") for (int i_ = 0; i_ < 2; ++i_) { uint4 w_; w_.x = cvtpk_s(v_[8 * i_], v_[8 * i_ + 1]); w_.y = cvtpk_s(v_[8 * i_ + 2], v_[8 * i_ + 3]); \
            w_.z = cvtpk_s(v_[8 * i_ + 4], v_[8 * i_ + 5]); w_.w = cvtpk_s(v_[8 * i_ + 6], v_[8 * i_ + 7]); *(uint4*)(dp_ + 16 * i_) = w_; } } } while (0)
#define CONV_ISSUE() do { if (CONV_MODE != 6 && rcl && cs.cj < CONV_NSTEP) { const int jb_ = 8 * cs.cj + 4 * (wid - 4); const ConvJob q_ = conv_job(cs, jb_); \
        const unsigned vo_ = (unsigned)(lane >> 3) * q_.ldwB + (unsigned)(lane & 7) * 16u; const unsigned lb_ = (unsigned)__builtin_amdgcn_readfirstlane(cs.ldsbuf + (jb_ & 31) * 1024); \
        glds16_s(q_.sbase, vo_, lb_); glds16_s(q_.sbase + (size_t)8 * q_.ldwB, vo_, lb_ + 1024); glds16_s(q_.sbase + (size_t)16 * q_.ldwB, vo_, lb_ + 2048); glds16_s(q_.sbase + (size_t)24 * q_.ldwB, vo_, lb_ + 3072); } \
        ++cs.cj; } while (0)
#define WAIT_BARL() asm volatile("s_waitcnt lgkmcnt(0)\n\ts_barrier" ::: "memory")
#define RWAIT(N) do { if (rkv) { WAIT_BAR(N); } else if (rcl) { WAIT_BAR(8); } else { WAIT_BARL(); } } while (0)
#elif CONV_MODE != 0
#define CONV_ISSUE() do { const ConvJob q_ = conv_job(cs, cs.cj); \
        glds16_s(q_.sbase, (unsigned)(lane >> 3) * q_.ldwB + (unsigned)(lane & 7) * 16u, (unsigned)__builtin_amdgcn_readfirstlane(cs.ldsbuf + (cs.cj & 3) * 1024)); ++cs.cj; } while (0)
#define WB_P() WAIT_BAR(3)
#define WB_S() WAIT_BAR(4)
#define WB_E1() WAIT_BAR(3)
#define WB_E0() WAIT_BAR(1)
#define WB_PL() WAIT_BAR(4)
#define WB_SL() WAIT_BAR(5)
#else
#define CONV_ISSUE() do { } while (0)
#define WB_P() WAIT_BAR(2)
#define WB_S() WAIT_BAR(2)
#define WB_E1() WAIT_BAR(1)
#define WB_E0() WAIT_BAR(0)
#define WB_PL() WAIT_BAR(3)
#define WB_SL() WAIT_BAR(3)
#endif

constexpr int T_SLOTB = 8192, T_LDS_K = 0, T_LDS_V = 3 * T_SLOTB, T_LDS_WS = 6 * T_SLOTB, T_LDS_OST = T_LDS_WS + NWAVES * 256;
#define WAIT_BAR(N) asm volatile("s_waitcnt vmcnt(" #N ") lgkmcnt(0)\n\ts_barrier" ::: "memory")
__device__ __forceinline__ float max3f(float a, float b, float c) { float r; asm("v_max3_f32 %0, %1, %2, %3" : "=v"(r) : "v"(a), "v"(b), "v"(c)); return r; }
__device__ __forceinline__ float max2f(float a, float b) { float r; asm("v_max_f32_e32 %0, %1, %2" : "=v"(r) : "v"(a), "v"(b)); return r; }
__device__ __forceinline__ float fadd_s(float a, float b) { float r; asm("v_add_f32_e32 %0, %1, %2" : "=v"(r) : "v"(a), "v"(b)); return r; }
__device__ __forceinline__ float fsub_s(float a, float b) { float r; asm("v_sub_f32_e32 %0, %1, %2" : "=v"(r) : "v"(a), "v"(b)); return r; }
__device__ __forceinline__ float rowmax_asm(const f32x16& p0, const f32x16& p1) {
    float a = max3f(p0[0], p0[1], p1[0]), b = max3f(p0[2], p0[3], p1[1]); a = max3f(a, p1[2], p1[3]);
#pragma unroll
    for (int r = 4; r < 16; r += 4) { a = max3f(a, p0[r], p0[r + 1]); b = max3f(b, p0[r + 2], p0[r + 3]); a = max3f(a, p1[r], p1[r + 1]); b = max3f(b, p1[r + 2], p1[r + 3]); }
    const float m = max2f(a, b);
    auto rr = __builtin_amdgcn_permlane32_swap(__float_as_uint(m), __float_as_uint(m), false, false);
    return max2f(__uint_as_float(rr[0]), __uint_as_float(rr[1]));
}
__device__ __forceinline__ void kload8(bf16x8* kf, lds_cptr kp) {
    kf[0] = *(const __attribute__((address_space(3))) bf16x8*)(kp);        kf[1] = *(const __attribute__((address_space(3))) bf16x8*)(kp + 512);
    kf[2] = *(const __attribute__((address_space(3))) bf16x8*)(kp + 2048); kf[3] = *(const __attribute__((address_space(3))) bf16x8*)(kp + 2560);
    kf[4] = *(const __attribute__((address_space(3))) bf16x8*)(kp + 4096); kf[5] = *(const __attribute__((address_space(3))) bf16x8*)(kp + 4608);
    kf[6] = *(const __attribute__((address_space(3))) bf16x8*)(kp + 6144); kf[7] = *(const __attribute__((address_space(3))) bf16x8*)(kp + 6656);
}
__device__ __forceinline__ void kload2(bf16x8* kf, lds_cptr kp, int j) { kf[2 * j] = *(const __attribute__((address_space(3))) bf16x8*)(kp + j * 2048); kf[2 * j + 1] = *(const __attribute__((address_space(3))) bf16x8*)(kp + j * 2048 + 512); }

template <int THRL>
__device__ __forceinline__ void unit64(const bf16_t* Qh, const bf16_t* __restrict__ Kh, const bf16_t* __restrict__ Vh, bf16_t* Ob, float* ostat, int q0, char* shm, ConvState& cs, float mfix) {
    constexpr int DQ = 64;
    int tid_ = threadIdx.x; asm volatile("" : "+v"(tid_));
    const int tid = tid_, lane = tid & 63, r32 = lane & 31, hi = lane >> 5; const int wid = __builtin_amdgcn_readfirstlane(tid >> 6);
    const bf16_t* Qw = Qh + (size_t)(q0 + wid * 32) * DQ;
    const unsigned lds0 = (unsigned)(uintptr_t)shm;
    float* wsf = (float*)(shm + T_LDS_WS) + wid * 64;
#if CONV_MODE >= 5
    const bool rkv = wid < 4, rcl = (wid == 4 || wid == 5), rst = wid >= 6; const int pw = wid & 3;
    const bf16_t* ksrc = Kh + (size_t)lane * DQ + pw * 8;
    const bf16_t* vsrc = Vh + (size_t)(16 * pw + (lane >> 2)) * 64 + (lane & 3) * 8;
    const unsigned kdst = lds0 + T_LDS_K + pw * 1024, vdst = lds0 + T_LDS_V + pw * 1024;
#define DMA_K(t, slot) do { if (rkv) { glds16(ksrc + (size_t)(t) * 64 * DQ, (unsigned)__builtin_amdgcn_readfirstlane(kdst + (slot))); \
        glds16(ksrc + 32 + (size_t)(t) * 64 * DQ, (unsigned)__builtin_amdgcn_readfirstlane(kdst + 4096 + (slot))); } } while (0)
#define DMA_V(t, slot) do { if (rkv) { glds16(vsrc + (size_t)(t) * 64 * 64, (unsigned)__builtin_amdgcn_readfirstlane(vdst + (slot))); \
        glds16(vsrc + 32 + (size_t)(t) * 64 * 64, (unsigned)__builtin_amdgcn_readfirstlane(vdst + 4096 + (slot))); } } while (0)
#define WB_P() RWAIT(4)
#define WB_S() RWAIT(4)
#define WB_E1() RWAIT(2)
#define WB_E0() RWAIT(0)
#else
    const bf16_t* ksrc = Kh + (size_t)lane * DQ + wid * 8;
    const bf16_t* vsrc = Vh + (size_t)(16 * (wid & 3) + (lane >> 2)) * 64 + (wid >> 2) * 32 + (lane & 3) * 8;
    const unsigned kdst = lds0 + T_LDS_K + wid * 1024, vdst = lds0 + T_LDS_V + wid * 1024;
#define DMA_K(t, slot) glds16(ksrc + (size_t)(t) * 64 * DQ, (unsigned)__builtin_amdgcn_readfirstlane(kdst + (slot)))
#define DMA_V(t, slot) glds16(vsrc + (size_t)(t) * 64 * 64, (unsigned)__builtin_amdgcn_readfirstlane(vdst + (slot)))
#endif
    const int vb0 = (int)(lds0 + T_LDS_V) + ((lane >> 4) & 1) * 32 + (lane & 3) * 8 + (4 * hi + ((lane & 15) >> 2)) * 64;
    bf16x8 kf[8];
    const lds_cptr shm3 = (lds_cptr)shm; const lds_cptr kp0 = shm3 + T_LDS_K + hi * 1024 + r32 * 16;
    const lds_cptr vp0 = shm3 + T_LDS_V + ((lane >> 4) & 1) * 32 + (lane & 3) * 8 + (4 * hi + ((lane & 15) >> 2)) * 64;
    DMA_K(0, 0); DMA_V(0, 0); DMA_K(1, T_SLOTB);
    bf16x8 qr[4];
#pragma unroll
    for (int d0 = 0; d0 < 4; ++d0) qr[d0] = *reinterpret_cast<const bf16x8*>(&Qw[(size_t)r32 * DQ + d0 * 16 + hi * 8]);
    float mfo = mfix; asm volatile("" : "+v"(mfo));
    float mhat = mfo, l_reg = 0.f; f32x16 o[2]; o[0] = f32x16{}; o[1] = f32x16{}; f32x16 negm;
#pragma unroll
    for (int r = 0; r < 16; ++r) negm[r] = -mfo;
    asm volatile("" : "+v"(negm));
    bool resc = false;
#define START(P0, P1) do { resc = false; _Pragma("unroll") for (int r = 0; r < 16; ++r) P0[r] = __builtin_amdgcn_exp2f(P0[r]); } while (0)
#define RESC() do { if (resc) { asm volatile("s_waitcnt lgkmcnt(0)" ::: "memory"); \
      _Pragma("unroll") for (int d_ = 0; d_ < 2; ++d_) _Pragma("unroll") for (int r = 0; r < 16; ++r) o[d_][r] *= wsf[crow(r, hi)]; } } while (0)
    f32x16 pA0, pA1, pB0, pB1;
    int sl_prev = 0, sl_cur = 0, sl_next = T_SLOTB;
#define ROT() do { sl_prev = sl_cur; sl_cur = sl_next; sl_next = (sl_next == 2 * T_SLOTB) ? 0 : sl_next + T_SLOTB; } while (0)
    DMA_K(2, 2 * T_SLOTB);
#if CONV_MODE >= 5
    WAIT_BAR(0);
#else
    WAIT_BAR(3);
#endif
    CONV_DRAIN();
    {
        const lds_cptr kb = kp0;
#pragma unroll
        for (int d0 = 0; d0 < 4; ++d0) {
            const bf16x8 b0 = *(const __attribute__((address_space(3))) bf16x8*)(kb + d0 * 2048);
            const bf16x8 b1 = *(const __attribute__((address_space(3))) bf16x8*)(kb + d0 * 2048 + 512);
            if (d0 == 0) { pA0 = MFMA(b0, qr[0], negm); pA1 = MFMA(b1, qr[0], negm); }
            else { pA0 = MFMA(b0, qr[d0], pA0); pA1 = MFMA(b1, qr[d0], pA1); } }
    }
    asm volatile("s_nop 15\n\ts_nop 7" : "+v"(pA0), "+v"(pA1));
    START(pA0, pA1);
#pragma unroll
    for (int r = 0; r < 16; ++r) pA1[r] = __builtin_amdgcn_exp2f(pA1[r]);
    WAIT_BAR(0);
    DMA_K(3, 0); DMA_V(1, T_SLOTB); CONV_ISSUE();
    ROT();
    kload8(kf, kp0 + sl_cur);
    WB_P();
    s16x4 vlo[8], vhi[8]; u32x4 pw0, pw1, pw2, pw3;
#define PKW(P, B) cvtpk_s(P[B], P[B + 1])
#define PAF(k) __builtin_bit_cast(bf16x8, pw##k)
#define VFR(i) (bf16x8){vlo[i][0], vlo[i][1], vlo[i][2], vlo[i][3], vhi[i][0], vhi[i][1], vhi[i][2], vhi[i][3]}
#define PIN(x) asm volatile("" : "+v"(x))
#define GAPA(MF, A0, A1, A2, A3, W0, W1, PW) do { MF; sacc += A0; sacc += A1; sacc += A2; sacc += A3; PIN(sacc); W0; W1; PIN(PW); SBAR(); } while (0)
#define EX(v) __builtin_amdgcn_exp2f(v)
#define GAPB(MF, X, B) do { MF; X[B] = EX(X[B]); X[B + 1] = EX(X[B + 1]); X[B + 2] = EX(X[B + 2]); X[B + 3] = EX(X[B + 3]); PIN(X); SBAR(); } while (0)
#define VRD(i) do { vlo[i] = vtr(vp_ + (((i) >> 2) * 4096 + ((i) & 3) * 1024)); vhi[i] = vtr(vp_ + (((i) >> 2) * 4096 + ((i) & 3) * 1024 + 512)); } while (0)
#define KRD(G, j) do { if (G) { kload2(kf, kp0 + sl_next, j); SBAR(); } } while (0)
#define STEP(C0, C1, P0, P1, t, GK, GV, GL) do { SBAR(); CONV_DRAIN(); SBAR(); \
    const lds_cptr vp_ = vp0 + sl_prev; \
    VRD(0); SBAR(); float sacc = (P0[0] + P0[1]); \
    GAPA(C0 = MFMA(kf[0], qr[0], negm), P0[2], P0[3], P0[4], P0[5],     pw0[0] = PKW(P0, 0), pw0[1] = PKW(P0, 2), pw0); \
    VRD(4); SBAR(); GAPA(C1 = MFMA(kf[1], qr[0], negm), P0[6], P0[7], P0[8], P0[9],     pw0[2] = PKW(P0, 4), pw0[3] = PKW(P0, 6), pw0); \
    VRD(1); SBAR(); GAPA(C0 = MFMA(kf[2], qr[1], C0),   P0[10], P0[11], P0[12], P0[13], pw1[0] = PKW(P0, 8), pw1[1] = PKW(P0, 10), pw1); \
    VRD(5); SBAR(); GAPA(C1 = MFMA(kf[3], qr[1], C1),   P0[14], P0[15], P1[0], P1[1],   pw1[2] = PKW(P0, 12), pw1[3] = PKW(P0, 14), pw1); \
    VRD(2); SBAR(); GAPA(C0 = MFMA(kf[4], qr[2], C0),   P1[2], P1[3], P1[4], P1[5],     pw2[0] = PKW(P1, 0), pw2[1] = PKW(P1, 2), pw2); \
    VRD(6); SBAR(); GAPA(C1 = MFMA(kf[5], qr[2], C1),   P1[6], P1[7], P1[8], P1[9],     pw2[2] = PKW(P1, 4), pw2[3] = PKW(P1, 6), pw2); \
    VRD(3); SBAR(); GAPA(C0 = MFMA(kf[6], qr[3], C0),   P1[10], P1[11], P1[12], P1[13], pw3[0] = PKW(P1, 8), pw3[1] = PKW(P1, 10), pw3); \
    VRD(7); SBAR(); GAPA(C1 = MFMA(kf[7], qr[3], C1),   P1[14], P1[15], 0.f, 0.f,       pw3[2] = PKW(P1, 12), pw3[3] = PKW(P1, 14), pw3); \
    l_reg += sacc; \
    if (GK) { DMA_K((t) + 3, sl_cur); } if (GV) { DMA_V((t) + 1, sl_next); } CONV_ISSUE(); \
    SBAR(); \
    GAPB(o[0] = MFMA(PAF(0), VFR(0), o[0]), C0, 0); \
    GAPB(o[1] = MFMA(PAF(0), VFR(4), o[1]), C0, 4); \
    KRD(GL, 0); GAPB(o[0] = MFMA(PAF(1), VFR(1), o[0]), C0, 8); \
    KRD(GL, 1); GAPB(o[1] = MFMA(PAF(1), VFR(5), o[1]), C0, 12); \
    KRD(GL, 2); GAPB(o[0] = MFMA(PAF(2), VFR(2), o[0]), C1, 0); \
    KRD(GL, 3); GAPB(o[1] = MFMA(PAF(2), VFR(6), o[1]), C1, 4); \
    GAPB(o[0] = MFMA(PAF(3), VFR(3), o[0]), C1, 8); \
    GAPB(o[1] = MFMA(PAF(3), VFR(7), o[1]), C1, 12); \
    } while (0)
    int t = 1;
    for (; t + 5 < NT; t += 2) {
        STEP(pB0, pB1, pA0, pA1, t, true, true, true);     WB_S(); RESC(); ROT();
        STEP(pA0, pA1, pB0, pB1, t + 1, true, true, true); WB_S(); RESC(); ROT();
    }
#define ENDW(tt) do { if ((tt) + 3 < NT) { WB_S(); } else if ((tt) + 2 < NT) { WB_E1(); } else { WB_E0(); } } while (0)
    for (; t + 1 < NT; t += 2) {
        STEP(pB0, pB1, pA0, pA1, t, (t + 3 < NT), (t + 1 < NT), (t + 1 < NT));         ENDW(t);     RESC(); ROT();
        STEP(pA0, pA1, pB0, pB1, t + 1, (t + 4 < NT), (t + 2 < NT), (t + 2 < NT));     ENDW(t + 1); RESC(); ROT();
    }
    STEP(pB0, pB1, pA0, pA1, NT - 1, false, false, false); RESC();
    {
        float sacc = pB0[0] + pB0[1];
#pragma unroll
        for (int r = 2; r < 16; ++r) sacc += pB0[r];
#pragma unroll
        for (int r = 0; r < 16; ++r) sacc += pB1[r];
        l_reg += sacc;
        pw0 = (u32x4){PKW(pB0, 0), PKW(pB0, 2), PKW(pB0, 4), PKW(pB0, 6)}; pw1 = (u32x4){PKW(pB0, 8), PKW(pB0, 10), PKW(pB0, 12), PKW(pB0, 14)};
        pw2 = (u32x4){PKW(pB1, 0), PKW(pB1, 2), PKW(pB1, 4), PKW(pB1, 6)}; pw3 = (u32x4){PKW(pB1, 8), PKW(pB1, 10), PKW(pB1, 12), PKW(pB1, 14)};
        SBAR();
        const lds_cptr vp_ = vp0 + sl_cur;
#pragma unroll
        for (int i = 0; i < 8; ++i) VRD(i);
        o[0] = MFMA(PAF(0), VFR(0), o[0]); o[1] = MFMA(PAF(0), VFR(4), o[1]); o[0] = MFMA(PAF(1), VFR(1), o[0]); o[1] = MFMA(PAF(1), VFR(5), o[1]);
        o[0] = MFMA(PAF(2), VFR(2), o[0]); o[1] = MFMA(PAF(2), VFR(6), o[1]); o[0] = MFMA(PAF(3), VFR(3), o[0]); o[1] = MFMA(PAF(3), VFR(7), o[1]);
    }
#undef PKW
#undef PAF
#undef VFR
#undef PIN
#undef GAPA
#undef GAPB
#undef EX
#undef VRD
#undef KRD
#undef STEP
#undef ENDW
    { auto rr = __builtin_amdgcn_permlane32_swap(__float_as_uint(l_reg), __float_as_uint(l_reg), false, false); l_reg = __uint_as_float(rr[0]) + __uint_as_float(rr[1]); }
    if (hi == 0) wsf[32 + r32] = l_reg; asm volatile("s_waitcnt lgkmcnt(0)" ::: "memory");
    float rli[16];
#pragma unroll
    for (int r = 0; r < 16; ++r) rli[r] = __builtin_amdgcn_rcpf(wsf[32 + crow(r, hi)]);
    bf16_t* Ow = Ob + (size_t)(wid * 32) * DM; bf16_t* stg = (bf16_t*)(shm + T_LDS_OST) + wid * 2048;
#pragma unroll
    for (int r = 0; r < 16; ++r) { const int orow = crow(r, hi);
#pragma unroll
        for (int d0 = 0; d0 < 2; ++d0) stg[orow * 64 + d0 * 32 + r32] = (bf16_t)f2bf(o[d0][r] * rli[r]); }
    asm volatile("s_waitcnt lgkmcnt(0)" ::: "memory");
#pragma unroll
    for (int i = 0; i < 4; ++i) { const int row = i * 8 + (lane >> 3), ch = lane & 7; const u32x4 v = *(const u32x4*)(stg + row * 64 + ch * 8); *(u32x4*)(Ow + (size_t)row * DM + ch * 8) = v;
        float q = 0.f;
#pragma unroll
        for (int d = 0; d < 4; ++d) { const float a = bf2f(v[d] & 0xffffu), bq = bf2f(v[d] >> 16); q += a * a + bq * bq; }
        q += dppmov<0xB1, 0xF>(0.f, q); q += dppmov<0x4E, 0xF>(0.f, q); q += dppmov<0x141, 0xF>(0.f, q);
        if (ch == 0) ostat[(size_t)(wid * 32 + row) * 16] = q; }
    asm volatile("s_waitcnt vmcnt(0) lgkmcnt(0)\n\ts_barrier" ::: "memory");
#if CONV_MODE >= 5
#undef WB_P
#undef WB_S
#undef WB_E1
#undef WB_E0
#endif
#undef DMA_K
#undef DMA_V
#undef START
#undef RESC
#undef ROT
}
constexpr int M_KSLOT = 12288, M_LDS_K = 0, M_LDS_V = 3 * M_KSLOT, M_LDS_WS = M_LDS_V + 3 * T_SLOTB, M_LDS_Q = M_LDS_WS + NWAVES * 256, M_LDS_OST = 0  ;
#define WBAR2() do { if (lowv) { WB_PL(); } else { WB_P(); } } while (0)
#define WBARS() do { if (lowv) { WB_SL(); } else { WB_S(); } } while (0)
template <int THRL>
__device__ __forceinline__ void unit96(const bf16_t* Qh, const bf16_t* __restrict__ Kh, const bf16_t* __restrict__ Vh, bf16_t* Ob, float* ostat, int q0, char* shm, ConvState& cs, float kb2) {
    constexpr int DQ = 96;
    int tid_ = threadIdx.x; asm volatile("" : "+v"(tid_));
    const int tid = tid_, lane = tid & 63, r32 = lane & 31, hi = lane >> 5; const int wid = __builtin_amdgcn_readfirstlane(tid >> 6);
    const bf16_t* Qw = Qh + (size_t)(q0 + wid * 32) * DQ;
    const unsigned lds0 = (unsigned)(uintptr_t)shm;
    float* wsf = (float*)(shm + M_LDS_WS) + wid * 64;
#if CONV_MODE >= 5
    const bool rkv = wid < 4, rcl = (wid == 4 || wid == 5), rst = wid >= 6; const int pw = wid & 3;
    const bf16_t* ksrc = Kh + (size_t)lane * DQ + pw * 8;
    const bool lowv = false;
#else
    const bf16_t* ksrc = Kh + (size_t)lane * DQ + wid * 8;
    const bf16_t* ksrc1 = Kh + (size_t)lane * DQ + (8 + (wid & 3)) * 8;
    const bool lowv = wid < 4;
#endif
#if CONV_MODE >= 5
    const bf16_t* vsrc = Vh + (size_t)(16 * pw + (lane >> 2)) * 64 + (lane & 3) * 8;
    const unsigned kdst = lds0 + M_LDS_K + pw * 1024, vdst = lds0 + M_LDS_V + pw * 1024, qdst = lds0 + M_LDS_Q + wid * 6144;
#define DMA_K(t, slot) do { if (rkv) { glds16(ksrc + (size_t)(t) * 64 * DQ, (unsigned)__builtin_amdgcn_readfirstlane(kdst + (slot))); \
        glds16(ksrc + 32 + (size_t)(t) * 64 * DQ, (unsigned)__builtin_amdgcn_readfirstlane(kdst + 4096 + (slot))); \
        glds16(ksrc + 64 + (size_t)(t) * 64 * DQ, (unsigned)__builtin_amdgcn_readfirstlane(kdst + 8192 + (slot))); } } while (0)
#define DMA_V(t, slot) do { if (rkv) { glds16(vsrc + (size_t)(t) * 64 * 64, (unsigned)__builtin_amdgcn_readfirstlane(vdst + (slot))); \
        glds16(vsrc + 32 + (size_t)(t) * 64 * 64, (unsigned)__builtin_amdgcn_readfirstlane(vdst + 4096 + (slot))); } } while (0)
#undef WBAR2
#undef WBARS
#define WBAR2() RWAIT(5)
#define WBARS() RWAIT(5)
#define WB_E1() RWAIT(2)
#define WB_E0() RWAIT(0)
#else
    const bf16_t* vsrc = Vh + (size_t)(16 * (wid & 3) + (lane >> 2)) * 64 + (wid >> 2) * 32 + (lane & 3) * 8;
    const unsigned kdst = lds0 + M_LDS_K + wid * 1024, kdst1 = lds0 + M_LDS_K + (8 + (wid & 3)) * 1024, vdst = lds0 + M_LDS_V + wid * 1024, qdst = lds0 + M_LDS_Q + wid * 6144;
#define DMA_K(t, slot) do { glds16(ksrc + (size_t)(t) * 64 * DQ, (unsigned)__builtin_amdgcn_readfirstlane(kdst + (slot))); \
        if (lowv) glds16(ksrc1 + (size_t)(t) * 64 * DQ, (unsigned)__builtin_amdgcn_readfirstlane(kdst1 + (slot))); } while (0)
#define DMA_V(t, slot) glds16(vsrc + (size_t)(t) * 64 * 64, (unsigned)__builtin_amdgcn_readfirstlane(vdst + (slot)))
#endif
    const int vb0 = (int)(lds0 + M_LDS_V) + ((lane >> 4) & 1) * 32 + (lane & 3) * 8 + (4 * hi + ((lane & 15) >> 2)) * 64;
    bf16x8 kf[12];
    const lds_cptr shm3 = (lds_cptr)shm; const lds_cptr kp0 = shm3 + M_LDS_K + hi * 1024 + r32 * 16; const lds_cptr qp0 = shm3 + M_LDS_Q + wid * 6144 + lane * 16;
    const lds_cptr vp0 = shm3 + M_LDS_V + ((lane >> 4) & 1) * 32 + (lane & 3) * 8 + (4 * hi + ((lane & 15) >> 2)) * 64;
#pragma unroll
    for (int d0 = 0; d0 < 6; ++d0) glds16(Qw + (size_t)r32 * DQ + d0 * 16 + hi * 8, (unsigned)__builtin_amdgcn_readfirstlane(qdst + d0 * 1024));
    DMA_K(0, 0); DMA_V(0, 0); DMA_K(1, M_KSLOT);
#define QF(d0) (*(const __attribute__((address_space(3))) bf16x8*)(qp0 + (d0) * 1024))
    float mhat = 0.f, l_reg = 0.f; f32x16 o[2]; o[0] = f32x16{}; o[1] = f32x16{}; f32x16 negm = f32x16{}; asm volatile("" : "+v"(negm));
    bool resc = false;
#define START(P0, P1) do { resc = false; _Pragma("unroll") for (int r = 0; r < 16; ++r) P0[r] = __builtin_amdgcn_exp2f(P0[r]); } while (0)
#define RESC() do { if (resc) { asm volatile("s_waitcnt lgkmcnt(0)" ::: "memory"); \
      _Pragma("unroll") for (int d_ = 0; d_ < 2; ++d_) _Pragma("unroll") for (int r = 0; r < 16; ++r) o[d_][r] *= wsf[crow(r, hi)]; } } while (0)
    f32x16 pA0, pA1, pB0, pB1;
    int sl_prev = 0, sl_cur = 0, sl_next = M_KSLOT; int vs_prev = 0, vs_cur = 0, vs_next = T_SLOTB;
#define ROT() do { sl_prev = sl_cur; sl_cur = sl_next; sl_next = (sl_next == 2 * M_KSLOT) ? 0 : sl_next + M_KSLOT; vs_prev = vs_cur; vs_cur = vs_next; vs_next = (vs_next == 2 * T_SLOTB) ? 0 : vs_next + T_SLOTB; } while (0)
    DMA_K(2, 2 * M_KSLOT);
    WAIT_BAR(0);
    {
        float qn = 0.f;
#pragma unroll
        for (int d0 = 0; d0 < 6; ++d0) { const bf16x8 qf = QF(d0);
#pragma unroll
            for (int i = 0; i < 8; ++i) { const float x = bf2f((unsigned short)qf[i]); qn += x * x; } }
        auto rr = __builtin_amdgcn_permlane32_swap(__float_as_uint(qn), __float_as_uint(qn), false, false); qn = __uint_as_float(rr[0]) + __uint_as_float(rr[1]);
        mhat = fminf(sqrtf(qn * kb2) * 1.02f + 0.5f, 60.f);
#pragma unroll
        for (int r = 0; r < 16; ++r) negm[r] = -mhat;
        asm volatile("" : "+v"(negm));
    }
    CONV_DRAIN();
    {
        const lds_cptr kb = kp0;
#pragma unroll
        for (int d0 = 0; d0 < 6; ++d0) {
            const bf16x8 b0 = *(const __attribute__((address_space(3))) bf16x8*)(kb + d0 * 2048);
            const bf16x8 b1 = *(const __attribute__((address_space(3))) bf16x8*)(kb + d0 * 2048 + 512);
            const bf16x8 qf = QF(d0);
            if (d0 == 0) { pA0 = MFMA(b0, qf, negm); pA1 = MFMA(b1, qf, negm); }
            else { pA0 = MFMA(b0, qf, pA0); pA1 = MFMA(b1, qf, pA1); } }
    }
    asm volatile("s_nop 15\n\ts_nop 7" : "+v"(pA0), "+v"(pA1));
    START(pA0, pA1);
#pragma unroll
    for (int r = 0; r < 16; ++r) pA1[r] = __builtin_amdgcn_exp2f(pA1[r]);
    WAIT_BAR(0);
    DMA_K(3, 0); DMA_V(1, T_SLOTB); CONV_ISSUE();
    ROT();
#pragma unroll
    for (int j = 0; j < 6; ++j) kload2(kf, kp0 + sl_cur, j);
    WBAR2();
    s16x4 vlo[8], vhi[8]; u32x4 pw0, pw1, pw2, pw3;
#define PKW(P, B) cvtpk_s(P[B], P[B + 1])
#define PAF(k) __builtin_bit_cast(bf16x8, pw##k)
#define VFR(i) (bf16x8){vlo[i][0], vlo[i][1], vlo[i][2], vlo[i][3], vhi[i][0], vhi[i][1], vhi[i][2], vhi[i][3]}
#define PIN(x) asm volatile("" : "+v"(x))
#define GAPA(MF, A0, A1, A2, A3, W0, W1, PW) do { MF; sacc += A0; sacc += A1; sacc += A2; sacc += A3; PIN(sacc); W0; W1; PIN(PW); SBAR(); } while (0)
#define EX(v) __builtin_amdgcn_exp2f(v)
#define GAPB(MF, X, B) do { MF; X[B] = EX(X[B]); X[B + 1] = EX(X[B + 1]); X[B + 2] = EX(X[B + 2]); X[B + 3] = EX(X[B + 3]); PIN(X); SBAR(); } while (0)
#define VRD(i) do { vlo[i] = vtr(vp_ + (((i) >> 2) * 4096 + ((i) & 3) * 1024)); vhi[i] = vtr(vp_ + (((i) >> 2) * 4096 + ((i) & 3) * 1024 + 512)); } while (0)
#define KRD(G, j) do { if (G) { kload2(kf, kp0 + sl_next, j); SBAR(); } } while (0)
#define STEP(C0, C1, P0, P1, t, GK, GV, GL) do { SBAR(); CONV_DRAIN(); SBAR(); \
    const lds_cptr vp_ = vp0 + vs_prev; \
    bf16x8 qa = QF(0), qb = QF(1); \
    VRD(0); SBAR(); float sacc = (P0[0] + P0[1]); \
    GAPA(C0 = MFMA(kf[0], qa, negm), P0[2], P0[3], P0[4], P0[5],     pw0[0] = PKW(P0, 0), pw0[1] = PKW(P0, 2), pw0); \
    VRD(4); SBAR(); GAPA(C1 = MFMA(kf[1], qa, negm), P0[6], P0[7], P0[8], P0[9],     pw0[2] = PKW(P0, 4), pw0[3] = PKW(P0, 6), pw0); \
    qa = QF(2); VRD(1); SBAR(); GAPA(C0 = MFMA(kf[2], qb, C0),   P0[10], P0[11], P0[12], P0[13], pw1[0] = PKW(P0, 8), pw1[1] = PKW(P0, 10), pw1); \
    VRD(5); SBAR(); GAPA(C1 = MFMA(kf[3], qb, C1),   P0[14], P0[15], P1[0], P1[1],   pw1[2] = PKW(P0, 12), pw1[3] = PKW(P0, 14), pw1); \
    qb = QF(3); VRD(2); SBAR(); GAPA(C0 = MFMA(kf[4], qa, C0),   P1[2], P1[3], P1[4], P1[5],     pw2[0] = PKW(P1, 0), pw2[1] = PKW(P1, 2), pw2); \
    VRD(6); SBAR(); GAPA(C1 = MFMA(kf[5], qa, C1),   P1[6], P1[7], P1[8], P1[9],     pw2[2] = PKW(P1, 4), pw2[3] = PKW(P1, 6), pw2); \
    qa = QF(4); VRD(3); SBAR(); GAPA(C0 = MFMA(kf[6], qb, C0),   P1[10], P1[11], P1[12], P1[13], pw3[0] = PKW(P1, 8), pw3[1] = PKW(P1, 10), pw3); \
    VRD(7); SBAR(); GAPA(C1 = MFMA(kf[7], qb, C1),   P1[14], P1[15], 0.f, 0.f,       pw3[2] = PKW(P1, 12), pw3[3] = PKW(P1, 14), pw3); \
    qb = QF(5); SBAR(); C0 = MFMA(kf[8], qa, C0); C1 = MFMA(kf[9], qa, C1); SBAR(); \
    C0 = MFMA(kf[10], qb, C0); C1 = MFMA(kf[11], qb, C1); SBAR(); \
    l_reg += sacc; \
    if (GK) { DMA_K((t) + 3, sl_cur); } if (GV) { DMA_V((t) + 1, vs_next); } CONV_ISSUE(); \
    SBAR(); \
    GAPB(o[0] = MFMA(PAF(0), VFR(0), o[0]), C0, 0); \
    KRD(GL, 0); GAPB(o[1] = MFMA(PAF(0), VFR(4), o[1]), C0, 4); \
    KRD(GL, 1); GAPB(o[0] = MFMA(PAF(1), VFR(1), o[0]), C0, 8); \
    KRD(GL, 2); GAPB(o[1] = MFMA(PAF(1), VFR(5), o[1]), C0, 12); \
    KRD(GL, 3); GAPB(o[0] = MFMA(PAF(2), VFR(2), o[0]), C1, 0); \
    KRD(GL, 4); GAPB(o[1] = MFMA(PAF(2), VFR(6), o[1]), C1, 4); \
    KRD(GL, 5); GAPB(o[0] = MFMA(PAF(3), VFR(3), o[0]), C1, 8); \
    GAPB(o[1] = MFMA(PAF(3), VFR(7), o[1]), C1, 12); \
    } while (0)
    int t = 1;
    for (; t + 5 < NT; t += 2) {
        STEP(pB0, pB1, pA0, pA1, t, true, true, true);     WBARS(); RESC(); ROT();
        STEP(pA0, pA1, pB0, pB1, t + 1, true, true, true); WBARS(); RESC(); ROT();
    }
#define ENDW(tt) do { if ((tt) + 3 < NT) { WBARS(); } else if ((tt) + 2 < NT) { WB_E1(); } else { WB_E0(); } } while (0)
    for (; t + 1 < NT; t += 2) {
        STEP(pB0, pB1, pA0, pA1, t, (t + 3 < NT), (t + 1 < NT), (t + 1 < NT));         ENDW(t);     RESC(); ROT();
        STEP(pA0, pA1, pB0, pB1, t + 1, (t + 4 < NT), (t + 2 < NT), (t + 2 < NT));     ENDW(t + 1); RESC(); ROT();
    }
    STEP(pB0, pB1, pA0, pA1, NT - 1, false, false, false); RESC();
    {
        float sacc = pB0[0] + pB0[1];
#pragma unroll
        for (int r = 2; r < 16; ++r) sacc += pB0[r];
#pragma unroll
        for (int r = 0; r < 16; ++r) sacc += pB1[r];
        l_reg += sacc;
        pw0 = (u32x4){PKW(pB0, 0), PKW(pB0, 2), PKW(pB0, 4), PKW(pB0, 6)}; pw1 = (u32x4){PKW(pB0, 8), PKW(pB0, 10), PKW(pB0, 12), PKW(pB0, 14)};
        pw2 = (u32x4){PKW(pB1, 0), PKW(pB1, 2), PKW(pB1, 4), PKW(pB1, 6)}; pw3 = (u32x4){PKW(pB1, 8), PKW(pB1, 10), PKW(pB1, 12), PKW(pB1, 14)};
        SBAR();
        const lds_cptr vp_ = vp0 + vs_cur;
#pragma unroll
        for (int i = 0; i < 8; ++i) VRD(i);
        o[0] = MFMA(PAF(0), VFR(0), o[0]); o[1] = MFMA(PAF(0), VFR(4), o[1]); o[0] = MFMA(PAF(1), VFR(1), o[0]); o[1] = MFMA(PAF(1), VFR(5), o[1]);
        o[0] = MFMA(PAF(2), VFR(2), o[0]); o[1] = MFMA(PAF(2), VFR(6), o[1]); o[0] = MFMA(PAF(3), VFR(3), o[0]); o[1] = MFMA(PAF(3), VFR(7), o[1]);
    }
#undef PKW
#undef PAF
#undef VFR
#undef PIN
#undef GAPA
#undef GAPB
#undef EX
#undef VRD
#undef KRD
#undef STEP
#undef ENDW
    { auto rr = __builtin_amdgcn_permlane32_swap(__float_as_uint(l_reg), __float_as_uint(l_reg), false, false); l_reg = __uint_as_float(rr[0]) + __uint_as_float(rr[1]); }
    if (hi == 0) wsf[32 + r32] = l_reg; asm volatile("s_waitcnt lgkmcnt(0)" ::: "memory");
    float rli[16];
#pragma unroll
    for (int r = 0; r < 16; ++r) rli[r] = __builtin_amdgcn_rcpf(wsf[32 + crow(r, hi)]);
    bf16_t* Ow = Ob + (size_t)(wid * 32) * DM; bf16_t* stg = (bf16_t*)(shm + M_LDS_OST) + wid * 2048;
#pragma unroll
    for (int r = 0; r < 16; ++r) { const int orow = crow(r, hi);
#pragma unroll
        for (int d0 = 0; d0 < 2; ++d0) stg[orow * 64 + d0 * 32 + r32] = (bf16_t)f2bf(o[d0][r] * rli[r]); }
    asm volatile("s_waitcnt lgkmcnt(0)" ::: "memory");
#pragma unroll
    for (int i = 0; i < 4; ++i) { const int row = i * 8 + (lane >> 3), ch = lane & 7; const u32x4 v = *(const u32x4*)(stg + row * 64 + ch * 8); *(u32x4*)(Ow + (size_t)row * DM + ch * 8) = v;
        float q = 0.f;
#pragma unroll
        for (int d = 0; d < 4; ++d) { const float a = bf2f(v[d] & 0xffffu), bq = bf2f(v[d] >> 16); q += a * a + bq * bq; }
        q += dppmov<0xB1, 0xF>(0.f, q); q += dppmov<0x4E, 0xF>(0.f, q); q += dppmov<0x141, 0xF>(0.f, q);
        if (ch == 0) ostat[(size_t)(wid * 32 + row) * 16] = q; }
    asm volatile("s_waitcnt vmcnt(0) lgkmcnt(0)\n\ts_barrier" ::: "memory");
#if CONV_MODE >= 5
#undef WB_E1
#undef WB_E0
#endif
#undef QF
#undef DMA_K
#undef DMA_V
#undef START
#undef RESC
#undef ROT
}
#undef WBAR2
#undef WBARS
#undef WAIT_BAR
}


namespace pg8 {
typedef short bf16x8 __attribute__((ext_vector_type(8)));
typedef float f32x4 __attribute__((ext_vector_type(4)));
typedef unsigned u32x4 __attribute__((ext_vector_type(4)));
constexpr int BM = 256, BK = 64, HALF = 128, HTB = HALF * BK * 2, STAGE_BYTES = 8 * HTB, NXCD = 8, WGM = 8;
__host__ __device__ __forceinline__ int lds_byte(int r, int c) { const int st = (r >> 4) * 2 + (c >> 5), rr = r & 15, cc = c & 31, ob = rr * 64 + cc * 2; return st * 1024 + (ob ^ (((ob >> 9) & 1) << 5)); }
__host__ __device__ __forceinline__ void stage_rc(int b, int& R, int& C) { const int st = b / 1024, sb = b % 1024, swz = sb ^ (((sb >> 9) & 1) << 5); R = (st >> 1) * 16 + swz / 64; C = (st & 1) * 32 + (swz % 64) / 2; }
__host__ __device__ __forceinline__ int perm32(int rho) { const int n = rho >> 4, i = rho & 15; return 8 * (i >> 2) + 4 * n + (i & 3); }
__device__ __forceinline__ unsigned cvt_pk_bf16(float lo, float hi) { unsigned r; asm volatile("v_cvt_pk_bf16_f32 %0, %1, %2" : "=v"(r) : "v"(lo), "v"(hi)); return r; }

struct Unit { int pm, pn, e, nrows, rowbase; };

struct DenseOrder {
    int nM, nN, nwg, G, c, K; const char* Bt;
    __device__ void init(int M, int N, int K_, const bf16_t* Bt_, int G_, int c_) { nM = M / BM; nN = N / BM; nwg = nM * nN; G = G_; c = c_; K = K_; Bt = (const char*)Bt_; }
    __device__ __forceinline__ bool next(int i, Unit& u) const {
        const long L = (long)i * G + c; if (L >= nwg) return false;
        int wgid = (int)L; { const int q = nwg / NXCD, r = nwg % NXCD, xcd = wgid % NXCD, off = wgid / NXCD; wgid = (xcd < r ? xcd * (q + 1) : r * (q + 1) + (xcd - r) * q) + off; }
        const int nig = WGM * nN, gid = wgid / nig, fm = gid * WGM, gsz = (nM - fm) < WGM ? (nM - fm) : WGM;
        u.pm = fm + ((wgid % nig) % gsz); u.pn = (wgid % nig) / gsz; u.e = 0; u.nrows = 256; u.rowbase = u.pm * BM; return true;
    }
    __device__ __forceinline__ void a_offsets(const Unit&, int, unsigned (&)[2][2]) const {}
    __device__ __forceinline__ const char* b_tile(const Unit& u) const { return Bt + (size_t)u.pn * BM * K * 2; }
};

struct EpiBf16 {
    static constexpr bool PERM = true;
    bf16_t* O; int ldc;
    __device__ __forceinline__ void operator()(const f32x4 (&acc)[2][2][4][2], const Unit& u, int wr, int wc, int fr, int fq) const {
        const int row0 = u.pm * BM + wr * 64 + fr, col0 = u.pn * BM + wc * 32 + 8 * fq;
#pragma unroll
        for (int ai = 0; ai < 2; ++ai)
#pragma unroll
            for (int m = 0; m < 4; ++m) { bf16_t* rowp = O + (size_t)(row0 + ai * HALF + m * 16) * ldc + col0;
#pragma unroll
                for (int bj = 0; bj < 2; ++bj) { const f32x4 v0 = acc[ai][bj][m][0], v1 = acc[ai][bj][m][1];
                    u32x4 w; w.x = cvt_pk_bf16(v0[0], v0[1]); w.y = cvt_pk_bf16(v0[2], v0[3]); w.z = cvt_pk_bf16(v1[0], v1[1]); w.w = cvt_pk_bf16(v1[2], v1[3]);
                    *(u32x4*)(rowp + bj * HALF) = w; } }
    }
};


__device__ __forceinline__ float silu_mul(float g, float u) { return g * __builtin_amdgcn_rcpf(1.f + __expf(-g)) * u; }

struct MoeOrder {
    const LAS int* pre; const LAS int* offs; const LAS int* cntl; const int* list; const char* Bt; size_t bstride; int K, npn, G, c, mode;
    __device__ __forceinline__ bool next(int i, Unit& u) const {
        const int L = i * G + c, total = pre[NE] * npn; if (L >= total) return false;
        const int rtg = L / npn; const int pn = L - rtg * npn;
        int lo_ = 0, hi_ = NE;
        while (hi_ - lo_ > 1) { const int mid = (lo_ + hi_) >> 1; if (pre[mid] <= rtg) lo_ = mid; else hi_ = mid; }
        const int e = lo_, pm = rtg - pre[e], n = cntl[e] - pm * BM;
        u.e = __builtin_amdgcn_readfirstlane(e); u.pm = __builtin_amdgcn_readfirstlane(pm); u.pn = __builtin_amdgcn_readfirstlane(pn);
        u.nrows = __builtin_amdgcn_readfirstlane(n < BM ? n : BM); u.rowbase = __builtin_amdgcn_readfirstlane(offs[e] + pm * BM); return true;
    }
    __device__ __forceinline__ void a_offsets(const Unit& u, int tid, unsigned (&ua)[2][2]) const {
#pragma unroll
        for (int i = 0; i < 2; ++i) { int R, C; stage_rc(tid * 16 + i * 8192, R, C);
#pragma unroll
            for (int h = 0; h < 2; ++h) { int r = h * HALF + R; if (r >= u.nrows) r = 0; const int row = list[(size_t)u.e * LCAP + u.pm * BM + r] >> 3;
                ua[h][i] = (unsigned)((row * K + C) * 2); } }
    }
    __device__ __forceinline__ const char* b_tile(const Unit& u) const { return Bt + (size_t)u.e * bstride + (size_t)u.pn * BM * K * 2; }
};

struct EpiAct {
    static constexpr bool PERM = true;
    bf16_t* ACT;
    __device__ __forceinline__ void operator()(const f32x4 (&acc)[2][2][4][2], const Unit& u, int wr, int wc, int fr, int fq) const {
        const __amdgpu_buffer_rsrc_t rs = __builtin_amdgcn_make_buffer_rsrc((void*)ACT, 0, (NTOK * TOPK + 256) * EFF * 2, 0x00020000);
        const unsigned cb = (unsigned)((u.pn * HALF + wc * 32 + 8 * fq) * 2);
#pragma unroll
        for (int ai = 0; ai < 2; ++ai)
#pragma unroll
            for (int m = 0; m < 4; ++m) { const int r = ai * HALF + wr * 64 + m * 16 + fr;
                const unsigned off = (r < u.nrows) ? (unsigned)(u.rowbase + r) * (EFF * 2) + cb : 0xFFFFFFF0u;
                const f32x4 g0 = acc[ai][0][m][0], g1 = acc[ai][0][m][1], u0 = acc[ai][1][m][0], u1 = acc[ai][1][m][1];
                u32x4 w; w.x = cvt_pk_bf16(silu_mul(g0[0], u0[0]), silu_mul(g0[1], u0[1])); w.y = cvt_pk_bf16(silu_mul(g0[2], u0[2]), silu_mul(g0[3], u0[3]));
                w.z = cvt_pk_bf16(silu_mul(g1[0], u1[0]), silu_mul(g1[1], u1[1])); w.w = cvt_pk_bf16(silu_mul(g1[2], u1[2]), silu_mul(g1[3], u1[3]));
                __builtin_amdgcn_raw_buffer_store_b128(w, rs, off, 0, 0); }
    }
};
struct EpiSlots {
    static constexpr bool PERM = true;
    unsigned char* SL;
    __device__ __forceinline__ void operator()(const f32x4 (&acc)[2][2][4][2], const Unit& u, int wr, int wc, int fr, int fq) const {
        const __amdgpu_buffer_rsrc_t rs = __builtin_amdgcn_make_buffer_rsrc((void*)SL, 0, NTOK * TOPK * DM, 0x00020000);
        const unsigned cb = (unsigned)(u.pn * BM + wc * 32 + 8 * fq);
#pragma unroll
        for (int ai = 0; ai < 2; ++ai)
#pragma unroll
            for (int m = 0; m < 4; ++m) { const int r = ai * HALF + wr * 64 + m * 16 + fr;
                const unsigned off = (r < u.nrows) ? (unsigned)(u.rowbase + r) * DM + cb : 0xFFFFFFF0u;
#pragma unroll
                for (int bj = 0; bj < 2; ++bj) { const f32x4 v0 = acc[ai][bj][m][0] * 16.f, v1 = acc[ai][bj][m][1] * 16.f;
                    int lo = __builtin_amdgcn_cvt_pk_fp8_f32(v0[0], v0[1], 0, false); lo = __builtin_amdgcn_cvt_pk_fp8_f32(v0[2], v0[3], lo, true);
                    int hi = __builtin_amdgcn_cvt_pk_fp8_f32(v1[0], v1[1], 0, false); hi = __builtin_amdgcn_cvt_pk_fp8_f32(v1[2], v1[3], hi, true);
                    typedef unsigned u32x2 __attribute__((ext_vector_type(2)));
                    __builtin_amdgcn_raw_buffer_store_b64((u32x2){(unsigned)lo, (unsigned)hi}, rs, off, bj * HALF, 0); } }
    }
};
struct EpiRS {
    static constexpr bool PERM = true;
    float* LOG; bf16_t* ACTS;
    __device__ __forceinline__ void operator()(const f32x4 (&acc)[2][2][4][2], const Unit& u, int wr, int wc, int fr, int fq) const {
        const int row0 = u.pm * BM + wr * 64 + fr;
#pragma unroll
        for (int ai = 0; ai < 2; ++ai)
#pragma unroll
            for (int m = 0; m < 4; ++m) { const int row = row0 + ai * HALF + m * 16;
                if (u.pn == 0) {
#pragma unroll
                    for (int bj = 0; bj < 2; ++bj) { float* lp = LOG + (size_t)row * NE + bj * HALF + wc * 32 + 8 * fq; *(f32x4*)lp = acc[ai][bj][m][0]; *(f32x4*)(lp + 4) = acc[ai][bj][m][1]; }
                } else {
                    const f32x4 g0 = acc[ai][0][m][0], g1 = acc[ai][0][m][1], u0 = acc[ai][1][m][0], u1 = acc[ai][1][m][1];
                    u32x4 w; w.x = cvt_pk_bf16(silu_mul(g0[0], u0[0]), silu_mul(g0[1], u0[1])); w.y = cvt_pk_bf16(silu_mul(g0[2], u0[2]), silu_mul(g0[3], u0[3]));
                    w.z = cvt_pk_bf16(silu_mul(g1[0], u1[0]), silu_mul(g1[1], u1[1])); w.w = cvt_pk_bf16(silu_mul(g1[2], u1[2]), silu_mul(g1[3], u1[3]));
                    *(u32x4*)(ACTS + (size_t)row * EFF + (u.pn - 1) * HALF + wc * 32 + 8 * fq) = w; } }
    }
};

struct EpiBf16RowScale {
    static constexpr bool PERM = true;
    bf16_t* O; int ldc; const LAS float* rtab;
    __device__ __forceinline__ void operator()(const f32x4 (&acc)[2][2][4][2], const Unit& u, int wr, int wc, int fr, int fq) const {
        const int row0 = u.pm * BM + wr * 64 + fr, col0 = u.pn * BM + wc * 32 + 8 * fq;
#pragma unroll
        for (int ai = 0; ai < 2; ++ai)
#pragma unroll
            for (int m = 0; m < 4; ++m) { const int row = row0 + ai * HALF + m * 16; bf16_t* rowp = O + (size_t)row * ldc + col0;
                const float g = rtab[2 * (row - u.pm * BM) + 1];
#pragma unroll
                for (int bj = 0; bj < 2; ++bj) { const f32x4 v0 = acc[ai][bj][m][0] * g, v1 = acc[ai][bj][m][1] * g;
                    u32x4 w; w.x = cvt_pk_bf16(v0[0], v0[1]); w.y = cvt_pk_bf16(v0[2], v0[3]); w.z = cvt_pk_bf16(v1[0], v1[1]); w.w = cvt_pk_bf16(v1[2], v1[3]);
                    *(u32x4*)(rowp + bj * HALF) = w; } }
    }
};

template <class Epi, class Sched, bool ALIGN_EPI, bool GATHER = false, bool MIDSCALE = false>
__device__ __forceinline__ void gemm_phase(LAS unsigned char* lds, const bf16_t* Abase_, int K, const Sched& S, const Epi& E, const float* stat = nullptr) {
    int tid_ = threadIdx.x; asm volatile("" : "+v"(tid_));
    const int tid = tid_, wid = __builtin_amdgcn_readfirstlane(tid >> 6), lane = tid & 63, wr = wid >> 2, wc = wid & 3, fr = lane & 15, fq = lane >> 4;
    const int nt = K / BK;
    const char* Abase = (const char*)Abase_;
    unsigned voffB[2], voffA[2];
#pragma unroll
    for (int i = 0; i < 2; ++i) { int R, C; stage_rc(tid * 16 + i * 8192, R, C); const int Rb = Epi::PERM ? ((R & ~31) + perm32(R & 31)) : R; voffB[i] = (unsigned)(Rb * K + C) * 2u; voffA[i] = (unsigned)(R * K + C) * 2u; }
    const size_t kstep = (size_t)(BK * 2);
    const size_t hstep = (size_t)HALF * K * 2;
    const unsigned ldsw = (unsigned)wid * 1024u;
    const int aoff = lds_byte(wr * 64 + fr, fq * 8), boff = lds_byte(wc * 32 + fr, fq * 8);
#define PG8_SA(b, h) (((b) * 2 + (h)) * HTB)
#define PG8_SB(b, h) ((4 + (b) * 2 + (h)) * HTB)
#define PG8_STAGE_B(bufoff, gbase) do { _Pragma("unroll") for (int _i = 0; _i < 2; ++_i) \
        __builtin_amdgcn_global_load_lds((const unsigned*)((const char*)(gbase) + voffB[_i]), (LAS unsigned*)(lds + (bufoff) + ldsw + _i * 8192), 16, 0, 0); } while (0)
#define PG8_STAGE_A(bufoff, ua, pa, h, koff) do { _Pragma("unroll") for (int _i = 0; _i < 2; ++_i) { \
        const char* _g = GATHER ? (Abase + (size_t)(ua)[h][_i] + (koff)) : ((pa) + (size_t)(h) * hstep + voffA[_i] + (koff)); \
        __builtin_amdgcn_global_load_lds((const unsigned*)_g, (LAS unsigned*)(lds + (bufoff) + ldsw + _i * 8192), 16, 0, 0); } } while (0)
#define PG8_LDA(dst, b, h) do { _Pragma("unroll") for (int m = 0; m < 4; ++m) _Pragma("unroll") for (int k = 0; k < 2; ++k) dst[m][k] = *(const LAS bf16x8*)(lds + PG8_SA(b, h) + aoff + m * 2048 + k * 1024); } while (0)
#define PG8_LDB(dst, b, h) do { _Pragma("unroll") for (int n = 0; n < 2; ++n) _Pragma("unroll") for (int k = 0; k < 2; ++k) dst[n][k] = *(const LAS bf16x8*)(lds + PG8_SB(b, h) + boff + n * 2048 + k * 1024); } while (0)
#define PG8_MMA(ai, bj, At, Bt) do { __builtin_amdgcn_s_setprio(1); _Pragma("unroll") for (int m = 0; m < 4; ++m) _Pragma("unroll") for (int n = 0; n < 2; ++n) _Pragma("unroll") for (int k = 0; k < 2; ++k) \
        acc[ai][bj][m][n] = __builtin_amdgcn_mfma_f32_16x16x32_bf16(Bt[n][k], At[m][k], acc[ai][bj][m][n], 0, 0, 0); __builtin_amdgcn_s_setprio(0); } while (0)
#define PG8_WAIT_V(n) asm volatile("s_waitcnt vmcnt(" #n ")" ::: "memory")
#define PG8_WAIT_L(n) asm volatile("s_waitcnt lgkmcnt(" #n ")" ::: "memory")
#define PG8_BAR __builtin_amdgcn_s_barrier()
#define PG8_SCHED __builtin_amdgcn_sched_barrier(0)
    Unit cur, nxt; int ui = 0;
    if (!S.next(0, cur)) return;
    f32x4 acc[2][2][4][2];
#pragma unroll
    for (int a = 0; a < 2; ++a)
#pragma unroll
        for (int b = 0; b < 2; ++b)
#pragma unroll
            for (int m = 0; m < 4; ++m)
#pragma unroll
                for (int n = 0; n < 2; ++n) acc[a][b][m][n] = (f32x4){0.f, 0.f, 0.f, 0.f};
    bf16x8 At[4][2], B0[2][2], B1[2][2];
    unsigned uc[2][2], un[2][2];
    if constexpr (GATHER) S.a_offsets(cur, tid, uc);
    const char* cA = Abase + (size_t)cur.rowbase * K * 2;
    const char* cB = S.b_tile(cur);
    PG8_STAGE_B(PG8_SB(0, 0), cB); PG8_STAGE_B(PG8_SB(0, 1), cB + hstep); PG8_STAGE_A(PG8_SA(0, 0), uc, cA, 0, (size_t)0); PG8_STAGE_A(PG8_SA(0, 1), uc, cA, 1, (size_t)0);
    if (wr == 1) PG8_BAR;
    PG8_WAIT_V(2); PG8_BAR;
    PG8_STAGE_B(PG8_SB(1, 0), cB + kstep); PG8_STAGE_A(PG8_SA(1, 0), uc, cA, 0, kstep); PG8_STAGE_B(PG8_SB(1, 1), cB + hstep + kstep);
    PG8_WAIT_V(6); PG8_BAR;
    for (;;) {
        const bool has_next = S.next(ui + 1, nxt);
        const bool lower = cur.nrows > wr * 64, upper = cur.nrows > HALF + wr * 64;
        const char* nB = cB; const char* nA = cA;
        if (has_next) { if constexpr (GATHER) S.a_offsets(nxt, tid, un); nB = S.b_tile(nxt); nA = Abase + (size_t)nxt.rowbase * K * 2; }
        else if constexpr (GATHER) {
#pragma unroll
            for (int h = 0; h < 2; ++h)
#pragma unroll
                for (int i = 0; i < 2; ++i) un[h][i] = uc[h][i];
        }
#pragma unroll 1
        for (int t = 0; t < nt; t += 2) {
            const bool last = (t == nt - 2);
            const size_t k1 = (size_t)(t + 1) * kstep;
            const size_t k2 = last ? (size_t)0 : (size_t)(t + 2) * kstep, k3 = k2 + kstep;
            const char* b2 = last ? nB : cB + (size_t)(t + 2) * kstep; const char* b3 = b2 + kstep;
            const char* a2 = last ? nA : cA;
            unsigned x2[2][2];
            if constexpr (GATHER) {
#pragma unroll
                for (int h = 0; h < 2; ++h)
#pragma unroll
                    for (int i = 0; i < 2; ++i) x2[h][i] = uc[h][i];
                if (last) { asm volatile("; next unit's A offsets" ::: "memory");
#pragma unroll
                    for (int h = 0; h < 2; ++h)
#pragma unroll
                        for (int i = 0; i < 2; ++i) x2[h][i] = un[h][i]; }
            }
            if constexpr (MIDSCALE) { if (t == nt / 2) {
#pragma unroll
                for (int ai = 0; ai < 2; ++ai)
#pragma unroll
                    for (int m = 0; m < 4; ++m) { const float f = ((const LAS float*)(lds + STAGE_BYTES))[2 * (ai * HALF + wr * 64 + m * 16 + fr)];
#pragma unroll
                        for (int bj = 0; bj < 2; ++bj)
#pragma unroll
                            for (int n = 0; n < 2; ++n) acc[ai][bj][m][n] *= f; } } }
            PG8_LDB(B0, 0, 0); PG8_LDB(B1, 0, 1); PG8_SCHED; PG8_LDA(At, 0, 0); PG8_STAGE_A(PG8_SA(1, 1), uc, cA, 1, k1);
            PG8_WAIT_V(8); PG8_WAIT_L(0); PG8_BAR; if (lower) { PG8_MMA(0, 0, At, B0); PG8_MMA(0, 1, At, B1); } PG8_BAR; PG8_SCHED;
            PG8_LDA(At, 0, 1); PG8_STAGE_B(PG8_SB(0, 0), b2); PG8_STAGE_B(PG8_SB(0, 1), b2 + hstep); PG8_STAGE_A(PG8_SA(0, 0), x2, a2, 0, k2);
            PG8_WAIT_V(8); PG8_WAIT_L(0); PG8_BAR; if (upper) { PG8_MMA(1, 0, At, B0); PG8_MMA(1, 1, At, B1); } PG8_BAR; PG8_SCHED;
            PG8_LDB(B0, 1, 0); PG8_LDB(B1, 1, 1); PG8_SCHED; PG8_LDA(At, 1, 0); PG8_STAGE_A(PG8_SA(0, 1), x2, a2, 1, k2);
            PG8_WAIT_V(8); PG8_WAIT_L(0); PG8_BAR; if (lower) { PG8_MMA(0, 0, At, B0); PG8_MMA(0, 1, At, B1); } PG8_BAR; PG8_SCHED;
            PG8_LDA(At, 1, 1); PG8_STAGE_B(PG8_SB(1, 0), b3); PG8_STAGE_B(PG8_SB(1, 1), b3 + hstep); PG8_STAGE_A(PG8_SA(1, 0), x2, a2, 0, k3);
            PG8_WAIT_V(8); PG8_WAIT_L(0); PG8_BAR; if (upper) { PG8_MMA(1, 0, At, B0); PG8_MMA(1, 1, At, B1); } PG8_BAR; PG8_SCHED;
        }
        if constexpr (ALIGN_EPI) { if (wr == 0) PG8_BAR; }
        E(acc, cur, wr, wc, fr, fq);
        if (!has_next) break;
#pragma unroll
        for (int a = 0; a < 2; ++a)
#pragma unroll
            for (int b = 0; b < 2; ++b)
#pragma unroll
                for (int m = 0; m < 4; ++m)
#pragma unroll
                    for (int n = 0; n < 2; ++n) acc[a][b][m][n] = (f32x4){0.f, 0.f, 0.f, 0.f};
        cur = nxt; cB = nB; cA = nA; ++ui;
        if constexpr (GATHER) {
#pragma unroll
            for (int h = 0; h < 2; ++h)
#pragma unroll
                for (int i = 0; i < 2; ++i) uc[h][i] = un[h][i];
        }
        if constexpr (ALIGN_EPI) { if (wr == 1) PG8_BAR; }
    }
    PG8_WAIT_V(0);
    if constexpr (!ALIGN_EPI) { if (wr == 0) PG8_BAR; }
    PG8_BAR;
#undef PG8_SA
#undef PG8_SB
#undef PG8_STAGE_A
#undef PG8_STAGE_B
#undef PG8_LDA
#undef PG8_LDB
#undef PG8_MMA
#undef PG8_WAIT_V
#undef PG8_WAIT_L
#undef PG8_BAR
#undef PG8_SCHED
}
}

__device__ __forceinline__ void cvt_item(const float* W, int ldw, int col0, int k0, bf16_t* WT, int drow0, int Kd, const float* gk, LAS float* scr, int lane) {
    const int kr = lane >> 3, n4 = lane & 7;
    float4 v[8];
#pragma unroll
    for (int i = 0; i < 8; ++i) v[i] = *(const float4*)&W[(size_t)(k0 + 8 * i + kr) * ldw + col0 + 4 * n4];
#pragma unroll
    for (int i = 0; i < 8; ++i) { const int kk = 8 * i + kr; const float g = gk ? gk[k0 + kk] : 1.f; LAS float* d = scr + kk * 33 + 4 * n4;
        d[0] = v[i].x * g; d[1] = v[i].y * g; d[2] = v[i].z * g; d[3] = v[i].w * g; }
    asm volatile("s_waitcnt lgkmcnt(0)" ::: "memory");
    const int cch = lane & 7;
#pragma unroll
    for (int j = 0; j < 4; ++j) { const int n = (lane >> 3) + 8 * j; const LAS float* sp = scr + (8 * cch) * 33 + n;
        uint4 o; o.x = pk2(sp[0 * 33], sp[1 * 33]); o.y = pk2(sp[2 * 33], sp[3 * 33]); o.z = pk2(sp[4 * 33], sp[5 * 33]); o.w = pk2(sp[6 * 33], sp[7 * 33]);
        *(uint4*)(WT + (size_t)(drow0 + n) * Kd + k0 + 8 * cch) = o; }
    asm volatile("s_waitcnt lgkmcnt(0)" ::: "memory");
}
#define PHASE_PTRS \
    unsigned char* wsp = args.ws; asm volatile("" : "+s"(wsp)); \
    const float* x = args.in[0]; const float* cvec = args.in[1]; const float* w_ada = args.in[2]; const float* b_ada = args.in[3]; \
    const float* g_pre_mix = args.in[4]; const float* g_post_mix = args.in[5]; const float* g_pre_ffn = args.in[6]; const float* g_post_ffn = args.in[7]; \
    const float* w_in = args.in[8]; const float* g_q_a = args.in[9]; const float* w_q_b = args.in[10]; const float* g_kv_a = args.in[11]; const float* w_kv_b = args.in[12]; \
    const float* g_q_head = args.in[13]; const float* g_k_head = args.in[14]; const float* g_mla_out = args.in[15]; const float* g_gqa_out = args.in[16]; \
    const float* w_out = args.in[17]; const float* w_router = args.in[18]; const float* b_router = args.in[19]; \
    const float* w_gate_e = args.in[20]; const float* w_up_e = args.in[21]; const float* w_down_e = args.in[22]; \
    const float* w_gate_s = args.in[23]; const float* w_up_s = args.in[24]; const float* w_down_s = args.in[25]; \
    float* mod = (float*)(wsp + WS_MOD); \
    float* cosm = (float*)(wsp + WS_COSM); float* sinm = (float*)(wsp + WS_SINM); float* cosg = (float*)(wsp + WS_COSG); float* sing = (float*)(wsp + WS_SING); \
    bf16_t* H2 = (bf16_t*)(wsp + WS_H2); \
    bf16_t* QM = (bf16_t*)(wsp + WS_QM); bf16_t* KM = (bf16_t*)(wsp + WS_KM); bf16_t* VM = (bf16_t*)(wsp + WS_VM); \
    bf16_t* QG = (bf16_t*)(wsp + WS_QG); bf16_t* KG = (bf16_t*)(wsp + WS_KG); bf16_t* VG = (bf16_t*)(wsp + WS_VG); \
    bf16_t* O = (bf16_t*)(wsp + WS_O); \
    bf16_t* X1 = (bf16_t*)(wsp + WS_X1); float* WTS = (float*)(wsp + WS_WTS); int* LIST = (int*)(wsp + WS_LIST); \
    bf16_t* SLOTS = (bf16_t*)(wsp + WS_SLOTS); int* POSREC = (int*)(wsp + WS_POSREC); float* OSTAT = (float*)(wsp + WS_OSTAT); \
    bf16_t* PBUF = (bf16_t*)(wsp + WS_PBUF); bf16_t* WBIGT = (bf16_t*)(wsp + WS_WBIGT); \
    bf16_t* WQBT = (bf16_t*)(wsp + WS_WQBT); bf16_t* WINQ = (bf16_t*)(wsp + WS_WINQ); bf16_t* WKVBT = (bf16_t*)(wsp + WS_WKVBT); bf16_t* WINKV = (bf16_t*)(wsp + WS_WINKV); \
    bf16_t* WOUTT = (bf16_t*)(wsp + WS_WOUTT); bf16_t* WRST = (bf16_t*)(wsp + WS_WRST); bf16_t* WDST = (bf16_t*)(wsp + WS_WDST); \
    bf16_t* WGUT = (bf16_t*)(wsp + WS_WGUT); bf16_t* WDT = (bf16_t*)(wsp + WS_WDT); \
    bf16_t* MIXED = (bf16_t*)(wsp + WS_MIXED); float* LOG = (float*)(wsp + WS_LOG); bf16_t* ACT = (bf16_t*)(wsp + WS_ACT); bf16_t* ACTS = (bf16_t*)(wsp + WS_ACTS); bf16_t* YSH = (bf16_t*)(wsp + WS_YSH);

__global__ void __launch_bounds__(NTHR, 2) mega(Args args) {
    extern __shared__ __attribute__((aligned(16))) unsigned char lds_raw[];
    unsigned char* ws = args.ws;
    unsigned* ctl = (unsigned*)(ws + WS_CTL);
    volatile LAS unsigned* bst = (volatile LAS unsigned*)(lds_raw + LDS_BYTES - 16);
    if (threadIdx.x < 4) bst[threadIdx.x] = 0u;
    const int nbk = gridDim.x, bidk = blockIdx.x;
    __syncthreads();
    XcdBarrier bar; bar.bar = ctl + CW_BAR; bar.x = 0; bar.st = bst;
    if (MK_N_LAUNCHES == 1) bar = xcd_barrier_post(ctl + CW_BAR, bst);
    const int lo = args.ph_lo, hi = args.ph_hi;
    const int vcu = (nbk % 8 == 0) ? (bidk % 8) * (nbk / 8) + bidk / 8 : bidk;
    LAS unsigned char* ldsb = (LAS unsigned char*)lds_raw;
#define IN(k) (lo <= (k) && (k) < hi && (pass_ == 0 || ((k) >= REP_FROM && (k) != 8)))
#define SEAM(k) do { if (lo <= (k) && (k) + 1 < hi && (pass_ == 0 || (k) >= REP_FROM)) xcd_barrier(bar); } while (0)

    unsigned* CNT = (unsigned*)(ws + WS_CNTS);

    for (int pass_ = 0; pass_ < (REP_FROM < 12 ? 2 : 1); ++pass_) {
    if (pass_) xcd_barrier(bar);
    if (IN(0)) for (int rep_ = 0; rep_ < (((REPEAT_MASK >> 0) & 1) ? 2 : 1); ++rep_) {
        const Ctx c = mkctx(ws, lds_raw); PHASE_PTRS
        float* red = c.lds;
        if (c.tid == 0) for (int e = c.bid; e < NE; e += c.nb) CNT[(size_t)e * CNT_STRIDE] = 0u;
        for (int g = c.bid; g < 192; g += c.nb) {
            const int c4 = c.tid & 7, kr = c.tid >> 3;
            float4 w[16];
#pragma unroll
            for (int i = 0; i < 16; ++i) w[i] = *(const float4*)&w_ada[(size_t)(64 * i + kr) * 6144 + g * 32 + 4 * c4];
            float4 a0 = make_float4(0.f, 0.f, 0.f, 0.f), a1 = a0;
#pragma unroll
            for (int i = 0; i < 16; ++i) { const int k = 64 * i + kr; const float c0 = cvec[k], c1 = cvec[DM + k]; const float f0 = c0 * sigmoidf_(c0), f1 = c1 * sigmoidf_(c1);
                a0.x += f0 * w[i].x; a0.y += f0 * w[i].y; a0.z += f0 * w[i].z; a0.w += f0 * w[i].w; a1.x += f1 * w[i].x; a1.y += f1 * w[i].y; a1.z += f1 * w[i].z; a1.w += f1 * w[i].w; }
            __syncthreads();
            *(float4*)&red[(kr * 8 + c4) * 4] = a0; *(float4*)&red[2048 + (kr * 8 + c4) * 4] = a1;
            __syncthreads();
            if (c.tid < 64) { const int b = c.tid >> 5, cc = c.tid & 31; float sacc = 0.f; for (int j = 0; j < 64; ++j) sacc += red[b * 2048 + j * 32 + cc]; mod[b * 6144 + g * 32 + cc] = sacc + b_ada[g * 32 + cc]; }
        }
        __syncthreads();
        for (int idx = c.bid * NTHR + c.tid; idx < SEQ * 16; idx += c.nb * NTHR) {
            const int s = idx >> 4, i = idx & 15, f = i & 7;
            const float inv = powf(10000.f, -(float)f / 8.f);
            const float pos = (float)((i < 8) ? (s >> 6) : (s & 63));
            const float ang = pos * inv;
            cosm[idx] = cosf(ang); sinm[idx] = sinf(ang);
        }
        for (int idx = c.bid * NTHR + c.tid; idx < SEQ * 32; idx += c.nb * NTHR) {
            const int s = idx >> 5, i = idx & 31, f = i & 15;
            const float inv = powf(10000.f, -(float)f / 16.f);
            const float pos = (float)((i < 16) ? (s >> 6) : (s & 63));
            const float ang = pos * inv;
            cosg[idx] = cosf(ang); sing[idx] = sinf(ang);
        }
        LAS float* scr = (LAS float*)(ldsb + 8192 + c.wave * 8448);
        constexpr int I_BIG = 37 * 16;
        constexpr int I_QB = 24 * 4;
        constexpr int I_KVB = 32 * 2;
        constexpr int I_OUT = 32 * 16;
        constexpr int I_RS = 24 * 16;
        constexpr int I_DS = 32 * 4;
        const int I_EXP = (c.nb == NE && (CONV_MODE == 1 || CONV_MODE == 5)) ? 0 : NE * 384;
        const int I_TOT = I_BIG + I_QB + I_KVB + I_OUT + I_RS + I_DS + I_EXP;
        for (int it = c.gw; it < I_TOT; it += c.ngw) {
            int r = it;
            if (r < I_BIG) { const int grp = r >> 4, kb = r & 15; const int col0 = grp * 32, drow = (grp < 13) ? grp * 32 : 2304 + (grp - 13) * 32;
                cvt_item(w_in, INC, col0, kb * 64, WBIGT, drow, DM, nullptr, scr, c.lane); continue; }
            r -= I_BIG;
            if (r < I_QB) { const int grp = r >> 2, kb = r & 3; cvt_item(w_q_b, 768, grp * 32, kb * 64, WQBT, grp * 32, 256, g_q_a, scr, c.lane); continue; }
            r -= I_QB;
            if (r < I_KVB) { const int grp = r >> 1, kb = r & 1; cvt_item(w_kv_b, 1024, grp * 32, kb * 64, WKVBT, grp * 32, 256, g_kv_a, scr, c.lane); continue; }
            r -= I_KVB;
            if (r < I_OUT) { const int grp = r >> 4, kb = r & 15; cvt_item(w_out, DM, grp * 32, kb * 64, WOUTT, grp * 32, DM, (kb < 8) ? g_mla_out : (g_gqa_out - 512), scr, c.lane); continue; }
            r -= I_OUT;
            if (r < I_RS) { const int grp = r >> 4, kb = r & 15;
                if (grp < 8) cvt_item(w_router, NE, grp * 32, kb * 64, WRST, grp * 32, DM, nullptr, scr, c.lane);
                else { const int q = grp - 8, blk = q >> 2, sub = q & 3;
                    cvt_item((blk & 1) ? w_up_s : w_gate_s, EFF, (blk >> 1) * 128 + sub * 32, kb * 64, WRST, 256 + blk * 128 + sub * 32, DM, nullptr, scr, c.lane); }
                continue; }
            r -= I_RS;
            if (r < I_DS) { const int grp = r >> 2, kb = r & 3; cvt_item(w_down_s, DM, grp * 32, kb * 64, WDST, grp * 32, EFF, nullptr, scr, c.lane); continue; }
            r -= I_DS;
            { const int e = r / 384, q = r % 384;
              if (q < 256) { const int up = q >> 7, q2 = q & 127, grp = q2 >> 4, kb = q2 & 15;
                  const int drow = ((grp < 4) ? grp * 32 : 256 + (grp - 4) * 32) + up * 128;
                  cvt_item((up ? w_up_e : w_gate_e) + (size_t)e * DM * EFF, EFF, grp * 32, kb * 64, WGUT + (size_t)e * 512 * DM, drow, DM, nullptr, scr, c.lane); }
              else { const int q2 = q - 256, grp = q2 >> 2, kb = q2 & 3;
                  cvt_item(w_down_e + (size_t)e * EFF * DM, DM, grp * 32, kb * 64, WDT + (size_t)e * DM * EFF, grp * 32, EFF, nullptr, scr, c.lane); } }
        }
        const int gt = c.bid * NTHR + c.tid, ngt = c.nb * NTHR;
        for (int i = gt; i < 96 * 1024 / 8; i += ngt) *(uint4*)(WBIGT + (size_t)416 * DM + (size_t)i * 8) = make_uint4(0u, 0u, 0u, 0u);
        for (int i = gt; i < 1024 * 16; i += ngt) { const int n = i >> 4, q = i & 15; *(uint4*)(WKVBT + (size_t)n * 256 + 128 + q * 8) = make_uint4(0u, 0u, 0u, 0u); }
        for (int i = gt; i < 1024 * 64; i += ngt) { const int k = i >> 6, q = i & 63; const float4 v = *(const float4*)&w_in[(size_t)k * INC + q * 4]; uint2 o; o.x = pk2(v.x, v.y); o.y = pk2(v.z, v.w); *(uint2*)(WINQ + (size_t)k * 256 + q * 4) = o; }
        for (int i = gt; i < 1024 * 64; i += ngt) { const int k = i >> 6, q = i & 63; uint2 o = make_uint2(0u, 0u);
            if (q < 32) { const float4 v = *(const float4*)&w_in[(size_t)k * INC + 256 + q * 4]; o.x = pk2(v.x, v.y); o.y = pk2(v.z, v.w); }
            *(uint2*)(WINKV + (size_t)k * 256 + q * 4) = o; }
    }
    SEAM(0);

    if (IN(1)) for (int rep_ = 0; rep_ < (((REPEAT_MASK >> 1) & 1) ? 2 : 1); ++rep_) {
        const Ctx c = mkctx(ws, lds_raw); PHASE_PTRS
        { pg8::DenseOrder S; S.init(768, 1024, 256, WINQ, c.nb, c.bid); pg8::EpiBf16 E{WBIGT + (size_t)512 * DM, DM};
          pg8::gemm_phase<pg8::EpiBf16, pg8::DenseOrder, true>(ldsb, WQBT, 256, S, E); }
        { pg8::DenseOrder S; S.init(1024, 1024, 256, WINKV, c.nb, (c.bid >= 12 && c.nb >= 28) ? c.bid - 12 : c.bid + (c.nb >= 28 ? c.nb : 0)); pg8::EpiBf16 E{WBIGT + (size_t)1280 * DM, DM};
          pg8::gemm_phase<pg8::EpiBf16, pg8::DenseOrder, true>(ldsb, WKVBT, 256, S, E); }
        const bool hsplit = c.nb >= 56; const int hw = hsplit ? c.gw - 28 * 8 : c.gw, nhw = hsplit ? c.ngw - 28 * 8 : c.ngw;
        if (hw >= 0) for (int m0 = hw; m0 < NTOK; m0 += 2 * nhw) {
            float4 v[2][4]; float ss[2];
#pragma unroll
            for (int q = 0; q < 2; ++q) { const int m = (m0 + q * nhw < NTOK) ? m0 + q * nhw : m0; ss[q] = 0.f;
#pragma unroll
                for (int j = 0; j < 4; ++j) { v[q][j] = *(const float4*)&x[(size_t)m * DM + 4 * c.lane + 256 * j]; } }
#pragma unroll
            for (int q = 0; q < 2; ++q) {
                const int m = (m0 + q * nhw < NTOK) ? m0 + q * nhw : m0; const int b = m / SEQ; const float* md = mod + b * 6144;
#pragma unroll
                for (int j = 0; j < 4; ++j) ss[q] += v[q][j].x * v[q][j].x + v[q][j].y * v[q][j].y + v[q][j].z * v[q][j].z + v[q][j].w * v[q][j].w;
                const float rstd = rsqrtf(wave_sum(ss[q]) * (1.f / DM) + EPS);
#pragma unroll
                for (int j = 0; j < 4; ++j) {
                    const int cc = 4 * c.lane + 256 * j;
                    const float4 g = *(const float4*)&g_pre_mix[cc], sc = *(const float4*)&md[1024 + cc], sh = *(const float4*)&md[cc];
                    uint2 o;
                    o.x = pk2(v[q][j].x * rstd * g.x * (1.f + sc.x) + sh.x, v[q][j].y * rstd * g.y * (1.f + sc.y) + sh.y);
                    o.y = pk2(v[q][j].z * rstd * g.z * (1.f + sc.z) + sh.z, v[q][j].w * rstd * g.w * (1.f + sc.w) + sh.w);
                    *(uint2*)&H2[(size_t)m * DM + cc] = o;
                }
            }
        }
    }
    SEAM(1);

    if (IN(2)) for (int rep_ = 0; rep_ < (((REPEAT_MASK >> 2) & 1) ? 2 : 1); ++rep_) {
        const Ctx c = mkctx(ws, lds_raw); PHASE_PTRS
        pg8::DenseOrder S; S.init(NTOK, 3072, DM, WBIGT, c.nb, c.bid); pg8::EpiBf16 E{PBUF, 3072};
        pg8::gemm_phase<pg8::EpiBf16, pg8::DenseOrder, true>(ldsb, H2, DM, S, E);
    }
    SEAM(2);

    if (IN(3)) for (int rep_ = 0; rep_ < (((REPEAT_MASK >> 3) & 1) ? 2 : 1); ++rep_) {
        const Ctx c = mkctx(ws, lds_raw); PHASE_PTRS
        unsigned* kmaxL = (unsigned*)lds_raw;
        if (c.tid < 18) kmaxL[c.tid] = 0u;
        __syncthreads();
        uint4 nraw[6];
#pragma unroll
        for (int j = 0; j < 6; ++j) nraw[j] = *(const uint4*)(PBUF + (size_t)c.gw * 3072 + 512 * j + 8 * c.lane);
        for (int m = c.gw; m < NTOK; m += c.ngw) {
            const int b = m / SEQ, s = m % SEQ;
            uint4 raw[6];
#pragma unroll
            for (int j = 0; j < 6; ++j) raw[j] = nraw[j];
            if (m + c.ngw < NTOK) {
#pragma unroll
                for (int j = 0; j < 6; ++j) nraw[j] = *(const uint4*)(PBUF + (size_t)(m + c.ngw) * 3072 + 512 * j + 8 * c.lane);
            }
            float rq, rkv;
            {
                float v[8]; { const uint4 u = raw[0]; v[0] = bf2f(u.x & 0xffffu); v[1] = bf2f(u.x >> 16); v[2] = bf2f(u.y & 0xffffu); v[3] = bf2f(u.y >> 16); v[4] = bf2f(u.z & 0xffffu); v[5] = bf2f(u.z >> 16); v[6] = bf2f(u.w & 0xffffu); v[7] = bf2f(u.w >> 16); }
                float sq = 0.f;
#pragma unroll
                for (int i = 0; i < 8; ++i) sq += v[i] * v[i];
                rq = rsqrtf(wave_sum(c.lane < 32 ? sq : 0.f) * (1.f / QLORA) + EPS);
                rkv = rsqrtf(wave_sum((c.lane >= 32 && c.lane < 48) ? sq : 0.f) * (1.f / KVLORA) + EPS);
                if (c.lane >= 48 && c.lane < 52) {
                    const int i0 = 4 * (c.lane - 48); uint4 o; unsigned ow[4];
#pragma unroll
                    for (int pq = 0; pq < 4; ++pq) { const float cs = cosm[s * 16 + i0 + pq], sn = sinm[s * 16 + i0 + pq]; ow[pq] = pk2(v[2 * pq] * cs - v[2 * pq + 1] * sn, v[2 * pq] * sn + v[2 * pq + 1] * cs); }
                    o.x = ow[0]; o.y = ow[1]; o.z = ow[2]; o.w = ow[3];
#pragma unroll
                    for (int h = 0; h < MH; ++h) *(uint4*)&KM[((size_t)(b * MH + h) * SEQ + s) * DQKM + MNOPE + 2 * i0] = o;
                    float pq = 0.f;
#pragma unroll
                    for (int i = 0; i < 8; ++i) pq += v[i] * v[i];
                    pq += dppmov<0xB1, 0xF>(0.f, pq); pq += dppmov<0x4E, 0xF>(0.f, pq);
                    if (c.lane == 48) atomicMax(&kmaxL[16 + b], __builtin_bit_cast(unsigned, pq));
                }
            }
#pragma unroll
            for (int j = 1; j < 6; ++j) {
                const int col0 = 512 * j + 8 * c.lane;
                float v[8]; { const uint4 u = raw[j]; v[0] = bf2f(u.x & 0xffffu); v[1] = bf2f(u.x >> 16); v[2] = bf2f(u.y & 0xffffu); v[3] = bf2f(u.y >> 16); v[4] = bf2f(u.z & 0xffffu); v[5] = bf2f(u.z >> 16); v[6] = bf2f(u.w & 0xffffu); v[7] = bf2f(u.w >> 16); }
                if (col0 < 1280) {
                    const int qc = col0 - 512, h = qc / DQKM, d0 = qc % DQKM; const float sc = rq * C2M;
                    uint4 o; unsigned ow[4];
                    if (d0 >= MNOPE) { const int i0 = (d0 - MNOPE) >> 1;
#pragma unroll
                        for (int pq = 0; pq < 4; ++pq) { const float cs = cosm[s * 16 + i0 + pq], sn = sinm[s * 16 + i0 + pq]; ow[pq] = pk2((v[2 * pq] * cs - v[2 * pq + 1] * sn) * sc, (v[2 * pq] * sn + v[2 * pq + 1] * cs) * sc); }
                    } else {
#pragma unroll
                        for (int pq = 0; pq < 4; ++pq) ow[pq] = pk2(v[2 * pq] * sc, v[2 * pq + 1] * sc);
                    }
                    o.x = ow[0]; o.y = ow[1]; o.z = ow[2]; o.w = ow[3];
                    *(uint4*)&QM[((size_t)(b * MH + h) * SEQ + s) * DQKM + d0] = o;
                } else if (col0 < 2304) {
                    const int kc = col0 - 1280, h = kc >> 7, d0 = kc & 127;
                    uint4 o; o.x = pk2(v[0] * rkv, v[1] * rkv); o.y = pk2(v[2] * rkv, v[3] * rkv); o.z = pk2(v[4] * rkv, v[5] * rkv); o.w = pk2(v[6] * rkv, v[7] * rkv);
                    if (d0 < MNOPE) { *(uint4*)&KM[((size_t)(b * MH + h) * SEQ + s) * DQKM + d0] = o;
                        float kq = 0.f;
#pragma unroll
                        for (int i = 0; i < 8; ++i) kq += (v[i] * rkv) * (v[i] * rkv);
                        kq += dppmov<0xB1, 0xF>(0.f, kq); kq += dppmov<0x4E, 0xF>(0.f, kq); kq += dppmov<0x141, 0xF>(0.f, kq);
                        if ((c.lane & 7) == 0) atomicMax(&kmaxL[b * 8 + h], __builtin_bit_cast(unsigned, kq)); }
                    else *(uint4*)&VM[((size_t)(b * MH + h) * SEQ + s) * MV + (d0 - MNOPE)] = o;
                } else if (col0 < 2944) {
                    const bool isq = col0 < 2816; const int hc = isq ? (col0 - 2304) : (col0 - 2816), h = hc >> 6, d0 = hc & 63;
                    float sq = 0.f;
#pragma unroll
                    for (int i = 0; i < 8; ++i) sq += v[i] * v[i];
                    sq += __shfl_xor(sq, 1); sq += __shfl_xor(sq, 2); sq += __shfl_xor(sq, 4);
                    const float rs = rsqrtf(sq * (1.f / GD) + EPS) * (isq ? C2G : 1.f); const float* gh = isq ? g_q_head : g_k_head;
                    uint4 o; unsigned ow[4];
#pragma unroll
                    for (int pq = 0; pq < 4; ++pq) { const int d = d0 + 2 * pq; const float cs = cosg[s * 32 + (d >> 1)], sn = sing[s * 32 + (d >> 1)];
                        const float x0 = v[2 * pq] * rs * gh[d], x1 = v[2 * pq + 1] * rs * gh[d + 1]; ow[pq] = pk2(x0 * cs - x1 * sn, x0 * sn + x1 * cs); }
                    o.x = ow[0]; o.y = ow[1]; o.z = ow[2]; o.w = ow[3];
                    if (isq) *(uint4*)&QG[((size_t)(b * GH + h) * SEQ + s) * GD + d0] = o;
                    else *(uint4*)&KG[((size_t)(b * GKV + h) * SEQ + s) * GD + d0] = o;
                } else {
                    const int hc = col0 - 2944, h = hc >> 6, d0 = hc & 63;
                    *(uint4*)&VG[((size_t)(b * GKV + h) * SEQ + s) * GD + d0] = raw[j];
                }
            }
        }
        __syncthreads();
        if (c.tid < 18) atomicMax(ctl + CW_KMAX + c.tid, kmaxL[c.tid]);
    }
    SEAM(3);

    if (IN(4)) for (int rep_ = 0; rep_ < (((REPEAT_MASK >> 4) & 1) ? 2 : 1); ++rep_) {
        const Ctx c = mkctx(ws, lds_raw); PHASE_PTRS
        att::ConvState cs;
        { const int e = (c.nb == NE) ? c.bid : 0;
          cs.cj = 0; cs.jbase = 384 * c.wave;
          cs.wg = (const char*)(w_gate_e + (size_t)e * DM * EFF); cs.wu = (const char*)(w_up_e + (size_t)e * DM * EFF); cs.wd = (const char*)(w_down_e + (size_t)e * EFF * DM);
          cs.dgu = (char*)(WGUT + (size_t)e * 512 * DM); cs.dd = (char*)(WDT + (size_t)e * DM * EFF);
          cs.ldsbuf = (unsigned)(uintptr_t)lds_raw + att::CONV_LDS + (CONV_MODE >= 5 ? 0 : c.wave * 4096); cs.rdbuf = (att::lds_cptr)lds_raw + att::CONV_LDS + (CONV_MODE >= 5 ? 0 : c.wave * 4096);
          if (CONV_MODE >= 5) cs.jbase = 0;
          if (CONV_MODE != 0 && CONV_MODE < 5) for (int i = 0; i < 3; ++i) { const att::ConvJob q = att::conv_job(cs, cs.cj);
              att::glds16_s(q.sbase, (unsigned)(c.lane >> 3) * q.ldwB + (unsigned)(c.lane & 7) * 16u, (unsigned)__builtin_amdgcn_readfirstlane(cs.ldsbuf + (cs.cj & 3) * 1024)); ++cs.cj; }
          asm volatile("s_waitcnt vmcnt(0)" ::: "memory"); }
        float mfix;
        { const float gq = wave_max(fabsf(g_q_head[c.lane])), gk = wave_max(fabsf(g_k_head[c.lane])); mfix = fminf(64.f * C2G * gq * gk * 1.03f + 0.5f, 60.f); }
        for (int uu = vcu; uu < 512; uu += c.nb) {
            const int bh = uu >> 5, b = bh >> 3, h = bh & 7, qp = uu & 31;
            const int q0 = qp * 256;
            const float kb2 = __builtin_bit_cast(float, ctl[CW_KMAX + b * 8 + h]) + __builtin_bit_cast(float, ctl[CW_KMAX + 16 + b]);
            att::unit96<8>(QM + (size_t)(b * MH + h) * SEQ * DQKM, KM + (size_t)(b * MH + h) * SEQ * DQKM, VM + (size_t)(b * MH + h) * SEQ * MV,
                                 O + ((size_t)b * SEQ + q0) * DM + h * 64, OSTAT + ((size_t)b * SEQ + q0) * 16 + h, q0, (char*)lds_raw, cs, kb2);
            att::unit64<8>(QG + (size_t)(b * GH + h) * SEQ * GD, KG + (size_t)(b * GKV + (h >> 2)) * SEQ * GD, VG + (size_t)(b * GKV + (h >> 2)) * SEQ * GD,
                                 O + ((size_t)b * SEQ + q0) * DM + (8 + h) * 64, OSTAT + ((size_t)b * SEQ + q0) * 16 + 8 + h, q0, (char*)lds_raw, cs, mfix);
        }
#if CONV_MODE >= 5
        {
            using namespace att;
            const int wid = c.wave, lane = c.lane; const bool rst = wid >= 6;
            for (int r4 = 0; r4 < 3; ++r4) { CONV_DRAIN(); ++cs.cj; }
        }
#endif
    }
    SEAM(4);

    if (IN(5)) for (int rep_ = 0; rep_ < (((REPEAT_MASK >> 5) & 1) ? 2 : 1); ++rep_) {
        const Ctx c = mkctx(ws, lds_raw); PHASE_PTRS
        pg8::DenseOrder S; S.init(NTOK, DM, DM, WOUTT, c.nb, c.bid);
        LAS float* rtab = (LAS float*)(ldsb + pg8::STAGE_BYTES);
        { pg8::Unit u0; if (S.next(0, u0) && c.tid < 256) { const float4* sp = (const float4*)&OSTAT[(size_t)(u0.pm * 256 + c.tid) * 16]; const float4 s0 = sp[0], s1 = sp[1], s2 = sp[2], s3 = sp[3];
            const float sm = ((s0.x + s0.y) + (s0.z + s0.w)) + ((s1.x + s1.y) + (s1.z + s1.w)), sg = ((s2.x + s2.y) + (s2.z + s2.w)) + ((s3.x + s3.y) + (s3.z + s3.w));
            const float rm = rsqrtf(sm * (1.f / 512) + EPS), rg = rsqrtf(sg * (1.f / 512) + EPS); rtab[2 * c.tid] = rm / rg; rtab[2 * c.tid + 1] = rg; }
          __syncthreads(); }
        pg8::EpiBf16RowScale E{MIXED, DM, rtab};
        pg8::gemm_phase<pg8::EpiBf16RowScale, pg8::DenseOrder, true, false, true>(ldsb, O, DM, S, E, nullptr);
    }
    SEAM(5);

    if (IN(6)) for (int rep_ = 0; rep_ < (((REPEAT_MASK >> 6) & 1) ? 2 : 1); ++rep_) {
        const Ctx c = mkctx(ws, lds_raw); PHASE_PTRS
        for (int m0 = c.gw; m0 < NTOK; m0 += 2 * c.ngw) {
            uint2 mu[2][4]; float4 xq[2][4];
#pragma unroll
            for (int q = 0; q < 2; ++q)
#pragma unroll
                for (int j = 0; j < 4; ++j) { const int m = m0 + q * c.ngw; mu[q][j] = *(const uint2*)&MIXED[(size_t)m * DM + 4 * c.lane + 256 * j]; xq[q][j] = *(const float4*)&x[(size_t)m * DM + 4 * c.lane + 256 * j]; }
#pragma unroll
            for (int q = 0; q < 2; ++q) {
                const int m = m0 + q * c.ngw; const int b = m / SEQ; const float* md = mod + b * 6144;
                float4 v[4], xr[4]; float ss = 0.f;
#pragma unroll
                for (int j = 0; j < 4; ++j) { const uint2 u = mu[q][j];
                    v[j].x = bf2f(u.x & 0xffffu); v[j].y = bf2f(u.x >> 16); v[j].z = bf2f(u.y & 0xffffu); v[j].w = bf2f(u.y >> 16);
                    ss += v[j].x * v[j].x + v[j].y * v[j].y + v[j].z * v[j].z + v[j].w * v[j].w; }
                const float rstd = rsqrtf(wave_sum(ss) * (1.f / DM) + EPS);
                float ss1 = 0.f;
#pragma unroll
                for (int j = 0; j < 4; ++j) {
                    const int cc = 4 * c.lane + 256 * j;
                    const float4 g = *(const float4*)&g_post_mix[cc], gt = *(const float4*)&md[2048 + cc], xx = xq[q][j];
                    xr[j].x = xx.x + gt.x * (v[j].x * rstd * g.x); xr[j].y = xx.y + gt.y * (v[j].y * rstd * g.y);
                    xr[j].z = xx.z + gt.z * (v[j].z * rstd * g.z); xr[j].w = xx.w + gt.w * (v[j].w * rstd * g.w);
                    ss1 += xr[j].x * xr[j].x + xr[j].y * xr[j].y + xr[j].z * xr[j].z + xr[j].w * xr[j].w;
                    { uint2 xo; xo.x = pk2(xr[j].x, xr[j].y); xo.y = pk2(xr[j].z, xr[j].w); *(uint2*)&X1[(size_t)m * DM + cc] = xo; }
                }
                const float rstd1 = rsqrtf(wave_sum(ss1) * (1.f / DM) + EPS);
#pragma unroll
                for (int j = 0; j < 4; ++j) {
                    const int cc = 4 * c.lane + 256 * j;
                    const float4 g = *(const float4*)&g_pre_ffn[cc], sc = *(const float4*)&md[4096 + cc], sh = *(const float4*)&md[3072 + cc];
                    uint2 pk;
                    pk.x = pk2(xr[j].x * rstd1 * g.x * (1.f + sc.x) + sh.x, xr[j].y * rstd1 * g.y * (1.f + sc.y) + sh.y);
                    pk.y = pk2(xr[j].z * rstd1 * g.z * (1.f + sc.z) + sh.z, xr[j].w * rstd1 * g.w * (1.f + sc.w) + sh.w);
                    *(uint2*)&H2[(size_t)m * DM + cc] = pk;
                }
            }
        }
    }
    SEAM(6);

    if (IN(7)) for (int rep_ = 0; rep_ < (((REPEAT_MASK >> 7) & 1) ? 2 : 1); ++rep_) {
        const Ctx c = mkctx(ws, lds_raw); PHASE_PTRS
        pg8::DenseOrder S; S.init(NTOK, 768, DM, WRST, c.nb, c.bid); pg8::EpiRS E{LOG, ACTS};
        pg8::gemm_phase<pg8::EpiRS, pg8::DenseOrder, true>(ldsb, H2, DM, S, E);
    }
    SEAM(7);

    if (IN(8)) for (int rep_ = 0; rep_ < (((REPEAT_MASK >> 8) & 1) ? 2 : 1); ++rep_) {
        const Ctx c = mkctx(ws, lds_raw); PHASE_PTRS
        const float4 bb = *(const float4*)&b_router[4 * c.lane];
        const unsigned rowL = (unsigned)(uintptr_t)lds_raw + c.wave * 8192;
        const LAS unsigned char* rowP = ldsb + c.wave * 8192;
        const bool cnt_sort = (MK_N_LAUNCHES == 1) && c.nb == NE && 8 * c.ngw == NTOK && lo < 8 && hi > 9;
        int* histg = (int*)(lds_raw + 65536); int* HIST = (int*)(wsp + WS_HIST);
        if (cnt_sort) { if (c.tid < NE) histg[c.tid] = 0; __syncthreads(); }
        for (int mb = c.gw; mb < NTOK; mb += 8 * c.ngw) {
#pragma unroll
          for (int r = 0; r < 8; ++r) { const int mr = mb + r * c.ngw; if (mr < NTOK) att::glds16(LOG + (size_t)mr * NE + 4 * c.lane, (unsigned)__builtin_amdgcn_readfirstlane(rowL + r * 1024)); }
          asm volatile("s_waitcnt vmcnt(0)" ::: "memory");
          int my_e = 0; float my_s = 0.f; int rb = 0;
#pragma unroll 1
          for (int m = mb; m < NTOK && rb < 8; m += c.ngw) {
            typedef float f32x4v __attribute__((ext_vector_type(4)));
            const f32x4v lg = *(const LAS f32x4v*)(rowP + rb * 1024 + c.lane * 16);
            const float s0 = __builtin_amdgcn_rcpf(1.f + __builtin_amdgcn_exp2f(lg.x * -1.44269504f)), s1 = __builtin_amdgcn_rcpf(1.f + __builtin_amdgcn_exp2f(lg.y * -1.44269504f));
            const float s2 = __builtin_amdgcn_rcpf(1.f + __builtin_amdgcn_exp2f(lg.z * -1.44269504f)), s3 = __builtin_amdgcn_rcpf(1.f + __builtin_amdgcn_exp2f(lg.w * -1.44269504f));
            const int o0 = ford(s0 + bb.x), o1 = ford(s1 + bb.y), o2 = ford(s2 + bb.z), o3 = ford(s3 + bb.w);
            const int e0 = 4 * c.lane, g = c.lane >> 3;
            const int IMIN = (int)0x80000000;
            int gkey;
            {
                const int h01 = imax_(o0, o1), l01 = imin_(o0, o1), h23 = imax_(o2, o3), l23 = imin_(o2, o3);
                const int a1 = imax_(h01, h23), a2 = imax_(imin_(h01, h23), (h01 >= h23) ? l01 : l23);
                const int g1 = grp8_max_i(a1);
                const unsigned long long bm = __ballot(a1 == g1);
                const unsigned grpbits = (unsigned)(bm >> (8 * g)) & 0xffu;
                const bool first = (a1 == g1) && ((grpbits & ((1u << (c.lane & 7)) - 1u)) == 0u);
                const int g2 = grp8_max_i(first ? a2 : a1);
                gkey = (ford(funord(g1) + funord(g2)) & ~7) | (7 - g);
            }
            int rank = 0;
#pragma unroll
            for (int j = 0; j < 8; ++j) rank += (__builtin_amdgcn_readlane(gkey, 8 * j) > gkey) ? 1 : 0;
            const bool sel = rank < 4;
            int k0 = sel ? ((o0 & ~0xff) | (255 - e0)) : IMIN, k1 = sel ? ((o1 & ~0xff) | (254 - e0)) : IMIN, k2 = sel ? ((o2 & ~0xff) | (253 - e0)) : IMIN, k3 = sel ? ((o3 & ~0xff) | (252 - e0)) : IMIN;
            int my_key = 0;
#pragma unroll 1
            for (int rnd = 0; rnd < TOPK; ++rnd) {
                const int mx = wave_max_i(imax_(imax_(k0, k1), imax_(k2, k3)));
                if (c.lane == 8 * rb + rnd) my_key = mx;
                k0 = (k0 == mx) ? IMIN : k0; k1 = (k1 == mx) ? IMIN : k1; k2 = (k2 == mx) ? IMIN : k2; k3 = (k3 == mx) ? IMIN : k3;
            }
            {
                const int ee = 255 - (my_key & 0xff), src = (ee >> 2) * 4;
                const float q0 = __builtin_bit_cast(float, __builtin_amdgcn_ds_bpermute(src, __builtin_bit_cast(int, s0))), q1 = __builtin_bit_cast(float, __builtin_amdgcn_ds_bpermute(src, __builtin_bit_cast(int, s1)));
                const float q2 = __builtin_bit_cast(float, __builtin_amdgcn_ds_bpermute(src, __builtin_bit_cast(int, s2))), q3 = __builtin_bit_cast(float, __builtin_amdgcn_ds_bpermute(src, __builtin_bit_cast(int, s3)));
                if ((c.lane >> 3) == rb) { my_e = ee; my_s = (ee & 2) ? ((ee & 1) ? q3 : q2) : ((ee & 1) ? q1 : q0); }
            }
            ++rb;
          }
          { const int rr = c.lane >> 3, k = c.lane & 7;
            const float tot = grp8_sum(my_s);
            const bool valid = rr < rb; const int id = (mb + rr * c.ngw) * TOPK + k; const float wt = my_s / tot * 2.5f;
            if (!cnt_sort) {
                if (valid) { const unsigned pos = atomicAdd(&CNT[(size_t)my_e * CNT_STRIDE], 1u);
                    LIST[(size_t)my_e * LCAP + pos] = id; POSREC[id] = (my_e << 16) | (int)pos; WTS[id] = wt; }
            } else {
                int lpos = 0; if (valid) lpos = atomicAdd(&histg[my_e], 1);
                __syncthreads();
                if (c.tid < 64) HIST[c.bid * 64 + c.tid] = histg[4 * c.tid] | (histg[4 * c.tid + 1] << 8) | (histg[4 * c.tid + 2] << 16) | (histg[4 * c.tid + 3] << 24);
                xcd_barrier(bar);
                { const int rg = c.tid >> 4, eb = c.tid & 15;
                  uint4 hv[8];
#pragma unroll
                  for (int j = 0; j < 8; ++j) { const int w = rg + 32 * j; hv[j] = make_uint4(0u, 0u, 0u, 0u); if (w < c.bid) hv[j] = *(const uint4*)&HIST[w * 64 + eb * 4]; }
                  int acc[16];
#pragma unroll
                  for (int i = 0; i < 16; ++i) acc[i] = 0;
#pragma unroll
                  for (int j = 0; j < 8; ++j) { const unsigned wd[4] = {hv[j].x, hv[j].y, hv[j].z, hv[j].w};
#pragma unroll
                      for (int q = 0; q < 4; ++q) { acc[4 * q] += (int)(wd[q] & 0xffu); acc[4 * q + 1] += (int)((wd[q] >> 8) & 0xffu); acc[4 * q + 2] += (int)((wd[q] >> 16) & 0xffu); acc[4 * q + 3] += (int)(wd[q] >> 24); } }
#pragma unroll
                  for (int q = 0; q < 4; ++q) *(int4*)&histg[1024 + rg * NE + eb * 16 + 4 * q] = make_int4(acc[4 * q], acc[4 * q + 1], acc[4 * q + 2], acc[4 * q + 3]); }
                __syncthreads();
                if (c.tid < NE) { int bs = 0;
#pragma unroll
                    for (int r = 0; r < 32; ++r) bs += histg[1024 + r * NE + c.tid];
                    histg[768 + c.tid] = bs; if (c.bid == c.nb - 1) HIST[NE * NE + c.tid] = bs + histg[c.tid]; }
                __syncthreads();
                if (valid) { const int pos = histg[768 + my_e] + lpos;
                    LIST[(size_t)my_e * LCAP + pos] = id; POSREC[id] = (my_e << 16) | pos; WTS[id] = wt; }
            } }
        }
    }
    SEAM(8);

    LAS int* pre = (LAS int*)(ldsb + pg8::STAGE_BYTES);
    LAS int* offs = pre + 320; LAS int* cntl = offs + 320;
    if (IN(9) || IN(10) || IN(11)) {
        const Ctx c = mkctx(ws, lds_raw); PHASE_PTRS
        __syncthreads();
        if (c.tid < NE) cntl[c.tid] = ((MK_N_LAUNCHES == 1) && c.nb == NE && 8 * c.ngw == NTOK && lo < 8 && hi > 9) ? ((const int*)(wsp + WS_HIST))[NE * NE + c.tid] : (int)CNT[(size_t)c.tid * CNT_STRIDE];
        __syncthreads();
        if (c.tid <= NE) { int a = 0, o = 0; for (int j = 0; j < c.tid; ++j) { const int q = cntl[j]; a += (q + 255) >> 8; o += q; } pre[c.tid] = a; offs[c.tid] = o; }
        __syncthreads();
    }
    if (IN(9)) for (int rep_ = 0; rep_ < (((REPEAT_MASK >> 9) & 1) ? 2 : 1); ++rep_) {
        const Ctx c = mkctx(ws, lds_raw); PHASE_PTRS
        pg8::MoeOrder S{pre, offs, cntl, LIST, (const char*)WGUT, (size_t)512 * DM * 2, DM, 2, c.nb, vcu, 0};
        pg8::EpiAct E{ACT};
        pg8::gemm_phase<pg8::EpiAct, pg8::MoeOrder, true, true>(ldsb, H2, DM, S, E);
    }
    SEAM(9);

    if (IN(10)) for (int rep_ = 0; rep_ < (((REPEAT_MASK >> 10) & 1) ? 2 : 1); ++rep_) {
        const Ctx c = mkctx(ws, lds_raw); PHASE_PTRS
        { pg8::MoeOrder S{pre, offs, cntl, LIST, (const char*)WDT, (size_t)DM * EFF * 2, EFF, 4, c.nb, vcu, 1};
          pg8::EpiSlots E{(unsigned char*)SLOTS};
          pg8::gemm_phase<pg8::EpiSlots, pg8::MoeOrder, true>(ldsb, ACT, EFF, S, E); }
        { pg8::DenseOrder S; S.init(NTOK, DM, EFF, WDST, c.nb, c.bid); pg8::EpiBf16 E{YSH, DM};
          pg8::gemm_phase<pg8::EpiBf16, pg8::DenseOrder, true>(ldsb, ACTS, EFF, S, E); }
    }
    SEAM(10);

    if (IN(11)) for (int rep_ = 0; rep_ < (((REPEAT_MASK >> 11) & 1) ? 2 : 1); ++rep_) {
        const Ctx c = mkctx(ws, lds_raw); PHASE_PTRS
        const unsigned char* SL8 = (const unsigned char*)SLOTS;
        typedef float f32x2v __attribute__((ext_vector_type(2)));
        for (int m0 = c.gw; m0 < NTOK; m0 += 2 * c.ngw) {
            int srow[2][TOPK]; float swt[2][TOPK];
#pragma unroll
            for (int q = 0; q < 2; ++q)
#pragma unroll
                for (int k = 0; k < TOPK; ++k) { const int m = m0 + q * c.ngw; const int rec = POSREC[(size_t)m * TOPK + k]; srow[q][k] = offs[rec >> 16] + (rec & 0xffff); swt[q][k] = WTS[(size_t)m * TOPK + k] * (1.f / 16.f); }
#pragma unroll
            for (int q = 0; q < 2; ++q) {
                const int m = m0 + q * c.ngw; const int b = m / SEQ; const float* md = mod + b * 6144;
                const int cc = 16 * c.lane;
                float y[16]; float ss = 0.f;
#pragma unroll
                for (int hq = 0; hq < 2; ++hq) { const uint4 u = *(const uint4*)&YSH[(size_t)m * DM + cc + 8 * hq];
                    y[8 * hq + 0] = bf2f(u.x & 0xffffu); y[8 * hq + 1] = bf2f(u.x >> 16); y[8 * hq + 2] = bf2f(u.y & 0xffffu); y[8 * hq + 3] = bf2f(u.y >> 16);
                    y[8 * hq + 4] = bf2f(u.z & 0xffffu); y[8 * hq + 5] = bf2f(u.z >> 16); y[8 * hq + 6] = bf2f(u.w & 0xffffu); y[8 * hq + 7] = bf2f(u.w >> 16); }
#pragma unroll
                for (int k = 0; k < TOPK; ++k) { const uint4 u = *(const uint4*)&SL8[(size_t)srow[q][k] * DM + cc]; const float wk = swt[q][k];
                    const unsigned wds[4] = {u.x, u.y, u.z, u.w};
#pragma unroll
                    for (int d = 0; d < 4; ++d) { const f32x2v a = __builtin_amdgcn_cvt_pk_f32_fp8((int)wds[d], false), bb = __builtin_amdgcn_cvt_pk_f32_fp8((int)wds[d], true);
                        y[4 * d] += wk * a.x; y[4 * d + 1] += wk * a.y; y[4 * d + 2] += wk * bb.x; y[4 * d + 3] += wk * bb.y; } }
#pragma unroll
                for (int i = 0; i < 16; ++i) ss += y[i] * y[i];
                const float rstd = rsqrtf(wave_sum(ss) * (1.f / DM) + EPS);
#pragma unroll
                for (int hq = 0; hq < 4; ++hq) {
                    const int c4 = cc + 4 * hq;
                    const float4 g = *(const float4*)&g_post_ffn[c4], gt = *(const float4*)&md[5120 + c4]; const uint2 xu = *(const uint2*)&X1[(size_t)m * DM + c4];
                    float4 xx; xx.x = bf2f(xu.x & 0xffffu); xx.y = bf2f(xu.x >> 16); xx.z = bf2f(xu.y & 0xffffu); xx.w = bf2f(xu.y >> 16);
                    float4 r; r.x = xx.x + gt.x * (y[4 * hq] * rstd * g.x); r.y = xx.y + gt.y * (y[4 * hq + 1] * rstd * g.y);
                    r.z = xx.z + gt.z * (y[4 * hq + 2] * rstd * g.z); r.w = xx.w + gt.w * (y[4 * hq + 3] * rstd * g.w);
                    *(float4*)&args.out[(size_t)m * DM + c4] = r;
                }
            }
        }
    }
    }
#undef IN
#undef SEAM
}

constexpr int NPHASE = 12;

extern "C" void kernel_launch(void* const* d_in, const int* in_sizes, int n_in, void* d_out, int out_size, void* d_ws, size_t ws_size, hipStream_t stream) {
    static int grid = 0;
    if (grid == 0) {
        if (n_in != 26 || out_size != NTOK * DM || ws_size < WS_END) { fprintf(stderr, "kernel_launch: unexpected shapes (n_in %d, out %d, ws %zu)\n", n_in, out_size, ws_size); grid = -1; return; }
        int dev = 0, cus = 0, per_cu = 0;
        if (hipGetDevice(&dev) != hipSuccess || hipDeviceGetAttribute(&cus, hipDeviceAttributeMultiprocessorCount, dev) != hipSuccess) { grid = -1; return; }
        if (hipFuncSetAttribute((const void*)mega, hipFuncAttributeMaxDynamicSharedMemorySize, LDS_BYTES) != hipSuccess) { fprintf(stderr, "kernel_launch: hipFuncSetAttribute failed\n"); grid = -1; return; }
        if (hipOccupancyMaxActiveBlocksPerMultiprocessor(&per_cu, (const void*)mega, NTHR, LDS_BYTES) != hipSuccess || per_cu < 1) fprintf(stderr, "kernel_launch: occupancy query says %d\n", per_cu);
        (void)hipGetLastError();
        grid = cus;
    }
    if (grid < 0) return;
    (void)hipMemsetAsync((char*)d_ws + WS_CTL, 0, CTL_ZERO_BYTES, stream);
    Args a{};
    for (int i = 0; i < 26; ++i) a.in[i] = (const float*)d_in[i];
    a.out = (float*)d_out; a.ws = (unsigned char*)d_ws;
    if (MK_N_LAUNCHES == 1) { a.ph_lo = 0; a.ph_hi = NPHASE; hipLaunchKernelGGL(mega, dim3(grid), dim3(NTHR), LDS_BYTES, stream, a); }
    else for (int p = 0; p < NPHASE; ++p) { a.ph_lo = p; a.ph_hi = p + 1; hipLaunchKernelGGL(mega, dim3(grid), dim3(NTHR), LDS_BYTES, stream, a); }
}
```

```cpp
#include <hip/hip_runtime.h>
#include <cstdio>
#include <cstdint>

#ifndef REP_FROM
#define REP_FROM 99
#endif
#ifndef REPEAT_MASK
#define REPEAT_MASK 0
#endif
#ifndef CONV_MODE
#define CONV_MODE 5
#endif
#ifndef MK_N_LAUNCHES
#define MK_N_LAUNCHES 1
#endif

#ifndef ATTN_NAIVE
#define ATTN_NAIVE 0
#endif
#define LAS __attribute__((address_space(3)))
typedef unsigned short bf16_t;

constexpr int NB = 2, SEQ = 8192, NTOK = NB * SEQ, DM = 1024;
constexpr int QLORA = 256, KVLORA = 128, MROPE = 32, MNOPE = 64, MV = 64, MH = 8, DQKM = 96;
constexpr int GH = 8, GKV = 2, GD = 64;
constexpr int INC = 1184;
constexpr int C_QLAT = 0, C_KVLAT = 256, C_KROPE = 384, C_GQ = 416, C_GK = 928, C_GV = 1056;
constexpr int NE = 256, TOPK = 8, EFF = 256;
constexpr int LCAP = 16384;
constexpr float EPS = 1e-6f;
constexpr float LOG2E = 1.4426950408889634f;
constexpr float C2M = 0.10206207261596575f * LOG2E;
constexpr float C2G = 0.125f * LOG2E;

constexpr size_t MiB = 1u << 20;
constexpr size_t WS_CTL = 0, CTL_ZERO_BYTES = 32768;
constexpr size_t WS_MOD = 1 * MiB;
constexpr size_t WS_COSM = 2 * MiB, WS_SINM = 2 * MiB + 512 * 1024, WS_COSG = 3 * MiB, WS_SING = 4 * MiB;
constexpr size_t WS_WQBT = 5 * MiB;
constexpr size_t WS_WINQ = 5 * MiB + 512 * 1024;
constexpr size_t WS_WKVBT = 6 * MiB;
constexpr size_t WS_WINKV = 6 * MiB + 512 * 1024;
constexpr size_t WS_WDST = 7 * MiB;
constexpr size_t WS_COEF = 7 * MiB + 512 * 1024;
constexpr size_t WS_H2 = 8 * MiB;
constexpr size_t WS_X1 = 40 * MiB;
constexpr size_t WS_CNTS = 72 * MiB;
constexpr int CNT_STRIDE = 1088;
constexpr size_t WS_HIST = 82 * MiB;
constexpr size_t WS_WTS = 104 * MiB;
constexpr size_t WS_OSTAT = 252 * MiB;
constexpr size_t WS_POSREC = 105 * MiB;
constexpr size_t WS_LIST = 106 * MiB;
constexpr size_t WS_WBIGT = 122 * MiB;
constexpr size_t WS_WOUTT = 128 * MiB;
constexpr size_t WS_WRST = 130 * MiB;
constexpr size_t WS_ACT = 132 * MiB;
constexpr size_t WS_LOG = 196 * MiB;
constexpr size_t WS_ACTS = 212 * MiB;
constexpr size_t WS_YSH = 220 * MiB;
constexpr size_t WS_SLOTS = 256 * MiB;
constexpr size_t WS_PBUF = 256 * MiB;
constexpr size_t WS_QM = 352 * MiB, WS_KM = 376 * MiB, WS_VM = 400 * MiB, WS_QG = 416 * MiB, WS_KG = 432 * MiB, WS_VG = 436 * MiB;
constexpr size_t WS_O = 440 * MiB;
constexpr size_t WS_MIXED = 472 * MiB;
constexpr size_t WS_WGUT = 512 * MiB;
constexpr size_t WS_WDT = 768 * MiB;
constexpr size_t WS_END = 896 * MiB;
constexpr size_t WS_HF = 512 * MiB, WS_PROJ = 576 * MiB, WS_H2F = 650 * MiB, WS_GS = 714 * MiB, WS_US = 730 * MiB, WS_ACTSF = 746 * MiB, WS_YSHF = 768 * MiB, WS_LOGF = 832 * MiB;
constexpr int CW_CNT = 1024;
constexpr int CW_KMAX = 2048;
constexpr int CW_BAR = 4096;

constexpr int LDS_BYTES = 147456;
constexpr int NTHR = 512, NWAVES = 8;

#define XB_TMO      128
#define XB_XCNT(j)  (256  + 64 * (j))
#define XB_XSUB(j)  (1280 + 64 * (j))
#define XB_XGEN(j)  (2304 + 64 * (j))
#define XB_TOP      3328
#define XB_TOPGEN   3392
#define XCD_BAR_WORDS 3456
#define XB_SPIN_CAP (1u << 18)
__device__ __forceinline__ unsigned xb_ld(unsigned* p)              { return __hip_atomic_load(p, __ATOMIC_RELAXED, __HIP_MEMORY_SCOPE_AGENT); }
__device__ __forceinline__ unsigned xb_add(unsigned* p, unsigned v) { return __hip_atomic_fetch_add(p, v, __ATOMIC_RELAXED, __HIP_MEMORY_SCOPE_AGENT); }
__device__ __forceinline__ unsigned xb_xcc_id() { return (unsigned)__builtin_amdgcn_s_getreg((3 << 11) | 20) & 0xFu; }
#define XB_SPIN(cond, bar) do { unsigned _sp = 0; while (cond) { __builtin_amdgcn_s_sleep(1); \
    if ((++_sp & 255u) == 0u) { if (xb_ld(&(bar)[XB_TMO])) break; if (_sp > XB_SPIN_CAP) { atomicAdd(&(bar)[XB_TMO], 1u); break; } } } } while (0)
struct XcdBarrier { unsigned* bar; unsigned x; volatile LAS unsigned* st; };
__device__ __forceinline__ XcdBarrier xcd_barrier_post(unsigned* bar, volatile LAS unsigned* st) {
    XcdBarrier b; b.bar = bar; b.x = xb_xcc_id(); b.st = st;
    if (threadIdx.x == 0) (void)xb_add(&bar[XB_XCNT(b.x)], 1u);
    return b;
}
__device__ __forceinline__ void xcd_barrier_complete(unsigned* bar, unsigned x, unsigned& nloc, unsigned& nx) {
    const unsigned G = gridDim.x * gridDim.y * gridDim.z;
    unsigned sum, cnt, mine, sp = 0u;
    for (;;) {
        sum = 0u; cnt = 0u; mine = 0u;
#pragma unroll
        for (unsigned j = 0; j < 16; ++j) { const unsigned c = xb_ld(&bar[XB_XCNT(j)]); sum += c; cnt += (c > 0u) ? 1u : 0u; mine = (j == x) ? c : mine; }
        if (sum == G) break;
        __builtin_amdgcn_s_sleep(1);
        if ((++sp & 255u) == 0u) { if (xb_ld(&bar[XB_TMO])) break; if (sp > XB_SPIN_CAP) { atomicAdd(&bar[XB_TMO], 1u); break; } }
    }
    nloc = mine > 0u ? mine : 1u; nx = cnt > 0u ? cnt : 1u;
}
__device__ __forceinline__ void xcd_barrier(const XcdBarrier& b) {
    asm volatile("s_waitcnt vmcnt(0)" ::: "memory");
    __syncthreads();
    if (threadIdx.x == 0) {
        unsigned* bar = b.bar;
        __builtin_amdgcn_s_waitcnt(0);
        unsigned nloc = b.st[0], nx = b.st[1];
        if (nloc == 0u) { xcd_barrier_complete(bar, b.x, nloc, nx); b.st[0] = nloc; b.st[1] = nx; }
        const unsigned old = xb_add(&bar[XB_XSUB(b.x)], 1u);
        const unsigned gen = old / nloc;
        if (old + 1u == (gen + 1u) * nloc) {
            __builtin_amdgcn_fence(__ATOMIC_RELEASE, "agent");
            asm volatile("s_waitcnt vmcnt(0)" ::: "memory");
            const unsigned og = xb_add(&bar[XB_TOP], 1u);
            const unsigned tg = og / nx;
            if (og + 1u == (tg + 1u) * nx) xb_add(&bar[XB_TOPGEN], 1u);
            else XB_SPIN(xb_ld(&bar[XB_TOPGEN]) == tg, bar);
            __builtin_amdgcn_fence(__ATOMIC_ACQUIRE, "agent");
            xb_add(&bar[XB_XGEN(b.x)], 1u);
            asm volatile("s_waitcnt vmcnt(0)" ::: "memory");
        } else {
            XB_SPIN(xb_ld(&bar[XB_XGEN(b.x)]) == gen, bar);
            __builtin_amdgcn_fence(__ATOMIC_ACQUIRE, "agent");
            asm volatile("s_waitcnt vmcnt(0)" ::: "memory");
        }
    }
    __syncthreads();
}

__device__ __forceinline__ unsigned f2bf(float f) { unsigned u = __builtin_bit_cast(unsigned, f); return (u + 0x7fffu + ((u >> 16) & 1u)) >> 16; }
__device__ __forceinline__ float bf2f(unsigned h) { return __builtin_bit_cast(float, h << 16); }
__device__ __forceinline__ unsigned pk2(float lo, float hi) { return f2bf(lo) | (f2bf(hi) << 16); }
template <int CTRL, int RM> __device__ __forceinline__ float dppmov(float old, float v) {
    return __builtin_bit_cast(float, __builtin_amdgcn_update_dpp(__builtin_bit_cast(int, old), __builtin_bit_cast(int, v), CTRL, RM, 0xF, false)); }
__device__ __forceinline__ float wave_sum(float v) {
    v += dppmov<0xB1, 0xF>(0.f, v);
    v += dppmov<0x4E, 0xF>(0.f, v);
    v += dppmov<0x141, 0xF>(0.f, v);
    v += dppmov<0x140, 0xF>(0.f, v);
    v += dppmov<0x142, 0xA>(0.f, v);
    v += dppmov<0x143, 0xC>(0.f, v);
    return __builtin_bit_cast(float, __builtin_amdgcn_readlane(__builtin_bit_cast(int, v), 63));
}
__device__ __forceinline__ float wave_max(float v) {
    const float NI = -INFINITY;
    v = fmaxf(v, dppmov<0xB1, 0xF>(NI, v)); v = fmaxf(v, dppmov<0x4E, 0xF>(NI, v)); v = fmaxf(v, dppmov<0x141, 0xF>(NI, v)); v = fmaxf(v, dppmov<0x140, 0xF>(NI, v));
    v = fmaxf(v, dppmov<0x142, 0xA>(NI, v)); v = fmaxf(v, dppmov<0x143, 0xC>(NI, v));
    return __builtin_bit_cast(float, __builtin_amdgcn_readlane(__builtin_bit_cast(int, v), 63));
}
template <int CTRL, int RM> __device__ __forceinline__ int dppmovi(int old, int v) { return __builtin_amdgcn_update_dpp(old, v, CTRL, RM, 0xF, false); }
__device__ __forceinline__ int imax_(int a, int b) { return a > b ? a : b; }
__device__ __forceinline__ int imin_(int a, int b) { return a < b ? a : b; }
__device__ __forceinline__ int wave_max_i(int v) {
    const int NI = (int)0x80000000;
    v = imax_(v, dppmovi<0xB1, 0xF>(NI, v)); v = imax_(v, dppmovi<0x4E, 0xF>(NI, v)); v = imax_(v, dppmovi<0x141, 0xF>(NI, v)); v = imax_(v, dppmovi<0x140, 0xF>(NI, v));
    v = imax_(v, dppmovi<0x142, 0xA>(NI, v)); v = imax_(v, dppmovi<0x143, 0xC>(NI, v));
    return __builtin_amdgcn_readlane(v, 63);
}
__device__ __forceinline__ int grp8_max_i(int v) {
    const int NI = (int)0x80000000;
    v = imax_(v, dppmovi<0xB1, 0xF>(NI, v)); v = imax_(v, dppmovi<0x4E, 0xF>(NI, v)); v = imax_(v, dppmovi<0x141, 0xF>(NI, v)); return v;
}
__device__ __forceinline__ int ford(float f) { const int b = __builtin_bit_cast(int, f); return b ^ ((b >> 31) & 0x7fffffff); }
__device__ __forceinline__ float funord(int k) { return __builtin_bit_cast(float, k ^ ((k >> 31) & 0x7fffffff)); }
__device__ __forceinline__ float grp8_sum(float v) {
    v += dppmov<0xB1, 0xF>(0.f, v); v += dppmov<0x4E, 0xF>(0.f, v); v += dppmov<0x141, 0xF>(0.f, v); return v;
}
__device__ __forceinline__ float grp8_max(float v) {
    const float NI = -INFINITY;
    v = fmaxf(v, dppmov<0xB1, 0xF>(NI, v)); v = fmaxf(v, dppmov<0x4E, 0xF>(NI, v)); v = fmaxf(v, dppmov<0x141, 0xF>(NI, v)); return v;
}
__device__ __forceinline__ float sigmoidf_(float x) { return 1.f / (1.f + __expf(-x)); }

struct Args { const float* in[26]; float* out; unsigned char* ws; int ph_lo, ph_hi; };

struct Ctx {
    int tid, lane, wave, bid, nb, gw, ngw;
    unsigned char* ws; float* lds;
};
__device__ __forceinline__ Ctx mkctx(unsigned char* ws, unsigned char* lds_raw) {
    Ctx c; int t = threadIdx.x; asm volatile("" : "+v"(t));
    c.tid = t; c.lane = t & 63; c.wave = __builtin_amdgcn_readfirstlane(t >> 6);
    c.bid = blockIdx.x; c.nb = gridDim.x; c.gw = c.bid * NWAVES + c.wave; c.ngw = c.nb * NWAVES; c.ws = ws; c.lds = (float*)lds_raw; return c;
}

namespace att {
using bf16x8 = __attribute__((ext_vector_type(8))) short;
using s16x4 = __attribute__((ext_vector_type(4))) short;
using f32x16 = __attribute__((ext_vector_type(16))) float;
using u32x4 = __attribute__((ext_vector_type(4))) unsigned;
typedef float f32x2_t __attribute__((ext_vector_type(2))); typedef __bf16 bf16x2_t __attribute__((ext_vector_type(2)));
typedef __attribute__((address_space(3))) const char* lds_cptr;
typedef short v4i16_t __attribute__((ext_vector_type(4)));
constexpr int NT = SEQ / 64;
constexpr int KSLOT = 12288, VSLOT = 8192, NSLOT = 3;
constexpr int LDS_K = 0, LDS_V = NSLOT * KSLOT, LDS_WS = LDS_V + NSLOT * VSLOT, LDS_OST = LDS_WS + NWAVES * 256, LDS_ATT = LDS_OST + NWAVES * 4096;
#define SBAR() __builtin_amdgcn_sched_barrier(0)
#define MFMA(a, b, c) __builtin_amdgcn_mfma_f32_32x32x16_bf16(a, b, c, 0, 0, 0)
__device__ __forceinline__ int crow(int r, int hi) { return (r & 3) + 8 * (r >> 2) + 4 * hi; }
__device__ __forceinline__ unsigned cvtpk_s(float lo, float hi) { f32x2_t v = {lo, hi}; bf16x2_t b = __builtin_convertvector(v, bf16x2_t); return __builtin_bit_cast(unsigned, b); }
__device__ __forceinline__ void glds16(const void* g, unsigned lds_base) {
    unsigned sv; asm volatile("s_mov_b32 %0, m0\n\ts_mov_b32 m0, %2\n\ts_nop 0\n\tglobal_load_lds_dwordx4 %1, off\n\ts_mov_b32 m0, %0" : "=&s"(sv) : "v"(g), "s"(lds_base) : "memory"); }
__device__ __forceinline__ s16x4 vtr(lds_cptr p) { return __builtin_bit_cast(s16x4, __builtin_amdgcn_ds_read_tr16_b64_v4i16((__attribute__((address_space(3))) v4i16_t*)p)); }
#define MX3(a, b, c) __builtin_fmaxf(__builtin_fmaxf((a), (b)), (c))
__device__ __forceinline__ float rowmax(const f32x16& p0, const f32x16& p1) {
    float a = MX3(p0[0], p0[1], p1[0]), b = MX3(p0[2], p0[3], p1[1]); a = MX3(a, p1[2], p1[3]);
#pragma unroll
    for (int r = 4; r < 16; r += 4) { a = MX3(a, p0[r], p0[r + 1]); b = MX3(b, p0[r + 2], p0[r + 3]); a = MX3(a, p1[r], p1[r + 1]); b = MX3(b, p1[r + 2], p1[r + 3]); }
    float m = __builtin_fmaxf(a, b); auto rr = __builtin_amdgcn_permlane32_swap(__float_as_uint(m), __float_as_uint(m), false, false);
    return __builtin_fmaxf(__uint_as_float(rr[0]), __uint_as_float(rr[1])); }

template <int DQK>
__device__ __forceinline__ void unit_simple(const bf16_t* Qh, const bf16_t* __restrict__ Kh, const bf16_t* __restrict__ Vh, bf16_t* Ob, int q0, char* shm) {
    constexpr int NCH = DQK / 8, ND0 = DQK / 16;
    int tid_ = threadIdx.x; asm volatile("" : "+v"(tid_));
    const int tid = tid_, lane = tid & 63, r32 = lane & 31, hi = lane >> 5; const int wid = __builtin_amdgcn_readfirstlane(tid >> 6);
    const bf16_t* Qw = Qh + (size_t)(q0 + wid * 32) * DQK;
    const unsigned lds0 = (unsigned)(uintptr_t)shm; float* wsf = (float*)(shm + LDS_WS) + wid * 64;
    const bf16_t* ksrc0 = Kh + (size_t)lane * DQK + wid * 8;
    const bf16_t* ksrc1 = Kh + (size_t)lane * DQK + (8 + (wid & 3)) * 8;
    const bf16_t* vsrc = Vh + (size_t)(16 * (wid & 3) + (lane >> 2)) * 64 + (wid >> 2) * 32 + (lane & 3) * 8;
    const unsigned kdst0 = lds0 + LDS_K + wid * 1024, kdst1 = lds0 + LDS_K + (8 + (wid & 3)) * 1024, vdst = lds0 + LDS_V + wid * 1024;
#define DMA_KV(t, sl) do { glds16(ksrc0 + (size_t)(t) * 64 * DQK, (unsigned)__builtin_amdgcn_readfirstlane(kdst0 + (sl) * KSLOT)); \
        if (NCH == 12 && wid < 4) glds16(ksrc1 + (size_t)(t) * 64 * DQK, (unsigned)__builtin_amdgcn_readfirstlane(kdst1 + (sl) * KSLOT)); \
        glds16(vsrc + (size_t)(t) * 64 * 64, (unsigned)__builtin_amdgcn_readfirstlane(vdst + (sl) * VSLOT)); } while (0)
    const lds_cptr shm3 = (lds_cptr)shm;
    const lds_cptr vp0 = shm3 + LDS_V + ((lane >> 4) & 1) * 32 + (lane & 3) * 8 + (4 * hi + ((lane & 15) >> 2)) * 64;
    const lds_cptr kp0 = shm3 + LDS_K + hi * 1024 + r32 * 16;
    DMA_KV(0, 0);
    bf16x8 qr[ND0];
#pragma unroll
    for (int d0 = 0; d0 < ND0; ++d0) qr[d0] = *reinterpret_cast<const bf16x8*>(&Qw[(size_t)r32 * DQK + d0 * 16 + hi * 8]);
    float mhat = -INFINITY, l_reg = 0.f; f32x16 o[2]; o[0] = f32x16{}; o[1] = f32x16{};
    asm volatile("s_waitcnt vmcnt(0) lgkmcnt(0)\n\ts_barrier" ::: "memory");
    for (int t = 0; t < NT; ++t) {
        const int sl = t & 1;
        if (t + 1 < NT) DMA_KV(t + 1, sl ^ 1);
        f32x16 p0 = f32x16{}, p1 = f32x16{};
        const lds_cptr kp = kp0 + sl * KSLOT;
#pragma unroll
        for (int d0 = 0; d0 < ND0; ++d0) {
            const bf16x8 b0 = *(const __attribute__((address_space(3))) bf16x8*)(kp + d0 * 2048);
            const bf16x8 b1 = *(const __attribute__((address_space(3))) bf16x8*)(kp + d0 * 2048 + 512);
            p0 = MFMA(b0, qr[d0], p0); p1 = MFMA(b1, qr[d0], p1);
        }
        const float rm = rowmax(p0, p1);
        const float mn = __builtin_fmaxf(mhat, rm), f = __builtin_amdgcn_exp2f(mhat - mn); mhat = mn;
        float sacc = 0.f;
#pragma unroll
        for (int r = 0; r < 16; ++r) { p0[r] = __builtin_amdgcn_exp2f(p0[r] - mn); p1[r] = __builtin_amdgcn_exp2f(p1[r] - mn); sacc += p0[r] + p1[r]; }
        l_reg = l_reg * f + sacc;
        if (hi == 0) wsf[r32] = f;
        asm volatile("s_waitcnt lgkmcnt(0)" ::: "memory");
#pragma unroll
        for (int d_ = 0; d_ < 2; ++d_)
#pragma unroll
            for (int r = 0; r < 16; ++r) o[d_][r] *= wsf[crow(r, hi)];
        u32x4 pw[4];
#pragma unroll
        for (int i = 0; i < 4; ++i) { pw[0][i] = cvtpk_s(p0[2 * i], p0[2 * i + 1]); pw[1][i] = cvtpk_s(p0[8 + 2 * i], p0[8 + 2 * i + 1]); pw[2][i] = cvtpk_s(p1[2 * i], p1[2 * i + 1]); pw[3][i] = cvtpk_s(p1[8 + 2 * i], p1[8 + 2 * i + 1]); }
        const lds_cptr vp_ = vp0 + sl * VSLOT;
#pragma unroll
        for (int d0 = 0; d0 < 2; ++d0)
#pragma unroll
            for (int ks = 0; ks < 4; ++ks) {
                const s16x4 lo = vtr(vp_ + d0 * 4096 + ks * 1024), hh = vtr(vp_ + d0 * 4096 + ks * 1024 + 512);
                const bf16x8 vf = (bf16x8){lo[0], lo[1], lo[2], lo[3], hh[0], hh[1], hh[2], hh[3]};
                o[d0] = MFMA(__builtin_bit_cast(bf16x8, pw[ks]), vf, o[d0]);
            }
        asm volatile("s_waitcnt vmcnt(0) lgkmcnt(0)\n\ts_barrier" ::: "memory");
    }
#undef DMA_KV
    { auto rr = __builtin_amdgcn_permlane32_swap(__float_as_uint(l_reg), __float_as_uint(l_reg), false, false); l_reg = __uint_as_float(rr[0]) + __uint_as_float(rr[1]); }
    if (hi == 0) wsf[32 + r32] = l_reg; asm volatile("s_waitcnt lgkmcnt(0)" ::: "memory");
    float rli[16];
#pragma unroll
    for (int r = 0; r < 16; ++r) rli[r] = __builtin_amdgcn_rcpf(wsf[32 + crow(r, hi)]);
    bf16_t* Ow = Ob + (size_t)(wid * 32) * DM; bf16_t* stg = (bf16_t*)(shm + LDS_OST) + wid * 2048;
#pragma unroll
    for (int r = 0; r < 16; ++r) { const int orow = crow(r, hi);
#pragma unroll
        for (int d0 = 0; d0 < 2; ++d0) stg[orow * 64 + d0 * 32 + r32] = (bf16_t)f2bf(o[d0][r] * rli[r]); }
    asm volatile("s_waitcnt lgkmcnt(0)" ::: "memory");
#pragma unroll
    for (int i = 0; i < 4; ++i) { const int row = i * 8 + (lane >> 3), ch = lane & 7; *(u32x4*)(Ow + (size_t)row * DM + ch * 8) = *(const u32x4*)(stg + row * 64 + ch * 8); }
    asm volatile("s_waitcnt vmcnt(0) lgkmcnt(0)\n\ts_barrier" ::: "memory");
}

constexpr int CONV_LDS = 112640;
struct ConvState { int cj, jbase; const char* wg; const char* wu; const char* wd; char* dgu; char* dd; unsigned ldsbuf; lds_cptr rdbuf; };
struct ConvJob { const char* sbase; char* dbase; unsigned ldwB, KdB; };
__device__ __forceinline__ ConvJob conv_job(const ConvState& cs, int j) {
    const int J = (CONV_MODE >= 5) ? j : cs.jbase + (j < 383 ? j : 383); const int m = J >> 10, r = J & 1023; ConvJob q;
    if (m < 2) { const int g = r >> 7, kg = r & 127; const int drow0 = ((g < 4) ? g * 32 : 256 + (g - 4) * 32) + m * 128;
        q.sbase = (m ? cs.wu : cs.wg) + (size_t)((8 * kg) * EFF + g * 32) * 4; q.ldwB = EFF * 4; q.dbase = cs.dgu + (size_t)(drow0 * DM + 8 * kg) * 2; q.KdB = DM * 2; }
    else { const int g = r >> 5, kg = r & 31;
        q.sbase = cs.wd + (size_t)((8 * kg) * DM + g * 32) * 4; q.ldwB = DM * 4; q.dbase = cs.dd + (size_t)((g * 32) * EFF + 8 * kg) * 2; q.KdB = EFF * 2; }
    return q;
}
__device__ __forceinline__ void glds16_s(const char* sbase, unsigned voff, unsigned lds_base) {
    unsigned sv; asm volatile("s_mov_b32 %0, m0\n\ts_mov_b32 m0, %3\n\ts_nop 4\n\tglobal_load_lds_dwordx4 %1, %2\n\ts_mov_b32 m0, %0" : "=&s"(sv) : "v"(voff), "s"(sbase), "s"(lds_base) : "memory"); }
#if CONV_MODE == 1 || CONV_MODE == 3 || CONV_MODE == 4 || CONV_MODE >= 5
#define CONV_DRAIN() do { const int jd_ = cs.cj - 3; const ConvJob q_ = conv_job(cs, jd_); \
        const __attribute__((address_space(3))) float* bp_ = (const __attribute__((address_space(3))) float*)(cs.rdbuf + (jd_ & 3) * 1024) + (lane >> 5) * 128 + (lane & 31); \
        uint2 w_; w_.x = cvtpk_s(bp_[0], bp_[32]); w_.y = cvtpk_s(bp_[64], bp_[96]); \
        if (CONV_MODE == 1) *(uint2*)(q_.dbase + (size_t)((unsigned)(lane & 31) * q_.KdB + (unsigned)(lane >> 5) * 8u)) = w_; \
        else if (CONV_MODE == 4) *(uint2*)(cs.dgu + 0x30000000ull + (size_t)((unsigned)(lane & 31) * 2048u + (unsigned)(lane >> 5) * 8u + (unsigned)(jd_ & 127) * 16u)) = w_; \
        else asm volatile("" :: "v"(w_)); } while (0)
#else
#define CONV_DRAIN() do { } while (0)
#endif
#if CONV_MODE >= 5
#undef CONV_DRAIN
#define CONV_NSTEP 384
#define CONV_DRAIN() do { if (CONV_MODE == 5 && rst && cs.cj >= 3 && cs.cj < CONV_NSTEP + 3) { const int jb_ = 8 * (cs.cj - 3) + 4 * (wid - 6); const ConvJob q_ = conv_job(cs, jb_); \
          \
        const __attribute__((address_space(3))) float* bp_ = (const __attribute__((address_space(3))) float*)(cs.rdbuf + (jb_ & 31) * 1024) + (lane >> 5) * 512 + (lane & 31); \
        float v_[16]; \
        _Pragma("unroll") for (int i_ = 0; i_ < 16; ++i_) v_[i_] = bp_[i_ * 32]; \
        char* dp_ = q_.dbase + (size_t)((unsigned)(lane & 31) * q_.KdB + (unsigned)(lane >> 5) * 32u); \
        _Pragma("unroll") for (int i_ = 0; i_ < 2; ++i_) { uint4 w_; w_.x = cvtpk_s(v_[8 * i_], v_[8 * i_ + 1]); w_.y = cvtpk_s(v_[8 * i_ + 2], v_[8 * i_ + 3]); \
            w_.z = cvtpk_s(v_[8 * i_ + 4], v_[8 * i_ + 5]); w_.w = cvtpk_s(v_[8 * i_ + 6], v_[8 * i_ + 7]); *(uint4*)(dp_ + 16 * i_) = w_; } } } while (0)
#define CONV_ISSUE() do { if (CONV_MODE != 6 && rcl && cs.cj < CONV_NSTEP) { const int jb_ = 8 * cs.cj + 4 * (wid - 4); const ConvJob q_ = conv_job(cs, jb_); \
        const unsigned vo_ = (unsigned)(lane >> 3) * q_.ldwB + (unsigned)(lane & 7) * 16u; const unsigned lb_ = (unsigned)__builtin_amdgcn_readfirstlane(cs.ldsbuf + (jb_ & 31) * 1024); \
        glds16_s(q_.sbase, vo_, lb_); glds16_s(q_.sbase + (size_t)8 * q_.ldwB, vo_, lb_ + 1024); glds16_s(q_.sbase + (size_t)16 * q_.ldwB, vo_, lb_ + 2048); glds16_s(q_.sbase + (size_t)24 * q_.ldwB, vo_, lb_ + 3072); } \
        ++cs.cj; } while (0)
#define WAIT_BARL() asm volatile("s_waitcnt lgkmcnt(0)\n\ts_barrier" ::: "memory")
#define RWAIT(N) do { if (rkv) { WAIT_BAR(N); } else if (rcl) { WAIT_BAR(8); } else { WAIT_BARL(); } } while (0)
#elif CONV_MODE != 0
#define CONV_ISSUE() do { const ConvJob q_ = conv_job(cs, cs.cj); \
        glds16_s(q_.sbase, (unsigned)(lane >> 3) * q_.ldwB + (unsigned)(lane & 7) * 16u, (unsigned)__builtin_amdgcn_readfirstlane(cs.ldsbuf + (cs.cj & 3) * 1024)); ++cs.cj; } while (0)
#define WB_P() WAIT_BAR(3)
#define WB_S() WAIT_BAR(4)
#define WB_E1() WAIT_BAR(3)
#define WB_E0() WAIT_BAR(1)
#define WB_PL() WAIT_BAR(4)
#define WB_SL() WAIT_BAR(5)
#else
#define CONV_ISSUE() do { } while (0)
#define WB_P() WAIT_BAR(2)
#define WB_S() WAIT_BAR(2)
#define WB_E1() WAIT_BAR(1)
#define WB_E0() WAIT_BAR(0)
#define WB_PL() WAIT_BAR(3)
#define WB_SL() WAIT_BAR(3)
#endif

constexpr int T_SLOTB = 8192, T_LDS_K = 0, T_LDS_V = 3 * T_SLOTB, T_LDS_WS = 6 * T_SLOTB, T_LDS_OST = T_LDS_WS + NWAVES * 256;
#define WAIT_BAR(N) asm volatile("s_waitcnt vmcnt(" #N ") lgkmcnt(0)\n\ts_barrier" ::: "memory")
__device__ __forceinline__ float max3f(float a, float b, float c) { float r; asm("v_max3_f32 %0, %1, %2, %3" : "=v"(r) : "v"(a), "v"(b), "v"(c)); return r; }
__device__ __forceinline__ float max2f(float a, float b) { float r; asm("v_max_f32_e32 %0, %1, %2" : "=v"(r) : "v"(a), "v"(b)); return r; }
__device__ __forceinline__ float fadd_s(float a, float b) { float r; asm("v_add_f32_e32 %0, %1, %2" : "=v"(r) : "v"(a), "v"(b)); return r; }
__device__ __forceinline__ float fsub_s(float a, float b) { float r; asm("v_sub_f32_e32 %0, %1, %2" : "=v"(r) : "v"(a), "v"(b)); return r; }
__device__ __forceinline__ float rowmax_asm(const f32x16& p0, const f32x16& p1) {
    float a = max3f(p0[0], p0[1], p1[0]), b = max3f(p0[2], p0[3], p1[1]); a = max3f(a, p1[2], p1[3]);
#pragma unroll
    for (int r = 4; r < 16; r += 4) { a = max3f(a, p0[r], p0[r + 1]); b = max3f(b, p0[r + 2], p0[r + 3]); a = max3f(a, p1[r], p1[r + 1]); b = max3f(b, p1[r + 2], p1[r + 3]); }
    const float m = max2f(a, b);
    auto rr = __builtin_amdgcn_permlane32_swap(__float_as_uint(m), __float_as_uint(m), false, false);
    return max2f(__uint_as_float(rr[0]), __uint_as_float(rr[1]));
}
__device__ __forceinline__ void kload8(bf16x8* kf, lds_cptr kp) {
    kf[0] = *(const __attribute__((address_space(3))) bf16x8*)(kp);        kf[1] = *(const __attribute__((address_space(3))) bf16x8*)(kp + 512);
    kf[2] = *(const __attribute__((address_space(3))) bf16x8*)(kp + 2048); kf[3] = *(const __attribute__((address_space(3))) bf16x8*)(kp + 2560);
    kf[4] = *(const __attribute__((address_space(3))) bf16x8*)(kp + 4096); kf[5] = *(const __attribute__((address_space(3))) bf16x8*)(kp + 4608);
    kf[6] = *(const __attribute__((address_space(3))) bf16x8*)(kp + 6144); kf[7] = *(const __attribute__((address_space(3))) bf16x8*)(kp + 6656);
}
__device__ __forceinline__ void kload2(bf16x8* kf, lds_cptr kp, int j) { kf[2 * j] = *(const __attribute__((address_space(3))) bf16x8*)(kp + j * 2048); kf[2 * j + 1] = *(const __attribute__((address_space(3))) bf16x8*)(kp + j * 2048 + 512); }

template <int THRL>
__device__ __forceinline__ void unit64(const bf16_t* Qh, const bf16_t* __restrict__ Kh, const bf16_t* __restrict__ Vh, bf16_t* Ob, float* ostat, int q0, char* shm, ConvState& cs, float mfix) {
    constexpr int DQ = 64;
    int tid_ = threadIdx.x; asm volatile("" : "+v"(tid_));
    const int tid = tid_, lane = tid & 63, r32 = lane & 31, hi = lane >> 5; const int wid = __builtin_amdgcn_readfirstlane(tid >> 6);
    const bf16_t* Qw = Qh + (size_t)(q0 + wid * 32) * DQ;
    const unsigned lds0 = (unsigned)(uintptr_t)shm;
    float* wsf = (float*)(shm + T_LDS_WS) + wid * 64;
#if CONV_MODE >= 5
    const bool rkv = wid < 4, rcl = (wid == 4 || wid == 5), rst = wid >= 6; const int pw = wid & 3;
    const bf16_t* ksrc = Kh + (size_t)lane * DQ + pw * 8;
    const bf16_t* vsrc = Vh + (size_t)(16 * pw + (lane >> 2)) * 64 + (lane & 3) * 8;
    const unsigned kdst = lds0 + T_LDS_K + pw * 1024, vdst = lds0 + T_LDS_V + pw * 1024;
#define DMA_K(t, slot) do { if (rkv) { glds16(ksrc + (size_t)(t) * 64 * DQ, (unsigned)__builtin_amdgcn_readfirstlane(kdst + (slot))); \
        glds16(ksrc + 32 + (size_t)(t) * 64 * DQ, (unsigned)__builtin_amdgcn_readfirstlane(kdst + 4096 + (slot))); } } while (0)
#define DMA_V(t, slot) do { if (rkv) { glds16(vsrc + (size_t)(t) * 64 * 64, (unsigned)__builtin_amdgcn_readfirstlane(vdst + (slot))); \
        glds16(vsrc + 32 + (size_t)(t) * 64 * 64, (unsigned)__builtin_amdgcn_readfirstlane(vdst + 4096 + (slot))); } } while (0)
#define WB_P() RWAIT(4)
#define WB_S() RWAIT(4)
#define WB_E1() RWAIT(2)
#define WB_E0() RWAIT(0)
#else
    const bf16_t* ksrc = Kh + (size_t)lane * DQ + wid * 8;
    const bf16_t* vsrc = Vh + (size_t)(16 * (wid & 3) + (lane >> 2)) * 64 + (wid >> 2) * 32 + (lane & 3) * 8;
    const unsigned kdst = lds0 + T_LDS_K + wid * 1024, vdst = lds0 + T_LDS_V + wid * 1024;
#define DMA_K(t, slot) glds16(ksrc + (size_t)(t) * 64 * DQ, (unsigned)__builtin_amdgcn_readfirstlane(kdst + (slot)))
#define DMA_V(t, slot) glds16(vsrc + (size_t)(t) * 64 * 64, (unsigned)__builtin_amdgcn_readfirstlane(vdst + (slot)))
#endif
    const int vb0 = (int)(lds0 + T_LDS_V) + ((lane >> 4) & 1) * 32 + (lane & 3) * 8 + (4 * hi + ((lane & 15) >> 2)) * 64;
    bf16x8 kf[8];
    const lds_cptr shm3 = (lds_cptr)shm; const lds_cptr kp0 = shm3 + T_LDS_K + hi * 1024 + r32 * 16;
    const lds_cptr vp0 = shm3 + T_LDS_V + ((lane >> 4) & 1) * 32 + (lane & 3) * 8 + (4 * hi + ((lane & 15) >> 2)) * 64;
    DMA_K(0, 0); DMA_V(0, 0); DMA_K(1, T_SLOTB);
    bf16x8 qr[4];
#pragma unroll
    for (int d0 = 0; d0 < 4; ++d0) qr[d0] = *reinterpret_cast<const bf16x8*>(&Qw[(size_t)r32 * DQ + d0 * 16 + hi * 8]);
    float mfo = mfix; asm volatile("" : "+v"(mfo));
    float mhat = mfo, l_reg = 0.f; f32x16 o[2]; o[0] = f32x16{}; o[1] = f32x16{}; f32x16 negm;
#pragma unroll
    for (int r = 0; r < 16; ++r) negm[r] = -mfo;
    asm volatile("" : "+v"(negm));
    bool resc = false;
#define START(P0, P1) do { resc = false; _Pragma("unroll") for (int r = 0; r < 16; ++r) P0[r] = __builtin_amdgcn_exp2f(P0[r]); } while (0)
#define RESC() do { if (resc) { asm volatile("s_waitcnt lgkmcnt(0)" ::: "memory"); \
      _Pragma("unroll") for (int d_ = 0; d_ < 2; ++d_) _Pragma("unroll") for (int r = 0; r < 16; ++r) o[d_][r] *= wsf[crow(r, hi)]; } } while (0)
    f32x16 pA0, pA1, pB0, pB1;
    int sl_prev = 0, sl_cur = 0, sl_next = T_SLOTB;
#define ROT() do { sl_prev = sl_cur; sl_cur = sl_next; sl_next = (sl_next == 2 * T_SLOTB) ? 0 : sl_next + T_SLOTB; } while (0)
    DMA_K(2, 2 * T_SLOTB);
#if CONV_MODE >= 5
    WAIT_BAR(0);
#else
    WAIT_BAR(3);
#endif
    CONV_DRAIN();
    {
        const lds_cptr kb = kp0;
#pragma unroll
        for (int d0 = 0; d0 < 4; ++d0) {
            const bf16x8 b0 = *(const __attribute__((address_space(3))) bf16x8*)(kb + d0 * 2048);
            const bf16x8 b1 = *(const __attribute__((address_space(3))) bf16x8*)(kb + d0 * 2048 + 512);
            if (d0 == 0) { pA0 = MFMA(b0, qr[0], negm); pA1 = MFMA(b1, qr[0], negm); }
            else { pA0 = MFMA(b0, qr[d0], pA0); pA1 = MFMA(b1, qr[d0], pA1); } }
    }
    asm volatile("s_nop 15\n\ts_nop 7" : "+v"(pA0), "+v"(pA1));
    START(pA0, pA1);
#pragma unroll
    for (int r = 0; r < 16; ++r) pA1[r] = __builtin_amdgcn_exp2f(pA1[r]);
    WAIT_BAR(0);
    DMA_K(3, 0); DMA_V(1, T_SLOTB); CONV_ISSUE();
    ROT();
    kload8(kf, kp0 + sl_cur);
    WB_P();
    s16x4 vlo[8], vhi[8]; u32x4 pw0, pw1, pw2, pw3;
#define PKW(P, B) cvtpk_s(P[B], P[B + 1])
#define PAF(k) __builtin_bit_cast(bf16x8, pw##k)
#define VFR(i) (bf16x8){vlo[i][0], vlo[i][1], vlo[i][2], vlo[i][3], vhi[i][0], vhi[i][1], vhi[i][2], vhi[i][3]}
#define PIN(x) asm volatile("" : "+v"(x))
#define GAPA(MF, A0, A1, A2, A3, W0, W1, PW) do { MF; sacc += A0; sacc += A1; sacc += A2; sacc += A3; PIN(sacc); W0; W1; PIN(PW); SBAR(); } while (0)
#define EX(v) __builtin_amdgcn_exp2f(v)
#define GAPB(MF, X, B) do { MF; X[B] = EX(X[B]); X[B + 1] = EX(X[B + 1]); X[B + 2] = EX(X[B + 2]); X[B + 3] = EX(X[B + 3]); PIN(X); SBAR(); } while (0)
#define VRD(i) do { vlo[i] = vtr(vp_ + (((i) >> 2) * 4096 + ((i) & 3) * 1024)); vhi[i] = vtr(vp_ + (((i) >> 2) * 4096 + ((i) & 3) * 1024 + 512)); } while (0)
#define KRD(G, j) do { if (G) { kload2(kf, kp0 + sl_next, j); SBAR(); } } while (0)
#define STEP(C0, C1, P0, P1, t, GK, GV, GL) do { SBAR(); CONV_DRAIN(); SBAR(); \
    const lds_cptr vp_ = vp0 + sl_prev; \
    VRD(0); SBAR(); float sacc = (P0[0] + P0[1]); \
    GAPA(C0 = MFMA(kf[0], qr[0], negm), P0[2], P0[3], P0[4], P0[5],     pw0[0] = PKW(P0, 0), pw0[1] = PKW(P0, 2), pw0); \
    VRD(4); SBAR(); GAPA(C1 = MFMA(kf[1], qr[0], negm), P0[6], P0[7], P0[8], P0[9],     pw0[2] = PKW(P0, 4), pw0[3] = PKW(P0, 6), pw0); \
    VRD(1); SBAR(); GAPA(C0 = MFMA(kf[2], qr[1], C0),   P0[10], P0[11], P0[12], P0[13], pw1[0] = PKW(P0, 8), pw1[1] = PKW(P0, 10), pw1); \
    VRD(5); SBAR(); GAPA(C1 = MFMA(kf[3], qr[1], C1),   P0[14], P0[15], P1[0], P1[1],   pw1[2] = PKW(P0, 12), pw1[3] = PKW(P0, 14), pw1); \
    VRD(2); SBAR(); GAPA(C0 = MFMA(kf[4], qr[2], C0),   P1[2], P1[3], P1[4], P1[5],     pw2[0] = PKW(P1, 0), pw2[1] = PKW(P1, 2), pw2); \
    VRD(6); SBAR(); GAPA(C1 = MFMA(kf[5], qr[2], C1),   P1[6], P1[7], P1[8], P1[9],     pw2[2] = PKW(P1, 4), pw2[3] = PKW(P1, 6), pw2); \
    VRD(3); SBAR(); GAPA(C0 = MFMA(kf[6], qr[3], C0),   P1[10], P1[11], P1[12], P1[13], pw3[0] = PKW(P1, 8), pw3[1] = PKW(P1, 10), pw3); \
    VRD(7); SBAR(); GAPA(C1 = MFMA(kf[7], qr[3], C1),   P1[14], P1[15], 0.f, 0.f,       pw3[2] = PKW(P1, 12), pw3[3] = PKW(P1, 14), pw3); \
    l_reg += sacc; \
    if (GK) { DMA_K((t) + 3, sl_cur); } if (GV) { DMA_V((t) + 1, sl_next); } CONV_ISSUE(); \
    SBAR(); \
    GAPB(o[0] = MFMA(PAF(0), VFR(0), o[0]), C0, 0); \
    GAPB(o[1] = MFMA(PAF(0), VFR(4), o[1]), C0, 4); \
    KRD(GL, 0); GAPB(o[0] = MFMA(PAF(1), VFR(1), o[0]), C0, 8); \
    KRD(GL, 1); GAPB(o[1] = MFMA(PAF(1), VFR(5), o[1]), C0, 12); \
    KRD(GL, 2); GAPB(o[0] = MFMA(PAF(2), VFR(2), o[0]), C1, 0); \
    KRD(GL, 3); GAPB(o[1] = MFMA(PAF(2), VFR(6), o[1]), C1, 4); \
    GAPB(o[0] = MFMA(PAF(3), VFR(3), o[0]), C1, 8); \
    GAPB(o[1] = MFMA(PAF(3), VFR(7), o[1]), C1, 12); \
    } while (0)
    int t = 1;
    for (; t + 5 < NT; t += 2) {
        STEP(pB0, pB1, pA0, pA1, t, true, true, true);     WB_S(); RESC(); ROT();
        STEP(pA0, pA1, pB0, pB1, t + 1, true, true, true); WB_S(); RESC(); ROT();
    }
#define ENDW(tt) do { if ((tt) + 3 < NT) { WB_S(); } else if ((tt) + 2 < NT) { WB_E1(); } else { WB_E0(); } } while (0)
    for (; t + 1 < NT; t += 2) {
        STEP(pB0, pB1, pA0, pA1, t, (t + 3 < NT), (t + 1 < NT), (t + 1 < NT));         ENDW(t);     RESC(); ROT();
        STEP(pA0, pA1, pB0, pB1, t + 1, (t + 4 < NT), (t + 2 < NT), (t + 2 < NT));     ENDW(t + 1); RESC(); ROT();
    }
    STEP(pB0, pB1, pA0, pA1, NT - 1, false, false, false); RESC();
    {
        float sacc = pB0[0] + pB0[1];
#pragma unroll
        for (int r = 2; r < 16; ++r) sacc += pB0[r];
#pragma unroll
        for (int r = 0; r < 16; ++r) sacc += pB1[r];
        l_reg += sacc;
        pw0 = (u32x4){PKW(pB0, 0), PKW(pB0, 2), PKW(pB0, 4), PKW(pB0, 6)}; pw1 = (u32x4){PKW(pB0, 8), PKW(pB0, 10), PKW(pB0, 12), PKW(pB0, 14)};
        pw2 = (u32x4){PKW(pB1, 0), PKW(pB1, 2), PKW(pB1, 4), PKW(pB1, 6)}; pw3 = (u32x4){PKW(pB1, 8), PKW(pB1, 10), PKW(pB1, 12), PKW(pB1, 14)};
        SBAR();
        const lds_cptr vp_ = vp0 + sl_cur;
#pragma unroll
        for (int i = 0; i < 8; ++i) VRD(i);
        o[0] = MFMA(PAF(0), VFR(0), o[0]); o[1] = MFMA(PAF(0), VFR(4), o[1]); o[0] = MFMA(PAF(1), VFR(1), o[0]); o[1] = MFMA(PAF(1), VFR(5), o[1]);
        o[0] = MFMA(PAF(2), VFR(2), o[0]); o[1] = MFMA(PAF(2), VFR(6), o[1]); o[0] = MFMA(PAF(3), VFR(3), o[0]); o[1] = MFMA(PAF(3), VFR(7), o[1]);
    }
#undef PKW
#undef PAF
#undef VFR
#undef PIN
#undef GAPA
#undef GAPB
#undef EX
#undef VRD
#undef KRD
#undef STEP
#undef ENDW
    { auto rr = __builtin_amdgcn_permlane32_swap(__float_as_uint(l_reg), __float_as_uint(l_reg), false, false); l_reg = __uint_as_float(rr[0]) + __uint_as_float(rr[1]); }
    if (hi == 0) wsf[32 + r32] = l_reg; asm volatile("s_waitcnt lgkmcnt(0)" ::: "memory");
    float rli[16];
#pragma unroll
    for (int r = 0; r < 16; ++r) rli[r] = __builtin_amdgcn_rcpf(wsf[32 + crow(r, hi)]);
    bf16_t* Ow = Ob + (size_t)(wid * 32) * DM; bf16_t* stg = (bf16_t*)(shm + T_LDS_OST) + wid * 2048;
#pragma unroll
    for (int r = 0; r < 16; ++r) { const int orow = crow(r, hi);
#pragma unroll
        for (int d0 = 0; d0 < 2; ++d0) stg[orow * 64 + d0 * 32 + r32] = (bf16_t)f2bf(o[d0][r] * rli[r]); }
    asm volatile("s_waitcnt lgkmcnt(0)" ::: "memory");
#pragma unroll
    for (int i = 0; i < 4; ++i) { const int row = i * 8 + (lane >> 3), ch = lane & 7; const u32x4 v = *(const u32x4*)(stg + row * 64 + ch * 8); *(u32x4*)(Ow + (size_t)row * DM + ch * 8) = v;
        float q = 0.f;
#pragma unroll
        for (int d = 0; d < 4; ++d) { const float a = bf2f(v[d] & 0xffffu), bq = bf2f(v[d] >> 16); q += a * a + bq * bq; }
        q += dppmov<0xB1, 0xF>(0.f, q); q += dppmov<0x4E, 0xF>(0.f, q); q += dppmov<0x141, 0xF>(0.f, q);
        if (ch == 0) ostat[(size_t)(wid * 32 + row) * 16] = q; }
    asm volatile("s_waitcnt vmcnt(0) lgkmcnt(0)\n\ts_barrier" ::: "memory");
#if CONV_MODE >= 5
#undef WB_P
#undef WB_S
#undef WB_E1
#undef WB_E0
#endif
#undef DMA_K
#undef DMA_V
#undef START
#undef RESC
#undef ROT
}
constexpr int M_KSLOT = 12288, M_LDS_K = 0, M_LDS_V = 3 * M_KSLOT, M_LDS_WS = M_LDS_V + 3 * T_SLOTB, M_LDS_Q = M_LDS_WS + NWAVES * 256, M_LDS_OST = 0  ;
#define WBAR2() do { if (lowv) { WB_PL(); } else { WB_P(); } } while (0)
#define WBARS() do { if (lowv) { WB_SL(); } else { WB_S(); } } while (0)
template <int THRL>
__device__ __forceinline__ void unit96(const bf16_t* Qh, const bf16_t* __restrict__ Kh, const bf16_t* __restrict__ Vh, bf16_t* Ob, float* ostat, int q0, char* shm, ConvState& cs, float kb2) {
    constexpr int DQ = 96;
    int tid_ = threadIdx.x; asm volatile("" : "+v"(tid_));
    const int tid = tid_, lane = tid & 63, r32 = lane & 31, hi = lane >> 5; const int wid = __builtin_amdgcn_readfirstlane(tid >> 6);
    const bf16_t* Qw = Qh + (size_t)(q0 + wid * 32) * DQ;
    const unsigned lds0 = (unsigned)(uintptr_t)shm;
    float* wsf = (float*)(shm + M_LDS_WS) + wid * 64;
#if CONV_MODE >= 5
    const bool rkv = wid < 4, rcl = (wid == 4 || wid == 5), rst = wid >= 6; const int pw = wid & 3;
    const bf16_t* ksrc = Kh + (size_t)lane * DQ + pw * 8;
    const bool lowv = false;
#else
    const bf16_t* ksrc = Kh + (size_t)lane * DQ + wid * 8;
    const bf16_t* ksrc1 = Kh + (size_t)lane * DQ + (8 + (wid & 3)) * 8;
    const bool lowv = wid < 4;
#endif
#if CONV_MODE >= 5
    const bf16_t* vsrc = Vh + (size_t)(16 * pw + (lane >> 2)) * 64 + (lane & 3) * 8;
    const unsigned kdst = lds0 + M_LDS_K + pw * 1024, vdst = lds0 + M_LDS_V + pw * 1024, qdst = lds0 + M_LDS_Q + wid * 6144;
#define DMA_K(t, slot) do { if (rkv) { glds16(ksrc + (size_t)(t) * 64 * DQ, (unsigned)__builtin_amdgcn_readfirstlane(kdst + (slot))); \
        glds16(ksrc + 32 + (size_t)(t) * 64 * DQ, (unsigned)__builtin_amdgcn_readfirstlane(kdst + 4096 + (slot))); \
        glds16(ksrc + 64 + (size_t)(t) * 64 * DQ, (unsigned)__builtin_amdgcn_readfirstlane(kdst + 8192 + (slot))); } } while (0)
#define DMA_V(t, slot) do { if (rkv) { glds16(vsrc + (size_t)(t) * 64 * 64, (unsigned)__builtin_amdgcn_readfirstlane(vdst + (slot))); \
        glds16(vsrc + 32 + (size_t)(t) * 64 * 64, (unsigned)__builtin_amdgcn_readfirstlane(vdst + 4096 + (slot))); } } while (0)
#undef WBAR2
#undef WBARS
#define WBAR2() RWAIT(5)
#define WBARS() RWAIT(5)
#define WB_E1() RWAIT(2)
#define WB_E0() RWAIT(0)
#else
    const bf16_t* vsrc = Vh + (size_t)(16 * (wid & 3) + (lane >> 2)) * 64 + (wid >> 2) * 32 + (lane & 3) * 8;
    const unsigned kdst = lds0 + M_LDS_K + wid * 1024, kdst1 = lds0 + M_LDS_K + (8 + (wid & 3)) * 1024, vdst = lds0 + M_LDS_V + wid * 1024, qdst = lds0 + M_LDS_Q + wid * 6144;
#define DMA_K(t, slot) do { glds16(ksrc + (size_t)(t) * 64 * DQ, (unsigned)__builtin_amdgcn_readfirstlane(kdst + (slot))); \
        if (lowv) glds16(ksrc1 + (size_t)(t) * 64 * DQ, (unsigned)__builtin_amdgcn_readfirstlane(kdst1 + (slot))); } while (0)
#define DMA_V(t, slot) glds16(vsrc + (size_t)(t) * 64 * 64, (unsigned)__builtin_amdgcn_readfirstlane(vdst + (slot)))
#endif
    const int vb0 = (int)(lds0 + M_LDS_V) + ((lane >> 4) & 1) * 32 + (lane & 3) * 8 + (4 * hi + ((lane & 15) >> 2)) * 64;
    bf16x8 kf[12];
    const lds_cptr shm3 = (lds_cptr)shm; const lds_cptr kp0 = shm3 + M_LDS_K + hi * 1024 + r32 * 16; const lds_cptr qp0 = shm3 + M_LDS_Q + wid * 6144 + lane * 16;
    const lds_cptr vp0 = shm3 + M_LDS_V + ((lane >> 4) & 1) * 32 + (lane & 3) * 8 + (4 * hi + ((lane & 15) >> 2)) * 64;
#pragma unroll
    for (int d0 = 0; d0 < 6; ++d0) glds16(Qw + (size_t)r32 * DQ + d0 * 16 + hi * 8, (unsigned)__builtin_amdgcn_readfirstlane(qdst + d0 * 1024));
    DMA_K(0, 0); DMA_V(0, 0); DMA_K(1, M_KSLOT);
#define QF(d0) (*(const __attribute__((address_space(3))) bf16x8*)(qp0 + (d0) * 1024))
    float mhat = 0.f, l_reg = 0.f; f32x16 o[2]; o[0] = f32x16{}; o[1] = f32x16{}; f32x16 negm = f32x16{}; asm volatile("" : "+v"(negm));
    bool resc = false;
#define START(P0, P1) do { resc = false; _Pragma("unroll") for (int r = 0; r < 16; ++r) P0[r] = __builtin_amdgcn_exp2f(P0[r]); } while (0)
#define RESC() do { if (resc) { asm volatile("s_waitcnt lgkmcnt(0)" ::: "memory"); \
      _Pragma("unroll") for (int d_ = 0; d_ < 2; ++d_) _Pragma("unroll") for (int r = 0; r < 16; ++r) o[d_][r] *= wsf[crow(r, hi)]; } } while (0)
    f32x16 pA0, pA1, pB0, pB1;
    int sl_prev = 0, sl_cur = 0, sl_next = M_KSLOT; int vs_prev = 0, vs_cur = 0, vs_next = T_SLOTB;
#define ROT() do { sl_prev = sl_cur; sl_cur = sl_next; sl_next = (sl_next == 2 * M_KSLOT) ? 0 : sl_next + M_KSLOT; vs_prev = vs_cur; vs_cur = vs_next; vs_next = (vs_next == 2 * T_SLOTB) ? 0 : vs_next + T_SLOTB; } while (0)
    DMA_K(2, 2 * M_KSLOT);
    WAIT_BAR(0);
    {
        float qn = 0.f;
#pragma unroll
        for (int d0 = 0; d0 < 6; ++d0) { const bf16x8 qf = QF(d0);
#pragma unroll
            for (int i = 0; i < 8; ++i) { const float x = bf2f((unsigned short)qf[i]); qn += x * x; } }
        auto rr = __builtin_amdgcn_permlane32_swap(__float_as_uint(qn), __float_as_uint(qn), false, false); qn = __uint_as_float(rr[0]) + __uint_as_float(rr[1]);
        mhat = fminf(sqrtf(qn * kb2) * 1.02f + 0.5f, 60.f);
#pragma unroll
        for (int r = 0; r < 16; ++r) negm[r] = -mhat;
        asm volatile("" : "+v"(negm));
    }
    CONV_DRAIN();
    {
        const lds_cptr kb = kp0;
#pragma unroll
        for (int d0 = 0; d0 < 6; ++d0) {
            const bf16x8 b0 = *(const __attribute__((address_space(3))) bf16x8*)(kb + d0 * 2048);
            const bf16x8 b1 = *(const __attribute__((address_space(3))) bf16x8*)(kb + d0 * 2048 + 512);
            const bf16x8 qf = QF(d0);
            if (d0 == 0) { pA0 = MFMA(b0, qf, negm); pA1 = MFMA(b1, qf, negm); }
            else { pA0 = MFMA(b0, qf, pA0); pA1 = MFMA(b1, qf, pA1); } }
    }
    asm volatile("s_nop 15\n\ts_nop 7" : "+v"(pA0), "+v"(pA1));
    START(pA0, pA1);
#pragma unroll
    for (int r = 0; r < 16; ++r) pA1[r] = __builtin_amdgcn_exp2f(pA1[r]);
    WAIT_BAR(0);
    DMA_K(3, 0); DMA_V(1, T_SLOTB); CONV_ISSUE();
    ROT();
#pragma unroll
    for (int j = 0; j < 6; ++j) kload2(kf, kp0 + sl_cur, j);
    WBAR2();
    s16x4 vlo[8], vhi[8]; u32x4 pw0, pw1, pw2, pw3;
#define PKW(P, B) cvtpk_s(P[B], P[B + 1])
#define PAF(k) __builtin_bit_cast(bf16x8, pw##k)
#define VFR(i) (bf16x8){vlo[i][0], vlo[i][1], vlo[i][2], vlo[i][3], vhi[i][0], vhi[i][1], vhi[i][2], vhi[i][3]}
#define PIN(x) asm volatile("" : "+v"(x))
#define GAPA(MF, A0, A1, A2, A3, W0, W1, PW) do { MF; sacc += A0; sacc += A1; sacc += A2; sacc += A3; PIN(sacc); W0; W1; PIN(PW); SBAR(); } while (0)
#define EX(v) __builtin_amdgcn_exp2f(v)
#define GAPB(MF, X, B) do { MF; X[B] = EX(X[B]); X[B + 1] = EX(X[B + 1]); X[B + 2] = EX(X[B + 2]); X[B + 3] = EX(X[B + 3]); PIN(X); SBAR(); } while (0)
#define VRD(i) do { vlo[i] = vtr(vp_ + (((i) >> 2) * 4096 + ((i) & 3) * 1024)); vhi[i] = vtr(vp_ + (((i) >> 2) * 4096 + ((i) & 3) * 1024 + 512)); } while (0)
#define KRD(G, j) do { if (G) { kload2(kf, kp0 + sl_next, j); SBAR(); } } while (0)
#define STEP(C0, C1, P0, P1, t, GK, GV, GL) do { SBAR(); CONV_DRAIN(); SBAR(); \
    const lds_cptr vp_ = vp0 + vs_prev; \
    bf16x8 qa = QF(0), qb = QF(1); \
    VRD(0); SBAR(); float sacc = (P0[0] + P0[1]); \
    GAPA(C0 = MFMA(kf[0], qa, negm), P0[2], P0[3], P0[4], P0[5],     pw0[0] = PKW(P0, 0), pw0[1] = PKW(P0, 2), pw0); \
    VRD(4); SBAR(); GAPA(C1 = MFMA(kf[1], qa, negm), P0[6], P0[7], P0[8], P0[9],     pw0[2] = PKW(P0, 4), pw0[3] = PKW(P0, 6), pw0); \
    qa = QF(2); VRD(1); SBAR(); GAPA(C0 = MFMA(kf[2], qb, C0),   P0[10], P0[11], P0[12], P0[13], pw1[0] = PKW(P0, 8), pw1[1] = PKW(P0, 10), pw1); \
    VRD(5); SBAR(); GAPA(C1 = MFMA(kf[3], qb, C1),   P0[14], P0[15], P1[0], P1[1],   pw1[2] = PKW(P0, 12), pw1[3] = PKW(P0, 14), pw1); \
    qb = QF(3); VRD(2); SBAR(); GAPA(C0 = MFMA(kf[4], qa, C0),   P1[2], P1[3], P1[4], P1[5],     pw2[0] = PKW(P1, 0), pw2[1] = PKW(P1, 2), pw2); \
    VRD(6); SBAR(); GAPA(C1 = MFMA(kf[5], qa, C1),   P1[6], P1[7], P1[8], P1[9],     pw2[2] = PKW(P1, 4), pw2[3] = PKW(P1, 6), pw2); \
    qa = QF(4); VRD(3); SBAR(); GAPA(C0 = MFMA(kf[6], qb, C0),   P1[10], P1[11], P1[12], P1[13], pw3[0] = PKW(P1, 8), pw3[1] = PKW(P1, 10), pw3); \
    VRD(7); SBAR(); GAPA(C1 = MFMA(kf[7], qb, C1),   P1[14], P1[15], 0.f, 0.f,       pw3[2] = PKW(P1, 12), pw3[3] = PKW(P1, 14), pw3); \
    qb = QF(5); SBAR(); C0 = MFMA(kf[8], qa, C0); C1 = MFMA(kf[9], qa, C1); SBAR(); \
    C0 = MFMA(kf[10], qb, C0); C1 = MFMA(kf[11], qb, C1); SBAR(); \
    l_reg += sacc; \
    if (GK) { DMA_K((t) + 3, sl_cur); } if (GV) { DMA_V((t) + 1, vs_next); } CONV_ISSUE(); \
    SBAR(); \
    GAPB(o[0] = MFMA(PAF(0), VFR(0), o[0]), C0, 0); \
    KRD(GL, 0); GAPB(o[1] = MFMA(PAF(0), VFR(4), o[1]), C0, 4); \
    KRD(GL, 1); GAPB(o[0] = MFMA(PAF(1), VFR(1), o[0]), C0, 8); \
    KRD(GL, 2); GAPB(o[1] = MFMA(PAF(1), VFR(5), o[1]), C0, 12); \
    KRD(GL, 3); GAPB(o[0] = MFMA(PAF(2), VFR(2), o[0]), C1, 0); \
    KRD(GL, 4); GAPB(o[1] = MFMA(PAF(2), VFR(6), o[1]), C1, 4); \
    KRD(GL, 5); GAPB(o[0] = MFMA(PAF(3), VFR(3), o[0]), C1, 8); \
    GAPB(o[1] = MFMA(PAF(3), VFR(7), o[1]), C1, 12); \
    } while (0)
    int t = 1;
    for (; t + 5 < NT; t += 2) {
        STEP(pB0, pB1, pA0, pA1, t, true, true, true);     WBARS(); RESC(); ROT();
        STEP(pA0, pA1, pB0, pB1, t + 1, true, true, true); WBARS(); RESC(); ROT();
    }
#define ENDW(tt) do { if ((tt) + 3 < NT) { WBARS(); } else if ((tt) + 2 < NT) { WB_E1(); } else { WB_E0(); } } while (0)
    for (; t + 1 < NT; t += 2) {
        STEP(pB0, pB1, pA0, pA1, t, (t + 3 < NT), (t + 1 < NT), (t + 1 < NT));         ENDW(t);     RESC(); ROT();
        STEP(pA0, pA1, pB0, pB1, t + 1, (t + 4 < NT), (t + 2 < NT), (t + 2 < NT));     ENDW(t + 1); RESC(); ROT();
    }
    STEP(pB0, pB1, pA0, pA1, NT - 1, false, false, false); RESC();
    {
        float sacc = pB0[0] + pB0[1];
#pragma unroll
        for (int r = 2; r < 16; ++r) sacc += pB0[r];
#pragma unroll
        for (int r = 0; r < 16; ++r) sacc += pB1[r];
        l_reg += sacc;
        pw0 = (u32x4){PKW(pB0, 0), PKW(pB0, 2), PKW(pB0, 4), PKW(pB0, 6)}; pw1 = (u32x4){PKW(pB0, 8), PKW(pB0, 10), PKW(pB0, 12), PKW(pB0, 14)};
        pw2 = (u32x4){PKW(pB1, 0), PKW(pB1, 2), PKW(pB1, 4), PKW(pB1, 6)}; pw3 = (u32x4){PKW(pB1, 8), PKW(pB1, 10), PKW(pB1, 12), PKW(pB1, 14)};
        SBAR();
        const lds_cptr vp_ = vp0 + vs_cur;
#pragma unroll
        for (int i = 0; i < 8; ++i) VRD(i);
        o[0] = MFMA(PAF(0), VFR(0), o[0]); o[1] = MFMA(PAF(0), VFR(4), o[1]); o[0] = MFMA(PAF(1), VFR(1), o[0]); o[1] = MFMA(PAF(1), VFR(5), o[1]);
        o[0] = MFMA(PAF(2), VFR(2), o[0]); o[1] = MFMA(PAF(2), VFR(6), o[1]); o[0] = MFMA(PAF(3), VFR(3), o[0]); o[1] = MFMA(PAF(3), VFR(7), o[1]);
    }
#undef PKW
#undef PAF
#undef VFR
#undef PIN
#undef GAPA
#undef GAPB
#undef EX
#undef VRD
#undef KRD
#undef STEP
#undef ENDW
    { auto rr = __builtin_amdgcn_permlane32_swap(__float_as_uint(l_reg), __float_as_uint(l_reg), false, false); l_reg = __uint_as_float(rr[0]) + __uint_as_float(rr[1]); }
    if (hi == 0) wsf[32 + r32] = l_reg; asm volatile("s_waitcnt lgkmcnt(0)" ::: "memory");
    float rli[16];
#pragma unroll
    for (int r = 0; r < 16; ++r) rli[r] = __builtin_amdgcn_rcpf(wsf[32 + crow(r, hi)]);
    bf16_t* Ow = Ob + (size_t)(wid * 32) * DM; bf16_t* stg = (bf16_t*)(shm + M_LDS_OST) + wid * 2048;
#pragma unroll
    for (int r = 0; r < 16; ++r) { const int orow = crow(r, hi);
#pragma unroll
        for (int d0 = 0; d0 < 2; ++d0) stg[orow * 64 + d0 * 32 + r32] = (bf16_t)f2bf(o[d0][r] * rli[r]); }
    asm volatile("s_waitcnt lgkmcnt(0)" ::: "memory");
#pragma unroll
    for (int i = 0; i < 4; ++i) { const int row = i * 8 + (lane >> 3), ch = lane & 7; const u32x4 v = *(const u32x4*)(stg + row * 64 + ch * 8); *(u32x4*)(Ow + (size_t)row * DM + ch * 8) = v;
        float q = 0.f;
#pragma unroll
        for (int d = 0; d < 4; ++d) { const float a = bf2f(v[d] & 0xffffu), bq = bf2f(v[d] >> 16); q += a * a + bq * bq; }
        q += dppmov<0xB1, 0xF>(0.f, q); q += dppmov<0x4E, 0xF>(0.f, q); q += dppmov<0x141, 0xF>(0.f, q);
        if (ch == 0) ostat[(size_t)(wid * 32 + row) * 16] = q; }
    asm volatile("s_waitcnt vmcnt(0) lgkmcnt(0)\n\ts_barrier" ::: "memory");
#if CONV_MODE >= 5
#undef WB_E1
#undef WB_E0
#endif
#undef QF
#undef DMA_K
#undef DMA_V
#undef START
#undef RESC
#undef ROT
}
#undef WBAR2
#undef WBARS
#undef WAIT_BAR
}


namespace pg8 {
typedef short bf16x8 __attribute__((ext_vector_type(8)));
typedef float f32x4 __attribute__((ext_vector_type(4)));
typedef unsigned u32x4 __attribute__((ext_vector_type(4)));
constexpr int BM = 256, BK = 64, HALF = 128, HTB = HALF * BK * 2, STAGE_BYTES = 8 * HTB, NXCD = 8, WGM = 8;
__host__ __device__ __forceinline__ int lds_byte(int r, int c) { const int st = (r >> 4) * 2 + (c >> 5), rr = r & 15, cc = c & 31, ob = rr * 64 + cc * 2; return st * 1024 + (ob ^ (((ob >> 9) & 1) << 5)); }
__host__ __device__ __forceinline__ void stage_rc(int b, int& R, int& C) { const int st = b / 1024, sb = b % 1024, swz = sb ^ (((sb >> 9) & 1) << 5); R = (st >> 1) * 16 + swz / 64; C = (st & 1) * 32 + (swz % 64) / 2; }
__host__ __device__ __forceinline__ int perm32(int rho) { const int n = rho >> 4, i = rho & 15; return 8 * (i >> 2) + 4 * n + (i & 3); }
__device__ __forceinline__ unsigned cvt_pk_bf16(float lo, float hi) { unsigned r; asm volatile("v_cvt_pk_bf16_f32 %0, %1, %2" : "=v"(r) : "v"(lo), "v"(hi)); return r; }

struct Unit { int pm, pn, e, nrows, rowbase; };

struct DenseOrder {
    int nM, nN, nwg, G, c, K; const char* Bt;
    __device__ void init(int M, int N, int K_, const bf16_t* Bt_, int G_, int c_) { nM = M / BM; nN = N / BM; nwg = nM * nN; G = G_; c = c_; K = K_; Bt = (const char*)Bt_; }
    __device__ __forceinline__ bool next(int i, Unit& u) const {
        const long L = (long)i * G + c; if (L >= nwg) return false;
        int wgid = (int)L; { const int q = nwg / NXCD, r = nwg % NXCD, xcd = wgid % NXCD, off = wgid / NXCD; wgid = (xcd < r ? xcd * (q + 1) : r * (q + 1) + (xcd - r) * q) + off; }
        const int nig = WGM * nN, gid = wgid / nig, fm = gid * WGM, gsz = (nM - fm) < WGM ? (nM - fm) : WGM;
        u.pm = fm + ((wgid % nig) % gsz); u.pn = (wgid % nig) / gsz; u.e = 0; u.nrows = 256; u.rowbase = u.pm * BM; return true;
    }
    __device__ __forceinline__ void a_offsets(const Unit&, int, unsigned (&)[2][2]) const {}
    __device__ __forceinline__ const char* b_tile(const Unit& u) const { return Bt + (size_t)u.pn * BM * K * 2; }
};

struct EpiBf16 {
    static constexpr bool PERM = true;
    bf16_t* O; int ldc;
    __device__ __forceinline__ void operator()(const f32x4 (&acc)[2][2][4][2], const Unit& u, int wr, int wc, int fr, int fq) const {
        const int row0 = u.pm * BM + wr * 64 + fr, col0 = u.pn * BM + wc * 32 + 8 * fq;
#pragma unroll
        for (int ai = 0; ai < 2; ++ai)
#pragma unroll
            for (int m = 0; m < 4; ++m) { bf16_t* rowp = O + (size_t)(row0 + ai * HALF + m * 16) * ldc + col0;
#pragma unroll
                for (int bj = 0; bj < 2; ++bj) { const f32x4 v0 = acc[ai][bj][m][0], v1 = acc[ai][bj][m][1];
                    u32x4 w; w.x = cvt_pk_bf16(v0[0], v0[1]); w.y = cvt_pk_bf16(v0[2], v0[3]); w.z = cvt_pk_bf16(v1[0], v1[1]); w.w = cvt_pk_bf16(v1[2], v1[3]);
                    *(u32x4*)(rowp + bj * HALF) = w; } }
    }
};


__device__ __forceinline__ float silu_mul(float g, float u) { return g * __builtin_amdgcn_rcpf(1.f + __expf(-g)) * u; }

struct MoeOrder {
    const LAS int* pre; const LAS int* offs; const LAS int* cntl; const int* list; const char* Bt; size_t bstride; int K, npn, G, c, mode;
    __device__ __forceinline__ bool next(int i, Unit& u) const {
        const int L = i * G + c, total = pre[NE] * npn; if (L >= total) return false;
        const int rtg = L / npn; const int pn = L - rtg * npn;
        int lo_ = 0, hi_ = NE;
        while (hi_ - lo_ > 1) { const int mid = (lo_ + hi_) >> 1; if (pre[mid] <= rtg) lo_ = mid; else hi_ = mid; }
        const int e = lo_, pm = rtg - pre[e], n = cntl[e] - pm * BM;
        u.e = __builtin_amdgcn_readfirstlane(e); u.pm = __builtin_amdgcn_readfirstlane(pm); u.pn = __builtin_amdgcn_readfirstlane(pn);
        u.nrows = __builtin_amdgcn_readfirstlane(n < BM ? n : BM); u.rowbase = __builtin_amdgcn_readfirstlane(offs[e] + pm * BM); return true;
    }
    __device__ __forceinline__ void a_offsets(const Unit& u, int tid, unsigned (&ua)[2][2]) const {
#pragma unroll
        for (int i = 0; i < 2; ++i) { int R, C; stage_rc(tid * 16 + i * 8192, R, C);
#pragma unroll
            for (int h = 0; h < 2; ++h) { int r = h * HALF + R; if (r >= u.nrows) r = 0; const int row = list[(size_t)u.e * LCAP + u.pm * BM + r] >> 3;
                ua[h][i] = (unsigned)((row * K + C) * 2); } }
    }
    __device__ __forceinline__ const char* b_tile(const Unit& u) const { return Bt + (size_t)u.e * bstride + (size_t)u.pn * BM * K * 2; }
};

struct EpiAct {
    static constexpr bool PERM = true;
    bf16_t* ACT;
    __device__ __forceinline__ void operator()(const f32x4 (&acc)[2][2][4][2], const Unit& u, int wr, int wc, int fr, int fq) const {
        const __amdgpu_buffer_rsrc_t rs = __builtin_amdgcn_make_buffer_rsrc((void*)ACT, 0, (NTOK * TOPK + 256) * EFF * 2, 0x00020000);
        const unsigned cb = (unsigned)((u.pn * HALF + wc * 32 + 8 * fq) * 2);
#pragma unroll
        for (int ai = 0; ai < 2; ++ai)
#pragma unroll
            for (int m = 0; m < 4; ++m) { const int r = ai * HALF + wr * 64 + m * 16 + fr;
                const unsigned off = (r < u.nrows) ? (unsigned)(u.rowbase + r) * (EFF * 2) + cb : 0xFFFFFFF0u;
                const f32x4 g0 = acc[ai][0][m][0], g1 = acc[ai][0][m][1], u0 = acc[ai][1][m][0], u1 = acc[ai][1][m][1];
                u32x4 w; w.x = cvt_pk_bf16(silu_mul(g0[0], u0[0]), silu_mul(g0[1], u0[1])); w.y = cvt_pk_bf16(silu_mul(g0[2], u0[2]), silu_mul(g0[3], u0[3]));
                w.z = cvt_pk_bf16(silu_mul(g1[0], u1[0]), silu_mul(g1[1], u1[1])); w.w = cvt_pk_bf16(silu_mul(g1[2], u1[2]), silu_mul(g1[3], u1[3]));
                __builtin_amdgcn_raw_buffer_store_b128(w, rs, off, 0, 0); }
    }
};
struct EpiSlots {
    static constexpr bool PERM = true;
    unsigned char* SL;
    __device__ __forceinline__ void operator()(const f32x4 (&acc)[2][2][4][2], const Unit& u, int wr, int wc, int fr, int fq) const {
        const __amdgpu_buffer_rsrc_t rs = __builtin_amdgcn_make_buffer_rsrc((void*)SL, 0, NTOK * TOPK * DM, 0x00020000);
        const unsigned cb = (unsigned)(u.pn * BM + wc * 32 + 8 * fq);
#pragma unroll
        for (int ai = 0; ai < 2; ++ai)
#pragma unroll
            for (int m = 0; m < 4; ++m) { const int r = ai * HALF + wr * 64 + m * 16 + fr;
                const unsigned off = (r < u.nrows) ? (unsigned)(u.rowbase + r) * DM + cb : 0xFFFFFFF0u;
#pragma unroll
                for (int bj = 0; bj < 2; ++bj) { const f32x4 v0 = acc[ai][bj][m][0] * 16.f, v1 = acc[ai][bj][m][1] * 16.f;
                    int lo = __builtin_amdgcn_cvt_pk_fp8_f32(v0[0], v0[1], 0, false); lo = __builtin_amdgcn_cvt_pk_fp8_f32(v0[2], v0[3], lo, true);
                    int hi = __builtin_amdgcn_cvt_pk_fp8_f32(v1[0], v1[1], 0, false); hi = __builtin_amdgcn_cvt_pk_fp8_f32(v1[2], v1[3], hi, true);
                    typedef unsigned u32x2 __attribute__((ext_vector_type(2)));
                    __builtin_amdgcn_raw_buffer_store_b64((u32x2){(unsigned)lo, (unsigned)hi}, rs, off, bj * HALF, 0); } }
    }
};
struct EpiRS {
    static constexpr bool PERM = true;
    float* LOG; bf16_t* ACTS;
    __device__ __forceinline__ void operator()(const f32x4 (&acc)[2][2][4][2], const Unit& u, int wr, int wc, int fr, int fq) const {
        const int row0 = u.pm * BM + wr * 64 + fr;
#pragma unroll
        for (int ai = 0; ai < 2; ++ai)
#pragma unroll
            for (int m = 0; m < 4; ++m) { const int row = row0 + ai * HALF + m * 16;
                if (u.pn == 0) {
#pragma unroll
                    for (int bj = 0; bj < 2; ++bj) { float* lp = LOG + (size_t)row * NE + bj * HALF + wc * 32 + 8 * fq; *(f32x4*)lp = acc[ai][bj][m][0]; *(f32x4*)(lp + 4) = acc[ai][bj][m][1]; }
                } else {
                    const f32x4 g0 = acc[ai][0][m][0], g1 = acc[ai][0][m][1], u0 = acc[ai][1][m][0], u1 = acc[ai][1][m][1];
                    u32x4 w; w.x = cvt_pk_bf16(silu_mul(g0[0], u0[0]), silu_mul(g0[1], u0[1])); w.y = cvt_pk_bf16(silu_mul(g0[2], u0[2]), silu_mul(g0[3], u0[3]));
                    w.z = cvt_pk_bf16(silu_mul(g1[0], u1[0]), silu_mul(g1[1], u1[1])); w.w = cvt_pk_bf16(silu_mul(g1[2], u1[2]), silu_mul(g1[3], u1[3]));
                    *(u32x4*)(ACTS + (size_t)row * EFF + (u.pn - 1) * HALF + wc * 32 + 8 * fq) = w; } }
    }
};

struct EpiBf16RowScale {
    static constexpr bool PERM = true;
    bf16_t* O; int ldc; const LAS float* rtab;
    __device__ __forceinline__ void operator()(const f32x4 (&acc)[2][2][4][2], const Unit& u, int wr, int wc, int fr, int fq) const {
        const int row0 = u.pm * BM + wr * 64 + fr, col0 = u.pn * BM + wc * 32 + 8 * fq;
#pragma unroll
        for (int ai = 0; ai < 2; ++ai)
#pragma unroll
            for (int m = 0; m < 4; ++m) { const int row = row0 + ai * HALF + m * 16; bf16_t* rowp = O + (size_t)row * ldc + col0;
                const float g = rtab[2 * (row - u.pm * BM) + 1];
#pragma unroll
                for (int bj = 0; bj < 2; ++bj) { const f32x4 v0 = acc[ai][bj][m][0] * g, v1 = acc[ai][bj][m][1] * g;
                    u32x4 w; w.x = cvt_pk_bf16(v0[0], v0[1]); w.y = cvt_pk_bf16(v0[2], v0[3]); w.z = cvt_pk_bf16(v1[0], v1[1]); w.w = cvt_pk_bf16(v1[2], v1[3]);
                    *(u32x4*)(rowp + bj * HALF) = w; } }
    }
};

template <class Epi, class Sched, bool ALIGN_EPI, bool GATHER = false, bool MIDSCALE = false>
__device__ __forceinline__ void gemm_phase(LAS unsigned char* lds, const bf16_t* Abase_, int K, const Sched& S, const Epi& E, const float* stat = nullptr) {
    int tid_ = threadIdx.x; asm volatile("" : "+v"(tid_));
    const int tid = tid_, wid = __builtin_amdgcn_readfirstlane(tid >> 6), lane = tid & 63, wr = wid >> 2, wc = wid & 3, fr = lane & 15, fq = lane >> 4;
    const int nt = K / BK;
    const char* Abase = (const char*)Abase_;
    unsigned voffB[2], voffA[2];
#pragma unroll
    for (int i = 0; i < 2; ++i) { int R, C; stage_rc(tid * 16 + i * 8192, R, C); const int Rb = Epi::PERM ? ((R & ~31) + perm32(R & 31)) : R; voffB[i] = (unsigned)(Rb * K + C) * 2u; voffA[i] = (unsigned)(R * K + C) * 2u; }
    const size_t kstep = (size_t)(BK * 2);
    const size_t hstep = (size_t)HALF * K * 2;
    const unsigned ldsw = (unsigned)wid * 1024u;
    const int aoff = lds_byte(wr * 64 + fr, fq * 8), boff = lds_byte(wc * 32 + fr, fq * 8);
#define PG8_SA(b, h) (((b) * 2 + (h)) * HTB)
#define PG8_SB(b, h) ((4 + (b) * 2 + (h)) * HTB)
#define PG8_STAGE_B(bufoff, gbase) do { _Pragma("unroll") for (int _i = 0; _i < 2; ++_i) \
        __builtin_amdgcn_global_load_lds((const unsigned*)((const char*)(gbase) + voffB[_i]), (LAS unsigned*)(lds + (bufoff) + ldsw + _i * 8192), 16, 0, 0); } while (0)
#define PG8_STAGE_A(bufoff, ua, pa, h, koff) do { _Pragma("unroll") for (int _i = 0; _i < 2; ++_i) { \
        const char* _g = GATHER ? (Abase + (size_t)(ua)[h][_i] + (koff)) : ((pa) + (size_t)(h) * hstep + voffA[_i] + (koff)); \
        __builtin_amdgcn_global_load_lds((const unsigned*)_g, (LAS unsigned*)(lds + (bufoff) + ldsw + _i * 8192), 16, 0, 0); } } while (0)
#define PG8_LDA(dst, b, h) do { _Pragma("unroll") for (int m = 0; m < 4; ++m) _Pragma("unroll") for (int k = 0; k < 2; ++k) dst[m][k] = *(const LAS bf16x8*)(lds + PG8_SA(b, h) + aoff + m * 2048 + k * 1024); } while (0)
#define PG8_LDB(dst, b, h) do { _Pragma("unroll") for (int n = 0; n < 2; ++n) _Pragma("unroll") for (int k = 0; k < 2; ++k) dst[n][k] = *(const LAS bf16x8*)(lds + PG8_SB(b, h) + boff + n * 2048 + k * 1024); } while (0)
#define PG8_MMA(ai, bj, At, Bt) do { __builtin_amdgcn_s_setprio(1); _Pragma("unroll") for (int m = 0; m < 4; ++m) _Pragma("unroll") for (int n = 0; n < 2; ++n) _Pragma("unroll") for (int k = 0; k < 2; ++k) \
        acc[ai][bj][m][n] = __builtin_amdgcn_mfma_f32_16x16x32_bf16(Bt[n][k], At[m][k], acc[ai][bj][m][n], 0, 0, 0); __builtin_amdgcn_s_setprio(0); } while (0)
#define PG8_WAIT_V(n) asm volatile("s_waitcnt vmcnt(" #n ")" ::: "memory")
#define PG8_WAIT_L(n) asm volatile("s_waitcnt lgkmcnt(" #n ")" ::: "memory")
#define PG8_BAR __builtin_amdgcn_s_barrier()
#define PG8_SCHED __builtin_amdgcn_sched_barrier(0)
    Unit cur, nxt; int ui = 0;
    if (!S.next(0, cur)) return;
    f32x4 acc[2][2][4][2];
#pragma unroll
    for (int a = 0; a < 2; ++a)
#pragma unroll
        for (int b = 0; b < 2; ++b)
#pragma unroll
            for (int m = 0; m < 4; ++m)
#pragma unroll
                for (int n = 0; n < 2; ++n) acc[a][b][m][n] = (f32x4){0.f, 0.f, 0.f, 0.f};
    bf16x8 At[4][2], B0[2][2], B1[2][2];
    unsigned uc[2][2], un[2][2];
    if constexpr (GATHER) S.a_offsets(cur, tid, uc);
    const char* cA = Abase + (size_t)cur.rowbase * K * 2;
    const char* cB = S.b_tile(cur);
    PG8_STAGE_B(PG8_SB(0, 0), cB); PG8_STAGE_B(PG8_SB(0, 1), cB + hstep); PG8_STAGE_A(PG8_SA(0, 0), uc, cA, 0, (size_t)0); PG8_STAGE_A(PG8_SA(0, 1), uc, cA, 1, (size_t)0);
    if (wr == 1) PG8_BAR;
    PG8_WAIT_V(2); PG8_BAR;
    PG8_STAGE_B(PG8_SB(1, 0), cB + kstep); PG8_STAGE_A(PG8_SA(1, 0), uc, cA, 0, kstep); PG8_STAGE_B(PG8_SB(1, 1), cB + hstep + kstep);
    PG8_WAIT_V(6); PG8_BAR;
    for (;;) {
        const bool has_next = S.next(ui + 1, nxt);
        const bool lower = cur.nrows > wr * 64, upper = cur.nrows > HALF + wr * 64;
        const char* nB = cB; const char* nA = cA;
        if (has_next) { if constexpr (GATHER) S.a_offsets(nxt, tid, un); nB = S.b_tile(nxt); nA = Abase + (size_t)nxt.rowbase * K * 2; }
        else if constexpr (GATHER) {
#pragma unroll
            for (int h = 0; h < 2; ++h)
#pragma unroll
                for (int i = 0; i < 2; ++i) un[h][i] = uc[h][i];
        }
#pragma unroll 1
        for (int t = 0; t < nt; t += 2) {
            const bool last = (t == nt - 2);
            const size_t k1 = (size_t)(t + 1) * kstep;
            const size_t k2 = last ? (size_t)0 : (size_t)(t + 2) * kstep, k3 = k2 + kstep;
            const char* b2 = last ? nB : cB + (size_t)(t + 2) * kstep; const char* b3 = b2 + kstep;
            const char* a2 = last ? nA : cA;
            unsigned x2[2][2];
            if constexpr (GATHER) {
#pragma unroll
                for (int h = 0; h < 2; ++h)
#pragma unroll
                    for (int i = 0; i < 2; ++i) x2[h][i] = uc[h][i];
                if (last) { asm volatile("; next unit's A offsets" ::: "memory");
#pragma unroll
                    for (int h = 0; h < 2; ++h)
#pragma unroll
                        for (int i = 0; i < 2; ++i) x2[h][i] = un[h][i]; }
            }
            if constexpr (MIDSCALE) { if (t == nt / 2) {
#pragma unroll
                for (int ai = 0; ai < 2; ++ai)
#pragma unroll
                    for (int m = 0; m < 4; ++m) { const float f = ((const LAS float*)(lds + STAGE_BYTES))[2 * (ai * HALF + wr * 64 + m * 16 + fr)];
#pragma unroll
                        for (int bj = 0; bj < 2; ++bj)
#pragma unroll
                            for (int n = 0; n < 2; ++n) acc[ai][bj][m][n] *= f; } } }
            PG8_LDB(B0, 0, 0); PG8_LDB(B1, 0, 1); PG8_SCHED; PG8_LDA(At, 0, 0); PG8_STAGE_A(PG8_SA(1, 1), uc, cA, 1, k1);
            PG8_WAIT_V(8); PG8_WAIT_L(0); PG8_BAR; if (lower) { PG8_MMA(0, 0, At, B0); PG8_MMA(0, 1, At, B1); } PG8_BAR; PG8_SCHED;
            PG8_LDA(At, 0, 1); PG8_STAGE_B(PG8_SB(0, 0), b2); PG8_STAGE_B(PG8_SB(0, 1), b2 + hstep); PG8_STAGE_A(PG8_SA(0, 0), x2, a2, 0, k2);
            PG8_WAIT_V(8); PG8_WAIT_L(0); PG8_BAR; if (upper) { PG8_MMA(1, 0, At, B0); PG8_MMA(1, 1, At, B1); } PG8_BAR; PG8_SCHED;
            PG8_LDB(B0, 1, 0); PG8_LDB(B1, 1, 1); PG8_SCHED; PG8_LDA(At, 1, 0); PG8_STAGE_A(PG8_SA(0, 1), x2, a2, 1, k2);
            PG8_WAIT_V(8); PG8_WAIT_L(0); PG8_BAR; if (lower) { PG8_MMA(0, 0, At, B0); PG8_MMA(0, 1, At, B1); } PG8_BAR; PG8_SCHED;
            PG8_LDA(At, 1, 1); PG8_STAGE_B(PG8_SB(1, 0), b3); PG8_STAGE_B(PG8_SB(1, 1), b3 + hstep); PG8_STAGE_A(PG8_SA(1, 0), x2, a2, 0, k3);
            PG8_WAIT_V(8); PG8_WAIT_L(0); PG8_BAR; if (upper) { PG8_MMA(1, 0, At, B0); PG8_MMA(1, 1, At, B1); } PG8_BAR; PG8_SCHED;
        }
        if constexpr (ALIGN_EPI) { if (wr == 0) PG8_BAR; }
        E(acc, cur, wr, wc, fr, fq);
        if (!has_next) break;
#pragma unroll
        for (int a = 0; a < 2; ++a)
#pragma unroll
            for (int b = 0; b < 2; ++b)
#pragma unroll
                for (int m = 0; m < 4; ++m)
#pragma unroll
                    for (int n = 0; n < 2; ++n) acc[a][b][m][n] = (f32x4){0.f, 0.f, 0.f, 0.f};
        cur = nxt; cB = nB; cA = nA; ++ui;
        if constexpr (GATHER) {
#pragma unroll
            for (int h = 0; h < 2; ++h)
#pragma unroll
                for (int i = 0; i < 2; ++i) uc[h][i] = un[h][i];
        }
        if constexpr (ALIGN_EPI) { if (wr == 1) PG8_BAR; }
    }
    PG8_WAIT_V(0);
    if constexpr (!ALIGN_EPI) { if (wr == 0) PG8_BAR; }
    PG8_BAR;
#undef PG8_SA
#undef PG8_SB
#undef PG8_STAGE_A
#undef PG8_STAGE_B
#undef PG8_LDA
#undef PG8_LDB
#undef PG8_MMA
#undef PG8_WAIT_V
#undef PG8_WAIT_L
#undef PG8_BAR
#undef PG8_SCHED
}
}

__device__ __forceinline__ void cvt_item(const float* W, int ldw, int col0, int k0, bf16_t* WT, int drow0, int Kd, const float* gk, LAS float* scr, int lane) {
    const int kr = lane >> 3, n4 = lane & 7;
    float4 v[8];
#pragma unroll
    for (int i = 0; i < 8; ++i) v[i] = *(const float4*)&W[(size_t)(k0 + 8 * i + kr) * ldw + col0 + 4 * n4];
#pragma unroll
    for (int i = 0; i < 8; ++i) { const int kk = 8 * i + kr; const float g = gk ? gk[k0 + kk] : 1.f; LAS float* d = scr + kk * 33 + 4 * n4;
        d[0] = v[i].x * g; d[1] = v[i].y * g; d[2] = v[i].z * g; d[3] = v[i].w * g; }
    asm volatile("s_waitcnt lgkmcnt(0)" ::: "memory");
    const int cch = lane & 7;
#pragma unroll
    for (int j = 0; j < 4; ++j) { const int n = (lane >> 3) + 8 * j; const LAS float* sp = scr + (8 * cch) * 33 + n;
        uint4 o; o.x = pk2(sp[0 * 33], sp[1 * 33]); o.y = pk2(sp[2 * 33], sp[3 * 33]); o.z = pk2(sp[4 * 33], sp[5 * 33]); o.w = pk2(sp[6 * 33], sp[7 * 33]);
        *(uint4*)(WT + (size_t)(drow0 + n) * Kd + k0 + 8 * cch) = o; }
    asm volatile("s_waitcnt lgkmcnt(0)" ::: "memory");
}
#define PHASE_PTRS \
    unsigned char* wsp = args.ws; asm volatile("" : "+s"(wsp)); \
    const float* x = args.in[0]; const float* cvec = args.in[1]; const float* w_ada = args.in[2]; const float* b_ada = args.in[3]; \
    const float* g_pre_mix = args.in[4]; const float* g_post_mix = args.in[5]; const float* g_pre_ffn = args.in[6]; const float* g_post_ffn = args.in[7]; \
    const float* w_in = args.in[8]; const float* g_q_a = args.in[9]; const float* w_q_b = args.in[10]; const float* g_kv_a = args.in[11]; const float* w_kv_b = args.in[12]; \
    const float* g_q_head = args.in[13]; const float* g_k_head = args.in[14]; const float* g_mla_out = args.in[15]; const float* g_gqa_out = args.in[16]; \
    const float* w_out = args.in[17]; const float* w_router = args.in[18]; const float* b_router = args.in[19]; \
    const float* w_gate_e = args.in[20]; const float* w_up_e = args.in[21]; const float* w_down_e = args.in[22]; \
    const float* w_gate_s = args.in[23]; const float* w_up_s = args.in[24]; const float* w_down_s = args.in[25]; \
    float* mod = (float*)(wsp + WS_MOD); \
    float* cosm = (float*)(wsp + WS_COSM); float* sinm = (float*)(wsp + WS_SINM); float* cosg = (float*)(wsp + WS_COSG); float* sing = (float*)(wsp + WS_SING); \
    bf16_t* H2 = (bf16_t*)(wsp + WS_H2); \
    bf16_t* QM = (bf16_t*)(wsp + WS_QM); bf16_t* KM = (bf16_t*)(wsp + WS_KM); bf16_t* VM = (bf16_t*)(wsp + WS_VM); \
    bf16_t* QG = (bf16_t*)(wsp + WS_QG); bf16_t* KG = (bf16_t*)(wsp + WS_KG); bf16_t* VG = (bf16_t*)(wsp + WS_VG); \
    bf16_t* O = (bf16_t*)(wsp + WS_O); \
    bf16_t* X1 = (bf16_t*)(wsp + WS_X1); float* WTS = (float*)(wsp + WS_WTS); int* LIST = (int*)(wsp + WS_LIST); \
    bf16_t* SLOTS = (bf16_t*)(wsp + WS_SLOTS); int* POSREC = (int*)(wsp + WS_POSREC); float* OSTAT = (float*)(wsp + WS_OSTAT); \
    bf16_t* PBUF = (bf16_t*)(wsp + WS_PBUF); bf16_t* WBIGT = (bf16_t*)(wsp + WS_WBIGT); \
    bf16_t* WQBT = (bf16_t*)(wsp + WS_WQBT); bf16_t* WINQ = (bf16_t*)(wsp + WS_WINQ); bf16_t* WKVBT = (bf16_t*)(wsp + WS_WKVBT); bf16_t* WINKV = (bf16_t*)(wsp + WS_WINKV); \
    bf16_t* WOUTT = (bf16_t*)(wsp + WS_WOUTT); bf16_t* WRST = (bf16_t*)(wsp + WS_WRST); bf16_t* WDST = (bf16_t*)(wsp + WS_WDST); \
    bf16_t* WGUT = (bf16_t*)(wsp + WS_WGUT); bf16_t* WDT = (bf16_t*)(wsp + WS_WDT); \
    bf16_t* MIXED = (bf16_t*)(wsp + WS_MIXED); float* LOG = (float*)(wsp + WS_LOG); bf16_t* ACT = (bf16_t*)(wsp + WS_ACT); bf16_t* ACTS = (bf16_t*)(wsp + WS_ACTS); bf16_t* YSH = (bf16_t*)(wsp + WS_YSH);

__global__ void __launch_bounds__(NTHR, 2) mega(Args args) {
    extern __shared__ __attribute__((aligned(16))) unsigned char lds_raw[];
    unsigned char* ws = args.ws;
    unsigned* ctl = (unsigned*)(ws + WS_CTL);
    volatile LAS unsigned* bst = (volatile LAS unsigned*)(lds_raw + LDS_BYTES - 16);
    if (threadIdx.x < 4) bst[threadIdx.x] = 0u;
    const int nbk = gridDim.x, bidk = blockIdx.x;
    __syncthreads();
    XcdBarrier bar; bar.bar = ctl + CW_BAR; bar.x = 0; bar.st = bst;
    if (MK_N_LAUNCHES == 1) bar = xcd_barrier_post(ctl + CW_BAR, bst);
    const int lo = args.ph_lo, hi = args.ph_hi;
    const int vcu = (nbk % 8 == 0) ? (bidk % 8) * (nbk / 8) + bidk / 8 : bidk;
    LAS unsigned char* ldsb = (LAS unsigned char*)lds_raw;
#define IN(k) (lo <= (k) && (k) < hi && (pass_ == 0 || ((k) >= REP_FROM && (k) != 8)))
#define SEAM(k) do { if (lo <= (k) && (k) + 1 < hi && (pass_ == 0 || (k) >= REP_FROM)) xcd_barrier(bar); } while (0)

    unsigned* CNT = (unsigned*)(ws + WS_CNTS);

    for (int pass_ = 0; pass_ < (REP_FROM < 12 ? 2 : 1); ++pass_) {
    if (pass_) xcd_barrier(bar);
    if (IN(0)) for (int rep_ = 0; rep_ < (((REPEAT_MASK >> 0) & 1) ? 2 : 1); ++rep_) {
        const Ctx c = mkctx(ws, lds_raw); PHASE_PTRS
        float* red = c.lds;
        if (c.tid == 0) for (int e = c.bid; e < NE; e += c.nb) CNT[(size_t)e * CNT_STRIDE] = 0u;
        for (int g = c.bid; g < 192; g += c.nb) {
            const int c4 = c.tid & 7, kr = c.tid >> 3;
            float4 w[16];
#pragma unroll
            for (int i = 0; i < 16; ++i) w[i] = *(const float4*)&w_ada[(size_t)(64 * i + kr) * 6144 + g * 32 + 4 * c4];
            float4 a0 = make_float4(0.f, 0.f, 0.f, 0.f), a1 = a0;
#pragma unroll
            for (int i = 0; i < 16; ++i) { const int k = 64 * i + kr; const float c0 = cvec[k], c1 = cvec[DM + k]; const float f0 = c0 * sigmoidf_(c0), f1 = c1 * sigmoidf_(c1);
                a0.x += f0 * w[i].x; a0.y += f0 * w[i].y; a0.z += f0 * w[i].z; a0.w += f0 * w[i].w; a1.x += f1 * w[i].x; a1.y += f1 * w[i].y; a1.z += f1 * w[i].z; a1.w += f1 * w[i].w; }
            __syncthreads();
            *(float4*)&red[(kr * 8 + c4) * 4] = a0; *(float4*)&red[2048 + (kr * 8 + c4) * 4] = a1;
            __syncthreads();
            if (c.tid < 64) { const int b = c.tid >> 5, cc = c.tid & 31; float sacc = 0.f; for (int j = 0; j < 64; ++j) sacc += red[b * 2048 + j * 32 + cc]; mod[b * 6144 + g * 32 + cc] = sacc + b_ada[g * 32 + cc]; }
        }
        __syncthreads();
        for (int idx = c.bid * NTHR + c.tid; idx < SEQ * 16; idx += c.nb * NTHR) {
            const int s = idx >> 4, i = idx & 15, f = i & 7;
            const float inv = powf(10000.f, -(float)f / 8.f);
            const float pos = (float)((i < 8) ? (s >> 6) : (s & 63));
            const float ang = pos * inv;
            cosm[idx] = cosf(ang); sinm[idx] = sinf(ang);
        }
        for (int idx = c.bid * NTHR + c.tid; idx < SEQ * 32; idx += c.nb * NTHR) {
            const int s = idx >> 5, i = idx & 31, f = i & 15;
            const float inv = powf(10000.f, -(float)f / 16.f);
            const float pos = (float)((i < 16) ? (s >> 6) : (s & 63));
            const float ang = pos * inv;
            cosg[idx] = cosf(ang); sing[idx] = sinf(ang);
        }
        LAS float* scr = (LAS float*)(ldsb + 8192 + c.wave * 8448);
        constexpr int I_BIG = 37 * 16;
        constexpr int I_QB = 24 * 4;
        constexpr int I_KVB = 32 * 2;
        constexpr int I_OUT = 32 * 16;
        constexpr int I_RS = 24 * 16;
        constexpr int I_DS = 32 * 4;
        const int I_EXP = (c.nb == NE && (CONV_MODE == 1 || CONV_MODE == 5)) ? 0 : NE * 384;
        const int I_TOT = I_BIG + I_QB + I_KVB + I_OUT + I_RS + I_DS + I_EXP;
        for (int it = c.gw; it < I_TOT; it += c.ngw) {
            int r = it;
            if (r < I_BIG) { const int grp = r >> 4, kb = r & 15; const int col0 = grp * 32, drow = (grp < 13) ? grp * 32 : 2304 + (grp - 13) * 32;
                cvt_item(w_in, INC, col0, kb * 64, WBIGT, drow, DM, nullptr, scr, c.lane); continue; }
            r -= I_BIG;
            if (r < I_QB) { const int grp = r >> 2, kb = r & 3; cvt_item(w_q_b, 768, grp * 32, kb * 64, WQBT, grp * 32, 256, g_q_a, scr, c.lane); continue; }
            r -= I_QB;
            if (r < I_KVB) { const int grp = r >> 1, kb = r & 1; cvt_item(w_kv_b, 1024, grp * 32, kb * 64, WKVBT, grp * 32, 256, g_kv_a, scr, c.lane); continue; }
            r -= I_KVB;
            if (r < I_OUT) { const int grp = r >> 4, kb = r & 15; cvt_item(w_out, DM, grp * 32, kb * 64, WOUTT, grp * 32, DM, (kb < 8) ? g_mla_out : (g_gqa_out - 512), scr, c.lane); continue; }
            r -= I_OUT;
            if (r < I_RS) { const int grp = r >> 4, kb = r & 15;
                if (grp < 8) cvt_item(w_router, NE, grp * 32, kb * 64, WRST, grp * 32, DM, nullptr, scr, c.lane);
                else { const int q = grp - 8, blk = q >> 2, sub = q & 3;
                    cvt_item((blk & 1) ? w_up_s : w_gate_s, EFF, (blk >> 1) * 128 + sub * 32, kb * 64, WRST, 256 + blk * 128 + sub * 32, DM, nullptr, scr, c.lane); }
                continue; }
            r -= I_RS;
            if (r < I_DS) { const int grp = r >> 2, kb = r & 3; cvt_item(w_down_s, DM, grp * 32, kb * 64, WDST, grp * 32, EFF, nullptr, scr, c.lane); continue; }
            r -= I_DS;
            { const int e = r / 384, q = r % 384;
              if (q < 256) { const int up = q >> 7, q2 = q & 127, grp = q2 >> 4, kb = q2 & 15;
                  const int drow = ((grp < 4) ? grp * 32 : 256 + (grp - 4) * 32) + up * 128;
                  cvt_item((up ? w_up_e : w_gate_e) + (size_t)e * DM * EFF, EFF, grp * 32, kb * 64, WGUT + (size_t)e * 512 * DM, drow, DM, nullptr, scr, c.lane); }
              else { const int q2 = q - 256, grp = q2 >> 2, kb = q2 & 3;
                  cvt_item(w_down_e + (size_t)e * EFF * DM, DM, grp * 32, kb * 64, WDT + (size_t)e * DM * EFF, grp * 32, EFF, nullptr, scr, c.lane); } }
        }
        const int gt = c.bid * NTHR + c.tid, ngt = c.nb * NTHR;
        for (int i = gt; i < 96 * 1024 / 8; i += ngt) *(uint4*)(WBIGT + (size_t)416 * DM + (size_t)i * 8) = make_uint4(0u, 0u, 0u, 0u);
        for (int i = gt; i < 1024 * 16; i += ngt) { const int n = i >> 4, q = i & 15; *(uint4*)(WKVBT + (size_t)n * 256 + 128 + q * 8) = make_uint4(0u, 0u, 0u, 0u); }
        for (int i = gt; i < 1024 * 64; i += ngt) { const int k = i >> 6, q = i & 63; const float4 v = *(const float4*)&w_in[(size_t)k * INC + q * 4]; uint2 o; o.x = pk2(v.x, v.y); o.y = pk2(v.z, v.w); *(uint2*)(WINQ + (size_t)k * 256 + q * 4) = o; }
        for (int i = gt; i < 1024 * 64; i += ngt) { const int k = i >> 6, q = i & 63; uint2 o = make_uint2(0u, 0u);
            if (q < 32) { const float4 v = *(const float4*)&w_in[(size_t)k * INC + 256 + q * 4]; o.x = pk2(v.x, v.y); o.y = pk2(v.z, v.w); }
            *(uint2*)(WINKV + (size_t)k * 256 + q * 4) = o; }
    }
    SEAM(0);

    if (IN(1)) for (int rep_ = 0; rep_ < (((REPEAT_MASK >> 1) & 1) ? 2 : 1); ++rep_) {
        const Ctx c = mkctx(ws, lds_raw); PHASE_PTRS
        for (int i = c.bid * NTHR + c.tid; i < 2 * 4 * DM; i += c.nb * NTHR) { const int b = i >> 12, k = (i >> 10) & 3, cc = i & 1023; const float* md = mod + b * 6144;
            ((float*)(wsp + WS_COEF))[i] = (k == 0) ? md[2048 + cc] * g_post_mix[cc] : (k == 1) ? g_pre_ffn[cc] * (1.f + md[4096 + cc]) : (k == 2) ? md[3072 + cc] : md[5120 + cc] * g_post_ffn[cc]; }
        { pg8::DenseOrder S; S.init(768, 1024, 256, WINQ, c.nb, c.bid); pg8::EpiBf16 E{WBIGT + (size_t)512 * DM, DM};
          pg8::gemm_phase<pg8::EpiBf16, pg8::DenseOrder, true>(ldsb, WQBT, 256, S, E); }
        { pg8::DenseOrder S; S.init(1024, 1024, 256, WINKV, c.nb, (c.bid >= 12 && c.nb >= 28) ? c.bid - 12 : c.bid + (c.nb >= 28 ? c.nb : 0)); pg8::EpiBf16 E{WBIGT + (size_t)1280 * DM, DM};
          pg8::gemm_phase<pg8::EpiBf16, pg8::DenseOrder, true>(ldsb, WKVBT, 256, S, E); }
        const bool hsplit = c.nb >= 56; const int hw = hsplit ? c.gw - 28 * 8 : c.gw, nhw = hsplit ? c.ngw - 28 * 8 : c.ngw;
        if (hw >= 0) {
            float4 nv[2][4];
#pragma unroll
            for (int q = 0; q < 2; ++q) { const int m = (hw + q * nhw < NTOK) ? hw + q * nhw : hw;
#pragma unroll
                for (int j = 0; j < 4; ++j) nv[q][j] = *(const float4*)&x[(size_t)m * DM + 4 * c.lane + 256 * j]; }
            for (int m0 = hw; m0 < NTOK; m0 += 2 * nhw) {
                float4 v[2][4];
#pragma unroll
                for (int q = 0; q < 2; ++q)
#pragma unroll
                    for (int j = 0; j < 4; ++j) v[q][j] = nv[q][j];
                const int m0n = m0 + 2 * nhw;
                if (m0n < NTOK) {
#pragma unroll
                    for (int q = 0; q < 2; ++q) { const int m = (m0n + q * nhw < NTOK) ? m0n + q * nhw : m0n;
#pragma unroll
                        for (int j = 0; j < 4; ++j) nv[q][j] = *(const float4*)&x[(size_t)m * DM + 4 * c.lane + 256 * j]; }
                }
#pragma unroll
                for (int q = 0; q < 2; ++q) {
                    const int m = (m0 + q * nhw < NTOK) ? m0 + q * nhw : m0; const int b = m / SEQ; const float* md = mod + b * 6144;
                    float4 g[4], sc[4], sh[4];
#pragma unroll
                    for (int j = 0; j < 4; ++j) { const int cc = 4 * c.lane + 256 * j; g[j] = *(const float4*)&g_pre_mix[cc]; sc[j] = *(const float4*)&md[1024 + cc]; sh[j] = *(const float4*)&md[cc]; }
                    float ss = 0.f;
#pragma unroll
                    for (int j = 0; j < 4; ++j) ss += v[q][j].x * v[q][j].x + v[q][j].y * v[q][j].y + v[q][j].z * v[q][j].z + v[q][j].w * v[q][j].w;
                    const float rstd = rsqrtf(wave_sum(ss) * (1.f / DM) + EPS);
#pragma unroll
                    for (int j = 0; j < 4; ++j) {
                        const int cc = 4 * c.lane + 256 * j;
                        uint2 o;
                        o.x = pk2(v[q][j].x * rstd * g[j].x * (1.f + sc[j].x) + sh[j].x, v[q][j].y * rstd * g[j].y * (1.f + sc[j].y) + sh[j].y);
                        o.y = pk2(v[q][j].z * rstd * g[j].z * (1.f + sc[j].z) + sh[j].z, v[q][j].w * rstd * g[j].w * (1.f + sc[j].w) + sh[j].w);
                        *(uint2*)&H2[(size_t)m * DM + cc] = o;
                    }
                }
            }
        }
    }
    SEAM(1);

    if (IN(2)) for (int rep_ = 0; rep_ < (((REPEAT_MASK >> 2) & 1) ? 2 : 1); ++rep_) {
        const Ctx c = mkctx(ws, lds_raw); PHASE_PTRS
        pg8::DenseOrder S; S.init(NTOK, 3072, DM, WBIGT, c.nb, c.bid); pg8::EpiBf16 E{PBUF, 3072};
        pg8::gemm_phase<pg8::EpiBf16, pg8::DenseOrder, true>(ldsb, H2, DM, S, E);
    }
    SEAM(2);

    if (IN(3)) for (int rep_ = 0; rep_ < (((REPEAT_MASK >> 3) & 1) ? 2 : 1); ++rep_) {
        const Ctx c = mkctx(ws, lds_raw); PHASE_PTRS
        unsigned* kmaxL = (unsigned*)lds_raw;
        if (c.tid < 18) kmaxL[c.tid] = 0u;
        __syncthreads();
        uint4 nraw[6];
#pragma unroll
        for (int j = 0; j < 6; ++j) nraw[j] = *(const uint4*)(PBUF + (size_t)c.gw * 3072 + 512 * j + 8 * c.lane);
        for (int m = c.gw; m < NTOK; m += c.ngw) {
            const int b = m / SEQ, s = m % SEQ;
            uint4 raw[6];
#pragma unroll
            for (int j = 0; j < 6; ++j) raw[j] = nraw[j];
            if (m + c.ngw < NTOK) {
#pragma unroll
                for (int j = 0; j < 6; ++j) nraw[j] = *(const uint4*)(PBUF + (size_t)(m + c.ngw) * 3072 + 512 * j + 8 * c.lane);
            }
            float rq, rkv;
            {
                float v[8]; { const uint4 u = raw[0]; v[0] = bf2f(u.x & 0xffffu); v[1] = bf2f(u.x >> 16); v[2] = bf2f(u.y & 0xffffu); v[3] = bf2f(u.y >> 16); v[4] = bf2f(u.z & 0xffffu); v[5] = bf2f(u.z >> 16); v[6] = bf2f(u.w & 0xffffu); v[7] = bf2f(u.w >> 16); }
                float sq = 0.f;
#pragma unroll
                for (int i = 0; i < 8; ++i) sq += v[i] * v[i];
                rq = rsqrtf(wave_sum(c.lane < 32 ? sq : 0.f) * (1.f / QLORA) + EPS);
                rkv = rsqrtf(wave_sum((c.lane >= 32 && c.lane < 48) ? sq : 0.f) * (1.f / KVLORA) + EPS);
                if (c.lane >= 48 && c.lane < 52) {
                    const int i0 = 4 * (c.lane - 48); uint4 o; unsigned ow[4];
#pragma unroll
                    for (int pq = 0; pq < 4; ++pq) { const float cs = cosm[s * 16 + i0 + pq], sn = sinm[s * 16 + i0 + pq]; ow[pq] = pk2(v[2 * pq] * cs - v[2 * pq + 1] * sn, v[2 * pq] * sn + v[2 * pq + 1] * cs); }
                    o.x = ow[0]; o.y = ow[1]; o.z = ow[2]; o.w = ow[3];
#pragma unroll
                    for (int h = 0; h < MH; ++h) *(uint4*)&KM[((size_t)(b * MH + h) * SEQ + s) * DQKM + MNOPE + 2 * i0] = o;
                    float pq = 0.f;
#pragma unroll
                    for (int i = 0; i < 8; ++i) pq += v[i] * v[i];
                    pq += dppmov<0xB1, 0xF>(0.f, pq); pq += dppmov<0x4E, 0xF>(0.f, pq);
                    if (c.lane == 48) atomicMax(&kmaxL[16 + b], __builtin_bit_cast(unsigned, pq));
                }
            }
#pragma unroll
            for (int j = 1; j < 6; ++j) {
                const int col0 = 512 * j + 8 * c.lane;
                float v[8]; { const uint4 u = raw[j]; v[0] = bf2f(u.x & 0xffffu); v[1] = bf2f(u.x >> 16); v[2] = bf2f(u.y & 0xffffu); v[3] = bf2f(u.y >> 16); v[4] = bf2f(u.z & 0xffffu); v[5] = bf2f(u.z >> 16); v[6] = bf2f(u.w & 0xffffu); v[7] = bf2f(u.w >> 16); }
                if (col0 < 1280) {
                    const int qc = col0 - 512, h = qc / DQKM, d0 = qc % DQKM; const float sc = rq * C2M;
                    uint4 o; unsigned ow[4];
                    if (d0 >= MNOPE) { const int i0 = (d0 - MNOPE) >> 1;
#pragma unroll
                        for (int pq = 0; pq < 4; ++pq) { const float cs = cosm[s * 16 + i0 + pq], sn = sinm[s * 16 + i0 + pq]; ow[pq] = pk2((v[2 * pq] * cs - v[2 * pq + 1] * sn) * sc, (v[2 * pq] * sn + v[2 * pq + 1] * cs) * sc); }
                    } else {
#pragma unroll
                        for (int pq = 0; pq < 4; ++pq) ow[pq] = pk2(v[2 * pq] * sc, v[2 * pq + 1] * sc);
                    }
                    o.x = ow[0]; o.y = ow[1]; o.z = ow[2]; o.w = ow[3];
                    *(uint4*)&QM[((size_t)(b * MH + h) * SEQ + s) * DQKM + d0] = o;
                } else if (col0 < 2304) {
                    const int kc = col0 - 1280, h = kc >> 7, d0 = kc & 127;
                    uint4 o; o.x = pk2(v[0] * rkv, v[1] * rkv); o.y = pk2(v[2] * rkv, v[3] * rkv); o.z = pk2(v[4] * rkv, v[5] * rkv); o.w = pk2(v[6] * rkv, v[7] * rkv);
                    if (d0 < MNOPE) { *(uint4*)&KM[((size_t)(b * MH + h) * SEQ + s) * DQKM + d0] = o;
                        float kq = 0.f;
#pragma unroll
                        for (int i = 0; i < 8; ++i) kq += (v[i] * rkv) * (v[i] * rkv);
                        kq += dppmov<0xB1, 0xF>(0.f, kq); kq += dppmov<0x4E, 0xF>(0.f, kq); kq += dppmov<0x141, 0xF>(0.f, kq);
                        if ((c.lane & 7) == 0) atomicMax(&kmaxL[b * 8 + h], __builtin_bit_cast(unsigned, kq)); }
                    else *(uint4*)&VM[((size_t)(b * MH + h) * SEQ + s) * MV + (d0 - MNOPE)] = o;
                } else if (col0 < 2944) {
                    const bool isq = col0 < 2816; const int hc = isq ? (col0 - 2304) : (col0 - 2816), h = hc >> 6, d0 = hc & 63;
                    float sq = 0.f;
#pragma unroll
                    for (int i = 0; i < 8; ++i) sq += v[i] * v[i];
                    sq += __shfl_xor(sq, 1); sq += __shfl_xor(sq, 2); sq += __shfl_xor(sq, 4);
                    const float rs = rsqrtf(sq * (1.f / GD) + EPS) * (isq ? C2G : 1.f); const float* gh = isq ? g_q_head : g_k_head;
                    uint4 o; unsigned ow[4];
#pragma unroll
                    for (int pq = 0; pq < 4; ++pq) { const int d = d0 + 2 * pq; const float cs = cosg[s * 32 + (d >> 1)], sn = sing[s * 32 + (d >> 1)];
                        const float x0 = v[2 * pq] * rs * gh[d], x1 = v[2 * pq + 1] * rs * gh[d + 1]; ow[pq] = pk2(x0 * cs - x1 * sn, x0 * sn + x1 * cs); }
                    o.x = ow[0]; o.y = ow[1]; o.z = ow[2]; o.w = ow[3];
                    if (isq) *(uint4*)&QG[((size_t)(b * GH + h) * SEQ + s) * GD + d0] = o;
                    else *(uint4*)&KG[((size_t)(b * GKV + h) * SEQ + s) * GD + d0] = o;
                } else {
                    const int hc = col0 - 2944, h = hc >> 6, d0 = hc & 63;
                    *(uint4*)&VG[((size_t)(b * GKV + h) * SEQ + s) * GD + d0] = raw[j];
                }
            }
        }
        __syncthreads();
        if (c.tid < 18) atomicMax(ctl + CW_KMAX + c.tid, kmaxL[c.tid]);
    }
    SEAM(3);

    if (IN(4)) for (int rep_ = 0; rep_ < (((REPEAT_MASK >> 4) & 1) ? 2 : 1); ++rep_) {
        const Ctx c = mkctx(ws, lds_raw); PHASE_PTRS
        att::ConvState cs;
        { const int e = (c.nb == NE) ? c.bid : 0;
          cs.cj = 0; cs.jbase = 384 * c.wave;
          cs.wg = (const char*)(w_gate_e + (size_t)e * DM * EFF); cs.wu = (const char*)(w_up_e + (size_t)e * DM * EFF); cs.wd = (const char*)(w_down_e + (size_t)e * EFF * DM);
          cs.dgu = (char*)(WGUT + (size_t)e * 512 * DM); cs.dd = (char*)(WDT + (size_t)e * DM * EFF);
          cs.ldsbuf = (unsigned)(uintptr_t)lds_raw + att::CONV_LDS + (CONV_MODE >= 5 ? 0 : c.wave * 4096); cs.rdbuf = (att::lds_cptr)lds_raw + att::CONV_LDS + (CONV_MODE >= 5 ? 0 : c.wave * 4096);
          if (CONV_MODE >= 5) cs.jbase = 0;
          if (CONV_MODE != 0 && CONV_MODE < 5) for (int i = 0; i < 3; ++i) { const att::ConvJob q = att::conv_job(cs, cs.cj);
              att::glds16_s(q.sbase, (unsigned)(c.lane >> 3) * q.ldwB + (unsigned)(c.lane & 7) * 16u, (unsigned)__builtin_amdgcn_readfirstlane(cs.ldsbuf + (cs.cj & 3) * 1024)); ++cs.cj; }
          asm volatile("s_waitcnt vmcnt(0)" ::: "memory"); }
        float mfix;
        { const float gq = wave_max(fabsf(g_q_head[c.lane])), gk = wave_max(fabsf(g_k_head[c.lane])); mfix = fminf(64.f * C2G * gq * gk * 1.03f + 0.5f, 60.f); }
        for (int uu = vcu; uu < 512; uu += c.nb) {
            const int bh = uu >> 5, b = bh >> 3, h = bh & 7, qp = uu & 31;
            const int q0 = qp * 256;
            const float kb2 = __builtin_bit_cast(float, ctl[CW_KMAX + b * 8 + h]) + __builtin_bit_cast(float, ctl[CW_KMAX + 16 + b]);
            att::unit96<8>(QM + (size_t)(b * MH + h) * SEQ * DQKM, KM + (size_t)(b * MH + h) * SEQ * DQKM, VM + (size_t)(b * MH + h) * SEQ * MV,
                                 O + ((size_t)b * SEQ + q0) * DM + h * 64, OSTAT + ((size_t)b * SEQ + q0) * 16 + h, q0, (char*)lds_raw, cs, kb2);
            att::unit64<8>(QG + (size_t)(b * GH + h) * SEQ * GD, KG + (size_t)(b * GKV + (h >> 2)) * SEQ * GD, VG + (size_t)(b * GKV + (h >> 2)) * SEQ * GD,
                                 O + ((size_t)b * SEQ + q0) * DM + (8 + h) * 64, OSTAT + ((size_t)b * SEQ + q0) * 16 + 8 + h, q0, (char*)lds_raw, cs, mfix);
        }
#if CONV_MODE >= 5
        {
            using namespace att;
            const int wid = c.wave, lane = c.lane; const bool rst = wid >= 6;
            for (int r4 = 0; r4 < 3; ++r4) { CONV_DRAIN(); ++cs.cj; }
        }
#endif
    }
    SEAM(4);

    if (IN(5)) for (int rep_ = 0; rep_ < (((REPEAT_MASK >> 5) & 1) ? 2 : 1); ++rep_) {
        const Ctx c = mkctx(ws, lds_raw); PHASE_PTRS
        pg8::DenseOrder S; S.init(NTOK, DM, DM, WOUTT, c.nb, c.bid);
        LAS float* rtab = (LAS float*)(ldsb + pg8::STAGE_BYTES);
        { pg8::Unit u0; if (S.next(0, u0) && c.tid < 256) { const float4* sp = (const float4*)&OSTAT[(size_t)(u0.pm * 256 + c.tid) * 16]; const float4 s0 = sp[0], s1 = sp[1], s2 = sp[2], s3 = sp[3];
            const float sm = ((s0.x + s0.y) + (s0.z + s0.w)) + ((s1.x + s1.y) + (s1.z + s1.w)), sg = ((s2.x + s2.y) + (s2.z + s2.w)) + ((s3.x + s3.y) + (s3.z + s3.w));
            const float rm = rsqrtf(sm * (1.f / 512) + EPS), rg = rsqrtf(sg * (1.f / 512) + EPS); rtab[2 * c.tid] = rm / rg; rtab[2 * c.tid + 1] = rg; }
          __syncthreads(); }
        pg8::EpiBf16RowScale E{MIXED, DM, rtab};
        pg8::gemm_phase<pg8::EpiBf16RowScale, pg8::DenseOrder, true, false, true>(ldsb, O, DM, S, E, nullptr);
    }
    SEAM(5);

    if (IN(6)) for (int rep_ = 0; rep_ < (((REPEAT_MASK >> 6) & 1) ? 2 : 1); ++rep_) {
        const Ctx c = mkctx(ws, lds_raw); PHASE_PTRS
        {
            const float* COEF = (const float*)(wsp + WS_COEF);
            uint2 nmu[2][4]; float4 nxq[2][4];
#pragma unroll
            for (int q = 0; q < 2; ++q) { const int m = (c.gw + q * c.ngw < NTOK) ? c.gw + q * c.ngw : c.gw;
#pragma unroll
                for (int j = 0; j < 4; ++j) { nmu[q][j] = *(const uint2*)&MIXED[(size_t)m * DM + 4 * c.lane + 256 * j]; nxq[q][j] = *(const float4*)&x[(size_t)m * DM + 4 * c.lane + 256 * j]; } }
            for (int m0 = c.gw; m0 < NTOK; m0 += 2 * c.ngw) {
                uint2 mu[2][4]; float4 xq[2][4];
#pragma unroll
                for (int q = 0; q < 2; ++q)
#pragma unroll
                    for (int j = 0; j < 4; ++j) { mu[q][j] = nmu[q][j]; xq[q][j] = nxq[q][j]; }
                const int m0n = m0 + 2 * c.ngw;
                if (m0n < NTOK) {
#pragma unroll
                    for (int q = 0; q < 2; ++q) { const int m = (m0n + q * c.ngw < NTOK) ? m0n + q * c.ngw : m0n;
#pragma unroll
                        for (int j = 0; j < 4; ++j) { nmu[q][j] = *(const uint2*)&MIXED[(size_t)m * DM + 4 * c.lane + 256 * j]; nxq[q][j] = *(const float4*)&x[(size_t)m * DM + 4 * c.lane + 256 * j]; } }
                }
#pragma unroll
                for (int q = 0; q < 2; ++q) {
                    const int m = (m0 + q * c.ngw < NTOK) ? m0 + q * c.ngw : m0; const int b = m / SEQ; const float* cf = COEF + b * 4096;
                    float4 ca[4], cb[4], cd[4];
#pragma unroll
                    for (int j = 0; j < 4; ++j) { const int cc = 4 * c.lane + 256 * j; ca[j] = *(const float4*)&cf[cc]; cb[j] = *(const float4*)&cf[1024 + cc]; cd[j] = *(const float4*)&cf[2048 + cc]; }
                    float4 v[4], xr[4]; float ss = 0.f;
#pragma unroll
                    for (int j = 0; j < 4; ++j) { const uint2 u = mu[q][j];
                        v[j].x = bf2f(u.x & 0xffffu); v[j].y = bf2f(u.x >> 16); v[j].z = bf2f(u.y & 0xffffu); v[j].w = bf2f(u.y >> 16);
                        ss += v[j].x * v[j].x + v[j].y * v[j].y + v[j].z * v[j].z + v[j].w * v[j].w; }
                    const float rstd = rsqrtf(wave_sum(ss) * (1.f / DM) + EPS);
                    float ss1 = 0.f;
#pragma unroll
                    for (int j = 0; j < 4; ++j) {
                        const int cc = 4 * c.lane + 256 * j; const float4 xx = xq[q][j];
                        xr[j].x = xx.x + ca[j].x * (v[j].x * rstd); xr[j].y = xx.y + ca[j].y * (v[j].y * rstd);
                        xr[j].z = xx.z + ca[j].z * (v[j].z * rstd); xr[j].w = xx.w + ca[j].w * (v[j].w * rstd);
                        ss1 += xr[j].x * xr[j].x + xr[j].y * xr[j].y + xr[j].z * xr[j].z + xr[j].w * xr[j].w;
                        { uint2 xo; xo.x = pk2(xr[j].x, xr[j].y); xo.y = pk2(xr[j].z, xr[j].w); *(uint2*)&X1[(size_t)m * DM + cc] = xo; }
                    }
                    const float rstd1 = rsqrtf(wave_sum(ss1) * (1.f / DM) + EPS);
#pragma unroll
                    for (int j = 0; j < 4; ++j) {
                        const int cc = 4 * c.lane + 256 * j;
                        uint2 pk;
                        pk.x = pk2(xr[j].x * rstd1 * cb[j].x + cd[j].x, xr[j].y * rstd1 * cb[j].y + cd[j].y);
                        pk.y = pk2(xr[j].z * rstd1 * cb[j].z + cd[j].z, xr[j].w * rstd1 * cb[j].w + cd[j].w);
                        *(uint2*)&H2[(size_t)m * DM + cc] = pk;
                    }
                }
            }
        }
    }
    SEAM(6);

    if (IN(7)) for (int rep_ = 0; rep_ < (((REPEAT_MASK >> 7) & 1) ? 2 : 1); ++rep_) {
        const Ctx c = mkctx(ws, lds_raw); PHASE_PTRS
        pg8::DenseOrder S; S.init(NTOK, 768, DM, WRST, c.nb, c.bid); pg8::EpiRS E{LOG, ACTS};
        pg8::gemm_phase<pg8::EpiRS, pg8::DenseOrder, true>(ldsb, H2, DM, S, E);
    }
    SEAM(7);

    if (IN(8)) for (int rep_ = 0; rep_ < (((REPEAT_MASK >> 8) & 1) ? 2 : 1); ++rep_) {
        const Ctx c = mkctx(ws, lds_raw); PHASE_PTRS
        const float4 bb = *(const float4*)&b_router[4 * c.lane];
        const unsigned rowL = (unsigned)(uintptr_t)lds_raw + c.wave * 8192;
        const LAS unsigned char* rowP = ldsb + c.wave * 8192;
        const bool cnt_sort = (MK_N_LAUNCHES == 1) && c.nb == NE && 8 * c.ngw == NTOK && lo < 8 && hi > 9;
        int* histg = (int*)(lds_raw + 65536); int* HIST = (int*)(wsp + WS_HIST);
        if (cnt_sort) { if (c.tid < NE) histg[c.tid] = 0; __syncthreads(); }
        for (int mb = c.gw; mb < NTOK; mb += 8 * c.ngw) {
#pragma unroll
          for (int r = 0; r < 8; ++r) { const int mr = mb + r * c.ngw; if (mr < NTOK) att::glds16(LOG + (size_t)mr * NE + 4 * c.lane, (unsigned)__builtin_amdgcn_readfirstlane(rowL + r * 1024)); }
          asm volatile("s_waitcnt vmcnt(0)" ::: "memory");
          int my_e = 0; float my_s = 0.f; int rb = 0;
#pragma unroll 1
          for (int m = mb; m < NTOK && rb < 8; m += c.ngw) {
            typedef float f32x4v __attribute__((ext_vector_type(4)));
            const f32x4v lg = *(const LAS f32x4v*)(rowP + rb * 1024 + c.lane * 16);
            const float s0 = __builtin_amdgcn_rcpf(1.f + __builtin_amdgcn_exp2f(lg.x * -1.44269504f)), s1 = __builtin_amdgcn_rcpf(1.f + __builtin_amdgcn_exp2f(lg.y * -1.44269504f));
            const float s2 = __builtin_amdgcn_rcpf(1.f + __builtin_amdgcn_exp2f(lg.z * -1.44269504f)), s3 = __builtin_amdgcn_rcpf(1.f + __builtin_amdgcn_exp2f(lg.w * -1.44269504f));
            const int o0 = ford(s0 + bb.x), o1 = ford(s1 + bb.y), o2 = ford(s2 + bb.z), o3 = ford(s3 + bb.w);
            const int e0 = 4 * c.lane, g = c.lane >> 3;
            const int IMIN = (int)0x80000000;
            int gkey;
            {
                const int h01 = imax_(o0, o1), l01 = imin_(o0, o1), h23 = imax_(o2, o3), l23 = imin_(o2, o3);
                const int a1 = imax_(h01, h23), a2 = imax_(imin_(h01, h23), (h01 >= h23) ? l01 : l23);
                const int g1 = grp8_max_i(a1);
                const unsigned long long bm = __ballot(a1 == g1);
                const unsigned grpbits = (unsigned)(bm >> (8 * g)) & 0xffu;
                const bool first = (a1 == g1) && ((grpbits & ((1u << (c.lane & 7)) - 1u)) == 0u);
                const int g2 = grp8_max_i(first ? a2 : a1);
                gkey = (ford(funord(g1) + funord(g2)) & ~7) | (7 - g);
            }
            int rank = 0;
#pragma unroll
            for (int j = 0; j < 8; ++j) rank += (__builtin_amdgcn_readlane(gkey, 8 * j) > gkey) ? 1 : 0;
            const bool sel = rank < 4;
            int k0 = sel ? ((o0 & ~0xff) | (255 - e0)) : IMIN, k1 = sel ? ((o1 & ~0xff) | (254 - e0)) : IMIN, k2 = sel ? ((o2 & ~0xff) | (253 - e0)) : IMIN, k3 = sel ? ((o3 & ~0xff) | (252 - e0)) : IMIN;
            int my_key = 0;
#pragma unroll 1
            for (int rnd = 0; rnd < TOPK; ++rnd) {
                const int mx = wave_max_i(imax_(imax_(k0, k1), imax_(k2, k3)));
                if (c.lane == 8 * rb + rnd) my_key = mx;
                k0 = (k0 == mx) ? IMIN : k0; k1 = (k1 == mx) ? IMIN : k1; k2 = (k2 == mx) ? IMIN : k2; k3 = (k3 == mx) ? IMIN : k3;
            }
            {
                const int ee = 255 - (my_key & 0xff), src = (ee >> 2) * 4;
                const float q0 = __builtin_bit_cast(float, __builtin_amdgcn_ds_bpermute(src, __builtin_bit_cast(int, s0))), q1 = __builtin_bit_cast(float, __builtin_amdgcn_ds_bpermute(src, __builtin_bit_cast(int, s1)));
                const float q2 = __builtin_bit_cast(float, __builtin_amdgcn_ds_bpermute(src, __builtin_bit_cast(int, s2))), q3 = __builtin_bit_cast(float, __builtin_amdgcn_ds_bpermute(src, __builtin_bit_cast(int, s3)));
                if ((c.lane >> 3) == rb) { my_e = ee; my_s = (ee & 2) ? ((ee & 1) ? q3 : q2) : ((ee & 1) ? q1 : q0); }
            }
            ++rb;
          }
          { const int rr = c.lane >> 3, k = c.lane & 7;
            const float tot = grp8_sum(my_s);
            const bool valid = rr < rb; const int id = (mb + rr * c.ngw) * TOPK + k; const float wt = my_s / tot * 2.5f;
            if (!cnt_sort) {
                if (valid) { const unsigned pos = atomicAdd(&CNT[(size_t)my_e * CNT_STRIDE], 1u);
                    LIST[(size_t)my_e * LCAP + pos] = id; POSREC[id] = (my_e << 16) | (int)pos; WTS[id] = wt; }
            } else {
                int lpos = 0; if (valid) lpos = atomicAdd(&histg[my_e], 1);
                __syncthreads();
                if (c.tid < 64) HIST[c.bid * 64 + c.tid] = histg[4 * c.tid] | (histg[4 * c.tid + 1] << 8) | (histg[4 * c.tid + 2] << 16) | (histg[4 * c.tid + 3] << 24);
                xcd_barrier(bar);
                { const int rg = c.tid >> 4, eb = c.tid & 15;
                  uint4 hv[8];
#pragma unroll
                  for (int j = 0; j < 8; ++j) { const int w = rg + 32 * j; hv[j] = make_uint4(0u, 0u, 0u, 0u); if (w < c.bid) hv[j] = *(const uint4*)&HIST[w * 64 + eb * 4]; }
                  int acc[16];
#pragma unroll
                  for (int i = 0; i < 16; ++i) acc[i] = 0;
#pragma unroll
                  for (int j = 0; j < 8; ++j) { const unsigned wd[4] = {hv[j].x, hv[j].y, hv[j].z, hv[j].w};
#pragma unroll
                      for (int q = 0; q < 4; ++q) { acc[4 * q] += (int)(wd[q] & 0xffu); acc[4 * q + 1] += (int)((wd[q] >> 8) & 0xffu); acc[4 * q + 2] += (int)((wd[q] >> 16) & 0xffu); acc[4 * q + 3] += (int)(wd[q] >> 24); } }
#pragma unroll
                  for (int q = 0; q < 4; ++q) *(int4*)&histg[1024 + rg * NE + eb * 16 + 4 * q] = make_int4(acc[4 * q], acc[4 * q + 1], acc[4 * q + 2], acc[4 * q + 3]); }
                __syncthreads();
                if (c.tid < NE) { int bs = 0;
#pragma unroll
                    for (int r = 0; r < 32; ++r) bs += histg[1024 + r * NE + c.tid];
                    histg[768 + c.tid] = bs; if (c.bid == c.nb - 1) HIST[NE * NE + c.tid] = bs + histg[c.tid]; }
                __syncthreads();
                if (valid) { const int pos = histg[768 + my_e] + lpos;
                    LIST[(size_t)my_e * LCAP + pos] = id; POSREC[id] = (my_e << 16) | pos; WTS[id] = wt; }
            } }
        }
    }
    SEAM(8);

    LAS int* pre = (LAS int*)(ldsb + pg8::STAGE_BYTES);
    LAS int* offs = pre + 320; LAS int* cntl = offs + 320;
    if (IN(9) || IN(10) || IN(11)) {
        const Ctx c = mkctx(ws, lds_raw); PHASE_PTRS
        __syncthreads();
        if (c.tid < NE) cntl[c.tid] = ((MK_N_LAUNCHES == 1) && c.nb == NE && 8 * c.ngw == NTOK && lo < 8 && hi > 9) ? ((const int*)(wsp + WS_HIST))[NE * NE + c.tid] : (int)CNT[(size_t)c.tid * CNT_STRIDE];
        __syncthreads();
        if (c.tid <= NE) { int a = 0, o = 0; for (int j = 0; j < c.tid; ++j) { const int q = cntl[j]; a += (q + 255) >> 8; o += q; } pre[c.tid] = a; offs[c.tid] = o; }
        __syncthreads();
    }
    if (IN(9)) for (int rep_ = 0; rep_ < (((REPEAT_MASK >> 9) & 1) ? 2 : 1); ++rep_) {
        const Ctx c = mkctx(ws, lds_raw); PHASE_PTRS
        pg8::MoeOrder S{pre, offs, cntl, LIST, (const char*)WGUT, (size_t)512 * DM * 2, DM, 2, c.nb, vcu, 0};
        pg8::EpiAct E{ACT};
        pg8::gemm_phase<pg8::EpiAct, pg8::MoeOrder, true, true>(ldsb, H2, DM, S, E);
    }
    SEAM(9);

    if (IN(10)) for (int rep_ = 0; rep_ < (((REPEAT_MASK >> 10) & 1) ? 2 : 1); ++rep_) {
        const Ctx c = mkctx(ws, lds_raw); PHASE_PTRS
        { pg8::MoeOrder S{pre, offs, cntl, LIST, (const char*)WDT, (size_t)DM * EFF * 2, EFF, 4, c.nb, vcu, 1};
          pg8::EpiSlots E{(unsigned char*)SLOTS};
          pg8::gemm_phase<pg8::EpiSlots, pg8::MoeOrder, true>(ldsb, ACT, EFF, S, E); }
        { pg8::DenseOrder S; S.init(NTOK, DM, EFF, WDST, c.nb, c.bid); pg8::EpiBf16 E{YSH, DM};
          pg8::gemm_phase<pg8::EpiBf16, pg8::DenseOrder, true>(ldsb, ACTS, EFF, S, E); }
    }
    SEAM(10);

    if (IN(11)) for (int rep_ = 0; rep_ < (((REPEAT_MASK >> 11) & 1) ? 2 : 1); ++rep_) {
        const Ctx c = mkctx(ws, lds_raw); PHASE_PTRS
        const unsigned char* SL8 = (const unsigned char*)SLOTS;
        typedef float f32x2v __attribute__((ext_vector_type(2)));
        for (int m0 = c.gw; m0 < NTOK; m0 += 2 * c.ngw) {
            int srow[2][TOPK]; float swt[2][TOPK];
#pragma unroll
            for (int q = 0; q < 2; ++q)
#pragma unroll
                for (int k = 0; k < TOPK; ++k) { const int m = m0 + q * c.ngw; const int rec = POSREC[(size_t)m * TOPK + k]; srow[q][k] = offs[rec >> 16] + (rec & 0xffff); swt[q][k] = WTS[(size_t)m * TOPK + k] * (1.f / 16.f); }
#pragma unroll
            for (int q = 0; q < 2; ++q) {
                const int m = m0 + q * c.ngw; const int b = m / SEQ; const float* md = mod + b * 6144;
                const int cc = 16 * c.lane;
                float y[16]; float ss = 0.f;
#pragma unroll
                for (int hq = 0; hq < 2; ++hq) { const uint4 u = *(const uint4*)&YSH[(size_t)m * DM + cc + 8 * hq];
                    y[8 * hq + 0] = bf2f(u.x & 0xffffu); y[8 * hq + 1] = bf2f(u.x >> 16); y[8 * hq + 2] = bf2f(u.y & 0xffffu); y[8 * hq + 3] = bf2f(u.y >> 16);
                    y[8 * hq + 4] = bf2f(u.z & 0xffffu); y[8 * hq + 5] = bf2f(u.z >> 16); y[8 * hq + 6] = bf2f(u.w & 0xffffu); y[8 * hq + 7] = bf2f(u.w >> 16); }
#pragma unroll
                for (int k = 0; k < TOPK; ++k) { const uint4 u = *(const uint4*)&SL8[(size_t)srow[q][k] * DM + cc]; const float wk = swt[q][k];
                    const unsigned wds[4] = {u.x, u.y, u.z, u.w};
#pragma unroll
                    for (int d = 0; d < 4; ++d) { const f32x2v a = __builtin_amdgcn_cvt_pk_f32_fp8((int)wds[d], false), bb = __builtin_amdgcn_cvt_pk_f32_fp8((int)wds[d], true);
                        y[4 * d] += wk * a.x; y[4 * d + 1] += wk * a.y; y[4 * d + 2] += wk * bb.x; y[4 * d + 3] += wk * bb.y; } }
#pragma unroll
                for (int i = 0; i < 16; ++i) ss += y[i] * y[i];
                const float rstd = rsqrtf(wave_sum(ss) * (1.f / DM) + EPS);
#pragma unroll
                for (int hq = 0; hq < 4; ++hq) {
                    const int c4 = cc + 4 * hq;
                    const float4 g = *(const float4*)&g_post_ffn[c4], gt = *(const float4*)&md[5120 + c4]; const uint2 xu = *(const uint2*)&X1[(size_t)m * DM + c4];
                    float4 xx; xx.x = bf2f(xu.x & 0xffffu); xx.y = bf2f(xu.x >> 16); xx.z = bf2f(xu.y & 0xffffu); xx.w = bf2f(xu.y >> 16);
                    float4 r; r.x = xx.x + gt.x * (y[4 * hq] * rstd * g.x); r.y = xx.y + gt.y * (y[4 * hq + 1] * rstd * g.y);
                    r.z = xx.z + gt.z * (y[4 * hq + 2] * rstd * g.z); r.w = xx.w + gt.w * (y[4 * hq + 3] * rstd * g.w);
                    *(float4*)&args.out[(size_t)m * DM + c4] = r;
                }
            }
        }
    }
    }
#undef IN
#undef SEAM
}

constexpr int NPHASE = 12;

extern "C" void kernel_launch(void* const* d_in, const int* in_sizes, int n_in, void* d_out, int out_size, void* d_ws, size_t ws_size, hipStream_t stream) {
    static int grid = 0;
    if (grid == 0) {
        if (n_in != 26 || out_size != NTOK * DM || ws_size < WS_END) { fprintf(stderr, "kernel_launch: unexpected shapes (n_in %d, out %d, ws %zu)\n", n_in, out_size, ws_size); grid = -1; return; }
        int dev = 0, cus = 0, per_cu = 0;
        if (hipGetDevice(&dev) != hipSuccess || hipDeviceGetAttribute(&cus, hipDeviceAttributeMultiprocessorCount, dev) != hipSuccess) { grid = -1; return; }
        if (hipFuncSetAttribute((const void*)mega, hipFuncAttributeMaxDynamicSharedMemorySize, LDS_BYTES) != hipSuccess) { fprintf(stderr, "kernel_launch: hipFuncSetAttribute failed\n"); grid = -1; return; }
        if (hipOccupancyMaxActiveBlocksPerMultiprocessor(&per_cu, (const void*)mega, NTHR, LDS_BYTES) != hipSuccess || per_cu < 1) fprintf(stderr, "kernel_launch: occupancy query says %d\n", per_cu);
        (void)hipGetLastError();
        grid = cus;
    }
    if (grid < 0) return;
    (void)hipMemsetAsync((char*)d_ws + WS_CTL, 0, CTL_ZERO_BYTES, stream);
    Args a{};
    for (int i = 0; i < 26; ++i) a.in[i] = (const float*)d_in[i];
    a.out = (float*)d_out; a.ws = (unsigned char*)d_ws;
    if (MK_N_LAUNCHES == 1) { a.ph_lo = 0; a.ph_hi = NPHASE; hipLaunchKernelGGL(mega, dim3(grid), dim3(NTHR), LDS_BYTES, stream, a); }
    else for (int p = 0; p < NPHASE; ++p) { a.ph_lo = p; a.ph_hi = p + 1; hipLaunchKernelGGL(mega, dim3(grid), dim3(NTHR), LDS_BYTES, stream, a); }
}
```

```cpp
#include <hip/hip_runtime.h>
#include <cstdio>
#include <cstdint>

#ifndef REP_FROM
#define REP_FROM 99
#endif
#ifndef REPEAT_MASK
#define REPEAT_MASK 0
#endif
#ifndef CONV_MODE
#define CONV_MODE 5
#endif
#ifndef MK_N_LAUNCHES
#define MK_N_LAUNCHES 1
#endif

#ifndef ATTN_NAIVE
#define ATTN_NAIVE 0
#endif
#define LAS __attribute__((address_space(3)))
typedef unsigned short bf16_t;

constexpr int NB = 2, SEQ = 8192, NTOK = NB * SEQ, DM = 1024;
constexpr int QLORA = 256, KVLORA = 128, MROPE = 32, MNOPE = 64, MV = 64, MH = 8, DQKM = 96;
constexpr int GH = 8, GKV = 2, GD = 64;
constexpr int INC = 1184;
constexpr int C_QLAT = 0, C_KVLAT = 256, C_KROPE = 384, C_GQ = 416, C_GK = 928, C_GV = 1056;
constexpr int NE = 256, TOPK = 8, EFF = 256;
constexpr int LCAP = 16384;
constexpr float EPS = 1e-6f;
constexpr float LOG2E = 1.4426950408889634f;
constexpr float C2M = 0.10206207261596575f * LOG2E;
constexpr float C2G = 0.125f * LOG2E;

constexpr size_t MiB = 1u << 20;
constexpr size_t WS_CTL = 0, CTL_ZERO_BYTES = 32768;
constexpr size_t WS_MOD = 1 * MiB;
constexpr size_t WS_COSM = 2 * MiB, WS_SINM = 2 * MiB + 512 * 1024, WS_COSG = 3 * MiB, WS_SING = 4 * MiB;
constexpr size_t WS_WQBT = 5 * MiB;
constexpr size_t WS_WINQ = 5 * MiB + 512 * 1024;
constexpr size_t WS_WKVBT = 6 * MiB;
constexpr size_t WS_WINKV = 6 * MiB + 512 * 1024;
constexpr size_t WS_WDST = 7 * MiB;
constexpr size_t WS_COEF = 7 * MiB + 512 * 1024;
constexpr size_t WS_H2 = 8 * MiB;
constexpr size_t WS_X1 = 40 * MiB;
constexpr size_t WS_CNTS = 72 * MiB;
constexpr int CNT_STRIDE = 1088;
constexpr size_t WS_HIST = 82 * MiB;
constexpr size_t WS_WTS = 104 * MiB;
constexpr size_t WS_OSTAT = 252 * MiB;
constexpr size_t WS_POSREC = 105 * MiB;
constexpr size_t WS_LIST = 106 * MiB;
constexpr size_t WS_WBIGT = 122 * MiB;
constexpr size_t WS_WOUTT = 128 * MiB;
constexpr size_t WS_WRST = 130 * MiB;
constexpr size_t WS_ACT = 132 * MiB;
constexpr size_t WS_LOG = 196 * MiB;
constexpr size_t WS_ACTS = 212 * MiB;
constexpr size_t WS_YSH = 220 * MiB;
constexpr size_t WS_SLOTS = 256 * MiB;
constexpr size_t WS_PBUF = 256 * MiB;
constexpr size_t WS_QM = 352 * MiB, WS_KM = 376 * MiB, WS_VM = 400 * MiB, WS_QG = 416 * MiB, WS_KG = 432 * MiB, WS_VG = 436 * MiB;
constexpr size_t WS_O = 440 * MiB;
constexpr size_t WS_MIXED = 472 * MiB;
constexpr size_t WS_WGUT = 512 * MiB;
constexpr size_t WS_WDT = 768 * MiB;
constexpr size_t WS_END = 896 * MiB;
constexpr size_t WS_HF = 512 * MiB, WS_PROJ = 576 * MiB, WS_H2F = 650 * MiB, WS_GS = 714 * MiB, WS_US = 730 * MiB, WS_ACTSF = 746 * MiB, WS_YSHF = 768 * MiB, WS_LOGF = 832 * MiB;
constexpr int CW_CNT = 1024;
constexpr int CW_KMAX = 2048;
constexpr int CW_BAR = 4096;

constexpr int LDS_BYTES = 147456;
constexpr int NTHR = 512, NWAVES = 8;

#define XB_TMO      128
#define XB_XCNT(j)  (256  + 64 * (j))
#define XB_XSUB(j)  (1280 + 64 * (j))
#define XB_XGEN(j)  (2304 + 64 * (j))
#define XB_TOP      3328
#define XB_TOPGEN   3392
#define XCD_BAR_WORDS 3456
#define XB_SPIN_CAP (1u << 18)
__device__ __forceinline__ unsigned xb_ld(unsigned* p)              { return __hip_atomic_load(p, __ATOMIC_RELAXED, __HIP_MEMORY_SCOPE_AGENT); }
__device__ __forceinline__ unsigned xb_add(unsigned* p, unsigned v) { return __hip_atomic_fetch_add(p, v, __ATOMIC_RELAXED, __HIP_MEMORY_SCOPE_AGENT); }
__device__ __forceinline__ unsigned xb_xcc_id() { return (unsigned)__builtin_amdgcn_s_getreg((3 << 11) | 20) & 0xFu; }
#define XB_SPIN(cond, bar) do { unsigned _sp = 0; while (cond) { __builtin_amdgcn_s_sleep(1); \
    if ((++_sp & 255u) == 0u) { if (xb_ld(&(bar)[XB_TMO])) break; if (_sp > XB_SPIN_CAP) { atomicAdd(&(bar)[XB_TMO], 1u); break; } } } } while (0)
struct XcdBarrier { unsigned* bar; unsigned x; volatile LAS unsigned* st; };
__device__ __forceinline__ XcdBarrier xcd_barrier_post(unsigned* bar, volatile LAS unsigned* st) {
    XcdBarrier b; b.bar = bar; b.x = xb_xcc_id(); b.st = st;
    if (threadIdx.x == 0) (void)xb_add(&bar[XB_XCNT(b.x)], 1u);
    return b;
}
__device__ __forceinline__ void xcd_barrier_complete(unsigned* bar, unsigned x, unsigned& nloc, unsigned& nx) {
    const unsigned G = gridDim.x * gridDim.y * gridDim.z;
    unsigned sum, cnt, mine, sp = 0u;
    for (;;) {
        sum = 0u; cnt = 0u; mine = 0u;
#pragma unroll
        for (unsigned j = 0; j < 16; ++j) { const unsigned c = xb_ld(&bar[XB_XCNT(j)]); sum += c; cnt += (c > 0u) ? 1u : 0u; mine = (j == x) ? c : mine; }
        if (sum == G) break;
        __builtin_amdgcn_s_sleep(1);
        if ((++sp & 255u) == 0u) { if (xb_ld(&bar[XB_TMO])) break; if (sp > XB_SPIN_CAP) { atomicAdd(&bar[XB_TMO], 1u); break; } }
    }
    nloc = mine > 0u ? mine : 1u; nx = cnt > 0u ? cnt : 1u;
}
__device__ __forceinline__ void xcd_barrier(const XcdBarrier& b) {
    asm volatile("s_waitcnt vmcnt(0)" ::: "memory");
    __syncthreads();
    if (threadIdx.x == 0) {
        unsigned* bar = b.bar;
        __builtin_amdgcn_s_waitcnt(0);
        unsigned nloc = b.st[0], nx = b.st[1];
        if (nloc == 0u) { xcd_barrier_complete(bar, b.x, nloc, nx); b.st[0] = nloc; b.st[1] = nx; }
        const unsigned old = xb_add(&bar[XB_XSUB(b.x)], 1u);
        const unsigned gen = old / nloc;
        if (old + 1u == (gen + 1u) * nloc) {
            __builtin_amdgcn_fence(__ATOMIC_RELEASE, "agent");
            asm volatile("s_waitcnt vmcnt(0)" ::: "memory");
            const unsigned og = xb_add(&bar[XB_TOP], 1u);
            const unsigned tg = og / nx;
            if (og + 1u == (tg + 1u) * nx) xb_add(&bar[XB_TOPGEN], 1u);
            else XB_SPIN(xb_ld(&bar[XB_TOPGEN]) == tg, bar);
            __builtin_amdgcn_fence(__ATOMIC_ACQUIRE, "agent");
            xb_add(&bar[XB_XGEN(b.x)], 1u);
            asm volatile("s_waitcnt vmcnt(0)" ::: "memory");
        } else {
            XB_SPIN(xb_ld(&bar[XB_XGEN(b.x)]) == gen, bar);
            __builtin_amdgcn_fence(__ATOMIC_ACQUIRE, "agent");
            asm volatile("s_waitcnt vmcnt(0)" ::: "memory");
        }
    }
    __syncthreads();
}

__device__ __forceinline__ unsigned f2bf(float f) { unsigned u = __builtin_bit_cast(unsigned, f); return (u + 0x7fffu + ((u >> 16) & 1u)) >> 16; }
__device__ __forceinline__ float bf2f(unsigned h) { return __builtin_bit_cast(float, h << 16); }
__device__ __forceinline__ unsigned pk2(float lo, float hi) { return f2bf(lo) | (f2bf(hi) << 16); }
template <int CTRL, int RM> __device__ __forceinline__ float dppmov(float old, float v) {
    return __builtin_bit_cast(float, __builtin_amdgcn_update_dpp(__builtin_bit_cast(int, old), __builtin_bit_cast(int, v), CTRL, RM, 0xF, false)); }
__device__ __forceinline__ float wave_sum(float v) {
    v += dppmov<0xB1, 0xF>(0.f, v);
    v += dppmov<0x4E, 0xF>(0.f, v);
    v += dppmov<0x141, 0xF>(0.f, v);
    v += dppmov<0x140, 0xF>(0.f, v);
    v += dppmov<0x142, 0xA>(0.f, v);
    v += dppmov<0x143, 0xC>(0.f, v);
    return __builtin_bit_cast(float, __builtin_amdgcn_readlane(__builtin_bit_cast(int, v), 63));
}
__device__ __forceinline__ float wave_max(float v) {
    const float NI = -INFINITY;
    v = fmaxf(v, dppmov<0xB1, 0xF>(NI, v)); v = fmaxf(v, dppmov<0x4E, 0xF>(NI, v)); v = fmaxf(v, dppmov<0x141, 0xF>(NI, v)); v = fmaxf(v, dppmov<0x140, 0xF>(NI, v));
    v = fmaxf(v, dppmov<0x142, 0xA>(NI, v)); v = fmaxf(v, dppmov<0x143, 0xC>(NI, v));
    return __builtin_bit_cast(float, __builtin_amdgcn_readlane(__builtin_bit_cast(int, v), 63));
}
template <int CTRL, int RM> __device__ __forceinline__ int dppmovi(int old, int v) { return __builtin_amdgcn_update_dpp(old, v, CTRL, RM, 0xF, false); }
__device__ __forceinline__ int imax_(int a, int b) { return a > b ? a : b; }
__device__ __forceinline__ int imin_(int a, int b) { return a < b ? a : b; }
__device__ __forceinline__ int wave_max_i(int v) {
    const int NI = (int)0x80000000;
    v = imax_(v, dppmovi<0xB1, 0xF>(NI, v)); v = imax_(v, dppmovi<0x4E, 0xF>(NI, v)); v = imax_(v, dppmovi<0x141, 0xF>(NI, v)); v = imax_(v, dppmovi<0x140, 0xF>(NI, v));
    v = imax_(v, dppmovi<0x142, 0xA>(NI, v)); v = imax_(v, dppmovi<0x143, 0xC>(NI, v));
    return __builtin_amdgcn_readlane(v, 63);
}
__device__ __forceinline__ int grp8_max_i(int v) {
    const int NI = (int)0x80000000;
    v = imax_(v, dppmovi<0xB1, 0xF>(NI, v)); v = imax_(v, dppmovi<0x4E, 0xF>(NI, v)); v = imax_(v, dppmovi<0x141, 0xF>(NI, v)); return v;
}
__device__ __forceinline__ int ford(float f) { const int b = __builtin_bit_cast(int, f); return b ^ ((b >> 31) & 0x7fffffff); }
__device__ __forceinline__ float funord(int k) { return __builtin_bit_cast(float, k ^ ((k >> 31) & 0x7fffffff)); }
__device__ __forceinline__ float grp8_sum(float v) {
    v += dppmov<0xB1, 0xF>(0.f, v); v += dppmov<0x4E, 0xF>(0.f, v); v += dppmov<0x141, 0xF>(0.f, v); return v;
}
__device__ __forceinline__ float grp8_max(float v) {
    const float NI = -INFINITY;
    v = fmaxf(v, dppmov<0xB1, 0xF>(NI, v)); v = fmaxf(v, dppmov<0x4E, 0xF>(NI, v)); v = fmaxf(v, dppmov<0x141, 0xF>(NI, v)); return v;
}
__device__ __forceinline__ float sigmoidf_(float x) { return 1.f / (1.f + __expf(-x)); }

struct Args { const float* in[26]; float* out; unsigned char* ws; int ph_lo, ph_hi; };

struct Ctx {
    int tid, lane, wave, bid, nb, gw, ngw;
    unsigned char* ws; float* lds;
};
__device__ __forceinline__ Ctx mkctx(unsigned char* ws, unsigned char* lds_raw) {
    Ctx c; int t = threadIdx.x; asm volatile("" : "+v"(t));
    c.tid = t; c.lane = t & 63; c.wave = __builtin_amdgcn_readfirstlane(t >> 6);
    c.bid = blockIdx.x; c.nb = gridDim.x; c.gw = c.bid * NWAVES + c.wave; c.ngw = c.nb * NWAVES; c.ws = ws; c.lds = (float*)lds_raw; return c;
}

namespace att {
using bf16x8 = __attribute__((ext_vector_type(8))) short;
using s16x4 = __attribute__((ext_vector_type(4))) short;
using f32x16 = __attribute__((ext_vector_type(16))) float;
using u32x4 = __attribute__((ext_vector_type(4))) unsigned;
typedef float f32x2_t __attribute__((ext_vector_type(2))); typedef __bf16 bf16x2_t __attribute__((ext_vector_type(2)));
typedef __attribute__((address_space(3))) const char* lds_cptr;
typedef short v4i16_t __attribute__((ext_vector_type(4)));
constexpr int NT = SEQ / 64;
constexpr int KSLOT = 12288, VSLOT = 8192, NSLOT = 3;
constexpr int LDS_K = 0, LDS_V = NSLOT * KSLOT, LDS_WS = LDS_V + NSLOT * VSLOT, LDS_OST = LDS_WS + NWAVES * 256, LDS_ATT = LDS_OST + NWAVES * 4096;
#define SBAR() __builtin_amdgcn_sched_barrier(0)
#define MFMA(a, b, c) __builtin_amdgcn_mfma_f32_32x32x16_bf16(a, b, c, 0, 0, 0)
__device__ __forceinline__ int crow(int r, int hi) { return (r & 3) + 8 * (r >> 2) + 4 * hi; }
__device__ __forceinline__ unsigned cvtpk_s(float lo, float hi) { f32x2_t v = {lo, hi}; bf16x2_t b = __builtin_convertvector(v, bf16x2_t); return __builtin_bit_cast(unsigned, b); }
__device__ __forceinline__ void glds16(const void* g, unsigned lds_base) {
    unsigned sv; asm volatile("s_mov_b32 %0, m0\n\ts_mov_b32 m0, %2\n\ts_nop 0\n\tglobal_load_lds_dwordx4 %1, off\n\ts_mov_b32 m0, %0" : "=&s"(sv) : "v"(g), "s"(lds_base) : "memory"); }
__device__ __forceinline__ s16x4 vtr(lds_cptr p) { return __builtin_bit_cast(s16x4, __builtin_amdgcn_ds_read_tr16_b64_v4i16((__attribute__((address_space(3))) v4i16_t*)p)); }
#define MX3(a, b, c) __builtin_fmaxf(__builtin_fmaxf((a), (b)), (c))
__device__ __forceinline__ float rowmax(const f32x16& p0, const f32x16& p1) {
    float a = MX3(p0[0], p0[1], p1[0]), b = MX3(p0[2], p0[3], p1[1]); a = MX3(a, p1[2], p1[3]);
#pragma unroll
    for (int r = 4; r < 16; r += 4) { a = MX3(a, p0[r], p0[r + 1]); b = MX3(b, p0[r + 2], p0[r + 3]); a = MX3(a, p1[r], p1[r + 1]); b = MX3(b, p1[r + 2], p1[r + 3]); }
    float m = __builtin_fmaxf(a, b); auto rr = __builtin_amdgcn_permlane32_swap(__float_as_uint(m), __float_as_uint(m), false, false);
    return __builtin_fmaxf(__uint_as_float(rr[0]), __uint_as_float(rr[1])); }

template <int DQK>
__device__ __forceinline__ void unit_simple(const bf16_t* Qh, const bf16_t* __restrict__ Kh, const bf16_t* __restrict__ Vh, bf16_t* Ob, int q0, char* shm) {
    constexpr int NCH = DQK / 8, ND0 = DQK / 16;
    int tid_ = threadIdx.x; asm volatile("" : "+v"(tid_));
    const int tid = tid_, lane = tid & 63, r32 = lane & 31, hi = lane >> 5; const int wid = __builtin_amdgcn_readfirstlane(tid >> 6);
    const bf16_t* Qw = Qh + (size_t)(q0 + wid * 32) * DQK;
    const unsigned lds0 = (unsigned)(uintptr_t)shm; float* wsf = (float*)(shm + LDS_WS) + wid * 64;
    const bf16_t* ksrc0 = Kh + (size_t)lane * DQK + wid * 8;
    const bf16_t* ksrc1 = Kh + (size_t)lane * DQK + (8 + (wid & 3)) * 8;
    const bf16_t* vsrc = Vh + (size_t)(16 * (wid & 3) + (lane >> 2)) * 64 + (wid >> 2) * 32 + (lane & 3) * 8;
    const unsigned kdst0 = lds0 + LDS_K + wid * 1024, kdst1 = lds0 + LDS_K + (8 + (wid & 3)) * 1024, vdst = lds0 + LDS_V + wid * 1024;
#define DMA_KV(t, sl) do { glds16(ksrc0 + (size_t)(t) * 64 * DQK, (unsigned)__builtin_amdgcn_readfirstlane(kdst0 + (sl) * KSLOT)); \
        if (NCH == 12 && wid < 4) glds16(ksrc1 + (size_t)(t) * 64 * DQK, (unsigned)__builtin_amdgcn_readfirstlane(kdst1 + (sl) * KSLOT)); \
        glds16(vsrc + (size_t)(t) * 64 * 64, (unsigned)__builtin_amdgcn_readfirstlane(vdst + (sl) * VSLOT)); } while (0)
    const lds_cptr shm3 = (lds_cptr)shm;
    const lds_cptr vp0 = shm3 + LDS_V + ((lane >> 4) & 1) * 32 + (lane & 3) * 8 + (4 * hi + ((lane & 15) >> 2)) * 64;
    const lds_cptr kp0 = shm3 + LDS_K + hi * 1024 + r32 * 16;
    DMA_KV(0, 0);
    bf16x8 qr[ND0];
#pragma unroll
    for (int d0 = 0; d0 < ND0; ++d0) qr[d0] = *reinterpret_cast<const bf16x8*>(&Qw[(size_t)r32 * DQK + d0 * 16 + hi * 8]);
    float mhat = -INFINITY, l_reg = 0.f; f32x16 o[2]; o[0] = f32x16{}; o[1] = f32x16{};
    asm volatile("s_waitcnt vmcnt(0) lgkmcnt(0)\n\ts_barrier" ::: "memory");
    for (int t = 0; t < NT; ++t) {
        const int sl = t & 1;
        if (t + 1 < NT) DMA_KV(t + 1, sl ^ 1);
        f32x16 p0 = f32x16{}, p1 = f32x16{};
        const lds_cptr kp = kp0 + sl * KSLOT;
#pragma unroll
        for (int d0 = 0; d0 < ND0; ++d0) {
            const bf16x8 b0 = *(const __attribute__((address_space(3))) bf16x8*)(kp + d0 * 2048);
            const bf16x8 b1 = *(const __attribute__((address_space(3))) bf16x8*)(kp + d0 * 2048 + 512);
            p0 = MFMA(b0, qr[d0], p0); p1 = MFMA(b1, qr[d0], p1);
        }
        const float rm = rowmax(p0, p1);
        const float mn = __builtin_fmaxf(mhat, rm), f = __builtin_amdgcn_exp2f(mhat - mn); mhat = mn;
        float sacc = 0.f;
#pragma unroll
        for (int r = 0; r < 16; ++r) { p0[r] = __builtin_amdgcn_exp2f(p0[r] - mn); p1[r] = __builtin_amdgcn_exp2f(p1[r] - mn); sacc += p0[r] + p1[r]; }
        l_reg = l_reg * f + sacc;
        if (hi == 0) wsf[r32] = f;
        asm volatile("s_waitcnt lgkmcnt(0)" ::: "memory");
#pragma unroll
        for (int d_ = 0; d_ < 2; ++d_)
#pragma unroll
            for (int r = 0; r < 16; ++r) o[d_][r] *= wsf[crow(r, hi)];
        u32x4 pw[4];
#pragma unroll
        for (int i = 0; i < 4; ++i) { pw[0][i] = cvtpk_s(p0[2 * i], p0[2 * i + 1]); pw[1][i] = cvtpk_s(p0[8 + 2 * i], p0[8 + 2 * i + 1]); pw[2][i] = cvtpk_s(p1[2 * i], p1[2 * i + 1]); pw[3][i] = cvtpk_s(p1[8 + 2 * i], p1[8 + 2 * i + 1]); }
        const lds_cptr vp_ = vp0 + sl * VSLOT;
#pragma unroll
        for (int d0 = 0; d0 < 2; ++d0)
#pragma unroll
            for (int ks = 0; ks < 4; ++ks) {
                const s16x4 lo = vtr(vp_ + d0 * 4096 + ks * 1024), hh = vtr(vp_ + d0 * 4096 + ks * 1024 + 512);
                const bf16x8 vf = (bf16x8){lo[0], lo[1], lo[2], lo[3], hh[0], hh[1], hh[2], hh[3]};
                o[d0] = MFMA(__builtin_bit_cast(bf16x8, pw[ks]), vf, o[d0]);
            }
        asm volatile("s_waitcnt vmcnt(0) lgkmcnt(0)\n\ts_barrier" ::: "memory");
    }
#undef DMA_KV
    { auto rr = __builtin_amdgcn_permlane32_swap(__float_as_uint(l_reg), __float_as_uint(l_reg), false, false); l_reg = __uint_as_float(rr[0]) + __uint_as_float(rr[1]); }
    if (hi == 0) wsf[32 + r32] = l_reg; asm volatile("s_waitcnt lgkmcnt(0)" ::: "memory");
    float rli[16];
#pragma unroll
    for (int r = 0; r < 16; ++r) rli[r] = __builtin_amdgcn_rcpf(wsf[32 + crow(r, hi)]);
    bf16_t* Ow = Ob + (size_t)(wid * 32) * DM; bf16_t* stg = (bf16_t*)(shm + LDS_OST) + wid * 2048;
#pragma unroll
    for (int r = 0; r < 16; ++r) { const int orow = crow(r, hi);
#pragma unroll
        for (int d0 = 0; d0 < 2; ++d0) stg[orow * 64 + d0 * 32 + r32] = (bf16_t)f2bf(o[d0][r] * rli[r]); }
    asm volatile("s_waitcnt lgkmcnt(0)" ::: "memory");
#pragma unroll
    for (int i = 0; i < 4; ++i) { const int row = i * 8 + (lane >> 3), ch = lane & 7; *(u32x4*)(Ow + (size_t)row * DM + ch * 8) = *(const u32x4*)(stg + row * 64 + ch * 8); }
    asm volatile("s_waitcnt vmcnt(0) lgkmcnt(0)\n\ts_barrier" ::: "memory");
}

constexpr int CONV_LDS = 112640;
struct ConvState { int cj, jbase; const char* wg; const char* wu; const char* wd; char* dgu; char* dd; unsigned ldsbuf; lds_cptr rdbuf; };
struct ConvJob { const char* sbase; char* dbase; unsigned ldwB, KdB; };
__device__ __forceinline__ ConvJob conv_job(const ConvState& cs, int j) {
    const int J = (CONV_MODE >= 5) ? j : cs.jbase + (j < 383 ? j : 383); const int m = J >> 10, r = J & 1023; ConvJob q;
    if (m < 2) { const int g = r >> 7, kg = r & 127; const int drow0 = ((g < 4) ? g * 32 : 256 + (g - 4) * 32) + m * 128;
        q.sbase = (m ? cs.wu : cs.wg) + (size_t)((8 * kg) * EFF + g * 32) * 4; q.ldwB = EFF * 4; q.dbase = cs.dgu + (size_t)(drow0 * DM + 8 * kg) * 2; q.KdB = DM * 2; }
    else { const int g = r >> 5, kg = r & 31;
        q.sbase = cs.wd + (size_t)((8 * kg) * DM + g * 32) * 4; q.ldwB = DM * 4; q.dbase = cs.dd + (size_t)((g * 32) * EFF + 8 * kg) * 2; q.KdB = EFF * 2; }
    return q;
}
__device__ __forceinline__ void glds16_s(const char* sbase, unsigned voff, unsigned lds_base) {
    unsigned sv; asm volatile("s_mov_b32 %0, m0\n\ts_mov_b32 m0, %3\n\ts_nop 4\n\tglobal_load_lds_dwordx4 %1, %2\n\ts_mov_b32 m0, %0" : "=&s"(sv) : "v"(voff), "s"(sbase), "s"(lds_base) : "memory"); }
#if CONV_MODE == 1 || CONV_MODE == 3 || CONV_MODE == 4 || CONV_MODE >= 5
#define CONV_DRAIN() do { const int jd_ = cs.cj - 3; const ConvJob q_ = conv_job(cs, jd_); \
        const __attribute__((address_space(3))) float* bp_ = (const __attribute__((address_space(3))) float*)(cs.rdbuf + (jd_ & 3) * 1024) + (lane >> 5) * 128 + (lane & 31); \
        uint2 w_; w_.x = cvtpk_s(bp_[0], bp_[32]); w_.y = cvtpk_s(bp_[64], bp_[96]); \
        if (CONV_MODE == 1) *(uint2*)(q_.dbase + (size_t)((unsigned)(lane & 31) * q_.KdB + (unsigned)(lane >> 5) * 8u)) = w_; \
        else if (CONV_MODE == 4) *(uint2*)(cs.dgu + 0x30000000ull + (size_t)((unsigned)(lane & 31) * 2048u + (unsigned)(lane >> 5) * 8u + (unsigned)(jd_ & 127) * 16u)) = w_; \
        else asm volatile("" :: "v"(w_)); } while (0)
#else
#define CONV_DRAIN() do { } while (0)
#endif
#if CONV_MODE >= 5
#undef CONV_DRAIN
#define CONV_NSTEP 384
#define CONV_DRAIN() do { if (CONV_MODE == 5 && rst && cs.cj >= 3 && cs.cj < CONV_NSTEP + 3) { const int jb_ = 8 * (cs.cj - 3) + 4 * (wid - 6); const ConvJob q_ = conv_job(cs, jb_); \
          \
        const __attribute__((address_space(3))) float* bp_ = (const __attribute__((address_space(3))) float*)(cs.rdbuf + (jb_ & 31) * 1024) + (lane >> 5) * 512 + (lane & 31); \
        float v_[16]; \
        _Pragma("unroll") for (int i_ = 0; i_ < 16; ++i_) v_[i_] = bp_[i_ * 32]; \
        char* dp_ = q_.dbase + (size_t)((unsigned)(lane & 31) * q_.KdB + (unsigned)(lane >> 5) * 32u); \
        _Pragma("unroll") for (int i_ = 0; i_ < 2; ++i_) { uint4 w_; w_.x = cvtpk_s(v_[8 * i_], v_[8 * i_ + 1]); w_.y = cvtpk_s(v_[8 * i_ + 2], v_[8 * i_ + 3]); \
            w_.z = cvtpk_s(v_[8 * i_ + 4], v_[8 * i_ + 5]); w_.w = cvtpk_s(v_[8 * i_ + 6], v_[8 * i_ + 7]); *(uint4*)(dp_ + 16 * i_) = w_; } } } while (0)
#define CONV_ISSUE() do { if (CONV_MODE != 6 && rcl && cs.cj < CONV_NSTEP) { const int jb_ = 8 * cs.cj + 4 * (wid - 4); const ConvJob q_ = conv_job(cs, jb_); \
        const unsigned vo_ = (unsigned)(lane >> 3) * q_.ldwB + (unsigned)(lane & 7) * 16u; const unsigned lb_ = (unsigned)__builtin_amdgcn_readfirstlane(cs.ldsbuf + (jb_ & 31) * 1024); \
        glds16_s(q_.sbase, vo_, lb_); glds16_s(q_.sbase + (size_t)8 * q_.ldwB, vo_, lb_ + 1024); glds16_s(q_.sbase + (size_t)16 * q_.ldwB, vo_, lb_ + 2048); glds16_s(q_.sbase + (size_t)24 * q_.ldwB, vo_, lb_ + 3072); } \
        ++cs.cj; } while (0)
#define WAIT_BARL() asm volatile("s_waitcnt lgkmcnt(0)\n\ts_barrier" ::: "memory")
#define RWAIT(N) do { if (rkv) { WAIT_BAR(N); } else if (rcl) { WAIT_BAR(8); } else { WAIT_BARL(); } } while (0)
#elif CONV_MODE != 0
#define CONV_ISSUE() do { const ConvJob q_ = conv_job(cs, cs.cj); \
        glds16_s(q_.sbase, (unsigned)(lane >> 3) * q_.ldwB + (unsigned)(lane & 7) * 16u, (unsigned)__builtin_amdgcn_readfirstlane(cs.ldsbuf + (cs.cj & 3) * 1024)); ++cs.cj; } while (0)
#define WB_P() WAIT_BAR(3)
#define WB_S() WAIT_BAR(4)
#define WB_E1() WAIT_BAR(3)
#define WB_E0() WAIT_BAR(1)
#define WB_PL() WAIT_BAR(4)
#define WB_SL() WAIT_BAR(5)
#else
#define CONV_ISSUE() do { } while (0)
#define WB_P() WAIT_BAR(2)
#define WB_S() WAIT_BAR(2)
#define WB_E1() WAIT_BAR(1)
#define WB_E0() WAIT_BAR(0)
#define WB_PL() WAIT_BAR(3)
#define WB_SL() WAIT_BAR(3)
#endif

constexpr int T_SLOTB = 8192, T_LDS_K = 0, T_LDS_V = 3 * T_SLOTB, T_LDS_WS = 6 * T_SLOTB, T_LDS_OST = T_LDS_WS + NWAVES * 256;
#define WAIT_BAR(N) asm volatile("s_waitcnt vmcnt(" #N ") lgkmcnt(0)\n\ts_barrier" ::: "memory")
__device__ __forceinline__ float max3f(float a, float b, float c) { float r; asm("v_max3_f32 %0, %1, %2, %3" : "=v"(r) : "v"(a), "v"(b), "v"(c)); return r; }
__device__ __forceinline__ float max2f(float a, float b) { float r; asm("v_max_f32_e32 %0, %1, %2" : "=v"(r) : "v"(a), "v"(b)); return r; }
__device__ __forceinline__ float fadd_s(float a, float b) { float r; asm("v_add_f32_e32 %0, %1, %2" : "=v"(r) : "v"(a), "v"(b)); return r; }
__device__ __forceinline__ float fsub_s(float a, float b) { float r; asm("v_sub_f32_e32 %0, %1, %2" : "=v"(r) : "v"(a), "v"(b)); return r; }
__device__ __forceinline__ float rowmax_asm(const f32x16& p0, const f32x16& p1) {
    float a = max3f(p0[0], p0[1], p1[0]), b = max3f(p0[2], p0[3], p1[1]); a = max3f(a, p1[2], p1[3]);
#pragma unroll
    for (int r = 4; r < 16; r += 4) { a = max3f(a, p0[r], p0[r + 1]); b = max3f(b, p0[r + 2], p0[r + 3]); a = max3f(a, p1[r], p1[r + 1]); b = max3f(b, p1[r + 2], p1[r + 3]); }
    const float m = max2f(a, b);
    auto rr = __builtin_amdgcn_permlane32_swap(__float_as_uint(m), __float_as_uint(m), false, false);
    return max2f(__uint_as_float(rr[0]), __uint_as_float(rr[1]));
}
__device__ __forceinline__ void kload8(bf16x8* kf, lds_cptr kp) {
    kf[0] = *(const __attribute__((address_space(3))) bf16x8*)(kp);        kf[1] = *(const __attribute__((address_space(3))) bf16x8*)(kp + 512);
    kf[2] = *(const __attribute__((address_space(3))) bf16x8*)(kp + 2048); kf[3] = *(const __attribute__((address_space(3))) bf16x8*)(kp + 2560);
    kf[4] = *(const __attribute__((address_space(3))) bf16x8*)(kp + 4096); kf[5] = *(const __attribute__((address_space(3))) bf16x8*)(kp + 4608);
    kf[6] = *(const __attribute__((address_space(3))) bf16x8*)(kp + 6144); kf[7] = *(const __attribute__((address_space(3))) bf16x8*)(kp + 6656);
}
__device__ __forceinline__ void kload2(bf16x8* kf, lds_cptr kp, int j) { kf[2 * j] = *(const __attribute__((address_space(3))) bf16x8*)(kp + j * 2048); kf[2 * j + 1] = *(const __attribute__((address_space(3))) bf16x8*)(kp + j * 2048 + 512); }

template <int THRL>
__device__ __forceinline__ void unit64(const bf16_t* Qh, const bf16_t* __restrict__ Kh, const bf16_t* __restrict__ Vh, bf16_t* Ob, float* ostat, int q0, char* shm, ConvState& cs, float mfix) {
    constexpr int DQ = 64;
    int tid_ = threadIdx.x; asm volatile("" : "+v"(tid_));
    const int tid = tid_, lane = tid & 63, r32 = lane & 31, hi = lane >> 5; const int wid = __builtin_amdgcn_readfirstlane(tid >> 6);
    const bf16_t* Qw = Qh + (size_t)(q0 + wid * 32) * DQ;
    const unsigned lds0 = (unsigned)(uintptr_t)shm;
    float* wsf = (float*)(shm + T_LDS_WS) + wid * 64;
#if CONV_MODE >= 5
    const bool rkv = wid < 4, rcl = (wid == 4 || wid == 5), rst = wid >= 6; const int pw = wid & 3;
    const bf16_t* ksrc = Kh + (size_t)lane * DQ + pw * 8;
    const bf16_t* vsrc = Vh + (size_t)(16 * pw + (lane >> 2)) * 64 + (lane & 3) * 8;
    const unsigned kdst = lds0 + T_LDS_K + pw * 1024, vdst = lds0 + T_LDS_V + pw * 1024;
#define DMA_K(t, slot) do { if (rkv) { glds16(ksrc + (size_t)(t) * 64 * DQ, (unsigned)__builtin_amdgcn_readfirstlane(kdst + (slot))); \
        glds16(ksrc + 32 + (size_t)(t) * 64 * DQ, (unsigned)__builtin_amdgcn_readfirstlane(kdst + 4096 + (slot))); } } while (0)
#define DMA_V(t, slot) do { if (rkv) { glds16(vsrc + (size_t)(t) * 64 * 64, (unsigned)__builtin_amdgcn_readfirstlane(vdst + (slot))); \
        glds16(vsrc + 32 + (size_t)(t) * 64 * 64, (unsigned)__builtin_amdgcn_readfirstlane(vdst + 4096 + (slot))); } } while (0)
#define WB_P() RWAIT(4)
#define WB_S() RWAIT(4)
#define WB_E1() RWAIT(2)
#define WB_E0() RWAIT(0)
#else
    const bf16_t* ksrc = Kh + (size_t)lane * DQ + wid * 8;
    const bf16_t* vsrc = Vh + (size_t)(16 * (wid & 3) + (lane >> 2)) * 64 + (wid >> 2) * 32 + (lane & 3) * 8;
    const unsigned kdst = lds0 + T_LDS_K + wid * 1024, vdst = lds0 + T_LDS_V + wid * 1024;
#define DMA_K(t, slot) glds16(ksrc + (size_t)(t) * 64 * DQ, (unsigned)__builtin_amdgcn_readfirstlane(kdst + (slot)))
#define DMA_V(t, slot) glds16(vsrc + (size_t)(t) * 64 * 64, (unsigned)__builtin_amdgcn_readfirstlane(vdst + (slot)))
#endif
    const int vb0 = (int)(lds0 + T_LDS_V) + ((lane >> 4) & 1) * 32 + (lane & 3) * 8 + (4 * hi + ((lane & 15) >> 2)) * 64;
    bf16x8 kf[8];
    const lds_cptr shm3 = (lds_cptr)shm; const lds_cptr kp0 = shm3 + T_LDS_K + hi * 1024 + r32 * 16;
    const lds_cptr vp0 = shm3 + T_LDS_V + ((lane >> 4) & 1) * 32 + (lane & 3) * 8 + (4 * hi + ((lane & 15) >> 2)) * 64;
    DMA_K(0, 0); DMA_V(0, 0); DMA_K(1, T_SLOTB);
    bf16x8 qr[4];
#pragma unroll
    for (int d0 = 0; d0 < 4; ++d0) qr[d0] = *reinterpret_cast<const bf16x8*>(&Qw[(size_t)r32 * DQ + d0 * 16 + hi * 8]);
    float mfo = mfix; asm volatile("" : "+v"(mfo));
    float mhat = mfo, l_reg = 0.f; f32x16 o[2]; o[0] = f32x16{}; o[1] = f32x16{}; f32x16 negm;
#pragma unroll
    for (int r = 0; r < 16; ++r) negm[r] = -mfo;
    asm volatile("" : "+v"(negm));
    bool resc = false;
#define START(P0, P1) do { resc = false; _Pragma("unroll") for (int r = 0; r < 16; ++r) P0[r] = __builtin_amdgcn_exp2f(P0[r]); } while (0)
#define RESC() do { if (resc) { asm volatile("s_waitcnt lgkmcnt(0)" ::: "memory"); \
      _Pragma("unroll") for (int d_ = 0; d_ < 2; ++d_) _Pragma("unroll") for (int r = 0; r < 16; ++r) o[d_][r] *= wsf[crow(r, hi)]; } } while (0)
    f32x16 pA0, pA1, pB0, pB1;
    int sl_prev = 0, sl_cur = 0, sl_next = T_SLOTB;
#define ROT() do { sl_prev = sl_cur; sl_cur = sl_next; sl_next = (sl_next == 2 * T_SLOTB) ? 0 : sl_next + T_SLOTB; } while (0)
    DMA_K(2, 2 * T_SLOTB);
#if CONV_MODE >= 5
    WAIT_BAR(0);
#else
    WAIT_BAR(3);
#endif
    CONV_DRAIN();
    {
        const lds_cptr kb = kp0;
#pragma unroll
        for (int d0 = 0; d0 < 4; ++d0) {
            const bf16x8 b0 = *(const __attribute__((address_space(3))) bf16x8*)(kb + d0 * 2048);
            const bf16x8 b1 = *(const __attribute__((address_space(3))) bf16x8*)(kb + d0 * 2048 + 512);
            if (d0 == 0) { pA0 = MFMA(b0, qr[0], negm); pA1 = MFMA(b1, qr[0], negm); }
            else { pA0 = MFMA(b0, qr[d0], pA0); pA1 = MFMA(b1, qr[d0], pA1); } }
    }
    asm volatile("s_nop 15\n\ts_nop 7" : "+v"(pA0), "+v"(pA1));
    START(pA0, pA1);
#pragma unroll
    for (int r = 0; r < 16; ++r) pA1[r] = __builtin_amdgcn_exp2f(pA1[r]);
    WAIT_BAR(0);
    DMA_K(3, 0); DMA_V(1, T_SLOTB); CONV_ISSUE();
    ROT();
    kload8(kf, kp0 + sl_cur);
    WB_P();
    s16x4 vlo[8], vhi[8]; u32x4 pw0, pw1, pw2, pw3;
#define PKW(P, B) cvtpk_s(P[B], P[B + 1])
#define PAF(k) __builtin_bit_cast(bf16x8, pw##k)
#define VFR(i) (bf16x8){vlo[i][0], vlo[i][1], vlo[i][2], vlo[i][3], vhi[i][0], vhi[i][1], vhi[i][2], vhi[i][3]}
#define PIN(x) asm volatile("" : "+v"(x))
#define GAPA(MF, A0, A1, A2, A3, W0, W1, PW) do { MF; sacc += A0; sacc += A1; sacc += A2; sacc += A3; PIN(sacc); W0; W1; PIN(PW); SBAR(); } while (0)
#define EX(v) __builtin_amdgcn_exp2f(v)
#define GAPB(MF, X, B) do { MF; X[B] = EX(X[B]); X[B + 1] = EX(X[B + 1]); X[B + 2] = EX(X[B + 2]); X[B + 3] = EX(X[B + 3]); PIN(X); SBAR(); } while (0)
#define VRD(i) do { vlo[i] = vtr(vp_ + (((i) >> 2) * 4096 + ((i) & 3) * 1024)); vhi[i] = vtr(vp_ + (((i) >> 2) * 4096 + ((i) & 3) * 1024 + 512)); } while (0)
#define KRD(G, j) do { if (G) { kload2(kf, kp0 + sl_next, j); SBAR(); } } while (0)
#define STEP(C0, C1, P0, P1, t, GK, GV, GL) do { SBAR(); CONV_DRAIN(); SBAR(); \
    const lds_cptr vp_ = vp0 + sl_prev; \
    VRD(0); SBAR(); float sacc = (P0[0] + P0[1]); \
    GAPA(C0 = MFMA(kf[0], qr[0], negm), P0[2], P0[3], P0[4], P0[5],     pw0[0] = PKW(P0, 0), pw0[1] = PKW(P0, 2), pw0); \
    VRD(4); SBAR(); GAPA(C1 = MFMA(kf[1], qr[0], negm), P0[6], P0[7], P0[8], P0[9],     pw0[2] = PKW(P0, 4), pw0[3] = PKW(P0, 6), pw0); \
    VRD(1); SBAR(); GAPA(C0 = MFMA(kf[2], qr[1], C0),   P0[10], P0[11], P0[12], P0[13], pw1[0] = PKW(P0, 8), pw1[1] = PKW(P0, 10), pw1); \
    VRD(5); SBAR(); GAPA(C1 = MFMA(kf[3], qr[1], C1),   P0[14], P0[15], P1[0], P1[1],   pw1[2] = PKW(P0, 12), pw1[3] = PKW(P0, 14), pw1); \
    VRD(2); SBAR(); GAPA(C0 = MFMA(kf[4], qr[2], C0),   P1[2], P1[3], P1[4], P1[5],     pw2[0] = PKW(P1, 0), pw2[1] = PKW(P1, 2), pw2); \
    VRD(6); SBAR(); GAPA(C1 = MFMA(kf[5], qr[2], C1),   P1[6], P1[7], P1[8], P1[9],     pw2[2] = PKW(P1, 4), pw2[3] = PKW(P1, 6), pw2); \
    VRD(3); SBAR(); GAPA(C0 = MFMA(kf[6], qr[3], C0),   P1[10], P1[11], P1[12], P1[13], pw3[0] = PKW(P1, 8), pw3[1] = PKW(P1, 10), pw3); \
    VRD(7); SBAR(); GAPA(C1 = MFMA(kf[7], qr[3], C1),   P1[14], P1[15], 0.f, 0.f,       pw3[2] = PKW(P1, 12), pw3[3] = PKW(P1, 14), pw3); \
    l_reg += sacc; \
    if (GK) { DMA_K((t) + 3, sl_cur); } if (GV) { DMA_V((t) + 1, sl_next); } CONV_ISSUE(); \
    SBAR(); \
    GAPB(o[0] = MFMA(PAF(0), VFR(0), o[0]), C0, 0); \
    GAPB(o[1] = MFMA(PAF(0), VFR(4), o[1]), C0, 4); \
    KRD(GL, 0); GAPB(o[0] = MFMA(PAF(1), VFR(1), o[0]), C0, 8); \
    KRD(GL, 1); GAPB(o[1] = MFMA(PAF(1), VFR(5), o[1]), C0, 12); \
    KRD(GL, 2); GAPB(o[0] = MFMA(PAF(2), VFR(2), o[0]), C1, 0); \
    KRD(GL, 3); GAPB(o[1] = MFMA(PAF(2), VFR(6), o[1]), C1, 4); \
    GAPB(o[0] = MFMA(PAF(3), VFR(3), o[0]), C1, 8); \
    GAPB(o[1] = MFMA(PAF(3), VFR(7), o[1]), C1, 12); \
    } while (0)
    int t = 1;
    for (; t + 5 < NT; t += 2) {
        STEP(pB0, pB1, pA0, pA1, t, true, true, true);     WB_S(); RESC(); ROT();
        STEP(pA0, pA1, pB0, pB1, t + 1, true, true, true); WB_S(); RESC(); ROT();
    }
#define ENDW(tt) do { if ((tt) + 3 < NT) { WB_S(); } else if ((tt) + 2 < NT) { WB_E1(); } else { WB_E0(); } } while (0)
    for (; t + 1 < NT; t += 2) {
        STEP(pB0, pB1, pA0, pA1, t, (t + 3 < NT), (t + 1 < NT), (t + 1 < NT));         ENDW(t);     RESC(); ROT();
        STEP(pA0, pA1, pB0, pB1, t + 1, (t + 4 < NT), (t + 2 < NT), (t + 2 < NT));     ENDW(t + 1); RESC(); ROT();
    }
    STEP(pB0, pB1, pA0, pA1, NT - 1, false, false, false); RESC();
    {
        float sacc = pB0[0] + pB0[1];
#pragma unroll
        for (int r = 2; r < 16; ++r) sacc += pB0[r];
#pragma unroll
        for (int r = 0; r < 16; ++r) sacc += pB1[r];
        l_reg += sacc;
        pw0 = (u32x4){PKW(pB0, 0), PKW(pB0, 2), PKW(pB0, 4), PKW(pB0, 6)}; pw1 = (u32x4){PKW(pB0, 8), PKW(pB0, 10), PKW(pB0, 12), PKW(pB0, 14)};
        pw2 = (u32x4){PKW(pB1, 0), PKW(pB1, 2), PKW(pB1, 4), PKW(pB1, 6)}; pw3 = (u32x4){PKW(pB1, 8), PKW(pB1, 10), PKW(pB1, 12), PKW(pB1, 14)};
        SBAR();
        const lds_cptr vp_ = vp0 + sl_cur;
#pragma unroll
        for (int i = 0; i < 8; ++i) VRD(i);
        o[0] = MFMA(PAF(0), VFR(0), o[0]); o[1] = MFMA(PAF(0), VFR(4), o[1]); o[0] = MFMA(PAF(1), VFR(1), o[0]); o[1] = MFMA(PAF(1), VFR(5), o[1]);
        o[0] = MFMA(PAF(2), VFR(2), o[0]); o[1] = MFMA(PAF(2), VFR(6), o[1]); o[0] = MFMA(PAF(3), VFR(3), o[0]); o[1] = MFMA(PAF(3), VFR(7), o[1]);
    }
#undef PKW
#undef PAF
#undef VFR
#undef PIN
#undef GAPA
#undef GAPB
#undef EX
#undef VRD
#undef KRD
#undef STEP
#undef ENDW
    { auto rr = __builtin_amdgcn_permlane32_swap(__float_as_uint(l_reg), __float_as_uint(l_reg), false, false); l_reg = __uint_as_float(rr[0]) + __uint_as_float(rr[1]); }
    if (hi == 0) wsf[32 + r32] = l_reg; asm volatile("s_waitcnt lgkmcnt(0)" ::: "memory");
    float rli[16];
#pragma unroll
    for (int r = 0; r < 16; ++r) rli[r] = __builtin_amdgcn_rcpf(wsf[32 + crow(r, hi)]);
    bf16_t* Ow = Ob + (size_t)(wid * 32) * DM; bf16_t* stg = (bf16_t*)(shm + T_LDS_OST) + wid * 2048;
#pragma unroll
    for (int r = 0; r < 16; ++r) { const int orow = crow(r, hi);
#pragma unroll
        for (int d0 = 0; d0 < 2; ++d0) stg[orow * 64 + d0 * 32 + r32] = (bf16_t)f2bf(o[d0][r] * rli[r]); }
    asm volatile("s_waitcnt lgkmcnt(0)" ::: "memory");
#pragma unroll
    for (int i = 0; i < 4; ++i) { const int row = i * 8 + (lane >> 3), ch = lane & 7; const u32x4 v = *(const u32x4*)(stg + row * 64 + ch * 8); *(u32x4*)(Ow + (size_t)row * DM + ch * 8) = v;
        float q = 0.f;
#pragma unroll
        for (int d = 0; d < 4; ++d) { const float a = bf2f(v[d] & 0xffffu), bq = bf2f(v[d] >> 16); q += a * a + bq * bq; }
        q += dppmov<0xB1, 0xF>(0.f, q); q += dppmov<0x4E, 0xF>(0.f, q); q += dppmov<0x141, 0xF>(0.f, q);
        if (ch == 0) ostat[(size_t)(wid * 32 + row) * 16] = q; }
    asm volatile("s_waitcnt vmcnt(0) lgkmcnt(0)\n\ts_barrier" ::: "memory");
#if CONV_MODE >= 5
#undef WB_P
#undef WB_S
#undef WB_E1
#undef WB_E0
#endif
#undef DMA_K
#undef DMA_V
#undef START
#undef RESC
#undef ROT
}
constexpr int M_KSLOT = 12288, M_LDS_K = 0, M_LDS_V = 3 * M_KSLOT, M_LDS_WS = M_LDS_V + 3 * T_SLOTB, M_LDS_Q = M_LDS_WS + NWAVES * 256, M_LDS_OST = 0  ;
#define WBAR2() do { if (lowv) { WB_PL(); } else { WB_P(); } } while (0)
#define WBARS() do { if (lowv) { WB_SL(); } else { WB_S(); } } while (0)
template <int THRL>
__device__ __forceinline__ void unit96(const bf16_t* Qh, const bf16_t* __restrict__ Kh, const bf16_t* __restrict__ Vh, bf16_t* Ob, float* ostat, int q0, char* shm, ConvState& cs, float kb2) {
    constexpr int DQ = 96;
    int tid_ = threadIdx.x; asm volatile("" : "+v"(tid_));
    const int tid = tid_, lane = tid & 63, r32 = lane & 31, hi = lane >> 5; const int wid = __builtin_amdgcn_readfirstlane(tid >> 6);
    const bf16_t* Qw = Qh + (size_t)(q0 + wid * 32) * DQ;
    const unsigned lds0 = (unsigned)(uintptr_t)shm;
    float* wsf = (float*)(shm + M_LDS_WS) + wid * 64;
#if CONV_MODE >= 5
    const bool rkv = wid < 4, rcl = (wid == 4 || wid == 5), rst = wid >= 6; const int pw = wid & 3;
    const bf16_t* ksrc = Kh + (size_t)lane * DQ + pw * 8;
    const bool lowv = false;
#else
    const bf16_t* ksrc = Kh + (size_t)lane * DQ + wid * 8;
    const bf16_t* ksrc1 = Kh + (size_t)lane * DQ + (8 + (wid & 3)) * 8;
    const bool lowv = wid < 4;
#endif
#if CONV_MODE >= 5
    const bf16_t* vsrc = Vh + (size_t)(16 * pw + (lane >> 2)) * 64 + (lane & 3) * 8;
    const unsigned kdst = lds0 + M_LDS_K + pw * 1024, vdst = lds0 + M_LDS_V + pw * 1024, qdst = lds0 + M_LDS_Q + wid * 6144;
#define DMA_K(t, slot) do { if (rkv) { glds16(ksrc + (size_t)(t) * 64 * DQ, (unsigned)__builtin_amdgcn_readfirstlane(kdst + (slot))); \
        glds16(ksrc + 32 + (size_t)(t) * 64 * DQ, (unsigned)__builtin_amdgcn_readfirstlane(kdst + 4096 + (slot))); \
        glds16(ksrc + 64 + (size_t)(t) * 64 * DQ, (unsigned)__builtin_amdgcn_readfirstlane(kdst + 8192 + (slot))); } } while (0)
#define DMA_V(t, slot) do { if (rkv) { glds16(vsrc + (size_t)(t) * 64 * 64, (unsigned)__builtin_amdgcn_readfirstlane(vdst + (slot))); \
        glds16(vsrc + 32 + (size_t)(t) * 64 * 64, (unsigned)__builtin_amdgcn_readfirstlane(vdst + 4096 + (slot))); } } while (0)
#undef WBAR2
#undef WBARS
#define WBAR2() RWAIT(5)
#define WBARS() RWAIT(5)
#define WB_E1() RWAIT(2)
#define WB_E0() RWAIT(0)
#else
    const bf16_t* vsrc = Vh + (size_t)(16 * (wid & 3) + (lane >> 2)) * 64 + (wid >> 2) * 32 + (lane & 3) * 8;
    const unsigned kdst = lds0 + M_LDS_K + wid * 1024, kdst1 = lds0 + M_LDS_K + (8 + (wid & 3)) * 1024, vdst = lds0 + M_LDS_V + wid * 1024, qdst = lds0 + M_LDS_Q + wid * 6144;
#define DMA_K(t, slot) do { glds16(ksrc + (size_t)(t) * 64 * DQ, (unsigned)__builtin_amdgcn_readfirstlane(kdst + (slot))); \
        if (lowv) glds16(ksrc1 + (size_t)(t) * 64 * DQ, (unsigned)__builtin_amdgcn_readfirstlane(kdst1 + (slot))); } while (0)
#define DMA_V(t, slot) glds16(vsrc + (size_t)(t) * 64 * 64, (unsigned)__builtin_amdgcn_readfirstlane(vdst + (slot)))
#endif
    const int vb0 = (int)(lds0 + M_LDS_V) + ((lane >> 4) & 1) * 32 + (lane & 3) * 8 + (4 * hi + ((lane & 15) >> 2)) * 64;
    bf16x8 kf[12];
    const lds_cptr shm3 = (lds_cptr)shm; const lds_cptr kp0 = shm3 + M_LDS_K + hi * 1024 + r32 * 16; const lds_cptr qp0 = shm3 + M_LDS_Q + wid * 6144 + lane * 16;
    const lds_cptr vp0 = shm3 + M_LDS_V + ((lane >> 4) & 1) * 32 + (lane & 3) * 8 + (4 * hi + ((lane & 15) >> 2)) * 64;
#pragma unroll
    for (int d0 = 0; d0 < 6; ++d0) glds16(Qw + (size_t)r32 * DQ + d0 * 16 + hi * 8, (unsigned)__builtin_amdgcn_readfirstlane(qdst + d0 * 1024));
    DMA_K(0, 0); DMA_V(0, 0); DMA_K(1, M_KSLOT);
#define QF(d0) (*(const __attribute__((address_space(3))) bf16x8*)(qp0 + (d0) * 1024))
    float mhat = 0.f, l_reg = 0.f; f32x16 o[2]; o[0] = f32x16{}; o[1] = f32x16{}; f32x16 negm = f32x16{}; asm volatile("" : "+v"(negm));
    bool resc = false;
#define START(P0, P1) do { resc = false; _Pragma("unroll") for (int r = 0; r < 16; ++r) P0[r] = __builtin_amdgcn_exp2f(P0[r]); } while (0)
#define RESC() do { if (resc) { asm volatile("s_waitcnt lgkmcnt(0)" ::: "memory"); \
      _Pragma("unroll") for (int d_ = 0; d_ < 2; ++d_) _Pragma("unroll") for (int r = 0; r < 16; ++r) o[d_][r] *= wsf[crow(r, hi)]; } } while (0)
    f32x16 pA0, pA1, pB0, pB1;
    int sl_prev = 0, sl_cur = 0, sl_next = M_KSLOT; int vs_prev = 0, vs_cur = 0, vs_next = T_SLOTB;
#define ROT() do { sl_prev = sl_cur; sl_cur = sl_next; sl_next = (sl_next == 2 * M_KSLOT) ? 0 : sl_next + M_KSLOT; vs_prev = vs_cur; vs_cur = vs_next; vs_next = (vs_next == 2 * T_SLOTB) ? 0 : vs_next + T_SLOTB; } while (0)
    DMA_K(2, 2 * M_KSLOT);
    WAIT_BAR(0);
    {
        float qn = 0.f;
#pragma unroll
        for (int d0 = 0; d0 < 6; ++d0) { const bf16x8 qf = QF(d0);
#pragma unroll
            for (int i = 0; i < 8; ++i) { const float x = bf2f((unsigned short)qf[i]); qn += x * x; } }
        auto rr = __builtin_amdgcn_permlane32_swap(__float_as_uint(qn), __float_as_uint(qn), false, false); qn = __uint_as_float(rr[0]) + __uint_as_float(rr[1]);
        mhat = fminf(sqrtf(qn * kb2) * 1.02f + 0.5f, 60.f);
#pragma unroll
        for (int r = 0; r < 16; ++r) negm[r] = -mhat;
        asm volatile("" : "+v"(negm));
    }
    CONV_DRAIN();
    {
        const lds_cptr kb = kp0;
#pragma unroll
        for (int d0 = 0; d0 < 6; ++d0) {
            const bf16x8 b0 = *(const __attribute__((address_space(3))) bf16x8*)(kb + d0 * 2048);
            const bf16x8 b1 = *(const __attribute__((address_space(3))) bf16x8*)(kb + d0 * 2048 + 512);
            const bf16x8 qf = QF(d0);
            if (d0 == 0) { pA0 = MFMA(b0, qf, negm); pA1 = MFMA(b1, qf, negm); }
            else { pA0 = MFMA(b0, qf, pA0); pA1 = MFMA(b1, qf, pA1); } }
    }
    asm volatile("s_nop 15\n\ts_nop 7" : "+v"(pA0), "+v"(pA1));
    START(pA0, pA1);
#pragma unroll
    for (int r = 0; r < 16; ++r) pA1[r] = __builtin_amdgcn_exp2f(pA1[r]);
    WAIT_BAR(0);
    DMA_K(3, 0); DMA_V(1, T_SLOTB); CONV_ISSUE();
    ROT();
#pragma unroll
    for (int j = 0; j < 6; ++j) kload2(kf, kp0 + sl_cur, j);
    WBAR2();
    s16x4 vlo[8], vhi[8]; u32x4 pw0, pw1, pw2, pw3;
#define PKW(P, B) cvtpk_s(P[B], P[B + 1])
#define PAF(k) __builtin_bit_cast(bf16x8, pw##k)
#define VFR(i) (bf16x8){vlo[i][0], vlo[i][1], vlo[i][2], vlo[i][3], vhi[i][0], vhi[i][1], vhi[i][2], vhi[i][3]}
#define PIN(x) asm volatile("" : "+v"(x))
#define GAPA(MF, A0, A1, A2, A3, W0, W1, PW) do { MF; sacc += A0; sacc += A1; sacc += A2; sacc += A3; PIN(sacc); W0; W1; PIN(PW); SBAR(); } while (0)
#define EX(v) __builtin_amdgcn_exp2f(v)
#define GAPB(MF, X, B) do { MF; X[B] = EX(X[B]); X[B + 1] = EX(X[B + 1]); X[B + 2] = EX(X[B + 2]); X[B + 3] = EX(X[B + 3]); PIN(X); SBAR(); } while (0)
#define VRD(i) do { vlo[i] = vtr(vp_ + (((i) >> 2) * 4096 + ((i) & 3) * 1024)); vhi[i] = vtr(vp_ + (((i) >> 2) * 4096 + ((i) & 3) * 1024 + 512)); } while (0)
#define KRD(G, j) do { if (G) { kload2(kf, kp0 + sl_next, j); SBAR(); } } while (0)
#define STEP(C0, C1, P0, P1, t, GK, GV, GL) do { SBAR(); CONV_DRAIN(); SBAR(); \
    const lds_cptr vp_ = vp0 + vs_prev; \
    bf16x8 qa = QF(0), qb = QF(1); \
    VRD(0); SBAR(); float sacc = (P0[0] + P0[1]); \
    GAPA(C0 = MFMA(kf[0], qa, negm), P0[2], P0[3], P0[4], P0[5],     pw0[0] = PKW(P0, 0), pw0[1] = PKW(P0, 2), pw0); \
    VRD(4); SBAR(); GAPA(C1 = MFMA(kf[1], qa, negm), P0[6], P0[7], P0[8], P0[9],     pw0[2] = PKW(P0, 4), pw0[3] = PKW(P0, 6), pw0); \
    qa = QF(2); VRD(1); SBAR(); GAPA(C0 = MFMA(kf[2], qb, C0),   P0[10], P0[11], P0[12], P0[13], pw1[0] = PKW(P0, 8), pw1[1] = PKW(P0, 10), pw1); \
    VRD(5); SBAR(); GAPA(C1 = MFMA(kf[3], qb, C1),   P0[14], P0[15], P1[0], P1[1],   pw1[2] = PKW(P0, 12), pw1[3] = PKW(P0, 14), pw1); \
    qb = QF(3); VRD(2); SBAR(); GAPA(C0 = MFMA(kf[4], qa, C0),   P1[2], P1[3], P1[4], P1[5],     pw2[0] = PKW(P1, 0), pw2[1] = PKW(P1, 2), pw2); \
    VRD(6); SBAR(); GAPA(C1 = MFMA(kf[5], qa, C1),   P1[6], P1[7], P1[8], P1[9],     pw2[2] = PKW(P1, 4), pw2[3] = PKW(P1, 6), pw2); \
    qa = QF(4); VRD(3); SBAR(); GAPA(C0 = MFMA(kf[6], qb, C0),   P1[10], P1[11], P1[12], P1[13], pw3[0] = PKW(P1, 8), pw3[1] = PKW(P1, 10), pw3); \
    VRD(7); SBAR(); GAPA(C1 = MFMA(kf[7], qb, C1),   P1[14], P1[15], 0.f, 0.f,       pw3[2] = PKW(P1, 12), pw3[3] = PKW(P1, 14), pw3); \
    qb = QF(5); SBAR(); C0 = MFMA(kf[8], qa, C0); C1 = MFMA(kf[9], qa, C1); SBAR(); \
    C0 = MFMA(kf[10], qb, C0); C1 = MFMA(kf[11], qb, C1); SBAR(); \
    l_reg += sacc; \
    if (GK) { DMA_K((t) + 3, sl_cur); } if (GV) { DMA_V((t) + 1, vs_next); } CONV_ISSUE(); \
    SBAR(); \
    GAPB(o[0] = MFMA(PAF(0), VFR(0), o[0]), C0, 0); \
    KRD(GL, 0); GAPB(o[1] = MFMA(PAF(0), VFR(4), o[1]), C0, 4); \
    KRD(GL, 1); GAPB(o[0] = MFMA(PAF(1), VFR(1), o[0]), C0, 8); \
    KRD(GL, 2); GAPB(o[1] = MFMA(PAF(1), VFR(5), o[1]), C0, 12); \
    KRD(GL, 3); GAPB(o[0] = MFMA(PAF(2), VFR(2), o[0]), C1, 0); \
    KRD(GL, 4); GAPB(o[1] = MFMA(PAF(2), VFR(6), o[1]), C1, 4); \
    KRD(GL, 5); GAPB(o[0] = MFMA(PAF(3), VFR(3), o[0]), C1, 8); \
    GAPB(o[1] = MFMA(PAF(3), VFR(7), o[1]), C1, 12); \
    } while (0)
    int t = 1;
    for (; t + 5 < NT; t += 2) {
        STEP(pB0, pB1, pA0, pA1, t, true, true, true);     WBARS(); RESC(); ROT();
        STEP(pA0, pA1, pB0, pB1, t + 1, true, true, true); WBARS(); RESC(); ROT();
    }
#define ENDW(tt) do { if ((tt) + 3 < NT) { WBARS(); } else if ((tt) + 2 < NT) { WB_E1(); } else { WB_E0(); } } while (0)
    for (; t + 1 < NT; t += 2) {
        STEP(pB0, pB1, pA0, pA1, t, (t + 3 < NT), (t + 1 < NT), (t + 1 < NT));         ENDW(t);     RESC(); ROT();
        STEP(pA0, pA1, pB0, pB1, t + 1, (t + 4 < NT), (t + 2 < NT), (t + 2 < NT));     ENDW(t + 1); RESC(); ROT();
    }
    STEP(pB0, pB1, pA0, pA1, NT - 1, false, false, false); RESC();
    {
        float sacc = pB0[0] + pB0[1];
#pragma unroll
        for (int r = 2; r < 16; ++r) sacc += pB0[r];
#pragma unroll
        for (int r = 0; r < 16; ++r) sacc += pB1[r];
        l_reg += sacc;
        pw0 = (u32x4){PKW(pB0, 0), PKW(pB0, 2), PKW(pB0, 4), PKW(pB0, 6)}; pw1 = (u32x4){PKW(pB0, 8), PKW(pB0, 10), PKW(pB0, 12), PKW(pB0, 14)};
        pw2 = (u32x4){PKW(pB1, 0), PKW(pB1, 2), PKW(pB1, 4), PKW(pB1, 6)}; pw3 = (u32x4){PKW(pB1, 8), PKW(pB1, 10), PKW(pB1, 12), PKW(pB1, 14)};
        SBAR();
        const lds_cptr vp_ = vp0 + vs_cur;
#pragma unroll
        for (int i = 0; i < 8; ++i) VRD(i);
        o[0] = MFMA(PAF(0), VFR(0), o[0]); o[1] = MFMA(PAF(0), VFR(4), o[1]); o[0] = MFMA(PAF(1), VFR(1), o[0]); o[1] = MFMA(PAF(1), VFR(5), o[1]);
        o[0] = MFMA(PAF(2), VFR(2), o[0]); o[1] = MFMA(PAF(2), VFR(6), o[1]); o[0] = MFMA(PAF(3), VFR(3), o[0]); o[1] = MFMA(PAF(3), VFR(7), o[1]);
    }
#undef PKW
#undef PAF
#undef VFR
#undef PIN
#undef GAPA
#undef GAPB
#undef EX
#undef VRD
#undef KRD
#undef STEP
#undef ENDW
    { auto rr = __builtin_amdgcn_permlane32_swap(__float_as_uint(l_reg), __float_as_uint(l_reg), false, false); l_reg = __uint_as_float(rr[0]) + __uint_as_float(rr[1]); }
    if (hi == 0) wsf[32 + r32] = l_reg; asm volatile("s_waitcnt lgkmcnt(0)" ::: "memory");
    float rli[16];
#pragma unroll
    for (int r = 0; r < 16; ++r) rli[r] = __builtin_amdgcn_rcpf(wsf[32 + crow(r, hi)]);
    bf16_t* Ow = Ob + (size_t)(wid * 32) * DM; bf16_t* stg = (bf16_t*)(shm + M_LDS_OST) + wid * 2048;
#pragma unroll
    for (int r = 0; r < 16; ++r) { const int orow = crow(r, hi);
#pragma unroll
        for (int d0 = 0; d0 < 2; ++d0) stg[orow * 64 + d0 * 32 + r32] = (bf16_t)f2bf(o[d0][r] * rli[r]); }
    asm volatile("s_waitcnt lgkmcnt(0)" ::: "memory");
#pragma unroll
    for (int i = 0; i < 4; ++i) { const int row = i * 8 + (lane >> 3), ch = lane & 7; const u32x4 v = *(const u32x4*)(stg + row * 64 + ch * 8); *(u32x4*)(Ow + (size_t)row * DM + ch * 8) = v;
        float q = 0.f;
#pragma unroll
        for (int d = 0; d < 4; ++d) { const float a = bf2f(v[d] & 0xffffu), bq = bf2f(v[d] >> 16); q += a * a + bq * bq; }
        q += dppmov<0xB1, 0xF>(0.f, q); q += dppmov<0x4E, 0xF>(0.f, q); q += dppmov<0x141, 0xF>(0.f, q);
        if (ch == 0) ostat[(size_t)(wid * 32 + row) * 16] = q; }
    asm volatile("s_waitcnt vmcnt(0) lgkmcnt(0)\n\ts_barrier" ::: "memory");
#if CONV_MODE >= 5
#undef WB_E1
#undef WB_E0
#endif
#undef QF
#undef DMA_K
#undef DMA_V
#undef START
#undef RESC
#undef ROT
}
#undef WBAR2
#undef WBARS
#undef WAIT_BAR
}


namespace pg8 {
typedef short bf16x8 __attribute__((ext_vector_type(8)));
typedef float f32x4 __attribute__((ext_vector_type(4)));
typedef unsigned u32x4 __attribute__((ext_vector_type(4)));
constexpr int BM = 256, BK = 64, HALF = 128, HTB = HALF * BK * 2, STAGE_BYTES = 8 * HTB, NXCD = 8, WGM = 8;
__host__ __device__ __forceinline__ int lds_byte(int r, int c) { const int st = (r >> 4) * 2 + (c >> 5), rr = r & 15, cc = c & 31, ob = rr * 64 + cc * 2; return st * 1024 + (ob ^ (((ob >> 9) & 1) << 5)); }
__host__ __device__ __forceinline__ void stage_rc(int b, int& R, int& C) { const int st = b / 1024, sb = b % 1024, swz = sb ^ (((sb >> 9) & 1) << 5); R = (st >> 1) * 16 + swz / 64; C = (st & 1) * 32 + (swz % 64) / 2; }
__host__ __device__ __forceinline__ int perm32(int rho) { const int n = rho >> 4, i = rho & 15; return 8 * (i >> 2) + 4 * n + (i & 3); }
__device__ __forceinline__ unsigned cvt_pk_bf16(float lo, float hi) { unsigned r; asm volatile("v_cvt_pk_bf16_f32 %0, %1, %2" : "=v"(r) : "v"(lo), "v"(hi)); return r; }

struct Unit { int pm, pn, e, nrows, rowbase; };

struct DenseOrder {
    int nM, nN, nwg, G, c, K; const char* Bt;
    __device__ void init(int M, int N, int K_, const bf16_t* Bt_, int G_, int c_) { nM = M / BM; nN = N / BM; nwg = nM * nN; G = G_; c = c_; K = K_; Bt = (const char*)Bt_; }
    __device__ __forceinline__ bool next(int i, Unit& u) const {
        const long L = (long)i * G + c; if (L >= nwg) return false;
        int wgid = (int)L; { const int q = nwg / NXCD, r = nwg % NXCD, xcd = wgid % NXCD, off = wgid / NXCD; wgid = (xcd < r ? xcd * (q + 1) : r * (q + 1) + (xcd - r) * q) + off; }
        const int nig = WGM * nN, gid = wgid / nig, fm = gid * WGM, gsz = (nM - fm) < WGM ? (nM - fm) : WGM;
        u.pm = fm + ((wgid % nig) % gsz); u.pn = (wgid % nig) / gsz; u.e = 0; u.nrows = 256; u.rowbase = u.pm * BM; return true;
    }
    __device__ __forceinline__ void a_offsets(const Unit&, int, unsigned (&)[2][2]) const {}
    __device__ __forceinline__ const char* b_tile(const Unit& u) const { return Bt + (size_t)u.pn * BM * K * 2; }
};

struct EpiBf16 {
    static constexpr bool PERM = true;
    bf16_t* O; int ldc;
    __device__ __forceinline__ void operator()(const f32x4 (&acc)[2][2][4][2], const Unit& u, int wr, int wc, int fr, int fq) const {
        const int row0 = u.pm * BM + wr * 64 + fr, col0 = u.pn * BM + wc * 32 + 8 * fq;
#pragma unroll
        for (int ai = 0; ai < 2; ++ai)
#pragma unroll
            for (int m = 0; m < 4; ++m) { bf16_t* rowp = O + (size_t)(row0 + ai * HALF + m * 16) * ldc + col0;
#pragma unroll
                for (int bj = 0; bj < 2; ++bj) { const f32x4 v0 = acc[ai][bj][m][0], v1 = acc[ai][bj][m][1];
                    u32x4 w; w.x = cvt_pk_bf16(v0[0], v0[1]); w.y = cvt_pk_bf16(v0[2], v0[3]); w.z = cvt_pk_bf16(v1[0], v1[1]); w.w = cvt_pk_bf16(v1[2], v1[3]);
                    *(u32x4*)(rowp + bj * HALF) = w; } }
    }
};


__device__ __forceinline__ float silu_mul(float g, float u) { return g * __builtin_amdgcn_rcpf(1.f + __expf(-g)) * u; }

struct MoeOrder {
    const LAS int* pre; const LAS int* offs; const LAS int* cntl; const int* list; const char* Bt; size_t bstride; int K, npn, G, c, mode;
    __device__ __forceinline__ bool next(int i, Unit& u) const {
        const int L = i * G + c, total = pre[NE] * npn; if (L >= total) return false;
        const int rtg = L / npn; const int pn = L - rtg * npn;
        int lo_ = 0, hi_ = NE;
        while (hi_ - lo_ > 1) { const int mid = (lo_ + hi_) >> 1; if (pre[mid] <= rtg) lo_ = mid; else hi_ = mid; }
        const int e = lo_, pm = rtg - pre[e], n = cntl[e] - pm * BM;
        u.e = __builtin_amdgcn_readfirstlane(e); u.pm = __builtin_amdgcn_readfirstlane(pm); u.pn = __builtin_amdgcn_readfirstlane(pn);
        u.nrows = __builtin_amdgcn_readfirstlane(n < BM ? n : BM); u.rowbase = __builtin_amdgcn_readfirstlane(offs[e] + pm * BM); return true;
    }
    __device__ __forceinline__ void a_offsets(const Unit& u, int tid, unsigned (&ua)[2][2]) const {
#pragma unroll
        for (int i = 0; i < 2; ++i) { int R, C; stage_rc(tid * 16 + i * 8192, R, C);
#pragma unroll
            for (int h = 0; h < 2; ++h) { int r = h * HALF + R; if (r >= u.nrows) r = 0; const int row = list[(size_t)u.e * LCAP + u.pm * BM + r] >> 3;
                ua[h][i] = (unsigned)((row * K + C) * 2); } }
    }
    __device__ __forceinline__ const char* b_tile(const Unit& u) const { return Bt + (size_t)u.e * bstride + (size_t)u.pn * BM * K * 2; }
};

struct EpiAct {
    static constexpr bool PERM = true;
    bf16_t* ACT;
    __device__ __forceinline__ void operator()(const f32x4 (&acc)[2][2][4][2], const Unit& u, int wr, int wc, int fr, int fq) const {
        const __amdgpu_buffer_rsrc_t rs = __builtin_amdgcn_make_buffer_rsrc((void*)ACT, 0, (NTOK * TOPK + 256) * EFF * 2, 0x00020000);
        const unsigned cb = (unsigned)((u.pn * HALF + wc * 32 + 8 * fq) * 2);
#pragma unroll
        for (int ai = 0; ai < 2; ++ai)
#pragma unroll
            for (int m = 0; m < 4; ++m) { const int r = ai * HALF + wr * 64 + m * 16 + fr;
                const unsigned off = (r < u.nrows) ? (unsigned)(u.rowbase + r) * (EFF * 2) + cb : 0xFFFFFFF0u;
                const f32x4 g0 = acc[ai][0][m][0], g1 = acc[ai][0][m][1], u0 = acc[ai][1][m][0], u1 = acc[ai][1][m][1];
                u32x4 w; w.x = cvt_pk_bf16(silu_mul(g0[0], u0[0]), silu_mul(g0[1], u0[1])); w.y = cvt_pk_bf16(silu_mul(g0[2], u0[2]), silu_mul(g0[3], u0[3]));
                w.z = cvt_pk_bf16(silu_mul(g1[0], u1[0]), silu_mul(g1[1], u1[1])); w.w = cvt_pk_bf16(silu_mul(g1[2], u1[2]), silu_mul(g1[3], u1[3]));
                __builtin_amdgcn_raw_buffer_store_b128(w, rs, off, 0, 0); }
    }
};
struct EpiSlots {
    static constexpr bool PERM = true;
    unsigned char* SL;
    __device__ __forceinline__ void operator()(const f32x4 (&acc)[2][2][4][2], const Unit& u, int wr, int wc, int fr, int fq) const {
        const __amdgpu_buffer_rsrc_t rs = __builtin_amdgcn_make_buffer_rsrc((void*)SL, 0, NTOK * TOPK * DM, 0x00020000);
        const unsigned cb = (unsigned)(u.pn * BM + wc * 32 + 8 * fq);
#pragma unroll
        for (int ai = 0; ai < 2; ++ai)
#pragma unroll
            for (int m = 0; m < 4; ++m) { const int r = ai * HALF + wr * 64 + m * 16 + fr;
                const unsigned off = (r < u.nrows) ? (unsigned)(u.rowbase + r) * DM + cb : 0xFFFFFFF0u;
#pragma unroll
                for (int bj = 0; bj < 2; ++bj) { const f32x4 v0 = acc[ai][bj][m][0] * 16.f, v1 = acc[ai][bj][m][1] * 16.f;
                    int lo = __builtin_amdgcn_cvt_pk_fp8_f32(v0[0], v0[1], 0, false); lo = __builtin_amdgcn_cvt_pk_fp8_f32(v0[2], v0[3], lo, true);
                    int hi = __builtin_amdgcn_cvt_pk_fp8_f32(v1[0], v1[1], 0, false); hi = __builtin_amdgcn_cvt_pk_fp8_f32(v1[2], v1[3], hi, true);
                    typedef unsigned u32x2 __attribute__((ext_vector_type(2)));
                    __builtin_amdgcn_raw_buffer_store_b64((u32x2){(unsigned)lo, (unsigned)hi}, rs, off, bj * HALF, 0); } }
    }
};
struct EpiRS {
    static constexpr bool PERM = true;
    float* LOG; bf16_t* ACTS;
    __device__ __forceinline__ void operator()(const f32x4 (&acc)[2][2][4][2], const Unit& u, int wr, int wc, int fr, int fq) const {
        const int row0 = u.pm * BM + wr * 64 + fr;
#pragma unroll
        for (int ai = 0; ai < 2; ++ai)
#pragma unroll
            for (int m = 0; m < 4; ++m) { const int row = row0 + ai * HALF + m * 16;
                if (u.pn == 0) {
#pragma unroll
                    for (int bj = 0; bj < 2; ++bj) { float* lp = LOG + (size_t)row * NE + bj * HALF + wc * 32 + 8 * fq; *(f32x4*)lp = acc[ai][bj][m][0]; *(f32x4*)(lp + 4) = acc[ai][bj][m][1]; }
                } else {
                    const f32x4 g0 = acc[ai][0][m][0], g1 = acc[ai][0][m][1], u0 = acc[ai][1][m][0], u1 = acc[ai][1][m][1];
                    u32x4 w; w.x = cvt_pk_bf16(silu_mul(g0[0], u0[0]), silu_mul(g0[1], u0[1])); w.y = cvt_pk_bf16(silu_mul(g0[2], u0[2]), silu_mul(g0[3], u0[3]));
                    w.z = cvt_pk_bf16(silu_mul(g1[0], u1[0]), silu_mul(g1[1], u1[1])); w.w = cvt_pk_bf16(silu_mul(g1[2], u1[2]), silu_mul(g1[3], u1[3]));
                    *(u32x4*)(ACTS + (size_t)row * EFF + (u.pn - 1) * HALF + wc * 32 + 8 * fq) = w; } }
    }
};

struct EpiBf16RowScale {
    static constexpr bool PERM = true;
    bf16_t* O; int ldc; const LAS float* rtab;
    __device__ __forceinline__ void operator()(const f32x4 (&acc)[2][2][4][2], const Unit& u, int wr, int wc, int fr, int fq) const {
        const int row0 = u.pm * BM + wr * 64 + fr, col0 = u.pn * BM + wc * 32 + 8 * fq;
#pragma unroll
        for (int ai = 0; ai < 2; ++ai)
#pragma unroll
            for (int m = 0; m < 4; ++m) { const int row = row0 + ai * HALF + m * 16; bf16_t* rowp = O + (size_t)row * ldc + col0;
                const float g = rtab[2 * (row - u.pm * BM) + 1];
#pragma unroll
                for (int bj = 0; bj < 2; ++bj) { const f32x4 v0 = acc[ai][bj][m][0] * g, v1 = acc[ai][bj][m][1] * g;
                    u32x4 w; w.x = cvt_pk_bf16(v0[0], v0[1]); w.y = cvt_pk_bf16(v0[2], v0[3]); w.z = cvt_pk_bf16(v1[0], v1[1]); w.w = cvt_pk_bf16(v1[2], v1[3]);
                    *(u32x4*)(rowp + bj * HALF) = w; } }
    }
};

template <class Epi, class Sched, bool ALIGN_EPI, bool GATHER = false, bool MIDSCALE = false>
__device__ __forceinline__ void gemm_phase(LAS unsigned char* lds, const bf16_t* Abase_, int K, const Sched& S, const Epi& E, const float* stat = nullptr) {
    int tid_ = threadIdx.x; asm volatile("" : "+v"(tid_));
    const int tid = tid_, wid = __builtin_amdgcn_readfirstlane(tid >> 6), lane = tid & 63, wr = wid >> 2, wc = wid & 3, fr = lane & 15, fq = lane >> 4;
    const int nt = K / BK;
    const char* Abase = (const char*)Abase_;
    unsigned voffB[2], voffA[2];
#pragma unroll
    for (int i = 0; i < 2; ++i) { int R, C; stage_rc(tid * 16 + i * 8192, R, C); const int Rb = Epi::PERM ? ((R & ~31) + perm32(R & 31)) : R; voffB[i] = (unsigned)(Rb * K + C) * 2u; voffA[i] = (unsigned)(R * K + C) * 2u; }
    const size_t kstep = (size_t)(BK * 2);
    const size_t hstep = (size_t)HALF * K * 2;
    const unsigned ldsw = (unsigned)wid * 1024u;
    const int aoff = lds_byte(wr * 64 + fr, fq * 8), boff = lds_byte(wc * 32 + fr, fq * 8);
#define PG8_SA(b, h) (((b) * 2 + (h)) * HTB)
#define PG8_SB(b, h) ((4 + (b) * 2 + (h)) * HTB)
#define PG8_STAGE_B(bufoff, gbase) do { _Pragma("unroll") for (int _i = 0; _i < 2; ++_i) \
        __builtin_amdgcn_global_load_lds((const unsigned*)((const char*)(gbase) + voffB[_i]), (LAS unsigned*)(lds + (bufoff) + ldsw + _i * 8192), 16, 0, 0); } while (0)
#define PG8_STAGE_A(bufoff, ua, pa, h, koff) do { _Pragma("unroll") for (int _i = 0; _i < 2; ++_i) { \
        const char* _g = GATHER ? (Abase + (size_t)(ua)[h][_i] + (koff)) : ((pa) + (size_t)(h) * hstep + voffA[_i] + (koff)); \
        __builtin_amdgcn_global_load_lds((const unsigned*)_g, (LAS unsigned*)(lds + (bufoff) + ldsw + _i * 8192), 16, 0, 0); } } while (0)
#define PG8_LDA(dst, b, h) do { _Pragma("unroll") for (int m = 0; m < 4; ++m) _Pragma("unroll") for (int k = 0; k < 2; ++k) dst[m][k] = *(const LAS bf16x8*)(lds + PG8_SA(b, h) + aoff + m * 2048 + k * 1024); } while (0)
#define PG8_LDB(dst, b, h) do { _Pragma("unroll") for (int n = 0; n < 2; ++n) _Pragma("unroll") for (int k = 0; k < 2; ++k) dst[n][k] = *(const LAS bf16x8*)(lds + PG8_SB(b, h) + boff + n * 2048 + k * 1024); } while (0)
#define PG8_MMA(ai, bj, At, Bt) do { __builtin_amdgcn_s_setprio(1); _Pragma("unroll") for (int m = 0; m < 4; ++m) _Pragma("unroll") for (int n = 0; n < 2; ++n) _Pragma("unroll") for (int k = 0; k < 2; ++k) \
        acc[ai][bj][m][n] = __builtin_amdgcn_mfma_f32_16x16x32_bf16(Bt[n][k], At[m][k], acc[ai][bj][m][n], 0, 0, 0); __builtin_amdgcn_s_setprio(0); } while (0)
#define PG8_WAIT_V(n) asm volatile("s_waitcnt vmcnt(" #n ")" ::: "memory")
#define PG8_WAIT_L(n) asm volatile("s_waitcnt lgkmcnt(" #n ")" ::: "memory")
#define PG8_BAR __builtin_amdgcn_s_barrier()
#define PG8_SCHED __builtin_amdgcn_sched_barrier(0)
    Unit cur, nxt; int ui = 0;
    if (!S.next(0, cur)) return;
    f32x4 acc[2][2][4][2];
#pragma unroll
    for (int a = 0; a < 2; ++a)
#pragma unroll
        for (int b = 0; b < 2; ++b)
#pragma unroll
            for (int m = 0; m < 4; ++m)
#pragma unroll
                for (int n = 0; n < 2; ++n) acc[a][b][m][n] = (f32x4){0.f, 0.f, 0.f, 0.f};
    bf16x8 At[4][2], B0[2][2], B1[2][2];
    unsigned uc[2][2], un[2][2];
    if constexpr (GATHER) S.a_offsets(cur, tid, uc);
    const char* cA = Abase + (size_t)cur.rowbase * K * 2;
    const char* cB = S.b_tile(cur);
    PG8_STAGE_B(PG8_SB(0, 0), cB); PG8_STAGE_B(PG8_SB(0, 1), cB + hstep); PG8_STAGE_A(PG8_SA(0, 0), uc, cA, 0, (size_t)0); PG8_STAGE_A(PG8_SA(0, 1), uc, cA, 1, (size_t)0);
    if (wr == 1) PG8_BAR;
    PG8_WAIT_V(2); PG8_BAR;
    PG8_STAGE_B(PG8_SB(1, 0), cB + kstep); PG8_STAGE_A(PG8_SA(1, 0), uc, cA, 0, kstep); PG8_STAGE_B(PG8_SB(1, 1), cB + hstep + kstep);
    PG8_WAIT_V(6); PG8_BAR;
    for (;;) {
        const bool has_next = S.next(ui + 1, nxt);
        const bool lower = cur.nrows > wr * 64, upper = cur.nrows > HALF + wr * 64;
        const char* nB = cB; const char* nA = cA;
        if (has_next) { if constexpr (GATHER) S.a_offsets(nxt, tid, un); nB = S.b_tile(nxt); nA = Abase + (size_t)nxt.rowbase * K * 2; }
        else if constexpr (GATHER) {
#pragma unroll
            for (int h = 0; h < 2; ++h)
#pragma unroll
                for (int i = 0; i < 2; ++i) un[h][i] = uc[h][i];
        }
#pragma unroll 1
        for (int t = 0; t < nt; t += 2) {
            const bool last = (t == nt - 2);
            const size_t k1 = (size_t)(t + 1) * kstep;
            const size_t k2 = last ? (size_t)0 : (size_t)(t + 2) * kstep, k3 = k2 + kstep;
            const char* b2 = last ? nB : cB + (size_t)(t + 2) * kstep; const char* b3 = b2 + kstep;
            const char* a2 = last ? nA : cA;
            unsigned x2[2][2];
            if constexpr (GATHER) {
#pragma unroll
                for (int h = 0; h < 2; ++h)
#pragma unroll
                    for (int i = 0; i < 2; ++i) x2[h][i] = uc[h][i];
                if (last) { asm volatile("; next unit's A offsets" ::: "memory");
#pragma unroll
                    for (int h = 0; h < 2; ++h)
#pragma unroll
                        for (int i = 0; i < 2; ++i) x2[h][i] = un[h][i]; }
            }
            if constexpr (MIDSCALE) { if (t == nt / 2) {
#pragma unroll
                for (int ai = 0; ai < 2; ++ai)
#pragma unroll
                    for (int m = 0; m < 4; ++m) { const float f = ((const LAS float*)(lds + STAGE_BYTES))[2 * (ai * HALF + wr * 64 + m * 16 + fr)];
#pragma unroll
                        for (int bj = 0; bj < 2; ++bj)
#pragma unroll
                            for (int n = 0; n < 2; ++n) acc[ai][bj][m][n] *= f; } } }
            PG8_LDB(B0, 0, 0); PG8_LDB(B1, 0, 1); PG8_SCHED; PG8_LDA(At, 0, 0); PG8_STAGE_A(PG8_SA(1, 1), uc, cA, 1, k1);
            PG8_WAIT_V(8); PG8_WAIT_L(0); PG8_BAR; if (lower) { PG8_MMA(0, 0, At, B0); PG8_MMA(0, 1, At, B1); } PG8_BAR; PG8_SCHED;
            PG8_LDA(At, 0, 1); PG8_STAGE_B(PG8_SB(0, 0), b2); PG8_STAGE_B(PG8_SB(0, 1), b2 + hstep); PG8_STAGE_A(PG8_SA(0, 0), x2, a2, 0, k2);
            PG8_WAIT_V(8); PG8_WAIT_L(0); PG8_BAR; if (upper) { PG8_MMA(1, 0, At, B0); PG8_MMA(1, 1, At, B1); } PG8_BAR; PG8_SCHED;
            PG8_LDB(B0, 1, 0); PG8_LDB(B1, 1, 1); PG8_SCHED; PG8_LDA(At, 1, 0); PG8_STAGE_A(PG8_SA(0, 1), x2, a2, 1, k2);
            PG8_WAIT_V(8); PG8_WAIT_L(0); PG8_BAR; if (lower) { PG8_MMA(0, 0, At, B0); PG8_MMA(0, 1, At, B1); } PG8_BAR; PG8_SCHED;
            PG8_LDA(At, 1, 1); PG8_STAGE_B(PG8_SB(1, 0), b3); PG8_STAGE_B(PG8_SB(1, 1), b3 + hstep); PG8_STAGE_A(PG8_SA(1, 0), x2, a2, 0, k3);
            PG8_WAIT_V(8); PG8_WAIT_L(0); PG8_BAR; if (upper) { PG8_MMA(1, 0, At, B0); PG8_MMA(1, 1, At, B1); } PG8_BAR; PG8_SCHED;
        }
        if constexpr (ALIGN_EPI) { if (wr == 0) PG8_BAR; }
        E(acc, cur, wr, wc, fr, fq);
        if (!has_next) break;
#pragma unroll
        for (int a = 0; a < 2; ++a)
#pragma unroll
            for (int b = 0; b < 2; ++b)
#pragma unroll
                for (int m = 0; m < 4; ++m)
#pragma unroll
                    for (int n = 0; n < 2; ++n) acc[a][b][m][n] = (f32x4){0.f, 0.f, 0.f, 0.f};
        cur = nxt; cB = nB; cA = nA; ++ui;
        if constexpr (GATHER) {
#pragma unroll
            for (int h = 0; h < 2; ++h)
#pragma unroll
                for (int i = 0; i < 2; ++i) uc[h][i] = un[h][i];
        }
        if constexpr (ALIGN_EPI) { if (wr == 1) PG8_BAR; }
    }
    PG8_WAIT_V(0);
    if constexpr (!ALIGN_EPI) { if (wr == 0) PG8_BAR; }
    PG8_BAR;
#undef PG8_SA
#undef PG8_SB
#undef PG8_STAGE_A
#undef PG8_STAGE_B
#undef PG8_LDA
#undef PG8_LDB
#undef PG8_MMA
#undef PG8_WAIT_V
#undef PG8_WAIT_L
#undef PG8_BAR
#undef PG8_SCHED
}
}

__device__ __forceinline__ void cvt_item(const float* W, int ldw, int col0, int k0, bf16_t* WT, int drow0, int Kd, const float* gk, LAS float* scr, int lane) {
    const int kr = lane >> 3, n4 = lane & 7;
    float4 v[8];
#pragma unroll
    for (int i = 0; i < 8; ++i) v[i] = *(const float4*)&W[(size_t)(k0 + 8 * i + kr) * ldw + col0 + 4 * n4];
#pragma unroll
    for (int i = 0; i < 8; ++i) { const int kk = 8 * i + kr; const float g = gk ? gk[k0 + kk] : 1.f; LAS float* d = scr + kk * 33 + 4 * n4;
        d[0] = v[i].x * g; d[1] = v[i].y * g; d[2] = v[i].z * g; d[3] = v[i].w * g; }
    asm volatile("s_waitcnt lgkmcnt(0)" ::: "memory");
    const int cch = lane & 7;
#pragma unroll
    for (int j = 0; j < 4; ++j) { const int n = (lane >> 3) + 8 * j; const LAS float* sp = scr + (8 * cch) * 33 + n;
        uint4 o; o.x = pk2(sp[0 * 33], sp[1 * 33]); o.y = pk2(sp[2 * 33], sp[3 * 33]); o.z = pk2(sp[4 * 33], sp[5 * 33]); o.w = pk2(sp[6 * 33], sp[7 * 33]);
        *(uint4*)(WT + (size_t)(drow0 + n) * Kd + k0 + 8 * cch) = o; }
    asm volatile("s_waitcnt lgkmcnt(0)" ::: "memory");
}
#define PHASE_PTRS \
    unsigned char* wsp = args.ws; asm volatile("" : "+s"(wsp)); \
    const float* x = args.in[0]; const float* cvec = args.in[1]; const float* w_ada = args.in[2]; const float* b_ada = args.in[3]; \
    const float* g_pre_mix = args.in[4]; const float* g_post_mix = args.in[5]; const float* g_pre_ffn = args.in[6]; const float* g_post_ffn = args.in[7]; \
    const float* w_in = args.in[8]; const float* g_q_a = args.in[9]; const float* w_q_b = args.in[10]; const float* g_kv_a = args.in[11]; const float* w_kv_b = args.in[12]; \
    const float* g_q_head = args.in[13]; const float* g_k_head = args.in[14]; const float* g_mla_out = args.in[15]; const float* g_gqa_out = args.in[16]; \
    const float* w_out = args.in[17]; const float* w_router = args.in[18]; const float* b_router = args.in[19]; \
    const float* w_gate_e = args.in[20]; const float* w_up_e = args.in[21]; const float* w_down_e = args.in[22]; \
    const float* w_gate_s = args.in[23]; const float* w_up_s = args.in[24]; const float* w_down_s = args.in[25]; \
    float* mod = (float*)(wsp + WS_MOD); \
    float* cosm = (float*)(wsp + WS_COSM); float* sinm = (float*)(wsp + WS_SINM); float* cosg = (float*)(wsp + WS_COSG); float* sing = (float*)(wsp + WS_SING); \
    bf16_t* H2 = (bf16_t*)(wsp + WS_H2); \
    bf16_t* QM = (bf16_t*)(wsp + WS_QM); bf16_t* KM = (bf16_t*)(wsp + WS_KM); bf16_t* VM = (bf16_t*)(wsp + WS_VM); \
    bf16_t* QG = (bf16_t*)(wsp + WS_QG); bf16_t* KG = (bf16_t*)(wsp + WS_KG); bf16_t* VG = (bf16_t*)(wsp + WS_VG); \
    bf16_t* O = (bf16_t*)(wsp + WS_O); \
    bf16_t* X1 = (bf16_t*)(wsp + WS_X1); float* WTS = (float*)(wsp + WS_WTS); int* LIST = (int*)(wsp + WS_LIST); \
    bf16_t* SLOTS = (bf16_t*)(wsp + WS_SLOTS); int* POSREC = (int*)(wsp + WS_POSREC); float* OSTAT = (float*)(wsp + WS_OSTAT); \
    bf16_t* PBUF = (bf16_t*)(wsp + WS_PBUF); bf16_t* WBIGT = (bf16_t*)(wsp + WS_WBIGT); \
    bf16_t* WQBT = (bf16_t*)(wsp + WS_WQBT); bf16_t* WINQ = (bf16_t*)(wsp + WS_WINQ); bf16_t* WKVBT = (bf16_t*)(wsp + WS_WKVBT); bf16_t* WINKV = (bf16_t*)(wsp + WS_WINKV); \
    bf16_t* WOUTT = (bf16_t*)(wsp + WS_WOUTT); bf16_t* WRST = (bf16_t*)(wsp + WS_WRST); bf16_t* WDST = (bf16_t*)(wsp + WS_WDST); \
    bf16_t* WGUT = (bf16_t*)(wsp + WS_WGUT); bf16_t* WDT = (bf16_t*)(wsp + WS_WDT); \
    bf16_t* MIXED = (bf16_t*)(wsp + WS_MIXED); float* LOG = (float*)(wsp + WS_LOG); bf16_t* ACT = (bf16_t*)(wsp + WS_ACT); bf16_t* ACTS = (bf16_t*)(wsp + WS_ACTS); bf16_t* YSH = (bf16_t*)(wsp + WS_YSH);

__global__ void __launch_bounds__(NTHR, 2) mega(Args args) {
    extern __shared__ __attribute__((aligned(16))) unsigned char lds_raw[];
    unsigned char* ws = args.ws;
    unsigned* ctl = (unsigned*)(ws + WS_CTL);
    volatile LAS unsigned* bst = (volatile LAS unsigned*)(lds_raw + LDS_BYTES - 16);
    if (threadIdx.x < 4) bst[threadIdx.x] = 0u;
    const int nbk = gridDim.x, bidk = blockIdx.x;
    __syncthreads();
    XcdBarrier bar; bar.bar = ctl + CW_BAR; bar.x = 0; bar.st = bst;
    if (MK_N_LAUNCHES == 1) bar = xcd_barrier_post(ctl + CW_BAR, bst);
    const int lo = args.ph_lo, hi = args.ph_hi;
    const int vcu = (nbk % 8 == 0) ? (bidk % 8) * (nbk / 8) + bidk / 8 : bidk;
    LAS unsigned char* ldsb = (LAS unsigned char*)lds_raw;
#define IN(k) (lo <= (k) && (k) < hi && (pass_ == 0 || ((k) >= REP_FROM && (k) != 8)))
#define SEAM(k) do { if (lo <= (k) && (k) + 1 < hi && (pass_ == 0 || (k) >= REP_FROM)) xcd_barrier(bar); } while (0)

    unsigned* CNT = (unsigned*)(ws + WS_CNTS);

    for (int pass_ = 0; pass_ < (REP_FROM < 12 ? 2 : 1); ++pass_) {
    if (pass_) xcd_barrier(bar);
    if (IN(0)) for (int rep_ = 0; rep_ < (((REPEAT_MASK >> 0) & 1) ? 2 : 1); ++rep_) {
        const Ctx c = mkctx(ws, lds_raw); PHASE_PTRS
        float* red = c.lds;
        if (c.tid == 0) for (int e = c.bid; e < NE; e += c.nb) CNT[(size_t)e * CNT_STRIDE] = 0u;
        for (int g = c.bid; g < 192; g += c.nb) {
            const int c4 = c.tid & 7, kr = c.tid >> 3;
            float4 w[16];
#pragma unroll
            for (int i = 0; i < 16; ++i) w[i] = *(const float4*)&w_ada[(size_t)(64 * i + kr) * 6144 + g * 32 + 4 * c4];
            float4 a0 = make_float4(0.f, 0.f, 0.f, 0.f), a1 = a0;
#pragma unroll
            for (int i = 0; i < 16; ++i) { const int k = 64 * i + kr; const float c0 = cvec[k], c1 = cvec[DM + k]; const float f0 = c0 * sigmoidf_(c0), f1 = c1 * sigmoidf_(c1);
                a0.x += f0 * w[i].x; a0.y += f0 * w[i].y; a0.z += f0 * w[i].z; a0.w += f0 * w[i].w; a1.x += f1 * w[i].x; a1.y += f1 * w[i].y; a1.z += f1 * w[i].z; a1.w += f1 * w[i].w; }
            __syncthreads();
            *(float4*)&red[(kr * 8 + c4) * 4] = a0; *(float4*)&red[2048 + (kr * 8 + c4) * 4] = a1;
            __syncthreads();
            if (c.tid < 64) { const int b = c.tid >> 5, cc = c.tid & 31; float sacc = 0.f; for (int j = 0; j < 64; ++j) sacc += red[b * 2048 + j * 32 + cc]; mod[b * 6144 + g * 32 + cc] = sacc + b_ada[g * 32 + cc]; }
        }
        __syncthreads();
        for (int idx = c.bid * NTHR + c.tid; idx < SEQ * 16; idx += c.nb * NTHR) {
            const int s = idx >> 4, i = idx & 15, f = i & 7;
            const float inv = powf(10000.f, -(float)f / 8.f);
            const float pos = (float)((i < 8) ? (s >> 6) : (s & 63));
            const float ang = pos * inv;
            cosm[idx] = cosf(ang); sinm[idx] = sinf(ang);
        }
        for (int idx = c.bid * NTHR + c.tid; idx < SEQ * 32; idx += c.nb * NTHR) {
            const int s = idx >> 5, i = idx & 31, f = i & 15;
            const float inv = powf(10000.f, -(float)f / 16.f);
            const float pos = (float)((i < 16) ? (s >> 6) : (s & 63));
            const float ang = pos * inv;
            cosg[idx] = cosf(ang); sing[idx] = sinf(ang);
        }
        LAS float* scr = (LAS float*)(ldsb + 8192 + c.wave * 8448);
        constexpr int I_BIG = 37 * 16;
        constexpr int I_QB = 24 * 4;
        constexpr int I_KVB = 32 * 2;
        constexpr int I_OUT = 32 * 16;
        constexpr int I_RS = 24 * 16;
        constexpr int I_DS = 32 * 4;
        const int I_EXP = (c.nb == NE && (CONV_MODE == 1 || CONV_MODE == 5)) ? 0 : NE * 384;
        const int I_TOT = I_BIG + I_QB + I_KVB + I_OUT + I_RS + I_DS + I_EXP;
        for (int it = c.gw; it < I_TOT; it += c.ngw) {
            int r = it;
            if (r < I_BIG) { const int grp = r >> 4, kb = r & 15; const int col0 = grp * 32, drow = (grp < 13) ? grp * 32 : 2304 + (grp - 13) * 32;
                cvt_item(w_in, INC, col0, kb * 64, WBIGT, drow, DM, nullptr, scr, c.lane); continue; }
            r -= I_BIG;
            if (r < I_QB) { const int grp = r >> 2, kb = r & 3; cvt_item(w_q_b, 768, grp * 32, kb * 64, WQBT, grp * 32, 256, g_q_a, scr, c.lane); continue; }
            r -= I_QB;
            if (r < I_KVB) { const int grp = r >> 1, kb = r & 1; cvt_item(w_kv_b, 1024, grp * 32, kb * 64, WKVBT, grp * 32, 256, g_kv_a, scr, c.lane); continue; }
            r -= I_KVB;
            if (r < I_OUT) { const int grp = r >> 4, kb = r & 15; cvt_item(w_out, DM, grp * 32, kb * 64, WOUTT, grp * 32, DM, (kb < 8) ? g_mla_out : (g_gqa_out - 512), scr, c.lane); continue; }
            r -= I_OUT;
            if (r < I_RS) { const int grp = r >> 4, kb = r & 15;
                if (grp < 8) cvt_item(w_router, NE, grp * 32, kb * 64, WRST, grp * 32, DM, nullptr, scr, c.lane);
                else { const int q = grp - 8, blk = q >> 2, sub = q & 3;
                    cvt_item((blk & 1) ? w_up_s : w_gate_s, EFF, (blk >> 1) * 128 + sub * 32, kb * 64, WRST, 256 + blk * 128 + sub * 32, DM, nullptr, scr, c.lane); }
                continue; }
            r -= I_RS;
            if (r < I_DS) { const int grp = r >> 2, kb = r & 3; cvt_item(w_down_s, DM, grp * 32, kb * 64, WDST, grp * 32, EFF, nullptr, scr, c.lane); continue; }
            r -= I_DS;
            { const int e = r / 384, q = r % 384;
              if (q < 256) { const int up = q >> 7, q2 = q & 127, grp = q2 >> 4, kb = q2 & 15;
                  const int drow = ((grp < 4) ? grp * 32 : 256 + (grp - 4) * 32) + up * 128;
                  cvt_item((up ? w_up_e : w_gate_e) + (size_t)e * DM * EFF, EFF, grp * 32, kb * 64, WGUT + (size_t)e * 512 * DM, drow, DM, nullptr, scr, c.lane); }
              else { const int q2 = q - 256, grp = q2 >> 2, kb = q2 & 3;
                  cvt_item(w_down_e + (size_t)e * EFF * DM, DM, grp * 32, kb * 64, WDT + (size_t)e * DM * EFF, grp * 32, EFF, nullptr, scr, c.lane); } }
        }
        const int gt = c.bid * NTHR + c.tid, ngt = c.nb * NTHR;
        for (int i = gt; i < 96 * 1024 / 8; i += ngt) *(uint4*)(WBIGT + (size_t)416 * DM + (size_t)i * 8) = make_uint4(0u, 0u, 0u, 0u);
        for (int i = gt; i < 1024 * 16; i += ngt) { const int n = i >> 4, q = i & 15; *(uint4*)(WKVBT + (size_t)n * 256 + 128 + q * 8) = make_uint4(0u, 0u, 0u, 0u); }
        for (int i = gt; i < 1024 * 64; i += ngt) { const int k = i >> 6, q = i & 63; const float4 v = *(const float4*)&w_in[(size_t)k * INC + q * 4]; uint2 o; o.x = pk2(v.x, v.y); o.y = pk2(v.z, v.w); *(uint2*)(WINQ + (size_t)k * 256 + q * 4) = o; }
        for (int i = gt; i < 1024 * 64; i += ngt) { const int k = i >> 6, q = i & 63; uint2 o = make_uint2(0u, 0u);
            if (q < 32) { const float4 v = *(const float4*)&w_in[(size_t)k * INC + 256 + q * 4]; o.x = pk2(v.x, v.y); o.y = pk2(v.z, v.w); }
            *(uint2*)(WINKV + (size_t)k * 256 + q * 4) = o; }
    }
    SEAM(0);

    if (IN(1)) for (int rep_ = 0; rep_ < (((REPEAT_MASK >> 1) & 1) ? 2 : 1); ++rep_) {
        const Ctx c = mkctx(ws, lds_raw); PHASE_PTRS
        for (int i = c.bid * NTHR + c.tid; i < 2 * 4 * DM; i += c.nb * NTHR) { const int b = i >> 12, k = (i >> 10) & 3, cc = i & 1023; const float* md = mod + b * 6144;
            ((float*)(wsp + WS_COEF))[i] = (k == 0) ? md[2048 + cc] * g_post_mix[cc] : (k == 1) ? g_pre_ffn[cc] * (1.f + md[4096 + cc]) : (k == 2) ? md[3072 + cc] : md[5120 + cc] * g_post_ffn[cc]; }
        { pg8::DenseOrder S; S.init(768, 1024, 256, WINQ, c.nb, c.bid); pg8::EpiBf16 E{WBIGT + (size_t)512 * DM, DM};
          pg8::gemm_phase<pg8::EpiBf16, pg8::DenseOrder, true>(ldsb, WQBT, 256, S, E); }
        { pg8::DenseOrder S; S.init(1024, 1024, 256, WINKV, c.nb, (c.bid >= 12 && c.nb >= 28) ? c.bid - 12 : c.bid + (c.nb >= 28 ? c.nb : 0)); pg8::EpiBf16 E{WBIGT + (size_t)1280 * DM, DM};
          pg8::gemm_phase<pg8::EpiBf16, pg8::DenseOrder, true>(ldsb, WKVBT, 256, S, E); }
        const bool hsplit = c.nb >= 56; const int hw = hsplit ? c.gw - 28 * 8 : c.gw, nhw = hsplit ? c.ngw - 28 * 8 : c.ngw;
        if (hw >= 0) {
            float4 nv[2][4];
#pragma unroll
            for (int q = 0; q < 2; ++q) { const int m = (hw + q * nhw < NTOK) ? hw + q * nhw : hw;
#pragma unroll
                for (int j = 0; j < 4; ++j) nv[q][j] = *(const float4*)&x[(size_t)m * DM + 4 * c.lane + 256 * j]; }
            for (int m0 = hw; m0 < NTOK; m0 += 2 * nhw) {
                float4 v[2][4];
#pragma unroll
                for (int q = 0; q < 2; ++q)
#pragma unroll
                    for (int j = 0; j < 4; ++j) v[q][j] = nv[q][j];
                const int m0n = m0 + 2 * nhw;
                if (m0n < NTOK) {
#pragma unroll
                    for (int q = 0; q < 2; ++q) { const int m = (m0n + q * nhw < NTOK) ? m0n + q * nhw : m0n;
#pragma unroll
                        for (int j = 0; j < 4; ++j) nv[q][j] = *(const float4*)&x[(size_t)m * DM + 4 * c.lane + 256 * j]; }
                }
#pragma unroll
                for (int q = 0; q < 2; ++q) {
                    const int m = (m0 + q * nhw < NTOK) ? m0 + q * nhw : m0; const int b = m / SEQ; const float* md = mod + b * 6144;
                    float4 g[4], sc[4], sh[4];
#pragma unroll
                    for (int j = 0; j < 4; ++j) { const int cc = 4 * c.lane + 256 * j; g[j] = *(const float4*)&g_pre_mix[cc]; sc[j] = *(const float4*)&md[1024 + cc]; sh[j] = *(const float4*)&md[cc]; }
                    float ss = 0.f;
#pragma unroll
                    for (int j = 0; j < 4; ++j) ss += v[q][j].x * v[q][j].x + v[q][j].y * v[q][j].y + v[q][j].z * v[q][j].z + v[q][j].w * v[q][j].w;
                    const float rstd = rsqrtf(wave_sum(ss) * (1.f / DM) + EPS);
#pragma unroll
                    for (int j = 0; j < 4; ++j) {
                        const int cc = 4 * c.lane + 256 * j;
                        uint2 o;
                        o.x = pk2(v[q][j].x * rstd * g[j].x * (1.f + sc[j].x) + sh[j].x, v[q][j].y * rstd * g[j].y * (1.f + sc[j].y) + sh[j].y);
                        o.y = pk2(v[q][j].z * rstd * g[j].z * (1.f + sc[j].z) + sh[j].z, v[q][j].w * rstd * g[j].w * (1.f + sc[j].w) + sh[j].w);
                        *(uint2*)&H2[(size_t)m * DM + cc] = o;
                    }
                }
            }
        }
    }
    SEAM(1);

    if (IN(2)) for (int rep_ = 0; rep_ < (((REPEAT_MASK >> 2) & 1) ? 2 : 1); ++rep_) {
        const Ctx c = mkctx(ws, lds_raw); PHASE_PTRS
        pg8::DenseOrder S; S.init(NTOK, 3072, DM, WBIGT, c.nb, c.bid); pg8::EpiBf16 E{PBUF, 3072};
        pg8::gemm_phase<pg8::EpiBf16, pg8::DenseOrder, true>(ldsb, H2, DM, S, E);
    }
    SEAM(2);

    if (IN(3)) for (int rep_ = 0; rep_ < (((REPEAT_MASK >> 3) & 1) ? 2 : 1); ++rep_) {
        const Ctx c = mkctx(ws, lds_raw); PHASE_PTRS
        unsigned* kmaxL = (unsigned*)lds_raw;
        if (c.tid < 18) kmaxL[c.tid] = 0u;
        __syncthreads();
        uint4 nraw[6];
#pragma unroll
        for (int j = 0; j < 6; ++j) nraw[j] = *(const uint4*)(PBUF + (size_t)c.gw * 3072 + 512 * j + 8 * c.lane);
        for (int m = c.gw; m < NTOK; m += c.ngw) {
            const int b = m / SEQ, s = m % SEQ;
            uint4 raw[6];
#pragma unroll
            for (int j = 0; j < 6; ++j) raw[j] = nraw[j];
            if (m + c.ngw < NTOK) {
#pragma unroll
                for (int j = 0; j < 6; ++j) nraw[j] = *(const uint4*)(PBUF + (size_t)(m + c.ngw) * 3072 + 512 * j + 8 * c.lane);
            }
            float rq, rkv;
            {
                float v[8]; { const uint4 u = raw[0]; v[0] = bf2f(u.x & 0xffffu); v[1] = bf2f(u.x >> 16); v[2] = bf2f(u.y & 0xffffu); v[3] = bf2f(u.y >> 16); v[4] = bf2f(u.z & 0xffffu); v[5] = bf2f(u.z >> 16); v[6] = bf2f(u.w & 0xffffu); v[7] = bf2f(u.w >> 16); }
                float sq = 0.f;
#pragma unroll
                for (int i = 0; i < 8; ++i) sq += v[i] * v[i];
                rq = rsqrtf(wave_sum(c.lane < 32 ? sq : 0.f) * (1.f / QLORA) + EPS);
                rkv = rsqrtf(wave_sum((c.lane >= 32 && c.lane < 48) ? sq : 0.f) * (1.f / KVLORA) + EPS);
                if (c.lane >= 48 && c.lane < 52) {
                    const int i0 = 4 * (c.lane - 48); uint4 o; unsigned ow[4];
#pragma unroll
                    for (int pq = 0; pq < 4; ++pq) { const float cs = cosm[s * 16 + i0 + pq], sn = sinm[s * 16 + i0 + pq]; ow[pq] = pk2(v[2 * pq] * cs - v[2 * pq + 1] * sn, v[2 * pq] * sn + v[2 * pq + 1] * cs); }
                    o.x = ow[0]; o.y = ow[1]; o.z = ow[2]; o.w = ow[3];
#pragma unroll
                    for (int h = 0; h < MH; ++h) *(uint4*)&KM[((size_t)(b * MH + h) * SEQ + s) * DQKM + MNOPE + 2 * i0] = o;
                    float pq = 0.f;
#pragma unroll
                    for (int i = 0; i < 8; ++i) pq += v[i] * v[i];
                    pq += dppmov<0xB1, 0xF>(0.f, pq); pq += dppmov<0x4E, 0xF>(0.f, pq);
                    if (c.lane == 48) atomicMax(&kmaxL[16 + b], __builtin_bit_cast(unsigned, pq));
                }
            }
#pragma unroll
            for (int j = 1; j < 6; ++j) {
                const int col0 = 512 * j + 8 * c.lane;
                float v[8]; { const uint4 u = raw[j]; v[0] = bf2f(u.x & 0xffffu); v[1] = bf2f(u.x >> 16); v[2] = bf2f(u.y & 0xffffu); v[3] = bf2f(u.y >> 16); v[4] = bf2f(u.z & 0xffffu); v[5] = bf2f(u.z >> 16); v[6] = bf2f(u.w & 0xffffu); v[7] = bf2f(u.w >> 16); }
                if (col0 < 1280) {
                    const int qc = col0 - 512, h = qc / DQKM, d0 = qc % DQKM; const float sc = rq * C2M;
                    uint4 o; unsigned ow[4];
                    if (d0 >= MNOPE) { const int i0 = (d0 - MNOPE) >> 1;
#pragma unroll
                        for (int pq = 0; pq < 4; ++pq) { const float cs = cosm[s * 16 + i0 + pq], sn = sinm[s * 16 + i0 + pq]; ow[pq] = pk2((v[2 * pq] * cs - v[2 * pq + 1] * sn) * sc, (v[2 * pq] * sn + v[2 * pq + 1] * cs) * sc); }
                    } else {
#pragma unroll
                        for (int pq = 0; pq < 4; ++pq) ow[pq] = pk2(v[2 * pq] * sc, v[2 * pq + 1] * sc);
                    }
                    o.x = ow[0]; o.y = ow[1]; o.z = ow[2]; o.w = ow[3];
                    *(uint4*)&QM[((size_t)(b * MH + h) * SEQ + s) * DQKM + d0] = o;
                } else if (col0 < 2304) {
                    const int kc = col0 - 1280, h = kc >> 7, d0 = kc & 127;
                    uint4 o; o.x = pk2(v[0] * rkv, v[1] * rkv); o.y = pk2(v[2] * rkv, v[3] * rkv); o.z = pk2(v[4] * rkv, v[5] * rkv); o.w = pk2(v[6] * rkv, v[7] * rkv);
                    if (d0 < MNOPE) { *(uint4*)&KM[((size_t)(b * MH + h) * SEQ + s) * DQKM + d0] = o;
                        float kq = 0.f;
#pragma unroll
                        for (int i = 0; i < 8; ++i) kq += (v[i] * rkv) * (v[i] * rkv);
                        kq += dppmov<0xB1, 0xF>(0.f, kq); kq += dppmov<0x4E, 0xF>(0.f, kq); kq += dppmov<0x141, 0xF>(0.f, kq);
                        if ((c.lane & 7) == 0) atomicMax(&kmaxL[b * 8 + h], __builtin_bit_cast(unsigned, kq)); }
                    else *(uint4*)&VM[((size_t)(b * MH + h) * SEQ + s) * MV + (d0 - MNOPE)] = o;
                } else if (col0 < 2944) {
                    const bool isq = col0 < 2816; const int hc = isq ? (col0 - 2304) : (col0 - 2816), h = hc >> 6, d0 = hc & 63;
                    float sq = 0.f;
#pragma unroll
                    for (int i = 0; i < 8; ++i) sq += v[i] * v[i];
                    sq += __shfl_xor(sq, 1); sq += __shfl_xor(sq, 2); sq += __shfl_xor(sq, 4);
                    const float rs = rsqrtf(sq * (1.f / GD) + EPS) * (isq ? C2G : 1.f); const float* gh = isq ? g_q_head : g_k_head;
                    uint4 o; unsigned ow[4];
#pragma unroll
                    for (int pq = 0; pq < 4; ++pq) { const int d = d0 + 2 * pq; const float cs = cosg[s * 32 + (d >> 1)], sn = sing[s * 32 + (d >> 1)];
                        const float x0 = v[2 * pq] * rs * gh[d], x1 = v[2 * pq + 1] * rs * gh[d + 1]; ow[pq] = pk2(x0 * cs - x1 * sn, x0 * sn + x1 * cs); }
                    o.x = ow[0]; o.y = ow[1]; o.z = ow[2]; o.w = ow[3];
                    if (isq) *(uint4*)&QG[((size_t)(b * GH + h) * SEQ + s) * GD + d0] = o;
                    else *(uint4*)&KG[((size_t)(b * GKV + h) * SEQ + s) * GD + d0] = o;
                } else {
                    const int hc = col0 - 2944, h = hc >> 6, d0 = hc & 63;
                    *(uint4*)&VG[((size_t)(b * GKV + h) * SEQ + s) * GD + d0] = raw[j];
                }
            }
        }
        __syncthreads();
        if (c.tid < 18) atomicMax(ctl + CW_KMAX + c.tid, kmaxL[c.tid]);
    }
    SEAM(3);

    if (IN(4)) for (int rep_ = 0; rep_ < (((REPEAT_MASK >> 4) & 1) ? 2 : 1); ++rep_) {
        const Ctx c = mkctx(ws, lds_raw); PHASE_PTRS
        att::ConvState cs;
        { const int e = (c.nb == NE) ? c.bid : 0;
          cs.cj = 0; cs.jbase = 384 * c.wave;
          cs.wg = (const char*)(w_gate_e + (size_t)e * DM * EFF); cs.wu = (const char*)(w_up_e + (size_t)e * DM * EFF); cs.wd = (const char*)(w_down_e + (size_t)e * EFF * DM);
          cs.dgu = (char*)(WGUT + (size_t)e * 512 * DM); cs.dd = (char*)(WDT + (size_t)e * DM * EFF);
          cs.ldsbuf = (unsigned)(uintptr_t)lds_raw + att::CONV_LDS + (CONV_MODE >= 5 ? 0 : c.wave * 4096); cs.rdbuf = (att::lds_cptr)lds_raw + att::CONV_LDS + (CONV_MODE >= 5 ? 0 : c.wave * 4096);
          if (CONV_MODE >= 5) cs.jbase = 0;
          if (CONV_MODE != 0 && CONV_MODE < 5) for (int i = 0; i < 3; ++i) { const att::ConvJob q = att::conv_job(cs, cs.cj);
              att::glds16_s(q.sbase, (unsigned)(c.lane >> 3) * q.ldwB + (unsigned)(c.lane & 7) * 16u, (unsigned)__builtin_amdgcn_readfirstlane(cs.ldsbuf + (cs.cj & 3) * 1024)); ++cs.cj; }
          asm volatile("s_waitcnt vmcnt(0)" ::: "memory"); }
        float mfix;
        { const float gq = wave_max(fabsf(g_q_head[c.lane])), gk = wave_max(fabsf(g_k_head[c.lane])); mfix = fminf(64.f * C2G * gq * gk * 1.03f + 0.5f, 60.f); }
        for (int uu = vcu; uu < 512; uu += c.nb) {
            const int bh = uu >> 5, b = bh >> 3, h = bh & 7, qp = uu & 31;
            const int q0 = qp * 256;
            const float kb2 = __builtin_bit_cast(float, ctl[CW_KMAX + b * 8 + h]) + __builtin_bit_cast(float, ctl[CW_KMAX + 16 + b]);
            att::unit96<8>(QM + (size_t)(b * MH + h) * SEQ * DQKM, KM + (size_t)(b * MH + h) * SEQ * DQKM, VM + (size_t)(b * MH + h) * SEQ * MV,
                                 O + ((size_t)b * SEQ + q0) * DM + h * 64, OSTAT + ((size_t)b * SEQ + q0) * 16 + h, q0, (char*)lds_raw, cs, kb2);
            att::unit64<8>(QG + (size_t)(b * GH + h) * SEQ * GD, KG + (size_t)(b * GKV + (h >> 2)) * SEQ * GD, VG + (size_t)(b * GKV + (h >> 2)) * SEQ * GD,
                                 O + ((size_t)b * SEQ + q0) * DM + (8 + h) * 64, OSTAT + ((size_t)b * SEQ + q0) * 16 + 8 + h, q0, (char*)lds_raw, cs, mfix);
        }
#if CONV_MODE >= 5
        {
            using namespace att;
            const int wid = c.wave, lane = c.lane; const bool rst = wid >= 6;
            for (int r4 = 0; r4 < 3; ++r4) { CONV_DRAIN(); ++cs.cj; }
        }
#endif
    }
    SEAM(4);

    if (IN(5)) for (int rep_ = 0; rep_ < (((REPEAT_MASK >> 5) & 1) ? 2 : 1); ++rep_) {
        const Ctx c = mkctx(ws, lds_raw); PHASE_PTRS
        pg8::DenseOrder S; S.init(NTOK, DM, DM, WOUTT, c.nb, c.bid);
        LAS float* rtab = (LAS float*)(ldsb + pg8::STAGE_BYTES);
        { pg8::Unit u0; if (S.next(0, u0) && c.tid < 256) { const float4* sp = (const float4*)&OSTAT[(size_t)(u0.pm * 256 + c.tid) * 16]; const float4 s0 = sp[0], s1 = sp[1], s2 = sp[2], s3 = sp[3];
            const float sm = ((s0.x + s0.y) + (s0.z + s0.w)) + ((s1.x + s1.y) + (s1.z + s1.w)), sg = ((s2.x + s2.y) + (s2.z + s2.w)) + ((s3.x + s3.y) + (s3.z + s3.w));
            const float rm = rsqrtf(sm * (1.f / 512) + EPS), rg = rsqrtf(sg * (1.f / 512) + EPS); rtab[2 * c.tid] = rm / rg; rtab[2 * c.tid + 1] = rg; }
          __syncthreads(); }
        pg8::EpiBf16RowScale E{MIXED, DM, rtab};
        pg8::gemm_phase<pg8::EpiBf16RowScale, pg8::DenseOrder, true, false, true>(ldsb, O, DM, S, E, nullptr);
    }
    SEAM(5);

    if (IN(6)) for (int rep_ = 0; rep_ < (((REPEAT_MASK >> 6) & 1) ? 2 : 1); ++rep_) {
        const Ctx c = mkctx(ws, lds_raw); PHASE_PTRS
        {
            const float* COEF = (const float*)(wsp + WS_COEF);
            uint2 nmu[2][4]; float4 nxq[2][4];
#pragma unroll
            for (int q = 0; q < 2; ++q) { const int m = (c.gw + q * c.ngw < NTOK) ? c.gw + q * c.ngw : c.gw;
#pragma unroll
                for (int j = 0; j < 4; ++j) { nmu[q][j] = *(const uint2*)&MIXED[(size_t)m * DM + 4 * c.lane + 256 * j]; nxq[q][j] = *(const float4*)&x[(size_t)m * DM + 4 * c.lane + 256 * j]; } }
            for (int m0 = c.gw; m0 < NTOK; m0 += 2 * c.ngw) {
                uint2 mu[2][4]; float4 xq[2][4];
#pragma unroll
                for (int q = 0; q < 2; ++q)
#pragma unroll
                    for (int j = 0; j < 4; ++j) { mu[q][j] = nmu[q][j]; xq[q][j] = nxq[q][j]; }
                const int m0n = m0 + 2 * c.ngw;
                if (m0n < NTOK) {
#pragma unroll
                    for (int q = 0; q < 2; ++q) { const int m = (m0n + q * c.ngw < NTOK) ? m0n + q * c.ngw : m0n;
#pragma unroll
                        for (int j = 0; j < 4; ++j) { nmu[q][j] = *(const uint2*)&MIXED[(size_t)m * DM + 4 * c.lane + 256 * j]; nxq[q][j] = *(const float4*)&x[(size_t)m * DM + 4 * c.lane + 256 * j]; } }
                }
#pragma unroll
                for (int q = 0; q < 2; ++q) {
                    const int m = (m0 + q * c.ngw < NTOK) ? m0 + q * c.ngw : m0; const int b = m / SEQ; const float* cf = COEF + b * 4096;
                    float4 ca[4], cb[4], cd[4];
#pragma unroll
                    for (int j = 0; j < 4; ++j) { const int cc = 4 * c.lane + 256 * j; ca[j] = *(const float4*)&cf[cc]; cb[j] = *(const float4*)&cf[1024 + cc]; cd[j] = *(const float4*)&cf[2048 + cc]; }
                    float4 v[4], xr[4]; float ss = 0.f;
#pragma unroll
                    for (int j = 0; j < 4; ++j) { const uint2 u = mu[q][j];
                        v[j].x = bf2f(u.x & 0xffffu); v[j].y = bf2f(u.x >> 16); v[j].z = bf2f(u.y & 0xffffu); v[j].w = bf2f(u.y >> 16);
                        ss += v[j].x * v[j].x + v[j].y * v[j].y + v[j].z * v[j].z + v[j].w * v[j].w; }
                    const float rstd = rsqrtf(wave_sum(ss) * (1.f / DM) + EPS);
                    float ss1 = 0.f;
#pragma unroll
                    for (int j = 0; j < 4; ++j) {
                        const int cc = 4 * c.lane + 256 * j; const float4 xx = xq[q][j];
                        xr[j].x = xx.x + ca[j].x * (v[j].x * rstd); xr[j].y = xx.y + ca[j].y * (v[j].y * rstd);
                        xr[j].z = xx.z + ca[j].z * (v[j].z * rstd); xr[j].w = xx.w + ca[j].w * (v[j].w * rstd);
                        ss1 += xr[j].x * xr[j].x + xr[j].y * xr[j].y + xr[j].z * xr[j].z + xr[j].w * xr[j].w;
                        { uint2 xo; xo.x = pk2(xr[j].x, xr[j].y); xo.y = pk2(xr[j].z, xr[j].w); *(uint2*)&X1[(size_t)m * DM + cc] = xo; }
                    }
                    const float rstd1 = rsqrtf(wave_sum(ss1) * (1.f / DM) + EPS);
#pragma unroll
                    for (int j = 0; j < 4; ++j) {
                        const int cc = 4 * c.lane + 256 * j;
                        uint2 pk;
                        pk.x = pk2(xr[j].x * rstd1 * cb[j].x + cd[j].x, xr[j].y * rstd1 * cb[j].y + cd[j].y);
                        pk.y = pk2(xr[j].z * rstd1 * cb[j].z + cd[j].z, xr[j].w * rstd1 * cb[j].w + cd[j].w);
                        *(uint2*)&H2[(size_t)m * DM + cc] = pk;
                    }
                }
            }
        }
    }
    SEAM(6);

    if (IN(7)) for (int rep_ = 0; rep_ < (((REPEAT_MASK >> 7) & 1) ? 2 : 1); ++rep_) {
        const Ctx c = mkctx(ws, lds_raw); PHASE_PTRS
        pg8::DenseOrder S; S.init(NTOK, 768, DM, WRST, c.nb, c.bid); pg8::EpiRS E{LOG, ACTS};
        pg8::gemm_phase<pg8::EpiRS, pg8::DenseOrder, true>(ldsb, H2, DM, S, E);
    }
    SEAM(7);

    if (IN(8)) for (int rep_ = 0; rep_ < (((REPEAT_MASK >> 8) & 1) ? 2 : 1); ++rep_) {
        const Ctx c = mkctx(ws, lds_raw); PHASE_PTRS
        const float4 bb = *(const float4*)&b_router[4 * c.lane];
        const unsigned rowL = (unsigned)(uintptr_t)lds_raw + c.wave * 8192;
        const LAS unsigned char* rowP = ldsb + c.wave * 8192;
        const bool cnt_sort = (MK_N_LAUNCHES == 1) && c.nb == NE && 8 * c.ngw == NTOK && lo < 8 && hi > 9;
        int* histg = (int*)(lds_raw + 65536); int* HIST = (int*)(wsp + WS_HIST);
        if (cnt_sort) { if (c.tid < NE) histg[c.tid] = 0; __syncthreads(); }
        for (int mb = c.gw; mb < NTOK; mb += 8 * c.ngw) {
#pragma unroll
          for (int r = 0; r < 8; ++r) { const int mr = mb + r * c.ngw; if (mr < NTOK) att::glds16(LOG + (size_t)mr * NE + 4 * c.lane, (unsigned)__builtin_amdgcn_readfirstlane(rowL + r * 1024)); }
          asm volatile("s_waitcnt vmcnt(0)" ::: "memory");
          int my_e = 0; float my_s = 0.f; int rb = 0;
#pragma unroll 1
          for (int m = mb; m < NTOK && rb < 8; m += c.ngw) {
            typedef float f32x4v __attribute__((ext_vector_type(4)));
            const f32x4v lg = *(const LAS f32x4v*)(rowP + rb * 1024 + c.lane * 16);
            const float s0 = __builtin_amdgcn_rcpf(1.f + __builtin_amdgcn_exp2f(lg.x * -1.44269504f)), s1 = __builtin_amdgcn_rcpf(1.f + __builtin_amdgcn_exp2f(lg.y * -1.44269504f));
            const float s2 = __builtin_amdgcn_rcpf(1.f + __builtin_amdgcn_exp2f(lg.z * -1.44269504f)), s3 = __builtin_amdgcn_rcpf(1.f + __builtin_amdgcn_exp2f(lg.w * -1.44269504f));
            const int o0 = ford(s0 + bb.x), o1 = ford(s1 + bb.y), o2 = ford(s2 + bb.z), o3 = ford(s3 + bb.w);
            const int e0 = 4 * c.lane, g = c.lane >> 3;
            const int IMIN = (int)0x80000000;
            int gkey;
            {
                const int h01 = imax_(o0, o1), l01 = imin_(o0, o1), h23 = imax_(o2, o3), l23 = imin_(o2, o3);
                const int a1 = imax_(h01, h23), a2 = imax_(imin_(h01, h23), (h01 >= h23) ? l01 : l23);
                const int g1 = grp8_max_i(a1);
                const unsigned long long bm = __ballot(a1 == g1);
                const unsigned grpbits = (unsigned)(bm >> (8 * g)) & 0xffu;
                const bool first = (a1 == g1) && ((grpbits & ((1u << (c.lane & 7)) - 1u)) == 0u);
                const int g2 = grp8_max_i(first ? a2 : a1);
                gkey = (ford(funord(g1) + funord(g2)) & ~7) | (7 - g);
            }
            int rank = 0;
#pragma unroll
            for (int j = 0; j < 8; ++j) rank += (__builtin_amdgcn_readlane(gkey, 8 * j) > gkey) ? 1 : 0;
            const bool sel = rank < 4;
            int k0 = sel ? ((o0 & ~0xff) | (255 - e0)) : IMIN, k1 = sel ? ((o1 & ~0xff) | (254 - e0)) : IMIN, k2 = sel ? ((o2 & ~0xff) | (253 - e0)) : IMIN, k3 = sel ? ((o3 & ~0xff) | (252 - e0)) : IMIN;
            int my_key = 0;
#pragma unroll 1
            for (int rnd = 0; rnd < TOPK; ++rnd) {
                const int mx = wave_max_i(imax_(imax_(k0, k1), imax_(k2, k3)));
                if (c.lane == 8 * rb + rnd) my_key = mx;
                k0 = (k0 == mx) ? IMIN : k0; k1 = (k1 == mx) ? IMIN : k1; k2 = (k2 == mx) ? IMIN : k2; k3 = (k3 == mx) ? IMIN : k3;
            }
            {
                const int ee = 255 - (my_key & 0xff), src = (ee >> 2) * 4;
                const float q0 = __builtin_bit_cast(float, __builtin_amdgcn_ds_bpermute(src, __builtin_bit_cast(int, s0))), q1 = __builtin_bit_cast(float, __builtin_amdgcn_ds_bpermute(src, __builtin_bit_cast(int, s1)));
                const float q2 = __builtin_bit_cast(float, __builtin_amdgcn_ds_bpermute(src, __builtin_bit_cast(int, s2))), q3 = __builtin_bit_cast(float, __builtin_amdgcn_ds_bpermute(src, __builtin_bit_cast(int, s3)));
                if ((c.lane >> 3) == rb) { my_e = ee; my_s = (ee & 2) ? ((ee & 1) ? q3 : q2) : ((ee & 1) ? q1 : q0); }
            }
            ++rb;
          }
          { const int rr = c.lane >> 3, k = c.lane & 7;
            const float tot = grp8_sum(my_s);
            const bool valid = rr < rb; const int id = (mb + rr * c.ngw) * TOPK + k; const float wt = my_s / tot * 2.5f;
            if (!cnt_sort) {
                if (valid) { const unsigned pos = atomicAdd(&CNT[(size_t)my_e * CNT_STRIDE], 1u);
                    LIST[(size_t)my_e * LCAP + pos] = id; POSREC[id] = (my_e << 16) | (int)pos; WTS[id] = wt; }
            } else {
                int lpos = 0; if (valid) lpos = atomicAdd(&histg[my_e], 1);
                __syncthreads();
                if (c.tid < 64) HIST[c.bid * 64 + c.tid] = histg[4 * c.tid] | (histg[4 * c.tid + 1] << 8) | (histg[4 * c.tid + 2] << 16) | (histg[4 * c.tid + 3] << 24);
                xcd_barrier(bar);
                { const int rg = c.tid >> 4, eb = c.tid & 15;
                  uint4 hv[8];
#pragma unroll
                  for (int j = 0; j < 8; ++j) { const int w = rg + 32 * j; hv[j] = make_uint4(0u, 0u, 0u, 0u); if (w < c.bid) hv[j] = *(const uint4*)&HIST[w * 64 + eb * 4]; }
                  int acc[16];
#pragma unroll
                  for (int i = 0; i < 16; ++i) acc[i] = 0;
#pragma unroll
                  for (int j = 0; j < 8; ++j) { const unsigned wd[4] = {hv[j].x, hv[j].y, hv[j].z, hv[j].w};
#pragma unroll
                      for (int q = 0; q < 4; ++q) { acc[4 * q] += (int)(wd[q] & 0xffu); acc[4 * q + 1] += (int)((wd[q] >> 8) & 0xffu); acc[4 * q + 2] += (int)((wd[q] >> 16) & 0xffu); acc[4 * q + 3] += (int)(wd[q] >> 24); } }
#pragma unroll
                  for (int q = 0; q < 4; ++q) *(int4*)&histg[1024 + rg * NE + eb * 16 + 4 * q] = make_int4(acc[4 * q], acc[4 * q + 1], acc[4 * q + 2], acc[4 * q + 3]); }
                __syncthreads();
                if (c.tid < NE) { int bs = 0;
#pragma unroll
                    for (int r = 0; r < 32; ++r) bs += histg[1024 + r * NE + c.tid];
                    histg[768 + c.tid] = bs; if (c.bid == c.nb - 1) HIST[NE * NE + c.tid] = bs + histg[c.tid]; }
                __syncthreads();
                if (valid) { const int pos = histg[768 + my_e] + lpos;
                    LIST[(size_t)my_e * LCAP + pos] = id; POSREC[id] = (my_e << 16) | pos; WTS[id] = wt; }
            } }
        }
    }
    SEAM(8);

    LAS int* pre = (LAS int*)(ldsb + pg8::STAGE_BYTES);
    LAS int* offs = pre + 320; LAS int* cntl = offs + 320;
    if (IN(9) || IN(10) || IN(11)) {
        const Ctx c = mkctx(ws, lds_raw); PHASE_PTRS
        __syncthreads();
        if (c.tid < NE) cntl[c.tid] = ((MK_N_LAUNCHES == 1) && c.nb == NE && 8 * c.ngw == NTOK && lo < 8 && hi > 9) ? ((const int*)(wsp + WS_HIST))[NE * NE + c.tid] : (int)CNT[(size_t)c.tid * CNT_STRIDE];
        __syncthreads();
        if (c.tid <= NE) { int a = 0, o = 0; for (int j = 0; j < c.tid; ++j) { const int q = cntl[j]; a += (q + 255) >> 8; o += q; } pre[c.tid] = a; offs[c.tid] = o; }
        __syncthreads();
    }
    if (IN(9)) for (int rep_ = 0; rep_ < (((REPEAT_MASK >> 9) & 1) ? 2 : 1); ++rep_) {
        const Ctx c = mkctx(ws, lds_raw); PHASE_PTRS
        pg8::MoeOrder S{pre, offs, cntl, LIST, (const char*)WGUT, (size_t)512 * DM * 2, DM, 2, c.nb, vcu, 0};
        pg8::EpiAct E{ACT};
        pg8::gemm_phase<pg8::EpiAct, pg8::MoeOrder, true, true>(ldsb, H2, DM, S, E);
    }
    SEAM(9);

    if (IN(10)) for (int rep_ = 0; rep_ < (((REPEAT_MASK >> 10) & 1) ? 2 : 1); ++rep_) {
        const Ctx c = mkctx(ws, lds_raw); PHASE_PTRS
        { pg8::MoeOrder S{pre, offs, cntl, LIST, (const char*)WDT, (size_t)DM * EFF * 2, EFF, 4, c.nb, vcu, 1};
          pg8::EpiSlots E{(unsigned char*)SLOTS};
          pg8::gemm_phase<pg8::EpiSlots, pg8::MoeOrder, true>(ldsb, ACT, EFF, S, E); }
        { pg8::DenseOrder S; S.init(NTOK, DM, EFF, WDST, c.nb, c.bid); pg8::EpiBf16 E{YSH, DM};
          pg8::gemm_phase<pg8::EpiBf16, pg8::DenseOrder, true>(ldsb, ACTS, EFF, S, E); }
    }
    SEAM(10);

    if (IN(11)) for (int rep_ = 0; rep_ < (((REPEAT_MASK >> 11) & 1) ? 2 : 1); ++rep_) {
        const Ctx c = mkctx(ws, lds_raw); PHASE_PTRS
        const unsigned char* SL8 = (const unsigned char*)SLOTS;
        typedef float f32x2v __attribute__((ext_vector_type(2)));
        const float* COEF = (const float*)(wsp + WS_COEF);
        const int nrw = (c.gw < NTOK) ? (NTOK - c.gw + c.ngw - 1) / c.ngw : 0;
        const int cc = 16 * c.lane;
        int recn = 0; float wtn = 0.f;
        int recf = 0; float wtf = 0.f;
        uint4 dsl[TOPK], dys[2]; uint2 dx1[4]; float dwt = 0.f;
        if (nrw > 0 && c.lane < TOPK) { recn = POSREC[(size_t)c.gw * TOPK + c.lane]; wtn = WTS[(size_t)c.gw * TOPK + c.lane] * (1.f / 16.f); }
        if (nrw > 1 && c.lane < TOPK) { recf = POSREC[(size_t)(c.gw + c.ngw) * TOPK + c.lane]; wtf = WTS[(size_t)(c.gw + c.ngw) * TOPK + c.lane] * (1.f / 16.f); }
        if (nrw > 0) { const int m = c.gw; const int sr = offs[(recn >> 16) & 255] + (recn & 0xffff);
#pragma unroll
            for (int k = 0; k < TOPK; ++k) dsl[k] = *(const uint4*)&SL8[(size_t)__builtin_amdgcn_readlane(sr, k) * DM + cc];
            dys[0] = *(const uint4*)&YSH[(size_t)m * DM + cc]; dys[1] = *(const uint4*)&YSH[(size_t)m * DM + cc + 8];
#pragma unroll
            for (int hq = 0; hq < 4; ++hq) dx1[hq] = *(const uint2*)&X1[(size_t)m * DM + cc + 4 * hq];
            dwt = wtn; recn = recf; wtn = wtf; }
        for (int i = 0; i < nrw; ++i) {
            const int m = c.gw + i * c.ngw;
            if (i + 2 < nrw && c.lane < TOPK) { const int m2 = m + 2 * c.ngw; recf = POSREC[(size_t)m2 * TOPK + c.lane]; wtf = WTS[(size_t)m2 * TOPK + c.lane] * (1.f / 16.f); }
            uint4 csl[TOPK], cys[2]; uint2 cx1[4]; const float cwt = dwt;
#pragma unroll
            for (int k = 0; k < TOPK; ++k) csl[k] = dsl[k];
            cys[0] = dys[0]; cys[1] = dys[1];
#pragma unroll
            for (int hq = 0; hq < 4; ++hq) cx1[hq] = dx1[hq];
            if (i + 1 < nrw) { const int m1 = m + c.ngw; const int sr = offs[(recn >> 16) & 255] + (recn & 0xffff);
#pragma unroll
                for (int k = 0; k < TOPK; ++k) dsl[k] = *(const uint4*)&SL8[(size_t)__builtin_amdgcn_readlane(sr, k) * DM + cc];
                dys[0] = *(const uint4*)&YSH[(size_t)m1 * DM + cc]; dys[1] = *(const uint4*)&YSH[(size_t)m1 * DM + cc + 8];
#pragma unroll
                for (int hq = 0; hq < 4; ++hq) dx1[hq] = *(const uint2*)&X1[(size_t)m1 * DM + cc + 4 * hq];
                dwt = wtn; recn = recf; wtn = wtf; }
            const int b = m / SEQ; const float* cf = COEF + b * 4096 + 3072;
            float4 ca[4];
#pragma unroll
            for (int hq = 0; hq < 4; ++hq) ca[hq] = *(const float4*)&cf[cc + 4 * hq];
            float y[16]; float ss = 0.f;
#pragma unroll
            for (int hq = 0; hq < 2; ++hq) { const uint4 u = cys[hq];
                y[8 * hq + 0] = bf2f(u.x & 0xffffu); y[8 * hq + 1] = bf2f(u.x >> 16); y[8 * hq + 2] = bf2f(u.y & 0xffffu); y[8 * hq + 3] = bf2f(u.y >> 16);
                y[8 * hq + 4] = bf2f(u.z & 0xffffu); y[8 * hq + 5] = bf2f(u.z >> 16); y[8 * hq + 6] = bf2f(u.w & 0xffffu); y[8 * hq + 7] = bf2f(u.w >> 16); }
#pragma unroll
            for (int k = 0; k < TOPK; ++k) { const uint4 u = csl[k]; const float wk = __builtin_bit_cast(float, __builtin_amdgcn_readlane(__builtin_bit_cast(int, cwt), k));
                const unsigned wds[4] = {u.x, u.y, u.z, u.w};
#pragma unroll
                for (int d = 0; d < 4; ++d) { const f32x2v a2 = __builtin_amdgcn_cvt_pk_f32_fp8((int)wds[d], false), b2 = __builtin_amdgcn_cvt_pk_f32_fp8((int)wds[d], true);
                    y[4 * d] += wk * a2.x; y[4 * d + 1] += wk * a2.y; y[4 * d + 2] += wk * b2.x; y[4 * d + 3] += wk * b2.y; } }
#pragma unroll
            for (int q = 0; q < 16; ++q) ss += y[q] * y[q];
            const float rstd = rsqrtf(wave_sum(ss) * (1.f / DM) + EPS);
#pragma unroll
            for (int hq = 0; hq < 4; ++hq) {
                const int c4 = cc + 4 * hq; const uint2 xu = cx1[hq];
                float4 xx; xx.x = bf2f(xu.x & 0xffffu); xx.y = bf2f(xu.x >> 16); xx.z = bf2f(xu.y & 0xffffu); xx.w = bf2f(xu.y >> 16);
                float4 r; r.x = xx.x + ca[hq].x * (y[4 * hq] * rstd); r.y = xx.y + ca[hq].y * (y[4 * hq + 1] * rstd);
                r.z = xx.z + ca[hq].z * (y[4 * hq + 2] * rstd); r.w = xx.w + ca[hq].w * (y[4 * hq + 3] * rstd);
                *(float4*)&args.out[(size_t)m * DM + c4] = r;
            }
        }
    }
    }
#undef IN
#undef SEAM
}

constexpr int NPHASE = 12;

extern "C" void kernel_launch(void* const* d_in, const int* in_sizes, int n_in, void* d_out, int out_size, void* d_ws, size_t ws_size, hipStream_t stream) {
    static int grid = 0;
    if (grid == 0) {
        if (n_in != 26 || out_size != NTOK * DM || ws_size < WS_END) { fprintf(stderr, "kernel_launch: unexpected shapes (n_in %d, out %d, ws %zu)\n", n_in, out_size, ws_size); grid = -1; return; }
        int dev = 0, cus = 0, per_cu = 0;
        if (hipGetDevice(&dev) != hipSuccess || hipDeviceGetAttribute(&cus, hipDeviceAttributeMultiprocessorCount, dev) != hipSuccess) { grid = -1; return; }
        if (hipFuncSetAttribute((const void*)mega, hipFuncAttributeMaxDynamicSharedMemorySize, LDS_BYTES) != hipSuccess) { fprintf(stderr, "kernel_launch: hipFuncSetAttribute failed\n"); grid = -1; return; }
        if (hipOccupancyMaxActiveBlocksPerMultiprocessor(&per_cu, (const void*)mega, NTHR, LDS_BYTES) != hipSuccess || per_cu < 1) fprintf(stderr, "kernel_launch: occupancy query says %d\n", per_cu);
        (void)hipGetLastError();
        grid = cus;
    }
    if (grid < 0) return;
    (void)hipMemsetAsync((char*)d_ws + WS_CTL, 0, CTL_ZERO_BYTES, stream);
    Args a{};
    for (int i = 0; i < 26; ++i) a.in[i] = (const float*)d_in[i];
    a.out = (float*)d_out; a.ws = (unsigned char*)d_ws;
    if (MK_N_LAUNCHES == 1) { a.ph_lo = 0; a.ph_hi = NPHASE; hipLaunchKernelGGL(mega, dim3(grid), dim3(NTHR), LDS_BYTES, stream, a); }
    else for (int p = 0; p < NPHASE; ++p) { a.ph_lo = p; a.ph_hi = p + 1; hipLaunchKernelGGL(mega, dim3(grid), dim3(NTHR), LDS_BYTES, stream, a); }
}
```

```cpp
#include <hip/hip_runtime.h>
#include <cstdio>
#include <cstdint>

#ifndef REP_FROM
#define REP_FROM 99
#endif
#ifndef REPEAT_MASK
#define REPEAT_MASK 0
#endif
#ifndef CONV_MODE
#define CONV_MODE 5
#endif
#ifndef MK_N_LAUNCHES
#define MK_N_LAUNCHES 1
#endif

#ifndef ATTN_NAIVE
#define ATTN_NAIVE 0
#endif
#define LAS __attribute__((address_space(3)))
typedef unsigned short bf16_t;

constexpr int NB = 2, SEQ = 8192, NTOK = NB * SEQ, DM = 1024;
constexpr int QLORA = 256, KVLORA = 128, MROPE = 32, MNOPE = 64, MV = 64, MH = 8, DQKM = 96;
constexpr int GH = 8, GKV = 2, GD = 64;
constexpr int INC = 1184;
constexpr int C_QLAT = 0, C_KVLAT = 256, C_KROPE = 384, C_GQ = 416, C_GK = 928, C_GV = 1056;
constexpr int NE = 256, TOPK = 8, EFF = 256;
constexpr int LCAP = 16384;
constexpr float EPS = 1e-6f;
constexpr float LOG2E = 1.4426950408889634f;
constexpr float C2M = 0.10206207261596575f * LOG2E;
constexpr float C2G = 0.125f * LOG2E;

constexpr size_t MiB = 1u << 20;
constexpr size_t WS_CTL = 0, CTL_ZERO_BYTES = 32768;
constexpr size_t WS_MOD = 1 * MiB;
constexpr size_t WS_COSM = 2 * MiB, WS_SINM = 2 * MiB + 512 * 1024, WS_COSG = 3 * MiB, WS_SING = 4 * MiB;
constexpr size_t WS_WQBT = 5 * MiB;
constexpr size_t WS_WINQ = 5 * MiB + 512 * 1024;
constexpr size_t WS_WKVBT = 6 * MiB;
constexpr size_t WS_WINKV = 6 * MiB + 512 * 1024;
constexpr size_t WS_WDST = 7 * MiB;
constexpr size_t WS_COEF = 7 * MiB + 512 * 1024;
constexpr size_t WS_H2 = 8 * MiB;
constexpr size_t WS_X1 = 40 * MiB;
constexpr size_t WS_CNTS = 72 * MiB;
constexpr int CNT_STRIDE = 1088;
constexpr size_t WS_HIST = 82 * MiB;
constexpr size_t WS_WTS = 104 * MiB;
constexpr size_t WS_OSTAT = 252 * MiB;
constexpr size_t WS_POSREC = 105 * MiB;
constexpr size_t WS_LIST = 106 * MiB;
constexpr size_t WS_WBIGT = 122 * MiB;
constexpr size_t WS_WOUTT = 128 * MiB;
constexpr size_t WS_WRST = 130 * MiB;
constexpr size_t WS_ACT = 132 * MiB;
constexpr size_t WS_LOG = 196 * MiB;
constexpr size_t WS_ACTS = 212 * MiB;
constexpr size_t WS_YSH = 220 * MiB;
constexpr size_t WS_SLOTS = 256 * MiB;
constexpr size_t WS_PBUF = 256 * MiB;
constexpr size_t WS_QM = 352 * MiB, WS_KM = 376 * MiB, WS_VM = 400 * MiB, WS_QG = 416 * MiB, WS_KG = 432 * MiB, WS_VG = 436 * MiB;
constexpr size_t WS_O = 440 * MiB;
constexpr size_t WS_MIXED = 472 * MiB;
constexpr size_t WS_WGUT = 512 * MiB;
constexpr size_t WS_WDT = 768 * MiB;
constexpr size_t WS_END = 896 * MiB;
constexpr size_t WS_HF = 512 * MiB, WS_PROJ = 576 * MiB, WS_H2F = 650 * MiB, WS_GS = 714 * MiB, WS_US = 730 * MiB, WS_ACTSF = 746 * MiB, WS_YSHF = 768 * MiB, WS_LOGF = 832 * MiB;
constexpr int CW_CNT = 1024;
constexpr int CW_KMAX = 2048;
constexpr int CW_BAR = 4096;

constexpr int LDS_BYTES = 147456;
constexpr int NTHR = 512, NWAVES = 8;

#define XB_TMO      128
#define XB_XCNT(j)  (256  + 64 * (j))
#define XB_XSUB(j)  (1280 + 64 * (j))
#define XB_XGEN(j)  (2304 + 64 * (j))
#define XB_TOP      3328
#define XB_TOPGEN   3392
#define XCD_BAR_WORDS 3456
#define XB_SPIN_CAP (1u << 18)
__device__ __forceinline__ unsigned xb_ld(unsigned* p)              { return __hip_atomic_load(p, __ATOMIC_RELAXED, __HIP_MEMORY_SCOPE_AGENT); }
__device__ __forceinline__ unsigned xb_add(unsigned* p, unsigned v) { return __hip_atomic_fetch_add(p, v, __ATOMIC_RELAXED, __HIP_MEMORY_SCOPE_AGENT); }
__device__ __forceinline__ unsigned xb_xcc_id() { return (unsigned)__builtin_amdgcn_s_getreg((3 << 11) | 20) & 0xFu; }
#define XB_SPIN(cond, bar) do { unsigned _sp = 0; while (cond) { __builtin_amdgcn_s_sleep(1); \
    if ((++_sp & 255u) == 0u) { if (xb_ld(&(bar)[XB_TMO])) break; if (_sp > XB_SPIN_CAP) { atomicAdd(&(bar)[XB_TMO], 1u); break; } } } } while (0)
struct XcdBarrier { unsigned* bar; unsigned x; volatile LAS unsigned* st; };
__device__ __forceinline__ XcdBarrier xcd_barrier_post(unsigned* bar, volatile LAS unsigned* st) {
    XcdBarrier b; b.bar = bar; b.x = xb_xcc_id(); b.st = st;
    if (threadIdx.x == 0) (void)xb_add(&bar[XB_XCNT(b.x)], 1u);
    return b;
}
__device__ __forceinline__ void xcd_barrier_complete(unsigned* bar, unsigned x, unsigned& nloc, unsigned& nx) {
    const unsigned G = gridDim.x * gridDim.y * gridDim.z;
    unsigned sum, cnt, mine, sp = 0u;
    for (;;) {
        sum = 0u; cnt = 0u; mine = 0u;
#pragma unroll
        for (unsigned j = 0; j < 16; ++j) { const unsigned c = xb_ld(&bar[XB_XCNT(j)]); sum += c; cnt += (c > 0u) ? 1u : 0u; mine = (j == x) ? c : mine; }
        if (sum == G) break;
        __builtin_amdgcn_s_sleep(1);
        if ((++sp & 255u) == 0u) { if (xb_ld(&bar[XB_TMO])) break; if (sp > XB_SPIN_CAP) { atomicAdd(&bar[XB_TMO], 1u); break; } }
    }
    nloc = mine > 0u ? mine : 1u; nx = cnt > 0u ? cnt : 1u;
}
__device__ __forceinline__ void xcd_barrier(const XcdBarrier& b) {
    asm volatile("s_waitcnt vmcnt(0)" ::: "memory");
    __syncthreads();
    if (threadIdx.x == 0) {
        unsigned* bar = b.bar;
        __builtin_amdgcn_s_waitcnt(0);
        unsigned nloc = b.st[0], nx = b.st[1];
        if (nloc == 0u) { xcd_barrier_complete(bar, b.x, nloc, nx); b.st[0] = nloc; b.st[1] = nx; }
        const unsigned old = xb_add(&bar[XB_XSUB(b.x)], 1u);
        const unsigned gen = old / nloc;
        if (old + 1u == (gen + 1u) * nloc) {
            __builtin_amdgcn_fence(__ATOMIC_RELEASE, "agent");
            asm volatile("s_waitcnt vmcnt(0)" ::: "memory");
            const unsigned og = xb_add(&bar[XB_TOP], 1u);
            const unsigned tg = og / nx;
            if (og + 1u == (tg + 1u) * nx) xb_add(&bar[XB_TOPGEN], 1u);
            else XB_SPIN(xb_ld(&bar[XB_TOPGEN]) == tg, bar);
            __builtin_amdgcn_fence(__ATOMIC_ACQUIRE, "agent");
            xb_add(&bar[XB_XGEN(b.x)], 1u);
            asm volatile("s_waitcnt vmcnt(0)" ::: "memory");
        } else {
            XB_SPIN(xb_ld(&bar[XB_XGEN(b.x)]) == gen, bar);
            __builtin_amdgcn_fence(__ATOMIC_ACQUIRE, "agent");
            asm volatile("s_waitcnt vmcnt(0)" ::: "memory");
        }
    }
    __syncthreads();
}

__device__ __forceinline__ unsigned f2bf(float f) { unsigned u = __builtin_bit_cast(unsigned, f); return (u + 0x7fffu + ((u >> 16) & 1u)) >> 16; }
__device__ __forceinline__ float bf2f(unsigned h) { return __builtin_bit_cast(float, h << 16); }
__device__ __forceinline__ unsigned pk2(float lo, float hi) { return f2bf(lo) | (f2bf(hi) << 16); }
template <int CTRL, int RM> __device__ __forceinline__ float dppmov(float old, float v) {
    return __builtin_bit_cast(float, __builtin_amdgcn_update_dpp(__builtin_bit_cast(int, old), __builtin_bit_cast(int, v), CTRL, RM, 0xF, false)); }
__device__ __forceinline__ float wave_sum(float v) {
    v += dppmov<0xB1, 0xF>(0.f, v);
    v += dppmov<0x4E, 0xF>(0.f, v);
    v += dppmov<0x141, 0xF>(0.f, v);
    v += dppmov<0x140, 0xF>(0.f, v);
    v += dppmov<0x142, 0xA>(0.f, v);
    v += dppmov<0x143, 0xC>(0.f, v);
    return __builtin_bit_cast(float, __builtin_amdgcn_readlane(__builtin_bit_cast(int, v), 63));
}
__device__ __forceinline__ float wave_max(float v) {
    const float NI = -INFINITY;
    v = fmaxf(v, dppmov<0xB1, 0xF>(NI, v)); v = fmaxf(v, dppmov<0x4E, 0xF>(NI, v)); v = fmaxf(v, dppmov<0x141, 0xF>(NI, v)); v = fmaxf(v, dppmov<0x140, 0xF>(NI, v));
    v = fmaxf(v, dppmov<0x142, 0xA>(NI, v)); v = fmaxf(v, dppmov<0x143, 0xC>(NI, v));
    return __builtin_bit_cast(float, __builtin_amdgcn_readlane(__builtin_bit_cast(int, v), 63));
}
template <int CTRL, int RM> __device__ __forceinline__ int dppmovi(int old, int v) { return __builtin_amdgcn_update_dpp(old, v, CTRL, RM, 0xF, false); }
__device__ __forceinline__ int imax_(int a, int b) { return a > b ? a : b; }
__device__ __forceinline__ int imin_(int a, int b) { return a < b ? a : b; }
__device__ __forceinline__ int wave_max_i(int v) {
    const int NI = (int)0x80000000;
    v = imax_(v, dppmovi<0xB1, 0xF>(NI, v)); v = imax_(v, dppmovi<0x4E, 0xF>(NI, v)); v = imax_(v, dppmovi<0x141, 0xF>(NI, v)); v = imax_(v, dppmovi<0x140, 0xF>(NI, v));
    v = imax_(v, dppmovi<0x142, 0xA>(NI, v)); v = imax_(v, dppmovi<0x143, 0xC>(NI, v));
    return __builtin_amdgcn_readlane(v, 63);
}
__device__ __forceinline__ int grp8_max_i(int v) {
    const int NI = (int)0x80000000;
    v = imax_(v, dppmovi<0xB1, 0xF>(NI, v)); v = imax_(v, dppmovi<0x4E, 0xF>(NI, v)); v = imax_(v, dppmovi<0x141, 0xF>(NI, v)); return v;
}
__device__ __forceinline__ int ford(float f) { const int b = __builtin_bit_cast(int, f); return b ^ ((b >> 31) & 0x7fffffff); }
__device__ __forceinline__ float funord(int k) { return __builtin_bit_cast(float, k ^ ((k >> 31) & 0x7fffffff)); }
__device__ __forceinline__ float grp8_sum(float v) {
    v += dppmov<0xB1, 0xF>(0.f, v); v += dppmov<0x4E, 0xF>(0.f, v); v += dppmov<0x141, 0xF>(0.f, v); return v;
}
__device__ __forceinline__ float grp8_max(float v) {
    const float NI = -INFINITY;
    v = fmaxf(v, dppmov<0xB1, 0xF>(NI, v)); v = fmaxf(v, dppmov<0x4E, 0xF>(NI, v)); v = fmaxf(v, dppmov<0x141, 0xF>(NI, v)); return v;
}
__device__ __forceinline__ float sigmoidf_(float x) { return 1.f / (1.f + __expf(-x)); }

struct Args { const float* in[26]; float* out; unsigned char* ws; int ph_lo, ph_hi; };

struct Ctx {
    int tid, lane, wave, bid, nb, gw, ngw;
    unsigned char* ws; float* lds;
};
__device__ __forceinline__ Ctx mkctx(unsigned char* ws, unsigned char* lds_raw) {
    Ctx c; int t = threadIdx.x; asm volatile("" : "+v"(t));
    c.tid = t; c.lane = t & 63; c.wave = __builtin_amdgcn_readfirstlane(t >> 6);
    c.bid = blockIdx.x; c.nb = gridDim.x; c.gw = c.bid * NWAVES + c.wave; c.ngw = c.nb * NWAVES; c.ws = ws; c.lds = (float*)lds_raw; return c;
}

namespace att {
using bf16x8 = __attribute__((ext_vector_type(8))) short;
using s16x4 = __attribute__((ext_vector_type(4))) short;
using f32x16 = __attribute__((ext_vector_type(16))) float;
using u32x4 = __attribute__((ext_vector_type(4))) unsigned;
typedef float f32x2_t __attribute__((ext_vector_type(2))); typedef __bf16 bf16x2_t __attribute__((ext_vector_type(2)));
typedef __attribute__((address_space(3))) const char* lds_cptr;
typedef short v4i16_t __attribute__((ext_vector_type(4)));
constexpr int NT = SEQ / 64;
constexpr int KSLOT = 12288, VSLOT = 8192, NSLOT = 3;
constexpr int LDS_K = 0, LDS_V = NSLOT * KSLOT, LDS_WS = LDS_V + NSLOT * VSLOT, LDS_OST = LDS_WS + NWAVES * 256, LDS_ATT = LDS_OST + NWAVES * 4096;
#define SBAR() __builtin_amdgcn_sched_barrier(0)
#define MFMA(a, b, c) __builtin_amdgcn_mfma_f32_32x32x16_bf16(a, b, c, 0, 0, 0)
__device__ __forceinline__ int crow(int r, int hi) { return (r & 3) + 8 * (r >> 2) + 4 * hi; }
__device__ __forceinline__ unsigned cvtpk_s(float lo, float hi) { f32x2_t v = {lo, hi}; bf16x2_t b = __builtin_convertvector(v, bf16x2_t); return __builtin_bit_cast(unsigned, b); }
__device__ __forceinline__ void glds16(const void* g, unsigned lds_base) {
    unsigned sv; asm volatile("s_mov_b32 %0, m0\n\ts_mov_b32 m0, %2\n\ts_nop 0\n\tglobal_load_lds_dwordx4 %1, off\n\ts_mov_b32 m0, %0" : "=&s"(sv) : "v"(g), "s"(lds_base) : "memory"); }
__device__ __forceinline__ s16x4 vtr(lds_cptr p) { return __builtin_bit_cast(s16x4, __builtin_amdgcn_ds_read_tr16_b64_v4i16((__attribute__((address_space(3))) v4i16_t*)p)); }
#define MX3(a, b, c) __builtin_fmaxf(__builtin_fmaxf((a), (b)), (c))
__device__ __forceinline__ float rowmax(const f32x16& p0, const f32x16& p1) {
    float a = MX3(p0[0], p0[1], p1[0]), b = MX3(p0[2], p0[3], p1[1]); a = MX3(a, p1[2], p1[3]);
#pragma unroll
    for (int r = 4; r < 16; r += 4) { a = MX3(a, p0[r], p0[r + 1]); b = MX3(b, p0[r + 2], p0[r + 3]); a = MX3(a, p1[r], p1[r + 1]); b = MX3(b, p1[r + 2], p1[r + 3]); }
    float m = __builtin_fmaxf(a, b); auto rr = __builtin_amdgcn_permlane32_swap(__float_as_uint(m), __float_as_uint(m), false, false);
    return __builtin_fmaxf(__uint_as_float(rr[0]), __uint_as_float(rr[1])); }

template <int DQK>
__device__ __forceinline__ void unit_simple(const bf16_t* Qh, const bf16_t* __restrict__ Kh, const bf16_t* __restrict__ Vh, bf16_t* Ob, int q0, char* shm) {
    constexpr int NCH = DQK / 8, ND0 = DQK / 16;
    int tid_ = threadIdx.x; asm volatile("" : "+v"(tid_));
    const int tid = tid_, lane = tid & 63, r32 = lane & 31, hi = lane >> 5; const int wid = __builtin_amdgcn_readfirstlane(tid >> 6);
    const bf16_t* Qw = Qh + (size_t)(q0 + wid * 32) * DQK;
    const unsigned lds0 = (unsigned)(uintptr_t)shm; float* wsf = (float*)(shm + LDS_WS) + wid * 64;
    const bf16_t* ksrc0 = Kh + (size_t)lane * DQK + wid * 8;
    const bf16_t* ksrc1 = Kh + (size_t)lane * DQK + (8 + (wid & 3)) * 8;
    const bf16_t* vsrc = Vh + (size_t)(16 * (wid & 3) + (lane >> 2)) * 64 + (wid >> 2) * 32 + (lane & 3) * 8;
    const unsigned kdst0 = lds0 + LDS_K + wid * 1024, kdst1 = lds0 + LDS_K + (8 + (wid & 3)) * 1024, vdst = lds0 + LDS_V + wid * 1024;
#define DMA_KV(t, sl) do { glds16(ksrc0 + (size_t)(t) * 64 * DQK, (unsigned)__builtin_amdgcn_readfirstlane(kdst0 + (sl) * KSLOT)); \
        if (NCH == 12 && wid < 4) glds16(ksrc1 + (size_t)(t) * 64 * DQK, (unsigned)__builtin_amdgcn_readfirstlane(kdst1 + (sl) * KSLOT)); \
        glds16(vsrc + (size_t)(t) * 64 * 64, (unsigned)__builtin_amdgcn_readfirstlane(vdst + (sl) * VSLOT)); } while (0)
    const lds_cptr shm3 = (lds_cptr)shm;
    const lds_cptr vp0 = shm3 + LDS_V + ((lane >> 4) & 1) * 32 + (lane & 3) * 8 + (4 * hi + ((lane & 15) >> 2)) * 64;
    const lds_cptr kp0 = shm3 + LDS_K + hi * 1024 + r32 * 16;
    DMA_KV(0, 0);
    bf16x8 qr[ND0];
#pragma unroll
    for (int d0 = 0; d0 < ND0; ++d0) qr[d0] = *reinterpret_cast<const bf16x8*>(&Qw[(size_t)r32 * DQK + d0 * 16 + hi * 8]);
    float mhat = -INFINITY, l_reg = 0.f; f32x16 o[2]; o[0] = f32x16{}; o[1] = f32x16{};
    asm volatile("s_waitcnt vmcnt(0) lgkmcnt(0)\n\ts_barrier" ::: "memory");
    for (int t = 0; t < NT; ++t) {
        const int sl = t & 1;
        if (t + 1 < NT) DMA_KV(t + 1, sl ^ 1);
        f32x16 p0 = f32x16{}, p1 = f32x16{};
        const lds_cptr kp = kp0 + sl * KSLOT;
#pragma unroll
        for (int d0 = 0; d0 < ND0; ++d0) {
            const bf16x8 b0 = *(const __attribute__((address_space(3))) bf16x8*)(kp + d0 * 2048);
            const bf16x8 b1 = *(const __attribute__((address_space(3))) bf16x8*)(kp + d0 * 2048 + 512);
            p0 = MFMA(b0, qr[d0], p0); p1 = MFMA(b1, qr[d0], p1);
        }
        const float rm = rowmax(p0, p1);
        const float mn = __builtin_fmaxf(mhat, rm), f = __builtin_amdgcn_exp2f(mhat - mn); mhat = mn;
        float sacc = 0.f;
#pragma unroll
        for (int r = 0; r < 16; ++r) { p0[r] = __builtin_amdgcn_exp2f(p0[r] - mn); p1[r] = __builtin_amdgcn_exp2f(p1[r] - mn); sacc += p0[r] + p1[r]; }
        l_reg = l_reg * f + sacc;
        if (hi == 0) wsf[r32] = f;
        asm volatile("s_waitcnt lgkmcnt(0)" ::: "memory");
#pragma unroll
        for (int d_ = 0; d_ < 2; ++d_)
#pragma unroll
            for (int r = 0; r < 16; ++r) o[d_][r] *= wsf[crow(r, hi)];
        u32x4 pw[4];
#pragma unroll
        for (int i = 0; i < 4; ++i) { pw[0][i] = cvtpk_s(p0[2 * i], p0[2 * i + 1]); pw[1][i] = cvtpk_s(p0[8 + 2 * i], p0[8 + 2 * i + 1]); pw[2][i] = cvtpk_s(p1[2 * i], p1[2 * i + 1]); pw[3][i] = cvtpk_s(p1[8 + 2 * i], p1[8 + 2 * i + 1]); }
        const lds_cptr vp_ = vp0 + sl * VSLOT;
#pragma unroll
        for (int d0 = 0; d0 < 2; ++d0)
#pragma unroll
            for (int ks = 0; ks < 4; ++ks) {
                const s16x4 lo = vtr(vp_ + d0 * 4096 + ks * 1024), hh = vtr(vp_ + d0 * 4096 + ks * 1024 + 512);
                const bf16x8 vf = (bf16x8){lo[0], lo[1], lo[2], lo[3], hh[0], hh[1], hh[2], hh[3]};
                o[d0] = MFMA(__builtin_bit_cast(bf16x8, pw[ks]), vf, o[d0]);
            }
        asm volatile("s_waitcnt vmcnt(0) lgkmcnt(0)\n\ts_barrier" ::: "memory");
    }
#undef DMA_KV
    { auto rr = __builtin_amdgcn_permlane32_swap(__float_as_uint(l_reg), __float_as_uint(l_reg), false, false); l_reg = __uint_as_float(rr[0]) + __uint_as_float(rr[1]); }
    if (hi == 0) wsf[32 + r32] = l_reg; asm volatile("s_waitcnt lgkmcnt(0)" ::: "memory");
    float rli[16];
#pragma unroll
    for (int r = 0; r < 16; ++r) rli[r] = __builtin_amdgcn_rcpf(wsf[32 + crow(r, hi)]);
    bf16_t* Ow = Ob + (size_t)(wid * 32) * DM; bf16_t* stg = (bf16_t*)(shm + LDS_OST) + wid * 2048;
#pragma unroll
    for (int r = 0; r < 16; ++r) { const int orow = crow(r, hi);
#pragma unroll
        for (int d0 = 0; d0 < 2; ++d0) stg[orow * 64 + d0 * 32 + r32] = (bf16_t)f2bf(o[d0][r] * rli[r]); }
    asm volatile("s_waitcnt lgkmcnt(0)" ::: "memory");
#pragma unroll
    for (int i = 0; i < 4; ++i) { const int row = i * 8 + (lane >> 3), ch = lane & 7; *(u32x4*)(Ow + (size_t)row * DM + ch * 8) = *(const u32x4*)(stg + row * 64 + ch * 8); }
    asm volatile("s_waitcnt vmcnt(0) lgkmcnt(0)\n\ts_barrier" ::: "memory");
}

constexpr int CONV_LDS = 112640;
struct ConvState { int cj, jbase; const char* wg; const char* wu; const char* wd; char* dgu; char* dd; unsigned ldsbuf; lds_cptr rdbuf; };
struct ConvJob { const char* sbase; char* dbase; unsigned ldwB, KdB; };
__device__ __forceinline__ ConvJob conv_job(const ConvState& cs, int j) {
    const int J = (CONV_MODE >= 5) ? j : cs.jbase + (j < 383 ? j : 383); const int m = J >> 10, r = J & 1023; ConvJob q;
    if (m < 2) { const int g = r >> 7, kg = r & 127; const int drow0 = ((g < 4) ? g * 32 : 256 + (g - 4) * 32) + m * 128;
        q.sbase = (m ? cs.wu : cs.wg) + (size_t)((8 * kg) * EFF + g * 32) * 4; q.ldwB = EFF * 4; q.dbase = cs.dgu + (size_t)(drow0 * DM + 8 * kg) * 2; q.KdB = DM * 2; }
    else { const int g = r >> 5, kg = r & 31;
        q.sbase = cs.wd + (size_t)((8 * kg) * DM + g * 32) * 4; q.ldwB = DM * 4; q.dbase = cs.dd + (size_t)((g * 32) * EFF + 8 * kg) * 2; q.KdB = EFF * 2; }
    return q;
}
__device__ __forceinline__ void glds16_s(const char* sbase, unsigned voff, unsigned lds_base) {
    unsigned sv; asm volatile("s_mov_b32 %0, m0\n\ts_mov_b32 m0, %3\n\ts_nop 4\n\tglobal_load_lds_dwordx4 %1, %2\n\ts_mov_b32 m0, %0" : "=&s"(sv) : "v"(voff), "s"(sbase), "s"(lds_base) : "memory"); }
#if CONV_MODE == 1 || CONV_MODE == 3 || CONV_MODE == 4 || CONV_MODE >= 5
#define CONV_DRAIN() do { const int jd_ = cs.cj - 3; const ConvJob q_ = conv_job(cs, jd_); \
        const __attribute__((address_space(3))) float* bp_ = (const __attribute__((address_space(3))) float*)(cs.rdbuf + (jd_ & 3) * 1024) + (lane >> 5) * 128 + (lane & 31); \
        uint2 w_; w_.x = cvtpk_s(bp_[0], bp_[32]); w_.y = cvtpk_s(bp_[64], bp_[96]); \
        if (CONV_MODE == 1) *(uint2*)(q_.dbase + (size_t)((unsigned)(lane & 31) * q_.KdB + (unsigned)(lane >> 5) * 8u)) = w_; \
        else if (CONV_MODE == 4) *(uint2*)(cs.dgu + 0x30000000ull + (size_t)((unsigned)(lane & 31) * 2048u + (unsigned)(lane >> 5) * 8u + (unsigned)(jd_ & 127) * 16u)) = w_; \
        else asm volatile("" :: "v"(w_)); } while (0)
#else
#define CONV_DRAIN() do { } while (0)
#endif
#if CONV_MODE >= 5
#undef CONV_DRAIN
#define CONV_NSTEP 384
#define CONV_DRAIN() do { if (CONV_MODE == 5 && rst && cs.cj >= 3 && cs.cj < CONV_NSTEP + 3) { const int jb_ = 8 * (cs.cj - 3) + 4 * (wid - 6); const ConvJob q_ = conv_job(cs, jb_); \
          \
        const __attribute__((address_space(3))) float* bp_ = (const __attribute__((address_space(3))) float*)(cs.rdbuf + (jb_ & 31) * 1024) + (lane >> 5) * 512 + (lane & 31); \
        float v_[16]; \
        _Pragma("unroll") for (int i_ = 0; i_ < 16; ++i_) v_[i_] = bp_[i_ * 32]; \
        char* dp_ = q_.dbase + (size_t)((unsigned)(lane & 31) * q_.KdB + (unsigned)(lane >> 5) * 32u); \
        _Pragma("unroll") for (int i_ = 0; i_ < 2; ++i_) { uint4 w_; w_.x = cvtpk_s(v_[8 * i_], v_[8 * i_ + 1]); w_.y = cvtpk_s(v_[8 * i_ + 2], v_[8 * i_ + 3]); \
            w_.z = cvtpk_s(v_[8 * i_ + 4], v_[8 * i_ + 5]); w_.w = cvtpk_s(v_[8 * i_ + 6], v_[8 * i_ + 7]); *(uint4*)(dp_ + 16 * i_) = w_; } } } while (0)
#define CONV_ISSUE() do { if (CONV_MODE != 6 && rcl && cs.cj < CONV_NSTEP) { const int jb_ = 8 * cs.cj + 4 * (wid - 4); const ConvJob q_ = conv_job(cs, jb_); \
        const unsigned vo_ = (unsigned)(lane >> 3) * q_.ldwB + (unsigned)(lane & 7) * 16u; const unsigned lb_ = (unsigned)__builtin_amdgcn_readfirstlane(cs.ldsbuf + (jb_ & 31) * 1024); \
        glds16_s(q_.sbase, vo_, lb_); glds16_s(q_.sbase + (size_t)8 * q_.ldwB, vo_, lb_ + 1024); glds16_s(q_.sbase + (size_t)16 * q_.ldwB, vo_, lb_ + 2048); glds16_s(q_.sbase + (size_t)24 * q_.ldwB, vo_, lb_ + 3072); } \
        ++cs.cj; } while (0)
#define WAIT_BARL() asm volatile("s_waitcnt lgkmcnt(0)\n\ts_barrier" ::: "memory")
#define RWAIT(N) do { if (rkv) { WAIT_BAR(N); } else if (rcl) { WAIT_BAR(8); } else { WAIT_BARL(); } } while (0)
#elif CONV_MODE != 0
#define CONV_ISSUE() do { const ConvJob q_ = conv_job(cs, cs.cj); \
        glds16_s(q_.sbase, (unsigned)(lane >> 3) * q_.ldwB + (unsigned)(lane & 7) * 16u, (unsigned)__builtin_amdgcn_readfirstlane(cs.ldsbuf + (cs.cj & 3) * 1024)); ++cs.cj; } while (0)
#define WB_P() WAIT_BAR(3)
#define WB_S() WAIT_BAR(4)
#define WB_E1() WAIT_BAR(3)
#define WB_E0() WAIT_BAR(1)
#define WB_PL() WAIT_BAR(4)
#define WB_SL() WAIT_BAR(5)
#else
#define CONV_ISSUE() do { } while (0)
#define WB_P() WAIT_BAR(2)
#define WB_S() WAIT_BAR(2)
#define WB_E1() WAIT_BAR(1)
#define WB_E0() WAIT_BAR(0)
#define WB_PL() WAIT_BAR(3)
#define WB_SL() WAIT_BAR(3)
#endif

constexpr int T_SLOTB = 8192, T_LDS_K = 0, T_LDS_V = 3 * T_SLOTB, T_LDS_WS = 6 * T_SLOTB, T_LDS_OST = T_LDS_WS + NWAVES * 256;
#define WAIT_BAR(N) asm volatile("s_waitcnt vmcnt(" #N ") lgkmcnt(0)\n\ts_barrier" ::: "memory")
__device__ __forceinline__ float max3f(float a, float b, float c) { float r; asm("v_max3_f32 %0, %1, %2, %3" : "=v"(r) : "v"(a), "v"(b), "v"(c)); return r; }
__device__ __forceinline__ float max2f(float a, float b) { float r; asm("v_max_f32_e32 %0, %1, %2" : "=v"(r) : "v"(a), "v"(b)); return r; }
__device__ __forceinline__ float fadd_s(float a, float b) { float r; asm("v_add_f32_e32 %0, %1, %2" : "=v"(r) : "v"(a), "v"(b)); return r; }
__device__ __forceinline__ float fsub_s(float a, float b) { float r; asm("v_sub_f32_e32 %0, %1, %2" : "=v"(r) : "v"(a), "v"(b)); return r; }
__device__ __forceinline__ float rowmax_asm(const f32x16& p0, const f32x16& p1) {
    float a = max3f(p0[0], p0[1], p1[0]), b = max3f(p0[2], p0[3], p1[1]); a = max3f(a, p1[2], p1[3]);
#pragma unroll
    for (int r = 4; r < 16; r += 4) { a = max3f(a, p0[r], p0[r + 1]); b = max3f(b, p0[r + 2], p0[r + 3]); a = max3f(a, p1[r], p1[r + 1]); b = max3f(b, p1[r + 2], p1[r + 3]); }
    const float m = max2f(a, b);
    auto rr = __builtin_amdgcn_permlane32_swap(__float_as_uint(m), __float_as_uint(m), false, false);
    return max2f(__uint_as_float(rr[0]), __uint_as_float(rr[1]));
}
__device__ __forceinline__ void kload8(bf16x8* kf, lds_cptr kp) {
    kf[0] = *(const __attribute__((address_space(3))) bf16x8*)(kp);        kf[1] = *(const __attribute__((address_space(3))) bf16x8*)(kp + 512);
    kf[2] = *(const __attribute__((address_space(3))) bf16x8*)(kp + 2048); kf[3] = *(const __attribute__((address_space(3))) bf16x8*)(kp + 2560);
    kf[4] = *(const __attribute__((address_space(3))) bf16x8*)(kp + 4096); kf[5] = *(const __attribute__((address_space(3))) bf16x8*)(kp + 4608);
    kf[6] = *(const __attribute__((address_space(3))) bf16x8*)(kp + 6144); kf[7] = *(const __attribute__((address_space(3))) bf16x8*)(kp + 6656);
}
__device__ __forceinline__ void kload2(bf16x8* kf, lds_cptr kp, int j) { kf[2 * j] = *(const __attribute__((address_space(3))) bf16x8*)(kp + j * 2048); kf[2 * j + 1] = *(const __attribute__((address_space(3))) bf16x8*)(kp + j * 2048 + 512); }

template <int THRL>
__device__ __forceinline__ void unit64(const bf16_t* Qh, const bf16_t* __restrict__ Kh, const bf16_t* __restrict__ Vh, bf16_t* Ob, float* ostat, int q0, char* shm, ConvState& cs, float mfix) {
    constexpr int DQ = 64;
    int tid_ = threadIdx.x; asm volatile("" : "+v"(tid_));
    const int tid = tid_, lane = tid & 63, r32 = lane & 31, hi = lane >> 5; const int wid = __builtin_amdgcn_readfirstlane(tid >> 6);
    const bf16_t* Qw = Qh + (size_t)(q0 + wid * 32) * DQ;
    const unsigned lds0 = (unsigned)(uintptr_t)shm;
    float* wsf = (float*)(shm + T_LDS_WS) + wid * 64;
#if CONV_MODE >= 5
    const bool rkv = wid < 4, rcl = (wid == 4 || wid == 5), rst = wid >= 6; const int pw = wid & 3;
    const bf16_t* ksrc = Kh + (size_t)lane * DQ + pw * 8;
    const bf16_t* vsrc = Vh + (size_t)(16 * pw + (lane >> 2)) * 64 + (lane & 3) * 8;
    const unsigned kdst = lds0 + T_LDS_K + pw * 1024, vdst = lds0 + T_LDS_V + pw * 1024;
#define DMA_K(t, slot) do { if (rkv) { glds16(ksrc + (size_t)(t) * 64 * DQ, (unsigned)__builtin_amdgcn_readfirstlane(kdst + (slot))); \
        glds16(ksrc + 32 + (size_t)(t) * 64 * DQ, (unsigned)__builtin_amdgcn_readfirstlane(kdst + 4096 + (slot))); } } while (0)
#define DMA_V(t, slot) do { if (rkv) { glds16(vsrc + (size_t)(t) * 64 * 64, (unsigned)__builtin_amdgcn_readfirstlane(vdst + (slot))); \
        glds16(vsrc + 32 + (size_t)(t) * 64 * 64, (unsigned)__builtin_amdgcn_readfirstlane(vdst + 4096 + (slot))); } } while (0)
#define WB_P() RWAIT(4)
#define WB_S() RWAIT(4)
#define WB_E1() RWAIT(2)
#define WB_E0() RWAIT(0)
#else
    const bf16_t* ksrc = Kh + (size_t)lane * DQ + wid * 8;
    const bf16_t* vsrc = Vh + (size_t)(16 * (wid & 3) + (lane >> 2)) * 64 + (wid >> 2) * 32 + (lane & 3) * 8;
    const unsigned kdst = lds0 + T_LDS_K + wid * 1024, vdst = lds0 + T_LDS_V + wid * 1024;
#define DMA_K(t, slot) glds16(ksrc + (size_t)(t) * 64 * DQ, (unsigned)__builtin_amdgcn_readfirstlane(kdst + (slot)))
#define DMA_V(t, slot) glds16(vsrc + (size_t)(t) * 64 * 64, (unsigned)__builtin_amdgcn_readfirstlane(vdst + (slot)))
#endif
    const int vb0 = (int)(lds0 + T_LDS_V) + ((lane >> 4) & 1) * 32 + (lane & 3) * 8 + (4 * hi + ((lane & 15) >> 2)) * 64;
    bf16x8 kf[8];
    const lds_cptr shm3 = (lds_cptr)shm; const lds_cptr kp0 = shm3 + T_LDS_K + hi * 1024 + r32 * 16;
    const lds_cptr vp0 = shm3 + T_LDS_V + ((lane >> 4) & 1) * 32 + (lane & 3) * 8 + (4 * hi + ((lane & 15) >> 2)) * 64;
    DMA_K(0, 0); DMA_V(0, 0); DMA_K(1, T_SLOTB);
    bf16x8 qr[4];
#pragma unroll
    for (int d0 = 0; d0 < 4; ++d0) qr[d0] = *reinterpret_cast<const bf16x8*>(&Qw[(size_t)r32 * DQ + d0 * 16 + hi * 8]);
    float mfo = mfix; asm volatile("" : "+v"(mfo));
    float mhat = mfo, l_reg = 0.f; f32x16 o[2]; o[0] = f32x16{}; o[1] = f32x16{}; f32x16 negm;
#pragma unroll
    for (int r = 0; r < 16; ++r) negm[r] = -mfo;
    asm volatile("" : "+v"(negm));
    bool resc = false;
#define START(P0, P1) do { resc = false; _Pragma("unroll") for (int r = 0; r < 16; ++r) P0[r] = __builtin_amdgcn_exp2f(P0[r]); } while (0)
#define RESC() do { if (resc) { asm volatile("s_waitcnt lgkmcnt(0)" ::: "memory"); \
      _Pragma("unroll") for (int d_ = 0; d_ < 2; ++d_) _Pragma("unroll") for (int r = 0; r < 16; ++r) o[d_][r] *= wsf[crow(r, hi)]; } } while (0)
    f32x16 pA0, pA1, pB0, pB1;
    int sl_prev = 0, sl_cur = 0, sl_next = T_SLOTB;
#define ROT() do { sl_prev = sl_cur; sl_cur = sl_next; sl_next = (sl_next == 2 * T_SLOTB) ? 0 : sl_next + T_SLOTB; } while (0)
    DMA_K(2, 2 * T_SLOTB);
#if CONV_MODE >= 5
    WAIT_BAR(0);
#else
    WAIT_BAR(3);
#endif
    CONV_DRAIN();
    {
        const lds_cptr kb = kp0;
#pragma unroll
        for (int d0 = 0; d0 < 4; ++d0) {
            const bf16x8 b0 = *(const __attribute__((address_space(3))) bf16x8*)(kb + d0 * 2048);
            const bf16x8 b1 = *(const __attribute__((address_space(3))) bf16x8*)(kb + d0 * 2048 + 512);
            if (d0 == 0) { pA0 = MFMA(b0, qr[0], negm); pA1 = MFMA(b1, qr[0], negm); }
            else { pA0 = MFMA(b0, qr[d0], pA0); pA1 = MFMA(b1, qr[d0], pA1); } }
    }
    asm volatile("s_nop 15\n\ts_nop 7" : "+v"(pA0), "+v"(pA1));
    START(pA0, pA1);
#pragma unroll
    for (int r = 0; r < 16; ++r) pA1[r] = __builtin_amdgcn_exp2f(pA1[r]);
    WAIT_BAR(0);
    DMA_K(3, 0); DMA_V(1, T_SLOTB); CONV_ISSUE();
    ROT();
    kload8(kf, kp0 + sl_cur);
    WB_P();
    s16x4 vlo[8], vhi[8]; u32x4 pw0, pw1, pw2, pw3;
#define PKW(P, B) cvtpk_s(P[B], P[B + 1])
#define PAF(k) __builtin_bit_cast(bf16x8, pw##k)
#define VFR(i) (bf16x8){vlo[i][0], vlo[i][1], vlo[i][2], vlo[i][3], vhi[i][0], vhi[i][1], vhi[i][2], vhi[i][3]}
#define PIN(x) asm volatile("" : "+v"(x))
#define GAPA(MF, A0, A1, A2, A3, W0, W1, PW) do { MF; sacc += A0; sacc += A1; sacc += A2; sacc += A3; PIN(sacc); W0; W1; PIN(PW); SBAR(); } while (0)
#define EX(v) __builtin_amdgcn_exp2f(v)
#define GAPB(MF, X, B) do { MF; X[B] = EX(X[B]); X[B + 1] = EX(X[B + 1]); X[B + 2] = EX(X[B + 2]); X[B + 3] = EX(X[B + 3]); PIN(X); SBAR(); } while (0)
#define VRD(i) do { vlo[i] = vtr(vp_ + (((i) >> 2) * 4096 + ((i) & 3) * 1024)); vhi[i] = vtr(vp_ + (((i) >> 2) * 4096 + ((i) & 3) * 1024 + 512)); } while (0)
#define KRD(G, j) do { if (G) { kload2(kf, kp0 + sl_next, j); SBAR(); } } while (0)
#define STEP(C0, C1, P0, P1, t, GK, GV, GL) do { SBAR(); CONV_DRAIN(); SBAR(); \
    const lds_cptr vp_ = vp0 + sl_prev; \
    VRD(0); SBAR(); float sacc = (P0[0] + P0[1]); \
    GAPA(C0 = MFMA(kf[0], qr[0], negm), P0[2], P0[3], P0[4], P0[5],     pw0[0] = PKW(P0, 0), pw0[1] = PKW(P0, 2), pw0); \
    VRD(4); SBAR(); GAPA(C1 = MFMA(kf[1], qr[0], negm), P0[6], P0[7], P0[8], P0[9],     pw0[2] = PKW(P0, 4), pw0[3] = PKW(P0, 6), pw0); \
    VRD(1); SBAR(); GAPA(C0 = MFMA(kf[2], qr[1], C0),   P0[10], P0[11], P0[12], P0[13], pw1[0] = PKW(P0, 8), pw1[1] = PKW(P0, 10), pw1); \
    VRD(5); SBAR(); GAPA(C1 = MFMA(kf[3], qr[1], C1),   P0[14], P0[15], P1[0], P1[1],   pw1[2] = PKW(P0, 12), pw1[3] = PKW(P0, 14), pw1); \
    VRD(2); SBAR(); GAPA(C0 = MFMA(kf[4], qr[2], C0),   P1[2], P1[3], P1[4], P1[5],     pw2[0] = PKW(P1, 0), pw2[1] = PKW(P1, 2), pw2); \
    VRD(6); SBAR(); GAPA(C1 = MFMA(kf[5], qr[2], C1),   P1[6], P1[7], P1[8], P1[9],     pw2[2] = PKW(P1, 4), pw2[3] = PKW(P1, 6), pw2); \
    VRD(3); SBAR(); GAPA(C0 = MFMA(kf[6], qr[3], C0),   P1[10], P1[11], P1[12], P1[13], pw3[0] = PKW(P1, 8), pw3[1] = PKW(P1, 10), pw3); \
    VRD(7); SBAR(); GAPA(C1 = MFMA(kf[7], qr[3], C1),   P1[14], P1[15], 0.f, 0.f,       pw3[2] = PKW(P1, 12), pw3[3] = PKW(P1, 14), pw3); \
    l_reg += sacc; \
    if (GK) { DMA_K((t) + 3, sl_cur); } if (GV) { DMA_V((t) + 1, sl_next); } CONV_ISSUE(); \
    SBAR(); \
    GAPB(o[0] = MFMA(PAF(0), VFR(0), o[0]), C0, 0); \
    GAPB(o[1] = MFMA(PAF(0), VFR(4), o[1]), C0, 4); \
    KRD(GL, 0); GAPB(o[0] = MFMA(PAF(1), VFR(1), o[0]), C0, 8); \
    KRD(GL, 1); GAPB(o[1] = MFMA(PAF(1), VFR(5), o[1]), C0, 12); \
    KRD(GL, 2); GAPB(o[0] = MFMA(PAF(2), VFR(2), o[0]), C1, 0); \
    KRD(GL, 3); GAPB(o[1] = MFMA(PAF(2), VFR(6), o[1]), C1, 4); \
    GAPB(o[0] = MFMA(PAF(3), VFR(3), o[0]), C1, 8); \
    GAPB(o[1] = MFMA(PAF(3), VFR(7), o[1]), C1, 12); \
    } while (0)
    int t = 1;
    for (; t + 5 < NT; t += 2) {
        STEP(pB0, pB1, pA0, pA1, t, true, true, true);     WB_S(); RESC(); ROT();
        STEP(pA0, pA1, pB0, pB1, t + 1, true, true, true); WB_S(); RESC(); ROT();
    }
#define ENDW(tt) do { if ((tt) + 3 < NT) { WB_S(); } else if ((tt) + 2 < NT) { WB_E1(); } else { WB_E0(); } } while (0)
    for (; t + 1 < NT; t += 2) {
        STEP(pB0, pB1, pA0, pA1, t, (t + 3 < NT), (t + 1 < NT), (t + 1 < NT));         ENDW(t);     RESC(); ROT();
        STEP(pA0, pA1, pB0, pB1, t + 1, (t + 4 < NT), (t + 2 < NT), (t + 2 < NT));     ENDW(t + 1); RESC(); ROT();
    }
    STEP(pB0, pB1, pA0, pA1, NT - 1, false, false, false); RESC();
    {
        float sacc = pB0[0] + pB0[1];
#pragma unroll
        for (int r = 2; r < 16; ++r) sacc += pB0[r];
#pragma unroll
        for (int r = 0; r < 16; ++r) sacc += pB1[r];
        l_reg += sacc;
        pw0 = (u32x4){PKW(pB0, 0), PKW(pB0, 2), PKW(pB0, 4), PKW(pB0, 6)}; pw1 = (u32x4){PKW(pB0, 8), PKW(pB0, 10), PKW(pB0, 12), PKW(pB0, 14)};
        pw2 = (u32x4){PKW(pB1, 0), PKW(pB1, 2), PKW(pB1, 4), PKW(pB1, 6)}; pw3 = (u32x4){PKW(pB1, 8), PKW(pB1, 10), PKW(pB1, 12), PKW(pB1, 14)};
        SBAR();
        const lds_cptr vp_ = vp0 + sl_cur;
#pragma unroll
        for (int i = 0; i < 8; ++i) VRD(i);
        o[0] = MFMA(PAF(0), VFR(0), o[0]); o[1] = MFMA(PAF(0), VFR(4), o[1]); o[0] = MFMA(PAF(1), VFR(1), o[0]); o[1] = MFMA(PAF(1), VFR(5), o[1]);
        o[0] = MFMA(PAF(2), VFR(2), o[0]); o[1] = MFMA(PAF(2), VFR(6), o[1]); o[0] = MFMA(PAF(3), VFR(3), o[0]); o[1] = MFMA(PAF(3), VFR(7), o[1]);
    }
#undef PKW
#undef PAF
#undef VFR
#undef PIN
#undef GAPA
#undef GAPB
#undef EX
#undef VRD
#undef KRD
#undef STEP
#undef ENDW
    { auto rr = __builtin_amdgcn_permlane32_swap(__float_as_uint(l_reg), __float_as_uint(l_reg), false, false); l_reg = __uint_as_float(rr[0]) + __uint_as_float(rr[1]); }
    if (hi == 0) wsf[32 + r32] = l_reg; asm volatile("s_waitcnt lgkmcnt(0)" ::: "memory");
    float rli[16];
#pragma unroll
    for (int r = 0; r < 16; ++r) rli[r] = __builtin_amdgcn_rcpf(wsf[32 + crow(r, hi)]);
    bf16_t* Ow = Ob + (size_t)(wid * 32) * DM; bf16_t* stg = (bf16_t*)(shm + T_LDS_OST) + wid * 2048;
#pragma unroll
    for (int r = 0; r < 16; ++r) { const int orow = crow(r, hi);
#pragma unroll
        for (int d0 = 0; d0 < 2; ++d0) stg[orow * 64 + d0 * 32 + r32] = (bf16_t)f2bf(o[d0][r] * rli[r]); }
    asm volatile("s_waitcnt lgkmcnt(0)" ::: "memory");
#pragma unroll
    for (int i = 0; i < 4; ++i) { const int row = i * 8 + (lane >> 3), ch = lane & 7; const u32x4 v = *(const u32x4*)(stg + row * 64 + ch * 8); *(u32x4*)(Ow + (size_t)row * DM + ch * 8) = v;
        float q = 0.f;
#pragma unroll
        for (int d = 0; d < 4; ++d) { const float a = bf2f(v[d] & 0xffffu), bq = bf2f(v[d] >> 16); q += a * a + bq * bq; }
        q += dppmov<0xB1, 0xF>(0.f, q); q += dppmov<0x4E, 0xF>(0.f, q); q += dppmov<0x141, 0xF>(0.f, q);
        if (ch == 0) ostat[(size_t)(wid * 32 + row) * 16] = q; }
    asm volatile("s_waitcnt vmcnt(0) lgkmcnt(0)\n\ts_barrier" ::: "memory");
#if CONV_MODE >= 5
#undef WB_P
#undef WB_S
#undef WB_E1
#undef WB_E0
#endif
#undef DMA_K
#undef DMA_V
#undef START
#undef RESC
#undef ROT
}
constexpr int M_KSLOT = 12288, M_LDS_K = 0, M_LDS_V = 3 * M_KSLOT, M_LDS_WS = M_LDS_V + 3 * T_SLOTB, M_LDS_Q = M_LDS_WS + NWAVES * 256, M_LDS_OST = 0  ;
#define WBAR2() do { if (lowv) { WB_PL(); } else { WB_P(); } } while (0)
#define WBARS() do { if (lowv) { WB_SL(); } else { WB_S(); } } while (0)
template <int THRL>
__device__ __forceinline__ void unit96(const bf16_t* Qh, const bf16_t* __restrict__ Kh, const bf16_t* __restrict__ Vh, bf16_t* Ob, float* ostat, int q0, char* shm, ConvState& cs, float kb2) {
    constexpr int DQ = 96;
    int tid_ = threadIdx.x; asm volatile("" : "+v"(tid_));
    const int tid = tid_, lane = tid & 63, r32 = lane & 31, hi = lane >> 5; const int wid = __builtin_amdgcn_readfirstlane(tid >> 6);
    const bf16_t* Qw = Qh + (size_t)(q0 + wid * 32) * DQ;
    const unsigned lds0 = (unsigned)(uintptr_t)shm;
    float* wsf = (float*)(shm + M_LDS_WS) + wid * 64;
#if CONV_MODE >= 5
    const bool rkv = wid < 4, rcl = (wid == 4 || wid == 5), rst = wid >= 6; const int pw = wid & 3;
    const bf16_t* ksrc = Kh + (size_t)lane * DQ + pw * 8;
    const bool lowv = false;
#else
    const bf16_t* ksrc = Kh + (size_t)lane * DQ + wid * 8;
    const bf16_t* ksrc1 = Kh + (size_t)lane * DQ + (8 + (wid & 3)) * 8;
    const bool lowv = wid < 4;
#endif
#if CONV_MODE >= 5
    const bf16_t* vsrc = Vh + (size_t)(16 * pw + (lane >> 2)) * 64 + (lane & 3) * 8;
    const unsigned kdst = lds0 + M_LDS_K + pw * 1024, vdst = lds0 + M_LDS_V + pw * 1024, qdst = lds0 + M_LDS_Q + wid * 6144;
#define DMA_K(t, slot) do { if (rkv) { glds16(ksrc + (size_t)(t) * 64 * DQ, (unsigned)__builtin_amdgcn_readfirstlane(kdst + (slot))); \
        glds16(ksrc + 32 + (size_t)(t) * 64 * DQ, (unsigned)__builtin_amdgcn_readfirstlane(kdst + 4096 + (slot))); \
        glds16(ksrc + 64 + (size_t)(t) * 64 * DQ, (unsigned)__builtin_amdgcn_readfirstlane(kdst + 8192 + (slot))); } } while (0)
#define DMA_V(t, slot) do { if (rkv) { glds16(vsrc + (size_t)(t) * 64 * 64, (unsigned)__builtin_amdgcn_readfirstlane(vdst + (slot))); \
        glds16(vsrc + 32 + (size_t)(t) * 64 * 64, (unsigned)__builtin_amdgcn_readfirstlane(vdst + 4096 + (slot))); } } while (0)
#undef WBAR2
#undef WBARS
#define WBAR2() RWAIT(5)
#define WBARS() RWAIT(5)
#define WB_E1() RWAIT(2)
#define WB_E0() RWAIT(0)
#else
    const bf16_t* vsrc = Vh + (size_t)(16 * (wid & 3) + (lane >> 2)) * 64 + (wid >> 2) * 32 + (lane & 3) * 8;
    const unsigned kdst = lds0 + M_LDS_K + wid * 1024, kdst1 = lds0 + M_LDS_K + (8 + (wid & 3)) * 1024, vdst = lds0 + M_LDS_V + wid * 1024, qdst = lds0 + M_LDS_Q + wid * 6144;
#define DMA_K(t, slot) do { glds16(ksrc + (size_t)(t) * 64 * DQ, (unsigned)__builtin_amdgcn_readfirstlane(kdst + (slot))); \
        if (lowv) glds16(ksrc1 + (size_t)(t) * 64 * DQ, (unsigned)__builtin_amdgcn_readfirstlane(kdst1 + (slot))); } while (0)
#define DMA_V(t, slot) glds16(vsrc + (size_t)(t) * 64 * 64, (unsigned)__builtin_amdgcn_readfirstlane(vdst + (slot)))
#endif
    const int vb0 = (int)(lds0 + M_LDS_V) + ((lane >> 4) & 1) * 32 + (lane & 3) * 8 + (4 * hi + ((lane & 15) >> 2)) * 64;
    bf16x8 kf[12];
    const lds_cptr shm3 = (lds_cptr)shm; const lds_cptr kp0 = shm3 + M_LDS_K + hi * 1024 + r32 * 16; const lds_cptr qp0 = shm3 + M_LDS_Q + wid * 6144 + lane * 16;
    const lds_cptr vp0 = shm3 + M_LDS_V + ((lane >> 4) & 1) * 32 + (lane & 3) * 8 + (4 * hi + ((lane & 15) >> 2)) * 64;
#pragma unroll
    for (int d0 = 0; d0 < 6; ++d0) glds16(Qw + (size_t)r32 * DQ + d0 * 16 + hi * 8, (unsigned)__builtin_amdgcn_readfirstlane(qdst + d0 * 1024));
    DMA_K(0, 0); DMA_V(0, 0); DMA_K(1, M_KSLOT);
#define QF(d0) (*(const __attribute__((address_space(3))) bf16x8*)(qp0 + (d0) * 1024))
    float mhat = 0.f, l_reg = 0.f; f32x16 o[2]; o[0] = f32x16{}; o[1] = f32x16{}; f32x16 negm = f32x16{}; asm volatile("" : "+v"(negm));
    bool resc = false;
#define START(P0, P1) do { resc = false; _Pragma("unroll") for (int r = 0; r < 16; ++r) P0[r] = __builtin_amdgcn_exp2f(P0[r]); } while (0)
#define RESC() do { if (resc) { asm volatile("s_waitcnt lgkmcnt(0)" ::: "memory"); \
      _Pragma("unroll") for (int d_ = 0; d_ < 2; ++d_) _Pragma("unroll") for (int r = 0; r < 16; ++r) o[d_][r] *= wsf[crow(r, hi)]; } } while (0)
    f32x16 pA0, pA1, pB0, pB1;
    int sl_prev = 0, sl_cur = 0, sl_next = M_KSLOT; int vs_prev = 0, vs_cur = 0, vs_next = T_SLOTB;
#define ROT() do { sl_prev = sl_cur; sl_cur = sl_next; sl_next = (sl_next == 2 * M_KSLOT) ? 0 : sl_next + M_KSLOT; vs_prev = vs_cur; vs_cur = vs_next; vs_next = (vs_next == 2 * T_SLOTB) ? 0 : vs_next + T_SLOTB; } while (0)
    DMA_K(2, 2 * M_KSLOT);
    WAIT_BAR(0);
    {
        float qn = 0.f;
#pragma unroll
        for (int d0 = 0; d0 < 6; ++d0) { const bf16x8 qf = QF(d0);
#pragma unroll
            for (int i = 0; i < 8; ++i) { const float x = bf2f((unsigned short)qf[i]); qn += x * x; } }
        auto rr = __builtin_amdgcn_permlane32_swap(__float_as_uint(qn), __float_as_uint(qn), false, false); qn = __uint_as_float(rr[0]) + __uint_as_float(rr[1]);
        mhat = fminf(sqrtf(qn * kb2) * 1.02f + 0.5f, 60.f);
#pragma unroll
        for (int r = 0; r < 16; ++r) negm[r] = -mhat;
        asm volatile("" : "+v"(negm));
    }
    CONV_DRAIN();
    {
        const lds_cptr kb = kp0;
#pragma unroll
        for (int d0 = 0; d0 < 6; ++d0) {
            const bf16x8 b0 = *(const __attribute__((address_space(3))) bf16x8*)(kb + d0 * 2048);
            const bf16x8 b1 = *(const __attribute__((address_space(3))) bf16x8*)(kb + d0 * 2048 + 512);
            const bf16x8 qf = QF(d0);
            if (d0 == 0) { pA0 = MFMA(b0, qf, negm); pA1 = MFMA(b1, qf, negm); }
            else { pA0 = MFMA(b0, qf, pA0); pA1 = MFMA(b1, qf, pA1); } }
    }
    asm volatile("s_nop 15\n\ts_nop 7" : "+v"(pA0), "+v"(pA1));
    START(pA0, pA1);
#pragma unroll
    for (int r = 0; r < 16; ++r) pA1[r] = __builtin_amdgcn_exp2f(pA1[r]);
    WAIT_BAR(0);
    DMA_K(3, 0); DMA_V(1, T_SLOTB); CONV_ISSUE();
    ROT();
#pragma unroll
    for (int j = 0; j < 6; ++j) kload2(kf, kp0 + sl_cur, j);
    WBAR2();
    s16x4 vlo[8], vhi[8]; u32x4 pw0, pw1, pw2, pw3;
#define PKW(P, B) cvtpk_s(P[B], P[B + 1])
#define PAF(k) __builtin_bit_cast(bf16x8, pw##k)
#define VFR(i) (bf16x8){vlo[i][0], vlo[i][1], vlo[i][2], vlo[i][3], vhi[i][0], vhi[i][1], vhi[i][2], vhi[i][3]}
#define PIN(x) asm volatile("" : "+v"(x))
#define GAPA(MF, A0, A1, A2, A3, W0, W1, PW) do { MF; sacc += A0; sacc += A1; sacc += A2; sacc += A3; PIN(sacc); W0; W1; PIN(PW); SBAR(); } while (0)
#define EX(v) __builtin_amdgcn_exp2f(v)
#define GAPB(MF, X, B) do { MF; X[B] = EX(X[B]); X[B + 1] = EX(X[B + 1]); X[B + 2] = EX(X[B + 2]); X[B + 3] = EX(X[B + 3]); PIN(X); SBAR(); } while (0)
#define VRD(i) do { vlo[i] = vtr(vp_ + (((i) >> 2) * 4096 + ((i) & 3) * 1024)); vhi[i] = vtr(vp_ + (((i) >> 2) * 4096 + ((i) & 3) * 1024 + 512)); } while (0)
#define KRD(G, j) do { if (G) { kload2(kf, kp0 + sl_next, j); SBAR(); } } while (0)
#define STEP(C0, C1, P0, P1, t, GK, GV, GL) do { SBAR(); CONV_DRAIN(); SBAR(); \
    const lds_cptr vp_ = vp0 + vs_prev; \
    bf16x8 qa = QF(0), qb = QF(1); \
    VRD(0); SBAR(); float sacc = (P0[0] + P0[1]); \
    GAPA(C0 = MFMA(kf[0], qa, negm), P0[2], P0[3], P0[4], P0[5],     pw0[0] = PKW(P0, 0), pw0[1] = PKW(P0, 2), pw0); \
    VRD(4); SBAR(); GAPA(C1 = MFMA(kf[1], qa, negm), P0[6], P0[7], P0[8], P0[9],     pw0[2] = PKW(P0, 4), pw0[3] = PKW(P0, 6), pw0); \
    qa = QF(2); VRD(1); SBAR(); GAPA(C0 = MFMA(kf[2], qb, C0),   P0[10], P0[11], P0[12], P0[13], pw1[0] = PKW(P0, 8), pw1[1] = PKW(P0, 10), pw1); \
    VRD(5); SBAR(); GAPA(C1 = MFMA(kf[3], qb, C1),   P0[14], P0[15], P1[0], P1[1],   pw1[2] = PKW(P0, 12), pw1[3] = PKW(P0, 14), pw1); \
    qb = QF(3); VRD(2); SBAR(); GAPA(C0 = MFMA(kf[4], qa, C0),   P1[2], P1[3], P1[4], P1[5],     pw2[0] = PKW(P1, 0), pw2[1] = PKW(P1, 2), pw2); \
    VRD(6); SBAR(); GAPA(C1 = MFMA(kf[5], qa, C1),   P1[6], P1[7], P1[8], P1[9],     pw2[2] = PKW(P1, 4), pw2[3] = PKW(P1, 6), pw2); \
    qa = QF(4); VRD(3); SBAR(); GAPA(C0 = MFMA(kf[6], qb, C0),   P1[10], P1[11], P1[12], P1[13], pw3[0] = PKW(P1, 8), pw3[1] = PKW(P1, 10), pw3); \
    VRD(7); SBAR(); GAPA(C1 = MFMA(kf[7], qb, C1),   P1[14], P1[15], 0.f, 0.f,       pw3[2] = PKW(P1, 12), pw3[3] = PKW(P1, 14), pw3); \
    qb = QF(5); SBAR(); C0 = MFMA(kf[8], qa, C0); C1 = MFMA(kf[9], qa, C1); SBAR(); \
    C0 = MFMA(kf[10], qb, C0); C1 = MFMA(kf[11], qb, C1); SBAR(); \
    l_reg += sacc; \
    if (GK) { DMA_K((t) + 3, sl_cur); } if (GV) { DMA_V((t) + 1, vs_next); } CONV_ISSUE(); \
    SBAR(); \
    GAPB(o[0] = MFMA(PAF(0), VFR(0), o[0]), C0, 0); \
    KRD(GL, 0); GAPB(o[1] = MFMA(PAF(0), VFR(4), o[1]), C0, 4); \
    KRD(GL, 1); GAPB(o[0] = MFMA(PAF(1), VFR(1), o[0]), C0, 8); \
    KRD(GL, 2); GAPB(o[1] = MFMA(PAF(1), VFR(5), o[1]), C0, 12); \
    KRD(GL, 3); GAPB(o[0] = MFMA(PAF(2), VFR(2), o[0]), C1, 0); \
    KRD(GL, 4); GAPB(o[1] = MFMA(PAF(2), VFR(6), o[1]), C1, 4); \
    KRD(GL, 5); GAPB(o[0] = MFMA(PAF(3), VFR(3), o[0]), C1, 8); \
    GAPB(o[1] = MFMA(PAF(3), VFR(7), o[1]), C1, 12); \
    } while (0)
    int t = 1;
    for (; t + 5 < NT; t += 2) {
        STEP(pB0, pB1, pA0, pA1, t, true, true, true);     WBARS(); RESC(); ROT();
        STEP(pA0, pA1, pB0, pB1, t + 1, true, true, true); WBARS(); RESC(); ROT();
    }
#define ENDW(tt) do { if ((tt) + 3 < NT) { WBARS(); } else if ((tt) + 2 < NT) { WB_E1(); } else { WB_E0(); } } while (0)
    for (; t + 1 < NT; t += 2) {
        STEP(pB0, pB1, pA0, pA1, t, (t + 3 < NT), (t + 1 < NT), (t + 1 < NT));         ENDW(t);     RESC(); ROT();
        STEP(pA0, pA1, pB0, pB1, t + 1, (t + 4 < NT), (t + 2 < NT), (t + 2 < NT));     ENDW(t + 1); RESC(); ROT();
    }
    STEP(pB0, pB1, pA0, pA1, NT - 1, false, false, false); RESC();
    {
        float sacc = pB0[0] + pB0[1];
#pragma unroll
        for (int r = 2; r < 16; ++r) sacc += pB0[r];
#pragma unroll
        for (int r = 0; r < 16; ++r) sacc += pB1[r];
        l_reg += sacc;
        pw0 = (u32x4){PKW(pB0, 0), PKW(pB0, 2), PKW(pB0, 4), PKW(pB0, 6)}; pw1 = (u32x4){PKW(pB0, 8), PKW(pB0, 10), PKW(pB0, 12), PKW(pB0, 14)};
        pw2 = (u32x4){PKW(pB1, 0), PKW(pB1, 2), PKW(pB1, 4), PKW(pB1, 6)}; pw3 = (u32x4){PKW(pB1, 8), PKW(pB1, 10), PKW(pB1, 12), PKW(pB1, 14)};
        SBAR();
        const lds_cptr vp_ = vp0 + vs_cur;
#pragma unroll
        for (int i = 0; i < 8; ++i) VRD(i);
        o[0] = MFMA(PAF(0), VFR(0), o[0]); o[1] = MFMA(PAF(0), VFR(4), o[1]); o[0] = MFMA(PAF(1), VFR(1), o[0]); o[1] = MFMA(PAF(1), VFR(5), o[1]);
        o[0] = MFMA(PAF(2), VFR(2), o[0]); o[1] = MFMA(PAF(2), VFR(6), o[1]); o[0] = MFMA(PAF(3), VFR(3), o[0]); o[1] = MFMA(PAF(3), VFR(7), o[1]);
    }
#undef PKW
#undef PAF
#undef VFR
#undef PIN
#undef GAPA
#undef GAPB
#undef EX
#undef VRD
#undef KRD
#undef STEP
#undef ENDW
    { auto rr = __builtin_amdgcn_permlane32_swap(__float_as_uint(l_reg), __float_as_uint(l_reg), false, false); l_reg = __uint_as_float(rr[0]) + __uint_as_float(rr[1]); }
    if (hi == 0) wsf[32 + r32] = l_reg; asm volatile("s_waitcnt lgkmcnt(0)" ::: "memory");
    float rli[16];
#pragma unroll
    for (int r = 0; r < 16; ++r) rli[r] = __builtin_amdgcn_rcpf(wsf[32 + crow(r, hi)]);
    bf16_t* Ow = Ob + (size_t)(wid * 32) * DM; bf16_t* stg = (bf16_t*)(shm + M_LDS_OST) + wid * 2048;
#pragma unroll
    for (int r = 0; r < 16; ++r) { const int orow = crow(r, hi);
#pragma unroll
        for (int d0 = 0; d0 < 2; ++d0) stg[orow * 64 + d0 * 32 + r32] = (bf16_t)f2bf(o[d0][r] * rli[r]); }
    asm volatile("s_waitcnt lgkmcnt(0)" ::: "memory");
#pragma unroll
    for (int i = 0; i < 4; ++i) { const int row = i * 8 + (lane >> 3), ch = lane & 7; const u32x4 v = *(const u32x4*)(stg + row * 64 + ch * 8); *(u32x4*)(Ow + (size_t)row * DM + ch * 8) = v;
        float q = 0.f;
#pragma unroll
        for (int d = 0; d < 4; ++d) { const float a = bf2f(v[d] & 0xffffu), bq = bf2f(v[d] >> 16); q += a * a + bq * bq; }
        q += dppmov<0xB1, 0xF>(0.f, q); q += dppmov<0x4E, 0xF>(0.f, q); q += dppmov<0x141, 0xF>(0.f, q);
        if (ch == 0) ostat[(size_t)(wid * 32 + row) * 16] = q; }
    asm volatile("s_waitcnt vmcnt(0) lgkmcnt(0)\n\ts_barrier" ::: "memory");
#if CONV_MODE >= 5
#undef WB_E1
#undef WB_E0
#endif
#undef QF
#undef DMA_K
#undef DMA_V
#undef START
#undef RESC
#undef ROT
}
#undef WBAR2
#undef WBARS
#undef WAIT_BAR
}


namespace pg8 {
typedef short bf16x8 __attribute__((ext_vector_type(8)));
typedef float f32x4 __attribute__((ext_vector_type(4)));
typedef unsigned u32x4 __attribute__((ext_vector_type(4)));
constexpr int BM = 256, BK = 64, HALF = 128, HTB = HALF * BK * 2, STAGE_BYTES = 8 * HTB, NXCD = 8, WGM = 8;
__host__ __device__ __forceinline__ int lds_byte(int r, int c) { const int st = (r >> 4) * 2 + (c >> 5), rr = r & 15, cc = c & 31, ob = rr * 64 + cc * 2; return st * 1024 + (ob ^ (((ob >> 9) & 1) << 5)); }
__host__ __device__ __forceinline__ void stage_rc(int b, int& R, int& C) { const int st = b / 1024, sb = b % 1024, swz = sb ^ (((sb >> 9) & 1) << 5); R = (st >> 1) * 16 + swz / 64; C = (st & 1) * 32 + (swz % 64) / 2; }
__host__ __device__ __forceinline__ int perm32(int rho) { const int n = rho >> 4, i = rho & 15; return 8 * (i >> 2) + 4 * n + (i & 3); }
__device__ __forceinline__ unsigned cvt_pk_bf16(float lo, float hi) { unsigned r; asm volatile("v_cvt_pk_bf16_f32 %0, %1, %2" : "=v"(r) : "v"(lo), "v"(hi)); return r; }

struct Unit { int pm, pn, e, nrows, rowbase; };

struct DenseOrder {
    int nM, nN, nwg, G, c, K; const char* Bt;
    __device__ void init(int M, int N, int K_, const bf16_t* Bt_, int G_, int c_) { nM = M / BM; nN = N / BM; nwg = nM * nN; G = G_; c = c_; K = K_; Bt = (const char*)Bt_; }
    __device__ __forceinline__ bool next(int i, Unit& u) const {
        const long L = (long)i * G + c; if (L >= nwg) return false;
        int wgid = (int)L; { const int q = nwg / NXCD, r = nwg % NXCD, xcd = wgid % NXCD, off = wgid / NXCD; wgid = (xcd < r ? xcd * (q + 1) : r * (q + 1) + (xcd - r) * q) + off; }
        const int nig = WGM * nN, gid = wgid / nig, fm = gid * WGM, gsz = (nM - fm) < WGM ? (nM - fm) : WGM;
        u.pm = fm + ((wgid % nig) % gsz); u.pn = (wgid % nig) / gsz; u.e = 0; u.nrows = 256; u.rowbase = u.pm * BM; return true;
    }
    __device__ __forceinline__ void a_offsets(const Unit&, int, unsigned (&)[2][2]) const {}
    __device__ __forceinline__ const char* b_tile(const Unit& u) const { return Bt + (size_t)u.pn * BM * K * 2; }
};

struct EpiBf16 {
    static constexpr bool PERM = true;
    bf16_t* O; int ldc;
    __device__ __forceinline__ void operator()(const f32x4 (&acc)[2][2][4][2], const Unit& u, int wr, int wc, int fr, int fq) const {
        const int row0 = u.pm * BM + wr * 64 + fr, col0 = u.pn * BM + wc * 32 + 8 * fq;
#pragma unroll
        for (int ai = 0; ai < 2; ++ai)
#pragma unroll
            for (int m = 0; m < 4; ++m) { bf16_t* rowp = O + (size_t)(row0 + ai * HALF + m * 16) * ldc + col0;
#pragma unroll
                for (int bj = 0; bj < 2; ++bj) { const f32x4 v0 = acc[ai][bj][m][0], v1 = acc[ai][bj][m][1];
                    u32x4 w; w.x = cvt_pk_bf16(v0[0], v0[1]); w.y = cvt_pk_bf16(v0[2], v0[3]); w.z = cvt_pk_bf16(v1[0], v1[1]); w.w = cvt_pk_bf16(v1[2], v1[3]);
                    *(u32x4*)(rowp + bj * HALF) = w; } }
    }
};


__device__ __forceinline__ float silu_mul(float g, float u) { return g * __builtin_amdgcn_rcpf(1.f + __expf(-g)) * u; }

struct MoeOrder {
    const LAS int* pre; const LAS int* offs; const LAS int* cntl; const int* list; const char* Bt; size_t bstride; int K, npn, G, c, mode;
    const LAS int* utab;
    static __device__ __forceinline__ int search(const LAS int* pre, int rtg) {
        int lo_ = 0, hi_ = NE;
        while (hi_ - lo_ > 1) { const int mid = (lo_ + hi_) >> 1; if (pre[mid] <= rtg) lo_ = mid; else hi_ = mid; }
        return lo_;
    }
    static __device__ __forceinline__ void fill_table(LAS int* tab, const LAS int* pre, int npn, int G, int c, int t) {
        const int L = t * G + c, total = pre[NE] * npn; int v = -1;
        if (L < total) { const int rtg = L / npn; const int e = search(pre, rtg); v = (e << 16) | (rtg - pre[e]); }
        tab[t] = v;
    }
    __device__ __forceinline__ bool next(int i, Unit& u) const {
        const int L = i * G + c; int e, pm, pn;
        if (i < 16) { const int v = utab[i]; if (v < 0) return false; e = v >> 16; pm = v & 0xffff; pn = L % npn; }
        else { const int total = pre[NE] * npn; if (L >= total) return false;
            const int rtg = L / npn; pn = L - rtg * npn; e = search(pre, rtg); pm = rtg - pre[e]; }
        const int n = cntl[e] - pm * BM;
        u.e = __builtin_amdgcn_readfirstlane(e); u.pm = __builtin_amdgcn_readfirstlane(pm); u.pn = __builtin_amdgcn_readfirstlane(pn);
        u.nrows = __builtin_amdgcn_readfirstlane(n < BM ? n : BM); u.rowbase = __builtin_amdgcn_readfirstlane(offs[e] + pm * BM); return true;
    }
    __device__ __forceinline__ void a_offsets(const Unit& u, int tid, unsigned (&ua)[2][2]) const {
#pragma unroll
        for (int i = 0; i < 2; ++i) { int R, C; stage_rc(tid * 16 + i * 8192, R, C);
#pragma unroll
            for (int h = 0; h < 2; ++h) { int r = h * HALF + R; if (r >= u.nrows) r = 0; const int row = list[(size_t)u.e * LCAP + u.pm * BM + r] >> 3;
                ua[h][i] = (unsigned)((row * K + C) * 2); } }
    }
    __device__ __forceinline__ const char* b_tile(const Unit& u) const { return Bt + (size_t)u.e * bstride + (size_t)u.pn * BM * K * 2; }
};

struct EpiAct {
    static constexpr bool PERM = true;
    bf16_t* ACT;
    __device__ __forceinline__ void operator()(const f32x4 (&acc)[2][2][4][2], const Unit& u, int wr, int wc, int fr, int fq) const {
        const __amdgpu_buffer_rsrc_t rs = __builtin_amdgcn_make_buffer_rsrc((void*)ACT, 0, (NTOK * TOPK + 256) * EFF * 2, 0x00020000);
        const unsigned cb = (unsigned)((u.pn * HALF + wc * 32 + 8 * fq) * 2);
#pragma unroll
        for (int ai = 0; ai < 2; ++ai)
#pragma unroll
            for (int m = 0; m < 4; ++m) { const int r = ai * HALF + wr * 64 + m * 16 + fr;
                const unsigned off = (r < u.nrows) ? (unsigned)(u.rowbase + r) * (EFF * 2) + cb : 0xFFFFFFF0u;
                const f32x4 g0 = acc[ai][0][m][0], g1 = acc[ai][0][m][1], u0 = acc[ai][1][m][0], u1 = acc[ai][1][m][1];
                u32x4 w; w.x = cvt_pk_bf16(silu_mul(g0[0], u0[0]), silu_mul(g0[1], u0[1])); w.y = cvt_pk_bf16(silu_mul(g0[2], u0[2]), silu_mul(g0[3], u0[3]));
                w.z = cvt_pk_bf16(silu_mul(g1[0], u1[0]), silu_mul(g1[1], u1[1])); w.w = cvt_pk_bf16(silu_mul(g1[2], u1[2]), silu_mul(g1[3], u1[3]));
                __builtin_amdgcn_raw_buffer_store_b128(w, rs, off, 0, 0); }
    }
};
struct EpiSlots {
    static constexpr bool PERM = true;
    unsigned char* SL;
    __device__ __forceinline__ void operator()(const f32x4 (&acc)[2][2][4][2], const Unit& u, int wr, int wc, int fr, int fq) const {
        const __amdgpu_buffer_rsrc_t rs = __builtin_amdgcn_make_buffer_rsrc((void*)SL, 0, NTOK * TOPK * DM, 0x00020000);
        const unsigned cb = (unsigned)(u.pn * BM + wc * 32 + 8 * fq);
#pragma unroll
        for (int ai = 0; ai < 2; ++ai)
#pragma unroll
            for (int m = 0; m < 4; ++m) { const int r = ai * HALF + wr * 64 + m * 16 + fr;
                const unsigned off = (r < u.nrows) ? (unsigned)(u.rowbase + r) * DM + cb : 0xFFFFFFF0u;
#pragma unroll
                for (int bj = 0; bj < 2; ++bj) { const f32x4 v0 = acc[ai][bj][m][0] * 16.f, v1 = acc[ai][bj][m][1] * 16.f;
                    int lo = __builtin_amdgcn_cvt_pk_fp8_f32(v0[0], v0[1], 0, false); lo = __builtin_amdgcn_cvt_pk_fp8_f32(v0[2], v0[3], lo, true);
                    int hi = __builtin_amdgcn_cvt_pk_fp8_f32(v1[0], v1[1], 0, false); hi = __builtin_amdgcn_cvt_pk_fp8_f32(v1[2], v1[3], hi, true);
                    typedef unsigned u32x2 __attribute__((ext_vector_type(2)));
                    __builtin_amdgcn_raw_buffer_store_b64((u32x2){(unsigned)lo, (unsigned)hi}, rs, off, bj * HALF, 0); } }
    }
};
struct EpiRS {
    static constexpr bool PERM = true;
    float* LOG; bf16_t* ACTS;
    __device__ __forceinline__ void operator()(const f32x4 (&acc)[2][2][4][2], const Unit& u, int wr, int wc, int fr, int fq) const {
        const int row0 = u.pm * BM + wr * 64 + fr;
#pragma unroll
        for (int ai = 0; ai < 2; ++ai)
#pragma unroll
            for (int m = 0; m < 4; ++m) { const int row = row0 + ai * HALF + m * 16;
                if (u.pn == 0) {
#pragma unroll
                    for (int bj = 0; bj < 2; ++bj) { float* lp = LOG + (size_t)row * NE + bj * HALF + wc * 32 + 8 * fq; *(f32x4*)lp = acc[ai][bj][m][0]; *(f32x4*)(lp + 4) = acc[ai][bj][m][1]; }
                } else {
                    const f32x4 g0 = acc[ai][0][m][0], g1 = acc[ai][0][m][1], u0 = acc[ai][1][m][0], u1 = acc[ai][1][m][1];
                    u32x4 w; w.x = cvt_pk_bf16(silu_mul(g0[0], u0[0]), silu_mul(g0[1], u0[1])); w.y = cvt_pk_bf16(silu_mul(g0[2], u0[2]), silu_mul(g0[3], u0[3]));
                    w.z = cvt_pk_bf16(silu_mul(g1[0], u1[0]), silu_mul(g1[1], u1[1])); w.w = cvt_pk_bf16(silu_mul(g1[2], u1[2]), silu_mul(g1[3], u1[3]));
                    *(u32x4*)(ACTS + (size_t)row * EFF + (u.pn - 1) * HALF + wc * 32 + 8 * fq) = w; } }
    }
};

struct EpiBf16RowScale {
    static constexpr bool PERM = true;
    bf16_t* O; int ldc; const LAS float* rtab;
    __device__ __forceinline__ void operator()(const f32x4 (&acc)[2][2][4][2], const Unit& u, int wr, int wc, int fr, int fq) const {
        const int row0 = u.pm * BM + wr * 64 + fr, col0 = u.pn * BM + wc * 32 + 8 * fq;
#pragma unroll
        for (int ai = 0; ai < 2; ++ai)
#pragma unroll
            for (int m = 0; m < 4; ++m) { const int row = row0 + ai * HALF + m * 16; bf16_t* rowp = O + (size_t)row * ldc + col0;
                const float g = rtab[2 * (row - u.pm * BM) + 1];
#pragma unroll
                for (int bj = 0; bj < 2; ++bj) { const f32x4 v0 = acc[ai][bj][m][0] * g, v1 = acc[ai][bj][m][1] * g;
                    u32x4 w; w.x = cvt_pk_bf16(v0[0], v0[1]); w.y = cvt_pk_bf16(v0[2], v0[3]); w.z = cvt_pk_bf16(v1[0], v1[1]); w.w = cvt_pk_bf16(v1[2], v1[3]);
                    *(u32x4*)(rowp + bj * HALF) = w; } }
    }
};

template <class Epi, class Sched, bool ALIGN_EPI, bool GATHER = false, bool MIDSCALE = false>
__device__ __forceinline__ void gemm_phase(LAS unsigned char* lds, const bf16_t* Abase_, int K, const Sched& S, const Epi& E, const float* stat = nullptr) {
    int tid_ = threadIdx.x; asm volatile("" : "+v"(tid_));
    const int tid = tid_, wid = __builtin_amdgcn_readfirstlane(tid >> 6), lane = tid & 63, wr = wid >> 2, wc = wid & 3, fr = lane & 15, fq = lane >> 4;
    const int nt = K / BK;
    const char* Abase = (const char*)Abase_;
    unsigned voffB[2], voffA[2];
#pragma unroll
    for (int i = 0; i < 2; ++i) { int R, C; stage_rc(tid * 16 + i * 8192, R, C); const int Rb = Epi::PERM ? ((R & ~31) + perm32(R & 31)) : R; voffB[i] = (unsigned)(Rb * K + C) * 2u; voffA[i] = (unsigned)(R * K + C) * 2u; }
    const size_t kstep = (size_t)(BK * 2);
    const size_t hstep = (size_t)HALF * K * 2;
    const unsigned ldsw = (unsigned)wid * 1024u;
    const int aoff = lds_byte(wr * 64 + fr, fq * 8), boff = lds_byte(wc * 32 + fr, fq * 8);
#define PG8_SA(b, h) (((b) * 2 + (h)) * HTB)
#define PG8_SB(b, h) ((4 + (b) * 2 + (h)) * HTB)
#define PG8_STAGE_B(bufoff, gbase) do { _Pragma("unroll") for (int _i = 0; _i < 2; ++_i) \
        __builtin_amdgcn_global_load_lds((const unsigned*)((const char*)(gbase) + voffB[_i]), (LAS unsigned*)(lds + (bufoff) + ldsw + _i * 8192), 16, 0, 0); } while (0)
#define PG8_STAGE_A(bufoff, ua, pa, h, koff) do { _Pragma("unroll") for (int _i = 0; _i < 2; ++_i) { \
        const char* _g = GATHER ? (Abase + (size_t)(ua)[h][_i] + (koff)) : ((pa) + (size_t)(h) * hstep + voffA[_i] + (koff)); \
        __builtin_amdgcn_global_load_lds((const unsigned*)_g, (LAS unsigned*)(lds + (bufoff) + ldsw + _i * 8192), 16, 0, 0); } } while (0)
#define PG8_LDA(dst, b, h) do { _Pragma("unroll") for (int m = 0; m < 4; ++m) _Pragma("unroll") for (int k = 0; k < 2; ++k) dst[m][k] = *(const LAS bf16x8*)(lds + PG8_SA(b, h) + aoff + m * 2048 + k * 1024); } while (0)
#define PG8_LDB(dst, b, h) do { _Pragma("unroll") for (int n = 0; n < 2; ++n) _Pragma("unroll") for (int k = 0; k < 2; ++k) dst[n][k] = *(const LAS bf16x8*)(lds + PG8_SB(b, h) + boff + n * 2048 + k * 1024); } while (0)
#define PG8_MMA(ai, bj, At, Bt) do { __builtin_amdgcn_s_setprio(1); _Pragma("unroll") for (int m = 0; m < 4; ++m) _Pragma("unroll") for (int n = 0; n < 2; ++n) _Pragma("unroll") for (int k = 0; k < 2; ++k) \
        acc[ai][bj][m][n] = __builtin_amdgcn_mfma_f32_16x16x32_bf16(Bt[n][k], At[m][k], acc[ai][bj][m][n], 0, 0, 0); __builtin_amdgcn_s_setprio(0); } while (0)
#define PG8_WAIT_V(n) asm volatile("s_waitcnt vmcnt(" #n ")" ::: "memory")
#define PG8_WAIT_L(n) asm volatile("s_waitcnt lgkmcnt(" #n ")" ::: "memory")
#define PG8_BAR __builtin_amdgcn_s_barrier()
#define PG8_SCHED __builtin_amdgcn_sched_barrier(0)
    Unit cur, nxt; int ui = 0;
    if (!S.next(0, cur)) return;
    f32x4 acc[2][2][4][2];
#pragma unroll
    for (int a = 0; a < 2; ++a)
#pragma unroll
        for (int b = 0; b < 2; ++b)
#pragma unroll
            for (int m = 0; m < 4; ++m)
#pragma unroll
                for (int n = 0; n < 2; ++n) acc[a][b][m][n] = (f32x4){0.f, 0.f, 0.f, 0.f};
    bf16x8 At[4][2], B0[2][2], B1[2][2];
    unsigned uc[2][2], un[2][2];
    if constexpr (GATHER) S.a_offsets(cur, tid, uc);
    const char* cA = Abase + (size_t)cur.rowbase * K * 2;
    const char* cB = S.b_tile(cur);
    PG8_STAGE_B(PG8_SB(0, 0), cB); PG8_STAGE_B(PG8_SB(0, 1), cB + hstep); PG8_STAGE_A(PG8_SA(0, 0), uc, cA, 0, (size_t)0); PG8_STAGE_A(PG8_SA(0, 1), uc, cA, 1, (size_t)0);
    if (wr == 1) PG8_BAR;
    PG8_WAIT_V(2); PG8_BAR;
    PG8_STAGE_B(PG8_SB(1, 0), cB + kstep); PG8_STAGE_A(PG8_SA(1, 0), uc, cA, 0, kstep); PG8_STAGE_B(PG8_SB(1, 1), cB + hstep + kstep);
    PG8_WAIT_V(6); PG8_BAR;
    for (;;) {
        const bool has_next = S.next(ui + 1, nxt);
        const bool lower = cur.nrows > wr * 64, upper = cur.nrows > HALF + wr * 64;
        const char* nB = cB; const char* nA = cA;
        if (has_next) { if constexpr (GATHER) S.a_offsets(nxt, tid, un); nB = S.b_tile(nxt); nA = Abase + (size_t)nxt.rowbase * K * 2; }
        else if constexpr (GATHER) {
#pragma unroll
            for (int h = 0; h < 2; ++h)
#pragma unroll
                for (int i = 0; i < 2; ++i) un[h][i] = uc[h][i];
        }
#pragma unroll 1
        for (int t = 0; t < nt; t += 2) {
            const bool last = (t == nt - 2);
            const size_t k1 = (size_t)(t + 1) * kstep;
            const size_t k2 = last ? (size_t)0 : (size_t)(t + 2) * kstep, k3 = k2 + kstep;
            const char* b2 = last ? nB : cB + (size_t)(t + 2) * kstep; const char* b3 = b2 + kstep;
            const char* a2 = last ? nA : cA;
            unsigned x2[2][2];
            if constexpr (GATHER) {
#pragma unroll
                for (int h = 0; h < 2; ++h)
#pragma unroll
                    for (int i = 0; i < 2; ++i) x2[h][i] = uc[h][i];
                if (last) { asm volatile("; next unit's A offsets" ::: "memory");
#pragma unroll
                    for (int h = 0; h < 2; ++h)
#pragma unroll
                        for (int i = 0; i < 2; ++i) x2[h][i] = un[h][i]; }
            }
            if constexpr (MIDSCALE) { if (t == nt / 2) {
#pragma unroll
                for (int ai = 0; ai < 2; ++ai)
#pragma unroll
                    for (int m = 0; m < 4; ++m) { const float f = ((const LAS float*)(lds + STAGE_BYTES))[2 * (ai * HALF + wr * 64 + m * 16 + fr)];
#pragma unroll
                        for (int bj = 0; bj < 2; ++bj)
#pragma unroll
                            for (int n = 0; n < 2; ++n) acc[ai][bj][m][n] *= f; } } }
            PG8_LDB(B0, 0, 0); PG8_LDB(B1, 0, 1); PG8_SCHED; PG8_LDA(At, 0, 0); PG8_STAGE_A(PG8_SA(1, 1), uc, cA, 1, k1);
            PG8_WAIT_V(8); PG8_WAIT_L(0); PG8_BAR; if (lower) { PG8_MMA(0, 0, At, B0); PG8_MMA(0, 1, At, B1); } PG8_BAR; PG8_SCHED;
            PG8_LDA(At, 0, 1); PG8_STAGE_B(PG8_SB(0, 0), b2); PG8_STAGE_B(PG8_SB(0, 1), b2 + hstep); PG8_STAGE_A(PG8_SA(0, 0), x2, a2, 0, k2);
            PG8_WAIT_V(8); PG8_WAIT_L(0); PG8_BAR; if (upper) { PG8_MMA(1, 0, At, B0); PG8_MMA(1, 1, At, B1); } PG8_BAR; PG8_SCHED;
            PG8_LDB(B0, 1, 0); PG8_LDB(B1, 1, 1); PG8_SCHED; PG8_LDA(At, 1, 0); PG8_STAGE_A(PG8_SA(0, 1), x2, a2, 1, k2);
            PG8_WAIT_V(8); PG8_WAIT_L(0); PG8_BAR; if (lower) { PG8_MMA(0, 0, At, B0); PG8_MMA(0, 1, At, B1); } PG8_BAR; PG8_SCHED;
            PG8_LDA(At, 1, 1); PG8_STAGE_B(PG8_SB(1, 0), b3); PG8_STAGE_B(PG8_SB(1, 1), b3 + hstep); PG8_STAGE_A(PG8_SA(1, 0), x2, a2, 0, k3);
            PG8_WAIT_V(8); PG8_WAIT_L(0); PG8_BAR; if (upper) { PG8_MMA(1, 0, At, B0); PG8_MMA(1, 1, At, B1); } PG8_BAR; PG8_SCHED;
        }
        if constexpr (ALIGN_EPI) { if (wr == 0) PG8_BAR; }
        E(acc, cur, wr, wc, fr, fq);
        if (!has_next) break;
#pragma unroll
        for (int a = 0; a < 2; ++a)
#pragma unroll
            for (int b = 0; b < 2; ++b)
#pragma unroll
                for (int m = 0; m < 4; ++m)
#pragma unroll
                    for (int n = 0; n < 2; ++n) acc[a][b][m][n] = (f32x4){0.f, 0.f, 0.f, 0.f};
        cur = nxt; cB = nB; cA = nA; ++ui;
        if constexpr (GATHER) {
#pragma unroll
            for (int h = 0; h < 2; ++h)
#pragma unroll
                for (int i = 0; i < 2; ++i) uc[h][i] = un[h][i];
        }
        if constexpr (ALIGN_EPI) { if (wr == 1) PG8_BAR; }
    }
    PG8_WAIT_V(0);
    if constexpr (!ALIGN_EPI) { if (wr == 0) PG8_BAR; }
    PG8_BAR;
#undef PG8_SA
#undef PG8_SB
#undef PG8_STAGE_A
#undef PG8_STAGE_B
#undef PG8_LDA
#undef PG8_LDB
#undef PG8_MMA
#undef PG8_WAIT_V
#undef PG8_WAIT_L
#undef PG8_BAR
#undef PG8_SCHED
}
}

__device__ __forceinline__ void cvt_item(const float* W, int ldw, int col0, int k0, bf16_t* WT, int drow0, int Kd, const float* gk, LAS float* scr, int lane) {
    const int kr = lane >> 3, n4 = lane & 7;
    float4 v[8];
#pragma unroll
    for (int i = 0; i < 8; ++i) v[i] = *(const float4*)&W[(size_t)(k0 + 8 * i + kr) * ldw + col0 + 4 * n4];
#pragma unroll
    for (int i = 0; i < 8; ++i) { const int kk = 8 * i + kr; const float g = gk ? gk[k0 + kk] : 1.f; LAS float* d = scr + kk * 33 + 4 * n4;
        d[0] = v[i].x * g; d[1] = v[i].y * g; d[2] = v[i].z * g; d[3] = v[i].w * g; }
    asm volatile("s_waitcnt lgkmcnt(0)" ::: "memory");
    const int cch = lane & 7;
#pragma unroll
    for (int j = 0; j < 4; ++j) { const int n = (lane >> 3) + 8 * j; const LAS float* sp = scr + (8 * cch) * 33 + n;
        uint4 o; o.x = pk2(sp[0 * 33], sp[1 * 33]); o.y = pk2(sp[2 * 33], sp[3 * 33]); o.z = pk2(sp[4 * 33], sp[5 * 33]); o.w = pk2(sp[6 * 33], sp[7 * 33]);
        *(uint4*)(WT + (size_t)(drow0 + n) * Kd + k0 + 8 * cch) = o; }
    asm volatile("s_waitcnt lgkmcnt(0)" ::: "memory");
}
#define PHASE_PTRS \
    unsigned char* wsp = args.ws; asm volatile("" : "+s"(wsp)); \
    const float* x = args.in[0]; const float* cvec = args.in[1]; const float* w_ada = args.in[2]; const float* b_ada = args.in[3]; \
    const float* g_pre_mix = args.in[4]; const float* g_post_mix = args.in[5]; const float* g_pre_ffn = args.in[6]; const float* g_post_ffn = args.in[7]; \
    const float* w_in = args.in[8]; const float* g_q_a = args.in[9]; const float* w_q_b = args.in[10]; const float* g_kv_a = args.in[11]; const float* w_kv_b = args.in[12]; \
    const float* g_q_head = args.in[13]; const float* g_k_head = args.in[14]; const float* g_mla_out = args.in[15]; const float* g_gqa_out = args.in[16]; \
    const float* w_out = args.in[17]; const float* w_router = args.in[18]; const float* b_router = args.in[19]; \
    const float* w_gate_e = args.in[20]; const float* w_up_e = args.in[21]; const float* w_down_e = args.in[22]; \
    const float* w_gate_s = args.in[23]; const float* w_up_s = args.in[24]; const float* w_down_s = args.in[25]; \
    float* mod = (float*)(wsp + WS_MOD); \
    float* cosm = (float*)(wsp + WS_COSM); float* sinm = (float*)(wsp + WS_SINM); float* cosg = (float*)(wsp + WS_COSG); float* sing = (float*)(wsp + WS_SING); \
    bf16_t* H2 = (bf16_t*)(wsp + WS_H2); \
    bf16_t* QM = (bf16_t*)(wsp + WS_QM); bf16_t* KM = (bf16_t*)(wsp + WS_KM); bf16_t* VM = (bf16_t*)(wsp + WS_VM); \
    bf16_t* QG = (bf16_t*)(wsp + WS_QG); bf16_t* KG = (bf16_t*)(wsp + WS_KG); bf16_t* VG = (bf16_t*)(wsp + WS_VG); \
    bf16_t* O = (bf16_t*)(wsp + WS_O); \
    bf16_t* X1 = (bf16_t*)(wsp + WS_X1); float* WTS = (float*)(wsp + WS_WTS); int* LIST = (int*)(wsp + WS_LIST); \
    bf16_t* SLOTS = (bf16_t*)(wsp + WS_SLOTS); int* POSREC = (int*)(wsp + WS_POSREC); float* OSTAT = (float*)(wsp + WS_OSTAT); \
    bf16_t* PBUF = (bf16_t*)(wsp + WS_PBUF); bf16_t* WBIGT = (bf16_t*)(wsp + WS_WBIGT); \
    bf16_t* WQBT = (bf16_t*)(wsp + WS_WQBT); bf16_t* WINQ = (bf16_t*)(wsp + WS_WINQ); bf16_t* WKVBT = (bf16_t*)(wsp + WS_WKVBT); bf16_t* WINKV = (bf16_t*)(wsp + WS_WINKV); \
    bf16_t* WOUTT = (bf16_t*)(wsp + WS_WOUTT); bf16_t* WRST = (bf16_t*)(wsp + WS_WRST); bf16_t* WDST = (bf16_t*)(wsp + WS_WDST); \
    bf16_t* WGUT = (bf16_t*)(wsp + WS_WGUT); bf16_t* WDT = (bf16_t*)(wsp + WS_WDT); \
    bf16_t* MIXED = (bf16_t*)(wsp + WS_MIXED); float* LOG = (float*)(wsp + WS_LOG); bf16_t* ACT = (bf16_t*)(wsp + WS_ACT); bf16_t* ACTS = (bf16_t*)(wsp + WS_ACTS); bf16_t* YSH = (bf16_t*)(wsp + WS_YSH);

__global__ void __launch_bounds__(NTHR, 2) mega(Args args) {
    extern __shared__ __attribute__((aligned(16))) unsigned char lds_raw[];
    unsigned char* ws = args.ws;
    unsigned* ctl = (unsigned*)(ws + WS_CTL);
    volatile LAS unsigned* bst = (volatile LAS unsigned*)(lds_raw + LDS_BYTES - 16);
    if (threadIdx.x < 4) bst[threadIdx.x] = 0u;
    const int nbk = gridDim.x, bidk = blockIdx.x;
    __syncthreads();
    XcdBarrier bar; bar.bar = ctl + CW_BAR; bar.x = 0; bar.st = bst;
    if (MK_N_LAUNCHES == 1) bar = xcd_barrier_post(ctl + CW_BAR, bst);
    const int lo = args.ph_lo, hi = args.ph_hi;
    const int vcu = (nbk % 8 == 0) ? (bidk % 8) * (nbk / 8) + bidk / 8 : bidk;
    LAS unsigned char* ldsb = (LAS unsigned char*)lds_raw;
#define IN(k) (lo <= (k) && (k) < hi && (pass_ == 0 || ((k) >= REP_FROM && (k) != 8)))
#define SEAM(k) do { if (lo <= (k) && (k) + 1 < hi && (pass_ == 0 || (k) >= REP_FROM)) xcd_barrier(bar); } while (0)

    unsigned* CNT = (unsigned*)(ws + WS_CNTS);

    for (int pass_ = 0; pass_ < (REP_FROM < 12 ? 2 : 1); ++pass_) {
    if (pass_) xcd_barrier(bar);
    if (IN(0)) for (int rep_ = 0; rep_ < (((REPEAT_MASK >> 0) & 1) ? 2 : 1); ++rep_) {
        const Ctx c = mkctx(ws, lds_raw); PHASE_PTRS
        float* red = c.lds;
        if (c.tid == 0) for (int e = c.bid; e < NE; e += c.nb) CNT[(size_t)e * CNT_STRIDE] = 0u;
        for (int g = c.bid; g < 192; g += c.nb) {
            const int c4 = c.tid & 7, kr = c.tid >> 3;
            float4 w[16];
#pragma unroll
            for (int i = 0; i < 16; ++i) w[i] = *(const float4*)&w_ada[(size_t)(64 * i + kr) * 6144 + g * 32 + 4 * c4];
            float4 a0 = make_float4(0.f, 0.f, 0.f, 0.f), a1 = a0;
#pragma unroll
            for (int i = 0; i < 16; ++i) { const int k = 64 * i + kr; const float c0 = cvec[k], c1 = cvec[DM + k]; const float f0 = c0 * sigmoidf_(c0), f1 = c1 * sigmoidf_(c1);
                a0.x += f0 * w[i].x; a0.y += f0 * w[i].y; a0.z += f0 * w[i].z; a0.w += f0 * w[i].w; a1.x += f1 * w[i].x; a1.y += f1 * w[i].y; a1.z += f1 * w[i].z; a1.w += f1 * w[i].w; }
            __syncthreads();
            *(float4*)&red[(kr * 8 + c4) * 4] = a0; *(float4*)&red[2048 + (kr * 8 + c4) * 4] = a1;
            __syncthreads();
            if (c.tid < 64) { const int b = c.tid >> 5, cc = c.tid & 31; float sacc = 0.f; for (int j = 0; j < 64; ++j) sacc += red[b * 2048 + j * 32 + cc]; mod[b * 6144 + g * 32 + cc] = sacc + b_ada[g * 32 + cc]; }
        }
        __syncthreads();
        for (int idx = c.bid * NTHR + c.tid; idx < SEQ * 16; idx += c.nb * NTHR) {
            const int s = idx >> 4, i = idx & 15, f = i & 7;
            const float inv = powf(10000.f, -(float)f / 8.f);
            const float pos = (float)((i < 8) ? (s >> 6) : (s & 63));
            const float ang = pos * inv;
            cosm[idx] = cosf(ang); sinm[idx] = sinf(ang);
        }
        for (int idx = c.bid * NTHR + c.tid; idx < SEQ * 32; idx += c.nb * NTHR) {
            const int s = idx >> 5, i = idx & 31, f = i & 15;
            const float inv = powf(10000.f, -(float)f / 16.f);
            const float pos = (float)((i < 16) ? (s >> 6) : (s & 63));
            const float ang = pos * inv;
            cosg[idx] = cosf(ang); sing[idx] = sinf(ang);
        }
        LAS float* scr = (LAS float*)(ldsb + 8192 + c.wave * 8448);
        constexpr int I_BIG = 37 * 16;
        constexpr int I_QB = 24 * 4;
        constexpr int I_KVB = 32 * 2;
        constexpr int I_OUT = 32 * 16;
        constexpr int I_RS = 24 * 16;
        constexpr int I_DS = 32 * 4;
        const int I_EXP = (c.nb == NE && (CONV_MODE == 1 || CONV_MODE == 5)) ? 0 : NE * 384;
        const int I_TOT = I_BIG + I_QB + I_KVB + I_OUT + I_RS + I_DS + I_EXP;
        for (int it = c.gw; it < I_TOT; it += c.ngw) {
            int r = it;
            if (r < I_BIG) { const int grp = r >> 4, kb = r & 15; const int col0 = grp * 32, drow = (grp < 13) ? grp * 32 : 2304 + (grp - 13) * 32;
                cvt_item(w_in, INC, col0, kb * 64, WBIGT, drow, DM, nullptr, scr, c.lane); continue; }
            r -= I_BIG;
            if (r < I_QB) { const int grp = r >> 2, kb = r & 3; cvt_item(w_q_b, 768, grp * 32, kb * 64, WQBT, grp * 32, 256, g_q_a, scr, c.lane); continue; }
            r -= I_QB;
            if (r < I_KVB) { const int grp = r >> 1, kb = r & 1; cvt_item(w_kv_b, 1024, grp * 32, kb * 64, WKVBT, grp * 32, 256, g_kv_a, scr, c.lane); continue; }
            r -= I_KVB;
            if (r < I_OUT) { const int grp = r >> 4, kb = r & 15; cvt_item(w_out, DM, grp * 32, kb * 64, WOUTT, grp * 32, DM, (kb < 8) ? g_mla_out : (g_gqa_out - 512), scr, c.lane); continue; }
            r -= I_OUT;
            if (r < I_RS) { const int grp = r >> 4, kb = r & 15;
                if (grp < 8) cvt_item(w_router, NE, grp * 32, kb * 64, WRST, grp * 32, DM, nullptr, scr, c.lane);
                else { const int q = grp - 8, blk = q >> 2, sub = q & 3;
                    cvt_item((blk & 1) ? w_up_s : w_gate_s, EFF, (blk >> 1) * 128 + sub * 32, kb * 64, WRST, 256 + blk * 128 + sub * 32, DM, nullptr, scr, c.lane); }
                continue; }
            r -= I_RS;
            if (r < I_DS) { const int grp = r >> 2, kb = r & 3; cvt_item(w_down_s, DM, grp * 32, kb * 64, WDST, grp * 32, EFF, nullptr, scr, c.lane); continue; }
            r -= I_DS;
            { const int e = r / 384, q = r % 384;
              if (q < 256) { const int up = q >> 7, q2 = q & 127, grp = q2 >> 4, kb = q2 & 15;
                  const int drow = ((grp < 4) ? grp * 32 : 256 + (grp - 4) * 32) + up * 128;
                  cvt_item((up ? w_up_e : w_gate_e) + (size_t)e * DM * EFF, EFF, grp * 32, kb * 64, WGUT + (size_t)e * 512 * DM, drow, DM, nullptr, scr, c.lane); }
              else { const int q2 = q - 256, grp = q2 >> 2, kb = q2 & 3;
                  cvt_item(w_down_e + (size_t)e * EFF * DM, DM, grp * 32, kb * 64, WDT + (size_t)e * DM * EFF, grp * 32, EFF, nullptr, scr, c.lane); } }
        }
        const int gt = c.bid * NTHR + c.tid, ngt = c.nb * NTHR;
        for (int i = gt; i < 96 * 1024 / 8; i += ngt) *(uint4*)(WBIGT + (size_t)416 * DM + (size_t)i * 8) = make_uint4(0u, 0u, 0u, 0u);
        for (int i = gt; i < 1024 * 16; i += ngt) { const int n = i >> 4, q = i & 15; *(uint4*)(WKVBT + (size_t)n * 256 + 128 + q * 8) = make_uint4(0u, 0u, 0u, 0u); }
        for (int i = gt; i < 1024 * 64; i += ngt) { const int k = i >> 6, q = i & 63; const float4 v = *(const float4*)&w_in[(size_t)k * INC + q * 4]; uint2 o; o.x = pk2(v.x, v.y); o.y = pk2(v.z, v.w); *(uint2*)(WINQ + (size_t)k * 256 + q * 4) = o; }
        for (int i = gt; i < 1024 * 64; i += ngt) { const int k = i >> 6, q = i & 63; uint2 o = make_uint2(0u, 0u);
            if (q < 32) { const float4 v = *(const float4*)&w_in[(size_t)k * INC + 256 + q * 4]; o.x = pk2(v.x, v.y); o.y = pk2(v.z, v.w); }
            *(uint2*)(WINKV + (size_t)k * 256 + q * 4) = o; }
    }
    SEAM(0);

    if (IN(1)) for (int rep_ = 0; rep_ < (((REPEAT_MASK >> 1) & 1) ? 2 : 1); ++rep_) {
        const Ctx c = mkctx(ws, lds_raw); PHASE_PTRS
        for (int i = c.bid * NTHR + c.tid; i < 2 * 4 * DM; i += c.nb * NTHR) { const int b = i >> 12, k = (i >> 10) & 3, cc = i & 1023; const float* md = mod + b * 6144;
            ((float*)(wsp + WS_COEF))[i] = (k == 0) ? md[2048 + cc] * g_post_mix[cc] : (k == 1) ? g_pre_ffn[cc] * (1.f + md[4096 + cc]) : (k == 2) ? md[3072 + cc] : md[5120 + cc] * g_post_ffn[cc]; }
        { pg8::DenseOrder S; S.init(768, 1024, 256, WINQ, c.nb, c.bid); pg8::EpiBf16 E{WBIGT + (size_t)512 * DM, DM};
          pg8::gemm_phase<pg8::EpiBf16, pg8::DenseOrder, true>(ldsb, WQBT, 256, S, E); }
        { pg8::DenseOrder S; S.init(1024, 1024, 256, WINKV, c.nb, (c.bid >= 12 && c.nb >= 28) ? c.bid - 12 : c.bid + (c.nb >= 28 ? c.nb : 0)); pg8::EpiBf16 E{WBIGT + (size_t)1280 * DM, DM};
          pg8::gemm_phase<pg8::EpiBf16, pg8::DenseOrder, true>(ldsb, WKVBT, 256, S, E); }
        const bool hsplit = c.nb >= 56; const int hw = hsplit ? c.gw - 28 * 8 : c.gw, nhw = hsplit ? c.ngw - 28 * 8 : c.ngw;
        if (hw >= 0) {
            float4 nv[2][4];
#pragma unroll
            for (int q = 0; q < 2; ++q) { const int m = (hw + q * nhw < NTOK) ? hw + q * nhw : hw;
#pragma unroll
                for (int j = 0; j < 4; ++j) nv[q][j] = *(const float4*)&x[(size_t)m * DM + 4 * c.lane + 256 * j]; }
            for (int m0 = hw; m0 < NTOK; m0 += 2 * nhw) {
                float4 v[2][4];
#pragma unroll
                for (int q = 0; q < 2; ++q)
#pragma unroll
                    for (int j = 0; j < 4; ++j) v[q][j] = nv[q][j];
                const int m0n = m0 + 2 * nhw;
                if (m0n < NTOK) {
#pragma unroll
                    for (int q = 0; q < 2; ++q) { const int m = (m0n + q * nhw < NTOK) ? m0n + q * nhw : m0n;
#pragma unroll
                        for (int j = 0; j < 4; ++j) nv[q][j] = *(const float4*)&x[(size_t)m * DM + 4 * c.lane + 256 * j]; }
                }
#pragma unroll
                for (int q = 0; q < 2; ++q) {
                    const int m = (m0 + q * nhw < NTOK) ? m0 + q * nhw : m0; const int b = m / SEQ; const float* md = mod + b * 6144;
                    float4 g[4], sc[4], sh[4];
#pragma unroll
                    for (int j = 0; j < 4; ++j) { const int cc = 4 * c.lane + 256 * j; g[j] = *(const float4*)&g_pre_mix[cc]; sc[j] = *(const float4*)&md[1024 + cc]; sh[j] = *(const float4*)&md[cc]; }
                    float ss = 0.f;
#pragma unroll
                    for (int j = 0; j < 4; ++j) ss += v[q][j].x * v[q][j].x + v[q][j].y * v[q][j].y + v[q][j].z * v[q][j].z + v[q][j].w * v[q][j].w;
                    const float rstd = rsqrtf(wave_sum(ss) * (1.f / DM) + EPS);
#pragma unroll
                    for (int j = 0; j < 4; ++j) {
                        const int cc = 4 * c.lane + 256 * j;
                        uint2 o;
                        o.x = pk2(v[q][j].x * rstd * g[j].x * (1.f + sc[j].x) + sh[j].x, v[q][j].y * rstd * g[j].y * (1.f + sc[j].y) + sh[j].y);
                        o.y = pk2(v[q][j].z * rstd * g[j].z * (1.f + sc[j].z) + sh[j].z, v[q][j].w * rstd * g[j].w * (1.f + sc[j].w) + sh[j].w);
                        *(uint2*)&H2[(size_t)m * DM + cc] = o;
                    }
                }
            }
        }
    }
    SEAM(1);

    if (IN(2)) for (int rep_ = 0; rep_ < (((REPEAT_MASK >> 2) & 1) ? 2 : 1); ++rep_) {
        const Ctx c = mkctx(ws, lds_raw); PHASE_PTRS
        pg8::DenseOrder S; S.init(NTOK, 3072, DM, WBIGT, c.nb, c.bid); pg8::EpiBf16 E{PBUF, 3072};
        pg8::gemm_phase<pg8::EpiBf16, pg8::DenseOrder, true>(ldsb, H2, DM, S, E);
    }
    SEAM(2);

    if (IN(3)) for (int rep_ = 0; rep_ < (((REPEAT_MASK >> 3) & 1) ? 2 : 1); ++rep_) {
        const Ctx c = mkctx(ws, lds_raw); PHASE_PTRS
        unsigned* kmaxL = (unsigned*)lds_raw;
        if (c.tid < 18) kmaxL[c.tid] = 0u;
        __syncthreads();
        uint4 nraw[6], nraw2[6];
#pragma unroll
        for (int j = 0; j < 6; ++j) nraw[j] = *(const uint4*)(PBUF + (size_t)c.gw * 3072 + 512 * j + 8 * c.lane);
#pragma unroll
        for (int j = 0; j < 6; ++j) nraw2[j] = *(const uint4*)(PBUF + (size_t)((c.gw + c.ngw < NTOK) ? c.gw + c.ngw : c.gw) * 3072 + 512 * j + 8 * c.lane);
        for (int m = c.gw; m < NTOK; m += c.ngw) {
            const int b = m / SEQ, s = m % SEQ;
            uint4 raw[6];
#pragma unroll
            for (int j = 0; j < 6; ++j) { raw[j] = nraw[j]; nraw[j] = nraw2[j]; }
            if (m + 2 * c.ngw < NTOK) {
#pragma unroll
                for (int j = 0; j < 6; ++j) nraw2[j] = *(const uint4*)(PBUF + (size_t)(m + 2 * c.ngw) * 3072 + 512 * j + 8 * c.lane);
            }
            float rq, rkv;
            {
                float v[8]; { const uint4 u = raw[0]; v[0] = bf2f(u.x & 0xffffu); v[1] = bf2f(u.x >> 16); v[2] = bf2f(u.y & 0xffffu); v[3] = bf2f(u.y >> 16); v[4] = bf2f(u.z & 0xffffu); v[5] = bf2f(u.z >> 16); v[6] = bf2f(u.w & 0xffffu); v[7] = bf2f(u.w >> 16); }
                float sq = 0.f;
#pragma unroll
                for (int i = 0; i < 8; ++i) sq += v[i] * v[i];
                rq = rsqrtf(wave_sum(c.lane < 32 ? sq : 0.f) * (1.f / QLORA) + EPS);
                rkv = rsqrtf(wave_sum((c.lane >= 32 && c.lane < 48) ? sq : 0.f) * (1.f / KVLORA) + EPS);
                if (c.lane >= 48 && c.lane < 52) {
                    const int i0 = 4 * (c.lane - 48); uint4 o; unsigned ow[4];
#pragma unroll
                    for (int pq = 0; pq < 4; ++pq) { const float cs = cosm[s * 16 + i0 + pq], sn = sinm[s * 16 + i0 + pq]; ow[pq] = pk2(v[2 * pq] * cs - v[2 * pq + 1] * sn, v[2 * pq] * sn + v[2 * pq + 1] * cs); }
                    o.x = ow[0]; o.y = ow[1]; o.z = ow[2]; o.w = ow[3];
#pragma unroll
                    for (int h = 0; h < MH; ++h) *(uint4*)&KM[((size_t)(b * MH + h) * SEQ + s) * DQKM + MNOPE + 2 * i0] = o;
                    float pq = 0.f;
#pragma unroll
                    for (int i = 0; i < 8; ++i) pq += v[i] * v[i];
                    pq += dppmov<0xB1, 0xF>(0.f, pq); pq += dppmov<0x4E, 0xF>(0.f, pq);
                    if (c.lane == 48) atomicMax(&kmaxL[16 + b], __builtin_bit_cast(unsigned, pq));
                }
            }
#pragma unroll
            for (int j = 1; j < 6; ++j) {
                const int col0 = 512 * j + 8 * c.lane;
                float v[8]; { const uint4 u = raw[j]; v[0] = bf2f(u.x & 0xffffu); v[1] = bf2f(u.x >> 16); v[2] = bf2f(u.y & 0xffffu); v[3] = bf2f(u.y >> 16); v[4] = bf2f(u.z & 0xffffu); v[5] = bf2f(u.z >> 16); v[6] = bf2f(u.w & 0xffffu); v[7] = bf2f(u.w >> 16); }
                if (col0 < 1280) {
                    const int qc = col0 - 512, h = qc / DQKM, d0 = qc % DQKM; const float sc = rq * C2M;
                    uint4 o; unsigned ow[4];
                    if (d0 >= MNOPE) { const int i0 = (d0 - MNOPE) >> 1;
#pragma unroll
                        for (int pq = 0; pq < 4; ++pq) { const float cs = cosm[s * 16 + i0 + pq], sn = sinm[s * 16 + i0 + pq]; ow[pq] = pk2((v[2 * pq] * cs - v[2 * pq + 1] * sn) * sc, (v[2 * pq] * sn + v[2 * pq + 1] * cs) * sc); }
                    } else {
#pragma unroll
                        for (int pq = 0; pq < 4; ++pq) ow[pq] = pk2(v[2 * pq] * sc, v[2 * pq + 1] * sc);
                    }
                    o.x = ow[0]; o.y = ow[1]; o.z = ow[2]; o.w = ow[3];
                    *(uint4*)&QM[((size_t)(b * MH + h) * SEQ + s) * DQKM + d0] = o;
                } else if (col0 < 2304) {
                    const int kc = col0 - 1280, h = kc >> 7, d0 = kc & 127;
                    uint4 o; o.x = pk2(v[0] * rkv, v[1] * rkv); o.y = pk2(v[2] * rkv, v[3] * rkv); o.z = pk2(v[4] * rkv, v[5] * rkv); o.w = pk2(v[6] * rkv, v[7] * rkv);
                    if (d0 < MNOPE) { *(uint4*)&KM[((size_t)(b * MH + h) * SEQ + s) * DQKM + d0] = o;
                        float kq = 0.f;
#pragma unroll
                        for (int i = 0; i < 8; ++i) kq += (v[i] * rkv) * (v[i] * rkv);
                        kq += dppmov<0xB1, 0xF>(0.f, kq); kq += dppmov<0x4E, 0xF>(0.f, kq); kq += dppmov<0x141, 0xF>(0.f, kq);
                        if ((c.lane & 7) == 0) atomicMax(&kmaxL[b * 8 + h], __builtin_bit_cast(unsigned, kq)); }
                    else *(uint4*)&VM[((size_t)(b * MH + h) * SEQ + s) * MV + (d0 - MNOPE)] = o;
                } else if (col0 < 2944) {
                    const bool isq = col0 < 2816; const int hc = isq ? (col0 - 2304) : (col0 - 2816), h = hc >> 6, d0 = hc & 63;
                    float sq = 0.f;
#pragma unroll
                    for (int i = 0; i < 8; ++i) sq += v[i] * v[i];
                    sq += __shfl_xor(sq, 1); sq += __shfl_xor(sq, 2); sq += __shfl_xor(sq, 4);
                    const float rs = rsqrtf(sq * (1.f / GD) + EPS) * (isq ? C2G : 1.f); const float* gh = isq ? g_q_head : g_k_head;
                    uint4 o; unsigned ow[4];
#pragma unroll
                    for (int pq = 0; pq < 4; ++pq) { const int d = d0 + 2 * pq; const float cs = cosg[s * 32 + (d >> 1)], sn = sing[s * 32 + (d >> 1)];
                        const float x0 = v[2 * pq] * rs * gh[d], x1 = v[2 * pq + 1] * rs * gh[d + 1]; ow[pq] = pk2(x0 * cs - x1 * sn, x0 * sn + x1 * cs); }
                    o.x = ow[0]; o.y = ow[1]; o.z = ow[2]; o.w = ow[3];
                    if (isq) *(uint4*)&QG[((size_t)(b * GH + h) * SEQ + s) * GD + d0] = o;
                    else *(uint4*)&KG[((size_t)(b * GKV + h) * SEQ + s) * GD + d0] = o;
                } else {
                    const int hc = col0 - 2944, h = hc >> 6, d0 = hc & 63;
                    *(uint4*)&VG[((size_t)(b * GKV + h) * SEQ + s) * GD + d0] = raw[j];
                }
            }
        }
        __syncthreads();
        if (c.tid < 18) atomicMax(ctl + CW_KMAX + c.tid, kmaxL[c.tid]);
    }
    SEAM(3);

    if (IN(4)) for (int rep_ = 0; rep_ < (((REPEAT_MASK >> 4) & 1) ? 2 : 1); ++rep_) {
        const Ctx c = mkctx(ws, lds_raw); PHASE_PTRS
        att::ConvState cs;
        { const int e = (c.nb == NE) ? c.bid : 0;
          cs.cj = 0; cs.jbase = 384 * c.wave;
          cs.wg = (const char*)(w_gate_e + (size_t)e * DM * EFF); cs.wu = (const char*)(w_up_e + (size_t)e * DM * EFF); cs.wd = (const char*)(w_down_e + (size_t)e * EFF * DM);
          cs.dgu = (char*)(WGUT + (size_t)e * 512 * DM); cs.dd = (char*)(WDT + (size_t)e * DM * EFF);
          cs.ldsbuf = (unsigned)(uintptr_t)lds_raw + att::CONV_LDS + (CONV_MODE >= 5 ? 0 : c.wave * 4096); cs.rdbuf = (att::lds_cptr)lds_raw + att::CONV_LDS + (CONV_MODE >= 5 ? 0 : c.wave * 4096);
          if (CONV_MODE >= 5) cs.jbase = 0;
          if (CONV_MODE != 0 && CONV_MODE < 5) for (int i = 0; i < 3; ++i) { const att::ConvJob q = att::conv_job(cs, cs.cj);
              att::glds16_s(q.sbase, (unsigned)(c.lane >> 3) * q.ldwB + (unsigned)(c.lane & 7) * 16u, (unsigned)__builtin_amdgcn_readfirstlane(cs.ldsbuf + (cs.cj & 3) * 1024)); ++cs.cj; }
          asm volatile("s_waitcnt vmcnt(0)" ::: "memory"); }
        float mfix;
        { const float gq = wave_max(fabsf(g_q_head[c.lane])), gk = wave_max(fabsf(g_k_head[c.lane])); mfix = fminf(64.f * C2G * gq * gk * 1.03f + 0.5f, 60.f); }
        for (int uu = vcu; uu < 512; uu += c.nb) {
            const int bh = uu >> 5, b = bh >> 3, h = bh & 7, qp = uu & 31;
            const int q0 = qp * 256;
            const float kb2 = __builtin_bit_cast(float, ctl[CW_KMAX + b * 8 + h]) + __builtin_bit_cast(float, ctl[CW_KMAX + 16 + b]);
            att::unit96<8>(QM + (size_t)(b * MH + h) * SEQ * DQKM, KM + (size_t)(b * MH + h) * SEQ * DQKM, VM + (size_t)(b * MH + h) * SEQ * MV,
                                 O + ((size_t)b * SEQ + q0) * DM + h * 64, OSTAT + ((size_t)b * SEQ + q0) * 16 + h, q0, (char*)lds_raw, cs, kb2);
            att::unit64<8>(QG + (size_t)(b * GH + h) * SEQ * GD, KG + (size_t)(b * GKV + (h >> 2)) * SEQ * GD, VG + (size_t)(b * GKV + (h >> 2)) * SEQ * GD,
                                 O + ((size_t)b * SEQ + q0) * DM + (8 + h) * 64, OSTAT + ((size_t)b * SEQ + q0) * 16 + 8 + h, q0, (char*)lds_raw, cs, mfix);
        }
#if CONV_MODE >= 5
        {
            using namespace att;
            const int wid = c.wave, lane = c.lane; const bool rst = wid >= 6;
            for (int r4 = 0; r4 < 3; ++r4) { CONV_DRAIN(); ++cs.cj; }
        }
#endif
    }
    SEAM(4);

    if (IN(5)) for (int rep_ = 0; rep_ < (((REPEAT_MASK >> 5) & 1) ? 2 : 1); ++rep_) {
        const Ctx c = mkctx(ws, lds_raw); PHASE_PTRS
        pg8::DenseOrder S; S.init(NTOK, DM, DM, WOUTT, c.nb, c.bid);
        LAS float* rtab = (LAS float*)(ldsb + pg8::STAGE_BYTES);
        { pg8::Unit u0; if (S.next(0, u0) && c.tid < 256) { const float4* sp = (const float4*)&OSTAT[(size_t)(u0.pm * 256 + c.tid) * 16]; const float4 s0 = sp[0], s1 = sp[1], s2 = sp[2], s3 = sp[3];
            const float sm = ((s0.x + s0.y) + (s0.z + s0.w)) + ((s1.x + s1.y) + (s1.z + s1.w)), sg = ((s2.x + s2.y) + (s2.z + s2.w)) + ((s3.x + s3.y) + (s3.z + s3.w));
            const float rm = rsqrtf(sm * (1.f / 512) + EPS), rg = rsqrtf(sg * (1.f / 512) + EPS); rtab[2 * c.tid] = rm / rg; rtab[2 * c.tid + 1] = rg; }
          __syncthreads(); }
        pg8::EpiBf16RowScale E{MIXED, DM, rtab};
        pg8::gemm_phase<pg8::EpiBf16RowScale, pg8::DenseOrder, true, false, true>(ldsb, O, DM, S, E, nullptr);
    }
    SEAM(5);

    if (IN(6)) for (int rep_ = 0; rep_ < (((REPEAT_MASK >> 6) & 1) ? 2 : 1); ++rep_) {
        const Ctx c = mkctx(ws, lds_raw); PHASE_PTRS
        {
            const float* COEF = (const float*)(wsp + WS_COEF);
            uint2 nmu[2][4]; float4 nxq[2][4];
#pragma unroll
            for (int q = 0; q < 2; ++q) { const int m = (c.gw + q * c.ngw < NTOK) ? c.gw + q * c.ngw : c.gw;
#pragma unroll
                for (int j = 0; j < 4; ++j) { nmu[q][j] = *(const uint2*)&MIXED[(size_t)m * DM + 4 * c.lane + 256 * j]; nxq[q][j] = *(const float4*)&x[(size_t)m * DM + 4 * c.lane + 256 * j]; } }
            for (int m0 = c.gw; m0 < NTOK; m0 += 2 * c.ngw) {
                uint2 mu[2][4]; float4 xq[2][4];
#pragma unroll
                for (int q = 0; q < 2; ++q)
#pragma unroll
                    for (int j = 0; j < 4; ++j) { mu[q][j] = nmu[q][j]; xq[q][j] = nxq[q][j]; }
                const int m0n = m0 + 2 * c.ngw;
                if (m0n < NTOK) {
#pragma unroll
                    for (int q = 0; q < 2; ++q) { const int m = (m0n + q * c.ngw < NTOK) ? m0n + q * c.ngw : m0n;
#pragma unroll
                        for (int j = 0; j < 4; ++j) { nmu[q][j] = *(const uint2*)&MIXED[(size_t)m * DM + 4 * c.lane + 256 * j]; nxq[q][j] = *(const float4*)&x[(size_t)m * DM + 4 * c.lane + 256 * j]; } }
                }
#pragma unroll
                for (int q = 0; q < 2; ++q) {
                    const int m = (m0 + q * c.ngw < NTOK) ? m0 + q * c.ngw : m0; const int b = m / SEQ; const float* cf = COEF + b * 4096;
                    float4 ca[4], cb[4], cd[4];
#pragma unroll
                    for (int j = 0; j < 4; ++j) { const int cc = 4 * c.lane + 256 * j; ca[j] = *(const float4*)&cf[cc]; cb[j] = *(const float4*)&cf[1024 + cc]; cd[j] = *(const float4*)&cf[2048 + cc]; }
                    float4 v[4], xr[4]; float ss = 0.f;
#pragma unroll
                    for (int j = 0; j < 4; ++j) { const uint2 u = mu[q][j];
                        v[j].x = bf2f(u.x & 0xffffu); v[j].y = bf2f(u.x >> 16); v[j].z = bf2f(u.y & 0xffffu); v[j].w = bf2f(u.y >> 16);
                        ss += v[j].x * v[j].x + v[j].y * v[j].y + v[j].z * v[j].z + v[j].w * v[j].w; }
                    const float rstd = rsqrtf(wave_sum(ss) * (1.f / DM) + EPS);
                    float ss1 = 0.f;
#pragma unroll
                    for (int j = 0; j < 4; ++j) {
                        const int cc = 4 * c.lane + 256 * j; const float4 xx = xq[q][j];
                        xr[j].x = xx.x + ca[j].x * (v[j].x * rstd); xr[j].y = xx.y + ca[j].y * (v[j].y * rstd);
                        xr[j].z = xx.z + ca[j].z * (v[j].z * rstd); xr[j].w = xx.w + ca[j].w * (v[j].w * rstd);
                        ss1 += xr[j].x * xr[j].x + xr[j].y * xr[j].y + xr[j].z * xr[j].z + xr[j].w * xr[j].w;
                        { uint2 xo; xo.x = pk2(xr[j].x, xr[j].y); xo.y = pk2(xr[j].z, xr[j].w); *(uint2*)&X1[(size_t)m * DM + cc] = xo; }
                    }
                    const float rstd1 = rsqrtf(wave_sum(ss1) * (1.f / DM) + EPS);
#pragma unroll
                    for (int j = 0; j < 4; ++j) {
                        const int cc = 4 * c.lane + 256 * j;
                        uint2 pk;
                        pk.x = pk2(xr[j].x * rstd1 * cb[j].x + cd[j].x, xr[j].y * rstd1 * cb[j].y + cd[j].y);
                        pk.y = pk2(xr[j].z * rstd1 * cb[j].z + cd[j].z, xr[j].w * rstd1 * cb[j].w + cd[j].w);
                        *(uint2*)&H2[(size_t)m * DM + cc] = pk;
                    }
                }
            }
        }
    }
    SEAM(6);

    if (IN(7)) for (int rep_ = 0; rep_ < (((REPEAT_MASK >> 7) & 1) ? 2 : 1); ++rep_) {
        const Ctx c = mkctx(ws, lds_raw); PHASE_PTRS
        pg8::DenseOrder S; S.init(NTOK, 768, DM, WRST, c.nb, c.bid); pg8::EpiRS E{LOG, ACTS};
        pg8::gemm_phase<pg8::EpiRS, pg8::DenseOrder, true>(ldsb, H2, DM, S, E);
    }
    SEAM(7);

    if (IN(8)) for (int rep_ = 0; rep_ < (((REPEAT_MASK >> 8) & 1) ? 2 : 1); ++rep_) {
        const Ctx c = mkctx(ws, lds_raw); PHASE_PTRS
        const float4 bb = *(const float4*)&b_router[4 * c.lane];
        const unsigned rowL = (unsigned)(uintptr_t)lds_raw + c.wave * 8192;
        const LAS unsigned char* rowP = ldsb + c.wave * 8192;
        const bool cnt_sort = (MK_N_LAUNCHES == 1) && c.nb == NE && 8 * c.ngw == NTOK && lo < 8 && hi > 9;
        int* histg = (int*)(lds_raw + 65536); int* HIST = (int*)(wsp + WS_HIST);
        if (cnt_sort) { if (c.tid < NE) histg[c.tid] = 0; __syncthreads(); }
        for (int mb = c.gw; mb < NTOK; mb += 8 * c.ngw) {
#pragma unroll
          for (int r = 0; r < 8; ++r) { const int mr = mb + r * c.ngw; if (mr < NTOK) att::glds16(LOG + (size_t)mr * NE + 4 * c.lane, (unsigned)__builtin_amdgcn_readfirstlane(rowL + r * 1024)); }
          asm volatile("s_waitcnt vmcnt(0)" ::: "memory");
          int my_e = 0; float my_s = 0.f; int rb = 0;
#pragma unroll 1
          for (int m = mb; m < NTOK && rb < 8; m += c.ngw) {
            typedef float f32x4v __attribute__((ext_vector_type(4)));
            const f32x4v lg = *(const LAS f32x4v*)(rowP + rb * 1024 + c.lane * 16);
            const float s0 = __builtin_amdgcn_rcpf(1.f + __builtin_amdgcn_exp2f(lg.x * -1.44269504f)), s1 = __builtin_amdgcn_rcpf(1.f + __builtin_amdgcn_exp2f(lg.y * -1.44269504f));
            const float s2 = __builtin_amdgcn_rcpf(1.f + __builtin_amdgcn_exp2f(lg.z * -1.44269504f)), s3 = __builtin_amdgcn_rcpf(1.f + __builtin_amdgcn_exp2f(lg.w * -1.44269504f));
            const int o0 = ford(s0 + bb.x), o1 = ford(s1 + bb.y), o2 = ford(s2 + bb.z), o3 = ford(s3 + bb.w);
            const int e0 = 4 * c.lane, g = c.lane >> 3;
            const int IMIN = (int)0x80000000;
            int gkey;
            {
                const int h01 = imax_(o0, o1), l01 = imin_(o0, o1), h23 = imax_(o2, o3), l23 = imin_(o2, o3);
                const int a1 = imax_(h01, h23), a2 = imax_(imin_(h01, h23), (h01 >= h23) ? l01 : l23);
                const int g1 = grp8_max_i(a1);
                const unsigned long long bm = __ballot(a1 == g1);
                const unsigned grpbits = (unsigned)(bm >> (8 * g)) & 0xffu;
                const bool first = (a1 == g1) && ((grpbits & ((1u << (c.lane & 7)) - 1u)) == 0u);
                const int g2 = grp8_max_i(first ? a2 : a1);
                gkey = (ford(funord(g1) + funord(g2)) & ~7) | (7 - g);
            }
            int rank = 0;
#pragma unroll
            for (int j = 0; j < 8; ++j) rank += (__builtin_amdgcn_readlane(gkey, 8 * j) > gkey) ? 1 : 0;
            const bool sel = rank < 4;
            int k0 = sel ? ((o0 & ~0xff) | (255 - e0)) : IMIN, k1 = sel ? ((o1 & ~0xff) | (254 - e0)) : IMIN, k2 = sel ? ((o2 & ~0xff) | (253 - e0)) : IMIN, k3 = sel ? ((o3 & ~0xff) | (252 - e0)) : IMIN;
            int my_key = 0;
#pragma unroll 1
            for (int rnd = 0; rnd < TOPK; ++rnd) {
                const int mx = wave_max_i(imax_(imax_(k0, k1), imax_(k2, k3)));
                if (c.lane == 8 * rb + rnd) my_key = mx;
                k0 = (k0 == mx) ? IMIN : k0; k1 = (k1 == mx) ? IMIN : k1; k2 = (k2 == mx) ? IMIN : k2; k3 = (k3 == mx) ? IMIN : k3;
            }
            {
                const int ee = 255 - (my_key & 0xff), src = (ee >> 2) * 4;
                const float q0 = __builtin_bit_cast(float, __builtin_amdgcn_ds_bpermute(src, __builtin_bit_cast(int, s0))), q1 = __builtin_bit_cast(float, __builtin_amdgcn_ds_bpermute(src, __builtin_bit_cast(int, s1)));
                const float q2 = __builtin_bit_cast(float, __builtin_amdgcn_ds_bpermute(src, __builtin_bit_cast(int, s2))), q3 = __builtin_bit_cast(float, __builtin_amdgcn_ds_bpermute(src, __builtin_bit_cast(int, s3)));
                if ((c.lane >> 3) == rb) { my_e = ee; my_s = (ee & 2) ? ((ee & 1) ? q3 : q2) : ((ee & 1) ? q1 : q0); }
            }
            ++rb;
          }
          { const int rr = c.lane >> 3, k = c.lane & 7;
            const float tot = grp8_sum(my_s);
            const bool valid = rr < rb; const int id = (mb + rr * c.ngw) * TOPK + k; const float wt = my_s / tot * 2.5f;
            if (!cnt_sort) {
                if (valid) { const unsigned pos = atomicAdd(&CNT[(size_t)my_e * CNT_STRIDE], 1u);
                    LIST[(size_t)my_e * LCAP + pos] = id; POSREC[id] = (my_e << 16) | (int)pos; WTS[id] = wt; }
            } else {
                int lpos = 0; if (valid) lpos = atomicAdd(&histg[my_e], 1);
                __syncthreads();
                if (c.tid < 64) HIST[c.bid * 64 + c.tid] = histg[4 * c.tid] | (histg[4 * c.tid + 1] << 8) | (histg[4 * c.tid + 2] << 16) | (histg[4 * c.tid + 3] << 24);
                xcd_barrier(bar);
                { const int rg = c.tid >> 4, eb = c.tid & 15;
                  uint4 hv[8];
#pragma unroll
                  for (int j = 0; j < 8; ++j) { const int w = rg + 32 * j; hv[j] = make_uint4(0u, 0u, 0u, 0u); if (w < c.bid) hv[j] = *(const uint4*)&HIST[w * 64 + eb * 4]; }
                  int acc[16];
#pragma unroll
                  for (int i = 0; i < 16; ++i) acc[i] = 0;
#pragma unroll
                  for (int j = 0; j < 8; ++j) { const unsigned wd[4] = {hv[j].x, hv[j].y, hv[j].z, hv[j].w};
#pragma unroll
                      for (int q = 0; q < 4; ++q) { acc[4 * q] += (int)(wd[q] & 0xffu); acc[4 * q + 1] += (int)((wd[q] >> 8) & 0xffu); acc[4 * q + 2] += (int)((wd[q] >> 16) & 0xffu); acc[4 * q + 3] += (int)(wd[q] >> 24); } }
#pragma unroll
                  for (int q = 0; q < 4; ++q) *(int4*)&histg[1024 + rg * NE + eb * 16 + 4 * q] = make_int4(acc[4 * q], acc[4 * q + 1], acc[4 * q + 2], acc[4 * q + 3]); }
                __syncthreads();
                if (c.tid < NE) { int bs = 0;
#pragma unroll
                    for (int r = 0; r < 32; ++r) bs += histg[1024 + r * NE + c.tid];
                    histg[768 + c.tid] = bs; if (c.bid == c.nb - 1) HIST[NE * NE + c.tid] = bs + histg[c.tid]; }
                __syncthreads();
                if (valid) { const int pos = histg[768 + my_e] + lpos;
                    LIST[(size_t)my_e * LCAP + pos] = id; POSREC[id] = (my_e << 16) | pos; WTS[id] = wt; }
            } }
        }
    }
    SEAM(8);

    LAS int* pre = (LAS int*)(ldsb + pg8::STAGE_BYTES);
    LAS int* offs = pre + 320; LAS int* cntl = offs + 320; LAS int* utab9 = cntl + 256; LAS int* utab10 = utab9 + 16;
    if (IN(9) || IN(10) || IN(11)) {
        const Ctx c = mkctx(ws, lds_raw); PHASE_PTRS
        __syncthreads();
        if (c.tid < NE) cntl[c.tid] = ((MK_N_LAUNCHES == 1) && c.nb == NE && 8 * c.ngw == NTOK && lo < 8 && hi > 9) ? ((const int*)(wsp + WS_HIST))[NE * NE + c.tid] : (int)CNT[(size_t)c.tid * CNT_STRIDE];
        __syncthreads();
        if (c.tid <= NE) { int a = 0, o = 0; for (int j = 0; j < c.tid; ++j) { const int q = cntl[j]; a += (q + 255) >> 8; o += q; } pre[c.tid] = a; offs[c.tid] = o; }
        __syncthreads();
        if (c.tid < 16) pg8::MoeOrder::fill_table(utab9, pre, 2, c.nb, vcu, c.tid);
        else if (c.tid >= 64 && c.tid < 80) pg8::MoeOrder::fill_table(utab10, pre, 4, c.nb, vcu, c.tid - 64);
        __syncthreads();
    }
    if (IN(9)) for (int rep_ = 0; rep_ < (((REPEAT_MASK >> 9) & 1) ? 2 : 1); ++rep_) {
        const Ctx c = mkctx(ws, lds_raw); PHASE_PTRS
        pg8::MoeOrder S{pre, offs, cntl, LIST, (const char*)WGUT, (size_t)512 * DM * 2, DM, 2, c.nb, vcu, 0, utab9};
        pg8::EpiAct E{ACT};
        pg8::gemm_phase<pg8::EpiAct, pg8::MoeOrder, true, true>(ldsb, H2, DM, S, E);
    }
    SEAM(9);

    if (IN(10)) for (int rep_ = 0; rep_ < (((REPEAT_MASK >> 10) & 1) ? 2 : 1); ++rep_) {
        const Ctx c = mkctx(ws, lds_raw); PHASE_PTRS
        { pg8::MoeOrder S{pre, offs, cntl, LIST, (const char*)WDT, (size_t)DM * EFF * 2, EFF, 4, c.nb, vcu, 1, utab10};
          pg8::EpiSlots E{(unsigned char*)SLOTS};
          pg8::gemm_phase<pg8::EpiSlots, pg8::MoeOrder, true>(ldsb, ACT, EFF, S, E); }
        { pg8::DenseOrder S; S.init(NTOK, DM, EFF, WDST, c.nb, c.bid); pg8::EpiBf16 E{YSH, DM};
          pg8::gemm_phase<pg8::EpiBf16, pg8::DenseOrder, true>(ldsb, ACTS, EFF, S, E); }
    }
    SEAM(10);

    if (IN(11)) for (int rep_ = 0; rep_ < (((REPEAT_MASK >> 11) & 1) ? 2 : 1); ++rep_) {
        const Ctx c = mkctx(ws, lds_raw); PHASE_PTRS
        const unsigned char* SL8 = (const unsigned char*)SLOTS;
        typedef float f32x2v __attribute__((ext_vector_type(2)));
        const float* COEF = (const float*)(wsp + WS_COEF);
        const int nrw = (c.gw < NTOK) ? (NTOK - c.gw + c.ngw - 1) / c.ngw : 0;
        const int cc = 16 * c.lane;
        int recn = 0; float wtn = 0.f;
        int recf = 0; float wtf = 0.f;
        uint4 dsl[TOPK], dys[2]; uint2 dx1[4]; float dwt = 0.f;
        if (nrw > 0 && c.lane < TOPK) { recn = POSREC[(size_t)c.gw * TOPK + c.lane]; wtn = WTS[(size_t)c.gw * TOPK + c.lane] * (1.f / 16.f); }
        if (nrw > 1 && c.lane < TOPK) { recf = POSREC[(size_t)(c.gw + c.ngw) * TOPK + c.lane]; wtf = WTS[(size_t)(c.gw + c.ngw) * TOPK + c.lane] * (1.f / 16.f); }
        if (nrw > 0) { const int m = c.gw; const int sr = offs[(recn >> 16) & 255] + (recn & 0xffff);
#pragma unroll
            for (int k = 0; k < TOPK; ++k) dsl[k] = *(const uint4*)&SL8[(size_t)__builtin_amdgcn_readlane(sr, k) * DM + cc];
            dys[0] = *(const uint4*)&YSH[(size_t)m * DM + cc]; dys[1] = *(const uint4*)&YSH[(size_t)m * DM + cc + 8];
#pragma unroll
            for (int hq = 0; hq < 4; ++hq) dx1[hq] = *(const uint2*)&X1[(size_t)m * DM + cc + 4 * hq];
            dwt = wtn; recn = recf; wtn = wtf; }
        for (int i = 0; i < nrw; ++i) {
            const int m = c.gw + i * c.ngw;
            if (i + 2 < nrw && c.lane < TOPK) { const int m2 = m + 2 * c.ngw; recf = POSREC[(size_t)m2 * TOPK + c.lane]; wtf = WTS[(size_t)m2 * TOPK + c.lane] * (1.f / 16.f); }
            uint4 csl[TOPK], cys[2]; uint2 cx1[4]; const float cwt = dwt;
#pragma unroll
            for (int k = 0; k < TOPK; ++k) csl[k] = dsl[k];
            cys[0] = dys[0]; cys[1] = dys[1];
#pragma unroll
            for (int hq = 0; hq < 4; ++hq) cx1[hq] = dx1[hq];
            if (i + 1 < nrw) { const int m1 = m + c.ngw; const int sr = offs[(recn >> 16) & 255] + (recn & 0xffff);
#pragma unroll
                for (int k = 0; k < TOPK; ++k) dsl[k] = *(const uint4*)&SL8[(size_t)__builtin_amdgcn_readlane(sr, k) * DM + cc];
                dys[0] = *(const uint4*)&YSH[(size_t)m1 * DM + cc]; dys[1] = *(const uint4*)&YSH[(size_t)m1 * DM + cc + 8];
#pragma unroll
                for (int hq = 0; hq < 4; ++hq) dx1[hq] = *(const uint2*)&X1[(size_t)m1 * DM + cc + 4 * hq];
                dwt = wtn; recn = recf; wtn = wtf; }
            const int b = m / SEQ; const float* cf = COEF + b * 4096 + 3072;
            float4 ca[4];
#pragma unroll
            for (int hq = 0; hq < 4; ++hq) ca[hq] = *(const float4*)&cf[cc + 4 * hq];
            float y[16]; float ss = 0.f;
#pragma unroll
            for (int hq = 0; hq < 2; ++hq) { const uint4 u = cys[hq];
                y[8 * hq + 0] = bf2f(u.x & 0xffffu); y[8 * hq + 1] = bf2f(u.x >> 16); y[8 * hq + 2] = bf2f(u.y & 0xffffu); y[8 * hq + 3] = bf2f(u.y >> 16);
                y[8 * hq + 4] = bf2f(u.z & 0xffffu); y[8 * hq + 5] = bf2f(u.z >> 16); y[8 * hq + 6] = bf2f(u.w & 0xffffu); y[8 * hq + 7] = bf2f(u.w >> 16); }
#pragma unroll
            for (int k = 0; k < TOPK; ++k) { const uint4 u = csl[k]; const float wk = __builtin_bit_cast(float, __builtin_amdgcn_readlane(__builtin_bit_cast(int, cwt), k));
                const unsigned wds[4] = {u.x, u.y, u.z, u.w};
#pragma unroll
                for (int d = 0; d < 4; ++d) { const f32x2v a2 = __builtin_amdgcn_cvt_pk_f32_fp8((int)wds[d], false), b2 = __builtin_amdgcn_cvt_pk_f32_fp8((int)wds[d], true);
                    y[4 * d] += wk * a2.x; y[4 * d + 1] += wk * a2.y; y[4 * d + 2] += wk * b2.x; y[4 * d + 3] += wk * b2.y; } }
#pragma unroll
            for (int q = 0; q < 16; ++q) ss += y[q] * y[q];
            const float rstd = rsqrtf(wave_sum(ss) * (1.f / DM) + EPS);
#pragma unroll
            for (int hq = 0; hq < 4; ++hq) {
                const int c4 = cc + 4 * hq; const uint2 xu = cx1[hq];
                float4 xx; xx.x = bf2f(xu.x & 0xffffu); xx.y = bf2f(xu.x >> 16); xx.z = bf2f(xu.y & 0xffffu); xx.w = bf2f(xu.y >> 16);
                float4 r; r.x = xx.x + ca[hq].x * (y[4 * hq] * rstd); r.y = xx.y + ca[hq].y * (y[4 * hq + 1] * rstd);
                r.z = xx.z + ca[hq].z * (y[4 * hq + 2] * rstd); r.w = xx.w + ca[hq].w * (y[4 * hq + 3] * rstd);
                *(float4*)&args.out[(size_t)m * DM + c4] = r;
            }
        }
    }
    }
#undef IN
#undef SEAM
}

constexpr int NPHASE = 12;

extern "C" void kernel_launch(void* const* d_in, const int* in_sizes, int n_in, void* d_out, int out_size, void* d_ws, size_t ws_size, hipStream_t stream) {
    static int grid = 0;
    if (grid == 0) {
        if (n_in != 26 || out_size != NTOK * DM || ws_size < WS_END) { fprintf(stderr, "kernel_launch: unexpected shapes (n_in %d, out %d, ws %zu)\n", n_in, out_size, ws_size); grid = -1; return; }
        int dev = 0, cus = 0, per_cu = 0;
        if (hipGetDevice(&dev) != hipSuccess || hipDeviceGetAttribute(&cus, hipDeviceAttributeMultiprocessorCount, dev) != hipSuccess) { grid = -1; return; }
        if (hipFuncSetAttribute((const void*)mega, hipFuncAttributeMaxDynamicSharedMemorySize, LDS_BYTES) != hipSuccess) { fprintf(stderr, "kernel_launch: hipFuncSetAttribute failed\n"); grid = -1; return; }
        if (hipOccupancyMaxActiveBlocksPerMultiprocessor(&per_cu, (const void*)mega, NTHR, LDS_BYTES) != hipSuccess || per_cu < 1) fprintf(stderr, "kernel_launch: occupancy query says %d\n", per_cu);
        (void)hipGetLastError();
        grid = cus;
    }
    if (grid < 0) return;
    (void)hipMemsetAsync((char*)d_ws + WS_CTL, 0, CTL_ZERO_BYTES, stream);
    Args a{};
    for (int i = 0; i < 26; ++i) a.in[i] = (const float*)d_in[i];
    a.out = (float*)d_out; a.ws = (unsigned char*)d_ws;
    if (MK_N_LAUNCHES == 1) { a.ph_lo = 0; a.ph_hi = NPHASE; hipLaunchKernelGGL(mega, dim3(grid), dim3(NTHR), LDS_BYTES, stream, a); }
    else for (int p = 0; p < NPHASE; ++p) { a.ph_lo = p; a.ph_hi = p + 1; hipLaunchKernelGGL(mega, dim3(grid), dim3(NTHR), LDS_BYTES, stream, a); }
}
```

```cpp
#include <hip/hip_runtime.h>
#include <cstdio>
#include <cstdint>

#ifndef REP_FROM
#define REP_FROM 99
#endif
#ifndef REPEAT_MASK
#define REPEAT_MASK 0
#endif
#ifndef CONV_MODE
#define CONV_MODE 5
#endif
#ifndef MK_N_LAUNCHES
#define MK_N_LAUNCHES 1
#endif

#ifndef ATTN_NAIVE
#define ATTN_NAIVE 0
#endif
#define LAS __attribute__((address_space(3)))
typedef unsigned short bf16_t;

constexpr int NB = 2, SEQ = 8192, NTOK = NB * SEQ, DM = 1024;
constexpr int QLORA = 256, KVLORA = 128, MROPE = 32, MNOPE = 64, MV = 64, MH = 8, DQKM = 96;
constexpr int GH = 8, GKV = 2, GD = 64;
constexpr int INC = 1184;
constexpr int C_QLAT = 0, C_KVLAT = 256, C_KROPE = 384, C_GQ = 416, C_GK = 928, C_GV = 1056;
constexpr int NE = 256, TOPK = 8, EFF = 256;
constexpr int LCAP = 16384;
constexpr float EPS = 1e-6f;
constexpr float LOG2E = 1.4426950408889634f;
constexpr float C2M = 0.10206207261596575f * LOG2E;
constexpr float C2G = 0.125f * LOG2E;

constexpr size_t MiB = 1u << 20;
constexpr size_t WS_CTL = 0, CTL_ZERO_BYTES = 32768;
constexpr size_t WS_MOD = 1 * MiB;
constexpr size_t WS_COSM = 2 * MiB, WS_SINM = 2 * MiB + 512 * 1024, WS_COSG = 3 * MiB, WS_SING = 4 * MiB;
constexpr size_t WS_WQBT = 5 * MiB;
constexpr size_t WS_WINQ = 5 * MiB + 512 * 1024;
constexpr size_t WS_WKVBT = 6 * MiB;
constexpr size_t WS_WINKV = 6 * MiB + 512 * 1024;
constexpr size_t WS_WDST = 7 * MiB;
constexpr size_t WS_COEF = 7 * MiB + 512 * 1024;
constexpr size_t WS_H2 = 8 * MiB;
constexpr size_t WS_X1 = 40 * MiB;
constexpr size_t WS_CNTS = 72 * MiB;
constexpr int CNT_STRIDE = 1088;
constexpr size_t WS_HIST = 82 * MiB;
constexpr size_t WS_WTS = 104 * MiB;
constexpr size_t WS_OSTAT = 252 * MiB;
constexpr size_t WS_POSREC = 105 * MiB;
constexpr size_t WS_LIST = 106 * MiB;
constexpr size_t WS_WBIGT = 122 * MiB;
constexpr size_t WS_WOUTT = 128 * MiB;
constexpr size_t WS_WRST = 130 * MiB;
constexpr size_t WS_ACT = 132 * MiB;
constexpr size_t WS_LOG = 196 * MiB;
constexpr size_t WS_ACTS = 212 * MiB;
constexpr size_t WS_YSH = 220 * MiB;
constexpr size_t WS_SLOTS = 256 * MiB;
constexpr size_t WS_PBUF = 256 * MiB;
constexpr size_t WS_QM = 352 * MiB, WS_KM = 376 * MiB, WS_VM = 400 * MiB, WS_QG = 416 * MiB, WS_KG = 432 * MiB, WS_VG = 436 * MiB;
constexpr size_t WS_O = 440 * MiB;
constexpr size_t WS_MIXED = 472 * MiB;
constexpr size_t WS_WGUT = 512 * MiB;
constexpr size_t WS_WDT = 768 * MiB;
constexpr size_t WS_END = 896 * MiB;
constexpr size_t WS_HF = 512 * MiB, WS_PROJ = 576 * MiB, WS_H2F = 650 * MiB, WS_GS = 714 * MiB, WS_US = 730 * MiB, WS_ACTSF = 746 * MiB, WS_YSHF = 768 * MiB, WS_LOGF = 832 * MiB;
constexpr int CW_CNT = 1024;
constexpr int CW_KMAX = 2048;
constexpr int CW_BAR = 4096;

constexpr int LDS_BYTES = 147456;
constexpr int NTHR = 512, NWAVES = 8;

#define XB_TMO      128
#define XB_XCNT(j)  (256  + 64 * (j))
#define XB_XSUB(j)  (1280 + 64 * (j))
#define XB_XGEN(j)  (2304 + 64 * (j))
#define XB_TOP      3328
#define XB_TOPGEN   3392
#define XCD_BAR_WORDS 3456
#define XB_SPIN_CAP (1u << 18)
__device__ __forceinline__ unsigned xb_ld(unsigned* p)              { return __hip_atomic_load(p, __ATOMIC_RELAXED, __HIP_MEMORY_SCOPE_AGENT); }
__device__ __forceinline__ unsigned xb_add(unsigned* p, unsigned v) { return __hip_atomic_fetch_add(p, v, __ATOMIC_RELAXED, __HIP_MEMORY_SCOPE_AGENT); }
__device__ __forceinline__ unsigned xb_xcc_id() { return (unsigned)__builtin_amdgcn_s_getreg((3 << 11) | 20) & 0xFu; }
#define XB_SPIN(cond, bar) do { unsigned _sp = 0; while (cond) { __builtin_amdgcn_s_sleep(1); \
    if ((++_sp & 255u) == 0u) { if (xb_ld(&(bar)[XB_TMO])) break; if (_sp > XB_SPIN_CAP) { atomicAdd(&(bar)[XB_TMO], 1u); break; } } } } while (0)
struct XcdBarrier { unsigned* bar; unsigned x; volatile LAS unsigned* st; };
__device__ __forceinline__ XcdBarrier xcd_barrier_post(unsigned* bar, volatile LAS unsigned* st) {
    XcdBarrier b; b.bar = bar; b.x = xb_xcc_id(); b.st = st;
    if (threadIdx.x == 0) (void)xb_add(&bar[XB_XCNT(b.x)], 1u);
    return b;
}
__device__ __forceinline__ void xcd_barrier_complete(unsigned* bar, unsigned x, unsigned& nloc, unsigned& nx) {
    const unsigned G = gridDim.x * gridDim.y * gridDim.z;
    unsigned sum, cnt, mine, sp = 0u;
    for (;;) {
        sum = 0u; cnt = 0u; mine = 0u;
#pragma unroll
        for (unsigned j = 0; j < 16; ++j) { const unsigned c = xb_ld(&bar[XB_XCNT(j)]); sum += c; cnt += (c > 0u) ? 1u : 0u; mine = (j == x) ? c : mine; }
        if (sum == G) break;
        __builtin_amdgcn_s_sleep(1);
        if ((++sp & 255u) == 0u) { if (xb_ld(&bar[XB_TMO])) break; if (sp > XB_SPIN_CAP) { atomicAdd(&bar[XB_TMO], 1u); break; } }
    }
    nloc = mine > 0u ? mine : 1u; nx = cnt > 0u ? cnt : 1u;
}
__device__ __forceinline__ void xcd_barrier(const XcdBarrier& b) {
    asm volatile("s_waitcnt vmcnt(0)" ::: "memory");
    __syncthreads();
    if (threadIdx.x == 0) {
        unsigned* bar = b.bar;
        __builtin_amdgcn_s_waitcnt(0);
        unsigned nloc = b.st[0], nx = b.st[1];
        if (nloc == 0u) { xcd_barrier_complete(bar, b.x, nloc, nx); b.st[0] = nloc; b.st[1] = nx; }
        const unsigned old = xb_add(&bar[XB_XSUB(b.x)], 1u);
        const unsigned gen = old / nloc;
        if (old + 1u == (gen + 1u) * nloc) {
            __builtin_amdgcn_fence(__ATOMIC_RELEASE, "agent");
            asm volatile("s_waitcnt vmcnt(0)" ::: "memory");
            const unsigned og = xb_add(&bar[XB_TOP], 1u);
            const unsigned tg = og / nx;
            if (og + 1u == (tg + 1u) * nx) xb_add(&bar[XB_TOPGEN], 1u);
            else XB_SPIN(xb_ld(&bar[XB_TOPGEN]) == tg, bar);
            __builtin_amdgcn_fence(__ATOMIC_ACQUIRE, "agent");
            xb_add(&bar[XB_XGEN(b.x)], 1u);
            asm volatile("s_waitcnt vmcnt(0)" ::: "memory");
        } else {
            XB_SPIN(xb_ld(&bar[XB_XGEN(b.x)]) == gen, bar);
            __builtin_amdgcn_fence(__ATOMIC_ACQUIRE, "agent");
            asm volatile("s_waitcnt vmcnt(0)" ::: "memory");
        }
    }
    __syncthreads();
}

__device__ __forceinline__ unsigned f2bf(float f) { unsigned u = __builtin_bit_cast(unsigned, f); return (u + 0x7fffu + ((u >> 16) & 1u)) >> 16; }
__device__ __forceinline__ float bf2f(unsigned h) { return __builtin_bit_cast(float, h << 16); }
typedef float f32x2p_t __attribute__((ext_vector_type(2))); typedef __bf16 bf16x2p_t __attribute__((ext_vector_type(2)));
__device__ __forceinline__ unsigned pk2(float lo, float hi) { f32x2p_t v = {lo, hi}; bf16x2p_t b = __builtin_convertvector(v, bf16x2p_t); return __builtin_bit_cast(unsigned, b); }
template <int CTRL, int RM> __device__ __forceinline__ float dppmov(float old, float v) {
    return __builtin_bit_cast(float, __builtin_amdgcn_update_dpp(__builtin_bit_cast(int, old), __builtin_bit_cast(int, v), CTRL, RM, 0xF, false)); }
__device__ __forceinline__ float wave_sum(float v) {
    v += dppmov<0xB1, 0xF>(0.f, v);
    v += dppmov<0x4E, 0xF>(0.f, v);
    v += dppmov<0x141, 0xF>(0.f, v);
    v += dppmov<0x140, 0xF>(0.f, v);
    v += dppmov<0x142, 0xA>(0.f, v);
    v += dppmov<0x143, 0xC>(0.f, v);
    return __builtin_bit_cast(float, __builtin_amdgcn_readlane(__builtin_bit_cast(int, v), 63));
}
__device__ __forceinline__ float wave_max(float v) {
    const float NI = -INFINITY;
    v = fmaxf(v, dppmov<0xB1, 0xF>(NI, v)); v = fmaxf(v, dppmov<0x4E, 0xF>(NI, v)); v = fmaxf(v, dppmov<0x141, 0xF>(NI, v)); v = fmaxf(v, dppmov<0x140, 0xF>(NI, v));
    v = fmaxf(v, dppmov<0x142, 0xA>(NI, v)); v = fmaxf(v, dppmov<0x143, 0xC>(NI, v));
    return __builtin_bit_cast(float, __builtin_amdgcn_readlane(__builtin_bit_cast(int, v), 63));
}
template <int CTRL, int RM> __device__ __forceinline__ int dppmovi(int old, int v) { return __builtin_amdgcn_update_dpp(old, v, CTRL, RM, 0xF, false); }
__device__ __forceinline__ int imax_(int a, int b) { return a > b ? a : b; }
__device__ __forceinline__ int imin_(int a, int b) { return a < b ? a : b; }
__device__ __forceinline__ int wave_max_i(int v) {
    const int NI = (int)0x80000000;
    v = imax_(v, dppmovi<0xB1, 0xF>(NI, v)); v = imax_(v, dppmovi<0x4E, 0xF>(NI, v)); v = imax_(v, dppmovi<0x141, 0xF>(NI, v)); v = imax_(v, dppmovi<0x140, 0xF>(NI, v));
    v = imax_(v, dppmovi<0x142, 0xA>(NI, v)); v = imax_(v, dppmovi<0x143, 0xC>(NI, v));
    return __builtin_amdgcn_readlane(v, 63);
}
__device__ __forceinline__ int grp8_max_i(int v) {
    const int NI = (int)0x80000000;
    v = imax_(v, dppmovi<0xB1, 0xF>(NI, v)); v = imax_(v, dppmovi<0x4E, 0xF>(NI, v)); v = imax_(v, dppmovi<0x141, 0xF>(NI, v)); return v;
}
__device__ __forceinline__ int ford(float f) { const int b = __builtin_bit_cast(int, f); return b ^ ((b >> 31) & 0x7fffffff); }
__device__ __forceinline__ float funord(int k) { return __builtin_bit_cast(float, k ^ ((k >> 31) & 0x7fffffff)); }
__device__ __forceinline__ float grp8_sum(float v) {
    v += dppmov<0xB1, 0xF>(0.f, v); v += dppmov<0x4E, 0xF>(0.f, v); v += dppmov<0x141, 0xF>(0.f, v); return v;
}
__device__ __forceinline__ float grp8_max(float v) {
    const float NI = -INFINITY;
    v = fmaxf(v, dppmov<0xB1, 0xF>(NI, v)); v = fmaxf(v, dppmov<0x4E, 0xF>(NI, v)); v = fmaxf(v, dppmov<0x141, 0xF>(NI, v)); return v;
}
__device__ __forceinline__ float sigmoidf_(float x) { return __builtin_amdgcn_rcpf(1.f + __expf(-x)); }

struct Args { const float* in[26]; float* out; unsigned char* ws; int ph_lo, ph_hi; };

struct Ctx {
    int tid, lane, wave, bid, nb, gw, ngw;
    unsigned char* ws; float* lds;
};
__device__ __forceinline__ Ctx mkctx(unsigned char* ws, unsigned char* lds_raw) {
    Ctx c; int t = threadIdx.x; asm volatile("" : "+v"(t));
    c.tid = t; c.lane = t & 63; c.wave = __builtin_amdgcn_readfirstlane(t >> 6);
    c.bid = blockIdx.x; c.nb = gridDim.x; c.gw = c.bid * NWAVES + c.wave; c.ngw = c.nb * NWAVES; c.ws = ws; c.lds = (float*)lds_raw; return c;
}

namespace att {
using bf16x8 = __attribute__((ext_vector_type(8))) short;
using s16x4 = __attribute__((ext_vector_type(4))) short;
using f32x16 = __attribute__((ext_vector_type(16))) float;
using u32x4 = __attribute__((ext_vector_type(4))) unsigned;
typedef float f32x2_t __attribute__((ext_vector_type(2))); typedef __bf16 bf16x2_t __attribute__((ext_vector_type(2)));
typedef __attribute__((address_space(3))) const char* lds_cptr;
typedef short v4i16_t __attribute__((ext_vector_type(4)));
constexpr int NT = SEQ / 64;
constexpr int KSLOT = 12288, VSLOT = 8192, NSLOT = 3;
constexpr int LDS_K = 0, LDS_V = NSLOT * KSLOT, LDS_WS = LDS_V + NSLOT * VSLOT, LDS_OST = LDS_WS + NWAVES * 256, LDS_ATT = LDS_OST + NWAVES * 4096;
#define SBAR() __builtin_amdgcn_sched_barrier(0)
#define MFMA(a, b, c) __builtin_amdgcn_mfma_f32_32x32x16_bf16(a, b, c, 0, 0, 0)
__device__ __forceinline__ int crow(int r, int hi) { return (r & 3) + 8 * (r >> 2) + 4 * hi; }
__device__ __forceinline__ unsigned cvtpk_s(float lo, float hi) { f32x2_t v = {lo, hi}; bf16x2_t b = __builtin_convertvector(v, bf16x2_t); return __builtin_bit_cast(unsigned, b); }
__device__ __forceinline__ void glds16(const void* g, unsigned lds_base) {
    unsigned sv; asm volatile("s_mov_b32 %0, m0\n\ts_mov_b32 m0, %2\n\ts_nop 0\n\tglobal_load_lds_dwordx4 %1, off\n\ts_mov_b32 m0, %0" : "=&s"(sv) : "v"(g), "s"(lds_base) : "memory"); }
__device__ __forceinline__ s16x4 vtr(lds_cptr p) { return __builtin_bit_cast(s16x4, __builtin_amdgcn_ds_read_tr16_b64_v4i16((__attribute__((address_space(3))) v4i16_t*)p)); }
#define MX3(a, b, c) __builtin_fmaxf(__builtin_fmaxf((a), (b)), (c))
__device__ __forceinline__ float rowmax(const f32x16& p0, const f32x16& p1) {
    float a = MX3(p0[0], p0[1], p1[0]), b = MX3(p0[2], p0[3], p1[1]); a = MX3(a, p1[2], p1[3]);
#pragma unroll
    for (int r = 4; r < 16; r += 4) { a = MX3(a, p0[r], p0[r + 1]); b = MX3(b, p0[r + 2], p0[r + 3]); a = MX3(a, p1[r], p1[r + 1]); b = MX3(b, p1[r + 2], p1[r + 3]); }
    float m = __builtin_fmaxf(a, b); auto rr = __builtin_amdgcn_permlane32_swap(__float_as_uint(m), __float_as_uint(m), false, false);
    return __builtin_fmaxf(__uint_as_float(rr[0]), __uint_as_float(rr[1])); }

template <int DQK>
__device__ __forceinline__ void unit_simple(const bf16_t* Qh, const bf16_t* __restrict__ Kh, const bf16_t* __restrict__ Vh, bf16_t* Ob, int q0, char* shm) {
    constexpr int NCH = DQK / 8, ND0 = DQK / 16;
    int tid_ = threadIdx.x; asm volatile("" : "+v"(tid_));
    const int tid = tid_, lane = tid & 63, r32 = lane & 31, hi = lane >> 5; const int wid = __builtin_amdgcn_readfirstlane(tid >> 6);
    const bf16_t* Qw = Qh + (size_t)(q0 + wid * 32) * DQK;
    const unsigned lds0 = (unsigned)(uintptr_t)shm; float* wsf = (float*)(shm + LDS_WS) + wid * 64;
    const bf16_t* ksrc0 = Kh + (size_t)lane * DQK + wid * 8;
    const bf16_t* ksrc1 = Kh + (size_t)lane * DQK + (8 + (wid & 3)) * 8;
    const bf16_t* vsrc = Vh + (size_t)(16 * (wid & 3) + (lane >> 2)) * 64 + (wid >> 2) * 32 + (lane & 3) * 8;
    const unsigned kdst0 = lds0 + LDS_K + wid * 1024, kdst1 = lds0 + LDS_K + (8 + (wid & 3)) * 1024, vdst = lds0 + LDS_V + wid * 1024;
#define DMA_KV(t, sl) do { glds16(ksrc0 + (size_t)(t) * 64 * DQK, (unsigned)__builtin_amdgcn_readfirstlane(kdst0 + (sl) * KSLOT)); \
        if (NCH == 12 && wid < 4) glds16(ksrc1 + (size_t)(t) * 64 * DQK, (unsigned)__builtin_amdgcn_readfirstlane(kdst1 + (sl) * KSLOT)); \
        glds16(vsrc + (size_t)(t) * 64 * 64, (unsigned)__builtin_amdgcn_readfirstlane(vdst + (sl) * VSLOT)); } while (0)
    const lds_cptr shm3 = (lds_cptr)shm;
    const lds_cptr vp0 = shm3 + LDS_V + ((lane >> 4) & 1) * 32 + (lane & 3) * 8 + (4 * hi + ((lane & 15) >> 2)) * 64;
    const lds_cptr kp0 = shm3 + LDS_K + hi * 1024 + r32 * 16;
    DMA_KV(0, 0);
    bf16x8 qr[ND0];
#pragma unroll
    for (int d0 = 0; d0 < ND0; ++d0) qr[d0] = *reinterpret_cast<const bf16x8*>(&Qw[(size_t)r32 * DQK + d0 * 16 + hi * 8]);
    float mhat = -INFINITY, l_reg = 0.f; f32x16 o[2]; o[0] = f32x16{}; o[1] = f32x16{};
    asm volatile("s_waitcnt vmcnt(0) lgkmcnt(0)\n\ts_barrier" ::: "memory");
    for (int t = 0; t < NT; ++t) {
        const int sl = t & 1;
        if (t + 1 < NT) DMA_KV(t + 1, sl ^ 1);
        f32x16 p0 = f32x16{}, p1 = f32x16{};
        const lds_cptr kp = kp0 + sl * KSLOT;
#pragma unroll
        for (int d0 = 0; d0 < ND0; ++d0) {
            const bf16x8 b0 = *(const __attribute__((address_space(3))) bf16x8*)(kp + d0 * 2048);
            const bf16x8 b1 = *(const __attribute__((address_space(3))) bf16x8*)(kp + d0 * 2048 + 512);
            p0 = MFMA(b0, qr[d0], p0); p1 = MFMA(b1, qr[d0], p1);
        }
        const float rm = rowmax(p0, p1);
        const float mn = __builtin_fmaxf(mhat, rm), f = __builtin_amdgcn_exp2f(mhat - mn); mhat = mn;
        float sacc = 0.f;
#pragma unroll
        for (int r = 0; r < 16; ++r) { p0[r] = __builtin_amdgcn_exp2f(p0[r] - mn); p1[r] = __builtin_amdgcn_exp2f(p1[r] - mn); sacc += p0[r] + p1[r]; }
        l_reg = l_reg * f + sacc;
        if (hi == 0) wsf[r32] = f;
        asm volatile("s_waitcnt lgkmcnt(0)" ::: "memory");
#pragma unroll
        for (int d_ = 0; d_ < 2; ++d_)
#pragma unroll
            for (int r = 0; r < 16; ++r) o[d_][r] *= wsf[crow(r, hi)];
        u32x4 pw[4];
#pragma unroll
        for (int i = 0; i < 4; ++i) { pw[0][i] = cvtpk_s(p0[2 * i], p0[2 * i + 1]); pw[1][i] = cvtpk_s(p0[8 + 2 * i], p0[8 + 2 * i + 1]); pw[2][i] = cvtpk_s(p1[2 * i], p1[2 * i + 1]); pw[3][i] = cvtpk_s(p1[8 + 2 * i], p1[8 + 2 * i + 1]); }
        const lds_cptr vp_ = vp0 + sl * VSLOT;
#pragma unroll
        for (int d0 = 0; d0 < 2; ++d0)
#pragma unroll
            for (int ks = 0; ks < 4; ++ks) {
                const s16x4 lo = vtr(vp_ + d0 * 4096 + ks * 1024), hh = vtr(vp_ + d0 * 4096 + ks * 1024 + 512);
                const bf16x8 vf = (bf16x8){lo[0], lo[1], lo[2], lo[3], hh[0], hh[1], hh[2], hh[3]};
                o[d0] = MFMA(__builtin_bit_cast(bf16x8, pw[ks]), vf, o[d0]);
            }
        asm volatile("s_waitcnt vmcnt(0) lgkmcnt(0)\n\ts_barrier" ::: "memory");
    }
#undef DMA_KV
    { auto rr = __builtin_amdgcn_permlane32_swap(__float_as_uint(l_reg), __float_as_uint(l_reg), false, false); l_reg = __uint_as_float(rr[0]) + __uint_as_float(rr[1]); }
    if (hi == 0) wsf[32 + r32] = l_reg; asm volatile("s_waitcnt lgkmcnt(0)" ::: "memory");
    float rli[16];
#pragma unroll
    for (int r = 0; r < 16; ++r) rli[r] = __builtin_amdgcn_rcpf(wsf[32 + crow(r, hi)]);
    bf16_t* Ow = Ob + (size_t)(wid * 32) * DM; bf16_t* stg = (bf16_t*)(shm + LDS_OST) + wid * 2048;
#pragma unroll
    for (int r = 0; r < 16; ++r) { const int orow = crow(r, hi);
#pragma unroll
        for (int d0 = 0; d0 < 2; ++d0) stg[orow * 64 + d0 * 32 + r32] = (bf16_t)f2bf(o[d0][r] * rli[r]); }
    asm volatile("s_waitcnt lgkmcnt(0)" ::: "memory");
#pragma unroll
    for (int i = 0; i < 4; ++i) { const int row = i * 8 + (lane >> 3), ch = lane & 7; *(u32x4*)(Ow + (size_t)row * DM + ch * 8) = *(const u32x4*)(stg + row * 64 + ch * 8); }
    asm volatile("s_waitcnt vmcnt(0) lgkmcnt(0)\n\ts_barrier" ::: "memory");
}

constexpr int CONV_LDS = 112640;
struct ConvState { int cj, jbase; const char* wg; const char* wu; const char* wd; char* dgu; char* dd; unsigned ldsbuf; lds_cptr rdbuf; };
struct ConvJob { const char* sbase; char* dbase; unsigned ldwB, KdB; char* tbase; int r0, kl; };
__device__ __forceinline__ int cv_lds_byte(int r, int c) { const int st = (r >> 4) * 2 + (c >> 5), rr = r & 15, cc = c & 31, ob = rr * 64 + cc * 2; return st * 1024 + (ob ^ (((ob >> 9) & 1) << 5)); }
__device__ __forceinline__ int cv_invperm32(int g) { return 16 * ((g >> 2) & 1) + 4 * (g >> 3) + (g & 3); }
__device__ __forceinline__ ConvJob conv_job(const ConvState& cs, int j) {
    const int J = (CONV_MODE >= 5) ? j : cs.jbase + (j < 383 ? j : 383); const int m = J >> 10, r = J & 1023; ConvJob q;
    if (m < 2) { const int g = r >> 7, kg = r & 127; const int drow0 = ((g < 4) ? g * 32 : 256 + (g - 4) * 32) + m * 128;
        q.sbase = (m ? cs.wu : cs.wg) + (size_t)((8 * kg) * EFF + g * 32) * 4; q.ldwB = EFF * 4; q.dbase = cs.dgu + (size_t)(drow0 * DM + 8 * kg) * 2; q.KdB = DM * 2;
        q.tbase = cs.dgu + (size_t)(drow0 >> 8) * (256 * DM * 2) + (size_t)(((drow0 >> 7) & 1) * (DM / 64) + ((8 * kg) >> 6)) * 16384; q.r0 = drow0 & 96; q.kl = (8 * kg) & 63; }
    else { const int g = r >> 5, kg = r & 31;
        q.sbase = cs.wd + (size_t)((8 * kg) * DM + g * 32) * 4; q.ldwB = DM * 4; q.dbase = cs.dd + (size_t)((g * 32) * EFF + 8 * kg) * 2; q.KdB = EFF * 2;
        const int row0 = g * 32; q.tbase = cs.dd + (size_t)(row0 >> 8) * (256 * EFF * 2) + (size_t)(((row0 >> 7) & 1) * (EFF / 64) + ((8 * kg) >> 6)) * 16384; q.r0 = row0 & 96; q.kl = (8 * kg) & 63; }
    return q;
}
__device__ __forceinline__ void glds16_s(const char* sbase, unsigned voff, unsigned lds_base) {
    unsigned sv; asm volatile("s_mov_b32 %0, m0\n\ts_mov_b32 m0, %3\n\ts_nop 4\n\tglobal_load_lds_dwordx4 %1, %2\n\ts_mov_b32 m0, %0" : "=&s"(sv) : "v"(voff), "s"(sbase), "s"(lds_base) : "memory"); }
#if CONV_MODE == 1 || CONV_MODE == 3 || CONV_MODE == 4 || CONV_MODE >= 5
#define CONV_DRAIN() do { const int jd_ = cs.cj - 3; const ConvJob q_ = conv_job(cs, jd_); \
        const __attribute__((address_space(3))) float* bp_ = (const __attribute__((address_space(3))) float*)(cs.rdbuf + (jd_ & 3) * 1024) + (lane >> 5) * 128 + (lane & 31); \
        uint2 w_; w_.x = cvtpk_s(bp_[0], bp_[32]); w_.y = cvtpk_s(bp_[64], bp_[96]); \
        if (CONV_MODE == 1) *(uint2*)(q_.dbase + (size_t)((unsigned)(lane & 31) * q_.KdB + (unsigned)(lane >> 5) * 8u)) = w_; \
        else if (CONV_MODE == 4) *(uint2*)(cs.dgu + 0x30000000ull + (size_t)((unsigned)(lane & 31) * 2048u + (unsigned)(lane >> 5) * 8u + (unsigned)(jd_ & 127) * 16u)) = w_; \
        else asm volatile("" :: "v"(w_)); } while (0)
#else
#define CONV_DRAIN() do { } while (0)
#endif
#if CONV_MODE >= 5
#undef CONV_DRAIN
#define CONV_NSTEP 384
#define CONV_DRAIN() do { if (CONV_MODE == 5 && rst && cs.cj >= 3 && cs.cj < CONV_NSTEP + 3) { const int jb_ = 8 * (cs.cj - 3) + 4 * (wid - 6); const ConvJob q_ = conv_job(cs, jb_); \
          \
        const __attribute__((address_space(3))) float* bp_ = (const __attribute__((address_space(3))) float*)(cs.rdbuf + (jb_ & 31) * 1024) + (lane >> 5) * 512 + (lane & 31); \
        float v_[16]; \
        _Pragma("unroll") for (int i_ = 0; i_ < 16; ++i_) v_[i_] = bp_[i_ * 32]; \
          \
        char* dp_ = q_.tbase + cv_lds_byte(q_.r0 + cv_invperm32(lane & 31), q_.kl + 16 * (lane >> 5)); \
        _Pragma("unroll") for (int i_ = 0; i_ < 2; ++i_) { uint4 w_; w_.x = cvtpk_s(v_[8 * i_], v_[8 * i_ + 1]); w_.y = cvtpk_s(v_[8 * i_ + 2], v_[8 * i_ + 3]); \
            w_.z = cvtpk_s(v_[8 * i_ + 4], v_[8 * i_ + 5]); w_.w = cvtpk_s(v_[8 * i_ + 6], v_[8 * i_ + 7]); *(uint4*)(dp_ + 16 * i_) = w_; } } } while (0)
#define CONV_ISSUE() do { if (CONV_MODE != 6 && rcl && cs.cj < CONV_NSTEP) { const int jb_ = 8 * cs.cj + 4 * (wid - 4); const ConvJob q_ = conv_job(cs, jb_); \
        const unsigned vo_ = (unsigned)(lane >> 3) * q_.ldwB + (unsigned)(lane & 7) * 16u; const unsigned lb_ = (unsigned)__builtin_amdgcn_readfirstlane(cs.ldsbuf + (jb_ & 31) * 1024); \
        glds16_s(q_.sbase, vo_, lb_); glds16_s(q_.sbase + (size_t)8 * q_.ldwB, vo_, lb_ + 1024); glds16_s(q_.sbase + (size_t)16 * q_.ldwB, vo_, lb_ + 2048); glds16_s(q_.sbase + (size_t)24 * q_.ldwB, vo_, lb_ + 3072); } \
        ++cs.cj; } while (0)
#define WAIT_BARL() asm volatile("s_waitcnt lgkmcnt(0)\n\ts_barrier" ::: "memory")
#define RWAIT(N) do { if (rkv) { WAIT_BAR(N); } else if (rcl) { WAIT_BAR(8); } else { WAIT_BARL(); } } while (0)
#elif CONV_MODE != 0
#define CONV_ISSUE() do { const ConvJob q_ = conv_job(cs, cs.cj); \
        glds16_s(q_.sbase, (unsigned)(lane >> 3) * q_.ldwB + (unsigned)(lane & 7) * 16u, (unsigned)__builtin_amdgcn_readfirstlane(cs.ldsbuf + (cs.cj & 3) * 1024)); ++cs.cj; } while (0)
#define WB_P() WAIT_BAR(3)
#define WB_S() WAIT_BAR(4)
#define WB_E1() WAIT_BAR(3)
#define WB_E0() WAIT_BAR(1)
#define WB_PL() WAIT_BAR(4)
#define WB_SL() WAIT_BAR(5)
#else
#define CONV_ISSUE() do { } while (0)
#define WB_P() WAIT_BAR(2)
#define WB_S() WAIT_BAR(2)
#define WB_E1() WAIT_BAR(1)
#define WB_E0() WAIT_BAR(0)
#define WB_PL() WAIT_BAR(3)
#define WB_SL() WAIT_BAR(3)
#endif

constexpr int T_SLOTB = 8192, T_LDS_K = 0, T_LDS_V = 3 * T_SLOTB, T_LDS_WS = 6 * T_SLOTB, T_LDS_OST = T_LDS_WS + NWAVES * 256;
#define WAIT_BAR(N) asm volatile("s_waitcnt vmcnt(" #N ") lgkmcnt(0)\n\ts_barrier" ::: "memory")
__device__ __forceinline__ float max3f(float a, float b, float c) { float r; asm("v_max3_f32 %0, %1, %2, %3" : "=v"(r) : "v"(a), "v"(b), "v"(c)); return r; }
__device__ __forceinline__ float max2f(float a, float b) { float r; asm("v_max_f32_e32 %0, %1, %2" : "=v"(r) : "v"(a), "v"(b)); return r; }
__device__ __forceinline__ float fadd_s(float a, float b) { float r; asm("v_add_f32_e32 %0, %1, %2" : "=v"(r) : "v"(a), "v"(b)); return r; }
__device__ __forceinline__ float fsub_s(float a, float b) { float r; asm("v_sub_f32_e32 %0, %1, %2" : "=v"(r) : "v"(a), "v"(b)); return r; }
__device__ __forceinline__ float rowmax_asm(const f32x16& p0, const f32x16& p1) {
    float a = max3f(p0[0], p0[1], p1[0]), b = max3f(p0[2], p0[3], p1[1]); a = max3f(a, p1[2], p1[3]);
#pragma unroll
    for (int r = 4; r < 16; r += 4) { a = max3f(a, p0[r], p0[r + 1]); b = max3f(b, p0[r + 2], p0[r + 3]); a = max3f(a, p1[r], p1[r + 1]); b = max3f(b, p1[r + 2], p1[r + 3]); }
    const float m = max2f(a, b);
    auto rr = __builtin_amdgcn_permlane32_swap(__float_as_uint(m), __float_as_uint(m), false, false);
    return max2f(__uint_as_float(rr[0]), __uint_as_float(rr[1]));
}
__device__ __forceinline__ void kload8(bf16x8* kf, lds_cptr kp) {
    kf[0] = *(const __attribute__((address_space(3))) bf16x8*)(kp);        kf[1] = *(const __attribute__((address_space(3))) bf16x8*)(kp + 512);
    kf[2] = *(const __attribute__((address_space(3))) bf16x8*)(kp + 2048); kf[3] = *(const __attribute__((address_space(3))) bf16x8*)(kp + 2560);
    kf[4] = *(const __attribute__((address_space(3))) bf16x8*)(kp + 4096); kf[5] = *(const __attribute__((address_space(3))) bf16x8*)(kp + 4608);
    kf[6] = *(const __attribute__((address_space(3))) bf16x8*)(kp + 6144); kf[7] = *(const __attribute__((address_space(3))) bf16x8*)(kp + 6656);
}
__device__ __forceinline__ void kload2(bf16x8* kf, lds_cptr kp, int j) { kf[2 * j] = *(const __attribute__((address_space(3))) bf16x8*)(kp + j * 2048); kf[2 * j + 1] = *(const __attribute__((address_space(3))) bf16x8*)(kp + j * 2048 + 512); }

template <int THRL>
__device__ __forceinline__ void unit64(const bf16_t* Qh, const bf16_t* __restrict__ Kh, const bf16_t* __restrict__ Vh, bf16_t* Ob, float* ostat, int q0, char* shm, ConvState& cs, float mfix) {
    constexpr int DQ = 64;
    int tid_ = threadIdx.x; asm volatile("" : "+v"(tid_));
    const int tid = tid_, lane = tid & 63, r32 = lane & 31, hi = lane >> 5; const int wid = __builtin_amdgcn_readfirstlane(tid >> 6);
    const bf16_t* Qw = Qh + (size_t)(q0 + wid * 32) * DQ;
    const unsigned lds0 = (unsigned)(uintptr_t)shm;
    float* wsf = (float*)(shm + T_LDS_WS) + wid * 64;
#if CONV_MODE >= 5
    const bool rkv = wid < 4, rcl = (wid == 4 || wid == 5), rst = wid >= 6; const int pw = wid & 3;
    const bf16_t* ksrc = Kh + (size_t)lane * DQ + pw * 8;
    const bf16_t* vsrc = Vh + (size_t)(16 * pw + (lane >> 2)) * 64 + (lane & 3) * 8;
    const unsigned kdst = lds0 + T_LDS_K + pw * 1024, vdst = lds0 + T_LDS_V + pw * 1024;
#define DMA_K(t, slot) do { if (rkv) { glds16(ksrc + (size_t)(t) * 64 * DQ, (unsigned)__builtin_amdgcn_readfirstlane(kdst + (slot))); \
        glds16(ksrc + 32 + (size_t)(t) * 64 * DQ, (unsigned)__builtin_amdgcn_readfirstlane(kdst + 4096 + (slot))); } } while (0)
#define DMA_V(t, slot) do { if (rkv) { glds16(vsrc + (size_t)(t) * 64 * 64, (unsigned)__builtin_amdgcn_readfirstlane(vdst + (slot))); \
        glds16(vsrc + 32 + (size_t)(t) * 64 * 64, (unsigned)__builtin_amdgcn_readfirstlane(vdst + 4096 + (slot))); } } while (0)
#define WB_P() RWAIT(4)
#define WB_S() RWAIT(4)
#define WB_E1() RWAIT(2)
#define WB_E0() RWAIT(0)
#else
    const bf16_t* ksrc = Kh + (size_t)lane * DQ + wid * 8;
    const bf16_t* vsrc = Vh + (size_t)(16 * (wid & 3) + (lane >> 2)) * 64 + (wid >> 2) * 32 + (lane & 3) * 8;
    const unsigned kdst = lds0 + T_LDS_K + wid * 1024, vdst = lds0 + T_LDS_V + wid * 1024;
#define DMA_K(t, slot) glds16(ksrc + (size_t)(t) * 64 * DQ, (unsigned)__builtin_amdgcn_readfirstlane(kdst + (slot)))
#define DMA_V(t, slot) glds16(vsrc + (size_t)(t) * 64 * 64, (unsigned)__builtin_amdgcn_readfirstlane(vdst + (slot)))
#endif
    const int vb0 = (int)(lds0 + T_LDS_V) + ((lane >> 4) & 1) * 32 + (lane & 3) * 8 + (4 * hi + ((lane & 15) >> 2)) * 64;
    bf16x8 kf[8];
    const lds_cptr shm3 = (lds_cptr)shm; const lds_cptr kp0 = shm3 + T_LDS_K + hi * 1024 + r32 * 16;
    const lds_cptr vp0 = shm3 + T_LDS_V + ((lane >> 4) & 1) * 32 + (lane & 3) * 8 + (4 * hi + ((lane & 15) >> 2)) * 64;
    DMA_K(0, 0); DMA_V(0, 0); DMA_K(1, T_SLOTB);
    bf16x8 qr[4];
#pragma unroll
    for (int d0 = 0; d0 < 4; ++d0) qr[d0] = *reinterpret_cast<const bf16x8*>(&Qw[(size_t)r32 * DQ + d0 * 16 + hi * 8]);
    float mfo = mfix; asm volatile("" : "+v"(mfo));
    float mhat = mfo, l_reg = 0.f; f32x16 o[2]; o[0] = f32x16{}; o[1] = f32x16{}; f32x16 negm;
#pragma unroll
    for (int r = 0; r < 16; ++r) negm[r] = -mfo;
    asm volatile("" : "+v"(negm));
    bool resc = false;
#define START(P0, P1) do { resc = false; _Pragma("unroll") for (int r = 0; r < 16; ++r) P0[r] = __builtin_amdgcn_exp2f(P0[r]); } while (0)
#define RESC() do { if (resc) { asm volatile("s_waitcnt lgkmcnt(0)" ::: "memory"); \
      _Pragma("unroll") for (int d_ = 0; d_ < 2; ++d_) _Pragma("unroll") for (int r = 0; r < 16; ++r) o[d_][r] *= wsf[crow(r, hi)]; } } while (0)
    f32x16 pA0, pA1, pB0, pB1;
    int sl_prev = 0, sl_cur = 0, sl_next = T_SLOTB;
#define ROT() do { sl_prev = sl_cur; sl_cur = sl_next; sl_next = (sl_next == 2 * T_SLOTB) ? 0 : sl_next + T_SLOTB; } while (0)
    DMA_K(2, 2 * T_SLOTB);
#if CONV_MODE >= 5
    WAIT_BAR(0);
#else
    WAIT_BAR(3);
#endif
    CONV_DRAIN();
    {
        const lds_cptr kb = kp0;
#pragma unroll
        for (int d0 = 0; d0 < 4; ++d0) {
            const bf16x8 b0 = *(const __attribute__((address_space(3))) bf16x8*)(kb + d0 * 2048);
            const bf16x8 b1 = *(const __attribute__((address_space(3))) bf16x8*)(kb + d0 * 2048 + 512);
            if (d0 == 0) { pA0 = MFMA(b0, qr[0], negm); pA1 = MFMA(b1, qr[0], negm); }
            else { pA0 = MFMA(b0, qr[d0], pA0); pA1 = MFMA(b1, qr[d0], pA1); } }
    }
    asm volatile("s_nop 15\n\ts_nop 7" : "+v"(pA0), "+v"(pA1));
    START(pA0, pA1);
#pragma unroll
    for (int r = 0; r < 16; ++r) pA1[r] = __builtin_amdgcn_exp2f(pA1[r]);
    WAIT_BAR(0);
    DMA_K(3, 0); DMA_V(1, T_SLOTB); CONV_ISSUE();
    ROT();
    kload8(kf, kp0 + sl_cur);
    WB_P();
    s16x4 vlo[8], vhi[8]; u32x4 pw0, pw1, pw2, pw3;
#define PKW(P, B) cvtpk_s(P[B], P[B + 1])
#define PAF(k) __builtin_bit_cast(bf16x8, pw##k)
#define VFR(i) (bf16x8){vlo[i][0], vlo[i][1], vlo[i][2], vlo[i][3], vhi[i][0], vhi[i][1], vhi[i][2], vhi[i][3]}
#define PIN(x) asm volatile("" : "+v"(x))
#define GAPA(MF, A0, A1, A2, A3, W0, W1, PW) do { MF; sacc += A0; sacc += A1; sacc += A2; sacc += A3; PIN(sacc); W0; W1; PIN(PW); SBAR(); } while (0)
#define EX(v) __builtin_amdgcn_exp2f(v)
#define GAPB(MF, X, B) do { MF; X[B] = EX(X[B]); X[B + 1] = EX(X[B + 1]); X[B + 2] = EX(X[B + 2]); X[B + 3] = EX(X[B + 3]); PIN(X); SBAR(); } while (0)
#define VRD(i) do { vlo[i] = vtr(vp_ + (((i) >> 2) * 4096 + ((i) & 3) * 1024)); vhi[i] = vtr(vp_ + (((i) >> 2) * 4096 + ((i) & 3) * 1024 + 512)); } while (0)
#define KRD(G, j) do { if (G) { kload2(kf, kp0 + sl_next, j); SBAR(); } } while (0)
#define STEP(C0, C1, P0, P1, t, GK, GV, GL) do { SBAR(); CONV_DRAIN(); SBAR(); \
    const lds_cptr vp_ = vp0 + sl_prev; \
    VRD(0); SBAR(); float sacc = (P0[0] + P0[1]); \
    GAPA(C0 = MFMA(kf[0], qr[0], negm), P0[2], P0[3], P0[4], P0[5],     pw0[0] = PKW(P0, 0), pw0[1] = PKW(P0, 2), pw0); \
    VRD(4); SBAR(); GAPA(C1 = MFMA(kf[1], qr[0], negm), P0[6], P0[7], P0[8], P0[9],     pw0[2] = PKW(P0, 4), pw0[3] = PKW(P0, 6), pw0); \
    VRD(1); SBAR(); GAPA(C0 = MFMA(kf[2], qr[1], C0),   P0[10], P0[11], P0[12], P0[13], pw1[0] = PKW(P0, 8), pw1[1] = PKW(P0, 10), pw1); \
    VRD(5); SBAR(); GAPA(C1 = MFMA(kf[3], qr[1], C1),   P0[14], P0[15], P1[0], P1[1],   pw1[2] = PKW(P0, 12), pw1[3] = PKW(P0, 14), pw1); \
    VRD(2); SBAR(); GAPA(C0 = MFMA(kf[4], qr[2], C0),   P1[2], P1[3], P1[4], P1[5],     pw2[0] = PKW(P1, 0), pw2[1] = PKW(P1, 2), pw2); \
    VRD(6); SBAR(); GAPA(C1 = MFMA(kf[5], qr[2], C1),   P1[6], P1[7], P1[8], P1[9],     pw2[2] = PKW(P1, 4), pw2[3] = PKW(P1, 6), pw2); \
    VRD(3); SBAR(); GAPA(C0 = MFMA(kf[6], qr[3], C0),   P1[10], P1[11], P1[12], P1[13], pw3[0] = PKW(P1, 8), pw3[1] = PKW(P1, 10), pw3); \
    VRD(7); SBAR(); GAPA(C1 = MFMA(kf[7], qr[3], C1),   P1[14], P1[15], 0.f, 0.f,       pw3[2] = PKW(P1, 12), pw3[3] = PKW(P1, 14), pw3); \
    l_reg += sacc; \
    if (GK) { DMA_K((t) + 3, sl_cur); } if (GV) { DMA_V((t) + 1, sl_next); } CONV_ISSUE(); \
    SBAR(); \
    GAPB(o[0] = MFMA(PAF(0), VFR(0), o[0]), C0, 0); \
    GAPB(o[1] = MFMA(PAF(0), VFR(4), o[1]), C0, 4); \
    KRD(GL, 0); GAPB(o[0] = MFMA(PAF(1), VFR(1), o[0]), C0, 8); \
    KRD(GL, 1); GAPB(o[1] = MFMA(PAF(1), VFR(5), o[1]), C0, 12); \
    KRD(GL, 2); GAPB(o[0] = MFMA(PAF(2), VFR(2), o[0]), C1, 0); \
    KRD(GL, 3); GAPB(o[1] = MFMA(PAF(2), VFR(6), o[1]), C1, 4); \
    GAPB(o[0] = MFMA(PAF(3), VFR(3), o[0]), C1, 8); \
    GAPB(o[1] = MFMA(PAF(3), VFR(7), o[1]), C1, 12); \
    } while (0)
    int t = 1;
    for (; t + 5 < NT; t += 2) {
        STEP(pB0, pB1, pA0, pA1, t, true, true, true);     WB_S(); RESC(); ROT();
        STEP(pA0, pA1, pB0, pB1, t + 1, true, true, true); WB_S(); RESC(); ROT();
    }
#define ENDW(tt) do { if ((tt) + 3 < NT) { WB_S(); } else if ((tt) + 2 < NT) { WB_E1(); } else { WB_E0(); } } while (0)
    for (; t + 1 < NT; t += 2) {
        STEP(pB0, pB1, pA0, pA1, t, (t + 3 < NT), (t + 1 < NT), (t + 1 < NT));         ENDW(t);     RESC(); ROT();
        STEP(pA0, pA1, pB0, pB1, t + 1, (t + 4 < NT), (t + 2 < NT), (t + 2 < NT));     ENDW(t + 1); RESC(); ROT();
    }
    STEP(pB0, pB1, pA0, pA1, NT - 1, false, false, false); RESC();
    {
        float sacc = pB0[0] + pB0[1];
#pragma unroll
        for (int r = 2; r < 16; ++r) sacc += pB0[r];
#pragma unroll
        for (int r = 0; r < 16; ++r) sacc += pB1[r];
        l_reg += sacc;
        pw0 = (u32x4){PKW(pB0, 0), PKW(pB0, 2), PKW(pB0, 4), PKW(pB0, 6)}; pw1 = (u32x4){PKW(pB0, 8), PKW(pB0, 10), PKW(pB0, 12), PKW(pB0, 14)};
        pw2 = (u32x4){PKW(pB1, 0), PKW(pB1, 2), PKW(pB1, 4), PKW(pB1, 6)}; pw3 = (u32x4){PKW(pB1, 8), PKW(pB1, 10), PKW(pB1, 12), PKW(pB1, 14)};
        SBAR();
        const lds_cptr vp_ = vp0 + sl_cur;
#pragma unroll
        for (int i = 0; i < 8; ++i) VRD(i);
        o[0] = MFMA(PAF(0), VFR(0), o[0]); o[1] = MFMA(PAF(0), VFR(4), o[1]); o[0] = MFMA(PAF(1), VFR(1), o[0]); o[1] = MFMA(PAF(1), VFR(5), o[1]);
        o[0] = MFMA(PAF(2), VFR(2), o[0]); o[1] = MFMA(PAF(2), VFR(6), o[1]); o[0] = MFMA(PAF(3), VFR(3), o[0]); o[1] = MFMA(PAF(3), VFR(7), o[1]);
    }
#undef PKW
#undef PAF
#undef VFR
#undef PIN
#undef GAPA
#undef GAPB
#undef EX
#undef VRD
#undef KRD
#undef STEP
#undef ENDW
    { auto rr = __builtin_amdgcn_permlane32_swap(__float_as_uint(l_reg), __float_as_uint(l_reg), false, false); l_reg = __uint_as_float(rr[0]) + __uint_as_float(rr[1]); }
    if (hi == 0) wsf[32 + r32] = l_reg; asm volatile("s_waitcnt lgkmcnt(0)" ::: "memory");
    float rli[16];
#pragma unroll
    for (int r = 0; r < 16; ++r) rli[r] = __builtin_amdgcn_rcpf(wsf[32 + crow(r, hi)]);
    bf16_t* Ow = Ob + (size_t)(wid * 32) * DM; bf16_t* stg = (bf16_t*)(shm + T_LDS_OST) + wid * 2048;
#pragma unroll
    for (int r = 0; r < 16; ++r) { const int orow = crow(r, hi);
#pragma unroll
        for (int d0 = 0; d0 < 2; ++d0) stg[orow * 64 + d0 * 32 + r32] = (bf16_t)f2bf(o[d0][r] * rli[r]); }
    asm volatile("s_waitcnt lgkmcnt(0)" ::: "memory");
#pragma unroll
    for (int i = 0; i < 4; ++i) { const int row = i * 8 + (lane >> 3), ch = lane & 7; const u32x4 v = *(const u32x4*)(stg + row * 64 + ch * 8); *(u32x4*)(Ow + (size_t)row * DM + ch * 8) = v;
        float q = 0.f;
#pragma unroll
        for (int d = 0; d < 4; ++d) { const float a = bf2f(v[d] & 0xffffu), bq = bf2f(v[d] >> 16); q += a * a + bq * bq; }
        q += dppmov<0xB1, 0xF>(0.f, q); q += dppmov<0x4E, 0xF>(0.f, q); q += dppmov<0x141, 0xF>(0.f, q);
        if (ch == 0) ostat[(size_t)(wid * 32 + row) * 16] = q; }
    asm volatile("s_waitcnt vmcnt(0) lgkmcnt(0)\n\ts_barrier" ::: "memory");
#if CONV_MODE >= 5
#undef WB_P
#undef WB_S
#undef WB_E1
#undef WB_E0
#endif
#undef DMA_K
#undef DMA_V
#undef START
#undef RESC
#undef ROT
}
constexpr int M_KSLOT = 12288, M_LDS_K = 0, M_LDS_V = 3 * M_KSLOT, M_LDS_WS = M_LDS_V + 3 * T_SLOTB, M_LDS_Q = M_LDS_WS + NWAVES * 256, M_LDS_OST = 0  ;
#define WBAR2() do { if (lowv) { WB_PL(); } else { WB_P(); } } while (0)
#define WBARS() do { if (lowv) { WB_SL(); } else { WB_S(); } } while (0)
template <int THRL>
__device__ __forceinline__ void unit96(const bf16_t* Qh, const bf16_t* __restrict__ Kh, const bf16_t* __restrict__ Vh, bf16_t* Ob, float* ostat, int q0, char* shm, ConvState& cs, float kb2) {
    constexpr int DQ = 96;
    int tid_ = threadIdx.x; asm volatile("" : "+v"(tid_));
    const int tid = tid_, lane = tid & 63, r32 = lane & 31, hi = lane >> 5; const int wid = __builtin_amdgcn_readfirstlane(tid >> 6);
    const bf16_t* Qw = Qh + (size_t)(q0 + wid * 32) * DQ;
    const unsigned lds0 = (unsigned)(uintptr_t)shm;
    float* wsf = (float*)(shm + M_LDS_WS) + wid * 64;
#if CONV_MODE >= 5
    const bool rkv = wid < 4, rcl = (wid == 4 || wid == 5), rst = wid >= 6; const int pw = wid & 3;
    const bf16_t* ksrc = Kh + (size_t)lane * DQ + pw * 8;
    const bool lowv = false;
#else
    const bf16_t* ksrc = Kh + (size_t)lane * DQ + wid * 8;
    const bf16_t* ksrc1 = Kh + (size_t)lane * DQ + (8 + (wid & 3)) * 8;
    const bool lowv = wid < 4;
#endif
#if CONV_MODE >= 5
    const bf16_t* vsrc = Vh + (size_t)(16 * pw + (lane >> 2)) * 64 + (lane & 3) * 8;
    const unsigned kdst = lds0 + M_LDS_K + pw * 1024, vdst = lds0 + M_LDS_V + pw * 1024, qdst = lds0 + M_LDS_Q + wid * 6144;
#define DMA_K(t, slot) do { if (rkv) { glds16(ksrc + (size_t)(t) * 64 * DQ, (unsigned)__builtin_amdgcn_readfirstlane(kdst + (slot))); \
        glds16(ksrc + 32 + (size_t)(t) * 64 * DQ, (unsigned)__builtin_amdgcn_readfirstlane(kdst + 4096 + (slot))); \
        glds16(ksrc + 64 + (size_t)(t) * 64 * DQ, (unsigned)__builtin_amdgcn_readfirstlane(kdst + 8192 + (slot))); } } while (0)
#define DMA_V(t, slot) do { if (rkv) { glds16(vsrc + (size_t)(t) * 64 * 64, (unsigned)__builtin_amdgcn_readfirstlane(vdst + (slot))); \
        glds16(vsrc + 32 + (size_t)(t) * 64 * 64, (unsigned)__builtin_amdgcn_readfirstlane(vdst + 4096 + (slot))); } } while (0)
#undef WBAR2
#undef WBARS
#define WBAR2() RWAIT(5)
#define WBARS() RWAIT(5)
#define WB_E1() RWAIT(2)
#define WB_E0() RWAIT(0)
#else
    const bf16_t* vsrc = Vh + (size_t)(16 * (wid & 3) + (lane >> 2)) * 64 + (wid >> 2) * 32 + (lane & 3) * 8;
    const unsigned kdst = lds0 + M_LDS_K + wid * 1024, kdst1 = lds0 + M_LDS_K + (8 + (wid & 3)) * 1024, vdst = lds0 + M_LDS_V + wid * 1024, qdst = lds0 + M_LDS_Q + wid * 6144;
#define DMA_K(t, slot) do { glds16(ksrc + (size_t)(t) * 64 * DQ, (unsigned)__builtin_amdgcn_readfirstlane(kdst + (slot))); \
        if (lowv) glds16(ksrc1 + (size_t)(t) * 64 * DQ, (unsigned)__builtin_amdgcn_readfirstlane(kdst1 + (slot))); } while (0)
#define DMA_V(t, slot) glds16(vsrc + (size_t)(t) * 64 * 64, (unsigned)__builtin_amdgcn_readfirstlane(vdst + (slot)))
#endif
    const int vb0 = (int)(lds0 + M_LDS_V) + ((lane >> 4) & 1) * 32 + (lane & 3) * 8 + (4 * hi + ((lane & 15) >> 2)) * 64;
    bf16x8 kf[12];
    const lds_cptr shm3 = (lds_cptr)shm; const lds_cptr kp0 = shm3 + M_LDS_K + hi * 1024 + r32 * 16; const lds_cptr qp0 = shm3 + M_LDS_Q + wid * 6144 + lane * 16;
    const lds_cptr vp0 = shm3 + M_LDS_V + ((lane >> 4) & 1) * 32 + (lane & 3) * 8 + (4 * hi + ((lane & 15) >> 2)) * 64;
#pragma unroll
    for (int d0 = 0; d0 < 6; ++d0) glds16(Qw + (size_t)r32 * DQ + d0 * 16 + hi * 8, (unsigned)__builtin_amdgcn_readfirstlane(qdst + d0 * 1024));
    DMA_K(0, 0); DMA_V(0, 0); DMA_K(1, M_KSLOT);
#define QF(d0) (*(const __attribute__((address_space(3))) bf16x8*)(qp0 + (d0) * 1024))
    float mhat = 0.f, l_reg = 0.f; f32x16 o[2]; o[0] = f32x16{}; o[1] = f32x16{}; f32x16 negm = f32x16{}; asm volatile("" : "+v"(negm));
    bool resc = false;
#define START(P0, P1) do { resc = false; _Pragma("unroll") for (int r = 0; r < 16; ++r) P0[r] = __builtin_amdgcn_exp2f(P0[r]); } while (0)
#define RESC() do { if (resc) { asm volatile("s_waitcnt lgkmcnt(0)" ::: "memory"); \
      _Pragma("unroll") for (int d_ = 0; d_ < 2; ++d_) _Pragma("unroll") for (int r = 0; r < 16; ++r) o[d_][r] *= wsf[crow(r, hi)]; } } while (0)
    f32x16 pA0, pA1, pB0, pB1;
    int sl_prev = 0, sl_cur = 0, sl_next = M_KSLOT; int vs_prev = 0, vs_cur = 0, vs_next = T_SLOTB;
#define ROT() do { sl_prev = sl_cur; sl_cur = sl_next; sl_next = (sl_next == 2 * M_KSLOT) ? 0 : sl_next + M_KSLOT; vs_prev = vs_cur; vs_cur = vs_next; vs_next = (vs_next == 2 * T_SLOTB) ? 0 : vs_next + T_SLOTB; } while (0)
    DMA_K(2, 2 * M_KSLOT);
    WAIT_BAR(0);
    {
        float qn = 0.f;
#pragma unroll
        for (int d0 = 0; d0 < 6; ++d0) { const bf16x8 qf = QF(d0);
#pragma unroll
            for (int i = 0; i < 8; ++i) { const float x = bf2f((unsigned short)qf[i]); qn += x * x; } }
        auto rr = __builtin_amdgcn_permlane32_swap(__float_as_uint(qn), __float_as_uint(qn), false, false); qn = __uint_as_float(rr[0]) + __uint_as_float(rr[1]);
        mhat = fminf(sqrtf(qn * kb2) * 1.02f + 0.5f, 60.f);
#pragma unroll
        for (int r = 0; r < 16; ++r) negm[r] = -mhat;
        asm volatile("" : "+v"(negm));
    }
    CONV_DRAIN();
    {
        const lds_cptr kb = kp0;
#pragma unroll
        for (int d0 = 0; d0 < 6; ++d0) {
            const bf16x8 b0 = *(const __attribute__((address_space(3))) bf16x8*)(kb + d0 * 2048);
            const bf16x8 b1 = *(const __attribute__((address_space(3))) bf16x8*)(kb + d0 * 2048 + 512);
            const bf16x8 qf = QF(d0);
            if (d0 == 0) { pA0 = MFMA(b0, qf, negm); pA1 = MFMA(b1, qf, negm); }
            else { pA0 = MFMA(b0, qf, pA0); pA1 = MFMA(b1, qf, pA1); } }
    }
    asm volatile("s_nop 15\n\ts_nop 7" : "+v"(pA0), "+v"(pA1));
    START(pA0, pA1);
#pragma unroll
    for (int r = 0; r < 16; ++r) pA1[r] = __builtin_amdgcn_exp2f(pA1[r]);
    WAIT_BAR(0);
    DMA_K(3, 0); DMA_V(1, T_SLOTB); CONV_ISSUE();
    ROT();
#pragma unroll
    for (int j = 0; j < 6; ++j) kload2(kf, kp0 + sl_cur, j);
    WBAR2();
    s16x4 vlo[8], vhi[8]; u32x4 pw0, pw1, pw2, pw3;
#define PKW(P, B) cvtpk_s(P[B], P[B + 1])
#define PAF(k) __builtin_bit_cast(bf16x8, pw##k)
#define VFR(i) (bf16x8){vlo[i][0], vlo[i][1], vlo[i][2], vlo[i][3], vhi[i][0], vhi[i][1], vhi[i][2], vhi[i][3]}
#define PIN(x) asm volatile("" : "+v"(x))
#define GAPA(MF, A0, A1, A2, A3, W0, W1, PW) do { MF; sacc += A0; sacc += A1; sacc += A2; sacc += A3; PIN(sacc); W0; W1; PIN(PW); SBAR(); } while (0)
#define EX(v) __builtin_amdgcn_exp2f(v)
#define GAPB(MF, X, B) do { MF; X[B] = EX(X[B]); X[B + 1] = EX(X[B + 1]); X[B + 2] = EX(X[B + 2]); X[B + 3] = EX(X[B + 3]); PIN(X); SBAR(); } while (0)
#define VRD(i) do { vlo[i] = vtr(vp_ + (((i) >> 2) * 4096 + ((i) & 3) * 1024)); vhi[i] = vtr(vp_ + (((i) >> 2) * 4096 + ((i) & 3) * 1024 + 512)); } while (0)
#define KRD(G, j) do { if (G) { kload2(kf, kp0 + sl_next, j); SBAR(); } } while (0)
#define STEP(C0, C1, P0, P1, t, GK, GV, GL) do { SBAR(); CONV_DRAIN(); SBAR(); \
    const lds_cptr vp_ = vp0 + vs_prev; \
    bf16x8 qa = QF(0), qb = QF(1); \
    VRD(0); SBAR(); float sacc = (P0[0] + P0[1]); \
    GAPA(C0 = MFMA(kf[0], qa, negm), P0[2], P0[3], P0[4], P0[5],     pw0[0] = PKW(P0, 0), pw0[1] = PKW(P0, 2), pw0); \
    VRD(4); SBAR(); GAPA(C1 = MFMA(kf[1], qa, negm), P0[6], P0[7], P0[8], P0[9],     pw0[2] = PKW(P0, 4), pw0[3] = PKW(P0, 6), pw0); \
    qa = QF(2); VRD(1); SBAR(); GAPA(C0 = MFMA(kf[2], qb, C0),   P0[10], P0[11], P0[12], P0[13], pw1[0] = PKW(P0, 8), pw1[1] = PKW(P0, 10), pw1); \
    VRD(5); SBAR(); GAPA(C1 = MFMA(kf[3], qb, C1),   P0[14], P0[15], P1[0], P1[1],   pw1[2] = PKW(P0, 12), pw1[3] = PKW(P0, 14), pw1); \
    qb = QF(3); VRD(2); SBAR(); GAPA(C0 = MFMA(kf[4], qa, C0),   P1[2], P1[3], P1[4], P1[5],     pw2[0] = PKW(P1, 0), pw2[1] = PKW(P1, 2), pw2); \
    VRD(6); SBAR(); GAPA(C1 = MFMA(kf[5], qa, C1),   P1[6], P1[7], P1[8], P1[9],     pw2[2] = PKW(P1, 4), pw2[3] = PKW(P1, 6), pw2); \
    qa = QF(4); VRD(3); SBAR(); GAPA(C0 = MFMA(kf[6], qb, C0),   P1[10], P1[11], P1[12], P1[13], pw3[0] = PKW(P1, 8), pw3[1] = PKW(P1, 10), pw3); \
    VRD(7); SBAR(); GAPA(C1 = MFMA(kf[7], qb, C1),   P1[14], P1[15], 0.f, 0.f,       pw3[2] = PKW(P1, 12), pw3[3] = PKW(P1, 14), pw3); \
    qb = QF(5); SBAR(); C0 = MFMA(kf[8], qa, C0); C1 = MFMA(kf[9], qa, C1); SBAR(); \
    C0 = MFMA(kf[10], qb, C0); C1 = MFMA(kf[11], qb, C1); SBAR(); \
    l_reg += sacc; \
    if (GK) { DMA_K((t) + 3, sl_cur); } if (GV) { DMA_V((t) + 1, vs_next); } CONV_ISSUE(); \
    SBAR(); \
    GAPB(o[0] = MFMA(PAF(0), VFR(0), o[0]), C0, 0); \
    KRD(GL, 0); GAPB(o[1] = MFMA(PAF(0), VFR(4), o[1]), C0, 4); \
    KRD(GL, 1); GAPB(o[0] = MFMA(PAF(1), VFR(1), o[0]), C0, 8); \
    KRD(GL, 2); GAPB(o[1] = MFMA(PAF(1), VFR(5), o[1]), C0, 12); \
    KRD(GL, 3); GAPB(o[0] = MFMA(PAF(2), VFR(2), o[0]), C1, 0); \
    KRD(GL, 4); GAPB(o[1] = MFMA(PAF(2), VFR(6), o[1]), C1, 4); \
    KRD(GL, 5); GAPB(o[0] = MFMA(PAF(3), VFR(3), o[0]), C1, 8); \
    GAPB(o[1] = MFMA(PAF(3), VFR(7), o[1]), C1, 12); \
    } while (0)
    int t = 1;
    for (; t + 5 < NT; t += 2) {
        STEP(pB0, pB1, pA0, pA1, t, true, true, true);     WBARS(); RESC(); ROT();
        STEP(pA0, pA1, pB0, pB1, t + 1, true, true, true); WBARS(); RESC(); ROT();
    }
#define ENDW(tt) do { if ((tt) + 3 < NT) { WBARS(); } else if ((tt) + 2 < NT) { WB_E1(); } else { WB_E0(); } } while (0)
    for (; t + 1 < NT; t += 2) {
        STEP(pB0, pB1, pA0, pA1, t, (t + 3 < NT), (t + 1 < NT), (t + 1 < NT));         ENDW(t);     RESC(); ROT();
        STEP(pA0, pA1, pB0, pB1, t + 1, (t + 4 < NT), (t + 2 < NT), (t + 2 < NT));     ENDW(t + 1); RESC(); ROT();
    }
    STEP(pB0, pB1, pA0, pA1, NT - 1, false, false, false); RESC();
    {
        float sacc = pB0[0] + pB0[1];
#pragma unroll
        for (int r = 2; r < 16; ++r) sacc += pB0[r];
#pragma unroll
        for (int r = 0; r < 16; ++r) sacc += pB1[r];
        l_reg += sacc;
        pw0 = (u32x4){PKW(pB0, 0), PKW(pB0, 2), PKW(pB0, 4), PKW(pB0, 6)}; pw1 = (u32x4){PKW(pB0, 8), PKW(pB0, 10), PKW(pB0, 12), PKW(pB0, 14)};
        pw2 = (u32x4){PKW(pB1, 0), PKW(pB1, 2), PKW(pB1, 4), PKW(pB1, 6)}; pw3 = (u32x4){PKW(pB1, 8), PKW(pB1, 10), PKW(pB1, 12), PKW(pB1, 14)};
        SBAR();
        const lds_cptr vp_ = vp0 + vs_cur;
#pragma unroll
        for (int i = 0; i < 8; ++i) VRD(i);
        o[0] = MFMA(PAF(0), VFR(0), o[0]); o[1] = MFMA(PAF(0), VFR(4), o[1]); o[0] = MFMA(PAF(1), VFR(1), o[0]); o[1] = MFMA(PAF(1), VFR(5), o[1]);
        o[0] = MFMA(PAF(2), VFR(2), o[0]); o[1] = MFMA(PAF(2), VFR(6), o[1]); o[0] = MFMA(PAF(3), VFR(3), o[0]); o[1] = MFMA(PAF(3), VFR(7), o[1]);
    }
#undef PKW
#undef PAF
#undef VFR
#undef PIN
#undef GAPA
#undef GAPB
#undef EX
#undef VRD
#undef KRD
#undef STEP
#undef ENDW
    { auto rr = __builtin_amdgcn_permlane32_swap(__float_as_uint(l_reg), __float_as_uint(l_reg), false, false); l_reg = __uint_as_float(rr[0]) + __uint_as_float(rr[1]); }
    if (hi == 0) wsf[32 + r32] = l_reg; asm volatile("s_waitcnt lgkmcnt(0)" ::: "memory");
    float rli[16];
#pragma unroll
    for (int r = 0; r < 16; ++r) rli[r] = __builtin_amdgcn_rcpf(wsf[32 + crow(r, hi)]);
    bf16_t* Ow = Ob + (size_t)(wid * 32) * DM; bf16_t* stg = (bf16_t*)(shm + M_LDS_OST) + wid * 2048;
#pragma unroll
    for (int r = 0; r < 16; ++r) { const int orow = crow(r, hi);
#pragma unroll
        for (int d0 = 0; d0 < 2; ++d0) stg[orow * 64 + d0 * 32 + r32] = (bf16_t)f2bf(o[d0][r] * rli[r]); }
    asm volatile("s_waitcnt lgkmcnt(0)" ::: "memory");
#pragma unroll
    for (int i = 0; i < 4; ++i) { const int row = i * 8 + (lane >> 3), ch = lane & 7; const u32x4 v = *(const u32x4*)(stg + row * 64 + ch * 8); *(u32x4*)(Ow + (size_t)row * DM + ch * 8) = v;
        float q = 0.f;
#pragma unroll
        for (int d = 0; d < 4; ++d) { const float a = bf2f(v[d] & 0xffffu), bq = bf2f(v[d] >> 16); q += a * a + bq * bq; }
        q += dppmov<0xB1, 0xF>(0.f, q); q += dppmov<0x4E, 0xF>(0.f, q); q += dppmov<0x141, 0xF>(0.f, q);
        if (ch == 0) ostat[(size_t)(wid * 32 + row) * 16] = q; }
    asm volatile("s_waitcnt vmcnt(0) lgkmcnt(0)\n\ts_barrier" ::: "memory");
#if CONV_MODE >= 5
#undef WB_E1
#undef WB_E0
#endif
#undef QF
#undef DMA_K
#undef DMA_V
#undef START
#undef RESC
#undef ROT
}
#undef WBAR2
#undef WBARS
#undef WAIT_BAR
}


namespace pg8 {
typedef short bf16x8 __attribute__((ext_vector_type(8)));
typedef float f32x4 __attribute__((ext_vector_type(4)));
typedef unsigned u32x4 __attribute__((ext_vector_type(4)));
constexpr int BM = 256, BK = 64, HALF = 128, HTB = HALF * BK * 2, STAGE_BYTES = 8 * HTB, NXCD = 8, WGM = 8;
__host__ __device__ __forceinline__ int lds_byte(int r, int c) { const int st = (r >> 4) * 2 + (c >> 5), rr = r & 15, cc = c & 31, ob = rr * 64 + cc * 2; return st * 1024 + (ob ^ (((ob >> 9) & 1) << 5)); }
__host__ __device__ __forceinline__ void stage_rc(int b, int& R, int& C) { const int st = b / 1024, sb = b % 1024, swz = sb ^ (((sb >> 9) & 1) << 5); R = (st >> 1) * 16 + swz / 64; C = (st & 1) * 32 + (swz % 64) / 2; }
__host__ __device__ __forceinline__ int perm32(int rho) { const int n = rho >> 4, i = rho & 15; return 8 * (i >> 2) + 4 * n + (i & 3); }
__device__ __forceinline__ unsigned cvt_pk_bf16(float lo, float hi) { unsigned r; asm volatile("v_cvt_pk_bf16_f32 %0, %1, %2" : "=v"(r) : "v"(lo), "v"(hi)); return r; }

struct Unit { int pm, pn, e, nrows, rowbase; };

struct DenseOrder {
    int nM, nN, nwg, G, c, K; const char* Bt; bool tiled;
    __device__ void init(int M, int N, int K_, const bf16_t* Bt_, int G_, int c_, bool tiled_ = false) { nM = M / BM; nN = N / BM; nwg = nM * nN; G = G_; c = c_; K = K_; Bt = (const char*)Bt_; tiled = tiled_; }
    __device__ __forceinline__ bool next(int i, Unit& u) const {
        const long L = (long)i * G + c; if (L >= nwg) return false;
        int wgid = (int)L; { const int q = nwg / NXCD, r = nwg % NXCD, xcd = wgid % NXCD, off = wgid / NXCD; wgid = (xcd < r ? xcd * (q + 1) : r * (q + 1) + (xcd - r) * q) + off; }
        const int nig = WGM * nN, gid = wgid / nig, fm = gid * WGM, gsz = (nM - fm) < WGM ? (nM - fm) : WGM;
        u.pm = fm + ((wgid % nig) % gsz); u.pn = (wgid % nig) / gsz; u.e = 0; u.nrows = 256; u.rowbase = u.pm * BM; return true;
    }
    __device__ __forceinline__ void a_offsets(const Unit&, int, unsigned (&)[2][2]) const {}
    __device__ __forceinline__ void a_rows_dma(const Unit&, int, LAS unsigned char*) const {}
    __device__ __forceinline__ bool b_tiled() const { return tiled; }
    __device__ __forceinline__ void a_offsets_lds(int, const LAS unsigned char*, unsigned (&)[2][2]) const {}
    __device__ __forceinline__ const char* b_tile(const Unit& u) const { return Bt + (size_t)u.pn * BM * K * 2; }
};

struct EpiBf16 {
    static constexpr bool PERM = true;
    bf16_t* O; int ldc;
    __device__ __forceinline__ void operator()(const f32x4 (&acc)[2][2][4][2], const Unit& u, int wr, int wc, int fr, int fq) const {
        const int row0 = u.pm * BM + wr * 64 + fr, col0 = u.pn * BM + wc * 32 + 8 * fq;
#pragma unroll
        for (int ai = 0; ai < 2; ++ai)
#pragma unroll
            for (int m = 0; m < 4; ++m) { bf16_t* rowp = O + (size_t)(row0 + ai * HALF + m * 16) * ldc + col0;
#pragma unroll
                for (int bj = 0; bj < 2; ++bj) { const f32x4 v0 = acc[ai][bj][m][0], v1 = acc[ai][bj][m][1];
                    u32x4 w; w.x = cvt_pk_bf16(v0[0], v0[1]); w.y = cvt_pk_bf16(v0[2], v0[3]); w.z = cvt_pk_bf16(v1[0], v1[1]); w.w = cvt_pk_bf16(v1[2], v1[3]);
                    *(u32x4*)(rowp + bj * HALF) = w; } }
    }
};


__device__ __forceinline__ float silu_mul(float g, float u) { return g * __builtin_amdgcn_rcpf(1.f + __expf(-g)) * u; }

struct MoeOrder {
    const LAS int* pre; const LAS int* offs; const LAS int* cntl; const int* list; const char* Bt; size_t bstride; int K, npn, G, c, mode;
    bool tiled;
    __device__ __forceinline__ bool b_tiled() const { return tiled; }
    const LAS int* utab;
    static __device__ __forceinline__ int search(const LAS int* pre, int rtg) {
        int lo_ = 0, hi_ = NE;
        while (hi_ - lo_ > 1) { const int mid = (lo_ + hi_) >> 1; if (pre[mid] <= rtg) lo_ = mid; else hi_ = mid; }
        return lo_;
    }
    static __device__ __forceinline__ void fill_table(LAS int* tab, const LAS int* pre, int npn, int G, int c, int t) {
        const int L = t * G + c, total = pre[NE] * npn; int v = -1;
        if (L < total) { const int rtg = L / npn; const int e = search(pre, rtg); v = (e << 16) | (rtg - pre[e]); }
        tab[t] = v;
    }
    __device__ __forceinline__ bool next(int i, Unit& u) const {
        const int L = i * G + c; int e, pm, pn;
        if (i < 16) { const int v = utab[i]; if (v < 0) return false; e = v >> 16; pm = v & 0xffff; pn = L % npn; }
        else { const int total = pre[NE] * npn; if (L >= total) return false;
            const int rtg = L / npn; pn = L - rtg * npn; e = search(pre, rtg); pm = rtg - pre[e]; }
        const int n = cntl[e] - pm * BM;
        u.e = __builtin_amdgcn_readfirstlane(e); u.pm = __builtin_amdgcn_readfirstlane(pm); u.pn = __builtin_amdgcn_readfirstlane(pn);
        u.nrows = __builtin_amdgcn_readfirstlane(n < BM ? n : BM); u.rowbase = __builtin_amdgcn_readfirstlane(offs[e] + pm * BM); return true;
    }
    __device__ __forceinline__ void a_offsets(const Unit& u, int tid, unsigned (&ua)[2][2]) const {
#pragma unroll
        for (int i = 0; i < 2; ++i) { int R, C; stage_rc(tid * 16 + i * 8192, R, C);
#pragma unroll
            for (int h = 0; h < 2; ++h) { int r = h * HALF + R; if (r >= u.nrows) r = 0; const int row = list[(size_t)u.e * LCAP + u.pm * BM + r] >> 3;
                ua[h][i] = (unsigned)((row * K + C) * 2); } }
    }
    __device__ __forceinline__ void a_rows_dma(const Unit& u, int tid, LAS unsigned char* lst) const {
        const int wv = __builtin_amdgcn_readfirstlane(tid >> 6);
#pragma unroll
        for (int i = 0; i < 2; ++i) { int R, C; stage_rc(tid * 16 + i * 8192, R, C);
#pragma unroll
            for (int h = 0; h < 2; ++h) { int r = h * HALF + R; if (r >= u.nrows) r = 0;
                __builtin_amdgcn_global_load_lds((const unsigned*)&list[(size_t)u.e * LCAP + u.pm * BM + r], (LAS unsigned*)(lst + ((2 * h + i) * 8 + wv) * 256), 4, 0, 0); } }
    }
    __device__ __forceinline__ void a_offsets_lds(int tid, const LAS unsigned char* lst, unsigned (&ua)[2][2]) const {
        const int wv = tid >> 6, ln = tid & 63;
#pragma unroll
        for (int i = 0; i < 2; ++i) { int R, C; stage_rc(tid * 16 + i * 8192, R, C);
#pragma unroll
            for (int h = 0; h < 2; ++h) { const int row = *(const LAS int*)(lst + ((2 * h + i) * 8 + wv) * 256 + ln * 4) >> 3; ua[h][i] = (unsigned)((row * K + C) * 2); } }
    }
    __device__ __forceinline__ const char* b_tile(const Unit& u) const { return Bt + (size_t)u.e * bstride + (size_t)u.pn * BM * K * 2; }
};

struct EpiAct {
    static constexpr bool PERM = true;
    bf16_t* ACT;
    __device__ __forceinline__ void operator()(const f32x4 (&acc)[2][2][4][2], const Unit& u, int wr, int wc, int fr, int fq) const {
        const __amdgpu_buffer_rsrc_t rs = __builtin_amdgcn_make_buffer_rsrc((void*)ACT, 0, (NTOK * TOPK + 256) * EFF * 2, 0x00020000);
        const unsigned cb = (unsigned)((u.pn * HALF + wc * 32 + 8 * fq) * 2);
#pragma unroll
        for (int ai = 0; ai < 2; ++ai)
#pragma unroll
            for (int m = 0; m < 4; ++m) { const int r = ai * HALF + wr * 64 + m * 16 + fr;
                const unsigned off = (r < u.nrows) ? (unsigned)(u.rowbase + r) * (EFF * 2) + cb : 0xFFFFFFF0u;
                const f32x4 g0 = acc[ai][0][m][0], g1 = acc[ai][0][m][1], u0 = acc[ai][1][m][0], u1 = acc[ai][1][m][1];
                u32x4 w; w.x = cvt_pk_bf16(silu_mul(g0[0], u0[0]), silu_mul(g0[1], u0[1])); w.y = cvt_pk_bf16(silu_mul(g0[2], u0[2]), silu_mul(g0[3], u0[3]));
                w.z = cvt_pk_bf16(silu_mul(g1[0], u1[0]), silu_mul(g1[1], u1[1])); w.w = cvt_pk_bf16(silu_mul(g1[2], u1[2]), silu_mul(g1[3], u1[3]));
                __builtin_amdgcn_raw_buffer_store_b128(w, rs, off, 0, 0); }
    }
};
struct EpiSlots {
    static constexpr bool PERM = true;
    unsigned char* SL;
    __device__ __forceinline__ void operator()(const f32x4 (&acc)[2][2][4][2], const Unit& u, int wr, int wc, int fr, int fq) const {
        const __amdgpu_buffer_rsrc_t rs = __builtin_amdgcn_make_buffer_rsrc((void*)SL, 0, NTOK * TOPK * DM, 0x00020000);
        const unsigned cb = (unsigned)(u.pn * BM + wc * 32 + 8 * (fq & ~1));
#pragma unroll
        for (int ai = 0; ai < 2; ++ai)
#pragma unroll
            for (int mp = 0; mp < 4; mp += 2) { const int r = ai * HALF + wr * 64 + (mp + (fq & 1)) * 16 + fr;
                const unsigned off = (r < u.nrows) ? (unsigned)(u.rowbase + r) * DM + cb : 0xFFFFFFF0u;
#pragma unroll
                for (int bj = 0; bj < 2; ++bj) {
                    unsigned w[2][2];
#pragma unroll
                    for (int q = 0; q < 2; ++q) { const f32x4 v0 = acc[ai][bj][mp + q][0] * 16.f, v1 = acc[ai][bj][mp + q][1] * 16.f;
                        int lo = __builtin_amdgcn_cvt_pk_fp8_f32(v0[0], v0[1], 0, false); lo = __builtin_amdgcn_cvt_pk_fp8_f32(v0[2], v0[3], lo, true);
                        int hi = __builtin_amdgcn_cvt_pk_fp8_f32(v1[0], v1[1], 0, false); hi = __builtin_amdgcn_cvt_pk_fp8_f32(v1[2], v1[3], hi, true);
                        w[q][0] = (unsigned)lo; w[q][1] = (unsigned)hi; }
                    const auto sx = __builtin_amdgcn_permlane16_swap(w[0][0], w[1][0], false, false);
                    const auto sy = __builtin_amdgcn_permlane16_swap(w[0][1], w[1][1], false, false);
                    __builtin_amdgcn_raw_buffer_store_b128((u32x4){sx[0], sy[0], sx[1], sy[1]}, rs, off, bj * HALF, 0); } }
    }
};
struct EpiRS {
    static constexpr bool PERM = true;
    float* LOG; bf16_t* ACTS;
    __device__ __forceinline__ void operator()(const f32x4 (&acc)[2][2][4][2], const Unit& u, int wr, int wc, int fr, int fq) const {
        const int row0 = u.pm * BM + wr * 64 + fr;
#pragma unroll
        for (int ai = 0; ai < 2; ++ai)
#pragma unroll
            for (int m = 0; m < 4; ++m) { const int row = row0 + ai * HALF + m * 16;
                if (u.pn == 0) {
#pragma unroll
                    for (int bj = 0; bj < 2; ++bj) { float* lp = LOG + (size_t)row * NE + bj * HALF + wc * 32 + 8 * fq; *(f32x4*)lp = acc[ai][bj][m][0]; *(f32x4*)(lp + 4) = acc[ai][bj][m][1]; }
                } else {
                    const f32x4 g0 = acc[ai][0][m][0], g1 = acc[ai][0][m][1], u0 = acc[ai][1][m][0], u1 = acc[ai][1][m][1];
                    u32x4 w; w.x = cvt_pk_bf16(silu_mul(g0[0], u0[0]), silu_mul(g0[1], u0[1])); w.y = cvt_pk_bf16(silu_mul(g0[2], u0[2]), silu_mul(g0[3], u0[3]));
                    w.z = cvt_pk_bf16(silu_mul(g1[0], u1[0]), silu_mul(g1[1], u1[1])); w.w = cvt_pk_bf16(silu_mul(g1[2], u1[2]), silu_mul(g1[3], u1[3]));
                    *(u32x4*)(ACTS + (size_t)row * EFF + (u.pn - 1) * HALF + wc * 32 + 8 * fq) = w; } }
    }
};

struct EpiBf16RowScale {
    static constexpr bool PERM = true;
    bf16_t* O; int ldc; const LAS float* rtab;
    __device__ __forceinline__ void operator()(const f32x4 (&acc)[2][2][4][2], const Unit& u, int wr, int wc, int fr, int fq) const {
        const int row0 = u.pm * BM + wr * 64 + fr, col0 = u.pn * BM + wc * 32 + 8 * fq;
#pragma unroll
        for (int ai = 0; ai < 2; ++ai)
#pragma unroll
            for (int m = 0; m < 4; ++m) { const int row = row0 + ai * HALF + m * 16; bf16_t* rowp = O + (size_t)row * ldc + col0;
                const float g = rtab[2 * (row - u.pm * BM) + 1];
#pragma unroll
                for (int bj = 0; bj < 2; ++bj) { const f32x4 v0 = acc[ai][bj][m][0] * g, v1 = acc[ai][bj][m][1] * g;
                    u32x4 w; w.x = cvt_pk_bf16(v0[0], v0[1]); w.y = cvt_pk_bf16(v0[2], v0[3]); w.z = cvt_pk_bf16(v1[0], v1[1]); w.w = cvt_pk_bf16(v1[2], v1[3]);
                    *(u32x4*)(rowp + bj * HALF) = w; } }
    }
};

template <class Epi, class Sched, bool ALIGN_EPI, bool GATHER = false, bool MIDSCALE = false>
__device__ __forceinline__ void gemm_phase(LAS unsigned char* lds, const bf16_t* Abase_, int K, const Sched& S, const Epi& E, const float* stat = nullptr) {
    int tid_ = threadIdx.x; asm volatile("" : "+v"(tid_));
    const int tid = tid_, wid = __builtin_amdgcn_readfirstlane(tid >> 6), lane = tid & 63, wr = wid >> 2, wc = wid & 3, fr = lane & 15, fq = lane >> 4;
    const int nt = K / BK;
    const char* Abase = (const char*)Abase_;
    unsigned voffB[2], voffA[2];
    const bool btile = S.b_tiled();
#pragma unroll
    for (int i = 0; i < 2; ++i) { int R, C; stage_rc(tid * 16 + i * 8192, R, C); const int Rb = Epi::PERM ? ((R & ~31) + perm32(R & 31)) : R; voffB[i] = btile ? (unsigned)(tid * 16 + i * 8192) : (unsigned)(Rb * K + C) * 2u; voffA[i] = (unsigned)(R * K + C) * 2u; }
    const size_t kstep = (size_t)(BK * 2);
    const size_t kstepB = btile ? (size_t)HTB : kstep;
    const size_t hstep = (size_t)HALF * K * 2;
    const unsigned ldsw = (unsigned)wid * 1024u;
    const int aoff = lds_byte(wr * 64 + fr, fq * 8), boff = lds_byte(wc * 32 + fr, fq * 8);
#define PG8_SA(b, h) (((b) * 2 + (h)) * HTB)
#define PG8_SB(b, h) ((4 + (b) * 2 + (h)) * HTB)
#define PG8_STAGE_B(bufoff, gbase) do { _Pragma("unroll") for (int _i = 0; _i < 2; ++_i) \
        __builtin_amdgcn_global_load_lds((const unsigned*)((const char*)(gbase) + voffB[_i]), (LAS unsigned*)(lds + (bufoff) + ldsw + _i * 8192), 16, 0, 0); } while (0)
#define PG8_STAGE_A(bufoff, ua, pa, h, koff) do { _Pragma("unroll") for (int _i = 0; _i < 2; ++_i) { \
        const char* _g = GATHER ? (Abase + (size_t)(ua)[h][_i] + (koff)) : ((pa) + (size_t)(h) * hstep + voffA[_i] + (koff)); \
        __builtin_amdgcn_global_load_lds((const unsigned*)_g, (LAS unsigned*)(lds + (bufoff) + ldsw + _i * 8192), 16, 0, 0); } } while (0)
#define PG8_LDA(dst, b, h) do { _Pragma("unroll") for (int m = 0; m < 4; ++m) _Pragma("unroll") for (int k = 0; k < 2; ++k) dst[m][k] = *(const LAS bf16x8*)(lds + PG8_SA(b, h) + aoff + m * 2048 + k * 1024); } while (0)
#define PG8_LDB(dst, b, h) do { _Pragma("unroll") for (int n = 0; n < 2; ++n) _Pragma("unroll") for (int k = 0; k < 2; ++k) dst[n][k] = *(const LAS bf16x8*)(lds + PG8_SB(b, h) + boff + n * 2048 + k * 1024); } while (0)
#define PG8_MMA(ai, bj, At, Bt) do { __builtin_amdgcn_s_setprio(1); _Pragma("unroll") for (int m = 0; m < 4; ++m) _Pragma("unroll") for (int n = 0; n < 2; ++n) _Pragma("unroll") for (int k = 0; k < 2; ++k) \
        acc[ai][bj][m][n] = __builtin_amdgcn_mfma_f32_16x16x32_bf16(Bt[n][k], At[m][k], acc[ai][bj][m][n], 0, 0, 0); __builtin_amdgcn_s_setprio(0); } while (0)
#define PG8_WAIT_V(n) asm volatile("s_waitcnt vmcnt(" #n ")" ::: "memory")
#define PG8_WAIT_L(n) asm volatile("s_waitcnt lgkmcnt(" #n ")" ::: "memory")
#define PG8_BAR __builtin_amdgcn_s_barrier()
#define PG8_SCHED __builtin_amdgcn_sched_barrier(0)
    Unit cur, nxt; int ui = 0;
    if (!S.next(0, cur)) return;
    f32x4 acc[2][2][4][2];
#pragma unroll
    for (int a = 0; a < 2; ++a)
#pragma unroll
        for (int b = 0; b < 2; ++b)
#pragma unroll
            for (int m = 0; m < 4; ++m)
#pragma unroll
                for (int n = 0; n < 2; ++n) acc[a][b][m][n] = (f32x4){0.f, 0.f, 0.f, 0.f};
    bf16x8 At[4][2], B0[2][2], B1[2][2];
    unsigned uc[2][2], un[2][2];
    if constexpr (GATHER) S.a_offsets(cur, tid, uc);
    const char* cA = Abase + (size_t)cur.rowbase * K * 2;
    const char* cB = S.b_tile(cur);
    PG8_STAGE_B(PG8_SB(0, 0), cB); PG8_STAGE_B(PG8_SB(0, 1), cB + hstep); PG8_STAGE_A(PG8_SA(0, 0), uc, cA, 0, (size_t)0); PG8_STAGE_A(PG8_SA(0, 1), uc, cA, 1, (size_t)0);
    if (wr == 1) PG8_BAR;
    PG8_WAIT_V(2); PG8_BAR;
    PG8_STAGE_B(PG8_SB(1, 0), cB + kstepB); PG8_STAGE_A(PG8_SA(1, 0), uc, cA, 0, kstep); PG8_STAGE_B(PG8_SB(1, 1), cB + hstep + kstepB);
    PG8_WAIT_V(6); PG8_BAR;
    for (;;) {
        const bool has_next = S.next(ui + 1, nxt);
        const bool lower = cur.nrows > wr * 64, upper = cur.nrows > HALF + wr * 64;
        const char* nB = cB; const char* nA = cA;
        if (has_next) { if constexpr (GATHER) S.a_rows_dma(nxt, tid, lds + STAGE_BYTES + 4096); nB = S.b_tile(nxt); nA = Abase + (size_t)nxt.rowbase * K * 2; }
        else if constexpr (GATHER) {
#pragma unroll
            for (int h = 0; h < 2; ++h)
#pragma unroll
                for (int i = 0; i < 2; ++i) un[h][i] = uc[h][i];
        }
#pragma unroll 1
        for (int t = 0; t < nt; t += 2) {
            const bool last = (t == nt - 2);
            const size_t k1 = (size_t)(t + 1) * kstep;
            const size_t k2 = last ? (size_t)0 : (size_t)(t + 2) * kstep, k3 = k2 + kstep;
            const char* b2 = last ? nB : cB + (size_t)(t + 2) * kstepB; const char* b3 = b2 + kstepB;
            const char* a2 = last ? nA : cA;
            unsigned x2[2][2];
            if constexpr (GATHER) {
#pragma unroll
                for (int h = 0; h < 2; ++h)
#pragma unroll
                    for (int i = 0; i < 2; ++i) x2[h][i] = uc[h][i];
                if (last) { asm volatile("; next unit's A offsets" ::: "memory");
                    if (has_next) S.a_offsets_lds(tid, lds + STAGE_BYTES + 4096, un);
#pragma unroll
                    for (int h = 0; h < 2; ++h)
#pragma unroll
                        for (int i = 0; i < 2; ++i) x2[h][i] = un[h][i]; }
            }
            if constexpr (MIDSCALE) { if (t == nt / 2) {
#pragma unroll
                for (int ai = 0; ai < 2; ++ai)
#pragma unroll
                    for (int m = 0; m < 4; ++m) { const float f = ((const LAS float*)(lds + STAGE_BYTES))[2 * (ai * HALF + wr * 64 + m * 16 + fr)];
#pragma unroll
                        for (int bj = 0; bj < 2; ++bj)
#pragma unroll
                            for (int n = 0; n < 2; ++n) acc[ai][bj][m][n] *= f; } } }
            PG8_LDB(B0, 0, 0); PG8_LDB(B1, 0, 1); PG8_SCHED; PG8_LDA(At, 0, 0); PG8_STAGE_A(PG8_SA(1, 1), uc, cA, 1, k1);
            PG8_WAIT_V(8); PG8_WAIT_L(0); PG8_BAR; if (lower) { PG8_MMA(0, 0, At, B0); PG8_MMA(0, 1, At, B1); } PG8_BAR; PG8_SCHED;
            PG8_LDA(At, 0, 1); PG8_STAGE_B(PG8_SB(0, 0), b2); PG8_STAGE_B(PG8_SB(0, 1), b2 + hstep); PG8_STAGE_A(PG8_SA(0, 0), x2, a2, 0, k2);
            PG8_WAIT_V(8); PG8_WAIT_L(0); PG8_BAR; if (upper) { PG8_MMA(1, 0, At, B0); PG8_MMA(1, 1, At, B1); } PG8_BAR; PG8_SCHED;
            PG8_LDB(B0, 1, 0); PG8_LDB(B1, 1, 1); PG8_SCHED; PG8_LDA(At, 1, 0); PG8_STAGE_A(PG8_SA(0, 1), x2, a2, 1, k2);
            PG8_WAIT_V(8); PG8_WAIT_L(0); PG8_BAR; if (lower) { PG8_MMA(0, 0, At, B0); PG8_MMA(0, 1, At, B1); } PG8_BAR; PG8_SCHED;
            PG8_LDA(At, 1, 1); PG8_STAGE_B(PG8_SB(1, 0), b3); PG8_STAGE_B(PG8_SB(1, 1), b3 + hstep); PG8_STAGE_A(PG8_SA(1, 0), x2, a2, 0, k3);
            PG8_WAIT_V(8); PG8_WAIT_L(0); PG8_BAR; if (upper) { PG8_MMA(1, 0, At, B0); PG8_MMA(1, 1, At, B1); } PG8_BAR; PG8_SCHED;
        }
        if constexpr (ALIGN_EPI) { if (wr == 0) PG8_BAR; }
        E(acc, cur, wr, wc, fr, fq);
        if (!has_next) break;
#pragma unroll
        for (int a = 0; a < 2; ++a)
#pragma unroll
            for (int b = 0; b < 2; ++b)
#pragma unroll
                for (int m = 0; m < 4; ++m)
#pragma unroll
                    for (int n = 0; n < 2; ++n) acc[a][b][m][n] = (f32x4){0.f, 0.f, 0.f, 0.f};
        cur = nxt; cB = nB; cA = nA; ++ui;
        if constexpr (GATHER) {
#pragma unroll
            for (int h = 0; h < 2; ++h)
#pragma unroll
                for (int i = 0; i < 2; ++i) uc[h][i] = un[h][i];
        }
        if constexpr (ALIGN_EPI) { if (wr == 1) PG8_BAR; }
    }
    PG8_WAIT_V(0);
    if constexpr (!ALIGN_EPI) { if (wr == 0) PG8_BAR; }
    PG8_BAR;
#undef PG8_SA
#undef PG8_SB
#undef PG8_STAGE_A
#undef PG8_STAGE_B
#undef PG8_LDA
#undef PG8_LDB
#undef PG8_MMA
#undef PG8_WAIT_V
#undef PG8_WAIT_L
#undef PG8_BAR
#undef PG8_SCHED
}
}

__device__ __forceinline__ void cvt_item(const float* W, int ldw, int col0, int k0, bf16_t* WT, int drow0, int Kd, const float* gk, LAS float* scr, int lane, bool tiled = false) {
    const int kr = lane >> 3, n4 = lane & 7;
    float4 v[8];
#pragma unroll
    for (int i = 0; i < 8; ++i) v[i] = *(const float4*)&W[(size_t)(k0 + 8 * i + kr) * ldw + col0 + 4 * n4];
#pragma unroll
    for (int i = 0; i < 8; ++i) { const int kk = 8 * i + kr; const float g = gk ? gk[k0 + kk] : 1.f; LAS float* d = scr + kk * 33 + 4 * n4;
        d[0] = v[i].x * g; d[1] = v[i].y * g; d[2] = v[i].z * g; d[3] = v[i].w * g; }
    asm volatile("s_waitcnt lgkmcnt(0)" ::: "memory");
    const int cch = lane & 7;
#pragma unroll
    for (int j = 0; j < 4; ++j) { const int n = (lane >> 3) + 8 * j; const LAS float* sp = scr + (8 * cch) * 33 + n;
        uint4 o; o.x = pk2(sp[0 * 33], sp[1 * 33]); o.y = pk2(sp[2 * 33], sp[3 * 33]); o.z = pk2(sp[4 * 33], sp[5 * 33]); o.w = pk2(sp[6 * 33], sp[7 * 33]);
        if (!tiled) *(uint4*)(WT + (size_t)(drow0 + n) * Kd + k0 + 8 * cch) = o;
        else { const int row = drow0 + n, nl = row & 127, R = (nl & ~31) + att::cv_invperm32(nl & 31);
            *(uint4*)((char*)WT + (size_t)(row >> 8) * (256 * Kd * 2) + (size_t)(((row >> 7) & 1) * (Kd / 64) + (k0 >> 6)) * 16384 + att::cv_lds_byte(R, 8 * cch)) = o; } }
    asm volatile("s_waitcnt lgkmcnt(0)" ::: "memory");
}
#define PHASE_PTRS \
    unsigned long long wsi_ = (unsigned long long)args.ws; asm volatile("" : "+s"(wsi_)); \
    unsigned char* wsp = (unsigned char*)(__attribute__((address_space(1))) unsigned char*)wsi_;        \
    const float* x = args.in[0]; const float* cvec = args.in[1]; const float* w_ada = args.in[2]; const float* b_ada = args.in[3]; \
    const float* g_pre_mix = args.in[4]; const float* g_post_mix = args.in[5]; const float* g_pre_ffn = args.in[6]; const float* g_post_ffn = args.in[7]; \
    const float* w_in = args.in[8]; const float* g_q_a = args.in[9]; const float* w_q_b = args.in[10]; const float* g_kv_a = args.in[11]; const float* w_kv_b = args.in[12]; \
    const float* g_q_head = args.in[13]; const float* g_k_head = args.in[14]; const float* g_mla_out = args.in[15]; const float* g_gqa_out = args.in[16]; \
    const float* w_out = args.in[17]; const float* w_router = args.in[18]; const float* b_router = args.in[19]; \
    const float* w_gate_e = args.in[20]; const float* w_up_e = args.in[21]; const float* w_down_e = args.in[22]; \
    const float* w_gate_s = args.in[23]; const float* w_up_s = args.in[24]; const float* w_down_s = args.in[25]; \
    float* mod = (float*)(wsp + WS_MOD); \
    float* cosm = (float*)(wsp + WS_COSM); float* sinm = (float*)(wsp + WS_SINM); float* cosg = (float*)(wsp + WS_COSG); float* sing = (float*)(wsp + WS_SING); \
    bf16_t* H2 = (bf16_t*)(wsp + WS_H2); \
    bf16_t* QM = (bf16_t*)(wsp + WS_QM); bf16_t* KM = (bf16_t*)(wsp + WS_KM); bf16_t* VM = (bf16_t*)(wsp + WS_VM); \
    bf16_t* QG = (bf16_t*)(wsp + WS_QG); bf16_t* KG = (bf16_t*)(wsp + WS_KG); bf16_t* VG = (bf16_t*)(wsp + WS_VG); \
    bf16_t* O = (bf16_t*)(wsp + WS_O); \
    bf16_t* X1 = (bf16_t*)(wsp + WS_X1); float* WTS = (float*)(wsp + WS_WTS); int* LIST = (int*)(wsp + WS_LIST); \
    bf16_t* SLOTS = (bf16_t*)(wsp + WS_SLOTS); int* POSREC = (int*)(wsp + WS_POSREC); float* OSTAT = (float*)(wsp + WS_OSTAT); \
    bf16_t* PBUF = (bf16_t*)(wsp + WS_PBUF); bf16_t* WBIGT = (bf16_t*)(wsp + WS_WBIGT); \
    bf16_t* WQBT = (bf16_t*)(wsp + WS_WQBT); bf16_t* WINQ = (bf16_t*)(wsp + WS_WINQ); bf16_t* WKVBT = (bf16_t*)(wsp + WS_WKVBT); bf16_t* WINKV = (bf16_t*)(wsp + WS_WINKV); \
    bf16_t* WOUTT = (bf16_t*)(wsp + WS_WOUTT); bf16_t* WRST = (bf16_t*)(wsp + WS_WRST); bf16_t* WDST = (bf16_t*)(wsp + WS_WDST); \
    bf16_t* WGUT = (bf16_t*)(wsp + WS_WGUT); bf16_t* WDT = (bf16_t*)(wsp + WS_WDT); \
    bf16_t* MIXED = (bf16_t*)(wsp + WS_MIXED); float* LOG = (float*)(wsp + WS_LOG); bf16_t* ACT = (bf16_t*)(wsp + WS_ACT); bf16_t* ACTS = (bf16_t*)(wsp + WS_ACTS); bf16_t* YSH = (bf16_t*)(wsp + WS_YSH);

__global__ void __launch_bounds__(NTHR, 2) mega(Args args) {
    extern __shared__ __attribute__((aligned(16))) unsigned char lds_raw[];
    unsigned char* ws = args.ws;
    unsigned* ctl = (unsigned*)(ws + WS_CTL);
    volatile LAS unsigned* bst = (volatile LAS unsigned*)(lds_raw + LDS_BYTES - 16);
    if (threadIdx.x < 4) bst[threadIdx.x] = 0u;
    const int nbk = gridDim.x, bidk = blockIdx.x;
    __syncthreads();
    XcdBarrier bar; bar.bar = ctl + CW_BAR; bar.x = 0; bar.st = bst;
    if (MK_N_LAUNCHES == 1) bar = xcd_barrier_post(ctl + CW_BAR, bst);
    const int lo = args.ph_lo, hi = args.ph_hi;
    const int vcu = (nbk % 8 == 0) ? (bidk % 8) * (nbk / 8) + bidk / 8 : bidk;
    LAS unsigned char* ldsb = (LAS unsigned char*)lds_raw;
#define IN(k) (lo <= (k) && (k) < hi && (pass_ == 0 || ((k) >= REP_FROM && (k) != 8)))
#define SEAM(k) do { if (lo <= (k) && (k) + 1 < hi && (pass_ == 0 || (k) >= REP_FROM)) xcd_barrier(bar); } while (0)

    unsigned* CNT = (unsigned*)(ws + WS_CNTS);
    const bool conv_in_attn = (nbk == NE) && (CONV_MODE == 1 || CONV_MODE == 5);

    for (int pass_ = 0; pass_ < (REP_FROM < 12 ? 2 : 1); ++pass_) {
    if (pass_) xcd_barrier(bar);
    if (IN(0)) for (int rep_ = 0; rep_ < (((REPEAT_MASK >> 0) & 1) ? 2 : 1); ++rep_) {
        const Ctx c = mkctx(ws, lds_raw); PHASE_PTRS
        float* red = c.lds;
        if (c.tid == 0) for (int e = c.bid; e < NE; e += c.nb) CNT[(size_t)e * CNT_STRIDE] = 0u;
        for (int g = c.bid; g < 192; g += c.nb) {
            const int c4 = c.tid & 7, kr = c.tid >> 3;
            float4 w[16];
#pragma unroll
            for (int i = 0; i < 16; ++i) w[i] = *(const float4*)&w_ada[(size_t)(64 * i + kr) * 6144 + g * 32 + 4 * c4];
            float4 a0 = make_float4(0.f, 0.f, 0.f, 0.f), a1 = a0;
#pragma unroll
            for (int i = 0; i < 16; ++i) { const int k = 64 * i + kr; const float c0 = cvec[k], c1 = cvec[DM + k]; const float f0 = c0 * sigmoidf_(c0), f1 = c1 * sigmoidf_(c1);
                a0.x += f0 * w[i].x; a0.y += f0 * w[i].y; a0.z += f0 * w[i].z; a0.w += f0 * w[i].w; a1.x += f1 * w[i].x; a1.y += f1 * w[i].y; a1.z += f1 * w[i].z; a1.w += f1 * w[i].w; }
            __syncthreads();
            *(float4*)&red[(kr * 8 + c4) * 4] = a0; *(float4*)&red[2048 + (kr * 8 + c4) * 4] = a1;
            __syncthreads();
            if (c.tid < 64) { const int b = c.tid >> 5, cc = c.tid & 31; float sacc = 0.f; for (int j = 0; j < 64; ++j) sacc += red[b * 2048 + j * 32 + cc]; mod[b * 6144 + g * 32 + cc] = sacc + b_ada[g * 32 + cc]; }
        }
        __syncthreads();
        for (int idx = c.bid * NTHR + c.tid; idx < SEQ * 16; idx += c.nb * NTHR) {
            const int s = idx >> 4, i = idx & 15, f = i & 7;
            const float inv = powf(10000.f, -(float)f / 8.f);
            const float pos = (float)((i < 8) ? (s >> 6) : (s & 63));
            const float ang = pos * inv;
            cosm[idx] = cosf(ang); sinm[idx] = sinf(ang);
        }
        for (int idx = c.bid * NTHR + c.tid; idx < SEQ * 32; idx += c.nb * NTHR) {
            const int s = idx >> 5, i = idx & 31, f = i & 15;
            const float inv = powf(10000.f, -(float)f / 16.f);
            const float pos = (float)((i < 16) ? (s >> 6) : (s & 63));
            const float ang = pos * inv;
            cosg[idx] = cosf(ang); sing[idx] = sinf(ang);
        }
        LAS float* scr = (LAS float*)(ldsb + 8192 + c.wave * 8448);
        constexpr int I_BIG = 37 * 16;
        constexpr int I_QB = 24 * 4;
        constexpr int I_KVB = 32 * 2;
        constexpr int I_OUT = 32 * 16;
        constexpr int I_RS = 24 * 16;
        constexpr int I_DS = 32 * 4;
        const int I_EXP = (c.nb == NE && (CONV_MODE == 1 || CONV_MODE == 5)) ? 0 : NE * 384;
        const int I_TOT = I_BIG + I_QB + I_KVB + I_OUT + I_RS + I_DS + I_EXP;
        for (int it = c.gw; it < I_TOT; it += c.ngw) {
            int r = it;
            if (r < I_BIG) { const int grp = r >> 4, kb = r & 15; const int col0 = grp * 32, drow = (grp < 13) ? grp * 32 : (grp < 29) ? 1536 + (grp - 13) * 32 : 2816 + (grp - 29) * 32;
                cvt_item(w_in, INC, col0, kb * 64, WBIGT, drow, DM, nullptr, scr, c.lane); continue; }
            r -= I_BIG;
            if (r < I_QB) { const int grp = r >> 2, kb = r & 3; cvt_item(w_q_b, 768, grp * 32, kb * 64, WQBT, grp * 32, 256, g_q_a, scr, c.lane); continue; }
            r -= I_QB;
            if (r < I_KVB) { const int grp = r >> 1, kb = r & 1; cvt_item(w_kv_b, 1024, grp * 32, kb * 64, WKVBT, grp * 32, 256, g_kv_a, scr, c.lane); continue; }
            r -= I_KVB;
            if (r < I_OUT) { const int grp = r >> 4, kb = r & 15; cvt_item(w_out, DM, grp * 32, kb * 64, WOUTT, grp * 32, DM, (kb < 8) ? g_mla_out : (g_gqa_out - 512), scr, c.lane, true); continue; }
            r -= I_OUT;
            if (r < I_RS) { const int grp = r >> 4, kb = r & 15;
                if (grp < 8) cvt_item(w_router, NE, grp * 32, kb * 64, WRST, grp * 32, DM, nullptr, scr, c.lane, true);
                else { const int q = grp - 8, blk = q >> 2, sub = q & 3;
                    cvt_item((blk & 1) ? w_up_s : w_gate_s, EFF, (blk >> 1) * 128 + sub * 32, kb * 64, WRST, 256 + blk * 128 + sub * 32, DM, nullptr, scr, c.lane, true); }
                continue; }
            r -= I_RS;
            if (r < I_DS) { const int grp = r >> 2, kb = r & 3; cvt_item(w_down_s, DM, grp * 32, kb * 64, WDST, grp * 32, EFF, nullptr, scr, c.lane, true); continue; }
            r -= I_DS;
            { const int e = r / 384, q = r % 384;
              if (q < 256) { const int up = q >> 7, q2 = q & 127, grp = q2 >> 4, kb = q2 & 15;
                  const int drow = ((grp < 4) ? grp * 32 : 256 + (grp - 4) * 32) + up * 128;
                  cvt_item((up ? w_up_e : w_gate_e) + (size_t)e * DM * EFF, EFF, grp * 32, kb * 64, WGUT + (size_t)e * 512 * DM, drow, DM, nullptr, scr, c.lane); }
              else { const int q2 = q - 256, grp = q2 >> 2, kb = q2 & 3;
                  cvt_item(w_down_e + (size_t)e * EFF * DM, DM, grp * 32, kb * 64, WDT + (size_t)e * DM * EFF, grp * 32, EFF, nullptr, scr, c.lane); } }
        }
        const int gt = c.bid * NTHR + c.tid, ngt = c.nb * NTHR;
        for (int i = gt; i < 96 * 1024 / 8; i += ngt) *(uint4*)(WBIGT + (size_t)416 * DM + (size_t)i * 8) = make_uint4(0u, 0u, 0u, 0u);
        for (int i = gt; i < 1024 * 16; i += ngt) { const int n = i >> 4, q = i & 15; *(uint4*)(WKVBT + (size_t)n * 256 + 128 + q * 8) = make_uint4(0u, 0u, 0u, 0u); }
        for (int i = gt; i < 1024 * 64; i += ngt) { const int k = i >> 6, q = i & 63; const float4 v = *(const float4*)&w_in[(size_t)k * INC + q * 4]; uint2 o; o.x = pk2(v.x, v.y); o.y = pk2(v.z, v.w); *(uint2*)(WINQ + (size_t)k * 256 + q * 4) = o; }
        for (int i = gt; i < 1024 * 64; i += ngt) { const int k = i >> 6, q = i & 63; uint2 o = make_uint2(0u, 0u);
            if (q < 32) { const float4 v = *(const float4*)&w_in[(size_t)k * INC + 256 + q * 4]; o.x = pk2(v.x, v.y); o.y = pk2(v.z, v.w); }
            *(uint2*)(WINKV + (size_t)k * 256 + q * 4) = o; }
    }
    SEAM(0);

    if (IN(1)) for (int rep_ = 0; rep_ < (((REPEAT_MASK >> 1) & 1) ? 2 : 1); ++rep_) {
        const Ctx c = mkctx(ws, lds_raw); PHASE_PTRS
        for (int i = c.bid * NTHR + c.tid; i < 2 * 4 * DM; i += c.nb * NTHR) { const int b = i >> 12, k = (i >> 10) & 3, cc = i & 1023; const float* md = mod + b * 6144;
            ((float*)(wsp + WS_COEF))[i] = (k == 0) ? md[2048 + cc] * g_post_mix[cc] : (k == 1) ? g_pre_ffn[cc] * (1.f + md[4096 + cc]) : (k == 2) ? md[3072 + cc] : md[5120 + cc] * g_post_ffn[cc]; }
        { pg8::DenseOrder S; S.init(768, 1024, 256, WINQ, c.nb, c.bid); pg8::EpiBf16 E{WBIGT + (size_t)2048 * DM, DM};
          pg8::gemm_phase<pg8::EpiBf16, pg8::DenseOrder, true>(ldsb, WQBT, 256, S, E); }
        { pg8::DenseOrder S; S.init(1024, 1024, 256, WINKV, c.nb, (c.bid >= 12 && c.nb >= 28) ? c.bid - 12 : c.bid + (c.nb >= 28 ? c.nb : 0)); pg8::EpiBf16 E{WBIGT + (size_t)512 * DM, DM};
          pg8::gemm_phase<pg8::EpiBf16, pg8::DenseOrder, true>(ldsb, WKVBT, 256, S, E); }
        const bool hsplit = c.nb >= 56; const int hw = hsplit ? c.gw - 28 * 8 : c.gw, nhw = hsplit ? c.ngw - 28 * 8 : c.ngw;
        typedef float f32x4v __attribute__((ext_vector_type(4)));
        LAS float* ctab = (LAS float*)ldsb;
        __syncthreads();
        {
            float4 gv[2], sv[2], hv[2];
#pragma unroll
            for (int q = 0; q < 2; ++q) { const int e = c.tid + q * NTHR, b = e >> 9, k = (e >> 8) & 1, cc = (e & 255) * 4; const float* md = mod + b * 6144;
                gv[q] = *(const float4*)&g_pre_mix[cc]; sv[q] = *(const float4*)&md[1024 + cc]; hv[q] = *(const float4*)&md[cc]; }
#pragma unroll
            for (int q = 0; q < 2; ++q) { const int e = c.tid + q * NTHR, b = e >> 9, k = (e >> 8) & 1, cc = (e & 255) * 4;
                f32x4v o; if (k == 0) { o.x = gv[q].x * (1.f + sv[q].x); o.y = gv[q].y * (1.f + sv[q].y); o.z = gv[q].z * (1.f + sv[q].z); o.w = gv[q].w * (1.f + sv[q].w); } else { o.x = hv[q].x; o.y = hv[q].y; o.z = hv[q].z; o.w = hv[q].w; }
                *(LAS f32x4v*)&ctab[b * 2048 + k * 1024 + cc] = o; } }
        __syncthreads();
        if (hw >= 0) {
            float4 nv[2][4];
#pragma unroll
            for (int q = 0; q < 2; ++q) { const int m = (hw + q * nhw < NTOK) ? hw + q * nhw : hw;
#pragma unroll
                for (int j = 0; j < 4; ++j) nv[q][j] = *(const float4*)&x[(size_t)m * DM + 8 * c.lane + 512 * (j >> 1) + 4 * (j & 1)]; }
            for (int m0 = hw; m0 < NTOK; m0 += 2 * nhw) {
                float4 v[2][4];
#pragma unroll
                for (int q = 0; q < 2; ++q)
#pragma unroll
                    for (int j = 0; j < 4; ++j) v[q][j] = nv[q][j];
                const int m0n = m0 + 2 * nhw;
                if (m0n < NTOK) {
#pragma unroll
                    for (int q = 0; q < 2; ++q) { const int m = (m0n + q * nhw < NTOK) ? m0n + q * nhw : m0n;
#pragma unroll
                        for (int j = 0; j < 4; ++j) nv[q][j] = *(const float4*)&x[(size_t)m * DM + 8 * c.lane + 512 * (j >> 1) + 4 * (j & 1)]; }
                }
#pragma unroll
                for (int q = 0; q < 2; ++q) {
                    const int m = (m0 + q * nhw < NTOK) ? m0 + q * nhw : m0; const int b = m / SEQ; const float* md = mod + b * 6144;
                    f32x4v ga[4], sh[4];
#pragma unroll
                    for (int j = 0; j < 4; ++j) { const int cc = 8 * c.lane + 512 * (j >> 1) + 4 * (j & 1); ga[j] = *(const LAS f32x4v*)&ctab[b * 2048 + cc]; sh[j] = *(const LAS f32x4v*)&ctab[b * 2048 + 1024 + cc]; }
                    float ss = 0.f;
#pragma unroll
                    for (int j = 0; j < 4; ++j) ss += v[q][j].x * v[q][j].x + v[q][j].y * v[q][j].y + v[q][j].z * v[q][j].z + v[q][j].w * v[q][j].w;
                    const float rstd = rsqrtf(wave_sum(ss) * (1.f / DM) + EPS);
                    uint2 o[4];
#pragma unroll
                    for (int j = 0; j < 4; ++j) {
                        o[j].x = pk2(v[q][j].x * rstd * ga[j].x + sh[j].x, v[q][j].y * rstd * ga[j].y + sh[j].y);
                        o[j].y = pk2(v[q][j].z * rstd * ga[j].z + sh[j].z, v[q][j].w * rstd * ga[j].w + sh[j].w);
                    }
#pragma unroll
                    for (int jp = 0; jp < 2; ++jp) *(uint4*)&H2[(size_t)m * DM + 8 * c.lane + 512 * jp] = make_uint4(o[2 * jp].x, o[2 * jp].y, o[2 * jp + 1].x, o[2 * jp + 1].y);
                }
            }
        }
    }
    SEAM(1);

    if (IN(2)) for (int rep_ = 0; rep_ < (((REPEAT_MASK >> 2) & 1) ? 2 : 1); ++rep_) {
        const Ctx c = mkctx(ws, lds_raw); PHASE_PTRS
        pg8::DenseOrder S; S.init(NTOK, 3072, DM, WBIGT, c.nb, c.bid); pg8::EpiBf16 E{PBUF, 3072};
        pg8::gemm_phase<pg8::EpiBf16, pg8::DenseOrder, true>(ldsb, H2, DM, S, E);
    }
    SEAM(2);

    if (IN(3)) for (int rep_ = 0; rep_ < (((REPEAT_MASK >> 3) & 1) ? 2 : 1); ++rep_) {
        const Ctx c = mkctx(ws, lds_raw); PHASE_PTRS
        unsigned* kmaxL = (unsigned*)lds_raw;
        if (c.tid < 18) kmaxL[c.tid] = 0u;
        __syncthreads();
        uint4 nraw[6];
#pragma unroll
        for (int j = 0; j < 6; ++j) nraw[j] = *(const uint4*)(PBUF + (size_t)c.gw * 3072 + 512 * j + 8 * c.lane);
        int tco[6], tsd[6]; bool tgq[6];
        float4 gha[2], ghb[2];
#pragma unroll
        for (int j = 0; j < 6; ++j) { const int col0 = 512 * j + 8 * c.lane; tco[j] = 0; tsd[j] = 0; tgq[j] = false;
            if (j == 0) { if (c.lane >= 48 && c.lane < 52) { tco[j] = 4 * (c.lane - 48); tsd[j] = 16; } }
            else if (col0 >= 2048 && col0 < 2816) { const int d0 = (col0 - 2048) % DQKM; if (d0 >= MNOPE) { tco[j] = (d0 - MNOPE) >> 1; tsd[j] = 16; } }
            else if ((col0 >= 1536 && col0 < 2048) || (col0 >= 2816 && col0 < 2944)) { const int d0 = ((col0 < 2048) ? (col0 - 1536) : (col0 - 2816)) & 63; tco[j] = d0 >> 1; tsd[j] = 32; tgq[j] = true; } }
#pragma unroll
        for (int j = 3; j < 6; j += 2) { const int col0 = 512 * j + 8 * c.lane; const bool isq = col0 < 2048; const int d0 = (isq ? (col0 - 1536) : ((col0 >= 2816 && col0 < 2944) ? (col0 - 2816) : 0)) & 63;
            const float* gh = isq ? g_q_head : g_k_head; gha[j == 5] = *(const float4*)&gh[d0]; ghb[j == 5] = *(const float4*)&gh[d0 + 4]; }
        typedef float f32x4t __attribute__((ext_vector_type(4)));
        LAS float* rtb = (LAS float*)(ldsb + 1024 + c.wave * 3072);
        int tlc[6], tls[6];
#pragma unroll
        for (int j = 0; j < 6; ++j) { tlc[j] = tgq[j] ? 32 + tco[j] : tco[j]; tls[j] = tgq[j] ? 64 + tco[j] : 16 + tco[j]; }
        int rowi = 0;
        for (int m = c.gw; m < NTOK; m += c.ngw, ++rowi) {
            const int b = m / SEQ, s = m % SEQ;
            if ((rowi & 7) == 0) {
                f32x4t tv[8];
#pragma unroll
                for (int r = 0; r < 8; ++r) { const int mr = (m + r * c.ngw < NTOK) ? m + r * c.ngw : m; const int sr = mr % SEQ; const int q = c.lane < 24 ? c.lane : 0;
                    const float* src = (q < 4) ? cosm + sr * 16 + 4 * q : (q < 8) ? sinm + sr * 16 + 4 * (q - 4) : (q < 16) ? cosg + sr * 32 + 4 * (q - 8) : sing + sr * 32 + 4 * (q - 16);
                    const float4 t4 = *(const float4*)src; tv[r] = (f32x4t){t4.x, t4.y, t4.z, t4.w}; }
                if (c.lane < 24) {
#pragma unroll
                    for (int r = 0; r < 8; ++r) *(LAS f32x4t*)&rtb[r * 96 + 4 * c.lane] = tv[r]; }
            }
            uint4 raw[6];
#pragma unroll
            for (int j = 0; j < 6; ++j) raw[j] = nraw[j];
            if (m + c.ngw < NTOK) {
#pragma unroll
                for (int j = 0; j < 6; ++j) nraw[j] = *(const uint4*)(PBUF + (size_t)(m + c.ngw) * 3072 + 512 * j + 8 * c.lane);
            }
            float4 tcs[6], tsn[6]; tcs[1] = make_float4(0.f, 0.f, 0.f, 0.f); tsn[1] = tcs[1]; tcs[2] = tcs[1]; tsn[2] = tcs[1];
#pragma unroll
            for (int j = 0; j < 6; ++j) if (j != 1 && j != 2) { const LAS float* rr = rtb + (rowi & 7) * 96; const f32x4t a4 = *(const LAS f32x4t*)&rr[tlc[j]], b4 = *(const LAS f32x4t*)&rr[tls[j]];
                tcs[j] = make_float4(a4.x, a4.y, a4.z, a4.w); tsn[j] = make_float4(b4.x, b4.y, b4.z, b4.w); }
            float rq, rkv;
            {
                float v[8]; { const uint4 u = raw[0]; v[0] = bf2f(u.x & 0xffffu); v[1] = bf2f(u.x >> 16); v[2] = bf2f(u.y & 0xffffu); v[3] = bf2f(u.y >> 16); v[4] = bf2f(u.z & 0xffffu); v[5] = bf2f(u.z >> 16); v[6] = bf2f(u.w & 0xffffu); v[7] = bf2f(u.w >> 16); }
                float sq = 0.f;
#pragma unroll
                for (int i = 0; i < 8; ++i) sq += v[i] * v[i];
                rq = rsqrtf(wave_sum(c.lane < 32 ? sq : 0.f) * (1.f / QLORA) + EPS);
                rkv = rsqrtf(wave_sum((c.lane >= 32 && c.lane < 48) ? sq : 0.f) * (1.f / KVLORA) + EPS);
                if (c.lane >= 48 && c.lane < 52) {
                    const int i0 = 4 * (c.lane - 48); uint4 o; unsigned ow[4];
#pragma unroll
                    for (int pq = 0; pq < 4; ++pq) { const float cs = (pq == 0) ? tcs[0].x : (pq == 1) ? tcs[0].y : (pq == 2) ? tcs[0].z : tcs[0].w, sn = (pq == 0) ? tsn[0].x : (pq == 1) ? tsn[0].y : (pq == 2) ? tsn[0].z : tsn[0].w; ow[pq] = pk2(v[2 * pq] * cs - v[2 * pq + 1] * sn, v[2 * pq] * sn + v[2 * pq + 1] * cs); }
                    o.x = ow[0]; o.y = ow[1]; o.z = ow[2]; o.w = ow[3];
#pragma unroll
                    for (int h = 0; h < MH; ++h) *(uint4*)((char*)KM + (size_t)(unsigned)((((b * MH + h) * SEQ + s) * DQKM + MNOPE + 2 * i0) * 2)) = o;
                    float pq = 0.f;
#pragma unroll
                    for (int i = 0; i < 8; ++i) pq += v[i] * v[i];
                    pq += dppmov<0xB1, 0xF>(0.f, pq); pq += dppmov<0x4E, 0xF>(0.f, pq);
                    if (c.lane == 48) atomicMax(&kmaxL[16 + b], __builtin_bit_cast(unsigned, pq));
                }
            }
#pragma unroll
            for (int j = 1; j < 6; ++j) {
                const int col0 = 512 * j + 8 * c.lane;
                float v[8]; { const uint4 u = raw[j]; v[0] = bf2f(u.x & 0xffffu); v[1] = bf2f(u.x >> 16); v[2] = bf2f(u.y & 0xffffu); v[3] = bf2f(u.y >> 16); v[4] = bf2f(u.z & 0xffffu); v[5] = bf2f(u.z >> 16); v[6] = bf2f(u.w & 0xffffu); v[7] = bf2f(u.w >> 16); }
                if (col0 >= 2048 && col0 < 2816) {
                    const int qc = col0 - 2048, h = qc / DQKM, d0 = qc % DQKM; const float sc = rq * C2M;
                    uint4 o; unsigned ow[4];
                    if (d0 >= MNOPE) { const int i0 = (d0 - MNOPE) >> 1;
#pragma unroll
                        for (int pq = 0; pq < 4; ++pq) { const float cs = (pq == 0) ? tcs[j].x : (pq == 1) ? tcs[j].y : (pq == 2) ? tcs[j].z : tcs[j].w, sn = (pq == 0) ? tsn[j].x : (pq == 1) ? tsn[j].y : (pq == 2) ? tsn[j].z : tsn[j].w;
                            ow[pq] = pk2((v[2 * pq] * cs - v[2 * pq + 1] * sn) * sc, (v[2 * pq] * sn + v[2 * pq + 1] * cs) * sc); }
                    } else {
#pragma unroll
                        for (int pq = 0; pq < 4; ++pq) ow[pq] = pk2(v[2 * pq] * sc, v[2 * pq + 1] * sc);
                    }
                    o.x = ow[0]; o.y = ow[1]; o.z = ow[2]; o.w = ow[3];
                    *(uint4*)((char*)QM + (size_t)(unsigned)((((b * MH + h) * SEQ + s) * DQKM + d0) * 2)) = o;
                } else if (col0 < 1536) {
                    const int kc = col0 - 512, h = kc >> 7, d0 = kc & 127;
                    uint4 o; o.x = pk2(v[0] * rkv, v[1] * rkv); o.y = pk2(v[2] * rkv, v[3] * rkv); o.z = pk2(v[4] * rkv, v[5] * rkv); o.w = pk2(v[6] * rkv, v[7] * rkv);
                    if (d0 < MNOPE) { *(uint4*)((char*)KM + (size_t)(unsigned)((((b * MH + h) * SEQ + s) * DQKM + d0) * 2)) = o;
                        float kq = 0.f;
#pragma unroll
                        for (int i = 0; i < 8; ++i) kq += (v[i] * rkv) * (v[i] * rkv);
                        kq += dppmov<0xB1, 0xF>(0.f, kq); kq += dppmov<0x4E, 0xF>(0.f, kq); kq += dppmov<0x141, 0xF>(0.f, kq);
                        if ((c.lane & 7) == 0) atomicMax(&kmaxL[b * 8 + h], __builtin_bit_cast(unsigned, kq)); }
                    else *(uint4*)((char*)VM + (size_t)(unsigned)((((b * MH + h) * SEQ + s) * MV + (d0 - MNOPE)) * 2)) = o;
                } else if (col0 < 2944) {
                    const bool isq = col0 < 2048; const int hc = isq ? (col0 - 1536) : (col0 - 2816), h = hc >> 6, d0 = hc & 63;
                    float sq = 0.f;
#pragma unroll
                    for (int i = 0; i < 8; ++i) sq += v[i] * v[i];
                    sq += __shfl_xor(sq, 1); sq += __shfl_xor(sq, 2); sq += __shfl_xor(sq, 4);
                    const float rs = rsqrtf(sq * (1.f / GD) + EPS) * (isq ? C2G : 1.f); const float* gh = isq ? g_q_head : g_k_head;
                    uint4 o; unsigned ow[4];
                    const float ghv[8] = {gha[j == 5].x, gha[j == 5].y, gha[j == 5].z, gha[j == 5].w, ghb[j == 5].x, ghb[j == 5].y, ghb[j == 5].z, ghb[j == 5].w};
                    const float csv[4] = {tcs[j].x, tcs[j].y, tcs[j].z, tcs[j].w}, snv[4] = {tsn[j].x, tsn[j].y, tsn[j].z, tsn[j].w};
#pragma unroll
                    for (int pq = 0; pq < 4; ++pq) { const float cs = csv[pq], sn = snv[pq];
                        const float x0 = v[2 * pq] * rs * ghv[2 * pq], x1 = v[2 * pq + 1] * rs * ghv[2 * pq + 1]; ow[pq] = pk2(x0 * cs - x1 * sn, x0 * sn + x1 * cs); }
                    o.x = ow[0]; o.y = ow[1]; o.z = ow[2]; o.w = ow[3];
                    if (isq) *(uint4*)((char*)QG + (size_t)(unsigned)((((b * GH + h) * SEQ + s) * GD + d0) * 2)) = o;
                    else *(uint4*)((char*)KG + (size_t)(unsigned)((((b * GKV + h) * SEQ + s) * GD + d0) * 2)) = o;
                } else {
                    const int hc = col0 - 2944, h = hc >> 6, d0 = hc & 63;
                    *(uint4*)((char*)VG + (size_t)(unsigned)((((b * GKV + h) * SEQ + s) * GD + d0) * 2)) = raw[j];
                }
            }
        }
        __syncthreads();
        if (c.tid < 18) atomicMax(ctl + CW_KMAX + c.tid, kmaxL[c.tid]);
    }
    SEAM(3);

    if (IN(4)) for (int rep_ = 0; rep_ < (((REPEAT_MASK >> 4) & 1) ? 2 : 1); ++rep_) {
        const Ctx c = mkctx(ws, lds_raw); PHASE_PTRS
        att::ConvState cs;
        { const int e = (c.nb == NE) ? c.bid : 0;
          cs.cj = 0; cs.jbase = 384 * c.wave;
          cs.wg = (const char*)(w_gate_e + (size_t)e * DM * EFF); cs.wu = (const char*)(w_up_e + (size_t)e * DM * EFF); cs.wd = (const char*)(w_down_e + (size_t)e * EFF * DM);
          cs.dgu = (char*)(WGUT + (size_t)e * 512 * DM); cs.dd = (char*)(WDT + (size_t)e * DM * EFF);
          cs.ldsbuf = (unsigned)(uintptr_t)lds_raw + att::CONV_LDS + (CONV_MODE >= 5 ? 0 : c.wave * 4096); cs.rdbuf = (att::lds_cptr)lds_raw + att::CONV_LDS + (CONV_MODE >= 5 ? 0 : c.wave * 4096);
          if (CONV_MODE >= 5) cs.jbase = 0;
          if (CONV_MODE != 0 && CONV_MODE < 5) for (int i = 0; i < 3; ++i) { const att::ConvJob q = att::conv_job(cs, cs.cj);
              att::glds16_s(q.sbase, (unsigned)(c.lane >> 3) * q.ldwB + (unsigned)(c.lane & 7) * 16u, (unsigned)__builtin_amdgcn_readfirstlane(cs.ldsbuf + (cs.cj & 3) * 1024)); ++cs.cj; }
          asm volatile("s_waitcnt vmcnt(0)" ::: "memory"); }
        float mfix;
        { const float gq = wave_max(fabsf(g_q_head[c.lane])), gk = wave_max(fabsf(g_k_head[c.lane])); mfix = fminf(64.f * C2G * gq * gk * 1.03f + 0.5f, 60.f); }
        for (int uu = vcu; uu < 512; uu += c.nb) {
            const int bh = uu >> 5, b = bh >> 3, h = bh & 7, qp = uu & 31;
            const int q0 = qp * 256;
            const float kb2 = __builtin_bit_cast(float, ctl[CW_KMAX + b * 8 + h]) + __builtin_bit_cast(float, ctl[CW_KMAX + 16 + b]);
            att::unit96<8>(QM + (size_t)(b * MH + h) * SEQ * DQKM, KM + (size_t)(b * MH + h) * SEQ * DQKM, VM + (size_t)(b * MH + h) * SEQ * MV,
                                 O + ((size_t)b * SEQ + q0) * DM + h * 64, OSTAT + ((size_t)b * SEQ + q0) * 16 + h, q0, (char*)lds_raw, cs, kb2);
            att::unit64<8>(QG + (size_t)(b * GH + h) * SEQ * GD, KG + (size_t)(b * GKV + (h >> 2)) * SEQ * GD, VG + (size_t)(b * GKV + (h >> 2)) * SEQ * GD,
                                 O + ((size_t)b * SEQ + q0) * DM + (8 + h) * 64, OSTAT + ((size_t)b * SEQ + q0) * 16 + 8 + h, q0, (char*)lds_raw, cs, mfix);
        }
#if CONV_MODE >= 5
        {
            using namespace att;
            const int wid = c.wave, lane = c.lane; const bool rst = wid >= 6;
            for (int r4 = 0; r4 < 3; ++r4) { CONV_DRAIN(); ++cs.cj; }
        }
#endif
    }
    SEAM(4);

    if (IN(5)) for (int rep_ = 0; rep_ < (((REPEAT_MASK >> 5) & 1) ? 2 : 1); ++rep_) {
        const Ctx c = mkctx(ws, lds_raw); PHASE_PTRS
        pg8::DenseOrder S; S.init(NTOK, DM, DM, WOUTT, c.nb, c.bid, true);
        LAS float* rtab = (LAS float*)(ldsb + pg8::STAGE_BYTES);
        { pg8::Unit u0; if (S.next(0, u0) && c.tid < 256) { const float4* sp = (const float4*)&OSTAT[(size_t)(u0.pm * 256 + c.tid) * 16]; const float4 s0 = sp[0], s1 = sp[1], s2 = sp[2], s3 = sp[3];
            const float sm = ((s0.x + s0.y) + (s0.z + s0.w)) + ((s1.x + s1.y) + (s1.z + s1.w)), sg = ((s2.x + s2.y) + (s2.z + s2.w)) + ((s3.x + s3.y) + (s3.z + s3.w));
            const float rm = rsqrtf(sm * (1.f / 512) + EPS), rg = rsqrtf(sg * (1.f / 512) + EPS); rtab[2 * c.tid] = rm / rg; rtab[2 * c.tid + 1] = rg; }
          __syncthreads(); }
        pg8::EpiBf16RowScale E{MIXED, DM, rtab};
        pg8::gemm_phase<pg8::EpiBf16RowScale, pg8::DenseOrder, true, false, true>(ldsb, O, DM, S, E, nullptr);
    }
    SEAM(5);

    if (IN(6)) for (int rep_ = 0; rep_ < (((REPEAT_MASK >> 6) & 1) ? 2 : 1); ++rep_) {
        const Ctx c = mkctx(ws, lds_raw); PHASE_PTRS
        {
            const float* COEF = (const float*)(wsp + WS_COEF);
            typedef float f32x4v __attribute__((ext_vector_type(4)));
            LAS float* ctab = (LAS float*)ldsb;
            __syncthreads();
            { float4 cv[3];
#pragma unroll
              for (int q = 0; q < 3; ++q) { const int e = c.tid + q * NTHR, b = e / 768, r = e % 768; cv[q] = *(const float4*)&COEF[b * 4096 + r * 4]; }
#pragma unroll
              for (int q = 0; q < 3; ++q) { const int e = c.tid + q * NTHR, b = e / 768, r = e % 768; f32x4v o; o.x = cv[q].x; o.y = cv[q].y; o.z = cv[q].z; o.w = cv[q].w; *(LAS f32x4v*)&ctab[b * 3072 + r * 4] = o; } }
            __syncthreads();
            uint4 nmu[2][2]; float4 nxq[2][4];
#define P6_CC(j) (8 * c.lane + 512 * ((j) >> 1) + 4 * ((j) & 1))
#define P6_LOAD(mm) do { _Pragma("unroll") for (int q = 0; q < 2; ++q) { const int m_ = ((mm) + q * c.ngw < NTOK) ? (mm) + q * c.ngw : (mm); \
                _Pragma("unroll") for (int jp = 0; jp < 2; ++jp) nmu[q][jp] = *(const uint4*)&MIXED[(size_t)m_ * DM + 8 * c.lane + 512 * jp]; \
                _Pragma("unroll") for (int j = 0; j < 4; ++j) nxq[q][j] = *(const float4*)&x[(size_t)m_ * DM + P6_CC(j)]; } } while (0)
            P6_LOAD(c.gw);
            for (int m0 = c.gw; m0 < NTOK; m0 += 2 * c.ngw) {
                uint2 mu[2][4]; float4 xq[2][4];
#pragma unroll
                for (int q = 0; q < 2; ++q) {
#pragma unroll
                    for (int jp = 0; jp < 2; ++jp) { mu[q][2 * jp] = make_uint2(nmu[q][jp].x, nmu[q][jp].y); mu[q][2 * jp + 1] = make_uint2(nmu[q][jp].z, nmu[q][jp].w); }
#pragma unroll
                    for (int j = 0; j < 4; ++j) xq[q][j] = nxq[q][j]; }
                const int m0n = m0 + 2 * c.ngw;
                if (m0n < NTOK) P6_LOAD(m0n);
#pragma unroll
                for (int q = 0; q < 2; ++q) {
                    const int m = (m0 + q * c.ngw < NTOK) ? m0 + q * c.ngw : m0; const int b = m / SEQ; const LAS float* cf = ctab + b * 3072;
                    f32x4v ca[4], cb[4], cd[4];
#pragma unroll
                    for (int j = 0; j < 4; ++j) { const int cc = P6_CC(j); ca[j] = *(const LAS f32x4v*)&cf[cc]; cb[j] = *(const LAS f32x4v*)&cf[1024 + cc]; cd[j] = *(const LAS f32x4v*)&cf[2048 + cc]; }
                    float4 v[4], xr[4]; float ss = 0.f;
#pragma unroll
                    for (int j = 0; j < 4; ++j) { const uint2 u = mu[q][j];
                        v[j].x = bf2f(u.x & 0xffffu); v[j].y = bf2f(u.x >> 16); v[j].z = bf2f(u.y & 0xffffu); v[j].w = bf2f(u.y >> 16);
                        ss += v[j].x * v[j].x + v[j].y * v[j].y + v[j].z * v[j].z + v[j].w * v[j].w; }
                    const float rstd = rsqrtf(wave_sum(ss) * (1.f / DM) + EPS);
                    float ss1 = 0.f; uint2 xo[4];
#pragma unroll
                    for (int j = 0; j < 4; ++j) {
                        const float4 xx = xq[q][j];
                        xr[j].x = xx.x + ca[j].x * (v[j].x * rstd); xr[j].y = xx.y + ca[j].y * (v[j].y * rstd);
                        xr[j].z = xx.z + ca[j].z * (v[j].z * rstd); xr[j].w = xx.w + ca[j].w * (v[j].w * rstd);
                        ss1 += xr[j].x * xr[j].x + xr[j].y * xr[j].y + xr[j].z * xr[j].z + xr[j].w * xr[j].w;
                        xo[j].x = pk2(xr[j].x, xr[j].y); xo[j].y = pk2(xr[j].z, xr[j].w);
                    }
#pragma unroll
                    for (int jp = 0; jp < 2; ++jp) *(uint4*)&X1[(size_t)m * DM + 8 * c.lane + 512 * jp] = make_uint4(xo[2 * jp].x, xo[2 * jp].y, xo[2 * jp + 1].x, xo[2 * jp + 1].y);
                    const float rstd1 = rsqrtf(wave_sum(ss1) * (1.f / DM) + EPS);
                    uint2 pk[4];
#pragma unroll
                    for (int j = 0; j < 4; ++j) {
                        pk[j].x = pk2(xr[j].x * rstd1 * cb[j].x + cd[j].x, xr[j].y * rstd1 * cb[j].y + cd[j].y);
                        pk[j].y = pk2(xr[j].z * rstd1 * cb[j].z + cd[j].z, xr[j].w * rstd1 * cb[j].w + cd[j].w);
                    }
#pragma unroll
                    for (int jp = 0; jp < 2; ++jp) *(uint4*)&H2[(size_t)m * DM + 8 * c.lane + 512 * jp] = make_uint4(pk[2 * jp].x, pk[2 * jp].y, pk[2 * jp + 1].x, pk[2 * jp + 1].y);
                }
            }
#undef P6_LOAD
#undef P6_CC
        }
    }
    SEAM(6);

    if (IN(7)) for (int rep_ = 0; rep_ < (((REPEAT_MASK >> 7) & 1) ? 2 : 1); ++rep_) {
        const Ctx c = mkctx(ws, lds_raw); PHASE_PTRS
        pg8::DenseOrder S; S.init(NTOK, 768, DM, WRST, c.nb, c.bid, true); pg8::EpiRS E{LOG, ACTS};
        pg8::gemm_phase<pg8::EpiRS, pg8::DenseOrder, true>(ldsb, H2, DM, S, E);
    }
    SEAM(7);

    if (IN(8)) for (int rep_ = 0; rep_ < (((REPEAT_MASK >> 8) & 1) ? 2 : 1); ++rep_) {
        const Ctx c = mkctx(ws, lds_raw); PHASE_PTRS
        const float4 bb = *(const float4*)&b_router[4 * c.lane];
        const unsigned rowL = (unsigned)(uintptr_t)lds_raw + c.wave * 8192;
        const LAS unsigned char* rowP = ldsb + c.wave * 8192;
        const bool cnt_sort = (MK_N_LAUNCHES == 1) && c.nb == NE && 8 * c.ngw == NTOK && lo < 8 && hi > 9;
        int* histg = (int*)(lds_raw + 65536); int* HIST = (int*)(wsp + WS_HIST);
        if (cnt_sort) { if (c.tid < NE) histg[c.tid] = 0; __syncthreads(); }
        for (int mb = c.gw; mb < NTOK; mb += 8 * c.ngw) {
#pragma unroll
          for (int r = 0; r < 8; ++r) { const int mr = mb + r * c.ngw; if (mr < NTOK) att::glds16(LOG + (size_t)mr * NE + 4 * c.lane, (unsigned)__builtin_amdgcn_readfirstlane(rowL + r * 1024)); }
          asm volatile("s_waitcnt vmcnt(0)" ::: "memory");
          int my_e = 0; float my_s = 0.f; int rb = 0;
#pragma unroll 1
          for (int m = mb; m < NTOK && rb < 8; m += c.ngw) {
            typedef float f32x4v __attribute__((ext_vector_type(4)));
            const f32x4v lg = *(const LAS f32x4v*)(rowP + rb * 1024 + c.lane * 16);
            const float s0 = __builtin_amdgcn_rcpf(1.f + __builtin_amdgcn_exp2f(lg.x * -1.44269504f)), s1 = __builtin_amdgcn_rcpf(1.f + __builtin_amdgcn_exp2f(lg.y * -1.44269504f));
            const float s2 = __builtin_amdgcn_rcpf(1.f + __builtin_amdgcn_exp2f(lg.z * -1.44269504f)), s3 = __builtin_amdgcn_rcpf(1.f + __builtin_amdgcn_exp2f(lg.w * -1.44269504f));
            const int o0 = ford(s0 + bb.x), o1 = ford(s1 + bb.y), o2 = ford(s2 + bb.z), o3 = ford(s3 + bb.w);
            const int e0 = 4 * c.lane, g = c.lane >> 3;
            const int IMIN = (int)0x80000000;
            int gkey;
            {
                const int h01 = imax_(o0, o1), l01 = imin_(o0, o1), h23 = imax_(o2, o3), l23 = imin_(o2, o3);
                const int a1 = imax_(h01, h23), a2 = imax_(imin_(h01, h23), (h01 >= h23) ? l01 : l23);
                const int g1 = grp8_max_i(a1);
                const unsigned long long bm = __ballot(a1 == g1);
                const unsigned grpbits = (unsigned)(bm >> (8 * g)) & 0xffu;
                const bool first = (a1 == g1) && ((grpbits & ((1u << (c.lane & 7)) - 1u)) == 0u);
                const int g2 = grp8_max_i(first ? a2 : a1);
                gkey = (ford(funord(g1) + funord(g2)) & ~7) | (7 - g);
            }
            int rank = 0;
#pragma unroll
            for (int j = 0; j < 8; ++j) rank += (__builtin_amdgcn_readlane(gkey, 8 * j) > gkey) ? 1 : 0;
            const bool sel = rank < 4;
            int k0 = sel ? ((o0 & ~0xff) | (255 - e0)) : IMIN, k1 = sel ? ((o1 & ~0xff) | (254 - e0)) : IMIN, k2 = sel ? ((o2 & ~0xff) | (253 - e0)) : IMIN, k3 = sel ? ((o3 & ~0xff) | (252 - e0)) : IMIN;
            int my_key = 0;
#pragma unroll 1
            for (int rnd = 0; rnd < TOPK; ++rnd) {
                const int mx = wave_max_i(imax_(imax_(k0, k1), imax_(k2, k3)));
                if (c.lane == 8 * rb + rnd) my_key = mx;
                k0 = (k0 == mx) ? IMIN : k0; k1 = (k1 == mx) ? IMIN : k1; k2 = (k2 == mx) ? IMIN : k2; k3 = (k3 == mx) ? IMIN : k3;
            }
            {
                const int ee = 255 - (my_key & 0xff), src = (ee >> 2) * 4;
                const float q0 = __builtin_bit_cast(float, __builtin_amdgcn_ds_bpermute(src, __builtin_bit_cast(int, s0))), q1 = __builtin_bit_cast(float, __builtin_amdgcn_ds_bpermute(src, __builtin_bit_cast(int, s1)));
                const float q2 = __builtin_bit_cast(float, __builtin_amdgcn_ds_bpermute(src, __builtin_bit_cast(int, s2))), q3 = __builtin_bit_cast(float, __builtin_amdgcn_ds_bpermute(src, __builtin_bit_cast(int, s3)));
                if ((c.lane >> 3) == rb) { my_e = ee; my_s = (ee & 2) ? ((ee & 1) ? q3 : q2) : ((ee & 1) ? q1 : q0); }
            }
            ++rb;
          }
          { const int rr = c.lane >> 3, k = c.lane & 7;
            const float tot = grp8_sum(my_s);
            const bool valid = rr < rb; const int id = (mb + rr * c.ngw) * TOPK + k; const float wt = my_s / tot * 2.5f;
            if (!cnt_sort) {
                if (valid) { const unsigned pos = atomicAdd(&CNT[(size_t)my_e * CNT_STRIDE], 1u);
                    LIST[(size_t)my_e * LCAP + pos] = id; POSREC[id] = (my_e << 16) | (int)pos; WTS[id] = wt; }
            } else {
                int lpos = 0; if (valid) lpos = atomicAdd(&histg[my_e], 1);
                __syncthreads();
                if (c.tid < 64) HIST[c.bid * 64 + c.tid] = histg[4 * c.tid] | (histg[4 * c.tid + 1] << 8) | (histg[4 * c.tid + 2] << 16) | (histg[4 * c.tid + 3] << 24);
                xcd_barrier(bar);
                { const int rg = c.tid >> 4, eb = c.tid & 15;
                  uint4 hv[8];
#pragma unroll
                  for (int j = 0; j < 8; ++j) { const int w = rg + 32 * j; hv[j] = make_uint4(0u, 0u, 0u, 0u); if (w < c.bid) hv[j] = *(const uint4*)&HIST[w * 64 + eb * 4]; }
                  int acc[16];
#pragma unroll
                  for (int i = 0; i < 16; ++i) acc[i] = 0;
#pragma unroll
                  for (int j = 0; j < 8; ++j) { const unsigned wd[4] = {hv[j].x, hv[j].y, hv[j].z, hv[j].w};
#pragma unroll
                      for (int q = 0; q < 4; ++q) { acc[4 * q] += (int)(wd[q] & 0xffu); acc[4 * q + 1] += (int)((wd[q] >> 8) & 0xffu); acc[4 * q + 2] += (int)((wd[q] >> 16) & 0xffu); acc[4 * q + 3] += (int)(wd[q] >> 24); } }
#pragma unroll
                  for (int q = 0; q < 4; ++q) *(int4*)&histg[1024 + rg * NE + eb * 16 + 4 * q] = make_int4(acc[4 * q], acc[4 * q + 1], acc[4 * q + 2], acc[4 * q + 3]); }
                __syncthreads();
                if (c.tid < NE) { int bs = 0;
#pragma unroll
                    for (int r = 0; r < 32; ++r) bs += histg[1024 + r * NE + c.tid];
                    histg[768 + c.tid] = bs; if (c.bid == c.nb - 1) HIST[NE * NE + c.tid] = bs + histg[c.tid]; }
                __syncthreads();
                if (valid) { const int pos = histg[768 + my_e] + lpos;
                    LIST[(size_t)my_e * LCAP + pos] = id; POSREC[id] = (my_e << 16) | pos; WTS[id] = wt; }
            } }
        }
    }
    SEAM(8);

    LAS int* pre = (LAS int*)(ldsb + pg8::STAGE_BYTES);
    LAS int* offs = pre + 320; LAS int* cntl = offs + 320; LAS int* utab9 = cntl + 256; LAS int* utab10 = utab9 + 16;
    if (IN(9) || IN(10) || IN(11)) {
        const Ctx c = mkctx(ws, lds_raw); PHASE_PTRS
        __syncthreads();
        if (c.tid < NE) cntl[c.tid] = ((MK_N_LAUNCHES == 1) && c.nb == NE && 8 * c.ngw == NTOK && lo < 8 && hi > 9) ? ((const int*)(wsp + WS_HIST))[NE * NE + c.tid] : (int)CNT[(size_t)c.tid * CNT_STRIDE];
        __syncthreads();
        LAS int* bsa = utab10 + 16; LAS int* bso = bsa + 16;
        if (c.tid < 16) { int a = 0, o = 0;
#pragma unroll
            for (int j = 0; j < 16; ++j) { const int q = cntl[16 * c.tid + j]; a += (q + 255) >> 8; o += q; } bsa[c.tid] = a; bso[c.tid] = o; }
        __syncthreads();
        if (c.tid <= NE) { int a = 0, o = 0; const int blk = c.tid >> 4;
            for (int t = 0; t < blk; ++t) { a += bsa[t]; o += bso[t]; }
            for (int j = 16 * blk; j < c.tid; ++j) { const int q = cntl[j]; a += (q + 255) >> 8; o += q; }
            pre[c.tid] = a; offs[c.tid] = o; }
        __syncthreads();
        if (c.tid < 16) pg8::MoeOrder::fill_table(utab9, pre, 2, c.nb, vcu, c.tid);
        else if (c.tid >= 64 && c.tid < 80) pg8::MoeOrder::fill_table(utab10, pre, 4, c.nb, vcu, c.tid - 64);
        __syncthreads();
    }
    if (IN(9)) for (int rep_ = 0; rep_ < (((REPEAT_MASK >> 9) & 1) ? 2 : 1); ++rep_) {
        const Ctx c = mkctx(ws, lds_raw); PHASE_PTRS
        pg8::MoeOrder S{pre, offs, cntl, LIST, (const char*)WGUT, (size_t)512 * DM * 2, DM, 2, c.nb, vcu, 0, conv_in_attn, utab9};
        pg8::EpiAct E{ACT};
        pg8::gemm_phase<pg8::EpiAct, pg8::MoeOrder, true, true>(ldsb, H2, DM, S, E);
    }
    SEAM(9);

    if (IN(10)) for (int rep_ = 0; rep_ < (((REPEAT_MASK >> 10) & 1) ? 2 : 1); ++rep_) {
        const Ctx c = mkctx(ws, lds_raw); PHASE_PTRS
        { pg8::MoeOrder S{pre, offs, cntl, LIST, (const char*)WDT, (size_t)DM * EFF * 2, EFF, 4, c.nb, vcu, 1, conv_in_attn, utab10};
          pg8::EpiSlots E{(unsigned char*)SLOTS};
          pg8::gemm_phase<pg8::EpiSlots, pg8::MoeOrder, true>(ldsb, ACT, EFF, S, E); }
        { pg8::DenseOrder S; S.init(NTOK, DM, EFF, WDST, c.nb, c.bid, true); pg8::EpiBf16 E{YSH, DM};
          pg8::gemm_phase<pg8::EpiBf16, pg8::DenseOrder, true>(ldsb, ACTS, EFF, S, E); }
    }
    SEAM(10);

    if (IN(11)) for (int rep_ = 0; rep_ < (((REPEAT_MASK >> 11) & 1) ? 2 : 1); ++rep_) {
        const Ctx c = mkctx(ws, lds_raw); PHASE_PTRS
        const unsigned char* SL8 = (const unsigned char*)SLOTS;
        typedef float f32x2v __attribute__((ext_vector_type(2)));
        const float* COEF = (const float*)(wsp + WS_COEF);
        typedef float f32x4v __attribute__((ext_vector_type(4)));
        LAS float* ctab = (LAS float*)ldsb;
        __syncthreads();
        { const float4 cv = *(const float4*)&COEF[(c.tid >> 8) * 4096 + 3072 + (c.tid & 255) * 4]; f32x4v o; o.x = cv.x; o.y = cv.y; o.z = cv.z; o.w = cv.w; *(LAS f32x4v*)&ctab[c.tid * 4] = o; }
        __syncthreads();
        const int nrw = (c.gw < NTOK) ? (NTOK - c.gw + c.ngw - 1) / c.ngw : 0;
        const int cc = 16 * c.lane;
        int recn = 0; float wtn = 0.f;
        int recf = 0; float wtf = 0.f;
        uint4 dsl[TOPK], dys[2], dx1[2]; float dwt = 0.f;
        if (nrw > 0 && c.lane < TOPK) { recn = POSREC[(size_t)c.gw * TOPK + c.lane]; wtn = WTS[(size_t)c.gw * TOPK + c.lane] * (1.f / 16.f); }
        if (nrw > 1 && c.lane < TOPK) { recf = POSREC[(size_t)(c.gw + c.ngw) * TOPK + c.lane]; wtf = WTS[(size_t)(c.gw + c.ngw) * TOPK + c.lane] * (1.f / 16.f); }
        if (nrw > 0) { const int m = c.gw; const int sr = offs[(recn >> 16) & 255] + (recn & 0xffff);
#pragma unroll
            for (int k = 0; k < TOPK; ++k) dsl[k] = *(const uint4*)&SL8[(size_t)__builtin_amdgcn_readlane(sr, k) * DM + cc];
            dys[0] = *(const uint4*)&YSH[(size_t)m * DM + cc]; dys[1] = *(const uint4*)&YSH[(size_t)m * DM + cc + 8];
#pragma unroll
            for (int hq = 0; hq < 2; ++hq) dx1[hq] = *(const uint4*)&X1[(size_t)m * DM + cc + 8 * hq];
            dwt = wtn; recn = recf; wtn = wtf; }
        for (int i = 0; i < nrw; ++i) {
            const int m = c.gw + i * c.ngw;
            if (i + 2 < nrw && c.lane < TOPK) { const int m2 = m + 2 * c.ngw; recf = POSREC[(size_t)m2 * TOPK + c.lane]; wtf = WTS[(size_t)m2 * TOPK + c.lane] * (1.f / 16.f); }
            uint4 csl[TOPK], cys[2], cx1[2]; const float cwt = dwt;
#pragma unroll
            for (int k = 0; k < TOPK; ++k) csl[k] = dsl[k];
            cys[0] = dys[0]; cys[1] = dys[1];
            cx1[0] = dx1[0]; cx1[1] = dx1[1];
            if (i + 1 < nrw) { const int m1 = m + c.ngw; const int sr = offs[(recn >> 16) & 255] + (recn & 0xffff);
#pragma unroll
                for (int k = 0; k < TOPK; ++k) dsl[k] = *(const uint4*)&SL8[(size_t)__builtin_amdgcn_readlane(sr, k) * DM + cc];
                dys[0] = *(const uint4*)&YSH[(size_t)m1 * DM + cc]; dys[1] = *(const uint4*)&YSH[(size_t)m1 * DM + cc + 8];
#pragma unroll
                for (int hq = 0; hq < 2; ++hq) dx1[hq] = *(const uint4*)&X1[(size_t)m1 * DM + cc + 8 * hq];
                dwt = wtn; recn = recf; wtn = wtf; }
            const int b = m / SEQ; const LAS float* cf = ctab + b * 1024;
            f32x4v ca[4];
#pragma unroll
            for (int hq = 0; hq < 4; ++hq) ca[hq] = *(const LAS f32x4v*)&cf[cc + 4 * hq];
            float y[16]; float ss = 0.f;
#pragma unroll
            for (int hq = 0; hq < 2; ++hq) { const uint4 u = cys[hq];
                y[8 * hq + 0] = bf2f(u.x & 0xffffu); y[8 * hq + 1] = bf2f(u.x >> 16); y[8 * hq + 2] = bf2f(u.y & 0xffffu); y[8 * hq + 3] = bf2f(u.y >> 16);
                y[8 * hq + 4] = bf2f(u.z & 0xffffu); y[8 * hq + 5] = bf2f(u.z >> 16); y[8 * hq + 6] = bf2f(u.w & 0xffffu); y[8 * hq + 7] = bf2f(u.w >> 16); }
#pragma unroll
            for (int k = 0; k < TOPK; ++k) { const uint4 u = csl[k]; const float wk = __builtin_bit_cast(float, __builtin_amdgcn_readlane(__builtin_bit_cast(int, cwt), k));
                const unsigned wds[4] = {u.x, u.y, u.z, u.w};
#pragma unroll
                for (int d = 0; d < 4; ++d) { const f32x2v a2 = __builtin_amdgcn_cvt_pk_f32_fp8((int)wds[d], false), b2 = __builtin_amdgcn_cvt_pk_f32_fp8((int)wds[d], true);
                    y[4 * d] += wk * a2.x; y[4 * d + 1] += wk * a2.y; y[4 * d + 2] += wk * b2.x; y[4 * d + 3] += wk * b2.y; } }
#pragma unroll
            for (int q = 0; q < 16; ++q) ss += y[q] * y[q];
            const float rstd = rsqrtf(wave_sum(ss) * (1.f / DM) + EPS);
#pragma unroll
            for (int hq = 0; hq < 4; ++hq) {
                const int c4 = cc + 4 * hq; uint2 xu; { const uint4 xw = cx1[hq >> 1]; xu = (hq & 1) ? make_uint2(xw.z, xw.w) : make_uint2(xw.x, xw.y); }
                float4 xx; xx.x = bf2f(xu.x & 0xffffu); xx.y = bf2f(xu.x >> 16); xx.z = bf2f(xu.y & 0xffffu); xx.w = bf2f(xu.y >> 16);
                float4 r; r.x = xx.x + ca[hq].x * (y[4 * hq] * rstd); r.y = xx.y + ca[hq].y * (y[4 * hq + 1] * rstd);
                r.z = xx.z + ca[hq].z * (y[4 * hq + 2] * rstd); r.w = xx.w + ca[hq].w * (y[4 * hq + 3] * rstd);
                *(float4*)&args.out[(size_t)m * DM + c4] = r;
            }
        }
    }
    }
#undef IN
#undef SEAM
}

constexpr int NPHASE = 12;

extern "C" void kernel_launch(void* const* d_in, const int* in_sizes, int n_in, void* d_out, int out_size, void* d_ws, size_t ws_size, hipStream_t stream) {
    static int grid = 0;
    if (grid == 0) {
        if (n_in != 26 || out_size != NTOK * DM || ws_size < WS_END) { fprintf(stderr, "kernel_launch: unexpected shapes (n_in %d, out %d, ws %zu)\n", n_in, out_size, ws_size); grid = -1; return; }
        int dev = 0, cus = 0, per_cu = 0;
        if (hipGetDevice(&dev) != hipSuccess || hipDeviceGetAttribute(&cus, hipDeviceAttributeMultiprocessorCount, dev) != hipSuccess) { grid = -1; return; }
        if (hipFuncSetAttribute((const void*)mega, hipFuncAttributeMaxDynamicSharedMemorySize, LDS_BYTES) != hipSuccess) { fprintf(stderr, "kernel_launch: hipFuncSetAttribute failed\n"); grid = -1; return; }
        if (hipOccupancyMaxActiveBlocksPerMultiprocessor(&per_cu, (const void*)mega, NTHR, LDS_BYTES) != hipSuccess || per_cu < 1) fprintf(stderr, "kernel_launch: occupancy query says %d\n", per_cu);
        (void)hipGetLastError();
        grid = cus;
    }
    if (grid < 0) return;
    (void)hipMemsetAsync((char*)d_ws + WS_CTL, 0, CTL_ZERO_BYTES, stream);
    Args a{};
    for (int i = 0; i < 26; ++i) a.in[i] = (const float*)d_in[i];
    a.out = (float*)d_out; a.ws = (unsigned char*)d_ws;
    if (MK_N_LAUNCHES == 1) { a.ph_lo = 0; a.ph_hi = NPHASE; hipLaunchKernelGGL(mega, dim3(grid), dim3(NTHR), LDS_BYTES, stream, a); }
    else for (int p = 0; p < NPHASE; ++p) { a.ph_lo = p; a.ph_hi = p + 1; hipLaunchKernelGGL(mega, dim3(grid), dim3(NTHR), LDS_BYTES, stream, a); }
}
```
